# Optimizing an MI355X kernel written in HIP

```python
import jax, jax.numpy as jnp
from jax import lax
import numpy as np

D_MODEL = 1024
BATCH = 2
SEQ = 8192
DEPTH = 2

N_META = 16
BLOCK = 128
ROPE_THETA = 10000.0
NORM_EPS = 1e-6
NEG_INF = -1e30

A_HEADS = 16
A_KV_HEADS = 2
A_HEAD_DIM = D_MODEL // A_HEADS
A_GROUP = A_HEADS // A_KV_HEADS
A_WINDOW = 128
A_Q_W = A_HEADS * A_HEAD_DIM
A_KV_W = A_KV_HEADS * A_HEAD_DIM
A_QKV = A_Q_W + 2 * A_KV_W

B_HEADS = 16
B_NOPE = 64
B_ROPE = 32
B_V = 64
B_Q_RANK = D_MODEL // 4
B_KV_RANK = D_MODEL // 8
B_IN = B_Q_RANK + B_KV_RANK + B_ROPE

N_GROUPS = 4
EXPERTS_PER_GROUP = 8
N_EXPERTS = N_GROUPS * EXPERTS_PER_GROUP
TOP_K = 2
D_EXPERT = D_MODEL // 4
MOE_BLOCK = 128

N_A_LAYERS = (DEPTH + 1) // 2
N_B_LAYERS = DEPTH // 2

kernel_name = "hybrid_swa_sink_mla_hier_moe_meta"


def rms_norm(x, g):
    xf = x.astype(jnp.float32)
    y = xf * lax.rsqrt(jnp.mean(xf * xf, axis=-1, keepdims=True) + NORM_EPS)
    return (y * g.astype(jnp.float32)).astype(x.dtype)


def rope_tables(length, dim):
    inv_freq = 1.0 / (ROPE_THETA ** (jnp.arange(0, dim, 2, dtype=jnp.float32) / dim))
    ang = jnp.arange(length, dtype=jnp.float32)[:, None] * inv_freq[None, :]
    return jnp.cos(ang), jnp.sin(ang)


def apply_rope(x, cos, sin):
    half = x.shape[-1] // 2
    xf = x.astype(jnp.float32)
    x1, x2 = xf[..., :half], xf[..., half:]
    return jnp.concatenate([x1 * cos - x2 * sin, x2 * cos + x1 * sin], axis=-1).astype(x.dtype)


def sink_softmax(s, sink):
    m = jnp.maximum(jnp.max(s, axis=-1, keepdims=True), sink)
    p = jnp.exp(s - m)
    return p / (jnp.sum(p, axis=-1, keepdims=True) + jnp.exp(sink - m))


def swa_sink_attention(h, w_qkv, b_qkv, sinks, w_o, b_o):
    B, L, _ = h.shape
    n_blk = (L - N_META) // BLOCK
    qkv = h @ w_qkv + b_qkv
    q = qkv[..., :A_Q_W].reshape(B, L, A_KV_HEADS, A_GROUP, A_HEAD_DIM)
    k = qkv[..., A_Q_W:A_Q_W + A_KV_W].reshape(B, L, A_KV_HEADS, A_HEAD_DIM)
    v = qkv[..., A_Q_W + A_KV_W:].reshape(B, L, A_KV_HEADS, A_HEAD_DIM)
    cos, sin = rope_tables(L, A_HEAD_DIM)
    q = apply_rope(q, cos[:, None, None], sin[:, None, None]) * (A_HEAD_DIM ** -0.5)
    k = apply_rope(k, cos[:, None], sin[:, None])
    sink = sinks.astype(jnp.float32).reshape(A_KV_HEADS, A_GROUP, 1, 1)

    qm, km, vm = q[:, :N_META], k[:, :N_META], v[:, :N_META]
    causal_m = jnp.tril(jnp.ones((N_META, N_META), dtype=bool))
    s_m = jnp.einsum('bqkgd,bskd->bkgqs', qm, km).astype(jnp.float32)
    p_m = sink_softmax(jnp.where(causal_m, s_m, NEG_INF), sink).astype(v.dtype)
    o_m = jnp.einsum('bkgqs,bskd->bqkgd', p_m, vm).reshape(B, N_META, A_Q_W)

    qr = q[:, N_META:].reshape(B, n_blk, BLOCK, A_KV_HEADS, A_GROUP, A_HEAD_DIM)
    kr = k[:, N_META:].reshape(B, n_blk, BLOCK, A_KV_HEADS, A_HEAD_DIM)
    vr = v[:, N_META:].reshape(B, n_blk, BLOCK, A_KV_HEADS, A_HEAD_DIM)

    def band(t, t_meta):
        prev = jnp.concatenate([jnp.zeros_like(t[:, :1]), t[:, :-1]], axis=1)
        meta = jnp.broadcast_to(t_meta[:, None], (B, n_blk) + t_meta.shape[1:])
        return jnp.concatenate([meta, prev, t], axis=2)

    kb, vb = band(kr, km), band(vr, vm)
    i = jnp.arange(BLOCK)[:, None]
    j = jnp.arange(BLOCK)[None, :]
    blk = jnp.arange(n_blk)[:, None, None]
    prev_ok = ((BLOCK + i - j) < A_WINDOW)[None] & (blk > 0)
    cur_ok = ((j <= i) & ((i - j) < A_WINDOW))[None]
    mask = jnp.concatenate([
        jnp.ones((n_blk, BLOCK, N_META), dtype=bool),
        jnp.broadcast_to(prev_ok, (n_blk, BLOCK, BLOCK)),
        jnp.broadcast_to(cur_ok, (n_blk, BLOCK, BLOCK))], axis=-1)
    s = jnp.einsum('bnqkgd,bnskd->bnkgqs', qr, kb).astype(jnp.float32)
    p = sink_softmax(jnp.where(mask[:, None, None], s, NEG_INF), sink).astype(v.dtype)
    o_r = jnp.einsum('bnkgqs,bnskd->bnqkgd', p, vb).reshape(B, n_blk * BLOCK, A_Q_W)

    o = jnp.concatenate([o_m, o_r], axis=1)
    return o @ w_o + b_o


def mla_attention(h, w_in, q_norm, kv_norm, w_uq, w_ukv, w_o):
    B, L, _ = h.shape
    n_blk = (L - N_META) // BLOCK
    c = h @ w_in
    c_q = c[..., :B_Q_RANK]
    c_kv = c[..., B_Q_RANK:B_Q_RANK + B_KV_RANK]
    k_pe = c[..., B_Q_RANK + B_KV_RANK:]
    q = (rms_norm(c_q, q_norm) @ w_uq).reshape(B, L, B_HEADS, B_NOPE + B_ROPE)
    kv = (rms_norm(c_kv, kv_norm) @ w_ukv).reshape(B, L, B_HEADS, B_NOPE + B_V)
    q_nope, q_pe = q[..., :B_NOPE], q[..., B_NOPE:]
    k_nope, v = kv[..., :B_NOPE], kv[..., B_NOPE:]
    cos, sin = rope_tables(L, B_ROPE)
    scale = (B_NOPE + B_ROPE) ** -0.5
    q_nope = q_nope * scale
    q_pe = apply_rope(q_pe, cos[:, None], sin[:, None]) * scale
    k_pe = apply_rope(k_pe, cos, sin)

    causal_m = jnp.tril(jnp.ones((N_META, N_META), dtype=bool))
    s_m = (jnp.einsum('bqhd,bshd->bhqs', q_nope[:, :N_META], k_nope[:, :N_META])
           + jnp.einsum('bqhd,bsd->bhqs', q_pe[:, :N_META], k_pe[:, :N_META])).astype(jnp.float32)
    p_m = jax.nn.softmax(jnp.where(causal_m, s_m, NEG_INF), axis=-1).astype(v.dtype)
    o_m = jnp.einsum('bhqs,bshd->bqhd', p_m, v[:, :N_META]).reshape(B, N_META, B_HEADS * B_V)

    qn_blocks = q_nope[:, N_META:].reshape(B, n_blk, BLOCK, B_HEADS, B_NOPE).transpose(1, 0, 2, 3, 4)
    qp_blocks = q_pe[:, N_META:].reshape(B, n_blk, BLOCK, B_HEADS, B_ROPE).transpose(1, 0, 2, 3, 4)
    k_pos = jnp.arange(L)

    def attend_block(args):
        qn, qp, b = args
        q_pos = N_META + b * BLOCK + jnp.arange(BLOCK)
        s = (jnp.einsum('bqhd,bshd->bhqs', qn, k_nope)
             + jnp.einsum('bqhd,bsd->bhqs', qp, k_pe)).astype(jnp.float32)
        s = jnp.where(k_pos[None, :] <= q_pos[:, None], s, NEG_INF)
        p = jax.nn.softmax(s, axis=-1).astype(v.dtype)
        return jnp.einsum('bhqs,bshd->bqhd', p, v)

    o_r = lax.map(attend_block, (qn_blocks, qp_blocks, jnp.arange(n_blk)))
    o_r = o_r.transpose(1, 0, 2, 3, 4).reshape(B, n_blk * BLOCK, B_HEADS * B_V)
    o = jnp.concatenate([o_m, o_r], axis=1)
    return o @ w_o


def hierarchical_moe(h, w_group, b_group, w_router, b_router, w_gate, w_up, w_down):
    B, L, D = h.shape
    T = B * L
    x = h.reshape(T, D)
    g_prob = jax.nn.softmax((x @ w_group).astype(jnp.float32) + b_group.astype(jnp.float32), axis=-1)
    g_p, g_idx = lax.top_k(g_prob, 1)
    e_logits = ((x @ w_router).astype(jnp.float32) + b_router.astype(jnp.float32)).reshape(T, N_GROUPS, EXPERTS_PER_GROUP)
    e_logits = jnp.take_along_axis(e_logits, g_idx[:, :, None], axis=1)[:, 0]
    e_prob = jax.nn.softmax(e_logits, axis=-1)
    e_p, e_idx = lax.top_k(e_prob, TOP_K)
    weights = g_p * e_p / jnp.sum(e_p, axis=-1, keepdims=True)
    expert_ids = g_idx * EXPERTS_PER_GROUP + e_idx

    n_slots = T * TOP_K
    slot_expert = expert_ids.reshape(-1)
    slot_token = jnp.repeat(jnp.arange(T), TOP_K)
    slot_weight = weights.reshape(-1)
    order = jnp.argsort(slot_expert)
    se, st, sw = slot_expert[order], slot_token[order], slot_weight[order]
    counts = jnp.bincount(slot_expert, length=N_EXPERTS)
    starts = jnp.cumsum(counts) - counts
    padded = (counts + MOE_BLOCK - 1) // MOE_BLOCK * MOE_BLOCK
    pends = jnp.cumsum(padded)
    pstarts = pends - padded
    dest = pstarts[se] + jnp.arange(n_slots) - starts[se]
    n_blocks = -(-(n_slots + N_EXPERTS * (MOE_BLOCK - 1)) // MOE_BLOCK)
    buf = jnp.zeros((n_blocks * MOE_BLOCK, D), x.dtype).at[dest].set(x[st])
    block_expert = jnp.minimum(jnp.searchsorted(pends, jnp.arange(n_blocks) * MOE_BLOCK, side='right'), N_EXPERTS - 1)

    def expert_block(args):
        xb, e = args
        return (jax.nn.silu(xb @ w_gate[e]) * (xb @ w_up[e])) @ w_down[e]

    y_buf = lax.map(expert_block, (buf.reshape(n_blocks, MOE_BLOCK, D), block_expert)).reshape(-1, D)
    y = jax.ops.segment_sum(y_buf[dest] * sw[:, None].astype(y_buf.dtype), st, num_segments=T)
    return y.reshape(B, L, D)


def setup_inputs(seed: int = 0) -> dict:
    key = jax.random.key(seed)
    ks = iter(jax.random.split(key, 32))
    f32 = jnp.float32

    def nrm(shape):
        return jax.random.normal(next(ks), shape, f32)

    def dense(shape, fan_in):
        return nrm(shape) * (fan_in ** -0.5)

    def gain(shape):
        return 1.0 + 0.02 * nrm(shape)

    return {
        "x": nrm((BATCH, SEQ, D_MODEL)),
        "meta_tokens": nrm((N_META, D_MODEL)),
        "attn_norm": gain((DEPTH, D_MODEL)),
        "ffn_norm": gain((DEPTH, D_MODEL)),
        "final_norm": gain((D_MODEL,)),
        "a_w_qkv": dense((N_A_LAYERS, D_MODEL, A_QKV), D_MODEL),
        "a_b_qkv": 0.02 * nrm((N_A_LAYERS, A_QKV)),
        "a_sinks": 0.5 * nrm((N_A_LAYERS, A_HEADS)),
        "a_w_o": dense((N_A_LAYERS, A_Q_W, D_MODEL), A_Q_W),
        "a_b_o": 0.02 * nrm((N_A_LAYERS, D_MODEL)),
        "b_w_in": dense((N_B_LAYERS, D_MODEL, B_IN), D_MODEL),
        "b_q_norm": gain((N_B_LAYERS, B_Q_RANK)),
        "b_kv_norm": gain((N_B_LAYERS, B_KV_RANK)),
        "b_w_uq": dense((N_B_LAYERS, B_Q_RANK, B_HEADS * (B_NOPE + B_ROPE)), B_Q_RANK),
        "b_w_ukv": dense((N_B_LAYERS, B_KV_RANK, B_HEADS * (B_NOPE + B_V)), B_KV_RANK),
        "b_w_o": dense((N_B_LAYERS, B_HEADS * B_V, D_MODEL), B_HEADS * B_V),
        "moe_w_group": dense((DEPTH, D_MODEL, N_GROUPS), D_MODEL),
        "moe_b_group": 0.01 * nrm((DEPTH, N_GROUPS)),
        "moe_w_router": dense((DEPTH, D_MODEL, N_EXPERTS), D_MODEL),
        "moe_b_router": 0.01 * nrm((DEPTH, N_EXPERTS)),
        "moe_w_gate": dense((DEPTH, N_EXPERTS, D_MODEL, D_EXPERT), D_MODEL),
        "moe_w_up": dense((DEPTH, N_EXPERTS, D_MODEL, D_EXPERT), D_MODEL),
        "moe_w_down": dense((DEPTH, N_EXPERTS, D_EXPERT, D_MODEL), D_EXPERT),
    }


def reference(x, meta_tokens, attn_norm, ffn_norm, final_norm,
              a_w_qkv, a_b_qkv, a_sinks, a_w_o, a_b_o,
              b_w_in, b_q_norm, b_kv_norm, b_w_uq, b_w_ukv, b_w_o,
              moe_w_group, moe_b_group, moe_w_router, moe_b_router,
              moe_w_gate, moe_w_up, moe_w_down):
    B = x.shape[0]
    meta = jnp.broadcast_to(meta_tokens[None].astype(x.dtype), (B, N_META, D_MODEL))
    h = jnp.concatenate([meta, x], axis=1)
    for i in range(DEPTH):
        hn = rms_norm(h, attn_norm[i])
        if i % 2 == 0:
            j = i // 2
            mix = swa_sink_attention(hn, a_w_qkv[j], a_b_qkv[j], a_sinks[j], a_w_o[j], a_b_o[j])
        else:
            j = i // 2
            mix = mla_attention(hn, b_w_in[j], b_q_norm[j], b_kv_norm[j], b_w_uq[j], b_w_ukv[j], b_w_o[j])
        h = h + mix
        h = h + hierarchical_moe(rms_norm(h, ffn_norm[i]), moe_w_group[i], moe_b_group[i],
                                 moe_w_router[i], moe_b_router[i],
                                 moe_w_gate[i], moe_w_up[i], moe_w_down[i])
    return rms_norm(h, final_norm)[:, N_META:]
```

```cpp
#include <hip/hip_runtime.h>
#include <cstdio>
#include <cstdint>

typedef unsigned short bf16_t;

constexpr int D = 1024, SEQ = 8192, NB = 2, NMETA = 16;
constexpr int MREAL = NB * SEQ;
constexpr int MTOT = MREAL + NB * NMETA;
constexpr int LPOS = NMETA + SEQ;
constexpr int NQKV = 1280;
constexpr int NE = 32, DE = 256;
constexpr int CAP = MTOT * 2;
constexpr float EPS = 1e-6f;

__device__ __forceinline__ float bf2f(bf16_t v) { return __uint_as_float(((unsigned)v) << 16); }
__device__ __forceinline__ bf16_t f2bf(float f) { unsigned u = __float_as_uint(f); u += 0x7fffu + ((u >> 16) & 1u); return (bf16_t)(u >> 16); }
__device__ __forceinline__ int row_pos(int row) { return row < MREAL ? NMETA + (row & (SEQ - 1)) : ((row - MREAL) & (NMETA - 1)); }
__device__ __forceinline__ int row_batch(int row) { return row < MREAL ? (row >> 13) : ((row - MREAL) >> 4); }
__device__ __forceinline__ float wave_sum(float v) {
#pragma unroll
    for (int o = 1; o < 64; o <<= 1) v += __shfl_xor(v, o);
    return v;
}

constexpr size_t MiB = 1u << 20;
constexpr size_t WS_CTL = 0;
constexpr size_t WS_ROPE = 1 * MiB;
constexpr size_t WS_RSTD = 4 * MiB;
constexpr size_t WS_WSLOT = WS_RSTD + 128 * 1024;
constexpr size_t WS_EID = WS_WSLOT + 256 * 1024;
constexpr size_t WS_LIST = 5 * MiB;
constexpr size_t WS_HB = 10 * MiB;
constexpr size_t WS_RB = 43 * MiB;
constexpr size_t WS_RC = 124 * MiB;
constexpr size_t WS_END = 256 * MiB;
constexpr size_t RB_QKV = WS_RB, RB_O = WS_RB + 41 * MiB;
constexpr size_t RC_CQN = WS_RC, RC_CKVN = WS_RC + 9 * MiB, RC_KPE = WS_RC + 14 * MiB, RC_Q1 = WS_RC + 16 * MiB, RC_K1 = WS_RC + 65 * MiB, RC_V1 = WS_RC + 98 * MiB;
static_assert(RC_V1 + (size_t)MTOT * 2048 <= WS_END, "ws map");

__global__ void k_rope_table(float2* cs) {
    int idx = blockIdx.x * blockDim.x + threadIdx.x;
    if (idx >= LPOS * 32) return;
    int pos = idx >> 5, i = idx & 31;
    float inv = 1.0f / powf(10000.0f, (float)(2 * i) / 64.0f);
    float ang = (float)pos * inv;
    float s, c; sincosf(ang, &s, &c);
    cs[idx] = make_float2(c, s);
}

__global__ void k_h0(const float* __restrict__ x, const float* __restrict__ meta, bf16_t* hb, float* rstd) {
    int row = blockIdx.x * 4 + (threadIdx.x >> 6), lane = threadIdx.x & 63;
    if (row >= MTOT) return;
    const float* src = row < MREAL ? x + (size_t)row * D : meta + (size_t)row_pos(row) * D;
    float ss = 0.f;
    for (int j = 0; j < 16; ++j) { float v = src[j * 64 + lane]; ss += v * v; hb[(size_t)row * D + j * 64 + lane] = f2bf(v); }
    ss = wave_sum(ss);
    if (lane == 0) rstd[row] = rsqrtf(ss * (1.0f / D) + EPS);
}

__global__ void k_ngemm(const bf16_t* __restrict__ A, int lda, const float* __restrict__ gain, const float* __restrict__ W, int ldw, int woff,
                        const float* __restrict__ rstd, const float* __restrict__ bias, const bf16_t* __restrict__ resid, int ldr,
                        float* C, int ldc, int M, int N, int K) {
    __shared__ float As[16][65];
    __shared__ float Ws[16][64];
    const int tx = threadIdx.x & 15, ty = threadIdx.x >> 4;
    const int m0 = blockIdx.y * 64, n0 = blockIdx.x * 64;
    float acc[4][4];
#pragma unroll
    for (int i = 0; i < 4; ++i)
#pragma unroll
        for (int j = 0; j < 4; ++j) acc[i][j] = 0.f;
    for (int k0 = 0; k0 < K; k0 += 16) {
#pragma unroll
        for (int i = 0; i < 4; ++i) {
            int idx = threadIdx.x + i * 256; int r = idx >> 4, kk = idx & 15; int row = m0 + r;
            float v = 0.f; if (row < M) { v = bf2f(A[(size_t)row * lda + k0 + kk]); if (gain) v *= gain[k0 + kk]; }
            As[kk][r] = v;
        }
#pragma unroll
        for (int i = 0; i < 4; ++i) {
            int idx = threadIdx.x + i * 256; int kk = idx >> 6, c = idx & 63; int col = n0 + c;
            Ws[kk][c] = (col < N) ? W[(size_t)(k0 + kk) * ldw + woff + col] : 0.f;
        }
        __syncthreads();
#pragma unroll
        for (int kk = 0; kk < 16; ++kk) {
            float a[4], w[4];
#pragma unroll
            for (int i = 0; i < 4; ++i) a[i] = As[kk][ty * 4 + i];
#pragma unroll
            for (int j = 0; j < 4; ++j) w[j] = Ws[kk][tx * 4 + j];
#pragma unroll
            for (int i = 0; i < 4; ++i)
#pragma unroll
                for (int j = 0; j < 4; ++j) acc[i][j] += a[i] * w[j];
        }
        __syncthreads();
    }
#pragma unroll
    for (int i = 0; i < 4; ++i)
#pragma unroll
        for (int j = 0; j < 4; ++j) {
            int row = m0 + ty * 4 + i, col = n0 + tx * 4 + j;
            if (row < M && col < N) {
                float v = acc[i][j];
                if (rstd) v *= rstd[row];
                if (bias) v += bias[woff + col];
                if (resid) v += bf2f(resid[(size_t)row * ldr + col]);
                C[(size_t)row * ldc + col] = v;
            }
        }
}

__global__ void k_qkv_epi(const float* __restrict__ scr, const float2* __restrict__ cs, bf16_t* qkv) {
    size_t idx = (size_t)blockIdx.x * blockDim.x + threadIdx.x;
    if (idx >= (size_t)MTOT * NQKV) return;
    int row = (int)(idx / NQKV), col = (int)(idx % NQKV);
    float out;
    if (col < 1152) {
        int d = col & 63, i = d & 31, base = col - d;
        float2 c = cs[row_pos(row) * 32 + i];
        float x1 = scr[(size_t)row * NQKV + base + i], x2 = scr[(size_t)row * NQKV + base + i + 32];
        out = d < 32 ? x1 * c.x - x2 * c.y : x2 * c.x + x1 * c.y;
        if (col < 1024) out *= 0.125f;
    } else out = scr[idx];
    qkv[idx] = f2bf(out);
}

__global__ void __launch_bounds__(64) k_swa_naive(const bf16_t* __restrict__ qkv, const float* __restrict__ sinks, bf16_t* o) {
    int idx = blockIdx.x * blockDim.x + threadIdx.x;
    if (idx >= MTOT * 16) return;
    int head = idx / MTOT, row = idx % MTOT;
    int b = row_batch(row), kh = head >> 3;
    float q[64];
#pragma unroll
    for (int d = 0; d < 64; ++d) q[d] = bf2f(qkv[(size_t)row * NQKV + head * 64 + d]);
    float m = sinks[head], l = 1.0f, acc[64];
#pragma unroll
    for (int d = 0; d < 64; ++d) acc[d] = 0.f;
    int nmeta, t0, t1;
    if (row < MREAL) { int t = row & (SEQ - 1); nmeta = NMETA; t0 = t - 127 < 0 ? 0 : t - 127; t1 = t; }
    else { nmeta = ((row - MREAL) & 15) + 1; t0 = 0; t1 = -1; }
    int nk = nmeta + (t1 - t0 + 1);
    for (int j = 0; j < nk; ++j) {
        int krow = j < nmeta ? MREAL + b * NMETA + j : b * SEQ + t0 + (j - nmeta);
        const bf16_t* kp = qkv + (size_t)krow * NQKV + 1024 + kh * 64;
        const bf16_t* vp = qkv + (size_t)krow * NQKV + 1152 + kh * 64;
        float s = 0.f;
#pragma unroll
        for (int d = 0; d < 64; ++d) s += q[d] * bf2f(kp[d]);
        float mn = fmaxf(m, s), sc = __expf(m - mn), p = __expf(s - mn);
        l = l * sc + p; m = mn;
#pragma unroll
        for (int d = 0; d < 64; ++d) acc[d] = acc[d] * sc + p * bf2f(vp[d]);
    }
    float inv = 1.0f / l;
#pragma unroll
    for (int d = 0; d < 64; ++d) o[(size_t)row * D + head * 64 + d] = f2bf(acc[d] * inv);
}

__global__ void k_row_router(const float* __restrict__ hf, const float* __restrict__ g, const float* __restrict__ wg, const float* __restrict__ bg,
                             const float* __restrict__ wr, const float* __restrict__ br, bf16_t* hb, float* rstd_out,
                             int* cnt, int* list, float* wslot, int* eid) {
    int row = blockIdx.x * 4 + (threadIdx.x >> 6), lane = threadIdx.x & 63;
    if (row >= MTOT) return;
    float x[16]; float ss = 0.f;
#pragma unroll
    for (int j = 0; j < 16; ++j) { float v = hf[(size_t)row * D + j * 64 + lane]; x[j] = v; ss += v * v; hb[(size_t)row * D + j * 64 + lane] = f2bf(v); }
    ss = wave_sum(ss);
    float rs = rsqrtf(ss * (1.0f / D) + EPS);
    if (lane == 0) rstd_out[row] = rs;
#pragma unroll
    for (int j = 0; j < 16; ++j) x[j] = x[j] * rs * g[j * 64 + lane];
    float lg[4], le[32];
#pragma unroll
    for (int c = 0; c < 4; ++c) { float p = 0.f;
#pragma unroll
        for (int j = 0; j < 16; ++j) p += x[j] * wg[(size_t)(j * 64 + lane) * 4 + c];
        lg[c] = wave_sum(p) + bg[c]; }
#pragma unroll
    for (int c = 0; c < 32; ++c) { float p = 0.f;
#pragma unroll
        for (int j = 0; j < 16; ++j) p += x[j] * wr[(size_t)(j * 64 + lane) * 32 + c];
        le[c] = wave_sum(p) + br[c]; }
    if (lane == 0) {
        int gi = 0; float gm = lg[0];
#pragma unroll
        for (int c = 1; c < 4; ++c) if (lg[c] > gm) { gm = lg[c]; gi = c; }
        float gs = 0.f;
#pragma unroll
        for (int c = 0; c < 4; ++c) gs += __expf(lg[c] - gm);
        float gp = 1.0f / gs;
        float e[8];
#pragma unroll
        for (int c = 0; c < 8; ++c) { float v = le[c];
#pragma unroll
            for (int q = 1; q < 4; ++q) if (gi == q) v = le[q * 8 + c];
            e[c] = v; }
        int i1 = 0; float v1 = e[0];
#pragma unroll
        for (int c = 1; c < 8; ++c) if (e[c] > v1) { v1 = e[c]; i1 = c; }
        int i2 = -1; float v2 = -3.0e38f;
#pragma unroll
        for (int c = 0; c < 8; ++c) if (c != i1 && e[c] > v2) { v2 = e[c]; i2 = c; }
        float r = __expf(v2 - v1);
        float w1 = gp / (1.0f + r), w2 = gp * r / (1.0f + r);
        int e1 = gi * 8 + i1, e2 = gi * 8 + i2;
        int p1 = atomicAdd(&cnt[e1], 1); list[(size_t)e1 * CAP + p1] = row * 2;
        int p2 = atomicAdd(&cnt[e2], 1); list[(size_t)e2 * CAP + p2] = row * 2 + 1;
        wslot[row * 2] = w1; wslot[row * 2 + 1] = w2; eid[row * 2] = e1; eid[row * 2 + 1] = e2;
    }
}

__global__ void k_moe_naive(const bf16_t* __restrict__ hb, const float* __restrict__ rstd, const float* __restrict__ g,
                            const float* __restrict__ wgate, const float* __restrict__ wup, const float* __restrict__ wdown,
                            const int* __restrict__ eid, const float* __restrict__ wslot, bf16_t* ybuf) {
    __shared__ float xs[1024];
    __shared__ float hs[256];
    int slot = blockIdx.x, row = slot >> 1, tid = threadIdx.x;
    int e = eid[slot];
    float rs = rstd[row];
    for (int k = tid; k < 1024; k += 256) xs[k] = bf2f(hb[(size_t)row * D + k]) * g[k];
    __syncthreads();
    const float* Wg = wgate + (size_t)e * D * DE; const float* Wu = wup + (size_t)e * D * DE; const float* Wd = wdown + (size_t)e * DE * D;
    float a = 0.f, u = 0.f;
    for (int k = 0; k < 1024; ++k) { float xv = xs[k]; a += xv * Wg[(size_t)k * DE + tid]; u += xv * Wu[(size_t)k * DE + tid]; }
    a *= rs; u *= rs;
    hs[tid] = (a / (1.0f + __expf(-a))) * u;
    __syncthreads();
    float w = wslot[slot];
    for (int c = tid; c < 1024; c += 256) {
        float y = 0.f;
        for (int j = 0; j < 256; ++j) y += hs[j] * Wd[(size_t)j * D + c];
        ybuf[(size_t)slot * D + c] = f2bf(y * w);
    }
}

__global__ void k_combine(bf16_t* hb, const bf16_t* __restrict__ ybuf, float* rstd) {
    int row = blockIdx.x * 4 + (threadIdx.x >> 6), lane = threadIdx.x & 63;
    if (row >= MTOT) return;
    float ss = 0.f;
    for (int j = 0; j < 16; ++j) {
        size_t c = j * 64 + lane;
        float v = bf2f(hb[(size_t)row * D + c]) + bf2f(ybuf[(size_t)(row * 2) * D + c]) + bf2f(ybuf[(size_t)(row * 2 + 1) * D + c]);
        ss += v * v; hb[(size_t)row * D + c] = f2bf(v);
    }
    ss = wave_sum(ss);
    if (lane == 0) rstd[row] = rsqrtf(ss * (1.0f / D) + EPS);
}

__global__ void k_c_epi(const float* __restrict__ c, const float2* __restrict__ cs, bf16_t* cqn, bf16_t* ckvn, bf16_t* kpe) {
    int row = blockIdx.x * 4 + (threadIdx.x >> 6), lane = threadIdx.x & 63;
    if (row >= MTOT) return;
    const float* cr = c + (size_t)row * 416;
    float q[4]; float ss = 0.f;
    for (int j = 0; j < 4; ++j) { q[j] = cr[j * 64 + lane]; ss += q[j] * q[j]; }
    ss = wave_sum(ss); float rq = rsqrtf(ss * (1.0f / 256) + EPS);
    for (int j = 0; j < 4; ++j) cqn[(size_t)row * 256 + j * 64 + lane] = f2bf(q[j] * rq);
    float k0 = cr[256 + lane], k1 = cr[320 + lane];
    float s2 = wave_sum(k0 * k0 + k1 * k1); float rk = rsqrtf(s2 * (1.0f / 128) + EPS);
    ckvn[(size_t)row * 128 + lane] = f2bf(k0 * rk); ckvn[(size_t)row * 128 + 64 + lane] = f2bf(k1 * rk);
    if (lane < 32) {
        int i = lane & 15; float2 t = cs[row_pos(row) * 32 + 2 * i];
        float x1 = cr[384 + i], x2 = cr[384 + 16 + i];
        float out = lane < 16 ? x1 * t.x - x2 * t.y : x2 * t.x + x1 * t.y;
        kpe[(size_t)row * 32 + lane] = f2bf(out);
    }
}

__global__ void k_q_epi(const float* __restrict__ scr, const float2* __restrict__ cs, bf16_t* Q1, int h0) {
    size_t idx = (size_t)blockIdx.x * blockDim.x + threadIdx.x;
    if (idx >= (size_t)MTOT * 768) return;
    int row = (int)(idx / 768), col = (int)(idx % 768), d = col % 96, base = col - d;
    const float scale = 0.10206207261596577f;
    float out;
    if (d < 64) out = scr[idx];
    else { int dd = d - 64, i = dd & 15; float2 t = cs[row_pos(row) * 32 + 2 * i];
        float x1 = scr[(size_t)row * 768 + base + 64 + i], x2 = scr[(size_t)row * 768 + base + 64 + 16 + i];
        out = dd < 16 ? x1 * t.x - x2 * t.y : x2 * t.x + x1 * t.y; }
    Q1[(size_t)row * 1536 + h0 * 96 + col] = f2bf(out * scale);
}
__global__ void k_kv_epi(const float* __restrict__ scr, bf16_t* K1, bf16_t* V1, int h0) {
    size_t idx = (size_t)blockIdx.x * blockDim.x + threadIdx.x;
    if (idx >= (size_t)MTOT * 1024) return;
    int row = (int)(idx >> 10), col = (int)(idx & 1023), h = h0 + (col >> 7), d = col & 127;
    bf16_t v = f2bf(scr[idx]);
    if (d < 64) K1[(size_t)row * D + h * 64 + d] = v; else V1[(size_t)row * D + h * 64 + d - 64] = v;
}

__global__ void __launch_bounds__(64) k_mla_naive(const bf16_t* __restrict__ Q1, const bf16_t* __restrict__ K1, const bf16_t* __restrict__ V1,
                                                  const bf16_t* __restrict__ kpe, bf16_t* o) {
    int idx = blockIdx.x * blockDim.x + threadIdx.x;
    if (idx >= MTOT * 16) return;
    int head = idx / MTOT, row = idx % MTOT;
    int b = row_batch(row);
    float q[96];
#pragma unroll
    for (int d = 0; d < 96; ++d) q[d] = bf2f(Q1[(size_t)row * 1536 + head * 96 + d]);
    float m = -1e30f, l = 0.f, acc[64];
#pragma unroll
    for (int d = 0; d < 64; ++d) acc[d] = 0.f;
    int nmeta, nreal;
    if (row < MREAL) { nmeta = NMETA; nreal = (row & (SEQ - 1)) + 1; } else { nmeta = ((row - MREAL) & 15) + 1; nreal = 0; }
    int nk = nmeta + nreal;
    for (int j = 0; j < nk; ++j) {
        int krow = j < nmeta ? MREAL + b * NMETA + j : b * SEQ + (j - nmeta);
        const bf16_t* kp = K1 + (size_t)krow * D + head * 64; const bf16_t* pp = kpe + (size_t)krow * 32; const bf16_t* vp = V1 + (size_t)krow * D + head * 64;
        float s = 0.f;
#pragma unroll
        for (int d = 0; d < 64; ++d) s += q[d] * bf2f(kp[d]);
#pragma unroll
        for (int d = 0; d < 32; ++d) s += q[64 + d] * bf2f(pp[d]);
        float mn = fmaxf(m, s), sc = __expf(m - mn), p = __expf(s - mn);
        l = l * sc + p; m = mn;
#pragma unroll
        for (int d = 0; d < 64; ++d) acc[d] = acc[d] * sc + p * bf2f(vp[d]);
    }
    float inv = 1.0f / l;
#pragma unroll
    for (int d = 0; d < 64; ++d) o[(size_t)row * D + head * 64 + d] = f2bf(acc[d] * inv);
}

__global__ void k_final(const bf16_t* __restrict__ hb, const bf16_t* __restrict__ ybuf, const float* __restrict__ g, float* out) {
    int row = blockIdx.x * 4 + (threadIdx.x >> 6), lane = threadIdx.x & 63;
    if (row >= MREAL) return;
    float v[16]; float ss = 0.f;
    for (int j = 0; j < 16; ++j) { size_t c = j * 64 + lane;
        v[j] = bf2f(hb[(size_t)row * D + c]) + bf2f(ybuf[(size_t)(row * 2) * D + c]) + bf2f(ybuf[(size_t)(row * 2 + 1) * D + c]); ss += v[j] * v[j]; }
    ss = wave_sum(ss); float rs = rsqrtf(ss * (1.0f / D) + EPS);
    for (int j = 0; j < 16; ++j) out[(size_t)row * D + j * 64 + lane] = v[j] * rs * g[j * 64 + lane];
}

static void ngemm(hipStream_t s, const bf16_t* A, int lda, const float* gain, const float* W, int ldw, int woff, const float* rstd, const float* bias,
                  const bf16_t* resid, int ldr, float* C, int ldc, int M, int N, int K) {
    dim3 grid((N + 63) / 64, (M + 63) / 64);
    hipLaunchKernelGGL(k_ngemm, grid, dim3(256), 0, s, A, lda, gain, W, ldw, woff, rstd, bias, resid, ldr, C, ldc, M, N, K);
}

extern "C" void kernel_launch(void* const* d_in, const int* in_sizes, int n_in, void* d_out, int out_size, void* d_ws, size_t ws_size, hipStream_t stream) {
    if (n_in != 23 || ws_size < WS_END) { fprintf(stderr, "kernel_launch: unexpected n_in %d or ws_size %zu\n", n_in, ws_size); return; }
    const float* x = (const float*)d_in[0]; const float* meta = (const float*)d_in[1];
    const float* attn_norm = (const float*)d_in[2]; const float* ffn_norm = (const float*)d_in[3]; const float* final_norm = (const float*)d_in[4];
    const float* a_w_qkv = (const float*)d_in[5]; const float* a_b_qkv = (const float*)d_in[6]; const float* a_sinks = (const float*)d_in[7];
    const float* a_w_o = (const float*)d_in[8]; const float* a_b_o = (const float*)d_in[9];
    const float* b_w_in = (const float*)d_in[10]; const float* b_q_norm = (const float*)d_in[11]; const float* b_kv_norm = (const float*)d_in[12];
    const float* b_w_uq = (const float*)d_in[13]; const float* b_w_ukv = (const float*)d_in[14]; const float* b_w_o = (const float*)d_in[15];
    const float* moe_w_group = (const float*)d_in[16]; const float* moe_b_group = (const float*)d_in[17];
    const float* moe_w_router = (const float*)d_in[18]; const float* moe_b_router = (const float*)d_in[19];
    const float* moe_w_gate = (const float*)d_in[20]; const float* moe_w_up = (const float*)d_in[21]; const float* moe_w_down = (const float*)d_in[22];
    char* ws = (char*)d_ws;
    int* cnt = (int*)(ws + WS_CTL);
    float2* cs = (float2*)(ws + WS_ROPE);
    float* rstd = (float*)(ws + WS_RSTD); float* wslot = (float*)(ws + WS_WSLOT); int* eid = (int*)(ws + WS_EID); int* list = (int*)(ws + WS_LIST);
    bf16_t* hb = (bf16_t*)(ws + WS_HB);
    bf16_t* qkv = (bf16_t*)(ws + RB_QKV); bf16_t* o0 = (bf16_t*)(ws + RB_O); bf16_t* ybuf0 = (bf16_t*)(ws + WS_RB);
    float* scr = (float*)(ws + WS_RC); float* hf = (float*)(ws + WS_RC);
    const int rowblocks = (MTOT + 3) / 4;

    hipMemsetAsync(ws + WS_CTL, 0, 4096, stream);
    hipLaunchKernelGGL(k_rope_table, dim3((LPOS * 32 + 255) / 256), dim3(256), 0, stream, cs);
    hipLaunchKernelGGL(k_h0, dim3(rowblocks), dim3(256), 0, stream, x, meta, hb, rstd);
    ngemm(stream, hb, D, attn_norm, a_w_qkv, NQKV, 0, rstd, a_b_qkv, nullptr, 0, scr, NQKV, MTOT, NQKV, D);
    hipLaunchKernelGGL(k_qkv_epi, dim3((unsigned)(((size_t)MTOT * NQKV + 255) / 256)), dim3(256), 0, stream, scr, cs, qkv);
    hipLaunchKernelGGL(k_swa_naive, dim3((MTOT * 16 + 63) / 64), dim3(64), 0, stream, qkv, a_sinks, o0);
    ngemm(stream, o0, D, nullptr, a_w_o, D, 0, nullptr, a_b_o, hb, D, hf, D, MTOT, D, D);
    hipLaunchKernelGGL(k_row_router, dim3(rowblocks), dim3(256), 0, stream, hf, ffn_norm, moe_w_group, moe_b_group, moe_w_router, moe_b_router, hb, rstd, cnt, list, wslot, eid);
    hipLaunchKernelGGL(k_moe_naive, dim3(MTOT * 2), dim3(256), 0, stream, hb, rstd, ffn_norm, moe_w_gate, moe_w_up, moe_w_down, eid, wslot, ybuf0);
    hipLaunchKernelGGL(k_combine, dim3(rowblocks), dim3(256), 0, stream, hb, ybuf0, rstd);
    float* cbuf = (float*)(ws + WS_RB);
    ngemm(stream, hb, D, attn_norm + D, b_w_in, 416, 0, rstd, nullptr, nullptr, 0, cbuf, 416, MTOT, 416, D);
    bf16_t* cqn = (bf16_t*)(ws + RC_CQN); bf16_t* ckvn = (bf16_t*)(ws + RC_CKVN); bf16_t* kpe = (bf16_t*)(ws + RC_KPE);
    bf16_t* Q1 = (bf16_t*)(ws + RC_Q1); bf16_t* K1 = (bf16_t*)(ws + RC_K1); bf16_t* V1 = (bf16_t*)(ws + RC_V1);
    hipLaunchKernelGGL(k_c_epi, dim3(rowblocks), dim3(256), 0, stream, cbuf, cs, cqn, ckvn, kpe);
    float* scr1 = (float*)(ws + WS_RB);
    for (int half = 0; half < 2; ++half) {
        ngemm(stream, cqn, 256, b_q_norm, b_w_uq, 1536, half * 768, nullptr, nullptr, nullptr, 0, scr1, 768, MTOT, 768, 256);
        hipLaunchKernelGGL(k_q_epi, dim3((unsigned)(((size_t)MTOT * 768 + 255) / 256)), dim3(256), 0, stream, scr1, cs, Q1, half * 8);
    }
    for (int half = 0; half < 2; ++half) {
        ngemm(stream, ckvn, 128, b_kv_norm, b_w_ukv, 2048, half * 1024, nullptr, nullptr, nullptr, 0, scr1, 1024, MTOT, 1024, 128);
        hipLaunchKernelGGL(k_kv_epi, dim3((unsigned)(((size_t)MTOT * 1024 + 255) / 256)), dim3(256), 0, stream, scr1, K1, V1, half * 8);
    }
    bf16_t* o1 = (bf16_t*)(ws + WS_RB);
    hipLaunchKernelGGL(k_mla_naive, dim3((MTOT * 16 + 63) / 64), dim3(64), 0, stream, Q1, K1, V1, kpe, o1);
    float* hf1 = (float*)(ws + RC_Q1);
    ngemm(stream, o1, D, nullptr, b_w_o, D, 0, nullptr, nullptr, hb, D, hf1, D, MTOT, D, D);
    hipLaunchKernelGGL(k_row_router, dim3(rowblocks), dim3(256), 0, stream, hf1, ffn_norm + D, moe_w_group + D * 4, moe_b_group + 4, moe_w_router + D * 32, moe_b_router + 32,
                       hb, rstd, cnt + 32, list, wslot, eid);
    bf16_t* ybuf1 = (bf16_t*)(ws + WS_RB);
    hipLaunchKernelGGL(k_moe_naive, dim3(MTOT * 2), dim3(256), 0, stream, hb, rstd, ffn_norm + D, moe_w_gate + (size_t)NE * D * DE, moe_w_up + (size_t)NE * D * DE,
                       moe_w_down + (size_t)NE * DE * D, eid, wslot, ybuf1);
    hipLaunchKernelGGL(k_final, dim3(MREAL / 4), dim3(256), 0, stream, hb, ybuf1, final_norm, (float*)d_out);
}
```

```cpp
#include <hip/hip_runtime.h>
#include <cstdio>
#include <cstdint>

typedef unsigned short bf16_t;

constexpr int D = 1024, SEQ = 8192, NB = 2, NMETA = 16;
constexpr int MREAL = NB * SEQ;
constexpr int MTOT = MREAL + NB * NMETA;
constexpr int LPOS = NMETA + SEQ;
constexpr int NQKV = 1280;
constexpr int NE = 32, DE = 256;
constexpr int CAP = MTOT * 2;
constexpr float EPS = 1e-6f;

__device__ __forceinline__ float bf2f(bf16_t v) { return __uint_as_float(((unsigned)v) << 16); }
__device__ __forceinline__ bf16_t f2bf(float f) { unsigned u = __float_as_uint(f); u += 0x7fffu + ((u >> 16) & 1u); return (bf16_t)(u >> 16); }
__device__ __forceinline__ int row_pos(int row) { return row < MREAL ? NMETA + (row & (SEQ - 1)) : ((row - MREAL) & (NMETA - 1)); }
__device__ __forceinline__ int row_batch(int row) { return row < MREAL ? (row >> 13) : ((row - MREAL) >> 4); }
constexpr int LP = 8256;
__device__ __forceinline__ int perm16(int p) { const int qd = (p >> 2) & 3; return (p & ~12) | ((((qd & 1) << 1) | (qd >> 1)) << 2); }
__device__ __forceinline__ float wave_sum(float v) {
#pragma unroll
    for (int o = 1; o < 64; o <<= 1) v += __shfl_xor(v, o);
    return v;
}

constexpr size_t MiB = 1u << 20;
constexpr size_t WS_CTL = 0;
constexpr size_t WS_ROPE = 1 * MiB;
constexpr size_t WS_END = 256 * MiB;

__global__ void k_rope_table(float2* cs) {
    int idx = blockIdx.x * blockDim.x + threadIdx.x;
    if (idx >= LPOS * 32) return;
    int pos = idx >> 5, i = idx & 31;
    float inv = 1.0f / powf(10000.0f, (float)(2 * i) / 64.0f);
    float ang = (float)pos * inv;
    float s, c; sincosf(ang, &s, &c);
    cs[idx] = make_float2(c, s);
}

__global__ void k_h0(const float* __restrict__ x, const float* __restrict__ meta, bf16_t* hb, float* rstd) {
    int row = blockIdx.x * 4 + (threadIdx.x >> 6), lane = threadIdx.x & 63;
    if (row >= MTOT) return;
    const float* src = row < MREAL ? x + (size_t)row * D : meta + (size_t)row_pos(row) * D;
    float ss = 0.f;
    for (int j = 0; j < 16; ++j) { float v = src[j * 64 + lane]; ss += v * v; hb[(size_t)row * D + j * 64 + lane] = f2bf(v); }
    ss = wave_sum(ss);
    if (lane == 0) rstd[row] = rsqrtf(ss * (1.0f / D) + EPS);
}

__global__ void k_ngemm(const bf16_t* __restrict__ A, int lda, const float* __restrict__ gain, const float* __restrict__ W, int ldw, int woff,
                        const float* __restrict__ rstd, const float* __restrict__ bias, const bf16_t* __restrict__ resid, int ldr,
                        float* C, int ldc, int M, int N, int K) {
    __shared__ float As[16][65];
    __shared__ float Ws[16][64];
    const int tx = threadIdx.x & 15, ty = threadIdx.x >> 4;
    const int m0 = blockIdx.y * 64, n0 = blockIdx.x * 64;
    float acc[4][4];
#pragma unroll
    for (int i = 0; i < 4; ++i)
#pragma unroll
        for (int j = 0; j < 4; ++j) acc[i][j] = 0.f;
    for (int k0 = 0; k0 < K; k0 += 16) {
#pragma unroll
        for (int i = 0; i < 4; ++i) {
            int idx = threadIdx.x + i * 256; int r = idx >> 4, kk = idx & 15; int row = m0 + r;
            float v = 0.f; if (row < M) { v = bf2f(A[(size_t)row * lda + k0 + kk]); if (gain) v *= gain[k0 + kk]; }
            As[kk][r] = v;
        }
#pragma unroll
        for (int i = 0; i < 4; ++i) {
            int idx = threadIdx.x + i * 256; int kk = idx >> 6, c = idx & 63; int col = n0 + c;
            Ws[kk][c] = (col < N) ? W[(size_t)(k0 + kk) * ldw + woff + col] : 0.f;
        }
        __syncthreads();
#pragma unroll
        for (int kk = 0; kk < 16; ++kk) {
            float a[4], w[4];
#pragma unroll
            for (int i = 0; i < 4; ++i) a[i] = As[kk][ty * 4 + i];
#pragma unroll
            for (int j = 0; j < 4; ++j) w[j] = Ws[kk][tx * 4 + j];
#pragma unroll
            for (int i = 0; i < 4; ++i)
#pragma unroll
                for (int j = 0; j < 4; ++j) acc[i][j] += a[i] * w[j];
        }
        __syncthreads();
    }
#pragma unroll
    for (int i = 0; i < 4; ++i)
#pragma unroll
        for (int j = 0; j < 4; ++j) {
            int row = m0 + ty * 4 + i, col = n0 + tx * 4 + j;
            if (row < M && col < N) {
                float v = acc[i][j];
                if (rstd) v *= rstd[row];
                if (bias) v += bias[woff + col];
                if (resid) v += bf2f(resid[(size_t)row * ldr + col]);
                C[(size_t)row * ldc + col] = v;
            }
        }
}

__global__ void k_qkv_epi(const float* __restrict__ scr, const float2* __restrict__ cs, bf16_t* qkv) {
    size_t idx = (size_t)blockIdx.x * blockDim.x + threadIdx.x;
    if (idx >= (size_t)MTOT * NQKV) return;
    int row = (int)(idx / NQKV), col = (int)(idx % NQKV);
    float out;
    if (col < 1152) {
        int d = col & 63, i = d & 31, base = col - d;
        float2 c = cs[row_pos(row) * 32 + i];
        float x1 = scr[(size_t)row * NQKV + base + i], x2 = scr[(size_t)row * NQKV + base + i + 32];
        out = d < 32 ? x1 * c.x - x2 * c.y : x2 * c.x + x1 * c.y;
        if (col < 1024) out *= 0.125f;
    } else out = scr[idx];
    qkv[idx] = f2bf(out);
}

__global__ void __launch_bounds__(64) k_swa_naive(const bf16_t* __restrict__ qkv, const bf16_t* __restrict__ VT0, const float* __restrict__ sinks, bf16_t* o) {
    int idx = blockIdx.x * blockDim.x + threadIdx.x;
    if (idx >= MTOT * 16) return;
    int head = idx / MTOT, row = idx % MTOT;
    int b = row_batch(row), kh = head >> 3;
    float q[64];
#pragma unroll
    for (int d = 0; d < 64; ++d) q[d] = bf2f(qkv[(size_t)row * NQKV + head * 64 + d]);
    float m = sinks[head], l = 1.0f, acc[64];
#pragma unroll
    for (int d = 0; d < 64; ++d) acc[d] = 0.f;
    int nmeta, t0, t1;
    if (row < MREAL) { int t = row & (SEQ - 1); nmeta = NMETA; t0 = t - 127 < 0 ? 0 : t - 127; t1 = t; }
    else { nmeta = ((row - MREAL) & 15) + 1; t0 = 0; t1 = -1; }
    int nk = nmeta + (t1 - t0 + 1);
    for (int j = 0; j < nk; ++j) {
        int krow = j < nmeta ? MREAL + b * NMETA + j : b * SEQ + t0 + (j - nmeta);
        int kpos = j < nmeta ? j : NMETA + t0 + (j - nmeta);
        const bf16_t* kp = qkv + (size_t)krow * NQKV + 1024 + kh * 64;
        const bf16_t* vp = VT0 + (size_t)((b * 2 + kh) * 64) * LP + perm16(kpos);
        float s = 0.f;
#pragma unroll
        for (int d = 0; d < 64; ++d) s += q[d] * bf2f(kp[d]);
        float mn = fmaxf(m, s), sc = __expf(m - mn), p = __expf(s - mn);
        l = l * sc + p; m = mn;
#pragma unroll
        for (int d = 0; d < 64; ++d) acc[d] = acc[d] * sc + p * bf2f(vp[(size_t)d * LP]);
    }
    float inv = 1.0f / l;
#pragma unroll
    for (int d = 0; d < 64; ++d) o[(size_t)row * D + head * 64 + d] = f2bf(acc[d] * inv);
}

__global__ void k_row_router(const float* __restrict__ hf, const float* __restrict__ g, const float* __restrict__ wg, const float* __restrict__ bg,
                             const float* __restrict__ wr, const float* __restrict__ br, bf16_t* hb, float* rstd_out,
                             int* cnt, int* list, float* wslot, int* eid) {
    int row = blockIdx.x * 4 + (threadIdx.x >> 6), lane = threadIdx.x & 63;
    if (row >= MTOT) return;
    float x[16]; float ss = 0.f;
#pragma unroll
    for (int j = 0; j < 16; ++j) { float v = hf[(size_t)row * D + j * 64 + lane]; x[j] = v; ss += v * v; hb[(size_t)row * D + j * 64 + lane] = f2bf(v); }
    ss = wave_sum(ss);
    float rs = rsqrtf(ss * (1.0f / D) + EPS);
    if (lane == 0) rstd_out[row] = rs;
#pragma unroll
    for (int j = 0; j < 16; ++j) x[j] = x[j] * rs * g[j * 64 + lane];
    float lg[4], le[32];
#pragma unroll
    for (int c = 0; c < 4; ++c) { float p = 0.f;
#pragma unroll
        for (int j = 0; j < 16; ++j) p += x[j] * wg[(size_t)(j * 64 + lane) * 4 + c];
        lg[c] = wave_sum(p) + bg[c]; }
#pragma unroll
    for (int c = 0; c < 32; ++c) { float p = 0.f;
#pragma unroll
        for (int j = 0; j < 16; ++j) p += x[j] * wr[(size_t)(j * 64 + lane) * 32 + c];
        le[c] = wave_sum(p) + br[c]; }
    if (lane == 0) {
        int gi = 0; float gm = lg[0];
#pragma unroll
        for (int c = 1; c < 4; ++c) if (lg[c] > gm) { gm = lg[c]; gi = c; }
        float gs = 0.f;
#pragma unroll
        for (int c = 0; c < 4; ++c) gs += __expf(lg[c] - gm);
        float gp = 1.0f / gs;
        float e[8];
#pragma unroll
        for (int c = 0; c < 8; ++c) { float v = le[c];
#pragma unroll
            for (int q = 1; q < 4; ++q) if (gi == q) v = le[q * 8 + c];
            e[c] = v; }
        int i1 = 0; float v1 = e[0];
#pragma unroll
        for (int c = 1; c < 8; ++c) if (e[c] > v1) { v1 = e[c]; i1 = c; }
        int i2 = -1; float v2 = -3.0e38f;
#pragma unroll
        for (int c = 0; c < 8; ++c) if (c != i1 && e[c] > v2) { v2 = e[c]; i2 = c; }
        float r = __expf(v2 - v1);
        float w1 = gp / (1.0f + r), w2 = gp * r / (1.0f + r);
        int e1 = gi * 8 + i1, e2 = gi * 8 + i2;
        int p1 = atomicAdd(&cnt[e1], 1); list[(size_t)e1 * CAP + p1] = row * 2;
        int p2 = atomicAdd(&cnt[e2], 1); list[(size_t)e2 * CAP + p2] = row * 2 + 1;
        wslot[row * 2] = w1; wslot[row * 2 + 1] = w2; eid[row * 2] = e1; eid[row * 2 + 1] = e2;
    }
}

__global__ void k_moe_naive(const bf16_t* __restrict__ hb, const float* __restrict__ rstd, const float* __restrict__ g,
                            const float* __restrict__ wgate, const float* __restrict__ wup, const float* __restrict__ wdown,
                            const int* __restrict__ eid, const float* __restrict__ wslot, bf16_t* ybuf) {
    __shared__ float xs[1024];
    __shared__ float hs[256];
    int slot = blockIdx.x, row = slot >> 1, tid = threadIdx.x;
    int e = eid[slot];
    float rs = rstd[row];
    for (int k = tid; k < 1024; k += 256) xs[k] = bf2f(hb[(size_t)row * D + k]) * g[k];
    __syncthreads();
    const float* Wg = wgate + (size_t)e * D * DE; const float* Wu = wup + (size_t)e * D * DE; const float* Wd = wdown + (size_t)e * DE * D;
    float a = 0.f, u = 0.f;
    for (int k = 0; k < 1024; ++k) { float xv = xs[k]; a += xv * Wg[(size_t)k * DE + tid]; u += xv * Wu[(size_t)k * DE + tid]; }
    a *= rs; u *= rs;
    hs[tid] = (a / (1.0f + __expf(-a))) * u;
    __syncthreads();
    float w = wslot[slot];
    for (int c = tid; c < 1024; c += 256) {
        float y = 0.f;
        for (int j = 0; j < 256; ++j) y += hs[j] * Wd[(size_t)j * D + c];
        ybuf[(size_t)slot * D + c] = f2bf(y * w);
    }
}

__global__ void k_combine(bf16_t* hb, const bf16_t* __restrict__ ybuf, float* rstd) {
    int row = blockIdx.x * 4 + (threadIdx.x >> 6), lane = threadIdx.x & 63;
    if (row >= MTOT) return;
    float ss = 0.f;
    for (int j = 0; j < 16; ++j) {
        size_t c = j * 64 + lane;
        float v = bf2f(hb[(size_t)row * D + c]) + bf2f(ybuf[(size_t)(row * 2) * D + c]) + bf2f(ybuf[(size_t)(row * 2 + 1) * D + c]);
        ss += v * v; hb[(size_t)row * D + c] = f2bf(v);
    }
    ss = wave_sum(ss);
    if (lane == 0) rstd[row] = rsqrtf(ss * (1.0f / D) + EPS);
}

__global__ void k_c_epi(const float* __restrict__ c, const float2* __restrict__ cs, bf16_t* cqn, bf16_t* ckvn, bf16_t* kpe) {
    int row = blockIdx.x * 4 + (threadIdx.x >> 6), lane = threadIdx.x & 63;
    if (row >= MTOT) return;
    const float* cr = c + (size_t)row * 416;
    float q[4]; float ss = 0.f;
    for (int j = 0; j < 4; ++j) { q[j] = cr[j * 64 + lane]; ss += q[j] * q[j]; }
    ss = wave_sum(ss); float rq = rsqrtf(ss * (1.0f / 256) + EPS);
    for (int j = 0; j < 4; ++j) cqn[(size_t)row * 256 + j * 64 + lane] = f2bf(q[j] * rq);
    float k0 = cr[256 + lane], k1 = cr[320 + lane];
    float s2 = wave_sum(k0 * k0 + k1 * k1); float rk = rsqrtf(s2 * (1.0f / 128) + EPS);
    ckvn[(size_t)row * 128 + lane] = f2bf(k0 * rk); ckvn[(size_t)row * 128 + 64 + lane] = f2bf(k1 * rk);
    if (lane < 32) {
        int i = lane & 15; float2 t = cs[row_pos(row) * 32 + 2 * i];
        float x1 = cr[384 + i], x2 = cr[384 + 16 + i];
        float out = lane < 16 ? x1 * t.x - x2 * t.y : x2 * t.x + x1 * t.y;
        kpe[(size_t)row * 32 + lane] = f2bf(out);
    }
}

__global__ void k_q_epi(const float* __restrict__ scr, const float2* __restrict__ cs, bf16_t* Q1, int h0) {
    size_t idx = (size_t)blockIdx.x * blockDim.x + threadIdx.x;
    if (idx >= (size_t)MTOT * 768) return;
    int row = (int)(idx / 768), col = (int)(idx % 768), d = col % 96, base = col - d;
    const float scale = 0.10206207261596577f;
    float out;
    if (d < 64) out = scr[idx];
    else { int dd = d - 64, i = dd & 15; float2 t = cs[row_pos(row) * 32 + 2 * i];
        float x1 = scr[(size_t)row * 768 + base + 64 + i], x2 = scr[(size_t)row * 768 + base + 64 + 16 + i];
        out = dd < 16 ? x1 * t.x - x2 * t.y : x2 * t.x + x1 * t.y; }
    Q1[(size_t)row * 1536 + h0 * 96 + col] = f2bf(out * scale);
}
__global__ void k_kv_epi(const float* __restrict__ scr, bf16_t* K1, bf16_t* V1, int h0) {
    size_t idx = (size_t)blockIdx.x * blockDim.x + threadIdx.x;
    if (idx >= (size_t)MTOT * 512) return;
    int row = (int)(idx >> 9), col = (int)(idx & 511), h = h0 + (col >> 7), d = col & 127;
    bf16_t v = f2bf(scr[idx]);
    if (d < 64) K1[(size_t)row * D + h * 64 + d] = v; else V1[(size_t)row * D + h * 64 + d - 64] = v;
}

__global__ void __launch_bounds__(64) k_mla_naive(const bf16_t* __restrict__ Q1, const bf16_t* __restrict__ K1, const bf16_t* __restrict__ V1,
                                                  const bf16_t* __restrict__ kpe, bf16_t* o) {
    int idx = blockIdx.x * blockDim.x + threadIdx.x;
    if (idx >= MTOT * 16) return;
    int head = idx / MTOT, row = idx % MTOT;
    int b = row_batch(row);
    float q[96];
#pragma unroll
    for (int d = 0; d < 96; ++d) q[d] = bf2f(Q1[(size_t)row * 1536 + head * 96 + d]);
    float m = -1e30f, l = 0.f, acc[64];
#pragma unroll
    for (int d = 0; d < 64; ++d) acc[d] = 0.f;
    int nmeta, nreal;
    if (row < MREAL) { nmeta = NMETA; nreal = (row & (SEQ - 1)) + 1; } else { nmeta = ((row - MREAL) & 15) + 1; nreal = 0; }
    int nk = nmeta + nreal;
    for (int j = 0; j < nk; ++j) {
        const size_t kr = (size_t)b * LP + j;
        const bf16_t* kp = K1 + kr * D + head * 64; const bf16_t* pp = kpe + kr * 32; const bf16_t* vp = V1 + (size_t)((b * 16 + head) * 64) * LP + perm16(j);
        float s = 0.f;
#pragma unroll
        for (int d = 0; d < 64; ++d) s += q[d] * bf2f(kp[d]);
#pragma unroll
        for (int d = 0; d < 32; ++d) s += q[64 + d] * bf2f(pp[d]);
        float mn = fmaxf(m, s), sc = __expf(m - mn), p = __expf(s - mn);
        l = l * sc + p; m = mn;
#pragma unroll
        for (int d = 0; d < 64; ++d) acc[d] = acc[d] * sc + p * bf2f(vp[(size_t)d * LP]);
    }
    float inv = 1.0f / l;
#pragma unroll
    for (int d = 0; d < 64; ++d) o[(size_t)row * D + head * 64 + d] = f2bf(acc[d] * inv);
}

__global__ void k_final(const bf16_t* __restrict__ hb, const bf16_t* __restrict__ ybuf, const float* __restrict__ g, float* out) {
    int row = blockIdx.x * 4 + (threadIdx.x >> 6), lane = threadIdx.x & 63;
    if (row >= MREAL) return;
    float v[16]; float ss = 0.f;
    for (int j = 0; j < 16; ++j) { size_t c = j * 64 + lane;
        v[j] = bf2f(hb[(size_t)row * D + c]) + bf2f(ybuf[(size_t)(row * 2) * D + c]) + bf2f(ybuf[(size_t)(row * 2 + 1) * D + c]); ss += v[j] * v[j]; }
    ss = wave_sum(ss); float rs = rsqrtf(ss * (1.0f / D) + EPS);
    for (int j = 0; j < 16; ++j) out[(size_t)row * D + j * 64 + lane] = v[j] * rs * g[j * 64 + lane];
}

#define LAS __attribute__((address_space(3)))
#define GAS __attribute__((address_space(1)))
typedef short bf16x8 __attribute__((ext_vector_type(8)));
typedef float f32x4 __attribute__((ext_vector_type(4)));
typedef unsigned u32x4 __attribute__((ext_vector_type(4)));
typedef unsigned u32x2 __attribute__((ext_vector_type(2)));
constexpr int NTHR = 512, NWAVE = 8;
constexpr int LDS_MISC = 147456;
constexpr int LDS_BYTES = LDS_MISC + 1024;

constexpr size_t WS_BAR = 64 * 1024;
constexpr size_t WS_KPE = 3 * MiB + 256 * 1024;
constexpr size_t W2_RSTD = 4 * MiB + 512 * 1024, W2_WSLOT = W2_RSTD + 80 * 1024, W2_EID = W2_WSLOT + 144 * 1024;
constexpr size_t W2_LIST = 5 * MiB;
constexpr size_t W2_WRF = 9 * MiB + 256 * 1024;
constexpr size_t W2_WQKV = 10 * MiB;
constexpr size_t W2_WO0 = W2_WQKV + 2560 * 1024;
constexpr size_t W2_WIN = W2_WO0 + 2048 * 1024;
constexpr size_t W2_WUQ = W2_WIN + 1024 * 1024;
constexpr size_t W2_WUKV = W2_WUQ + 768 * 1024;
constexpr size_t W2_WO1 = W2_WUKV + 512 * 1024;
constexpr size_t W2_HB = 20 * MiB;
constexpr size_t W2_RB = 53 * MiB;
constexpr size_t W2_RC = 134 * MiB;
static_assert(W2_EID + (size_t)MTOT * 8 <= W2_LIST && W2_LIST + (size_t)NE * CAP * 4 <= W2_WRF && W2_WO1 + 2 * MiB <= W2_HB && W2_HB + (size_t)MTOT * 2048 <= W2_RB, "fixed map");
constexpr size_t B_QKV = W2_RB, B_O0 = W2_RB + 41 * MiB, B_VT0 = W2_RB + 74 * MiB  , B_Y0 = W2_RB, B_CBUF = W2_RB, B_CQN = W2_RB + 33 * MiB, B_CKVN = W2_RB + 42 * MiB, B_O1 = W2_RB, B_W1 = W2_RB + 33 * MiB;
constexpr size_t C_W0 = W2_RC, C_HF = W2_RC + 48 * MiB, C_Q1 = W2_RC, C_K1 = W2_RC + 49 * MiB, C_V1 = W2_RC + 82 * MiB, C_HF1 = W2_RC, C_Y1 = W2_RC;
static_assert(C_V1 + (size_t)2 * 16 * 64 * LP * 2 <= WS_END && C_K1 + (size_t)2 * LP * 2048 <= C_V1 && B_VT0 + (size_t)2 * 2 * 64 * LP * 2 <= W2_RC && C_HF + (size_t)MTOT * 4096 <= WS_END && B_W1 + 48 * MiB <= W2_RC, "region map");
constexpr size_t MOE_WGU_BYTES = (size_t)NE * 512 * 1024 * 2, MOE_WD_BYTES = (size_t)NE * 1024 * 256 * 2;

struct MArgs { const float* in[23]; float* out; unsigned char* ws; int ph_lo, ph_hi, li, pad; };

__device__ __forceinline__ unsigned pk2(float lo, float hi) { return (unsigned)f2bf(lo) | ((unsigned)f2bf(hi) << 16); }

#define XB_TMO      128
#define XB_XCNT(j)  (256  + 64 * (j))
#define XB_XSUB(j)  (1280 + 64 * (j))
#define XB_XGEN(j)  (2304 + 64 * (j))
#define XB_TOP      3328
#define XB_TOPGEN   3392
#define XCD_BAR_WORDS 3456
#define XB_SPIN_CAP (1u << 18)
__device__ __forceinline__ unsigned xb_ld(unsigned* p)              { return __hip_atomic_load(p, __ATOMIC_RELAXED, __HIP_MEMORY_SCOPE_AGENT); }
__device__ __forceinline__ unsigned xb_add(unsigned* p, unsigned v) { return __hip_atomic_fetch_add(p, v, __ATOMIC_RELAXED, __HIP_MEMORY_SCOPE_AGENT); }
__device__ __forceinline__ unsigned xb_xcc_id() { return (unsigned)__builtin_amdgcn_s_getreg((3 << 11) | 20) & 0xFu; }
#define XB_SPIN(cond, bar) do { unsigned _sp = 0; while (cond) { __builtin_amdgcn_s_sleep(1); \
    if ((++_sp & 255u) == 0u) { if (xb_ld(&(bar)[XB_TMO])) break; if (_sp > XB_SPIN_CAP) { atomicAdd(&(bar)[XB_TMO], 1u); break; } } } } while (0)
struct XcdBarrier { unsigned* bar; unsigned x; volatile LAS unsigned* st; };
__device__ __forceinline__ XcdBarrier xcd_barrier_post(unsigned* bar, volatile LAS unsigned* st) {
    XcdBarrier b; b.bar = bar; b.x = xb_xcc_id(); b.st = st;
    if (threadIdx.x == 0) (void)xb_add(&bar[XB_XCNT(b.x)], 1u);
    return b;
}
__device__ __forceinline__ void xcd_barrier_complete(unsigned* bar, unsigned x, unsigned& nloc, unsigned& nx) {
    const unsigned G = gridDim.x * gridDim.y * gridDim.z;
    unsigned sum, cnt, mine, sp = 0u;
    for (;;) {
        sum = 0u; cnt = 0u; mine = 0u;
#pragma unroll
        for (unsigned j = 0; j < 16; ++j) { const unsigned c = xb_ld(&bar[XB_XCNT(j)]); sum += c; cnt += (c > 0u) ? 1u : 0u; mine = (j == x) ? c : mine; }
        if (sum == G) break;
        __builtin_amdgcn_s_sleep(1);
        if ((++sp & 255u) == 0u) { if (xb_ld(&bar[XB_TMO])) break; if (sp > XB_SPIN_CAP) { atomicAdd(&bar[XB_TMO], 1u); break; } }
    }
    nloc = mine > 0u ? mine : 1u; nx = cnt > 0u ? cnt : 1u;
}
__device__ __forceinline__ void xcd_barrier(const XcdBarrier& b) {
    asm volatile("s_waitcnt vmcnt(0)" ::: "memory");
    __syncthreads();
    if (threadIdx.x == 0) {
        unsigned* bar = b.bar;
        __builtin_amdgcn_s_waitcnt(0);
        unsigned nloc = b.st[0], nx = b.st[1];
        if (nloc == 0u) { xcd_barrier_complete(bar, b.x, nloc, nx); b.st[0] = nloc; b.st[1] = nx; }
        const unsigned old = xb_add(&bar[XB_XSUB(b.x)], 1u);
        const unsigned gen = old / nloc;
        if (old + 1u == (gen + 1u) * nloc) {
            __builtin_amdgcn_fence(__ATOMIC_RELEASE, "agent");
            asm volatile("s_waitcnt vmcnt(0)" ::: "memory");
            const unsigned og = xb_add(&bar[XB_TOP], 1u);
            const unsigned tg = og / nx;
            if (og + 1u == (tg + 1u) * nx) xb_add(&bar[XB_TOPGEN], 1u);
            else XB_SPIN(xb_ld(&bar[XB_TOPGEN]) == tg, bar);
            __builtin_amdgcn_fence(__ATOMIC_ACQUIRE, "agent");
            xb_add(&bar[XB_XGEN(b.x)], 1u);
            asm volatile("s_waitcnt vmcnt(0)" ::: "memory");
        } else {
            XB_SPIN(xb_ld(&bar[XB_XGEN(b.x)]) == gen, bar);
            __builtin_amdgcn_fence(__ATOMIC_ACQUIRE, "agent");
            asm volatile("s_waitcnt vmcnt(0)" ::: "memory");
        }
    }
    __syncthreads();
}

template <int MT, int NT, int WM, int WN, bool NSW, class RowA, class Epi>
__device__ __forceinline__ void gemm_tile(LAS unsigned char* lds, const RowA& rowA, const bf16_t* __restrict__ Bt, int ldb  , int nk, Epi& epi) {
    constexpr int BM = WM * MT * 16, BN = WN * NT * 16, GA = BM / 8, G = (BM + BN) / 8, NG = (G + 7) / 8, STAGE = (BM + BN) * 128;
    static_assert(WM * WN == 8 && 2 * STAGE <= LDS_MISC, "gemm_tile config");
    const int tid = threadIdx.x, lane = tid & 63, wave = __builtin_amdgcn_readfirstlane(tid >> 6), wm = wave / WN, wn = wave % WN;
    const char* src[NG];
    const int lc = (lane & 7) ^ (lane >> 3);
#pragma unroll
    for (int i = 0; i < NG; ++i) {
        const int g = wave + 8 * i;
        if (g < GA) src[i] = (const char*)rowA(g * 8 + (lane >> 3)) + lc * 16;
        else if (g < G) src[i] = (const char*)(Bt + (size_t)((g - GA) * 8 + (lane >> 3)) * ldb) + lc * 16;
        else src[i] = nullptr;
    }
    f32x4 acc[MT][NT];
#pragma unroll
    for (int mi = 0; mi < MT; ++mi)
#pragma unroll
        for (int ni = 0; ni < NT; ++ni) acc[mi][ni] = (f32x4){0.f, 0.f, 0.f, 0.f};
    const int fro = (lane & 15) * 128;
    const int fc0 = (((lane >> 4)) ^ (lane & 7)) << 4, fc1 = (((4 + (lane >> 4))) ^ (lane & 7)) << 4;
#define GT_STAGE(st, kt) do { _Pragma("unroll") for (int _i = 0; _i < NG; ++_i) { const int _g = wave + 8 * _i; if (_g < G) \
        __builtin_amdgcn_global_load_lds((const unsigned*)(src[_i] + (size_t)(kt) * 128), (LAS unsigned*)(lds + (st) * STAGE + _g * 1024), 16, 0, 0); } } while (0)
    GT_STAGE(0, 0);
    for (int kt = 0; kt < nk; ++kt) {
        asm volatile("s_waitcnt vmcnt(0)" ::: "memory");
        __syncthreads();
        if (kt + 1 < nk) GT_STAGE((kt + 1) & 1, kt + 1);
        LAS const unsigned char* sa = lds + (kt & 1) * STAGE + (wm * MT * 16) * 128 + fro;
        LAS const unsigned char* sb = lds + (kt & 1) * STAGE + (BM + wn * NT * 16) * 128 + fro;
#pragma unroll
        for (int ks = 0; ks < 2; ++ks) {
            const int fc = ks ? fc1 : fc0;
            bf16x8 af[MT], bfr[NT];
#pragma unroll
            for (int mi = 0; mi < MT; ++mi) af[mi] = *(LAS const bf16x8*)(sa + mi * 2048 + fc);
#pragma unroll
            for (int ni = 0; ni < NT; ++ni) bfr[ni] = *(LAS const bf16x8*)(sb + ni * 2048 + fc);
            if (NSW) {
#pragma unroll
                for (int mi = 0; mi < MT; ++mi)
#pragma unroll
                    for (int ni = 0; ni < NT; ++ni) acc[mi][ni] = __builtin_amdgcn_mfma_f32_16x16x32_bf16(af[mi], bfr[ni], acc[mi][ni], 0, 0, 0);
            } else {
#pragma unroll
                for (int mi = 0; mi < MT; ++mi)
#pragma unroll
                    for (int ni = 0; ni < NT; ++ni) acc[mi][ni] = __builtin_amdgcn_mfma_f32_16x16x32_bf16(bfr[ni], af[mi], acc[mi][ni], 0, 0, 0);
            }
        }
    }
#undef GT_STAGE
    epi(acc, wm * MT * 16, wn * NT * 16, lane);
    __syncthreads();
}

struct RowDense { const bf16_t* A; int lda, m0, mlast; __device__ __forceinline__ const bf16_t* operator()(int r) const { int row = m0 + r; row = row > mlast ? mlast : row; return A + (size_t)row * lda; } };

struct EpiQKV {
    const float* rstd; const float* bias; const float2* cs; bf16_t* qkv; int m0, n0;
    template <int MT, int NT> __device__ __forceinline__ void operator()(f32x4 (&acc)[MT][NT], int mb, int nb, int lane) const {
        static_assert(NT == 4, "rope needs a 64-column wave span");
        const int cb = n0 + nb, d0 = (lane >> 4) * 4;
#pragma unroll
        for (int mi = 0; mi < MT; ++mi) {
            const int row = m0 + mb + mi * 16 + (lane & 15);
            if (row < MTOT) {
                const float rs = rstd[row]; const int pos = row_pos(row);
                bf16_t* orow = qkv + (size_t)row * NQKV + cb;
                {
                    const float sc = cb < 1024 ? 0.125f : 1.0f;
#pragma unroll
                    for (int ni = 0; ni < 2; ++ni) {
                        const int d = ni * 16 + d0;
                        const f32x4 b1 = *(const f32x4*)(bias + cb + d), b2 = *(const f32x4*)(bias + cb + 32 + d);
                        float o1[4], o2[4];
#pragma unroll
                        for (int r = 0; r < 4; ++r) {
                            const float2 t = cs[pos * 32 + d + r];
                            const float x1 = acc[mi][ni][r] * rs + b1[r], x2 = acc[mi][ni + 2][r] * rs + b2[r];
                            o1[r] = (x1 * t.x - x2 * t.y) * sc; o2[r] = (x2 * t.x + x1 * t.y) * sc;
                        }
                        *(u32x2*)(orow + d) = (u32x2){pk2(o1[0], o1[1]), pk2(o1[2], o1[3])};
                        *(u32x2*)(orow + 32 + d) = (u32x2){pk2(o2[0], o2[1]), pk2(o2[2], o2[3])};
                    }
                }
            }
        }
    }
};
struct EpiV0 {
    const float* rstd; const float* bias; bf16_t* vt0; int m0, n0;
    template <int MT, int NT> __device__ __forceinline__ void operator()(f32x4 (&acc)[MT][NT], int mb, int nb, int lane) const {
        static_assert(NT == 4, "64-column wave span");
        const int cb = n0 + nb, kh = (cb - 1152) >> 6;
#pragma unroll
        for (int mi = 0; mi < MT; ++mi) {
            const int row0 = m0 + mb + mi * 16 + (lane >> 4) * 4;
            if (row0 < MTOT) {
                const f32x4 rs = *(const f32x4*)(rstd + row0); const int b = row_batch(row0), pp = perm16(row_pos(row0));
#pragma unroll
                for (int ni = 0; ni < NT; ++ni) { const int d = ni * 16 + (lane & 15); const float bb = bias[cb + d];
                    const f32x4 v = acc[mi][ni] * rs + bb;
                    *(u32x2*)(vt0 + (size_t)((b * 2 + kh) * 64 + d) * LP + pp) = (u32x2){pk2(v[0], v[1]), pk2(v[2], v[3])}; }
            }
        }
    }
};
struct EpiResF32 {
    const float* bias; const bf16_t* hb; float* hf; int m0, n0;
    template <int MT, int NT> __device__ __forceinline__ void operator()(f32x4 (&acc)[MT][NT], int mb, int nb, int lane) const {
#pragma unroll
        for (int mi = 0; mi < MT; ++mi) {
            const int row = m0 + mb + mi * 16 + (lane & 15);
            if (row < MTOT) {
#pragma unroll
                for (int ni = 0; ni < NT; ++ni) {
                    const int col = n0 + nb + ni * 16 + (lane >> 4) * 4;
                    const u32x2 h = *(const u32x2*)(hb + (size_t)row * D + col);
                    f32x4 v = acc[mi][ni];
                    if (bias) v += *(const f32x4*)(bias + col);
                    v[0] += __uint_as_float(h.x << 16); v[1] += __uint_as_float(h.x & 0xffff0000u); v[2] += __uint_as_float(h.y << 16); v[3] += __uint_as_float(h.y & 0xffff0000u);
                    *(f32x4*)(hf + (size_t)row * D + col) = v;
                }
            }
        }
    }
};

struct EpiWin {
    const float* rstd; float* cbuf; int m0, n0;
    template <int MT, int NT> __device__ __forceinline__ void operator()(f32x4 (&acc)[MT][NT], int mb, int nb, int lane) const {
#pragma unroll
        for (int mi = 0; mi < MT; ++mi) {
            const int row = m0 + mb + mi * 16 + (lane & 15);
            if (row < MTOT) { const float rs = rstd[row];
#pragma unroll
                for (int ni = 0; ni < NT; ++ni) *(f32x4*)(cbuf + (size_t)row * 512 + n0 + nb + ni * 16 + (lane >> 4) * 4) = acc[mi][ni] * rs; }
        }
    }
};
struct EpiUQ {
    const float2* cs; bf16_t* Q1; int m0, n0;
    template <int MT, int NT> __device__ __forceinline__ void operator()(f32x4 (&acc)[MT][NT], int mb, int nb, int lane) const {
        static_assert(NT == 4, "rope needs whole 32-column blocks per wave");
        const float scale = 0.10206207261596577f;
        const int d0 = (lane >> 4) * 4;
#pragma unroll
        for (int mi = 0; mi < MT; ++mi) {
            const int row = m0 + mb + mi * 16 + (lane & 15);
            if (row < MTOT) { const int pos = row_pos(row);
#pragma unroll
                for (int bi = 0; bi < 2; ++bi) {
                    const int gc = n0 + nb + bi * 32; bf16_t* orow = Q1 + (size_t)row * 1536 + gc;
                    f32x4 v1 = acc[mi][2 * bi], v2 = acc[mi][2 * bi + 1];
                    if (((gc >> 5) % 3) == 2) {
#pragma unroll
                        for (int r = 0; r < 4; ++r) { const float2 t = cs[pos * 32 + 2 * (d0 + r)]; const float x1 = v1[r], x2 = v2[r]; v1[r] = x1 * t.x - x2 * t.y; v2[r] = x2 * t.x + x1 * t.y; }
                    }
                    v1 = v1 * scale; v2 = v2 * scale;
                    *(u32x2*)(orow + d0) = (u32x2){pk2(v1[0], v1[1]), pk2(v1[2], v1[3])};
                    *(u32x2*)(orow + 16 + d0) = (u32x2){pk2(v2[0], v2[1]), pk2(v2[2], v2[3])};
                }
            }
        }
    }
};
struct EpiK1 {
    bf16_t* K1; int m0, n0;
    template <int MT, int NT> __device__ __forceinline__ void operator()(f32x4 (&acc)[MT][NT], int mb, int nb, int lane) const {
#pragma unroll
        for (int mi = 0; mi < MT; ++mi) {
            const int row = m0 + mb + mi * 16 + (lane & 15);
            if (row < MTOT) { const size_t kr = (size_t)row_batch(row) * LP + row_pos(row);
#pragma unroll
                for (int ni = 0; ni < NT; ++ni) { const f32x4 v = acc[mi][ni];
                    *(u32x2*)(K1 + kr * D + n0 + nb + ni * 16 + (lane >> 4) * 4) = (u32x2){pk2(v[0], v[1]), pk2(v[2], v[3])}; } }
        }
    }
};
struct EpiV1 {
    bf16_t* VT1; int m0, n0;
    template <int MT, int NT> __device__ __forceinline__ void operator()(f32x4 (&acc)[MT][NT], int mb, int nb, int lane) const {
#pragma unroll
        for (int mi = 0; mi < MT; ++mi) {
            const int row0 = m0 + mb + mi * 16 + (lane >> 4) * 4;
            if (row0 < MTOT) { const int b = row_batch(row0), pp = perm16(row_pos(row0));
#pragma unroll
                for (int ni = 0; ni < NT; ++ni) { const int hd = n0 - 1024 + nb + ni * 16 + (lane & 15); const f32x4 v = acc[mi][ni];
                    *(u32x2*)(VT1 + (size_t)(b * 1024 + hd) * LP + pp) = (u32x2){pk2(v[0], v[1]), pk2(v[2], v[3])}; } }
        }
    }
};

__device__ __forceinline__ void route_phase(LAS unsigned char* lds, const float* __restrict__ hf, const float* __restrict__ wrf, const float* __restrict__ bg, const float* __restrict__ br,
                                            bf16_t* hb, float* rstd_out, int* cnt, int* list, float* wslot, int* eid, int bid, int nblk) {
    const int tid = threadIdx.x, lane = tid & 63, wave = __builtin_amdgcn_readfirstlane(tid >> 6);
    LAS f32x4* wl = (LAS f32x4*)lds;
    for (int i = tid; i < 36 * 256; i += NTHR) wl[i] = *(const f32x4*)(wrf + (size_t)i * 4);
    __syncthreads();
    for (int row = bid * NWAVE + wave; row < MTOT; row += nblk * NWAVE) {
        f32x4 x[4]; float ss = 0.f;
#pragma unroll
        for (int j = 0; j < 4; ++j) { x[j] = *(const f32x4*)(hf + (size_t)row * D + j * 256 + lane * 4); ss += x[j][0] * x[j][0] + x[j][1] * x[j][1] + x[j][2] * x[j][2] + x[j][3] * x[j][3];
            *(u32x2*)(hb + (size_t)row * D + j * 256 + lane * 4) = (u32x2){pk2(x[j][0], x[j][1]), pk2(x[j][2], x[j][3])}; }
        ss = wave_sum(ss);
        const float rs = rsqrtf(ss * (1.0f / D) + EPS);
        float lg[4];
#pragma unroll
        for (int c = 0; c < 4; ++c) { float p = 0.f;
#pragma unroll
            for (int j = 0; j < 4; ++j) { const f32x4 w = wl[c * 256 + j * 64 + lane]; p += x[j][0] * w[0] + x[j][1] * w[1] + x[j][2] * w[2] + x[j][3] * w[3]; }
            lg[c] = wave_sum(p) * rs + bg[c]; }
        int gi = 0; float gm = lg[0];
#pragma unroll
        for (int c = 1; c < 4; ++c) if (lg[c] > gm) { gm = lg[c]; gi = c; }
        float gs = 0.f;
#pragma unroll
        for (int c = 0; c < 4; ++c) gs += __expf(lg[c] - gm);
        const float gp = 1.0f / gs;
        gi = __builtin_amdgcn_readfirstlane(gi);
        float e[8];
#pragma unroll
        for (int c = 0; c < 8; ++c) { float p = 0.f;
#pragma unroll
            for (int j = 0; j < 4; ++j) { const f32x4 w = wl[(4 + gi * 8 + c) * 256 + j * 64 + lane]; p += x[j][0] * w[0] + x[j][1] * w[1] + x[j][2] * w[2] + x[j][3] * w[3]; }
            e[c] = wave_sum(p) * rs + br[gi * 8 + c]; }
        int i1 = 0; float v1 = e[0];
#pragma unroll
        for (int c = 1; c < 8; ++c) if (e[c] > v1) { v1 = e[c]; i1 = c; }
        int i2 = -1; float v2 = -3.0e38f;
#pragma unroll
        for (int c = 0; c < 8; ++c) if (c != i1 && e[c] > v2) { v2 = e[c]; i2 = c; }
        if (lane == 0) {
            const float r = __expf(v2 - v1);
            const float w1 = gp / (1.0f + r), w2 = gp * r / (1.0f + r);
            const int e1 = gi * 8 + i1, e2 = gi * 8 + i2;
            const int p1 = atomicAdd(&cnt[e1], 1); list[(size_t)e1 * CAP + p1] = row * 2;
            const int p2 = atomicAdd(&cnt[e2], 1); list[(size_t)e2 * CAP + p2] = row * 2 + 1;
            wslot[row * 2] = w1; wslot[row * 2 + 1] = w2; eid[row * 2] = e1; eid[row * 2 + 1] = e2; rstd_out[row] = rs;
        }
    }
    __syncthreads();
}
__device__ __forceinline__ void combine_phase(bf16_t* hb, const bf16_t* __restrict__ ybuf, float* rstd, int bid, int nblk) {
    const int tid = threadIdx.x, lane = tid & 63, wave = tid >> 6;
    for (int row = bid * NWAVE + wave; row < MTOT; row += nblk * NWAVE) {
        float ss = 0.f;
#pragma unroll
        for (int j = 0; j < 4; ++j) { const size_t c = j * 256 + lane * 4;
            const u32x2 h = *(const u32x2*)(hb + (size_t)row * D + c), y0 = *(const u32x2*)(ybuf + (size_t)(row * 2) * D + c), y1 = *(const u32x2*)(ybuf + (size_t)(row * 2 + 1) * D + c);
            float v[4];
            v[0] = __uint_as_float(h.x << 16) + __uint_as_float(y0.x << 16) + __uint_as_float(y1.x << 16);
            v[1] = __uint_as_float(h.x & 0xffff0000u) + __uint_as_float(y0.x & 0xffff0000u) + __uint_as_float(y1.x & 0xffff0000u);
            v[2] = __uint_as_float(h.y << 16) + __uint_as_float(y0.y << 16) + __uint_as_float(y1.y << 16);
            v[3] = __uint_as_float(h.y & 0xffff0000u) + __uint_as_float(y0.y & 0xffff0000u) + __uint_as_float(y1.y & 0xffff0000u);
            ss += v[0] * v[0] + v[1] * v[1] + v[2] * v[2] + v[3] * v[3];
            *(u32x2*)(hb + (size_t)row * D + c) = (u32x2){pk2(v[0], v[1]), pk2(v[2], v[3])}; }
        ss = wave_sum(ss); if (lane == 0) rstd[row] = rsqrtf(ss * (1.0f / D) + EPS);
    }
}
__device__ __forceinline__ void cepi_phase(const float* __restrict__ c, const float2* __restrict__ cs, bf16_t* cqn, bf16_t* ckvn, bf16_t* kpe, int bid, int nblk) {
    const int tid = threadIdx.x, lane = tid & 63, wave = tid >> 6;
    for (int row = bid * NWAVE + wave; row < MTOT; row += nblk * NWAVE) {
        const float* cr = c + (size_t)row * 512;
        const f32x4 q = *(const f32x4*)(cr + lane * 4);
        const float rq = rsqrtf(wave_sum(q[0] * q[0] + q[1] * q[1] + q[2] * q[2] + q[3] * q[3]) * (1.0f / 256) + EPS);
        *(u32x2*)(cqn + (size_t)row * 256 + lane * 4) = (u32x2){pk2(q[0] * rq, q[1] * rq), pk2(q[2] * rq, q[3] * rq)};
        const float k0 = cr[256 + lane], k1 = cr[320 + lane];
        const float rk = rsqrtf(wave_sum(k0 * k0 + k1 * k1) * (1.0f / 128) + EPS);
        ckvn[(size_t)row * 128 + lane] = f2bf(k0 * rk); ckvn[(size_t)row * 128 + 64 + lane] = f2bf(k1 * rk);
        if (lane < 32) { const int i = lane & 15; const float2 t = cs[row_pos(row) * 32 + 2 * i];
            const float x1 = cr[384 + i], x2 = cr[400 + i];
            kpe[((size_t)row_batch(row) * LP + row_pos(row)) * 32 + lane] = f2bf(lane < 16 ? x1 * t.x - x2 * t.y : x2 * t.x + x1 * t.y); }
    }
}
__device__ __forceinline__ void final_phase(const bf16_t* __restrict__ hb, const bf16_t* __restrict__ ybuf, const float* __restrict__ g, float* out, int bid, int nblk) {
    const int tid = threadIdx.x, lane = tid & 63, wave = tid >> 6;
    for (int row = bid * NWAVE + wave; row < MREAL; row += nblk * NWAVE) {
        f32x4 v[4]; float ss = 0.f;
#pragma unroll
        for (int j = 0; j < 4; ++j) { const size_t c = j * 256 + lane * 4;
            const u32x2 h = *(const u32x2*)(hb + (size_t)row * D + c), y0 = *(const u32x2*)(ybuf + (size_t)(row * 2) * D + c), y1 = *(const u32x2*)(ybuf + (size_t)(row * 2 + 1) * D + c);
            v[j][0] = __uint_as_float(h.x << 16) + __uint_as_float(y0.x << 16) + __uint_as_float(y1.x << 16);
            v[j][1] = __uint_as_float(h.x & 0xffff0000u) + __uint_as_float(y0.x & 0xffff0000u) + __uint_as_float(y1.x & 0xffff0000u);
            v[j][2] = __uint_as_float(h.y << 16) + __uint_as_float(y0.y << 16) + __uint_as_float(y1.y << 16);
            v[j][3] = __uint_as_float(h.y & 0xffff0000u) + __uint_as_float(y0.y & 0xffff0000u) + __uint_as_float(y1.y & 0xffff0000u);
            ss += v[j][0] * v[j][0] + v[j][1] * v[j][1] + v[j][2] * v[j][2] + v[j][3] * v[j][3]; }
        const float rs = rsqrtf(wave_sum(ss) * (1.0f / D) + EPS);
#pragma unroll
        for (int j = 0; j < 4; ++j) { const f32x4 gg = *(const f32x4*)(g + j * 256 + lane * 4); *(f32x4*)(out + (size_t)row * D + j * 256 + lane * 4) = v[j] * rs * gg; }
    }
}

typedef float f32x16 __attribute__((ext_vector_type(16)));
constexpr int AT_STAGE = 20480;
__device__ __forceinline__ unsigned cvtpk(float lo, float hi) { typedef float f2 __attribute__((ext_vector_type(2))); typedef __bf16 b2 __attribute__((ext_vector_type(2)));
    f2 v = {lo, hi}; b2 r = __builtin_convertvector(v, b2); return __builtin_bit_cast(unsigned, r); }
__device__ __forceinline__ void mla_unit(LAS unsigned char* lds, int b, int h, int qi, const bf16_t* __restrict__ Q1, const bf16_t* __restrict__ K1, const bf16_t* __restrict__ kpe,
                                         const bf16_t* __restrict__ VT1, bf16_t* o) {
    const int tid = threadIdx.x, lane = tid & 63, wave = __builtin_amdgcn_readfirstlane(tid >> 6), r32 = lane & 31, hi = lane >> 5;
    const float C2 = 1.4426950408889634f;
    const size_t qrow = (size_t)b * SEQ + 256 * qi + 32 * wave + r32;
    bf16x8 qf[6];
#pragma unroll
    for (int s = 0; s < 6; ++s) qf[s] = *(const bf16x8*)(Q1 + qrow * 1536 + h * 96 + 16 * s + 8 * hi);
    const int lr = 8 * wave + (lane >> 3);
    const char* ksrc = (const char*)(K1 + ((size_t)b * LP + lr) * 1024 + h * 64) + (((lane & 7) ^ ((lr >> 1) & 7)) << 4);
    const char* vsrc = (const char*)(VT1 + ((size_t)(b * 16 + h) * 64 + lr) * LP) + (((lane & 7) ^ ((lr >> 1) & 7)) << 4);
    const int pr = 16 * wave + (lane >> 2);
    const char* psrc = (const char*)(kpe + ((size_t)b * LP + (pr & 63)) * 32) + (((lane & 3) ^ ((pr >> 2) & 3)) << 4);
#define MLA_ISSUE(j, st) do { \
        __builtin_amdgcn_global_load_lds((const unsigned*)(ksrc + (size_t)(j) * (64 * 2048)), (LAS unsigned*)(lds + (st) * AT_STAGE + wave * 1024), 16, 0, 0); \
        __builtin_amdgcn_global_load_lds((const unsigned*)(vsrc + (size_t)(j) * 128), (LAS unsigned*)(lds + (st) * AT_STAGE + 8192 + wave * 1024), 16, 0, 0); \
        if (wave < 4) __builtin_amdgcn_global_load_lds((const unsigned*)(psrc + (size_t)(j) * (64 * 64)), (LAS unsigned*)(lds + (st) * AT_STAGE + 16384 + wave * 1024), 16, 0, 0); } while (0)
    const int NT = 4 * qi + 5, jmaxw = 4 * qi + ((32 * wave + 47) >> 6);
    const int qp = 16 + 256 * qi + 32 * wave + r32;
    const int koff = r32 * 128, ksw = (r32 >> 1) & 7, poff = 16384 + r32 * 64, psw = (r32 >> 2) & 3, voff = 8192 + r32 * 128;
    f32x16 oacc[2]; oacc[0] = (f32x16){}; oacc[1] = (f32x16){};
    float m = -1e30f, lsum = 0.f;
    MLA_ISSUE(0, 0);
    if (NT > 1) MLA_ISSUE(1, 1);
    int st = 0;
    for (int j = 0; j < NT; ++j) {
        if (j + 1 < NT) { if (wave < 4) asm volatile("s_waitcnt vmcnt(3)" ::: "memory"); else asm volatile("s_waitcnt vmcnt(2)" ::: "memory"); }
        else asm volatile("s_waitcnt vmcnt(0)" ::: "memory");
        __builtin_amdgcn_s_barrier(); asm volatile("" ::: "memory");
        if (j + 2 < NT) { const int st2 = st >= 1 ? st - 1 : 2; MLA_ISSUE(j + 2, st2); }
        if (j <= jmaxw) {
            LAS const unsigned char* sb = lds + st * AT_STAGE;
            f32x16 p0 = (f32x16){}, p1 = (f32x16){};
#pragma unroll
            for (int s = 0; s < 4; ++s) {
                const bf16x8 k0 = *(LAS const bf16x8*)(sb + koff + (((2 * s + hi) ^ ksw) << 4));
                const bf16x8 k1 = *(LAS const bf16x8*)(sb + 4096 + koff + (((2 * s + hi) ^ ksw) << 4));
                p0 = __builtin_amdgcn_mfma_f32_32x32x16_bf16(k0, qf[s], p0, 0, 0, 0);
                p1 = __builtin_amdgcn_mfma_f32_32x32x16_bf16(k1, qf[s], p1, 0, 0, 0);
            }
#pragma unroll
            for (int s = 0; s < 2; ++s) {
                const bf16x8 k0 = *(LAS const bf16x8*)(sb + poff + (((2 * s + hi) ^ psw) << 4));
                const bf16x8 k1 = *(LAS const bf16x8*)(sb + 2048 + poff + (((2 * s + hi) ^ psw) << 4));
                p0 = __builtin_amdgcn_mfma_f32_32x32x16_bf16(k0, qf[4 + s], p0, 0, 0, 0);
                p1 = __builtin_amdgcn_mfma_f32_32x32x16_bf16(k1, qf[4 + s], p1, 0, 0, 0);
            }
            if (j >= 4 * qi) {
                const int kb0 = 64 * j + 4 * hi;
#pragma unroll
                for (int r = 0; r < 16; ++r) { const int kp = kb0 + (r & 3) + 8 * (r >> 2); if (kp > qp) p0[r] = -1e30f; if (kp + 32 > qp) p1[r] = -1e30f; }
            }
            float tm = fmaxf(p0[0], p1[0]);
#pragma unroll
            for (int r = 1; r < 16; ++r) tm = fmaxf(tm, fmaxf(p0[r], p1[r]));
            tm = fmaxf(tm, __shfl_xor(tm, 32));
            const float mn = fmaxf(m, tm), alpha = __builtin_amdgcn_exp2f((m - mn) * C2), nmc = -mn * C2;
            m = mn;
            float ps = 0.f;
#pragma unroll
            for (int r = 0; r < 16; ++r) { p0[r] = __builtin_amdgcn_exp2f(__builtin_fmaf(p0[r], C2, nmc)); p1[r] = __builtin_amdgcn_exp2f(__builtin_fmaf(p1[r], C2, nmc)); ps += p0[r] + p1[r]; }
            lsum = lsum * alpha + ps;
#pragma unroll
            for (int r = 0; r < 16; ++r) { oacc[0][r] *= alpha; oacc[1][r] *= alpha; }
            u32x4 pf[4];
            pf[0] = (u32x4){cvtpk(p0[0], p0[1]), cvtpk(p0[2], p0[3]), cvtpk(p0[4], p0[5]), cvtpk(p0[6], p0[7])};
            pf[1] = (u32x4){cvtpk(p0[8], p0[9]), cvtpk(p0[10], p0[11]), cvtpk(p0[12], p0[13]), cvtpk(p0[14], p0[15])};
            pf[2] = (u32x4){cvtpk(p1[0], p1[1]), cvtpk(p1[2], p1[3]), cvtpk(p1[4], p1[5]), cvtpk(p1[6], p1[7])};
            pf[3] = (u32x4){cvtpk(p1[8], p1[9]), cvtpk(p1[10], p1[11]), cvtpk(p1[12], p1[13]), cvtpk(p1[14], p1[15])};
#pragma unroll
            for (int s = 0; s < 4; ++s) {
                const bf16x8 v0 = *(LAS const bf16x8*)(sb + voff + (((2 * s + hi) ^ ksw) << 4));
                const bf16x8 v1 = *(LAS const bf16x8*)(sb + 4096 + voff + (((2 * s + hi) ^ ksw) << 4));
                const bf16x8 pb = __builtin_bit_cast(bf16x8, pf[s]);
                oacc[0] = __builtin_amdgcn_mfma_f32_32x32x16_bf16(v0, pb, oacc[0], 0, 0, 0);
                oacc[1] = __builtin_amdgcn_mfma_f32_32x32x16_bf16(v1, pb, oacc[1], 0, 0, 0);
            }
        }
        st = st == 2 ? 0 : st + 1;
    }
#undef MLA_ISSUE
    lsum += __shfl_xor(lsum, 32);
    const float inv = 1.0f / lsum;
    bf16_t* orow = o + qrow * D + h * 64 + 4 * hi;
#pragma unroll
    for (int db = 0; db < 2; ++db)
#pragma unroll
        for (int g = 0; g < 4; ++g)
            *(u32x2*)(orow + 32 * db + 8 * g) = (u32x2){cvtpk(oacc[db][4 * g] * inv, oacc[db][4 * g + 1] * inv), cvtpk(oacc[db][4 * g + 2] * inv, oacc[db][4 * g + 3] * inv)};
    asm volatile("s_waitcnt lgkmcnt(0)" ::: "memory");
    __builtin_amdgcn_s_barrier(); asm volatile("" ::: "memory");
}
__device__ __forceinline__ void mla_meta(int b, int h, const bf16_t* __restrict__ Q1, const bf16_t* __restrict__ K1, const bf16_t* __restrict__ kpe, const bf16_t* __restrict__ VT1, bf16_t* o, int lane) {
    const int qi = lane & 15, part = lane >> 4; const size_t qrow = (size_t)MREAL + b * 16 + qi;
    float q[24];
#pragma unroll
    for (int d = 0; d < 24; ++d) q[d] = bf2f(Q1[qrow * 1536 + h * 96 + 24 * part + d]);
    float sc[16]; float mx = -1e30f;
#pragma unroll
    for (int j = 0; j < 16; ++j) {
        const size_t kr = (size_t)b * LP + j; float s = 0.f;
#pragma unroll
        for (int d = 0; d < 24; ++d) { const int dd = 24 * part + d; const float kv = dd < 64 ? bf2f(K1[kr * D + h * 64 + dd]) : bf2f(kpe[kr * 32 + dd - 64]); s += q[d] * kv; }
        s += __shfl_xor(s, 16); s += __shfl_xor(s, 32);
        sc[j] = j <= qi ? s : -1e30f; mx = fmaxf(mx, sc[j]);
    }
    float l = 0.f;
#pragma unroll
    for (int j = 0; j < 16; ++j) { sc[j] = __expf(sc[j] - mx); l += sc[j]; }
    const float inv = 1.0f / l;
#pragma unroll
    for (int dd = 0; dd < 16; ++dd) { const int d = 16 * part + dd; float acc = 0.f;
#pragma unroll
        for (int j = 0; j < 16; ++j) acc += sc[j] * bf2f(VT1[((size_t)(b * 16 + h) * 64 + d) * LP + perm16(j)]);
        o[qrow * D + h * 64 + d] = f2bf(acc * inv); }
}
__device__ __forceinline__ void mla_phase(LAS unsigned char* lds, const bf16_t* Q1, const bf16_t* K1, const bf16_t* kpe, const bf16_t* VT1, bf16_t* o, int bid, int nblk) {
    const int v = (nblk % 8 == 0) ? (bid % 8) * (nblk / 8) + bid / 8 : bid;
    for (int vv = v; vv < 256; vv += nblk) {
        const int bh = vv >> 3, s = vv & 7, b = bh >> 4, h = bh & 15;
#pragma unroll 1
        for (int i = 0; i < 4; ++i) { const int qi = (i == 0) ? s : (i == 1) ? 15 - s : (i == 2) ? 16 + s : 31 - s; mla_unit(lds, b, h, qi, Q1, K1, kpe, VT1, o); }
        if (s == 0 && threadIdx.x < 64) mla_meta(b, h, Q1, K1, kpe, VT1, o, threadIdx.x);
    }
}

constexpr int SW_K = 0, SW_V = 36864, SW_VP = 560;
__device__ __forceinline__ void swa_block32(LAS const unsigned char* lds, int rb, int gk0, int nks, int mode, int i_q, const bf16x8 (&qf)[4], float& m, float& lsum, f32x16 (&oacc)[2], int r32, int hi) {
    const float C2 = 1.4426950408889634f;
    const int ksw = (r32 >> 1) & 7;
    f32x16 p = (f32x16){};
#pragma unroll
    for (int s = 0; s < 4; ++s) { const bf16x8 k = *(LAS const bf16x8*)(lds + SW_K + (rb + r32) * 128 + (((2 * s + hi) ^ ksw) << 4)); p = __builtin_amdgcn_mfma_f32_32x32x16_bf16(k, qf[s], p, 0, 0, 0); }
    if (mode != 0) {
        const int jb = ((rb - 32) & 127) + 4 * hi;
#pragma unroll
        for (int r = 0; r < 16; ++r) { const int kk = (r & 3) + 8 * (r >> 2);
            const bool ok = mode == 1 ? (kk + 4 * hi < 16) : mode == 2 ? (jb + kk > i_q) : (jb + kk <= i_q);
            if (!ok) p[r] = -1e30f; }
    }
    float tm = p[0];
#pragma unroll
    for (int r = 1; r < 16; ++r) tm = fmaxf(tm, p[r]);
    tm = fmaxf(tm, __shfl_xor(tm, 32));
    const float mn = fmaxf(m, tm), alpha = __builtin_amdgcn_exp2f((m - mn) * C2), nmc = -mn * C2;
    m = mn;
    float ps = 0.f;
#pragma unroll
    for (int r = 0; r < 16; ++r) { p[r] = __builtin_amdgcn_exp2f(__builtin_fmaf(p[r], C2, nmc)); ps += p[r]; }
    lsum = lsum * alpha + ps;
#pragma unroll
    for (int r = 0; r < 16; ++r) { oacc[0][r] *= alpha; oacc[1][r] *= alpha; }
    u32x4 pf[2];
    pf[0] = (u32x4){cvtpk(p[0], p[1]), cvtpk(p[2], p[3]), cvtpk(p[4], p[5]), cvtpk(p[6], p[7])};
    pf[1] = (u32x4){cvtpk(p[8], p[9]), cvtpk(p[10], p[11]), cvtpk(p[12], p[13]), cvtpk(p[14], p[15])};
#pragma unroll
    for (int ks = 0; ks < 2; ++ks) if (ks < nks) {
        const bf16x8 v0 = *(LAS const bf16x8*)(lds + SW_V + r32 * SW_VP + (gk0 + ks) * 32 + hi * 16);
        const bf16x8 v1 = *(LAS const bf16x8*)(lds + SW_V + (32 + r32) * SW_VP + (gk0 + ks) * 32 + hi * 16);
        const bf16x8 pb = __builtin_bit_cast(bf16x8, pf[ks]);
        oacc[0] = __builtin_amdgcn_mfma_f32_32x32x16_bf16(v0, pb, oacc[0], 0, 0, 0);
        oacc[1] = __builtin_amdgcn_mfma_f32_32x32x16_bf16(v1, pb, oacc[1], 0, 0, 0);
    }
}
__device__ __forceinline__ void swa_unit(LAS unsigned char* lds, int b, int n, int kh, const bf16_t* __restrict__ qkv, const bf16_t* __restrict__ VT0, const float* __restrict__ sinks, bf16_t* o) {
    const int tid = threadIdx.x, lane = tid & 63, wave = __builtin_amdgcn_readfirstlane(tid >> 6), r32 = lane & 31, hi = lane >> 5;
    for (int idx = tid; idx < 2176; idx += NTHR) {
        const int row = idx >> 3, c = idx & 7;
        if (row < 16 || n > 0 || row >= 144) {
            const size_t srow = row < 16 ? (size_t)MREAL + b * 16 + row : (size_t)b * SEQ + 128 * (n - 1) + (row - 16);
            const int lrow = row < 16 ? row : 16 + row;
            const u32x4 v = *(const u32x4*)(qkv + srow * NQKV + 1024 + kh * 64 + c * 8);
            *(LAS u32x4*)(lds + SW_K + lrow * 128 + ((c ^ ((lrow >> 1) & 7)) << 4)) = v;
        }
    }
    for (int idx = tid; idx < 2176; idx += NTHR) {
        const int d = idx / 34, c = idx % 34;
        if (c < 2 || n > 0 || c >= 18) {
            const bf16_t* src = VT0 + (size_t)((b * 2 + kh) * 64 + d) * LP + (c < 2 ? c * 8 : 16 + 128 * (n - 1) + (c - 2) * 8);
            *(LAS u32x4*)(lds + SW_V + d * SW_VP + c * 16) = *(const u32x4*)src;
        }
    }
    __syncthreads();
    const int hq = kh * 8 + wave;
    const float sink = sinks[hq];
#pragma unroll 1
    for (int qs = 0; qs < 4; ++qs) {
        const size_t qrow = (size_t)b * SEQ + 128 * n + 32 * qs + r32;
        bf16x8 qf[4];
#pragma unroll
        for (int s = 0; s < 4; ++s) qf[s] = *(const bf16x8*)(qkv + qrow * NQKV + hq * 64 + 16 * s + 8 * hi);
        f32x16 oacc[2]; oacc[0] = (f32x16){}; oacc[1] = (f32x16){};
        float m = sink, lsum = hi == 0 ? 1.0f : 0.0f;
        const int i_q = 32 * qs + r32;
        swa_block32(lds, 0, 0, 1, 1, i_q, qf, m, lsum, oacc, r32, hi);
        if (n > 0) {
            swa_block32(lds, 32 + 32 * qs, 1 + 2 * qs, 2, 2, i_q, qf, m, lsum, oacc, r32, hi);
#pragma unroll 1
            for (int kb = qs + 1; kb < 4; ++kb) swa_block32(lds, 32 + 32 * kb, 1 + 2 * kb, 2, 0, i_q, qf, m, lsum, oacc, r32, hi);
        }
#pragma unroll 1
        for (int kb = 0; kb < qs; ++kb) swa_block32(lds, 160 + 32 * kb, 9 + 2 * kb, 2, 0, i_q, qf, m, lsum, oacc, r32, hi);
        swa_block32(lds, 160 + 32 * qs, 9 + 2 * qs, 2, 3, i_q, qf, m, lsum, oacc, r32, hi);
        lsum += __shfl_xor(lsum, 32);
        const float inv = 1.0f / lsum;
        bf16_t* orow = o + qrow * D + hq * 64 + 4 * hi;
#pragma unroll
        for (int db = 0; db < 2; ++db)
#pragma unroll
            for (int g = 0; g < 4; ++g)
                *(u32x2*)(orow + 32 * db + 8 * g) = (u32x2){cvtpk(oacc[db][4 * g] * inv, oacc[db][4 * g + 1] * inv), cvtpk(oacc[db][4 * g + 2] * inv, oacc[db][4 * g + 3] * inv)};
    }
    __syncthreads();
}
__device__ __forceinline__ void swa_meta(int b, int hq, const bf16_t* __restrict__ qkv, const bf16_t* __restrict__ VT0, const float* __restrict__ sinks, bf16_t* o, int lane) {
    const int qi = lane & 15, part = lane >> 4, kh = hq >> 3; const size_t qrow = (size_t)MREAL + b * 16 + qi;
    float q[16];
#pragma unroll
    for (int d = 0; d < 16; ++d) q[d] = bf2f(qkv[qrow * NQKV + hq * 64 + 16 * part + d]);
    const float sink = sinks[hq];
    float sc[16]; float mx = sink;
#pragma unroll
    for (int j = 0; j < 16; ++j) {
        const size_t kr = (size_t)MREAL + b * 16 + j; float s = 0.f;
#pragma unroll
        for (int d = 0; d < 16; ++d) s += q[d] * bf2f(qkv[kr * NQKV + 1024 + kh * 64 + 16 * part + d]);
        s += __shfl_xor(s, 16); s += __shfl_xor(s, 32);
        sc[j] = j <= qi ? s : -1e30f; mx = fmaxf(mx, sc[j]);
    }
    float l = __expf(sink - mx);
#pragma unroll
    for (int j = 0; j < 16; ++j) { sc[j] = __expf(sc[j] - mx); l += sc[j]; }
    const float inv = 1.0f / l;
#pragma unroll
    for (int dd = 0; dd < 16; ++dd) { const int d = 16 * part + dd; float acc = 0.f;
#pragma unroll
        for (int j = 0; j < 16; ++j) acc += sc[j] * bf2f(VT0[((size_t)(b * 2 + kh) * 64 + d) * LP + perm16(j)]);
        o[qrow * D + hq * 64 + d] = f2bf(acc * inv); }
}
__device__ __forceinline__ void swa_phase(LAS unsigned char* lds, const bf16_t* qkv, const bf16_t* VT0, const float* sinks, bf16_t* o, int bid, int nblk) {
    for (int u = bid; u < 256; u += nblk) {
        const int b = u >> 7, n = (u >> 1) & 63, kh = u & 1;
        swa_unit(lds, b, n, kh, qkv, VT0, sinks, o);
        if (n == 0) swa_meta(b, kh * 8 + (threadIdx.x >> 6), qkv, VT0, sinks, o, threadIdx.x & 63);
    }
}

constexpr int MOE_ST1 = (64 + 512) * 128;
constexpr int MOE_H = 0, MOE_B2 = 32768, MOE_ST2 = 32768;
static_assert(2 * MOE_ST1 <= LDS_MISC, "moe lds");
__device__ __forceinline__ void moe_unit(LAS unsigned char* lds, int e, int s0, int ns, const int* __restrict__ list, const bf16_t* __restrict__ hb, const float* __restrict__ rstd,
                                         const float* __restrict__ wslot, const bf16_t* __restrict__ wgu, const bf16_t* __restrict__ wd, bf16_t* ybuf) {
    const int tid = threadIdx.x, lane = tid & 63, wave = __builtin_amdgcn_readfirstlane(tid >> 6);
    LAS int* slotl = (LAS int*)(lds + LDS_MISC + 256);
    if (tid < 64) slotl[tid] = list[(size_t)e * CAP + s0 + (tid < ns ? tid : 0)];
    __syncthreads();
    const int lc = (lane & 7) ^ (lane >> 3);
    const int fro = (lane & 15) * 128, fc0 = ((lane >> 4) ^ (lane & 7)) << 4, fc1 = ((4 + (lane >> 4)) ^ (lane & 7)) << 4;
    int myslot[4]; float myrs[4];
#pragma unroll
    for (int mi = 0; mi < 4; ++mi) { myslot[mi] = slotl[mi * 16 + (lane & 15)]; myrs[mi] = rstd[myslot[mi] >> 1]; }
    {
        const char* src[9];
#pragma unroll
        for (int i = 0; i < 9; ++i) { const int g = wave + 8 * i;
            if (g < 8) src[i] = (const char*)(hb + (size_t)(slotl[g * 8 + (lane >> 3)] >> 1) * D) + lc * 16;
            else src[i] = (const char*)(wgu + (size_t)((g - 8) * 8 + (lane >> 3)) * D) + lc * 16; }
        f32x4 acc[4][4];
#pragma unroll
        for (int mi = 0; mi < 4; ++mi)
#pragma unroll
            for (int ni = 0; ni < 4; ++ni) acc[mi][ni] = (f32x4){0.f, 0.f, 0.f, 0.f};
#define M1_STAGE(st, kt) do { _Pragma("unroll") for (int _i = 0; _i < 9; ++_i) \
        __builtin_amdgcn_global_load_lds((const unsigned*)(src[_i] + (size_t)(kt) * 128), (LAS unsigned*)(lds + (st) * MOE_ST1 + (wave + 8 * _i) * 1024), 16, 0, 0); } while (0)
        M1_STAGE(0, 0);
        for (int kt = 0; kt < 16; ++kt) {
            asm volatile("s_waitcnt vmcnt(0)" ::: "memory");
            __syncthreads();
            if (kt + 1 < 16) M1_STAGE((kt + 1) & 1, kt + 1);
            LAS const unsigned char* sa = lds + (kt & 1) * MOE_ST1 + fro;
            LAS const unsigned char* sb = lds + (kt & 1) * MOE_ST1 + (64 + wave * 64) * 128 + fro;
#pragma unroll
            for (int ks = 0; ks < 2; ++ks) { const int fc = ks ? fc1 : fc0;
                bf16x8 af[4], bfr[4];
#pragma unroll
                for (int mi = 0; mi < 4; ++mi) af[mi] = *(LAS const bf16x8*)(sa + mi * 2048 + fc);
#pragma unroll
                for (int ni = 0; ni < 4; ++ni) bfr[ni] = *(LAS const bf16x8*)(sb + ni * 2048 + fc);
#pragma unroll
                for (int mi = 0; mi < 4; ++mi)
#pragma unroll
                    for (int ni = 0; ni < 4; ++ni) acc[mi][ni] = __builtin_amdgcn_mfma_f32_16x16x32_bf16(bfr[ni], af[mi], acc[mi][ni], 0, 0, 0);
            }
        }
#undef M1_STAGE
#pragma unroll
        for (int mi = 0; mi < 4; ++mi) { const int row = mi * 16 + (lane & 15); const float rs = myrs[mi];
#pragma unroll
            for (int ni = 0; ni < 2; ++ni) { float hv[4];
#pragma unroll
                for (int r = 0; r < 4; ++r) { const float g = acc[mi][ni][r] * rs, u = acc[mi][ni + 2][r] * rs; hv[r] = g / (1.0f + __expf(-g)) * u; }
                const int n = 32 * wave + ni * 16 + (lane >> 4) * 4;
                *(LAS u32x2*)(lds + MOE_H + (n >> 6) * 8192 + row * 128 + ((((n & 63) >> 3) ^ (row & 7)) << 4) + (n & 4) * 2) = (u32x2){pk2(hv[0], hv[1]), pk2(hv[2], hv[3])}; }
        }
    }
    __syncthreads();
    {
        const char* src2[4];
#pragma unroll
        for (int i = 0; i < 4; ++i) src2[i] = (const char*)(wd + (size_t)((wave + 8 * i) * 8 + (lane >> 3)) * DE) + lc * 16;
        float myw[4];
#pragma unroll
        for (int mi = 0; mi < 4; ++mi) myw[mi] = wslot[myslot[mi]];
        f32x4 acc[4][2];
#pragma unroll
        for (int mi = 0; mi < 4; ++mi) { acc[mi][0] = (f32x4){0.f, 0.f, 0.f, 0.f}; acc[mi][1] = (f32x4){0.f, 0.f, 0.f, 0.f}; }
#define M2_STAGE(st, q) do { _Pragma("unroll") for (int _i = 0; _i < 4; ++_i) \
        __builtin_amdgcn_global_load_lds((const unsigned*)(src2[_i] + (size_t)((q) >> 2) * (256 * 512) + (size_t)((q) & 3) * 128), (LAS unsigned*)(lds + MOE_B2 + (st) * MOE_ST2 + (wave + 8 * _i) * 1024), 16, 0, 0); } while (0)
        M2_STAGE(0, 0);
        for (int q = 0; q < 16; ++q) {
            asm volatile("s_waitcnt vmcnt(0)" ::: "memory");
            __syncthreads();
            if (q + 1 < 16) M2_STAGE((q + 1) & 1, q + 1);
            LAS const unsigned char* sa = lds + MOE_H + (q & 3) * 8192 + fro;
            LAS const unsigned char* sb = lds + MOE_B2 + (q & 1) * MOE_ST2 + (wave * 32) * 128 + fro;
#pragma unroll
            for (int ks = 0; ks < 2; ++ks) { const int fc = ks ? fc1 : fc0;
                bf16x8 af[4], bfr[2];
#pragma unroll
                for (int mi = 0; mi < 4; ++mi) af[mi] = *(LAS const bf16x8*)(sa + mi * 2048 + fc);
#pragma unroll
                for (int ni = 0; ni < 2; ++ni) bfr[ni] = *(LAS const bf16x8*)(sb + ni * 2048 + fc);
#pragma unroll
                for (int mi = 0; mi < 4; ++mi)
#pragma unroll
                    for (int ni = 0; ni < 2; ++ni) acc[mi][ni] = __builtin_amdgcn_mfma_f32_16x16x32_bf16(bfr[ni], af[mi], acc[mi][ni], 0, 0, 0);
            }
            if ((q & 3) == 3) {
                const int cb = (q >> 2) * 256 + wave * 32 + (lane >> 4) * 4;
#pragma unroll
                for (int mi = 0; mi < 4; ++mi) { const int row = mi * 16 + (lane & 15);
                    if (row < ns) {
#pragma unroll
                        for (int ni = 0; ni < 2; ++ni) { const f32x4 v = acc[mi][ni] * myw[mi];
                            *(u32x2*)(ybuf + (size_t)myslot[mi] * D + cb + ni * 16) = (u32x2){pk2(v[0], v[1]), pk2(v[2], v[3])}; } }
                    acc[mi][0] = (f32x4){0.f, 0.f, 0.f, 0.f}; acc[mi][1] = (f32x4){0.f, 0.f, 0.f, 0.f}; }
            }
        }
#undef M2_STAGE
    }
    __syncthreads();
}
__device__ __forceinline__ void moe_phase(LAS unsigned char* lds, int* cnt, const int* list, const bf16_t* hb, const float* rstd, const float* wslot, const bf16_t* wgu, const bf16_t* wd, bf16_t* ybuf, int bid, int nblk) {
    int u = bid, base = 0;
    for (int e = 0; e < NE; ++e) {
        const int c = __hip_atomic_load(cnt + e, __ATOMIC_RELAXED, __HIP_MEMORY_SCOPE_AGENT);
        const int nt = (c + 63) >> 6;
        while (u < base + nt) { const int t = u - base; const int ns = c - t * 64 < 64 ? c - t * 64 : 64;
            moe_unit(lds, e, t * 64, ns, list, hb, rstd, wslot, wgu + (size_t)e * 512 * 1024, wd + (size_t)e * 1024 * 256, ybuf);
            u += nblk; }
        base += nt;
    }
}

__device__ __forceinline__ void transpose_item(const float* __restrict__ W, int N, const float* __restrict__ gain, bf16_t* dst, int ldk, int drow0, int k0, int n0, LAS float* scr, int lane) {
#pragma unroll 8
    for (int i = 0; i < 32; ++i) { const int kk = 2 * i + (lane >> 5); float v = W[(size_t)(k0 + kk) * N + n0 + (lane & 31)]; if (gain) v *= gain[k0 + kk]; scr[kk * 33 + (lane & 31)] = v; }
    asm volatile("s_waitcnt lgkmcnt(0)" ::: "memory");
    const int c = lane & 7;
#pragma unroll
    for (int j = 0; j < 4; ++j) { const int n = (lane >> 3) + 8 * j; const LAS float* s = scr + (8 * c) * 33 + n;
        u32x4 o; o.x = pk2(s[0 * 33], s[1 * 33]); o.y = pk2(s[2 * 33], s[3 * 33]); o.z = pk2(s[4 * 33], s[5 * 33]); o.w = pk2(s[6 * 33], s[7 * 33]);
        *(u32x4*)(dst + (size_t)(drow0 + n) * ldk + k0 + 8 * c) = o; }
    asm volatile("s_waitcnt lgkmcnt(0)" ::: "memory");
}
__device__ __forceinline__ void moe_weight_items(const float* wgate, const float* wup, const float* wdown, const float* gain, bf16_t* wgu_t, bf16_t* wd_t, LAS float* scr, int gw, int ngw, int lane) {
    for (int it = gw; it < NE * 384; it += ngw) {
        const int e = it / 384, r = it % 384, which = r >> 7, q = r & 127;
        if (which < 2) { const int kb = q >> 3, nb = q & 7;
            transpose_item((which ? wup : wgate) + (size_t)e * D * DE, DE, gain, wgu_t + (size_t)e * 512 * 1024, 1024, nb * 64 + which * 32, kb * 64, nb * 32, scr, lane);
        } else { const int kb = q >> 5, nb = q & 31;
            transpose_item(wdown + (size_t)e * DE * D, D, nullptr, wd_t + (size_t)e * 1024 * 256, 256, nb * 32, kb * 64, nb * 32, scr, lane);
        }
    }
}
__device__ __forceinline__ void p0_prologue(const MArgs& a, LAS unsigned char* lds, int bid, int nblk) {
    const int tid = threadIdx.x, lane = tid & 63, wave = __builtin_amdgcn_readfirstlane(tid >> 6);
    const int gw = bid * NWAVE + wave, ngw = nblk * NWAVE, gt = bid * NTHR + tid, ngt = nblk * NTHR;
    unsigned char* ws = a.ws;
    float2* cs = (float2*)(ws + WS_ROPE);
    for (int idx = gt; idx < LPOS * 32; idx += ngt) { const int pos = idx >> 5, i = idx & 31; const float inv = 1.0f / powf(10000.0f, (float)(2 * i) / 64.0f); float s, c; sincosf((float)pos * inv, &s, &c); cs[idx] = make_float2(c, s); }
    float* wrf = (float*)(ws + W2_WRF);
    for (int idx = gt; idx < 2 * 36 * 1024; idx += ngt) { const int l = idx / (36 * 1024), j = (idx >> 10) % 36, k = idx & 1023;
        const float g = a.in[3][l * D + k]; wrf[idx] = g * (j < 4 ? a.in[16][(size_t)l * D * 4 + k * 4 + j] : a.in[18][(size_t)l * D * 32 + k * 32 + (j - 4)]); }
    { u32x4* z = (u32x4*)(ws + W2_WIN + (size_t)416 * 1024 * 2); for (int idx = gt; idx < 96 * 1024 * 2 / 16; idx += ngt) z[idx] = (u32x4){0u, 0u, 0u, 0u}; }
    { bf16_t* kpe = (bf16_t*)(ws + WS_KPE); for (int idx = gt; idx < 2 * 48 * 32; idx += ngt) { const int b = idx / (48 * 32), r = idx % (48 * 32); kpe[((size_t)b * LP + 8208) * 32 + r] = 0; }
      bf16_t* vt0 = (bf16_t*)(ws + B_VT0); for (int idx = gt; idx < 2 * 2 * 64 * 48; idx += ngt) { const int rr = idx / 48, c = idx % 48; vt0[(size_t)rr * LP + 8208 + c] = 0; } }
    { bf16_t* hb = (bf16_t*)(ws + W2_HB); float* rstd = (float*)(ws + W2_RSTD);
      for (int row = gw; row < MTOT; row += ngw) {
        const float* src = row < MREAL ? a.in[0] + (size_t)row * D : a.in[1] + (size_t)row_pos(row) * D;
        float ss = 0.f;
#pragma unroll
        for (int j = 0; j < 4; ++j) { const f32x4 v = *(const f32x4*)(src + j * 256 + lane * 4); ss += v[0] * v[0] + v[1] * v[1] + v[2] * v[2] + v[3] * v[3];
            *(u32x2*)(hb + (size_t)row * D + j * 256 + lane * 4) = (u32x2){pk2(v[0], v[1]), pk2(v[2], v[3])}; }
        ss = wave_sum(ss); if (lane == 0) rstd[row] = rsqrtf(ss * (1.0f / D) + EPS);
      } }
    LAS float* scr = (LAS float*)(lds + wave * 16384);
    for (int it = gw; it < 2192; it += ngw) {
        int r = it;
        if (r < 640) { transpose_item(a.in[5], NQKV, a.in[2], (bf16_t*)(ws + W2_WQKV), 1024, (r % 40) * 32, (r / 40) * 64, (r % 40) * 32, scr, lane); continue; } r -= 640;
        if (r < 512) { transpose_item(a.in[8], D, nullptr, (bf16_t*)(ws + W2_WO0), 1024, (r & 31) * 32, (r >> 5) * 64, (r & 31) * 32, scr, lane); continue; } r -= 512;
        if (r < 208) { transpose_item(a.in[10], 416, a.in[2] + D, (bf16_t*)(ws + W2_WIN), 1024, (r % 13) * 32, (r / 13) * 64, (r % 13) * 32, scr, lane); continue; } r -= 208;
        if (r < 192) { transpose_item(a.in[13], 1536, a.in[11], (bf16_t*)(ws + W2_WUQ), 256, (r % 48) * 32, (r / 48) * 64, (r % 48) * 32, scr, lane); continue; } r -= 192;
        if (r < 128) { const int nb32 = r & 63, hh = nb32 >> 2, part = nb32 & 3;
            transpose_item(a.in[14], 2048, a.in[12], (bf16_t*)(ws + W2_WUKV), 128, part < 2 ? hh * 64 + part * 32 : 1024 + hh * 64 + (part - 2) * 32, (r >> 6) * 64, nb32 * 32, scr, lane); continue; } r -= 128;
        transpose_item(a.in[15], D, nullptr, (bf16_t*)(ws + W2_WO1), 1024, (r & 31) * 32, (r >> 5) * 64, (r & 31) * 32, scr, lane);
    }
    moe_weight_items(a.in[20], a.in[21], a.in[22], a.in[3], (bf16_t*)(ws + C_W0), (bf16_t*)(ws + C_W0 + MOE_WGU_BYTES), scr, gw, ngw, lane);
}

template <bool NSW, class MakeEpi>
__device__ __forceinline__ void gemm_phase(LAS unsigned char* lds, const bf16_t* A, int lda, const bf16_t* Bt, int K, int pn0, int pn1, int bid, int nblk, const MakeEpi& mk) {
    const int ntn = pn1 - pn0, nbig = 64 * ntn, ntot = nbig + ntn;
    for (int u = bid; u < ntot; u += nblk) {
        if (u < nbig) { const int pm = u / ntn, pn = pn0 + u % ntn;
            RowDense ra{A, lda, pm * 256, MTOT - 1}; auto e = mk(pm * 256, pn * 256);
            gemm_tile<8, 4, 2, 4, NSW>(lds, ra, Bt + (size_t)pn * 256 * K, K, K / 64, e);
        } else { const int pn = pn0 + u - nbig;
            RowDense ra{A, lda, MREAL, MTOT - 1}; auto e = mk(MREAL, pn * 256);
            gemm_tile<1, 4, 2, 4, NSW>(lds, ra, Bt + (size_t)pn * 256 * K, K, K / 64, e);
        }
    }
}

constexpr int PH_PROLOGUE = 0, PH_QKV = 1, PH_SWA = 2, PH_OPROJ0 = 3, PH_ROUTE0 = 4, PH_MOE0 = 5, PH_COMBINE = 6, PH_WIN = 7, PH_CEPI = 8, PH_UQKV = 9, PH_MLA = 10, PH_OPROJ1 = 11, PH_ROUTE1 = 12, PH_MOE1 = 13, PH_FINAL = 14, PH_N = 15;
__global__ void __launch_bounds__(NTHR, 2) mega(MArgs a) {
    extern __shared__ __attribute__((aligned(16))) unsigned char lds_raw[];
    LAS unsigned char* lds = (LAS unsigned char*)lds_raw;
    const int tid = threadIdx.x, bid = blockIdx.x, nblk = gridDim.x;
    volatile LAS unsigned* misc = (volatile LAS unsigned*)(lds + LDS_MISC);
    if (tid < 64) misc[tid] = 0u;
    __syncthreads();
    unsigned char* ws = a.ws;
    XcdBarrier bar = xcd_barrier_post((unsigned*)(ws + WS_BAR) + a.li * XCD_BAR_WORDS, misc);
    const int lo = a.ph_lo, hi = a.ph_hi;
#define IN(k) (lo <= (k) && (k) < hi)
#define SEAM(k) do { if (IN(k) && IN((k) + 1)) xcd_barrier(bar); } while (0)
    if (IN(PH_PROLOGUE)) p0_prologue(a, lds, bid, nblk);
    SEAM(PH_PROLOGUE);
    if (IN(PH_QKV)) {
        const float* rstd = (const float*)(ws + W2_RSTD); const float* bias = a.in[6]; const float2* cs = (const float2*)(ws + WS_ROPE); bf16_t* qkv = (bf16_t*)(ws + B_QKV); bf16_t* vt0 = (bf16_t*)(ws + B_VT0);
        const bf16_t* hbA = (const bf16_t*)(ws + W2_HB); const bf16_t* Wt = (const bf16_t*)(ws + W2_WQKV);
        for (int u = bid; u < 390; u += nblk) {
            if (u < 256) { const int pm = u >> 2, pn = u & 3; RowDense ra{hbA, D, pm * 256, MTOT - 1}; EpiQKV e{rstd, bias, cs, qkv, pm * 256, pn * 256};
                gemm_tile<8, 4, 2, 4, false>(lds, ra, Wt + (size_t)pn * 256 * D, D, D / 64, e);
            } else if (u < 320) { const int pm = u - 256; RowDense ra{hbA, D, pm * 256, MTOT - 1}; EpiQKV e{rstd, bias, cs, qkv, pm * 256, 1024};
                gemm_tile<4, 4, 4, 2, false>(lds, ra, Wt + (size_t)1024 * D, D, D / 64, e);
            } else if (u < 384) { const int pm = u - 320; RowDense ra{hbA, D, pm * 256, MTOT - 1}; EpiV0 e{rstd, bias, vt0, pm * 256, 1152};
                gemm_tile<4, 4, 4, 2, true>(lds, ra, Wt + (size_t)1152 * D, D, D / 64, e);
            } else if (u < 388) { const int pn = u - 384; RowDense ra{hbA, D, MREAL, MTOT - 1}; EpiQKV e{rstd, bias, cs, qkv, MREAL, pn * 256};
                gemm_tile<1, 4, 2, 4, false>(lds, ra, Wt + (size_t)pn * 256 * D, D, D / 64, e);
            } else if (u == 388) { RowDense ra{hbA, D, MREAL, MTOT - 1}; EpiQKV e{rstd, bias, cs, qkv, MREAL, 1024};
                gemm_tile<1, 4, 4, 2, false>(lds, ra, Wt + (size_t)1024 * D, D, D / 64, e);
            } else { RowDense ra{hbA, D, MREAL, MTOT - 1}; EpiV0 e{rstd, bias, vt0, MREAL, 1152};
                gemm_tile<1, 4, 4, 2, true>(lds, ra, Wt + (size_t)1152 * D, D, D / 64, e);
            }
        }
    }
    SEAM(PH_QKV);
    if (IN(PH_SWA)) swa_phase(lds, (const bf16_t*)(ws + B_QKV), (const bf16_t*)(ws + B_VT0), a.in[7], (bf16_t*)(ws + B_O0), bid, nblk);
    SEAM(PH_SWA);
    if (IN(PH_OPROJ0)) {
        const float* bias = a.in[9]; const bf16_t* hb = (const bf16_t*)(ws + W2_HB); float* hf = (float*)(ws + C_HF);
        gemm_phase<false>(lds, (const bf16_t*)(ws + B_O0), D, (const bf16_t*)(ws + W2_WO0), D, 0, 4, bid, nblk, [=](int m0, int n0) { return EpiResF32{bias, hb, hf, m0, n0}; });
    }
    SEAM(PH_OPROJ0);
    if (IN(PH_ROUTE0))
        route_phase(lds, (const float*)(ws + C_HF), (const float*)(ws + W2_WRF), a.in[17], a.in[19], (bf16_t*)(ws + W2_HB), (float*)(ws + W2_RSTD), (int*)(ws + WS_CTL),
                    (int*)(ws + W2_LIST), (float*)(ws + W2_WSLOT), (int*)(ws + W2_EID), bid, nblk);
    SEAM(PH_ROUTE0);
    if (IN(PH_MOE0)) moe_phase(lds, (int*)(ws + WS_CTL), (const int*)(ws + W2_LIST), (const bf16_t*)(ws + W2_HB), (const float*)(ws + W2_RSTD), (const float*)(ws + W2_WSLOT),
                               (const bf16_t*)(ws + C_W0), (const bf16_t*)(ws + C_W0 + MOE_WGU_BYTES), (bf16_t*)(ws + B_Y0), bid, nblk);
    SEAM(PH_MOE0);
    if (IN(PH_COMBINE)) combine_phase((bf16_t*)(ws + W2_HB), (const bf16_t*)(ws + B_Y0), (float*)(ws + W2_RSTD), bid, nblk);
    SEAM(PH_COMBINE);
    if (IN(PH_WIN)) {
        const float* rstd = (const float*)(ws + W2_RSTD); float* cbuf = (float*)(ws + B_CBUF);
        gemm_phase<false>(lds, (const bf16_t*)(ws + W2_HB), D, (const bf16_t*)(ws + W2_WIN), D, 0, 2, bid, nblk, [=](int m0, int n0) { return EpiWin{rstd, cbuf, m0, n0}; });
    }
    SEAM(PH_WIN);
    if (IN(PH_CEPI)) cepi_phase((const float*)(ws + B_CBUF), (const float2*)(ws + WS_ROPE), (bf16_t*)(ws + B_CQN), (bf16_t*)(ws + B_CKVN), (bf16_t*)(ws + WS_KPE), bid, nblk);
    SEAM(PH_CEPI);
    if (IN(PH_UQKV)) {
        const float2* cs = (const float2*)(ws + WS_ROPE); bf16_t* Q1 = (bf16_t*)(ws + C_Q1); bf16_t* K1 = (bf16_t*)(ws + C_K1); bf16_t* V1 = (bf16_t*)(ws + C_V1);
        { const int gt = bid * NTHR + tid, ngt = nblk * NTHR;
          for (int idx = gt; idx < 2 * 48 * 1024; idx += ngt) { const int b = idx / (48 * 1024), r = idx % (48 * 1024); K1[((size_t)b * LP + 8208) * 1024 + r] = 0; }
          for (int idx = gt; idx < 2 * 16 * 64 * 48; idx += ngt) { const int rr = idx / 48, c = idx % 48; V1[(size_t)rr * LP + 8208 + c] = 0; } }
        gemm_phase<false>(lds, (const bf16_t*)(ws + B_CQN), 256, (const bf16_t*)(ws + W2_WUQ), 256, 0, 6, bid, nblk, [=](int m0, int n0) { return EpiUQ{cs, Q1, m0, n0}; });
        gemm_phase<false>(lds, (const bf16_t*)(ws + B_CKVN), 128, (const bf16_t*)(ws + W2_WUKV), 128, 0, 4, bid, nblk, [=](int m0, int n0) { return EpiK1{K1, m0, n0}; });
        gemm_phase<true>(lds, (const bf16_t*)(ws + B_CKVN), 128, (const bf16_t*)(ws + W2_WUKV), 128, 4, 8, bid, nblk, [=](int m0, int n0) { return EpiV1{V1, m0, n0}; });
    }
    SEAM(PH_UQKV);
    if (IN(PH_MLA)) {
        const int wave = __builtin_amdgcn_readfirstlane(tid >> 6);
        moe_weight_items(a.in[20] + (size_t)NE * D * DE, a.in[21] + (size_t)NE * D * DE, a.in[22] + (size_t)NE * DE * D, a.in[3] + D, (bf16_t*)(ws + B_W1), (bf16_t*)(ws + B_W1 + MOE_WGU_BYTES),
                         (LAS float*)(lds + 65536 + wave * 8704), bid * NWAVE + wave, nblk * NWAVE, tid & 63);
        __syncthreads();
    }
    if (IN(PH_MLA)) mla_phase(lds, (const bf16_t*)(ws + C_Q1), (const bf16_t*)(ws + C_K1), (const bf16_t*)(ws + WS_KPE), (const bf16_t*)(ws + C_V1), (bf16_t*)(ws + B_O1), bid, nblk);
    SEAM(PH_MLA);
    if (IN(PH_OPROJ1)) {
        const bf16_t* hb = (const bf16_t*)(ws + W2_HB); float* hf = (float*)(ws + C_HF1);
        gemm_phase<false>(lds, (const bf16_t*)(ws + B_O1), D, (const bf16_t*)(ws + W2_WO1), D, 0, 4, bid, nblk, [=](int m0, int n0) { return EpiResF32{nullptr, hb, hf, m0, n0}; });
    }
    SEAM(PH_OPROJ1);
    if (IN(PH_ROUTE1))
        route_phase(lds, (const float*)(ws + C_HF1), (const float*)(ws + W2_WRF) + 36 * 1024, a.in[17] + 4, a.in[19] + 32, (bf16_t*)(ws + W2_HB), (float*)(ws + W2_RSTD), (int*)(ws + WS_CTL) + 32,
                    (int*)(ws + W2_LIST), (float*)(ws + W2_WSLOT), (int*)(ws + W2_EID), bid, nblk);
    SEAM(PH_ROUTE1);
    if (IN(PH_MOE1)) moe_phase(lds, (int*)(ws + WS_CTL) + 32, (const int*)(ws + W2_LIST), (const bf16_t*)(ws + W2_HB), (const float*)(ws + W2_RSTD), (const float*)(ws + W2_WSLOT),
                               (const bf16_t*)(ws + B_W1), (const bf16_t*)(ws + B_W1 + MOE_WGU_BYTES), (bf16_t*)(ws + C_Y1), bid, nblk);
    SEAM(PH_MOE1);
    if (IN(PH_FINAL)) final_phase((const bf16_t*)(ws + W2_HB), (const bf16_t*)(ws + C_Y1), a.in[4], a.out, bid, nblk);
#undef IN
#undef SEAM
}

static void ngemm(hipStream_t s, const bf16_t* A, int lda, const float* gain, const float* W, int ldw, int woff, const float* rstd, const float* bias,
                  const bf16_t* resid, int ldr, float* C, int ldc, int M, int N, int K) {
    dim3 grid((N + 63) / 64, (M + 63) / 64);
    hipLaunchKernelGGL(k_ngemm, grid, dim3(256), 0, s, A, lda, gain, W, ldw, woff, rstd, bias, resid, ldr, C, ldc, M, N, K);
}
static void run_mega(hipStream_t s, const MArgs& base, int lo, int hi, int grid) {
    MArgs a = base; a.ph_lo = lo; a.ph_hi = hi; a.li = lo;
    hipLaunchKernelGGL(mega, dim3(grid), dim3(NTHR), LDS_BYTES, s, a);
}
#define OPT_QKV 1
#define OPT_OPROJ 1

extern "C" void kernel_launch(void* const* d_in, const int* in_sizes, int n_in, void* d_out, int out_size, void* d_ws, size_t ws_size, hipStream_t stream) {
    static int grid = 0;
    if (grid == 0) {
        if (n_in != 23 || ws_size < WS_END) { fprintf(stderr, "kernel_launch: unexpected n_in %d or ws_size %zu\n", n_in, ws_size); grid = -1; return; }
        if (hipFuncSetAttribute((const void*)mega, hipFuncAttributeMaxDynamicSharedMemorySize, LDS_BYTES) != hipSuccess) { fprintf(stderr, "hipFuncSetAttribute failed\n"); grid = -1; return; }
        int dev = 0, cus = 0, per_cu = 0;
        (void)hipGetDevice(&dev); (void)hipDeviceGetAttribute(&cus, hipDeviceAttributeMultiprocessorCount, dev);
        (void)hipOccupancyMaxActiveBlocksPerMultiprocessor(&per_cu, (const void*)mega, NTHR, LDS_BYTES);
        if (per_cu < 1) { fprintf(stderr, "occupancy query says %d blocks/CU\n", per_cu); }
        (void)hipGetLastError();
        grid = cus;
    }
    if (grid < 0) return;
    (void)in_sizes; (void)out_size;
    unsigned char* ws = (unsigned char*)d_ws;
    MArgs base{}; for (int i = 0; i < 23; ++i) base.in[i] = (const float*)d_in[i]; base.out = (float*)d_out; base.ws = ws;
    (void)hipMemsetAsync(ws + WS_CTL, 0, 1 * MiB, stream);
    run_mega(stream, base, 0, PH_N, grid);
}
```

```cpp
#include <hip/hip_runtime.h>
#include <cstdio>
#include <cstdint>

typedef unsigned short bf16_t;

constexpr int D = 1024, SEQ = 8192, NB = 2, NMETA = 16;
constexpr int MREAL = NB * SEQ;
constexpr int MTOT = MREAL + NB * NMETA;
constexpr int LPOS = NMETA + SEQ;
constexpr int NQKV = 1280;
constexpr int NE = 32, DE = 256;
constexpr int CAP = MTOT * 2;
constexpr float EPS = 1e-6f;

__device__ __forceinline__ float bf2f(bf16_t v) { return __uint_as_float(((unsigned)v) << 16); }
__device__ __forceinline__ bf16_t f2bf(float f) { unsigned u = __float_as_uint(f); u += 0x7fffu + ((u >> 16) & 1u); return (bf16_t)(u >> 16); }
__device__ __forceinline__ int row_pos(int row) { return row < MREAL ? NMETA + (row & (SEQ - 1)) : ((row - MREAL) & (NMETA - 1)); }
__device__ __forceinline__ int row_batch(int row) { return row < MREAL ? (row >> 13) : ((row - MREAL) >> 4); }
constexpr int LP = 8256;
__device__ __forceinline__ int perm16(int p) { const int qd = (p >> 2) & 3; return (p & ~12) | ((((qd & 1) << 1) | (qd >> 1)) << 2); }
__device__ __forceinline__ float wave_sum(float v) {
#pragma unroll
    for (int o = 1; o < 64; o <<= 1) v += __shfl_xor(v, o);
    return v;
}

constexpr size_t MiB = 1u << 20;
constexpr size_t WS_CTL = 0;
constexpr size_t WS_ROPE = 1 * MiB;
constexpr size_t WS_END = 256 * MiB;

#define LAS __attribute__((address_space(3)))
#define GAS __attribute__((address_space(1)))
typedef short bf16x8 __attribute__((ext_vector_type(8)));
typedef float f32x4 __attribute__((ext_vector_type(4)));
typedef unsigned u32x4 __attribute__((ext_vector_type(4)));
typedef unsigned u32x2 __attribute__((ext_vector_type(2)));
constexpr int NTHR = 512, NWAVE = 8;
constexpr int LDS_MISC = 147456;
constexpr int LDS_BYTES = LDS_MISC + 1024;

constexpr size_t WS_BAR = 64 * 1024;
constexpr size_t WS_KPE = 3 * MiB + 256 * 1024;
constexpr size_t W2_RSTD = 4 * MiB + 512 * 1024, W2_WSLOT = W2_RSTD + 80 * 1024, W2_EID = W2_WSLOT + 144 * 1024;
constexpr size_t W2_LIST = 5 * MiB;
constexpr size_t W2_WRF = 9 * MiB + 256 * 1024;
constexpr size_t W2_WQKV = 10 * MiB;
constexpr size_t W2_WO0 = W2_WQKV + 2560 * 1024;
constexpr size_t W2_WIN = W2_WO0 + 2048 * 1024;
constexpr size_t W2_WUQ = W2_WIN + 1024 * 1024;
constexpr size_t W2_WUKV = W2_WUQ + 768 * 1024;
constexpr size_t W2_WO1 = W2_WUKV + 512 * 1024;
constexpr size_t W2_HB = 20 * MiB;
constexpr size_t W2_RB = 53 * MiB;
constexpr size_t W2_RC = 134 * MiB;
static_assert(W2_EID + (size_t)MTOT * 8 <= W2_LIST && W2_LIST + (size_t)NE * CAP * 4 <= W2_WRF && W2_WO1 + 2 * MiB <= W2_HB && W2_HB + (size_t)MTOT * 2048 <= W2_RB, "fixed map");
constexpr size_t B_QKV = W2_RB, B_O0 = W2_RB + 41 * MiB, B_VT0 = W2_RB + 74 * MiB  , B_Y0 = W2_RB, B_CBUF = W2_RB, B_CQN = W2_RB + 33 * MiB, B_CKVN = W2_RB + 42 * MiB, B_O1 = W2_RB, B_W1 = W2_RB + 33 * MiB;
constexpr size_t C_W0 = W2_RC, C_HF = W2_RC + 48 * MiB, C_Q1 = W2_RC, C_K1 = W2_RC + 49 * MiB, C_V1 = W2_RC + 82 * MiB, C_HF1 = W2_RC, C_Y1 = W2_RC;
static_assert(C_V1 + (size_t)2 * 16 * 64 * LP * 2 <= WS_END && C_K1 + (size_t)2 * LP * 2048 <= C_V1 && B_VT0 + (size_t)2 * 2 * 64 * LP * 2 <= W2_RC && C_HF + (size_t)MTOT * 4096 <= WS_END && B_W1 + 48 * MiB <= W2_RC, "region map");
constexpr size_t MOE_WGU_BYTES = (size_t)NE * 512 * 1024 * 2, MOE_WD_BYTES = (size_t)NE * 1024 * 256 * 2;

struct MArgs { const float* in[23]; float* out; unsigned char* ws; int ph_lo, ph_hi, li, pad; };

__device__ __forceinline__ unsigned pk2(float lo, float hi) { return (unsigned)f2bf(lo) | ((unsigned)f2bf(hi) << 16); }

#define XB_TMO      128
#define XB_XCNT(j)  (256  + 64 * (j))
#define XB_XSUB(j)  (1280 + 64 * (j))
#define XB_XGEN(j)  (2304 + 64 * (j))
#define XB_TOP      3328
#define XB_TOPGEN   3392
#define XCD_BAR_WORDS 3456
#define XB_SPIN_CAP (1u << 18)
__device__ __forceinline__ unsigned xb_ld(unsigned* p)              { return __hip_atomic_load(p, __ATOMIC_RELAXED, __HIP_MEMORY_SCOPE_AGENT); }
__device__ __forceinline__ unsigned xb_add(unsigned* p, unsigned v) { return __hip_atomic_fetch_add(p, v, __ATOMIC_RELAXED, __HIP_MEMORY_SCOPE_AGENT); }
__device__ __forceinline__ unsigned xb_xcc_id() { return (unsigned)__builtin_amdgcn_s_getreg((3 << 11) | 20) & 0xFu; }
#define XB_SPIN(cond, bar) do { unsigned _sp = 0; while (cond) { __builtin_amdgcn_s_sleep(1); \
    if ((++_sp & 255u) == 0u) { if (xb_ld(&(bar)[XB_TMO])) break; if (_sp > XB_SPIN_CAP) { atomicAdd(&(bar)[XB_TMO], 1u); break; } } } } while (0)
struct XcdBarrier { unsigned* bar; unsigned x; volatile LAS unsigned* st; };
__device__ __forceinline__ XcdBarrier xcd_barrier_post(unsigned* bar, volatile LAS unsigned* st) {
    XcdBarrier b; b.bar = bar; b.x = xb_xcc_id(); b.st = st;
    if (threadIdx.x == 0) (void)xb_add(&bar[XB_XCNT(b.x)], 1u);
    return b;
}
__device__ __forceinline__ void xcd_barrier_complete(unsigned* bar, unsigned x, unsigned& nloc, unsigned& nx) {
    const unsigned G = gridDim.x * gridDim.y * gridDim.z;
    unsigned sum, cnt, mine, sp = 0u;
    for (;;) {
        sum = 0u; cnt = 0u; mine = 0u;
#pragma unroll
        for (unsigned j = 0; j < 16; ++j) { const unsigned c = xb_ld(&bar[XB_XCNT(j)]); sum += c; cnt += (c > 0u) ? 1u : 0u; mine = (j == x) ? c : mine; }
        if (sum == G) break;
        __builtin_amdgcn_s_sleep(1);
        if ((++sp & 255u) == 0u) { if (xb_ld(&bar[XB_TMO])) break; if (sp > XB_SPIN_CAP) { atomicAdd(&bar[XB_TMO], 1u); break; } }
    }
    nloc = mine > 0u ? mine : 1u; nx = cnt > 0u ? cnt : 1u;
}
__device__ __forceinline__ void xcd_barrier(const XcdBarrier& b) {
    asm volatile("s_waitcnt vmcnt(0)" ::: "memory");
    __syncthreads();
    if (threadIdx.x == 0) {
        unsigned* bar = b.bar;
        __builtin_amdgcn_s_waitcnt(0);
        unsigned nloc = b.st[0], nx = b.st[1];
        if (nloc == 0u) { xcd_barrier_complete(bar, b.x, nloc, nx); b.st[0] = nloc; b.st[1] = nx; }
        const unsigned old = xb_add(&bar[XB_XSUB(b.x)], 1u);
        const unsigned gen = old / nloc;
        if (old + 1u == (gen + 1u) * nloc) {
            __builtin_amdgcn_fence(__ATOMIC_RELEASE, "agent");
            asm volatile("s_waitcnt vmcnt(0)" ::: "memory");
            const unsigned og = xb_add(&bar[XB_TOP], 1u);
            const unsigned tg = og / nx;
            if (og + 1u == (tg + 1u) * nx) xb_add(&bar[XB_TOPGEN], 1u);
            else XB_SPIN(xb_ld(&bar[XB_TOPGEN]) == tg, bar);
            __builtin_amdgcn_fence(__ATOMIC_ACQUIRE, "agent");
            xb_add(&bar[XB_XGEN(b.x)], 1u);
            asm volatile("s_waitcnt vmcnt(0)" ::: "memory");
        } else {
            XB_SPIN(xb_ld(&bar[XB_XGEN(b.x)]) == gen, bar);
            __builtin_amdgcn_fence(__ATOMIC_ACQUIRE, "agent");
            asm volatile("s_waitcnt vmcnt(0)" ::: "memory");
        }
    }
    __syncthreads();
}

template <int MT, int NT, int WM, int WN, bool NSW, class RowA, class Epi>
__device__ __forceinline__ void gemm_tile(LAS unsigned char* lds, const RowA& rowA, const bf16_t* __restrict__ Bt, int ldb  , int nk, Epi& epi) {
    constexpr int BM = WM * MT * 16, BN = WN * NT * 16, GA = BM / 8, G = (BM + BN) / 8, NG = (G + 7) / 8, STAGE = (BM + BN) * 128;
    static_assert(WM * WN == 8 && 2 * STAGE <= LDS_MISC, "gemm_tile config");
    const int tid = threadIdx.x, lane = tid & 63, wave = __builtin_amdgcn_readfirstlane(tid >> 6), wm = wave / WN, wn = wave % WN;
    const char* src[NG];
    const int lc = (lane & 7) ^ (lane >> 3);
#pragma unroll
    for (int i = 0; i < NG; ++i) {
        const int g = wave + 8 * i;
        if (g < GA) src[i] = (const char*)rowA(g * 8 + (lane >> 3)) + lc * 16;
        else if (g < G) src[i] = (const char*)(Bt + (size_t)((g - GA) * 8 + (lane >> 3)) * ldb) + lc * 16;
        else src[i] = nullptr;
    }
    f32x4 acc[MT][NT];
#pragma unroll
    for (int mi = 0; mi < MT; ++mi)
#pragma unroll
        for (int ni = 0; ni < NT; ++ni) acc[mi][ni] = (f32x4){0.f, 0.f, 0.f, 0.f};
    const int fro = (lane & 15) * 128;
    const int fc0 = (((lane >> 4)) ^ (lane & 7)) << 4, fc1 = (((4 + (lane >> 4))) ^ (lane & 7)) << 4;
#define GT_STAGE(st, kt) do { _Pragma("unroll") for (int _i = 0; _i < NG; ++_i) { const int _g = wave + 8 * _i; if (_g < G) \
        __builtin_amdgcn_global_load_lds((const unsigned*)(src[_i] + (size_t)(kt) * 128), (LAS unsigned*)(lds + (st) * STAGE + _g * 1024), 16, 0, 0); } } while (0)
    GT_STAGE(0, 0);
    for (int kt = 0; kt < nk; ++kt) {
        asm volatile("s_waitcnt vmcnt(0)" ::: "memory");
        __syncthreads();
        if (kt + 1 < nk) GT_STAGE((kt + 1) & 1, kt + 1);
        LAS const unsigned char* sa = lds + (kt & 1) * STAGE + (wm * MT * 16) * 128 + fro;
        LAS const unsigned char* sb = lds + (kt & 1) * STAGE + (BM + wn * NT * 16) * 128 + fro;
#pragma unroll
        for (int ks = 0; ks < 2; ++ks) {
            const int fc = ks ? fc1 : fc0;
            bf16x8 af[MT], bfr[NT];
#pragma unroll
            for (int mi = 0; mi < MT; ++mi) af[mi] = *(LAS const bf16x8*)(sa + mi * 2048 + fc);
#pragma unroll
            for (int ni = 0; ni < NT; ++ni) bfr[ni] = *(LAS const bf16x8*)(sb + ni * 2048 + fc);
            if (NSW) {
#pragma unroll
                for (int mi = 0; mi < MT; ++mi)
#pragma unroll
                    for (int ni = 0; ni < NT; ++ni) acc[mi][ni] = __builtin_amdgcn_mfma_f32_16x16x32_bf16(af[mi], bfr[ni], acc[mi][ni], 0, 0, 0);
            } else {
#pragma unroll
                for (int mi = 0; mi < MT; ++mi)
#pragma unroll
                    for (int ni = 0; ni < NT; ++ni) acc[mi][ni] = __builtin_amdgcn_mfma_f32_16x16x32_bf16(bfr[ni], af[mi], acc[mi][ni], 0, 0, 0);
            }
        }
    }
#undef GT_STAGE
    epi(acc, wm * MT * 16, wn * NT * 16, lane);
    __syncthreads();
}

struct RowDense { const bf16_t* A; int lda, m0, mlast; __device__ __forceinline__ const bf16_t* operator()(int r) const { int row = m0 + r; row = row > mlast ? mlast : row; return A + (size_t)row * lda; } };

struct EpiQKV {
    const float* rstd; const float* bias; const float2* cs; bf16_t* qkv; int m0, n0;
    template <int MT, int NT> __device__ __forceinline__ void operator()(f32x4 (&acc)[MT][NT], int mb, int nb, int lane) const {
        static_assert(NT == 4, "rope needs a 64-column wave span");
        const int cb = n0 + nb, d0 = (lane >> 4) * 4;
#pragma unroll
        for (int mi = 0; mi < MT; ++mi) {
            const int row = m0 + mb + mi * 16 + (lane & 15);
            if (row < MTOT) {
                const float rs = rstd[row]; const int pos = row_pos(row);
                bf16_t* orow = qkv + (size_t)row * NQKV + cb;
                {
                    const float sc = cb < 1024 ? 0.125f : 1.0f;
#pragma unroll
                    for (int ni = 0; ni < 2; ++ni) {
                        const int d = ni * 16 + d0;
                        const f32x4 b1 = *(const f32x4*)(bias + cb + d), b2 = *(const f32x4*)(bias + cb + 32 + d);
                        float o1[4], o2[4];
#pragma unroll
                        for (int r = 0; r < 4; ++r) {
                            const float2 t = cs[pos * 32 + d + r];
                            const float x1 = acc[mi][ni][r] * rs + b1[r], x2 = acc[mi][ni + 2][r] * rs + b2[r];
                            o1[r] = (x1 * t.x - x2 * t.y) * sc; o2[r] = (x2 * t.x + x1 * t.y) * sc;
                        }
                        *(u32x2*)(orow + d) = (u32x2){pk2(o1[0], o1[1]), pk2(o1[2], o1[3])};
                        *(u32x2*)(orow + 32 + d) = (u32x2){pk2(o2[0], o2[1]), pk2(o2[2], o2[3])};
                    }
                }
            }
        }
    }
};
struct EpiV0 {
    const float* rstd; const float* bias; bf16_t* vt0; int m0, n0;
    template <int MT, int NT> __device__ __forceinline__ void operator()(f32x4 (&acc)[MT][NT], int mb, int nb, int lane) const {
        static_assert(NT == 4, "64-column wave span");
        const int cb = n0 + nb, kh = (cb - 1152) >> 6;
#pragma unroll
        for (int mi = 0; mi < MT; ++mi) {
            const int row0 = m0 + mb + mi * 16 + (lane >> 4) * 4;
            if (row0 < MTOT) {
                const f32x4 rs = *(const f32x4*)(rstd + row0); const int b = row_batch(row0), pp = perm16(row_pos(row0));
#pragma unroll
                for (int ni = 0; ni < NT; ++ni) { const int d = ni * 16 + (lane & 15); const float bb = bias[cb + d];
                    const f32x4 v = acc[mi][ni] * rs + bb;
                    *(u32x2*)(vt0 + (size_t)((b * 2 + kh) * 64 + d) * LP + pp) = (u32x2){pk2(v[0], v[1]), pk2(v[2], v[3])}; }
            }
        }
    }
};
struct EpiResF32 {
    const float* bias; const bf16_t* hb; float* hf; int m0, n0;
    template <int MT, int NT> __device__ __forceinline__ void operator()(f32x4 (&acc)[MT][NT], int mb, int nb, int lane) const {
#pragma unroll
        for (int mi = 0; mi < MT; ++mi) {
            const int row = m0 + mb + mi * 16 + (lane & 15);
            if (row < MTOT) {
#pragma unroll
                for (int ni = 0; ni < NT; ++ni) {
                    const int col = n0 + nb + ni * 16 + (lane >> 4) * 4;
                    const u32x2 h = *(const u32x2*)(hb + (size_t)row * D + col);
                    f32x4 v = acc[mi][ni];
                    if (bias) v += *(const f32x4*)(bias + col);
                    v[0] += __uint_as_float(h.x << 16); v[1] += __uint_as_float(h.x & 0xffff0000u); v[2] += __uint_as_float(h.y << 16); v[3] += __uint_as_float(h.y & 0xffff0000u);
                    *(f32x4*)(hf + (size_t)row * D + col) = v;
                }
            }
        }
    }
};

struct EpiWin {
    const float* rstd; float* cbuf; int m0, n0;
    template <int MT, int NT> __device__ __forceinline__ void operator()(f32x4 (&acc)[MT][NT], int mb, int nb, int lane) const {
#pragma unroll
        for (int mi = 0; mi < MT; ++mi) {
            const int row = m0 + mb + mi * 16 + (lane & 15);
            if (row < MTOT) { const float rs = rstd[row];
#pragma unroll
                for (int ni = 0; ni < NT; ++ni) *(f32x4*)(cbuf + (size_t)row * 512 + n0 + nb + ni * 16 + (lane >> 4) * 4) = acc[mi][ni] * rs; }
        }
    }
};
struct EpiUQ {
    const float2* cs; bf16_t* Q1; int m0, n0;
    template <int MT, int NT> __device__ __forceinline__ void operator()(f32x4 (&acc)[MT][NT], int mb, int nb, int lane) const {
        static_assert(NT == 4, "rope needs whole 32-column blocks per wave");
        const float scale = 0.10206207261596577f;
        const int d0 = (lane >> 4) * 4;
#pragma unroll
        for (int mi = 0; mi < MT; ++mi) {
            const int row = m0 + mb + mi * 16 + (lane & 15);
            if (row < MTOT) { const int pos = row_pos(row);
#pragma unroll
                for (int bi = 0; bi < 2; ++bi) {
                    const int gc = n0 + nb + bi * 32; bf16_t* orow = Q1 + (size_t)row * 1536 + gc;
                    f32x4 v1 = acc[mi][2 * bi], v2 = acc[mi][2 * bi + 1];
                    if (((gc >> 5) % 3) == 2) {
#pragma unroll
                        for (int r = 0; r < 4; ++r) { const float2 t = cs[pos * 32 + 2 * (d0 + r)]; const float x1 = v1[r], x2 = v2[r]; v1[r] = x1 * t.x - x2 * t.y; v2[r] = x2 * t.x + x1 * t.y; }
                    }
                    v1 = v1 * scale; v2 = v2 * scale;
                    *(u32x2*)(orow + d0) = (u32x2){pk2(v1[0], v1[1]), pk2(v1[2], v1[3])};
                    *(u32x2*)(orow + 16 + d0) = (u32x2){pk2(v2[0], v2[1]), pk2(v2[2], v2[3])};
                }
            }
        }
    }
};
struct EpiK1 {
    bf16_t* K1; int m0, n0;
    template <int MT, int NT> __device__ __forceinline__ void operator()(f32x4 (&acc)[MT][NT], int mb, int nb, int lane) const {
#pragma unroll
        for (int mi = 0; mi < MT; ++mi) {
            const int row = m0 + mb + mi * 16 + (lane & 15);
            if (row < MTOT) { const size_t kr = (size_t)row_batch(row) * LP + row_pos(row);
#pragma unroll
                for (int ni = 0; ni < NT; ++ni) { const f32x4 v = acc[mi][ni];
                    *(u32x2*)(K1 + kr * D + n0 + nb + ni * 16 + (lane >> 4) * 4) = (u32x2){pk2(v[0], v[1]), pk2(v[2], v[3])}; } }
        }
    }
};
struct EpiV1 {
    bf16_t* VT1; int m0, n0;
    template <int MT, int NT> __device__ __forceinline__ void operator()(f32x4 (&acc)[MT][NT], int mb, int nb, int lane) const {
#pragma unroll
        for (int mi = 0; mi < MT; ++mi) {
            const int row0 = m0 + mb + mi * 16 + (lane >> 4) * 4;
            if (row0 < MTOT) { const int b = row_batch(row0), pp = perm16(row_pos(row0));
#pragma unroll
                for (int ni = 0; ni < NT; ++ni) { const int hd = n0 - 1024 + nb + ni * 16 + (lane & 15); const f32x4 v = acc[mi][ni];
                    *(u32x2*)(VT1 + (size_t)(b * 1024 + hd) * LP + pp) = (u32x2){pk2(v[0], v[1]), pk2(v[2], v[3])}; } }
        }
    }
};

__device__ __forceinline__ void route_phase(LAS unsigned char* lds, const float* __restrict__ hf, const float* __restrict__ wrf, const float* __restrict__ bg, const float* __restrict__ br,
                                            bf16_t* hb, float* rstd_out, int* cnt, int* list, float* wslot, int bid, int nblk) {
    const int tid = threadIdx.x, lane = tid & 63, wave = __builtin_amdgcn_readfirstlane(tid >> 6);
    LAS f32x4* wl = (LAS f32x4*)lds;
    LAS int* nrec = (LAS int*)(lds + LDS_MISC + 16); LAS int* bcnt = (LAS int*)(lds + LDS_MISC + 32); LAS int* bbase = (LAS int*)(lds + LDS_MISC + 160); LAS int* rec = (LAS int*)(lds + LDS_MISC + 288);
    for (int i = tid; i < 36 * 256; i += NTHR) wl[i] = *(const f32x4*)(wrf + (size_t)i * 4);
    if (tid < NE) bcnt[tid] = 0;
    if (tid == 0) *nrec = 0;
    __syncthreads();
    for (int row = bid * NWAVE + wave; row < MTOT; row += nblk * NWAVE) {
        f32x4 x[4]; float ss = 0.f;
#pragma unroll
        for (int j = 0; j < 4; ++j) { x[j] = *(const f32x4*)(hf + (size_t)row * D + j * 256 + lane * 4); ss += x[j][0] * x[j][0] + x[j][1] * x[j][1] + x[j][2] * x[j][2] + x[j][3] * x[j][3];
            *(u32x2*)(hb + (size_t)row * D + j * 256 + lane * 4) = (u32x2){pk2(x[j][0], x[j][1]), pk2(x[j][2], x[j][3])}; }
        ss = wave_sum(ss);
        const float rs = rsqrtf(ss * (1.0f / D) + EPS);
        float lg[4];
#pragma unroll
        for (int c = 0; c < 4; ++c) { float p = 0.f;
#pragma unroll
            for (int j = 0; j < 4; ++j) { const f32x4 w = wl[c * 256 + j * 64 + lane]; p += x[j][0] * w[0] + x[j][1] * w[1] + x[j][2] * w[2] + x[j][3] * w[3]; }
            lg[c] = wave_sum(p) * rs + bg[c]; }
        int gi = 0; float gm = lg[0];
#pragma unroll
        for (int c = 1; c < 4; ++c) if (lg[c] > gm) { gm = lg[c]; gi = c; }
        float gs = 0.f;
#pragma unroll
        for (int c = 0; c < 4; ++c) gs += __expf(lg[c] - gm);
        const float gp = 1.0f / gs;
        gi = __builtin_amdgcn_readfirstlane(gi);
        float e[8];
#pragma unroll
        for (int c = 0; c < 8; ++c) { float p = 0.f;
#pragma unroll
            for (int j = 0; j < 4; ++j) { const f32x4 w = wl[(4 + gi * 8 + c) * 256 + j * 64 + lane]; p += x[j][0] * w[0] + x[j][1] * w[1] + x[j][2] * w[2] + x[j][3] * w[3]; }
            e[c] = wave_sum(p) * rs + br[gi * 8 + c]; }
        int i1 = 0; float v1 = e[0];
#pragma unroll
        for (int c = 1; c < 8; ++c) if (e[c] > v1) { v1 = e[c]; i1 = c; }
        int i2 = -1; float v2 = -3.0e38f;
#pragma unroll
        for (int c = 0; c < 8; ++c) if (c != i1 && e[c] > v2) { v2 = e[c]; i2 = c; }
        if (lane == 0) {
            const float r = __expf(v2 - v1);
            const float w1 = gp / (1.0f + r), w2 = gp * r / (1.0f + r);
            const int e1 = gi * 8 + i1, e2 = gi * 8 + i2;
            const int p1 = atomicAdd((int*)&bcnt[e1], 1), p2 = atomicAdd((int*)&bcnt[e2], 1);
            const int k = atomicAdd((int*)nrec, 2);
            rec[k] = ((row * 2) << 13) | (e1 << 8) | p1; rec[k + 1] = ((row * 2 + 1) << 13) | (e2 << 8) | p2;
            wslot[row * 2] = w1; wslot[row * 2 + 1] = w2; rstd_out[row] = rs;
        }
    }
    __syncthreads();
    if (tid < NE) { const int c = bcnt[tid]; bbase[tid] = c ? __hip_atomic_fetch_add(cnt + tid * 64, c, __ATOMIC_RELAXED, __HIP_MEMORY_SCOPE_AGENT) : 0; }
    __syncthreads();
    for (int k = tid; k < *nrec; k += NTHR) { const int r = rec[k], e = (r >> 8) & 31; list[(size_t)e * CAP + bbase[e] + (r & 255)] = r >> 13; }
    __syncthreads();
}
__device__ __forceinline__ void combine_phase(bf16_t* hb, const bf16_t* __restrict__ ybuf, float* rstd, int bid, int nblk) {
    const int tid = threadIdx.x, lane = tid & 63, wave = tid >> 6;
    for (int row = bid * NWAVE + wave; row < MTOT; row += nblk * NWAVE) {
        float ss = 0.f;
#pragma unroll
        for (int j = 0; j < 4; ++j) { const size_t c = j * 256 + lane * 4;
            const u32x2 h = *(const u32x2*)(hb + (size_t)row * D + c), y0 = *(const u32x2*)(ybuf + (size_t)(row * 2) * D + c), y1 = *(const u32x2*)(ybuf + (size_t)(row * 2 + 1) * D + c);
            float v[4];
            v[0] = __uint_as_float(h.x << 16) + __uint_as_float(y0.x << 16) + __uint_as_float(y1.x << 16);
            v[1] = __uint_as_float(h.x & 0xffff0000u) + __uint_as_float(y0.x & 0xffff0000u) + __uint_as_float(y1.x & 0xffff0000u);
            v[2] = __uint_as_float(h.y << 16) + __uint_as_float(y0.y << 16) + __uint_as_float(y1.y << 16);
            v[3] = __uint_as_float(h.y & 0xffff0000u) + __uint_as_float(y0.y & 0xffff0000u) + __uint_as_float(y1.y & 0xffff0000u);
            ss += v[0] * v[0] + v[1] * v[1] + v[2] * v[2] + v[3] * v[3];
            *(u32x2*)(hb + (size_t)row * D + c) = (u32x2){pk2(v[0], v[1]), pk2(v[2], v[3])}; }
        ss = wave_sum(ss); if (lane == 0) rstd[row] = rsqrtf(ss * (1.0f / D) + EPS);
    }
}
__device__ __forceinline__ void cepi_phase(const float* __restrict__ c, const float2* __restrict__ cs, bf16_t* cqn, bf16_t* ckvn, bf16_t* kpe, int bid, int nblk) {
    const int tid = threadIdx.x, lane = tid & 63, wave = tid >> 6;
    for (int row = bid * NWAVE + wave; row < MTOT; row += nblk * NWAVE) {
        const float* cr = c + (size_t)row * 512;
        const f32x4 q = *(const f32x4*)(cr + lane * 4);
        const float rq = rsqrtf(wave_sum(q[0] * q[0] + q[1] * q[1] + q[2] * q[2] + q[3] * q[3]) * (1.0f / 256) + EPS);
        *(u32x2*)(cqn + (size_t)row * 256 + lane * 4) = (u32x2){pk2(q[0] * rq, q[1] * rq), pk2(q[2] * rq, q[3] * rq)};
        const float k0 = cr[256 + lane], k1 = cr[320 + lane];
        const float rk = rsqrtf(wave_sum(k0 * k0 + k1 * k1) * (1.0f / 128) + EPS);
        ckvn[(size_t)row * 128 + lane] = f2bf(k0 * rk); ckvn[(size_t)row * 128 + 64 + lane] = f2bf(k1 * rk);
        if (lane < 32) { const int i = lane & 15; const float2 t = cs[row_pos(row) * 32 + 2 * i];
            const float x1 = cr[384 + i], x2 = cr[400 + i];
            kpe[((size_t)row_batch(row) * LP + row_pos(row)) * 32 + lane] = f2bf(lane < 16 ? x1 * t.x - x2 * t.y : x2 * t.x + x1 * t.y); }
    }
}
__device__ __forceinline__ void final_phase(const bf16_t* __restrict__ hb, const bf16_t* __restrict__ ybuf, const float* __restrict__ g, float* out, int bid, int nblk) {
    const int tid = threadIdx.x, lane = tid & 63, wave = tid >> 6;
    for (int row = bid * NWAVE + wave; row < MREAL; row += nblk * NWAVE) {
        f32x4 v[4]; float ss = 0.f;
#pragma unroll
        for (int j = 0; j < 4; ++j) { const size_t c = j * 256 + lane * 4;
            const u32x2 h = *(const u32x2*)(hb + (size_t)row * D + c), y0 = *(const u32x2*)(ybuf + (size_t)(row * 2) * D + c), y1 = *(const u32x2*)(ybuf + (size_t)(row * 2 + 1) * D + c);
            v[j][0] = __uint_as_float(h.x << 16) + __uint_as_float(y0.x << 16) + __uint_as_float(y1.x << 16);
            v[j][1] = __uint_as_float(h.x & 0xffff0000u) + __uint_as_float(y0.x & 0xffff0000u) + __uint_as_float(y1.x & 0xffff0000u);
            v[j][2] = __uint_as_float(h.y << 16) + __uint_as_float(y0.y << 16) + __uint_as_float(y1.y << 16);
            v[j][3] = __uint_as_float(h.y & 0xffff0000u) + __uint_as_float(y0.y & 0xffff0000u) + __uint_as_float(y1.y & 0xffff0000u);
            ss += v[j][0] * v[j][0] + v[j][1] * v[j][1] + v[j][2] * v[j][2] + v[j][3] * v[j][3]; }
        const float rs = rsqrtf(wave_sum(ss) * (1.0f / D) + EPS);
#pragma unroll
        for (int j = 0; j < 4; ++j) { const f32x4 gg = *(const f32x4*)(g + j * 256 + lane * 4); *(f32x4*)(out + (size_t)row * D + j * 256 + lane * 4) = v[j] * rs * gg; }
    }
}

typedef float f32x16 __attribute__((ext_vector_type(16)));
constexpr int AT_STAGE = 20480;
__device__ __forceinline__ unsigned cvtpk(float lo, float hi) { typedef float f2 __attribute__((ext_vector_type(2))); typedef __bf16 b2 __attribute__((ext_vector_type(2)));
    f2 v = {lo, hi}; b2 r = __builtin_convertvector(v, b2); return __builtin_bit_cast(unsigned, r); }
__device__ __forceinline__ void mla_unit(LAS unsigned char* lds, int b, int h, int qi, const bf16_t* __restrict__ Q1, const bf16_t* __restrict__ K1, const bf16_t* __restrict__ kpe,
                                         const bf16_t* __restrict__ VT1, bf16_t* o) {
    const int tid = threadIdx.x, lane = tid & 63, wave = __builtin_amdgcn_readfirstlane(tid >> 6), r32 = lane & 31, hi = lane >> 5;
    const float C2 = 1.4426950408889634f;
    const size_t qrow = (size_t)b * SEQ + 256 * qi + 32 * wave + r32;
    bf16x8 qf[6];
#pragma unroll
    for (int s = 0; s < 6; ++s) qf[s] = *(const bf16x8*)(Q1 + qrow * 1536 + h * 96 + 16 * s + 8 * hi);
    const int lr = 8 * wave + (lane >> 3);
    const char* ksrc = (const char*)(K1 + ((size_t)b * LP + lr) * 1024 + h * 64) + (((lane & 7) ^ ((lr >> 1) & 7)) << 4);
    const char* vsrc = (const char*)(VT1 + ((size_t)(b * 16 + h) * 64 + lr) * LP) + (((lane & 7) ^ ((lr >> 1) & 7)) << 4);
    const int pr = 16 * wave + (lane >> 2);
    const char* psrc = (const char*)(kpe + ((size_t)b * LP + (pr & 63)) * 32) + (((lane & 3) ^ ((pr >> 2) & 3)) << 4);
#define MLA_ISSUE(j, st) do { \
        __builtin_amdgcn_global_load_lds((const unsigned*)(ksrc + (size_t)(j) * (64 * 2048)), (LAS unsigned*)(lds + (st) * AT_STAGE + wave * 1024), 16, 0, 0); \
        __builtin_amdgcn_global_load_lds((const unsigned*)(vsrc + (size_t)(j) * 128), (LAS unsigned*)(lds + (st) * AT_STAGE + 8192 + wave * 1024), 16, 0, 0); \
        if (wave < 4) __builtin_amdgcn_global_load_lds((const unsigned*)(psrc + (size_t)(j) * (64 * 64)), (LAS unsigned*)(lds + (st) * AT_STAGE + 16384 + wave * 1024), 16, 0, 0); } while (0)
    const int NT = 4 * qi + 5, jmaxw = 4 * qi + ((32 * wave + 47) >> 6);
    const int qp = 16 + 256 * qi + 32 * wave + r32;
    const int koff = r32 * 128, ksw = (r32 >> 1) & 7, poff = 16384 + r32 * 64, psw = (r32 >> 2) & 3, voff = 8192 + r32 * 128;
    f32x16 oacc[2]; oacc[0] = (f32x16){}; oacc[1] = (f32x16){};
    float m = -1e30f, lsum = 0.f;
    MLA_ISSUE(0, 0);
    if (NT > 1) MLA_ISSUE(1, 1);
    int st = 0;
    for (int j = 0; j < NT; ++j) {
        if (j + 1 < NT) { if (wave < 4) asm volatile("s_waitcnt vmcnt(3)" ::: "memory"); else asm volatile("s_waitcnt vmcnt(2)" ::: "memory"); }
        else asm volatile("s_waitcnt vmcnt(0)" ::: "memory");
        __builtin_amdgcn_s_barrier(); asm volatile("" ::: "memory");
        if (j + 2 < NT) { const int st2 = st >= 1 ? st - 1 : 2; MLA_ISSUE(j + 2, st2); }
        if (j <= jmaxw) {
            LAS const unsigned char* sb = lds + st * AT_STAGE;
            f32x16 p0 = (f32x16){}, p1 = (f32x16){};
#pragma unroll
            for (int s = 0; s < 4; ++s) {
                const bf16x8 k0 = *(LAS const bf16x8*)(sb + koff + (((2 * s + hi) ^ ksw) << 4));
                const bf16x8 k1 = *(LAS const bf16x8*)(sb + 4096 + koff + (((2 * s + hi) ^ ksw) << 4));
                p0 = __builtin_amdgcn_mfma_f32_32x32x16_bf16(k0, qf[s], p0, 0, 0, 0);
                p1 = __builtin_amdgcn_mfma_f32_32x32x16_bf16(k1, qf[s], p1, 0, 0, 0);
            }
#pragma unroll
            for (int s = 0; s < 2; ++s) {
                const bf16x8 k0 = *(LAS const bf16x8*)(sb + poff + (((2 * s + hi) ^ psw) << 4));
                const bf16x8 k1 = *(LAS const bf16x8*)(sb + 2048 + poff + (((2 * s + hi) ^ psw) << 4));
                p0 = __builtin_amdgcn_mfma_f32_32x32x16_bf16(k0, qf[4 + s], p0, 0, 0, 0);
                p1 = __builtin_amdgcn_mfma_f32_32x32x16_bf16(k1, qf[4 + s], p1, 0, 0, 0);
            }
            if (j >= 4 * qi) {
                const int kb0 = 64 * j + 4 * hi;
#pragma unroll
                for (int r = 0; r < 16; ++r) { const int kp = kb0 + (r & 3) + 8 * (r >> 2); if (kp > qp) p0[r] = -1e30f; if (kp + 32 > qp) p1[r] = -1e30f; }
            }
            float tm = fmaxf(p0[0], p1[0]);
#pragma unroll
            for (int r = 1; r < 16; ++r) tm = fmaxf(tm, fmaxf(p0[r], p1[r]));
            tm = fmaxf(tm, __shfl_xor(tm, 32));
            const float mn = fmaxf(m, tm), alpha = __builtin_amdgcn_exp2f((m - mn) * C2), nmc = -mn * C2;
            m = mn;
            float ps = 0.f;
#pragma unroll
            for (int r = 0; r < 16; ++r) { p0[r] = __builtin_amdgcn_exp2f(__builtin_fmaf(p0[r], C2, nmc)); p1[r] = __builtin_amdgcn_exp2f(__builtin_fmaf(p1[r], C2, nmc)); ps += p0[r] + p1[r]; }
            lsum = lsum * alpha + ps;
#pragma unroll
            for (int r = 0; r < 16; ++r) { oacc[0][r] *= alpha; oacc[1][r] *= alpha; }
            u32x4 pf[4];
            pf[0] = (u32x4){cvtpk(p0[0], p0[1]), cvtpk(p0[2], p0[3]), cvtpk(p0[4], p0[5]), cvtpk(p0[6], p0[7])};
            pf[1] = (u32x4){cvtpk(p0[8], p0[9]), cvtpk(p0[10], p0[11]), cvtpk(p0[12], p0[13]), cvtpk(p0[14], p0[15])};
            pf[2] = (u32x4){cvtpk(p1[0], p1[1]), cvtpk(p1[2], p1[3]), cvtpk(p1[4], p1[5]), cvtpk(p1[6], p1[7])};
            pf[3] = (u32x4){cvtpk(p1[8], p1[9]), cvtpk(p1[10], p1[11]), cvtpk(p1[12], p1[13]), cvtpk(p1[14], p1[15])};
#pragma unroll
            for (int s = 0; s < 4; ++s) {
                const bf16x8 v0 = *(LAS const bf16x8*)(sb + voff + (((2 * s + hi) ^ ksw) << 4));
                const bf16x8 v1 = *(LAS const bf16x8*)(sb + 4096 + voff + (((2 * s + hi) ^ ksw) << 4));
                const bf16x8 pb = __builtin_bit_cast(bf16x8, pf[s]);
                oacc[0] = __builtin_amdgcn_mfma_f32_32x32x16_bf16(v0, pb, oacc[0], 0, 0, 0);
                oacc[1] = __builtin_amdgcn_mfma_f32_32x32x16_bf16(v1, pb, oacc[1], 0, 0, 0);
            }
        }
        st = st == 2 ? 0 : st + 1;
    }
#undef MLA_ISSUE
    lsum += __shfl_xor(lsum, 32);
    const float inv = 1.0f / lsum;
    bf16_t* orow = o + qrow * D + h * 64 + 4 * hi;
#pragma unroll
    for (int db = 0; db < 2; ++db)
#pragma unroll
        for (int g = 0; g < 4; ++g)
            *(u32x2*)(orow + 32 * db + 8 * g) = (u32x2){cvtpk(oacc[db][4 * g] * inv, oacc[db][4 * g + 1] * inv), cvtpk(oacc[db][4 * g + 2] * inv, oacc[db][4 * g + 3] * inv)};
    asm volatile("s_waitcnt lgkmcnt(0)" ::: "memory");
    __builtin_amdgcn_s_barrier(); asm volatile("" ::: "memory");
}
__device__ __forceinline__ void mla_meta(int b, int h, const bf16_t* __restrict__ Q1, const bf16_t* __restrict__ K1, const bf16_t* __restrict__ kpe, const bf16_t* __restrict__ VT1, bf16_t* o, int lane) {
    const int qi = lane & 15, part = lane >> 4; const size_t qrow = (size_t)MREAL + b * 16 + qi;
    float q[24];
#pragma unroll
    for (int d = 0; d < 24; ++d) q[d] = bf2f(Q1[qrow * 1536 + h * 96 + 24 * part + d]);
    float sc[16]; float mx = -1e30f;
#pragma unroll
    for (int j = 0; j < 16; ++j) {
        const size_t kr = (size_t)b * LP + j; float s = 0.f;
#pragma unroll
        for (int d = 0; d < 24; ++d) { const int dd = 24 * part + d; const float kv = dd < 64 ? bf2f(K1[kr * D + h * 64 + dd]) : bf2f(kpe[kr * 32 + dd - 64]); s += q[d] * kv; }
        s += __shfl_xor(s, 16); s += __shfl_xor(s, 32);
        sc[j] = j <= qi ? s : -1e30f; mx = fmaxf(mx, sc[j]);
    }
    float l = 0.f;
#pragma unroll
    for (int j = 0; j < 16; ++j) { sc[j] = __expf(sc[j] - mx); l += sc[j]; }
    const float inv = 1.0f / l;
#pragma unroll
    for (int dd = 0; dd < 16; ++dd) { const int d = 16 * part + dd; float acc = 0.f;
#pragma unroll
        for (int j = 0; j < 16; ++j) acc += sc[j] * bf2f(VT1[((size_t)(b * 16 + h) * 64 + d) * LP + perm16(j)]);
        o[qrow * D + h * 64 + d] = f2bf(acc * inv); }
}
__device__ __forceinline__ void mla_phase(LAS unsigned char* lds, const bf16_t* Q1, const bf16_t* K1, const bf16_t* kpe, const bf16_t* VT1, bf16_t* o, int bid, int nblk) {
    const int v = (nblk % 8 == 0) ? (bid % 8) * (nblk / 8) + bid / 8 : bid;
    for (int vv = v; vv < 256; vv += nblk) {
        const int bh = vv >> 3, s = vv & 7, b = bh >> 4, h = bh & 15;
#pragma unroll 1
        for (int i = 0; i < 4; ++i) { const int qi = (i == 0) ? s : (i == 1) ? 15 - s : (i == 2) ? 16 + s : 31 - s; mla_unit(lds, b, h, qi, Q1, K1, kpe, VT1, o); }
        if (s == 0 && threadIdx.x < 64) mla_meta(b, h, Q1, K1, kpe, VT1, o, threadIdx.x);
    }
}

constexpr int SW_K = 0, SW_V = 36864, SW_VP = 560;
__device__ __forceinline__ void swa_block32(LAS const unsigned char* lds, int rb, int gk0, int nks, int mode, int i_q, const bf16x8 (&qf)[4], float& m, float& lsum, f32x16 (&oacc)[2], int r32, int hi) {
    const float C2 = 1.4426950408889634f;
    const int ksw = (r32 >> 1) & 7;
    f32x16 p = (f32x16){};
#pragma unroll
    for (int s = 0; s < 4; ++s) { const bf16x8 k = *(LAS const bf16x8*)(lds + SW_K + (rb + r32) * 128 + (((2 * s + hi) ^ ksw) << 4)); p = __builtin_amdgcn_mfma_f32_32x32x16_bf16(k, qf[s], p, 0, 0, 0); }
    if (mode != 0) {
        const int jb = ((rb - 32) & 127) + 4 * hi;
#pragma unroll
        for (int r = 0; r < 16; ++r) { const int kk = (r & 3) + 8 * (r >> 2);
            const bool ok = mode == 1 ? (kk + 4 * hi < 16) : mode == 2 ? (jb + kk > i_q) : (jb + kk <= i_q);
            if (!ok) p[r] = -1e30f; }
    }
    float tm = p[0];
#pragma unroll
    for (int r = 1; r < 16; ++r) tm = fmaxf(tm, p[r]);
    tm = fmaxf(tm, __shfl_xor(tm, 32));
    const float mn = fmaxf(m, tm), alpha = __builtin_amdgcn_exp2f((m - mn) * C2), nmc = -mn * C2;
    m = mn;
    float ps = 0.f;
#pragma unroll
    for (int r = 0; r < 16; ++r) { p[r] = __builtin_amdgcn_exp2f(__builtin_fmaf(p[r], C2, nmc)); ps += p[r]; }
    lsum = lsum * alpha + ps;
#pragma unroll
    for (int r = 0; r < 16; ++r) { oacc[0][r] *= alpha; oacc[1][r] *= alpha; }
    u32x4 pf[2];
    pf[0] = (u32x4){cvtpk(p[0], p[1]), cvtpk(p[2], p[3]), cvtpk(p[4], p[5]), cvtpk(p[6], p[7])};
    pf[1] = (u32x4){cvtpk(p[8], p[9]), cvtpk(p[10], p[11]), cvtpk(p[12], p[13]), cvtpk(p[14], p[15])};
#pragma unroll
    for (int ks = 0; ks < 2; ++ks) if (ks < nks) {
        const bf16x8 v0 = *(LAS const bf16x8*)(lds + SW_V + r32 * SW_VP + (gk0 + ks) * 32 + hi * 16);
        const bf16x8 v1 = *(LAS const bf16x8*)(lds + SW_V + (32 + r32) * SW_VP + (gk0 + ks) * 32 + hi * 16);
        const bf16x8 pb = __builtin_bit_cast(bf16x8, pf[ks]);
        oacc[0] = __builtin_amdgcn_mfma_f32_32x32x16_bf16(v0, pb, oacc[0], 0, 0, 0);
        oacc[1] = __builtin_amdgcn_mfma_f32_32x32x16_bf16(v1, pb, oacc[1], 0, 0, 0);
    }
}
__device__ __forceinline__ void swa_unit(LAS unsigned char* lds, int b, int n, int kh, const bf16_t* __restrict__ qkv, const bf16_t* __restrict__ VT0, const float* __restrict__ sinks, bf16_t* o) {
    const int tid = threadIdx.x, lane = tid & 63, wave = __builtin_amdgcn_readfirstlane(tid >> 6), r32 = lane & 31, hi = lane >> 5;
    for (int idx = tid; idx < 2176; idx += NTHR) {
        const int row = idx >> 3, c = idx & 7;
        if (row < 16 || n > 0 || row >= 144) {
            const size_t srow = row < 16 ? (size_t)MREAL + b * 16 + row : (size_t)b * SEQ + 128 * (n - 1) + (row - 16);
            const int lrow = row < 16 ? row : 16 + row;
            const u32x4 v = *(const u32x4*)(qkv + srow * NQKV + 1024 + kh * 64 + c * 8);
            *(LAS u32x4*)(lds + SW_K + lrow * 128 + ((c ^ ((lrow >> 1) & 7)) << 4)) = v;
        }
    }
    for (int idx = tid; idx < 2176; idx += NTHR) {
        const int d = idx / 34, c = idx % 34;
        if (c < 2 || n > 0 || c >= 18) {
            const bf16_t* src = VT0 + (size_t)((b * 2 + kh) * 64 + d) * LP + (c < 2 ? c * 8 : 16 + 128 * (n - 1) + (c - 2) * 8);
            *(LAS u32x4*)(lds + SW_V + d * SW_VP + c * 16) = *(const u32x4*)src;
        }
    }
    __syncthreads();
    const int hq = kh * 8 + wave;
    const float sink = sinks[hq];
#pragma unroll 1
    for (int qs = 0; qs < 4; ++qs) {
        const size_t qrow = (size_t)b * SEQ + 128 * n + 32 * qs + r32;
        bf16x8 qf[4];
#pragma unroll
        for (int s = 0; s < 4; ++s) qf[s] = *(const bf16x8*)(qkv + qrow * NQKV + hq * 64 + 16 * s + 8 * hi);
        f32x16 oacc[2]; oacc[0] = (f32x16){}; oacc[1] = (f32x16){};
        float m = sink, lsum = hi == 0 ? 1.0f : 0.0f;
        const int i_q = 32 * qs + r32;
        swa_block32(lds, 0, 0, 1, 1, i_q, qf, m, lsum, oacc, r32, hi);
        if (n > 0) {
            swa_block32(lds, 32 + 32 * qs, 1 + 2 * qs, 2, 2, i_q, qf, m, lsum, oacc, r32, hi);
#pragma unroll 1
            for (int kb = qs + 1; kb < 4; ++kb) swa_block32(lds, 32 + 32 * kb, 1 + 2 * kb, 2, 0, i_q, qf, m, lsum, oacc, r32, hi);
        }
#pragma unroll 1
        for (int kb = 0; kb < qs; ++kb) swa_block32(lds, 160 + 32 * kb, 9 + 2 * kb, 2, 0, i_q, qf, m, lsum, oacc, r32, hi);
        swa_block32(lds, 160 + 32 * qs, 9 + 2 * qs, 2, 3, i_q, qf, m, lsum, oacc, r32, hi);
        lsum += __shfl_xor(lsum, 32);
        const float inv = 1.0f / lsum;
        bf16_t* orow = o + qrow * D + hq * 64 + 4 * hi;
#pragma unroll
        for (int db = 0; db < 2; ++db)
#pragma unroll
            for (int g = 0; g < 4; ++g)
                *(u32x2*)(orow + 32 * db + 8 * g) = (u32x2){cvtpk(oacc[db][4 * g] * inv, oacc[db][4 * g + 1] * inv), cvtpk(oacc[db][4 * g + 2] * inv, oacc[db][4 * g + 3] * inv)};
    }
    __syncthreads();
}
__device__ __forceinline__ void swa_meta(int b, int hq, const bf16_t* __restrict__ qkv, const bf16_t* __restrict__ VT0, const float* __restrict__ sinks, bf16_t* o, int lane) {
    const int qi = lane & 15, part = lane >> 4, kh = hq >> 3; const size_t qrow = (size_t)MREAL + b * 16 + qi;
    float q[16];
#pragma unroll
    for (int d = 0; d < 16; ++d) q[d] = bf2f(qkv[qrow * NQKV + hq * 64 + 16 * part + d]);
    const float sink = sinks[hq];
    float sc[16]; float mx = sink;
#pragma unroll
    for (int j = 0; j < 16; ++j) {
        const size_t kr = (size_t)MREAL + b * 16 + j; float s = 0.f;
#pragma unroll
        for (int d = 0; d < 16; ++d) s += q[d] * bf2f(qkv[kr * NQKV + 1024 + kh * 64 + 16 * part + d]);
        s += __shfl_xor(s, 16); s += __shfl_xor(s, 32);
        sc[j] = j <= qi ? s : -1e30f; mx = fmaxf(mx, sc[j]);
    }
    float l = __expf(sink - mx);
#pragma unroll
    for (int j = 0; j < 16; ++j) { sc[j] = __expf(sc[j] - mx); l += sc[j]; }
    const float inv = 1.0f / l;
#pragma unroll
    for (int dd = 0; dd < 16; ++dd) { const int d = 16 * part + dd; float acc = 0.f;
#pragma unroll
        for (int j = 0; j < 16; ++j) acc += sc[j] * bf2f(VT0[((size_t)(b * 2 + kh) * 64 + d) * LP + perm16(j)]);
        o[qrow * D + hq * 64 + d] = f2bf(acc * inv); }
}
__device__ __forceinline__ void swa_phase(LAS unsigned char* lds, const bf16_t* qkv, const bf16_t* VT0, const float* sinks, bf16_t* o, int bid, int nblk) {
    for (int u = bid; u < 256; u += nblk) {
        const int b = u >> 7, n = (u >> 1) & 63, kh = u & 1;
        swa_unit(lds, b, n, kh, qkv, VT0, sinks, o);
        if (n == 0) swa_meta(b, kh * 8 + (threadIdx.x >> 6), qkv, VT0, sinks, o, threadIdx.x & 63);
    }
}

constexpr int MOE_ST1 = (64 + 512) * 128;
constexpr int MOE_H = 0, MOE_B2 = 32768, MOE_ST2 = 32768;
static_assert(2 * MOE_ST1 <= LDS_MISC, "moe lds");
__device__ __forceinline__ void moe_unit(LAS unsigned char* lds, int e, int s0, int ns, const int* __restrict__ list, const bf16_t* __restrict__ hb, const float* __restrict__ rstd,
                                         const float* __restrict__ wslot, const bf16_t* __restrict__ wgu, const bf16_t* __restrict__ wd, bf16_t* ybuf) {
    const int tid = threadIdx.x, lane = tid & 63, wave = __builtin_amdgcn_readfirstlane(tid >> 6);
    LAS int* slotl = (LAS int*)(lds + LDS_MISC + 256);
    if (tid < 64) slotl[tid] = list[(size_t)e * CAP + s0 + (tid < ns ? tid : 0)];
    __syncthreads();
    const int lc = (lane & 7) ^ (lane >> 3);
    const int fro = (lane & 15) * 128, fc0 = ((lane >> 4) ^ (lane & 7)) << 4, fc1 = ((4 + (lane >> 4)) ^ (lane & 7)) << 4;
    int myslot[4]; float myrs[4];
#pragma unroll
    for (int mi = 0; mi < 4; ++mi) { myslot[mi] = slotl[mi * 16 + (lane & 15)]; myrs[mi] = rstd[myslot[mi] >> 1]; }
    {
        const char* src[9];
#pragma unroll
        for (int i = 0; i < 9; ++i) { const int g = wave + 8 * i;
            if (g < 8) src[i] = (const char*)(hb + (size_t)(slotl[g * 8 + (lane >> 3)] >> 1) * D) + lc * 16;
            else src[i] = (const char*)(wgu + (size_t)((g - 8) * 8 + (lane >> 3)) * D) + lc * 16; }
        f32x4 acc[4][4];
#pragma unroll
        for (int mi = 0; mi < 4; ++mi)
#pragma unroll
            for (int ni = 0; ni < 4; ++ni) acc[mi][ni] = (f32x4){0.f, 0.f, 0.f, 0.f};
#define M1_STAGE(st, kt) do { _Pragma("unroll") for (int _i = 0; _i < 9; ++_i) \
        __builtin_amdgcn_global_load_lds((const unsigned*)(src[_i] + (size_t)(kt) * 128), (LAS unsigned*)(lds + (st) * MOE_ST1 + (wave + 8 * _i) * 1024), 16, 0, 0); } while (0)
        M1_STAGE(0, 0);
        for (int kt = 0; kt < 16; ++kt) {
            asm volatile("s_waitcnt vmcnt(0)" ::: "memory");
            __syncthreads();
            if (kt + 1 < 16) M1_STAGE((kt + 1) & 1, kt + 1);
            LAS const unsigned char* sa = lds + (kt & 1) * MOE_ST1 + fro;
            LAS const unsigned char* sb = lds + (kt & 1) * MOE_ST1 + (64 + wave * 64) * 128 + fro;
#pragma unroll
            for (int ks = 0; ks < 2; ++ks) { const int fc = ks ? fc1 : fc0;
                bf16x8 af[4], bfr[4];
#pragma unroll
                for (int mi = 0; mi < 4; ++mi) af[mi] = *(LAS const bf16x8*)(sa + mi * 2048 + fc);
#pragma unroll
                for (int ni = 0; ni < 4; ++ni) bfr[ni] = *(LAS const bf16x8*)(sb + ni * 2048 + fc);
#pragma unroll
                for (int mi = 0; mi < 4; ++mi)
#pragma unroll
                    for (int ni = 0; ni < 4; ++ni) acc[mi][ni] = __builtin_amdgcn_mfma_f32_16x16x32_bf16(bfr[ni], af[mi], acc[mi][ni], 0, 0, 0);
            }
        }
#undef M1_STAGE
#pragma unroll
        for (int mi = 0; mi < 4; ++mi) { const int row = mi * 16 + (lane & 15); const float rs = myrs[mi];
#pragma unroll
            for (int ni = 0; ni < 2; ++ni) { float hv[4];
#pragma unroll
                for (int r = 0; r < 4; ++r) { const float g = acc[mi][ni][r] * rs, u = acc[mi][ni + 2][r] * rs; hv[r] = g / (1.0f + __expf(-g)) * u; }
                const int n = 32 * wave + ni * 16 + (lane >> 4) * 4;
                *(LAS u32x2*)(lds + MOE_H + (n >> 6) * 8192 + row * 128 + ((((n & 63) >> 3) ^ (row & 7)) << 4) + (n & 4) * 2) = (u32x2){pk2(hv[0], hv[1]), pk2(hv[2], hv[3])}; }
        }
    }
    __syncthreads();
    {
        const char* src2[4];
#pragma unroll
        for (int i = 0; i < 4; ++i) src2[i] = (const char*)(wd + (size_t)((wave + 8 * i) * 8 + (lane >> 3)) * DE) + lc * 16;
        float myw[4];
#pragma unroll
        for (int mi = 0; mi < 4; ++mi) myw[mi] = wslot[myslot[mi]];
        f32x4 acc[4][2];
#pragma unroll
        for (int mi = 0; mi < 4; ++mi) { acc[mi][0] = (f32x4){0.f, 0.f, 0.f, 0.f}; acc[mi][1] = (f32x4){0.f, 0.f, 0.f, 0.f}; }
#define M2_STAGE(st, q) do { _Pragma("unroll") for (int _i = 0; _i < 4; ++_i) \
        __builtin_amdgcn_global_load_lds((const unsigned*)(src2[_i] + (size_t)((q) >> 2) * (256 * 512) + (size_t)((q) & 3) * 128), (LAS unsigned*)(lds + MOE_B2 + (st) * MOE_ST2 + (wave + 8 * _i) * 1024), 16, 0, 0); } while (0)
        M2_STAGE(0, 0);
        for (int q = 0; q < 16; ++q) {
            asm volatile("s_waitcnt vmcnt(0)" ::: "memory");
            __syncthreads();
            if (q + 1 < 16) M2_STAGE((q + 1) & 1, q + 1);
            LAS const unsigned char* sa = lds + MOE_H + (q & 3) * 8192 + fro;
            LAS const unsigned char* sb = lds + MOE_B2 + (q & 1) * MOE_ST2 + (wave * 32) * 128 + fro;
#pragma unroll
            for (int ks = 0; ks < 2; ++ks) { const int fc = ks ? fc1 : fc0;
                bf16x8 af[4], bfr[2];
#pragma unroll
                for (int mi = 0; mi < 4; ++mi) af[mi] = *(LAS const bf16x8*)(sa + mi * 2048 + fc);
#pragma unroll
                for (int ni = 0; ni < 2; ++ni) bfr[ni] = *(LAS const bf16x8*)(sb + ni * 2048 + fc);
#pragma unroll
                for (int mi = 0; mi < 4; ++mi)
#pragma unroll
                    for (int ni = 0; ni < 2; ++ni) acc[mi][ni] = __builtin_amdgcn_mfma_f32_16x16x32_bf16(bfr[ni], af[mi], acc[mi][ni], 0, 0, 0);
            }
            if ((q & 3) == 3) {
                const int cb = (q >> 2) * 256 + wave * 32 + (lane >> 4) * 4;
#pragma unroll
                for (int mi = 0; mi < 4; ++mi) { const int row = mi * 16 + (lane & 15);
                    if (row < ns) {
#pragma unroll
                        for (int ni = 0; ni < 2; ++ni) { const f32x4 v = acc[mi][ni] * myw[mi];
                            *(u32x2*)(ybuf + (size_t)myslot[mi] * D + cb + ni * 16) = (u32x2){pk2(v[0], v[1]), pk2(v[2], v[3])}; } }
                    acc[mi][0] = (f32x4){0.f, 0.f, 0.f, 0.f}; acc[mi][1] = (f32x4){0.f, 0.f, 0.f, 0.f}; }
            }
        }
#undef M2_STAGE
    }
    __syncthreads();
}
__device__ __forceinline__ void moe_phase(LAS unsigned char* lds, int* cnt, const int* list, const bf16_t* hb, const float* rstd, const float* wslot, const bf16_t* wgu, const bf16_t* wd, bf16_t* ybuf, int bid, int nblk) {
    int u = bid, base = 0;
    for (int e = 0; e < NE; ++e) {
        const int c = __hip_atomic_load(cnt + e * 64, __ATOMIC_RELAXED, __HIP_MEMORY_SCOPE_AGENT);
        const int nt = (c + 63) >> 6;
        while (u < base + nt) { const int t = u - base; const int ns = c - t * 64 < 64 ? c - t * 64 : 64;
            moe_unit(lds, e, t * 64, ns, list, hb, rstd, wslot, wgu + (size_t)e * 512 * 1024, wd + (size_t)e * 1024 * 256, ybuf);
            u += nblk; }
        base += nt;
    }
}

__device__ __forceinline__ void transpose_item(const float* __restrict__ W, int N, const float* __restrict__ gain, bf16_t* dst, int ldk, int drow0, int k0, int n0, LAS float* scr, int lane) {
#pragma unroll 8
    for (int i = 0; i < 32; ++i) { const int kk = 2 * i + (lane >> 5); float v = W[(size_t)(k0 + kk) * N + n0 + (lane & 31)]; if (gain) v *= gain[k0 + kk]; scr[kk * 33 + (lane & 31)] = v; }
    asm volatile("s_waitcnt lgkmcnt(0)" ::: "memory");
    const int c = lane & 7;
#pragma unroll
    for (int j = 0; j < 4; ++j) { const int n = (lane >> 3) + 8 * j; const LAS float* s = scr + (8 * c) * 33 + n;
        u32x4 o; o.x = pk2(s[0 * 33], s[1 * 33]); o.y = pk2(s[2 * 33], s[3 * 33]); o.z = pk2(s[4 * 33], s[5 * 33]); o.w = pk2(s[6 * 33], s[7 * 33]);
        *(u32x4*)(dst + (size_t)(drow0 + n) * ldk + k0 + 8 * c) = o; }
    asm volatile("s_waitcnt lgkmcnt(0)" ::: "memory");
}
__device__ __forceinline__ void moe_weight_items(const float* wgate, const float* wup, const float* wdown, const float* gain, bf16_t* wgu_t, bf16_t* wd_t, LAS float* scr, int gw, int ngw, int lane) {
    for (int it = gw; it < NE * 384; it += ngw) {
        const int e = it / 384, r = it % 384, which = r >> 7, q = r & 127;
        if (which < 2) { const int kb = q >> 3, nb = q & 7;
            transpose_item((which ? wup : wgate) + (size_t)e * D * DE, DE, gain, wgu_t + (size_t)e * 512 * 1024, 1024, nb * 64 + which * 32, kb * 64, nb * 32, scr, lane);
        } else { const int kb = q >> 5, nb = q & 31;
            transpose_item(wdown + (size_t)e * DE * D, D, nullptr, wd_t + (size_t)e * 1024 * 256, 256, nb * 32, kb * 64, nb * 32, scr, lane);
        }
    }
}
__device__ __forceinline__ void p0_prologue(const MArgs& a, LAS unsigned char* lds, int bid, int nblk) {
    const int tid = threadIdx.x, lane = tid & 63, wave = __builtin_amdgcn_readfirstlane(tid >> 6);
    const int gw = bid * NWAVE + wave, ngw = nblk * NWAVE, gt = bid * NTHR + tid, ngt = nblk * NTHR;
    unsigned char* ws = a.ws;
    float2* cs = (float2*)(ws + WS_ROPE);
    for (int idx = gt; idx < LPOS * 32; idx += ngt) { const int pos = idx >> 5, i = idx & 31; const float inv = 1.0f / powf(10000.0f, (float)(2 * i) / 64.0f); float s, c; sincosf((float)pos * inv, &s, &c); cs[idx] = make_float2(c, s); }
    float* wrf = (float*)(ws + W2_WRF);
    for (int idx = gt; idx < 2 * 36 * 1024; idx += ngt) { const int l = idx / (36 * 1024), j = (idx >> 10) % 36, k = idx & 1023;
        const float g = a.in[3][l * D + k]; wrf[idx] = g * (j < 4 ? a.in[16][(size_t)l * D * 4 + k * 4 + j] : a.in[18][(size_t)l * D * 32 + k * 32 + (j - 4)]); }
    { u32x4* z = (u32x4*)(ws + W2_WIN + (size_t)416 * 1024 * 2); for (int idx = gt; idx < 96 * 1024 * 2 / 16; idx += ngt) z[idx] = (u32x4){0u, 0u, 0u, 0u}; }
    { bf16_t* kpe = (bf16_t*)(ws + WS_KPE); for (int idx = gt; idx < 2 * 48 * 32; idx += ngt) { const int b = idx / (48 * 32), r = idx % (48 * 32); kpe[((size_t)b * LP + 8208) * 32 + r] = 0; }
      bf16_t* vt0 = (bf16_t*)(ws + B_VT0); for (int idx = gt; idx < 2 * 2 * 64 * 48; idx += ngt) { const int rr = idx / 48, c = idx % 48; vt0[(size_t)rr * LP + 8208 + c] = 0; } }
    { bf16_t* hb = (bf16_t*)(ws + W2_HB); float* rstd = (float*)(ws + W2_RSTD);
      for (int row = gw; row < MTOT; row += ngw) {
        const float* src = row < MREAL ? a.in[0] + (size_t)row * D : a.in[1] + (size_t)row_pos(row) * D;
        float ss = 0.f;
#pragma unroll
        for (int j = 0; j < 4; ++j) { const f32x4 v = *(const f32x4*)(src + j * 256 + lane * 4); ss += v[0] * v[0] + v[1] * v[1] + v[2] * v[2] + v[3] * v[3];
            *(u32x2*)(hb + (size_t)row * D + j * 256 + lane * 4) = (u32x2){pk2(v[0], v[1]), pk2(v[2], v[3])}; }
        ss = wave_sum(ss); if (lane == 0) rstd[row] = rsqrtf(ss * (1.0f / D) + EPS);
      } }
    LAS float* scr = (LAS float*)(lds + wave * 16384);
    for (int it = gw; it < 2192; it += ngw) {
        int r = it;
        if (r < 640) { transpose_item(a.in[5], NQKV, a.in[2], (bf16_t*)(ws + W2_WQKV), 1024, (r % 40) * 32, (r / 40) * 64, (r % 40) * 32, scr, lane); continue; } r -= 640;
        if (r < 512) { transpose_item(a.in[8], D, nullptr, (bf16_t*)(ws + W2_WO0), 1024, (r & 31) * 32, (r >> 5) * 64, (r & 31) * 32, scr, lane); continue; } r -= 512;
        if (r < 208) { transpose_item(a.in[10], 416, a.in[2] + D, (bf16_t*)(ws + W2_WIN), 1024, (r % 13) * 32, (r / 13) * 64, (r % 13) * 32, scr, lane); continue; } r -= 208;
        if (r < 192) { transpose_item(a.in[13], 1536, a.in[11], (bf16_t*)(ws + W2_WUQ), 256, (r % 48) * 32, (r / 48) * 64, (r % 48) * 32, scr, lane); continue; } r -= 192;
        if (r < 128) { const int nb32 = r & 63, hh = nb32 >> 2, part = nb32 & 3;
            transpose_item(a.in[14], 2048, a.in[12], (bf16_t*)(ws + W2_WUKV), 128, part < 2 ? hh * 64 + part * 32 : 1024 + hh * 64 + (part - 2) * 32, (r >> 6) * 64, nb32 * 32, scr, lane); continue; } r -= 128;
        transpose_item(a.in[15], D, nullptr, (bf16_t*)(ws + W2_WO1), 1024, (r & 31) * 32, (r >> 5) * 64, (r & 31) * 32, scr, lane);
    }
    moe_weight_items(a.in[20], a.in[21], a.in[22], a.in[3], (bf16_t*)(ws + C_W0), (bf16_t*)(ws + C_W0 + MOE_WGU_BYTES), scr, gw, ngw, lane);
}

template <bool NSW, class MakeEpi>
__device__ __forceinline__ void gemm_phase(LAS unsigned char* lds, const bf16_t* A, int lda, const bf16_t* Bt, int K, int pn0, int pn1, int bid, int nblk, const MakeEpi& mk) {
    const int ntn = pn1 - pn0, nbig = 64 * ntn, ntot = nbig + ntn;
    for (int u = bid; u < ntot; u += nblk) {
        if (u < nbig) { const int pm = u / ntn, pn = pn0 + u % ntn;
            RowDense ra{A, lda, pm * 256, MTOT - 1}; auto e = mk(pm * 256, pn * 256);
            gemm_tile<8, 4, 2, 4, NSW>(lds, ra, Bt + (size_t)pn * 256 * K, K, K / 64, e);
        } else { const int pn = pn0 + u - nbig;
            RowDense ra{A, lda, MREAL, MTOT - 1}; auto e = mk(MREAL, pn * 256);
            gemm_tile<1, 4, 2, 4, NSW>(lds, ra, Bt + (size_t)pn * 256 * K, K, K / 64, e);
        }
    }
}

constexpr int PH_PROLOGUE = 0, PH_QKV = 1, PH_SWA = 2, PH_OPROJ0 = 3, PH_ROUTE0 = 4, PH_MOE0 = 5, PH_COMBINE = 6, PH_WIN = 7, PH_CEPI = 8, PH_UQKV = 9, PH_MLA = 10, PH_OPROJ1 = 11, PH_ROUTE1 = 12, PH_MOE1 = 13, PH_FINAL = 14, PH_N = 15;
__global__ void __launch_bounds__(NTHR, 2) mega(MArgs a) {
    extern __shared__ __attribute__((aligned(16))) unsigned char lds_raw[];
    LAS unsigned char* lds = (LAS unsigned char*)lds_raw;
    const int tid = threadIdx.x, bid = blockIdx.x, nblk = gridDim.x;
    volatile LAS unsigned* misc = (volatile LAS unsigned*)(lds + LDS_MISC);
    if (tid < 64) misc[tid] = 0u;
    __syncthreads();
    unsigned char* ws = a.ws;
    XcdBarrier bar = xcd_barrier_post((unsigned*)(ws + WS_BAR) + a.li * XCD_BAR_WORDS, misc);
    const int lo = a.ph_lo, hi = a.ph_hi;
#ifndef PROBE_PHASE
#define PROBE_PHASE -1
#endif
#define IN(k) (lo <= (k) && (k) < hi)
#define REP(k) for (int _rep = 0; _rep < ((k) == PROBE_PHASE ? 2 : 1); ++_rep, (void)((k) == PROBE_PHASE && _rep == 1 ? (xcd_barrier(bar), 0) : 0))
#define SEAM(k) do { if (IN(k) && IN((k) + 1)) xcd_barrier(bar); } while (0)
    if (PROBE_PHASE == 200) { for (int i = 0; i < 10; ++i) xcd_barrier(bar); }
    if (IN(PH_PROLOGUE)) REP(PH_PROLOGUE) p0_prologue(a, lds, bid, nblk);
    SEAM(PH_PROLOGUE);
    if (IN(PH_QKV)) REP(PH_QKV) {
        const float* rstd = (const float*)(ws + W2_RSTD); const float* bias = a.in[6]; const float2* cs = (const float2*)(ws + WS_ROPE); bf16_t* qkv = (bf16_t*)(ws + B_QKV); bf16_t* vt0 = (bf16_t*)(ws + B_VT0);
        const bf16_t* hbA = (const bf16_t*)(ws + W2_HB); const bf16_t* Wt = (const bf16_t*)(ws + W2_WQKV);
        for (int u = bid; u < 390; u += nblk) {
            if (u < 256) { const int pm = u >> 2, pn = u & 3; RowDense ra{hbA, D, pm * 256, MTOT - 1}; EpiQKV e{rstd, bias, cs, qkv, pm * 256, pn * 256};
                gemm_tile<8, 4, 2, 4, false>(lds, ra, Wt + (size_t)pn * 256 * D, D, D / 64, e);
            } else if (u < 320) { const int pm = u - 256; RowDense ra{hbA, D, pm * 256, MTOT - 1}; EpiQKV e{rstd, bias, cs, qkv, pm * 256, 1024};
                gemm_tile<4, 4, 4, 2, false>(lds, ra, Wt + (size_t)1024 * D, D, D / 64, e);
            } else if (u < 384) { const int pm = u - 320; RowDense ra{hbA, D, pm * 256, MTOT - 1}; EpiV0 e{rstd, bias, vt0, pm * 256, 1152};
                gemm_tile<4, 4, 4, 2, true>(lds, ra, Wt + (size_t)1152 * D, D, D / 64, e);
            } else if (u < 388) { const int pn = u - 384; RowDense ra{hbA, D, MREAL, MTOT - 1}; EpiQKV e{rstd, bias, cs, qkv, MREAL, pn * 256};
                gemm_tile<1, 4, 2, 4, false>(lds, ra, Wt + (size_t)pn * 256 * D, D, D / 64, e);
            } else if (u == 388) { RowDense ra{hbA, D, MREAL, MTOT - 1}; EpiQKV e{rstd, bias, cs, qkv, MREAL, 1024};
                gemm_tile<1, 4, 4, 2, false>(lds, ra, Wt + (size_t)1024 * D, D, D / 64, e);
            } else { RowDense ra{hbA, D, MREAL, MTOT - 1}; EpiV0 e{rstd, bias, vt0, MREAL, 1152};
                gemm_tile<1, 4, 4, 2, true>(lds, ra, Wt + (size_t)1152 * D, D, D / 64, e);
            }
        }
    }
    SEAM(PH_QKV);
    if (IN(PH_SWA)) REP(PH_SWA) swa_phase(lds, (const bf16_t*)(ws + B_QKV), (const bf16_t*)(ws + B_VT0), a.in[7], (bf16_t*)(ws + B_O0), bid, nblk);
    SEAM(PH_SWA);
    if (IN(PH_OPROJ0)) REP(PH_OPROJ0) {
        const float* bias = a.in[9]; const bf16_t* hb = (const bf16_t*)(ws + W2_HB); float* hf = (float*)(ws + C_HF);
        gemm_phase<false>(lds, (const bf16_t*)(ws + B_O0), D, (const bf16_t*)(ws + W2_WO0), D, 0, 4, bid, nblk, [=](int m0, int n0) { return EpiResF32{bias, hb, hf, m0, n0}; });
    }
    SEAM(PH_OPROJ0);
    if (IN(PH_ROUTE0) && PROBE_PHASE == PH_ROUTE0) { route_phase(lds, (const float*)(ws + C_HF), (const float*)(ws + W2_WRF), a.in[17], a.in[19], (bf16_t*)(ws + W2_HB), (float*)(ws + W2_RSTD), (int*)(ws + WS_CTL) + 4096,
                    (int*)(ws + W2_LIST), (float*)(ws + W2_WSLOT), bid, nblk); xcd_barrier(bar); }
    if (IN(PH_ROUTE0))
        route_phase(lds, (const float*)(ws + C_HF), (const float*)(ws + W2_WRF), a.in[17], a.in[19], (bf16_t*)(ws + W2_HB), (float*)(ws + W2_RSTD), (int*)(ws + WS_CTL),
                    (int*)(ws + W2_LIST), (float*)(ws + W2_WSLOT), bid, nblk);
    SEAM(PH_ROUTE0);
    if (IN(PH_MOE0)) REP(PH_MOE0) moe_phase(lds, (int*)(ws + WS_CTL), (const int*)(ws + W2_LIST), (const bf16_t*)(ws + W2_HB), (const float*)(ws + W2_RSTD), (const float*)(ws + W2_WSLOT),
                               (const bf16_t*)(ws + C_W0), (const bf16_t*)(ws + C_W0 + MOE_WGU_BYTES), (bf16_t*)(ws + B_Y0), bid, nblk);
    SEAM(PH_MOE0);
    if (IN(PH_COMBINE)) REP(PH_COMBINE) combine_phase((bf16_t*)(ws + W2_HB), (const bf16_t*)(ws + B_Y0), (float*)(ws + W2_RSTD), bid, nblk);
    SEAM(PH_COMBINE);
    if (IN(PH_WIN)) REP(PH_WIN) {
        const float* rstd = (const float*)(ws + W2_RSTD); float* cbuf = (float*)(ws + B_CBUF);
        gemm_phase<false>(lds, (const bf16_t*)(ws + W2_HB), D, (const bf16_t*)(ws + W2_WIN), D, 0, 2, bid, nblk, [=](int m0, int n0) { return EpiWin{rstd, cbuf, m0, n0}; });
    }
    SEAM(PH_WIN);
    if (IN(PH_CEPI)) REP(PH_CEPI) cepi_phase((const float*)(ws + B_CBUF), (const float2*)(ws + WS_ROPE), (bf16_t*)(ws + B_CQN), (bf16_t*)(ws + B_CKVN), (bf16_t*)(ws + WS_KPE), bid, nblk);
    SEAM(PH_CEPI);
    if (IN(PH_UQKV)) REP(PH_UQKV) {
        const float2* cs = (const float2*)(ws + WS_ROPE); bf16_t* Q1 = (bf16_t*)(ws + C_Q1); bf16_t* K1 = (bf16_t*)(ws + C_K1); bf16_t* V1 = (bf16_t*)(ws + C_V1);
        { const int gt = bid * NTHR + tid, ngt = nblk * NTHR;
          for (int idx = gt; idx < 2 * 48 * 1024; idx += ngt) { const int b = idx / (48 * 1024), r = idx % (48 * 1024); K1[((size_t)b * LP + 8208) * 1024 + r] = 0; }
          for (int idx = gt; idx < 2 * 16 * 64 * 48; idx += ngt) { const int rr = idx / 48, c = idx % 48; V1[(size_t)rr * LP + 8208 + c] = 0; } }
        gemm_phase<false>(lds, (const bf16_t*)(ws + B_CQN), 256, (const bf16_t*)(ws + W2_WUQ), 256, 0, 6, bid, nblk, [=](int m0, int n0) { return EpiUQ{cs, Q1, m0, n0}; });
        gemm_phase<false>(lds, (const bf16_t*)(ws + B_CKVN), 128, (const bf16_t*)(ws + W2_WUKV), 128, 0, 4, bid, nblk, [=](int m0, int n0) { return EpiK1{K1, m0, n0}; });
        gemm_phase<true>(lds, (const bf16_t*)(ws + B_CKVN), 128, (const bf16_t*)(ws + W2_WUKV), 128, 4, 8, bid, nblk, [=](int m0, int n0) { return EpiV1{V1, m0, n0}; });
    }
    SEAM(PH_UQKV);
    if (IN(PH_MLA)) REP(100) {
        const int wave = __builtin_amdgcn_readfirstlane(tid >> 6);
        moe_weight_items(a.in[20] + (size_t)NE * D * DE, a.in[21] + (size_t)NE * D * DE, a.in[22] + (size_t)NE * DE * D, a.in[3] + D, (bf16_t*)(ws + B_W1), (bf16_t*)(ws + B_W1 + MOE_WGU_BYTES),
                         (LAS float*)(lds + 65536 + wave * 8704), bid * NWAVE + wave, nblk * NWAVE, tid & 63);
        __syncthreads();
    }
    if (IN(PH_MLA)) REP(PH_MLA) mla_phase(lds, (const bf16_t*)(ws + C_Q1), (const bf16_t*)(ws + C_K1), (const bf16_t*)(ws + WS_KPE), (const bf16_t*)(ws + C_V1), (bf16_t*)(ws + B_O1), bid, nblk);
    SEAM(PH_MLA);
    if (IN(PH_OPROJ1)) REP(PH_OPROJ1) {
        const bf16_t* hb = (const bf16_t*)(ws + W2_HB); float* hf = (float*)(ws + C_HF1);
        gemm_phase<false>(lds, (const bf16_t*)(ws + B_O1), D, (const bf16_t*)(ws + W2_WO1), D, 0, 4, bid, nblk, [=](int m0, int n0) { return EpiResF32{nullptr, hb, hf, m0, n0}; });
    }
    SEAM(PH_OPROJ1);
    if (IN(PH_ROUTE1))
        route_phase(lds, (const float*)(ws + C_HF1), (const float*)(ws + W2_WRF) + 36 * 1024, a.in[17] + 4, a.in[19] + 32, (bf16_t*)(ws + W2_HB), (float*)(ws + W2_RSTD), (int*)(ws + WS_CTL) + 2048,
                    (int*)(ws + W2_LIST), (float*)(ws + W2_WSLOT), bid, nblk);
    SEAM(PH_ROUTE1);
    if (IN(PH_MOE1)) REP(PH_MOE1) moe_phase(lds, (int*)(ws + WS_CTL) + 2048, (const int*)(ws + W2_LIST), (const bf16_t*)(ws + W2_HB), (const float*)(ws + W2_RSTD), (const float*)(ws + W2_WSLOT),
                               (const bf16_t*)(ws + B_W1), (const bf16_t*)(ws + B_W1 + MOE_WGU_BYTES), (bf16_t*)(ws + C_Y1), bid, nblk);
    SEAM(PH_MOE1);
    if (IN(PH_FINAL)) REP(PH_FINAL) final_phase((const bf16_t*)(ws + W2_HB), (const bf16_t*)(ws + C_Y1), a.in[4], a.out, bid, nblk);
#undef IN
#undef SEAM
}

static void run_mega(hipStream_t s, const MArgs& base, int lo, int hi, int grid) {
    MArgs a = base; a.ph_lo = lo; a.ph_hi = hi; a.li = lo;
    hipLaunchKernelGGL(mega, dim3(grid), dim3(NTHR), LDS_BYTES, s, a);
}
extern "C" void kernel_launch(void* const* d_in, const int* in_sizes, int n_in, void* d_out, int out_size, void* d_ws, size_t ws_size, hipStream_t stream) {
    static int grid = 0;
    if (grid == 0) {
        if (n_in != 23 || ws_size < WS_END) { fprintf(stderr, "kernel_launch: unexpected n_in %d or ws_size %zu\n", n_in, ws_size); grid = -1; return; }
        if (hipFuncSetAttribute((const void*)mega, hipFuncAttributeMaxDynamicSharedMemorySize, LDS_BYTES) != hipSuccess) { fprintf(stderr, "hipFuncSetAttribute failed\n"); grid = -1; return; }
        int dev = 0, cus = 0, per_cu = 0;
        (void)hipGetDevice(&dev); (void)hipDeviceGetAttribute(&cus, hipDeviceAttributeMultiprocessorCount, dev);
        (void)hipOccupancyMaxActiveBlocksPerMultiprocessor(&per_cu, (const void*)mega, NTHR, LDS_BYTES);
        if (per_cu < 1) { fprintf(stderr, "occupancy query says %d blocks/CU\n", per_cu); }
        (void)hipGetLastError();
        grid = cus;
    }
    if (grid < 0) return;
    (void)in_sizes; (void)out_size;
    unsigned char* ws = (unsigned char*)d_ws;
    MArgs base{}; for (int i = 0; i < 23; ++i) base.in[i] = (const float*)d_in[i]; base.out = (float*)d_out; base.ws = ws;
    (void)hipMemsetAsync(ws + WS_CTL, 0, 1 * MiB, stream);
    run_mega(stream, base, 0, PH_N, grid);
}
```

```cpp
#include <hip/hip_runtime.h>
#ifndef PROBE_PHASE
#define PROBE_PHASE -1
#endif
#include <cstdio>
#include <cstdint>

typedef unsigned short bf16_t;

constexpr int D = 1024, SEQ = 8192, NB = 2, NMETA = 16;
constexpr int MREAL = NB * SEQ;
constexpr int MTOT = MREAL + NB * NMETA;
constexpr int LPOS = NMETA + SEQ;
constexpr int NQKV = 1280;
constexpr int NE = 32, DE = 256;
constexpr int CAP = MTOT * 2;
constexpr float EPS = 1e-6f;

__device__ __forceinline__ float bf2f(bf16_t v) { return __uint_as_float(((unsigned)v) << 16); }
__device__ __forceinline__ bf16_t f2bf(float f) { unsigned u = __float_as_uint(f); u += 0x7fffu + ((u >> 16) & 1u); return (bf16_t)(u >> 16); }
__device__ __forceinline__ int row_pos(int row) { return row < MREAL ? NMETA + (row & (SEQ - 1)) : ((row - MREAL) & (NMETA - 1)); }
__device__ __forceinline__ int row_batch(int row) { return row < MREAL ? (row >> 13) : ((row - MREAL) >> 4); }
constexpr int LP = 8256;
__device__ __forceinline__ int perm16(int p) { const int qd = (p >> 2) & 3; return (p & ~12) | ((((qd & 1) << 1) | (qd >> 1)) << 2); }
__device__ __forceinline__ float wave_sum(float v) {
#pragma unroll
    for (int o = 1; o < 64; o <<= 1) v += __shfl_xor(v, o);
    return v;
}

constexpr size_t MiB = 1u << 20;
constexpr size_t WS_CTL = 0;
constexpr size_t WS_ROPE = 1 * MiB;
constexpr size_t WS_END = 256 * MiB;

#define LAS __attribute__((address_space(3)))
#define GAS __attribute__((address_space(1)))
typedef short bf16x8 __attribute__((ext_vector_type(8)));
typedef float f32x4 __attribute__((ext_vector_type(4)));
typedef unsigned u32x4 __attribute__((ext_vector_type(4)));
typedef unsigned u32x2 __attribute__((ext_vector_type(2)));
constexpr int NTHR = 512, NWAVE = 8;
constexpr int LDS_MISC = 151552;
constexpr int LDS_BYTES = LDS_MISC + 1024;

constexpr size_t WS_BAR = 64 * 1024;
constexpr size_t WS_KPE = 3 * MiB + 256 * 1024;
constexpr size_t W2_RSTD = 4 * MiB + 512 * 1024, W2_WSLOT = W2_RSTD + 80 * 1024, W2_EID = W2_WSLOT + 144 * 1024;
constexpr size_t W2_LIST = 5 * MiB;
constexpr size_t W2_WRF = 9 * MiB + 256 * 1024;
constexpr size_t W2_WQKV = 10 * MiB;
constexpr size_t W2_WO0 = W2_WQKV + 2560 * 1024;
constexpr size_t W2_WIN = W2_WO0 + 2048 * 1024;
constexpr size_t W2_WUQ = W2_WIN + 1024 * 1024;
constexpr size_t W2_WUKV = W2_WUQ + 768 * 1024;
constexpr size_t W2_WO1 = W2_WUKV + 512 * 1024;
constexpr size_t W2_HB = 20 * MiB;
constexpr size_t W2_RB = 53 * MiB;
constexpr size_t W2_RC = 134 * MiB;
static_assert(W2_EID + (size_t)MTOT * 8 <= W2_LIST && W2_LIST + (size_t)NE * CAP * 4 <= W2_WRF && W2_WO1 + 2 * MiB <= W2_HB && W2_HB + (size_t)MTOT * 2048 <= W2_RB, "fixed map");
constexpr size_t B_QKV = W2_RB, B_O0 = W2_RB + 41 * MiB, B_VT0 = W2_RB + 74 * MiB  , B_Y0 = W2_RB, B_CBUF = W2_RB, B_CQN = W2_RB + 33 * MiB, B_CKVN = W2_RB + 42 * MiB, B_O1 = W2_RB, B_W1 = W2_RB + 33 * MiB;
constexpr size_t C_W0 = W2_RC, C_HF = W2_RC + 48 * MiB, C_Q1 = W2_RC, C_K1 = W2_RC + 49 * MiB, C_V1 = W2_RC + 82 * MiB, C_HF1 = W2_RC, C_Y1 = W2_RC;
static_assert(C_V1 + (size_t)2 * 16 * 64 * LP * 2 <= WS_END && C_K1 + (size_t)2 * LP * 2048 <= C_V1 && B_VT0 + (size_t)2 * 2 * 64 * LP * 2 <= W2_RC && C_HF + (size_t)MTOT * 4096 <= WS_END && B_W1 + 48 * MiB <= W2_RC, "region map");
constexpr size_t MOE_WGU_BYTES = (size_t)NE * 512 * 1024 * 2, MOE_WD_BYTES = (size_t)NE * 1024 * 256 * 2;

struct MArgs { const float* in[23]; float* out; unsigned char* ws; int ph_lo, ph_hi, li, pad; };

__device__ __forceinline__ unsigned pk2(float lo, float hi) { return (unsigned)f2bf(lo) | ((unsigned)f2bf(hi) << 16); }

#define XB_TMO      128
#define XB_XCNT(j)  (256  + 64 * (j))
#define XB_XSUB(j)  (1280 + 64 * (j))
#define XB_XGEN(j)  (2304 + 64 * (j))
#define XB_TOP      3328
#define XB_TOPGEN   3392
#define XCD_BAR_WORDS 3456
#define XB_SPIN_CAP (1u << 18)
__device__ __forceinline__ unsigned xb_ld(unsigned* p)              { return __hip_atomic_load(p, __ATOMIC_RELAXED, __HIP_MEMORY_SCOPE_AGENT); }
__device__ __forceinline__ unsigned xb_add(unsigned* p, unsigned v) { return __hip_atomic_fetch_add(p, v, __ATOMIC_RELAXED, __HIP_MEMORY_SCOPE_AGENT); }
__device__ __forceinline__ unsigned xb_xcc_id() { return (unsigned)__builtin_amdgcn_s_getreg((3 << 11) | 20) & 0xFu; }
#define XB_SPIN(cond, bar) do { unsigned _sp = 0; while (cond) { __builtin_amdgcn_s_sleep(1); \
    if ((++_sp & 255u) == 0u) { if (xb_ld(&(bar)[XB_TMO])) break; if (_sp > XB_SPIN_CAP) { atomicAdd(&(bar)[XB_TMO], 1u); break; } } } } while (0)
struct XcdBarrier { unsigned* bar; unsigned x; volatile LAS unsigned* st; };
__device__ __forceinline__ XcdBarrier xcd_barrier_post(unsigned* bar, volatile LAS unsigned* st) {
    XcdBarrier b; b.bar = bar; b.x = xb_xcc_id(); b.st = st;
    if (threadIdx.x == 0) (void)xb_add(&bar[XB_XCNT(b.x)], 1u);
    return b;
}
__device__ __forceinline__ void xcd_barrier_complete(unsigned* bar, unsigned x, unsigned& nloc, unsigned& nx) {
    const unsigned G = gridDim.x * gridDim.y * gridDim.z;
    unsigned sum, cnt, mine, sp = 0u;
    for (;;) {
        sum = 0u; cnt = 0u; mine = 0u;
#pragma unroll
        for (unsigned j = 0; j < 16; ++j) { const unsigned c = xb_ld(&bar[XB_XCNT(j)]); sum += c; cnt += (c > 0u) ? 1u : 0u; mine = (j == x) ? c : mine; }
        if (sum == G) break;
        __builtin_amdgcn_s_sleep(1);
        if ((++sp & 255u) == 0u) { if (xb_ld(&bar[XB_TMO])) break; if (sp > XB_SPIN_CAP) { atomicAdd(&bar[XB_TMO], 1u); break; } }
    }
    nloc = mine > 0u ? mine : 1u; nx = cnt > 0u ? cnt : 1u;
}
__device__ __forceinline__ void xcd_barrier(const XcdBarrier& b) {
    asm volatile("s_waitcnt vmcnt(0)" ::: "memory");
    __syncthreads();
    if (threadIdx.x == 0) {
        unsigned* bar = b.bar;
        __builtin_amdgcn_s_waitcnt(0);
        unsigned nloc = b.st[0], nx = b.st[1];
        if (nloc == 0u) { xcd_barrier_complete(bar, b.x, nloc, nx); b.st[0] = nloc; b.st[1] = nx; }
        const unsigned old = xb_add(&bar[XB_XSUB(b.x)], 1u);
        const unsigned gen = old / nloc;
        if (old + 1u == (gen + 1u) * nloc) {
            __builtin_amdgcn_fence(__ATOMIC_RELEASE, "agent");
            asm volatile("s_waitcnt vmcnt(0)" ::: "memory");
            const unsigned og = xb_add(&bar[XB_TOP], 1u);
            const unsigned tg = og / nx;
            if (og + 1u == (tg + 1u) * nx) xb_add(&bar[XB_TOPGEN], 1u);
            else XB_SPIN(xb_ld(&bar[XB_TOPGEN]) == tg, bar);
            __builtin_amdgcn_fence(__ATOMIC_ACQUIRE, "agent");
            xb_add(&bar[XB_XGEN(b.x)], 1u);
            asm volatile("s_waitcnt vmcnt(0)" ::: "memory");
        } else {
            XB_SPIN(xb_ld(&bar[XB_XGEN(b.x)]) == gen, bar);
            __builtin_amdgcn_fence(__ATOMIC_ACQUIRE, "agent");
            asm volatile("s_waitcnt vmcnt(0)" ::: "memory");
        }
    }
    __syncthreads();
}

template <int N> __device__ __forceinline__ void wait_vm() { asm volatile("s_waitcnt vmcnt(%0)" :: "n"(N) : "memory"); }
__device__ __forceinline__ int swzF(int g) { return (0x78 >> (2 * g)) & 3; }
constexpr int GT_NS = 4;
template <int MT, int NT, int WM, int WN, bool NSW, class RowA, class Epi>
__device__ __forceinline__ void gemm_tile(LAS unsigned char* lds, const RowA& rowA, const bf16_t* __restrict__ Bt, int ldb  , int nk  , Epi& epi) {
    constexpr int BM = WM * MT * 16, BN = WN * NT * 16, GA = BM / 16, G = (BM + BN) / 16, NG = (G + 7) / 8, GR = G % 8, STAGE = (BM + BN) * 64;
    static_assert(WM * WN == 8 && GT_NS * STAGE <= LDS_MISC && BM % 16 == 0 && BN % 16 == 0, "gemm_tile config");
    const int tid = threadIdx.x, lane = tid & 63, wave = __builtin_amdgcn_readfirstlane(tid >> 6), wm = wave / WN, wn = wave % WN;
    const char* src[NG];
    const int lc = (lane & 3) ^ swzF(lane >> 4);
#pragma unroll
    for (int i = 0; i < NG; ++i) {
        const int g = wave + 8 * i;
        if (g < GA) src[i] = (const char*)rowA(g * 16 + (lane >> 2)) + lc * 16;
        else if (g < G) src[i] = (const char*)(Bt + (size_t)((g - GA) * 16 + (lane >> 2)) * ldb) + lc * 16;
        else src[i] = nullptr;
    }
    f32x4 acc[MT][NT];
#pragma unroll
    for (int mi = 0; mi < MT; ++mi)
#pragma unroll
        for (int ni = 0; ni < NT; ++ni) acc[mi][ni] = (f32x4){0.f, 0.f, 0.f, 0.f};
    const int fro = (lane & 15) * 64 + (((lane >> 4) ^ swzF((lane >> 2) & 3)) << 4);
    constexpr int LM = PROBE_PHASE == 402 ? 2 : 1;
#define GT_STAGE(st, kt) do { _Pragma("unroll") for (int _i = 0; _i < NG; ++_i) { const int _g = wave + 8 * _i; if (_g < G) { \
        __builtin_amdgcn_global_load_lds((const unsigned*)(src[_i] + (size_t)(kt) * 64), (LAS unsigned*)(lds + (st) * STAGE + _g * 1024), 16, 0, 0); \
        if (LM == 2) __builtin_amdgcn_global_load_lds((const unsigned*)(src[_i] + (size_t)(kt) * 64), (LAS unsigned*)(lds + (st) * STAGE + _g * 1024), 16, 0, 0); } } } while (0)
#define GT_WAIT(ntl) do { if (GR == 0 || wave < GR) wait_vm<LM * NG * (ntl)>(); else wait_vm<LM * (NG - 1) * (ntl)>(); } while (0)
    GT_STAGE(0, 0);
    if (nk > 1) GT_STAGE(1, 1);
    if (nk > 2) GT_STAGE(2, 2);
    int st = 0;
    for (int kt = 0; kt < nk; ++kt) {
        const int rem = nk - 1 - kt;
        if (rem >= 2) GT_WAIT(2); else if (rem == 1) GT_WAIT(1); else GT_WAIT(0);
        __builtin_amdgcn_s_barrier(); asm volatile("" ::: "memory");
        if (kt + 3 < nk) GT_STAGE((st + 3) & 3, kt + 3);
        LAS const unsigned char* sa = lds + st * STAGE + (wm * MT * 16) * 64 + fro;
        LAS const unsigned char* sb = lds + st * STAGE + (BM + wn * NT * 16) * 64 + fro;
        bf16x8 bfr[NT];
#pragma unroll
        for (int ni = 0; ni < NT; ++ni) bfr[ni] = *(LAS const bf16x8*)(sb + ni * 1024);
        constexpr int PG = MT >= 2 ? 2 : 1, NPG = MT / PG;
        bf16x8 afc[PG], afn[PG];
#pragma unroll
        for (int i = 0; i < PG; ++i) afc[i] = *(LAS const bf16x8*)(sa + i * 1024);
#pragma unroll
        for (int pg = 0; pg < NPG; ++pg) {
            if (pg + 1 < NPG) {
#pragma unroll
                for (int i = 0; i < PG; ++i) afn[i] = *(LAS const bf16x8*)(sa + ((pg + 1) * PG + i) * 1024);
            }
#pragma unroll
            for (int i = 0; i < PG; ++i) { const int mi = pg * PG + i;
#pragma unroll
                for (int ni = 0; ni < NT; ++ni) {
                    if (NSW) acc[mi][ni] = __builtin_amdgcn_mfma_f32_16x16x32_bf16(afc[i], bfr[ni], acc[mi][ni], 0, 0, 0);
                    else acc[mi][ni] = __builtin_amdgcn_mfma_f32_16x16x32_bf16(bfr[ni], afc[i], acc[mi][ni], 0, 0, 0);
                } }
#pragma unroll
            for (int i = 0; i < PG; ++i) afc[i] = afn[i];
        }
        __builtin_amdgcn_sched_group_barrier(0x100, NT + PG, 0);
#pragma unroll
        for (int pg = 0; pg < NPG; ++pg) { if (pg + 1 < NPG) __builtin_amdgcn_sched_group_barrier(0x100, PG, 0); __builtin_amdgcn_sched_group_barrier(0x008, PG * NT, 0); }
        st = (st + 1) & 3;
    }
#undef GT_STAGE
#undef GT_WAIT
    epi(acc, wm * MT * 16, wn * NT * 16, lane);
    asm volatile("s_waitcnt lgkmcnt(0)" ::: "memory");
    __syncthreads();
}

struct RowDense { const bf16_t* A; int lda, m0, mlast; __device__ __forceinline__ const bf16_t* operator()(int r) const { int row = m0 + r; row = row > mlast ? mlast : row; return A + (size_t)row * lda; } };

struct EpiQKV {
    const float* rstd; const float* bias; const float2* cs; bf16_t* qkv; int m0, n0;
    template <int MT, int NT> __device__ __forceinline__ void operator()(f32x4 (&acc)[MT][NT], int mb, int nb, int lane) const {
        static_assert(NT == 4, "rope needs a 64-column wave span");
        const int cb = n0 + nb, d0 = (lane >> 4) * 4;
#pragma unroll
        for (int mi = 0; mi < MT; ++mi) {
            const int row = m0 + mb + mi * 16 + (lane & 15);
            if (row < MTOT) {
                const float rs = rstd[row]; const int pos = row_pos(row);
                bf16_t* orow = qkv + (size_t)row * NQKV + cb;
                {
                    const float sc = cb < 1024 ? 0.125f : 1.0f;
#pragma unroll
                    for (int ni = 0; ni < 2; ++ni) {
                        const int d = ni * 16 + d0;
                        const f32x4 b1 = *(const f32x4*)(bias + cb + d), b2 = *(const f32x4*)(bias + cb + 32 + d);
                        float o1[4], o2[4];
#pragma unroll
                        for (int r = 0; r < 4; ++r) {
                            const float2 t = cs[pos * 32 + d + r];
                            const float x1 = acc[mi][ni][r] * rs + b1[r], x2 = acc[mi][ni + 2][r] * rs + b2[r];
                            o1[r] = (x1 * t.x - x2 * t.y) * sc; o2[r] = (x2 * t.x + x1 * t.y) * sc;
                        }
                        *(u32x2*)(orow + d) = (u32x2){pk2(o1[0], o1[1]), pk2(o1[2], o1[3])};
                        *(u32x2*)(orow + 32 + d) = (u32x2){pk2(o2[0], o2[1]), pk2(o2[2], o2[3])};
                    }
                }
            }
        }
    }
};
struct EpiV0 {
    const float* rstd; const float* bias; bf16_t* vt0; int m0, n0;
    template <int MT, int NT> __device__ __forceinline__ void operator()(f32x4 (&acc)[MT][NT], int mb, int nb, int lane) const {
        static_assert(NT == 4, "64-column wave span");
        const int cb = n0 + nb, kh = (cb - 1152) >> 6;
#pragma unroll
        for (int mi = 0; mi < MT; ++mi) {
            const int row0 = m0 + mb + mi * 16 + (lane >> 4) * 4;
            if (row0 < MTOT) {
                const f32x4 rs = *(const f32x4*)(rstd + row0); const int b = row_batch(row0), pp = perm16(row_pos(row0));
#pragma unroll
                for (int ni = 0; ni < NT; ++ni) { const int d = ni * 16 + (lane & 15); const float bb = bias[cb + d];
                    const f32x4 v = acc[mi][ni] * rs + bb;
                    *(u32x2*)(vt0 + (size_t)((b * 2 + kh) * 64 + d) * LP + pp) = (u32x2){pk2(v[0], v[1]), pk2(v[2], v[3])}; }
            }
        }
    }
};
struct EpiRes {
    const float* bias; bf16_t* hb; int m0, n0;
    template <int MT, int NT> __device__ __forceinline__ void operator()(f32x4 (&acc)[MT][NT], int mb, int nb, int lane) const {
#pragma unroll
        for (int mi = 0; mi < MT; ++mi) {
            const int row = m0 + mb + mi * 16 + (lane & 15);
            if (row < MTOT) {
#pragma unroll
                for (int ni = 0; ni < NT; ++ni) {
                    const int col = n0 + nb + ni * 16 + (lane >> 4) * 4;
                    u32x2* p = (u32x2*)(hb + (size_t)row * D + col);
                    const u32x2 h = *p;
                    f32x4 v = acc[mi][ni];
                    if (bias) v += *(const f32x4*)(bias + col);
                    v[0] += __uint_as_float(h.x << 16); v[1] += __uint_as_float(h.x & 0xffff0000u); v[2] += __uint_as_float(h.y << 16); v[3] += __uint_as_float(h.y & 0xffff0000u);
                    *p = (u32x2){pk2(v[0], v[1]), pk2(v[2], v[3])};
                }
            }
        }
    }
};
struct EpiWin {
    const float* rstd; float* cbuf; int m0, n0;
    template <int MT, int NT> __device__ __forceinline__ void operator()(f32x4 (&acc)[MT][NT], int mb, int nb, int lane) const {
#pragma unroll
        for (int mi = 0; mi < MT; ++mi) {
            const int row = m0 + mb + mi * 16 + (lane & 15);
            if (row < MTOT) { const float rs = rstd[row];
#pragma unroll
                for (int ni = 0; ni < NT; ++ni) *(f32x4*)(cbuf + (size_t)row * 512 + n0 + nb + ni * 16 + (lane >> 4) * 4) = acc[mi][ni] * rs; }
        }
    }
};
struct EpiUQ {
    const float2* cs; bf16_t* Q1; int m0, n0;
    template <int MT, int NT> __device__ __forceinline__ void operator()(f32x4 (&acc)[MT][NT], int mb, int nb, int lane) const {
        static_assert(NT == 4, "rope needs whole 32-column blocks per wave");
        const float scale = 0.10206207261596577f * 1.4426950408889634f;
        const int d0 = (lane >> 4) * 4;
#pragma unroll
        for (int mi = 0; mi < MT; ++mi) {
            const int row = m0 + mb + mi * 16 + (lane & 15);
            if (row < MTOT) { const int pos = row_pos(row);
#pragma unroll
                for (int bi = 0; bi < 2; ++bi) {
                    const int gc = n0 + nb + bi * 32; bf16_t* orow = Q1 + (size_t)row * 1536 + gc;
                    f32x4 v1 = acc[mi][2 * bi], v2 = acc[mi][2 * bi + 1];
                    if (((gc >> 5) % 3) == 2) {
#pragma unroll
                        for (int r = 0; r < 4; ++r) { const float2 t = cs[pos * 32 + 2 * (d0 + r)]; const float x1 = v1[r], x2 = v2[r]; v1[r] = x1 * t.x - x2 * t.y; v2[r] = x2 * t.x + x1 * t.y; }
                    }
                    v1 = v1 * scale; v2 = v2 * scale;
                    *(u32x2*)(orow + d0) = (u32x2){pk2(v1[0], v1[1]), pk2(v1[2], v1[3])};
                    *(u32x2*)(orow + 16 + d0) = (u32x2){pk2(v2[0], v2[1]), pk2(v2[2], v2[3])};
                }
            }
        }
    }
};
struct EpiK1 {
    bf16_t* K1; int m0, n0;
    template <int MT, int NT> __device__ __forceinline__ void operator()(f32x4 (&acc)[MT][NT], int mb, int nb, int lane) const {
#pragma unroll
        for (int mi = 0; mi < MT; ++mi) {
            const int row = m0 + mb + mi * 16 + (lane & 15);
            if (row < MTOT) { const size_t kr = (size_t)row_batch(row) * LP + row_pos(row);
#pragma unroll
                for (int ni = 0; ni < NT; ++ni) { const f32x4 v = acc[mi][ni];
                    *(u32x2*)(K1 + kr * D + n0 + nb + ni * 16 + (lane >> 4) * 4) = (u32x2){pk2(v[0], v[1]), pk2(v[2], v[3])}; } }
        }
    }
};
struct EpiV1 {
    bf16_t* VT1; int m0, n0;
    template <int MT, int NT> __device__ __forceinline__ void operator()(f32x4 (&acc)[MT][NT], int mb, int nb, int lane) const {
#pragma unroll
        for (int mi = 0; mi < MT; ++mi) {
            const int row0 = m0 + mb + mi * 16 + (lane >> 4) * 4;
            if (row0 < MTOT) { const int b = row_batch(row0), pp = perm16(row_pos(row0));
#pragma unroll
                for (int ni = 0; ni < NT; ++ni) { const int hd = n0 - 1024 + nb + ni * 16 + (lane & 15); const f32x4 v = acc[mi][ni];
                    *(u32x2*)(VT1 + (size_t)(b * 1024 + hd) * LP + pp) = (u32x2){pk2(v[0], v[1]), pk2(v[2], v[3])}; } }
        }
    }
};

__device__ __forceinline__ void route_phase(LAS unsigned char* lds, const bf16_t* __restrict__ hbr, const float* __restrict__ wrf, const float* __restrict__ bg, const float* __restrict__ br,
                                            float* rstd_out, int* cnt, int* list, float* wslot, int bid, int nblk) {
    const int tid = threadIdx.x, lane = tid & 63, wave = __builtin_amdgcn_readfirstlane(tid >> 6);
    LAS f32x4* wl = (LAS f32x4*)lds;
    LAS int* nrec = (LAS int*)(lds + LDS_MISC + 16); LAS int* bcnt = (LAS int*)(lds + LDS_MISC + 32); LAS int* bbase = (LAS int*)(lds + LDS_MISC + 160); LAS int* rec = (LAS int*)(lds + LDS_MISC + 288);
    for (int i = tid; i < 36 * 256; i += NTHR) wl[i] = *(const f32x4*)(wrf + (size_t)i * 4);
    if (tid < NE) bcnt[tid] = 0;
    if (tid == 0) *nrec = 0;
    __syncthreads();
    for (int row = bid * NWAVE + wave; row < MTOT; row += nblk * NWAVE) {
        f32x4 x[4]; float ss = 0.f;
#pragma unroll
        for (int j = 0; j < 4; ++j) { const u32x2 h = *(const u32x2*)(hbr + (size_t)row * D + j * 256 + lane * 4);
            x[j] = (f32x4){__uint_as_float(h.x << 16), __uint_as_float(h.x & 0xffff0000u), __uint_as_float(h.y << 16), __uint_as_float(h.y & 0xffff0000u)};
            ss += x[j][0] * x[j][0] + x[j][1] * x[j][1] + x[j][2] * x[j][2] + x[j][3] * x[j][3]; }
        ss = wave_sum(ss);
        const float rs = rsqrtf(ss * (1.0f / D) + EPS);
        float lg[4];
#pragma unroll
        for (int c = 0; c < 4; ++c) { float p = 0.f;
#pragma unroll
            for (int j = 0; j < 4; ++j) { const f32x4 w = wl[c * 256 + j * 64 + lane]; p += x[j][0] * w[0] + x[j][1] * w[1] + x[j][2] * w[2] + x[j][3] * w[3]; }
            lg[c] = wave_sum(p) * rs + bg[c]; }
        int gi = 0; float gm = lg[0];
#pragma unroll
        for (int c = 1; c < 4; ++c) if (lg[c] > gm) { gm = lg[c]; gi = c; }
        float gs = 0.f;
#pragma unroll
        for (int c = 0; c < 4; ++c) gs += __expf(lg[c] - gm);
        const float gp = 1.0f / gs;
        gi = __builtin_amdgcn_readfirstlane(gi);
        float e[8];
#pragma unroll
        for (int c = 0; c < 8; ++c) { float p = 0.f;
#pragma unroll
            for (int j = 0; j < 4; ++j) { const f32x4 w = wl[(4 + gi * 8 + c) * 256 + j * 64 + lane]; p += x[j][0] * w[0] + x[j][1] * w[1] + x[j][2] * w[2] + x[j][3] * w[3]; }
            e[c] = wave_sum(p) * rs + br[gi * 8 + c]; }
        int i1 = 0; float v1 = e[0];
#pragma unroll
        for (int c = 1; c < 8; ++c) if (e[c] > v1) { v1 = e[c]; i1 = c; }
        int i2 = -1; float v2 = -3.0e38f;
#pragma unroll
        for (int c = 0; c < 8; ++c) if (c != i1 && e[c] > v2) { v2 = e[c]; i2 = c; }
        if (lane == 0) {
            const float r = __expf(v2 - v1);
            const float w1 = gp / (1.0f + r), w2 = gp * r / (1.0f + r);
            const int e1 = gi * 8 + i1, e2 = gi * 8 + i2;
            const int p1 = atomicAdd((int*)&bcnt[e1], 1), p2 = atomicAdd((int*)&bcnt[e2], 1);
            const int k = atomicAdd((int*)nrec, 2);
            rec[k] = ((row * 2) << 13) | (e1 << 8) | p1; rec[k + 1] = ((row * 2 + 1) << 13) | (e2 << 8) | p2;
            wslot[row * 2] = w1; wslot[row * 2 + 1] = w2; rstd_out[row] = rs;
        }
    }
    __syncthreads();
    if (tid < NE) { const int c = bcnt[tid]; bbase[tid] = c ? __hip_atomic_fetch_add(cnt + tid * 64, c, __ATOMIC_RELAXED, __HIP_MEMORY_SCOPE_AGENT) : 0; }
    __syncthreads();
    for (int k = tid; k < *nrec; k += NTHR) { const int r = rec[k], e = (r >> 8) & 31; list[(size_t)e * CAP + bbase[e] + (r & 255)] = r >> 13; }
    __syncthreads();
}
__device__ __forceinline__ void combine_phase(bf16_t* hb, const bf16_t* __restrict__ ybuf, float* rstd, int bid, int nblk) {
    const int tid = threadIdx.x, lane = tid & 63, wave = tid >> 6;
    for (int row = bid * NWAVE + wave; row < MTOT; row += nblk * NWAVE) {
        float ss = 0.f;
#pragma unroll
        for (int j = 0; j < 4; ++j) { const size_t c = j * 256 + lane * 4;
            const u32x2 h = *(const u32x2*)(hb + (size_t)row * D + c), y0 = *(const u32x2*)(ybuf + (size_t)(row * 2) * D + c), y1 = *(const u32x2*)(ybuf + (size_t)(row * 2 + 1) * D + c);
            float v[4];
            v[0] = __uint_as_float(h.x << 16) + __uint_as_float(y0.x << 16) + __uint_as_float(y1.x << 16);
            v[1] = __uint_as_float(h.x & 0xffff0000u) + __uint_as_float(y0.x & 0xffff0000u) + __uint_as_float(y1.x & 0xffff0000u);
            v[2] = __uint_as_float(h.y << 16) + __uint_as_float(y0.y << 16) + __uint_as_float(y1.y << 16);
            v[3] = __uint_as_float(h.y & 0xffff0000u) + __uint_as_float(y0.y & 0xffff0000u) + __uint_as_float(y1.y & 0xffff0000u);
            ss += v[0] * v[0] + v[1] * v[1] + v[2] * v[2] + v[3] * v[3];
            *(u32x2*)(hb + (size_t)row * D + c) = (u32x2){pk2(v[0], v[1]), pk2(v[2], v[3])}; }
        ss = wave_sum(ss); if (lane == 0) rstd[row] = rsqrtf(ss * (1.0f / D) + EPS);
    }
}
__device__ __forceinline__ void cepi_phase(const float* __restrict__ c, const float2* __restrict__ cs, bf16_t* cqn, bf16_t* ckvn, bf16_t* kpe, int bid, int nblk) {
    const int tid = threadIdx.x, lane = tid & 63, wave = tid >> 6;
    for (int row = bid * NWAVE + wave; row < MTOT; row += nblk * NWAVE) {
        const float* cr = c + (size_t)row * 512;
        const f32x4 q = *(const f32x4*)(cr + lane * 4);
        const float rq = rsqrtf(wave_sum(q[0] * q[0] + q[1] * q[1] + q[2] * q[2] + q[3] * q[3]) * (1.0f / 256) + EPS);
        *(u32x2*)(cqn + (size_t)row * 256 + lane * 4) = (u32x2){pk2(q[0] * rq, q[1] * rq), pk2(q[2] * rq, q[3] * rq)};
        const float k0 = cr[256 + lane], k1 = cr[320 + lane];
        const float rk = rsqrtf(wave_sum(k0 * k0 + k1 * k1) * (1.0f / 128) + EPS);
        ckvn[(size_t)row * 128 + lane] = f2bf(k0 * rk); ckvn[(size_t)row * 128 + 64 + lane] = f2bf(k1 * rk);
        if (lane < 32) { const int i = lane & 15; const float2 t = cs[row_pos(row) * 32 + 2 * i];
            const float x1 = cr[384 + i], x2 = cr[400 + i];
            kpe[((size_t)row_batch(row) * LP + row_pos(row)) * 32 + lane] = f2bf(lane < 16 ? x1 * t.x - x2 * t.y : x2 * t.x + x1 * t.y); }
    }
}
__device__ __forceinline__ void final_phase(const bf16_t* __restrict__ hb, const bf16_t* __restrict__ ybuf, const float* __restrict__ g, float* out, int bid, int nblk) {
    const int tid = threadIdx.x, lane = tid & 63, wave = tid >> 6;
    for (int row = bid * NWAVE + wave; row < MREAL; row += nblk * NWAVE) {
        f32x4 v[4]; float ss = 0.f;
#pragma unroll
        for (int j = 0; j < 4; ++j) { const size_t c = j * 256 + lane * 4;
            const u32x2 h = *(const u32x2*)(hb + (size_t)row * D + c), y0 = *(const u32x2*)(ybuf + (size_t)(row * 2) * D + c), y1 = *(const u32x2*)(ybuf + (size_t)(row * 2 + 1) * D + c);
            v[j][0] = __uint_as_float(h.x << 16) + __uint_as_float(y0.x << 16) + __uint_as_float(y1.x << 16);
            v[j][1] = __uint_as_float(h.x & 0xffff0000u) + __uint_as_float(y0.x & 0xffff0000u) + __uint_as_float(y1.x & 0xffff0000u);
            v[j][2] = __uint_as_float(h.y << 16) + __uint_as_float(y0.y << 16) + __uint_as_float(y1.y << 16);
            v[j][3] = __uint_as_float(h.y & 0xffff0000u) + __uint_as_float(y0.y & 0xffff0000u) + __uint_as_float(y1.y & 0xffff0000u);
            ss += v[j][0] * v[j][0] + v[j][1] * v[j][1] + v[j][2] * v[j][2] + v[j][3] * v[j][3]; }
        const float rs = rsqrtf(wave_sum(ss) * (1.0f / D) + EPS);
#pragma unroll
        for (int j = 0; j < 4; ++j) { const f32x4 gg = *(const f32x4*)(g + j * 256 + lane * 4); *(f32x4*)(out + (size_t)row * D + j * 256 + lane * 4) = v[j] * rs * gg; }
    }
}

typedef float f32x16 __attribute__((ext_vector_type(16)));
constexpr int AT_STAGE = 20480;
__device__ __forceinline__ unsigned cvtpk(float lo, float hi) { typedef float f2 __attribute__((ext_vector_type(2))); typedef __bf16 b2 __attribute__((ext_vector_type(2)));
    f2 v = {lo, hi}; b2 r = __builtin_convertvector(v, b2); return __builtin_bit_cast(unsigned, r); }
__device__ __forceinline__ void mla_unit(LAS unsigned char* lds, int b, int h, int qi, const bf16_t* __restrict__ Q1, const bf16_t* __restrict__ K1, const bf16_t* __restrict__ kpe,
                                         const bf16_t* __restrict__ VT1, bf16_t* o) {
    const int tid = threadIdx.x, lane = tid & 63, wave = __builtin_amdgcn_readfirstlane(tid >> 6), r32 = lane & 31, hi = lane >> 5;
    const size_t qrow = (size_t)b * SEQ + 256 * qi + 32 * wave + r32;
    bf16x8 qf[6];
#pragma unroll
    for (int s = 0; s < 6; ++s) qf[s] = *(const bf16x8*)(Q1 + qrow * 1536 + h * 96 + 16 * s + 8 * hi);
    const int lr = 8 * wave + (lane >> 3);
    const char* ksrc = (const char*)(K1 + ((size_t)b * LP + lr) * 1024 + h * 64) + (((lane & 7) ^ ((lr >> 1) & 7)) << 4);
    const char* vsrc = (const char*)(VT1 + ((size_t)(b * 16 + h) * 64 + lr) * LP) + (((lane & 7) ^ ((lr >> 1) & 7)) << 4);
    const int pr = 16 * wave + (lane >> 2);
    const char* psrc = (const char*)(kpe + ((size_t)b * LP + (pr & 63)) * 32) + (((lane & 3) ^ ((pr >> 2) & 3)) << 4);
#define MLA_ISSUE(j, st) do { \
        __builtin_amdgcn_global_load_lds((const unsigned*)(ksrc + (size_t)(j) * (64 * 2048)), (LAS unsigned*)(lds + (st) * AT_STAGE + wave * 1024), 16, 0, 0); \
        __builtin_amdgcn_global_load_lds((const unsigned*)(vsrc + (size_t)(j) * 128), (LAS unsigned*)(lds + (st) * AT_STAGE + 8192 + wave * 1024), 16, 0, 0); \
        if (wave < 4) __builtin_amdgcn_global_load_lds((const unsigned*)(psrc + (size_t)(j) * (64 * 64)), (LAS unsigned*)(lds + (st) * AT_STAGE + 16384 + wave * 1024), 16, 0, 0); } while (0)
    const int NT = 4 * qi + 5, jmaxw = 4 * qi + ((32 * wave + 47) >> 6);
    const int qp = 16 + 256 * qi + 32 * wave + r32;
    const int koff = r32 * 128, ksw = (r32 >> 1) & 7, poff = 16384 + r32 * 64, psw = (r32 >> 2) & 3, voff = 8192 + r32 * 128;
    f32x16 oacc[2]; oacc[0] = (f32x16){}; oacc[1] = (f32x16){};
    constexpr float MLA_THR = 8.0f;
    float mref = 0.f, lsum = 0.f;
    f32x16 negm = (f32x16){};
    MLA_ISSUE(0, 0);
    if (NT > 1) MLA_ISSUE(1, 1);
    int st = 0;
    for (int j = 0; j < NT; ++j) {
        if (j + 1 < NT) { if (wave < 4) asm volatile("s_waitcnt vmcnt(3)" ::: "memory"); else asm volatile("s_waitcnt vmcnt(2)" ::: "memory"); }
        else asm volatile("s_waitcnt vmcnt(0)" ::: "memory");
        __builtin_amdgcn_s_barrier(); asm volatile("" ::: "memory");
        if (j + 2 < NT) { const int st2 = st >= 1 ? st - 1 : 2; MLA_ISSUE(j + 2, st2); }
        if (j <= jmaxw) {
            LAS const unsigned char* sb = lds + st * AT_STAGE;
            f32x16 p0, p1;
            {
                const bf16x8 k0 = *(LAS const bf16x8*)(sb + koff + ((hi ^ ksw) << 4));
                const bf16x8 k1 = *(LAS const bf16x8*)(sb + 4096 + koff + ((hi ^ ksw) << 4));
                p0 = __builtin_amdgcn_mfma_f32_32x32x16_bf16(k0, qf[0], negm, 0, 0, 0);
                p1 = __builtin_amdgcn_mfma_f32_32x32x16_bf16(k1, qf[0], negm, 0, 0, 0);
            }
#pragma unroll
            for (int s = 1; s < 4; ++s) {
                const bf16x8 k0 = *(LAS const bf16x8*)(sb + koff + (((2 * s + hi) ^ ksw) << 4));
                const bf16x8 k1 = *(LAS const bf16x8*)(sb + 4096 + koff + (((2 * s + hi) ^ ksw) << 4));
                p0 = __builtin_amdgcn_mfma_f32_32x32x16_bf16(k0, qf[s], p0, 0, 0, 0);
                p1 = __builtin_amdgcn_mfma_f32_32x32x16_bf16(k1, qf[s], p1, 0, 0, 0);
            }
#pragma unroll
            for (int s = 0; s < 2; ++s) {
                const bf16x8 k0 = *(LAS const bf16x8*)(sb + poff + (((2 * s + hi) ^ psw) << 4));
                const bf16x8 k1 = *(LAS const bf16x8*)(sb + 2048 + poff + (((2 * s + hi) ^ psw) << 4));
                p0 = __builtin_amdgcn_mfma_f32_32x32x16_bf16(k0, qf[4 + s], p0, 0, 0, 0);
                p1 = __builtin_amdgcn_mfma_f32_32x32x16_bf16(k1, qf[4 + s], p1, 0, 0, 0);
            }
            if (j >= 4 * qi) {
                const int kb0 = 64 * j + 4 * hi;
#pragma unroll
                for (int r = 0; r < 16; ++r) { const int kp = kb0 + (r & 3) + 8 * (r >> 2); if (kp > qp) p0[r] = -1e30f; if (kp + 32 > qp) p1[r] = -1e30f; }
            }
            float tm = fmaxf(p0[0], p1[0]);
#pragma unroll
            for (int r = 1; r < 16; ++r) tm = fmaxf(tm, fmaxf(p0[r], p1[r]));
            tm = fmaxf(tm, __shfl_xor(tm, 32));
            if (j == 0 || __any(tm > MLA_THR)) {
                const float dl = j == 0 ? tm : fmaxf(tm, 0.f);
                mref += dl;
                const float f = __builtin_amdgcn_exp2f(-dl);
                lsum *= f;
#pragma unroll
                for (int r = 0; r < 16; ++r) { oacc[0][r] *= f; oacc[1][r] *= f; p0[r] -= dl; p1[r] -= dl; negm[r] = -mref; }
            }
            float ps = 0.f;
#pragma unroll
            for (int r = 0; r < 16; ++r) { p0[r] = __builtin_amdgcn_exp2f(p0[r]); p1[r] = __builtin_amdgcn_exp2f(p1[r]); ps += p0[r] + p1[r]; }
            lsum += ps;
            u32x4 pf[4];
            pf[0] = (u32x4){cvtpk(p0[0], p0[1]), cvtpk(p0[2], p0[3]), cvtpk(p0[4], p0[5]), cvtpk(p0[6], p0[7])};
            pf[1] = (u32x4){cvtpk(p0[8], p0[9]), cvtpk(p0[10], p0[11]), cvtpk(p0[12], p0[13]), cvtpk(p0[14], p0[15])};
            pf[2] = (u32x4){cvtpk(p1[0], p1[1]), cvtpk(p1[2], p1[3]), cvtpk(p1[4], p1[5]), cvtpk(p1[6], p1[7])};
            pf[3] = (u32x4){cvtpk(p1[8], p1[9]), cvtpk(p1[10], p1[11]), cvtpk(p1[12], p1[13]), cvtpk(p1[14], p1[15])};
#pragma unroll
            for (int s = 0; s < 4; ++s) {
                const bf16x8 v0 = *(LAS const bf16x8*)(sb + voff + (((2 * s + hi) ^ ksw) << 4));
                const bf16x8 v1 = *(LAS const bf16x8*)(sb + 4096 + voff + (((2 * s + hi) ^ ksw) << 4));
                const bf16x8 pb = __builtin_bit_cast(bf16x8, pf[s]);
                oacc[0] = __builtin_amdgcn_mfma_f32_32x32x16_bf16(v0, pb, oacc[0], 0, 0, 0);
                oacc[1] = __builtin_amdgcn_mfma_f32_32x32x16_bf16(v1, pb, oacc[1], 0, 0, 0);
            }
        }
        st = st == 2 ? 0 : st + 1;
    }
#undef MLA_ISSUE
    lsum += __shfl_xor(lsum, 32);
    const float inv = 1.0f / lsum;
    bf16_t* orow = o + qrow * D + h * 64 + 4 * hi;
#pragma unroll
    for (int db = 0; db < 2; ++db)
#pragma unroll
        for (int g = 0; g < 4; ++g)
            *(u32x2*)(orow + 32 * db + 8 * g) = (u32x2){cvtpk(oacc[db][4 * g] * inv, oacc[db][4 * g + 1] * inv), cvtpk(oacc[db][4 * g + 2] * inv, oacc[db][4 * g + 3] * inv)};
    asm volatile("s_waitcnt lgkmcnt(0)" ::: "memory");
    __builtin_amdgcn_s_barrier(); asm volatile("" ::: "memory");
}
__device__ __forceinline__ void mla_meta(int b, int h, const bf16_t* __restrict__ Q1, const bf16_t* __restrict__ K1, const bf16_t* __restrict__ kpe, const bf16_t* __restrict__ VT1, bf16_t* o, int lane) {
    const int qi = lane & 15, part = lane >> 4; const size_t qrow = (size_t)MREAL + b * 16 + qi;
    float q[24];
#pragma unroll
    for (int d = 0; d < 24; ++d) q[d] = bf2f(Q1[qrow * 1536 + h * 96 + 24 * part + d]);
    float sc[16]; float mx = -1e30f;
#pragma unroll
    for (int j = 0; j < 16; ++j) {
        const size_t kr = (size_t)b * LP + j; float s = 0.f;
#pragma unroll
        for (int d = 0; d < 24; ++d) { const int dd = 24 * part + d; const float kv = dd < 64 ? bf2f(K1[kr * D + h * 64 + dd]) : bf2f(kpe[kr * 32 + dd - 64]); s += q[d] * kv; }
        s += __shfl_xor(s, 16); s += __shfl_xor(s, 32);
        sc[j] = j <= qi ? s : -1e30f; mx = fmaxf(mx, sc[j]);
    }
    float l = 0.f;
#pragma unroll
    for (int j = 0; j < 16; ++j) { sc[j] = exp2f(sc[j] - mx); l += sc[j]; }
    const float inv = 1.0f / l;
#pragma unroll
    for (int dd = 0; dd < 16; ++dd) { const int d = 16 * part + dd; float acc = 0.f;
#pragma unroll
        for (int j = 0; j < 16; ++j) acc += sc[j] * bf2f(VT1[((size_t)(b * 16 + h) * 64 + d) * LP + perm16(j)]);
        o[qrow * D + h * 64 + d] = f2bf(acc * inv); }
}
__device__ __forceinline__ void mla_phase(LAS unsigned char* lds, const bf16_t* Q1, const bf16_t* K1, const bf16_t* kpe, const bf16_t* VT1, bf16_t* o, int bid, int nblk) {
    const int v = (nblk % 8 == 0) ? (bid % 8) * (nblk / 8) + bid / 8 : bid;
    for (int vv = v; vv < 256; vv += nblk) {
        const int bh = vv >> 3, s = vv & 7, b = bh >> 4, h = bh & 15;
#pragma unroll 1
        for (int i = 0; i < 4; ++i) { const int qi = (i == 0) ? s : (i == 1) ? 15 - s : (i == 2) ? 16 + s : 31 - s; mla_unit(lds, b, h, qi, Q1, K1, kpe, VT1, o); }
        if (s == 0 && threadIdx.x < 64) mla_meta(b, h, Q1, K1, kpe, VT1, o, threadIdx.x);
    }
}

constexpr int SW_K = 0, SW_V = 36864, SW_VP = 560;
__device__ __forceinline__ void swa_block32(LAS const unsigned char* lds, int rb, int gk0, int nks, int mode, int i_q, const bf16x8 (&qf)[4], float& m, float& lsum, f32x16 (&oacc)[2], int r32, int hi) {
    const float C2 = 1.4426950408889634f;
    const int ksw = (r32 >> 1) & 7;
    f32x16 p = (f32x16){};
#pragma unroll
    for (int s = 0; s < 4; ++s) { const bf16x8 k = *(LAS const bf16x8*)(lds + SW_K + (rb + r32) * 128 + (((2 * s + hi) ^ ksw) << 4)); p = __builtin_amdgcn_mfma_f32_32x32x16_bf16(k, qf[s], p, 0, 0, 0); }
    if (mode != 0) {
        const int jb = ((rb - 32) & 127) + 4 * hi;
#pragma unroll
        for (int r = 0; r < 16; ++r) { const int kk = (r & 3) + 8 * (r >> 2);
            const bool ok = mode == 1 ? (kk + 4 * hi < 16) : mode == 2 ? (jb + kk > i_q) : (jb + kk <= i_q);
            if (!ok) p[r] = -1e30f; }
    }
    float tm = p[0];
#pragma unroll
    for (int r = 1; r < 16; ++r) tm = fmaxf(tm, p[r]);
    tm = fmaxf(tm, __shfl_xor(tm, 32));
    const float mn = fmaxf(m, tm), alpha = __builtin_amdgcn_exp2f((m - mn) * C2), nmc = -mn * C2;
    m = mn;
    float ps = 0.f;
#pragma unroll
    for (int r = 0; r < 16; ++r) { p[r] = __builtin_amdgcn_exp2f(__builtin_fmaf(p[r], C2, nmc)); ps += p[r]; }
    lsum = lsum * alpha + ps;
#pragma unroll
    for (int r = 0; r < 16; ++r) { oacc[0][r] *= alpha; oacc[1][r] *= alpha; }
    u32x4 pf[2];
    pf[0] = (u32x4){cvtpk(p[0], p[1]), cvtpk(p[2], p[3]), cvtpk(p[4], p[5]), cvtpk(p[6], p[7])};
    pf[1] = (u32x4){cvtpk(p[8], p[9]), cvtpk(p[10], p[11]), cvtpk(p[12], p[13]), cvtpk(p[14], p[15])};
#pragma unroll
    for (int ks = 0; ks < 2; ++ks) if (ks < nks) {
        const bf16x8 v0 = *(LAS const bf16x8*)(lds + SW_V + r32 * SW_VP + (gk0 + ks) * 32 + hi * 16);
        const bf16x8 v1 = *(LAS const bf16x8*)(lds + SW_V + (32 + r32) * SW_VP + (gk0 + ks) * 32 + hi * 16);
        const bf16x8 pb = __builtin_bit_cast(bf16x8, pf[ks]);
        oacc[0] = __builtin_amdgcn_mfma_f32_32x32x16_bf16(v0, pb, oacc[0], 0, 0, 0);
        oacc[1] = __builtin_amdgcn_mfma_f32_32x32x16_bf16(v1, pb, oacc[1], 0, 0, 0);
    }
}
__device__ __forceinline__ void swa_unit(LAS unsigned char* lds, int b, int n, int kh, const bf16_t* __restrict__ qkv, const bf16_t* __restrict__ VT0, const float* __restrict__ sinks, bf16_t* o) {
    const int tid = threadIdx.x, lane = tid & 63, wave = __builtin_amdgcn_readfirstlane(tid >> 6), r32 = lane & 31, hi = lane >> 5;
    for (int idx = tid; idx < 2176; idx += NTHR) {
        const int row = idx >> 3, c = idx & 7;
        if (row < 16 || n > 0 || row >= 144) {
            const size_t srow = row < 16 ? (size_t)MREAL + b * 16 + row : (size_t)b * SEQ + 128 * (n - 1) + (row - 16);
            const int lrow = row < 16 ? row : 16 + row;
            const u32x4 v = *(const u32x4*)(qkv + srow * NQKV + 1024 + kh * 64 + c * 8);
            *(LAS u32x4*)(lds + SW_K + lrow * 128 + ((c ^ ((lrow >> 1) & 7)) << 4)) = v;
        }
    }
    for (int idx = tid; idx < 2176; idx += NTHR) {
        const int d = idx / 34, c = idx % 34;
        if (c < 2 || n > 0 || c >= 18) {
            const bf16_t* src = VT0 + (size_t)((b * 2 + kh) * 64 + d) * LP + (c < 2 ? c * 8 : 16 + 128 * (n - 1) + (c - 2) * 8);
            *(LAS u32x4*)(lds + SW_V + d * SW_VP + c * 16) = *(const u32x4*)src;
        }
    }
    __syncthreads();
    const int hq = kh * 8 + wave;
    const float sink = sinks[hq];
#pragma unroll 1
    for (int qs = 0; qs < 4; ++qs) {
        const size_t qrow = (size_t)b * SEQ + 128 * n + 32 * qs + r32;
        bf16x8 qf[4];
#pragma unroll
        for (int s = 0; s < 4; ++s) qf[s] = *(const bf16x8*)(qkv + qrow * NQKV + hq * 64 + 16 * s + 8 * hi);
        f32x16 oacc[2]; oacc[0] = (f32x16){}; oacc[1] = (f32x16){};
        float m = sink, lsum = hi == 0 ? 1.0f : 0.0f;
        const int i_q = 32 * qs + r32;
        swa_block32(lds, 0, 0, 1, 1, i_q, qf, m, lsum, oacc, r32, hi);
        if (n > 0) {
            swa_block32(lds, 32 + 32 * qs, 1 + 2 * qs, 2, 2, i_q, qf, m, lsum, oacc, r32, hi);
#pragma unroll 1
            for (int kb = qs + 1; kb < 4; ++kb) swa_block32(lds, 32 + 32 * kb, 1 + 2 * kb, 2, 0, i_q, qf, m, lsum, oacc, r32, hi);
        }
#pragma unroll 1
        for (int kb = 0; kb < qs; ++kb) swa_block32(lds, 160 + 32 * kb, 9 + 2 * kb, 2, 0, i_q, qf, m, lsum, oacc, r32, hi);
        swa_block32(lds, 160 + 32 * qs, 9 + 2 * qs, 2, 3, i_q, qf, m, lsum, oacc, r32, hi);
        lsum += __shfl_xor(lsum, 32);
        const float inv = 1.0f / lsum;
        bf16_t* orow = o + qrow * D + hq * 64 + 4 * hi;
#pragma unroll
        for (int db = 0; db < 2; ++db)
#pragma unroll
            for (int g = 0; g < 4; ++g)
                *(u32x2*)(orow + 32 * db + 8 * g) = (u32x2){cvtpk(oacc[db][4 * g] * inv, oacc[db][4 * g + 1] * inv), cvtpk(oacc[db][4 * g + 2] * inv, oacc[db][4 * g + 3] * inv)};
    }
    __syncthreads();
}
__device__ __forceinline__ void swa_meta(int b, int hq, const bf16_t* __restrict__ qkv, const bf16_t* __restrict__ VT0, const float* __restrict__ sinks, bf16_t* o, int lane) {
    const int qi = lane & 15, part = lane >> 4, kh = hq >> 3; const size_t qrow = (size_t)MREAL + b * 16 + qi;
    float q[16];
#pragma unroll
    for (int d = 0; d < 16; ++d) q[d] = bf2f(qkv[qrow * NQKV + hq * 64 + 16 * part + d]);
    const float sink = sinks[hq];
    float sc[16]; float mx = sink;
#pragma unroll
    for (int j = 0; j < 16; ++j) {
        const size_t kr = (size_t)MREAL + b * 16 + j; float s = 0.f;
#pragma unroll
        for (int d = 0; d < 16; ++d) s += q[d] * bf2f(qkv[kr * NQKV + 1024 + kh * 64 + 16 * part + d]);
        s += __shfl_xor(s, 16); s += __shfl_xor(s, 32);
        sc[j] = j <= qi ? s : -1e30f; mx = fmaxf(mx, sc[j]);
    }
    float l = __expf(sink - mx);
#pragma unroll
    for (int j = 0; j < 16; ++j) { sc[j] = __expf(sc[j] - mx); l += sc[j]; }
    const float inv = 1.0f / l;
#pragma unroll
    for (int dd = 0; dd < 16; ++dd) { const int d = 16 * part + dd; float acc = 0.f;
#pragma unroll
        for (int j = 0; j < 16; ++j) acc += sc[j] * bf2f(VT0[((size_t)(b * 2 + kh) * 64 + d) * LP + perm16(j)]);
        o[qrow * D + hq * 64 + d] = f2bf(acc * inv); }
}
__device__ __forceinline__ void swa_phase(LAS unsigned char* lds, const bf16_t* qkv, const bf16_t* VT0, const float* sinks, bf16_t* o, int bid, int nblk) {
    for (int u = bid; u < 256; u += nblk) {
        const int b = u >> 7, n = (u >> 1) & 63, kh = u & 1;
        swa_unit(lds, b, n, kh, qkv, VT0, sinks, o);
        if (n == 0) swa_meta(b, kh * 8 + (threadIdx.x >> 6), qkv, VT0, sinks, o, threadIdx.x & 63);
    }
}

template <int MOE_MT>
__device__ __forceinline__ void moe_unit(LAS unsigned char* lds, int e, int s0, int ns, const int* __restrict__ list, const bf16_t* __restrict__ hb, const float* __restrict__ rstd,
                                         const float* __restrict__ wslot, const bf16_t* __restrict__ wgu, const bf16_t* __restrict__ wd, bf16_t* ybuf) {
    constexpr int MOE_BM = 16 * MOE_MT, MOE_ST1 = (MOE_BM + 256) * 128, MOE_HT = MOE_BM * 128, MOE_HLO = 2 * MOE_ST1, MOE_B2 = 2 * MOE_HT, MOE_ST2 = 32768, MOE_INFO = MOE_HLO + 2 * MOE_HT;
    static_assert(MOE_B2 + 2 * MOE_ST2 <= MOE_HLO && MOE_INFO + 3072 <= LDS_MISC, "moe lds");
#define moe_hoff(kt2) ((kt2) < 2 ? MOE_HLO + (kt2) * MOE_HT : ((kt2) - 2) * MOE_HT)
    const int tid = threadIdx.x, lane = tid & 63, wave = __builtin_amdgcn_readfirstlane(tid >> 6);
    LAS int* slotl = (LAS int*)(lds + MOE_INFO); LAS float* rsl = (LAS float*)(lds + MOE_INFO + 1024); LAS float* wl = (LAS float*)(lds + MOE_INFO + 2048);
    if (tid < MOE_BM) { const int sl = list[(size_t)e * CAP + s0 + (tid < ns ? tid : 0)]; slotl[tid] = sl; rsl[tid] = rstd[sl >> 1]; wl[tid] = wslot[sl]; }
    __syncthreads();
    const int lc = (lane & 7) ^ (lane >> 3);
    const int fro = (lane & 15) * 128, fc0 = ((lane >> 4) ^ (lane & 7)) << 4, fc1 = ((4 + (lane >> 4)) ^ (lane & 7)) << 4;
    {
        constexpr int G = (MOE_BM + 256) / 8, GA = MOE_BM / 8, NG = (G + 7) / 8;
        const char* src[NG];
#pragma unroll
        for (int i = 0; i < NG; ++i) { const int g = wave + 8 * i;
            if (g < GA) src[i] = (const char*)(hb + (size_t)(slotl[g * 8 + (lane >> 3)] >> 1) * D) + lc * 16;
            else if (g < G) src[i] = (const char*)(wgu + (size_t)((g - GA) * 8 + (lane >> 3)) * D) + lc * 16;
            else src[i] = nullptr; }
        f32x4 acc[MOE_MT][2];
#pragma unroll
        for (int mi = 0; mi < MOE_MT; ++mi) { acc[mi][0] = (f32x4){0.f, 0.f, 0.f, 0.f}; acc[mi][1] = (f32x4){0.f, 0.f, 0.f, 0.f}; }
#define M1_STAGE(st, step) do { _Pragma("unroll") for (int _i = 0; _i < NG; ++_i) { const int _g = wave + 8 * _i; if (_g < G) \
        __builtin_amdgcn_global_load_lds((const unsigned*)(src[_i] + (size_t)((step) & 15) * 128 + ((_g >= GA && (step) >= 16) ? (size_t)256 * 2048 : 0)), (LAS unsigned*)(lds + (st) * MOE_ST1 + _g * 1024), 16, 0, 0); } } while (0)
        M1_STAGE(0, 0);
        for (int step = 0; step < 32; ++step) {
            asm volatile("s_waitcnt vmcnt(0)" ::: "memory");
            __syncthreads();
            if (step + 1 < 32) M1_STAGE((step + 1) & 1, step + 1);
            LAS const unsigned char* sa = lds + (step & 1) * MOE_ST1 + fro;
            LAS const unsigned char* sb = lds + (step & 1) * MOE_ST1 + (MOE_BM + wave * 32) * 128 + fro;
#pragma unroll
            for (int ks = 0; ks < 2; ++ks) { const int fc = ks ? fc1 : fc0;
                const bf16x8 b0 = *(LAS const bf16x8*)(sb + fc), b1 = *(LAS const bf16x8*)(sb + 2048 + fc);
#pragma unroll
                for (int mi = 0; mi < MOE_MT; ++mi) { const bf16x8 af = *(LAS const bf16x8*)(sa + mi * 2048 + fc);
                    acc[mi][0] = __builtin_amdgcn_mfma_f32_16x16x32_bf16(b0, af, acc[mi][0], 0, 0, 0);
                    acc[mi][1] = __builtin_amdgcn_mfma_f32_16x16x32_bf16(b1, af, acc[mi][1], 0, 0, 0); }
            }
            if ((step & 15) == 15) {
                const int n = 16 * (8 * (step >> 4) + wave) + (lane >> 4) * 4;
                const int csw = ((n & 63) >> 3);
#pragma unroll
                for (int mi = 0; mi < MOE_MT; ++mi) { const int row = mi * 16 + (lane & 15); const float rs = rsl[row]; float hv[4];
#pragma unroll
                    for (int r = 0; r < 4; ++r) { const float g = acc[mi][0][r] * rs, u = acc[mi][1][r] * rs; hv[r] = g / (1.0f + __expf(-g)) * u; }
                    *(LAS u32x2*)(lds + moe_hoff(n >> 6) + row * 128 + ((csw ^ (row & 7)) << 4) + (n & 4) * 2) = (u32x2){pk2(hv[0], hv[1]), pk2(hv[2], hv[3])};
                    acc[mi][0] = (f32x4){0.f, 0.f, 0.f, 0.f}; acc[mi][1] = (f32x4){0.f, 0.f, 0.f, 0.f}; }
            }
        }
#undef M1_STAGE
    }
    __syncthreads();
    {
        const char* src2[4];
#pragma unroll
        for (int i = 0; i < 4; ++i) src2[i] = (const char*)(wd + (size_t)((wave + 8 * i) * 8 + (lane >> 3)) * DE) + lc * 16;
        f32x4 acc[MOE_MT][2];
#pragma unroll
        for (int mi = 0; mi < MOE_MT; ++mi) { acc[mi][0] = (f32x4){0.f, 0.f, 0.f, 0.f}; acc[mi][1] = (f32x4){0.f, 0.f, 0.f, 0.f}; }
#define M2_STAGE(st, q) do { _Pragma("unroll") for (int _i = 0; _i < 4; ++_i) \
        __builtin_amdgcn_global_load_lds((const unsigned*)(src2[_i] + (size_t)((q) >> 2) * (256 * 512) + (size_t)((q) & 3) * 128), (LAS unsigned*)(lds + MOE_B2 + (st) * MOE_ST2 + (wave + 8 * _i) * 1024), 16, 0, 0); } while (0)
        M2_STAGE(0, 0);
        for (int q = 0; q < 16; ++q) {
            asm volatile("s_waitcnt vmcnt(0)" ::: "memory");
            __syncthreads();
            if (q + 1 < 16) M2_STAGE((q + 1) & 1, q + 1);
            LAS const unsigned char* sa = lds + moe_hoff(q & 3) + fro;
            LAS const unsigned char* sb = lds + MOE_B2 + (q & 1) * MOE_ST2 + (wave * 32) * 128 + fro;
#pragma unroll
            for (int ks = 0; ks < 2; ++ks) { const int fc = ks ? fc1 : fc0;
                const bf16x8 b0 = *(LAS const bf16x8*)(sb + fc), b1 = *(LAS const bf16x8*)(sb + 2048 + fc);
#pragma unroll
                for (int mi = 0; mi < MOE_MT; ++mi) { const bf16x8 af = *(LAS const bf16x8*)(sa + mi * 2048 + fc);
                    acc[mi][0] = __builtin_amdgcn_mfma_f32_16x16x32_bf16(b0, af, acc[mi][0], 0, 0, 0);
                    acc[mi][1] = __builtin_amdgcn_mfma_f32_16x16x32_bf16(b1, af, acc[mi][1], 0, 0, 0); }
            }
            if ((q & 3) == 3) {
                const int cb = (q >> 2) * 256 + wave * 32 + (lane >> 4) * 4;
#pragma unroll
                for (int mi = 0; mi < MOE_MT; ++mi) { const int row = mi * 16 + (lane & 15);
                    if (row < ns) { const float w = wl[row]; bf16_t* yr = ybuf + (size_t)slotl[row] * D + cb;
#pragma unroll
                        for (int ni = 0; ni < 2; ++ni) { const f32x4 v = acc[mi][ni] * w; *(u32x2*)(yr + ni * 16) = (u32x2){pk2(v[0], v[1]), pk2(v[2], v[3])}; } }
                    acc[mi][0] = (f32x4){0.f, 0.f, 0.f, 0.f}; acc[mi][1] = (f32x4){0.f, 0.f, 0.f, 0.f}; }
            }
        }
#undef M2_STAGE
    }
#undef moe_hoff
    __syncthreads();
}
__device__ __forceinline__ void moe_phase(LAS unsigned char* lds, int* cnt, const int* list, const bf16_t* hb, const float* rstd, const float* wslot, const bf16_t* wgu, const bf16_t* wd, bf16_t* ybuf, int bid, int nblk) {
    const bool grp = (nblk % 8) == 0;
    int u = grp ? (bid % 8) * (nblk / 8) + bid / 8 : bid, base = 0;
    for (int e = 0; e < NE; ++e) {
        const int c = __hip_atomic_load(cnt + e * 64, __ATOMIC_RELAXED, __HIP_MEMORY_SCOPE_AGENT);
        const bool big = c > 8 * 144; const int bm = big ? 160 : 144, nt = (c + bm - 1) / bm;
        while (u < base + nt) { const int t = u - base; const int ns = c - t * bm < bm ? c - t * bm : bm;
            if (big) moe_unit<10>(lds, e, t * bm, ns, list, hb, rstd, wslot, wgu + (size_t)e * 512 * 1024, wd + (size_t)e * 1024 * 256, ybuf);
            else moe_unit<9>(lds, e, t * bm, ns, list, hb, rstd, wslot, wgu + (size_t)e * 512 * 1024, wd + (size_t)e * 1024 * 256, ybuf);
            u += nblk; }
        base += nt;
    }
}

struct EpiNull { int m0, n0;
    template <int MT, int NT> __device__ __forceinline__ void operator()(f32x4 (&acc)[MT][NT], int, int, int) const {
#pragma unroll
        for (int mi = 0; mi < MT; ++mi)
#pragma unroll
            for (int ni = 0; ni < NT; ++ni) asm volatile("" :: "v"(acc[mi][ni])); } };
__device__ __forceinline__ void transpose_item(const float* __restrict__ W, int N, const float* __restrict__ gain, bf16_t* dst, int ldk, int drow0, int k0, int n0, LAS float* scr, int lane, int dskip = 0) {
#pragma unroll 8
    for (int i = 0; i < 32; ++i) { const int kk = 2 * i + (lane >> 5); float v = W[(size_t)(k0 + kk) * N + n0 + (lane & 31)]; if (gain) v *= gain[k0 + kk]; scr[kk * 33 + (lane & 31)] = v; }
    asm volatile("s_waitcnt lgkmcnt(0)" ::: "memory");
    const int c = lane & 7;
#pragma unroll
    for (int j = 0; j < 4; ++j) { const int n = (lane >> 3) + 8 * j; const LAS float* s = scr + (8 * c) * 33 + n;
        u32x4 o; o.x = pk2(s[0 * 33], s[1 * 33]); o.y = pk2(s[2 * 33], s[3 * 33]); o.z = pk2(s[4 * 33], s[5 * 33]); o.w = pk2(s[6 * 33], s[7 * 33]);
        *(u32x4*)(dst + (size_t)(drow0 + n + (n >= 16 ? dskip : 0)) * ldk + k0 + 8 * c) = o; }
    asm volatile("s_waitcnt lgkmcnt(0)" ::: "memory");
}
__device__ __forceinline__ void moe_convert_item(const float* __restrict__ src, int pitch  , const float* __restrict__ gain  , bf16_t* dst, int ldk, int kind  , int nrow0, LAS float* T) {
    const int tid = threadIdx.x;
#pragma unroll
    for (int i = 0; i < 8; ++i) { const int idx = tid + i * NTHR, k = idx >> 6, c4 = idx & 63;
        f32x4 v = *(const f32x4*)(src + (size_t)k * pitch + c4 * 4); if (gain) v = v * gain[k];
        LAS float* t = T + k * 257 + c4 * 4; t[0] = v[0]; t[1] = v[1]; t[2] = v[2]; t[3] = v[3]; }
    __syncthreads();
#pragma unroll
    for (int i = 0; i < 4; ++i) { const int idx = tid + i * NTHR, kc = idx & 7, n = idx >> 3;
        const LAS float* t = T + (8 * kc) * 257 + n;
        u32x4 o; o.x = pk2(t[0], t[257]); o.y = pk2(t[2 * 257], t[3 * 257]); o.z = pk2(t[4 * 257], t[5 * 257]); o.w = pk2(t[6 * 257], t[7 * 257]);
        const int row = kind == 2 ? nrow0 + n : (n >> 4) * 32 + kind * 16 + (n & 15);
        *(u32x4*)(dst + (size_t)row * ldk + 8 * kc) = o; }
    __syncthreads();
}
__device__ __forceinline__ void moe_weight_items(const float* wgate, const float* wup, const float* wdown, const float* gain, bf16_t* wgu_t, bf16_t* wd_t, LAS float* T, int bid, int nblk) {
    for (int it = bid; it < NE * 48; it += nblk) {
        const int e = it / 48, r = it % 48, which = r >> 4, q = r & 15;
        if (which < 2) moe_convert_item((which ? wup : wgate) + (size_t)e * D * DE + (size_t)q * 64 * DE, DE, gain + q * 64, wgu_t + (size_t)e * 512 * 1024 + q * 64, 1024, which, 0, T);
        else { const int kb = q >> 2, nb = q & 3;
            moe_convert_item(wdown + (size_t)e * DE * D + (size_t)kb * 64 * D + nb * 256, D, nullptr, wd_t + (size_t)e * 1024 * 256 + kb * 64, 256, 2, nb * 256, T); }
    }
}
__device__ __forceinline__ void p0_prologue(const MArgs& a, LAS unsigned char* lds, int bid, int nblk) {
    const int tid = threadIdx.x, lane = tid & 63, wave = __builtin_amdgcn_readfirstlane(tid >> 6);
    const int gw = bid * NWAVE + wave, ngw = nblk * NWAVE, gt = bid * NTHR + tid, ngt = nblk * NTHR;
    unsigned char* ws = a.ws;
    float2* cs = (float2*)(ws + WS_ROPE);
    for (int _r = 0; _r < (PROBE_PHASE == 301 ? 2 : 1); ++_r)
    for (int idx = gt; idx < LPOS * 32; idx += ngt) { const int pos = idx >> 5, i = idx & 31; const float inv = 1.0f / powf(10000.0f, (float)(2 * i) / 64.0f); float s, c; sincosf((float)pos * inv, &s, &c); cs[idx] = make_float2(c, s); }
    float* wrf = (float*)(ws + W2_WRF);
    for (int idx = gt; idx < 2 * 36 * 1024; idx += ngt) { const int l = idx / (36 * 1024), j = (idx >> 10) % 36, k = idx & 1023;
        const float g = a.in[3][l * D + k]; wrf[idx] = g * (j < 4 ? a.in[16][(size_t)l * D * 4 + k * 4 + j] : a.in[18][(size_t)l * D * 32 + k * 32 + (j - 4)]); }
    { u32x4* z = (u32x4*)(ws + W2_WIN + (size_t)416 * 1024 * 2); for (int idx = gt; idx < 96 * 1024 * 2 / 16; idx += ngt) z[idx] = (u32x4){0u, 0u, 0u, 0u}; }
    { bf16_t* kpe = (bf16_t*)(ws + WS_KPE); for (int idx = gt; idx < 2 * 48 * 32; idx += ngt) { const int b = idx / (48 * 32), r = idx % (48 * 32); kpe[((size_t)b * LP + 8208) * 32 + r] = 0; }
      bf16_t* vt0 = (bf16_t*)(ws + B_VT0); for (int idx = gt; idx < 2 * 2 * 64 * 48; idx += ngt) { const int rr = idx / 48, c = idx % 48; vt0[(size_t)rr * LP + 8208 + c] = 0; } }
    { bf16_t* hb = (bf16_t*)(ws + W2_HB); float* rstd = (float*)(ws + W2_RSTD);
      for (int _r = 0; _r < (PROBE_PHASE == 303 ? 2 : 1); ++_r)
      for (int row = gw; row < MTOT; row += ngw) {
        const float* src = row < MREAL ? a.in[0] + (size_t)row * D : a.in[1] + (size_t)row_pos(row) * D;
        float ss = 0.f;
#pragma unroll
        for (int j = 0; j < 4; ++j) { const f32x4 v = *(const f32x4*)(src + j * 256 + lane * 4); ss += v[0] * v[0] + v[1] * v[1] + v[2] * v[2] + v[3] * v[3];
            *(u32x2*)(hb + (size_t)row * D + j * 256 + lane * 4) = (u32x2){pk2(v[0], v[1]), pk2(v[2], v[3])}; }
        ss = wave_sum(ss); if (lane == 0) rstd[row] = rsqrtf(ss * (1.0f / D) + EPS);
      } }
    LAS float* scr = (LAS float*)(lds + wave * 16384);
    for (int _r = 0; _r < (PROBE_PHASE == 304 ? 2 : 1); ++_r)
    for (int it = gw; it < 2192; it += ngw) {
        int r = it;
        if (r < 640) { transpose_item(a.in[5], NQKV, a.in[2], (bf16_t*)(ws + W2_WQKV), 1024, (r % 40) * 32, (r / 40) * 64, (r % 40) * 32, scr, lane); continue; } r -= 640;
        if (r < 512) { transpose_item(a.in[8], D, nullptr, (bf16_t*)(ws + W2_WO0), 1024, (r & 31) * 32, (r >> 5) * 64, (r & 31) * 32, scr, lane); continue; } r -= 512;
        if (r < 208) { transpose_item(a.in[10], 416, a.in[2] + D, (bf16_t*)(ws + W2_WIN), 1024, (r % 13) * 32, (r / 13) * 64, (r % 13) * 32, scr, lane); continue; } r -= 208;
        if (r < 192) { transpose_item(a.in[13], 1536, a.in[11], (bf16_t*)(ws + W2_WUQ), 256, (r % 48) * 32, (r / 48) * 64, (r % 48) * 32, scr, lane); continue; } r -= 192;
        if (r < 128) { const int nb32 = r & 63, hh = nb32 >> 2, part = nb32 & 3;
            transpose_item(a.in[14], 2048, a.in[12], (bf16_t*)(ws + W2_WUKV), 128, part < 2 ? hh * 64 + part * 32 : 1024 + hh * 64 + (part - 2) * 32, (r >> 6) * 64, nb32 * 32, scr, lane); continue; } r -= 128;
        transpose_item(a.in[15], D, nullptr, (bf16_t*)(ws + W2_WO1), 1024, (r & 31) * 32, (r >> 5) * 64, (r & 31) * 32, scr, lane);
    }
    __syncthreads();
    moe_weight_items(a.in[20], a.in[21], a.in[22], a.in[3], (bf16_t*)(ws + C_W0), (bf16_t*)(ws + C_W0 + MOE_WGU_BYTES), (LAS float*)lds, bid, nblk);
}

template <bool NSW, bool HALFN, class MakeEpi>
__device__ __forceinline__ void gemm_phase(LAS unsigned char* lds, const bf16_t* A, int lda, const bf16_t* Bt, int K, int pn0, int pn1, int bid, int nblk, const MakeEpi& mk) {
    constexpr int BN = HALFN ? 128 : 256;
    const int ntn = pn1 - pn0;
    const bool grp = (nblk % 8) == 0;
    const int x = grp ? bid % 8 : 0, j = grp ? bid / 8 : bid, nslot = grp ? nblk / 8 : nblk, pmg = grp ? 8 : 64;
    for (int u = j; u < pmg * ntn; u += nslot) {
        const int pm = x * pmg + u / ntn, pn = pn0 + u % ntn;
        RowDense ra{A, lda, pm * 256, MTOT - 1}; auto e = mk(pm * 256, pn * BN);
        if (HALFN) gemm_tile<4, 4, 4, 2, NSW>(lds, ra, Bt + (size_t)pn * BN * K, K, K / 32, e);
        else gemm_tile<8, 4, 2, 4, NSW>(lds, ra, Bt + (size_t)pn * BN * K, K, K / 32, e);
    }
    const int nfull = (pmg * ntn + nslot - 1) / nslot;
    for (int pn = pn0; pn < pn1; ++pn) {
        const int owner = (pn - pn0) * 37 % nblk;
        if (bid == owner) { RowDense ra{A, lda, MREAL, MTOT - 1}; auto e = mk(MREAL, pn * BN);
            if (HALFN) gemm_tile<1, 4, 4, 2, NSW>(lds, ra, Bt + (size_t)pn * BN * K, K, K / 32, e);
            else gemm_tile<1, 4, 2, 4, NSW>(lds, ra, Bt + (size_t)pn * BN * K, K, K / 32, e); }
    }
    (void)nfull;
}

constexpr int PH_PROLOGUE = 0, PH_QKV = 1, PH_SWA = 2, PH_OPROJ0 = 3, PH_ROUTE0 = 4, PH_MOE0 = 5, PH_COMBINE = 6, PH_WIN = 7, PH_CEPI = 8, PH_UQKV = 9, PH_MLA = 10, PH_OPROJ1 = 11, PH_ROUTE1 = 12, PH_MOE1 = 13, PH_FINAL = 14, PH_N = 15;
__global__ void __launch_bounds__(NTHR, 2) mega(MArgs a) {
    extern __shared__ __attribute__((aligned(16))) unsigned char lds_raw[];
    LAS unsigned char* lds = (LAS unsigned char*)lds_raw;
    const int tid = threadIdx.x, bid = blockIdx.x, nblk = gridDim.x;
    volatile LAS unsigned* misc = (volatile LAS unsigned*)(lds + LDS_MISC);
    if (tid < 64) misc[tid] = 0u;
    __syncthreads();
    unsigned char* ws = a.ws;
    XcdBarrier bar = xcd_barrier_post((unsigned*)(ws + WS_BAR) + a.li * XCD_BAR_WORDS, misc);
    const int lo = a.ph_lo, hi = a.ph_hi;
#define IN(k) (lo <= (k) && (k) < hi)
#define REP(k) for (int _rep = 0; _rep < ((k) == PROBE_PHASE ? 2 : 1); ++_rep, (void)((k) == PROBE_PHASE && _rep == 1 ? (xcd_barrier(bar), 0) : 0))
#define STAMP(i) do { if (PROBE_PHASE >= 600 && bid == 0 && tid == 0) ((unsigned long long*)(ws + 512 * 1024))[i] = __builtin_amdgcn_s_memrealtime(); } while (0)
#define SEAM(k) do { if (IN(k) && IN((k) + 1)) xcd_barrier(bar); STAMP((k) + 1); } while (0)
    STAMP(0);
    if (PROBE_PHASE == 200) { for (int i = 0; i < 10; ++i) xcd_barrier(bar); }
    if (IN(PH_PROLOGUE)) REP(PH_PROLOGUE) p0_prologue(a, lds, bid, nblk);
    SEAM(PH_PROLOGUE);
    if (IN(PH_QKV)) REP(PH_QKV) {
        const float* rstd = (const float*)(ws + W2_RSTD); const float* bias = a.in[6]; const float2* cs = (const float2*)(ws + WS_ROPE); bf16_t* qkv = (bf16_t*)(ws + B_QKV); bf16_t* vt0 = (bf16_t*)(ws + B_VT0);
        const bf16_t* hbA = (const bf16_t*)(ws + W2_HB); const bf16_t* Wt = (const bf16_t*)(ws + W2_WQKV);
        const bool grp = (nblk % 8) == 0; const int x = grp ? bid % 8 : 0, j = grp ? bid / 8 : bid, nslot = grp ? nblk / 8 : nblk, pmg = grp ? 8 : 64;
        for (int u = j; u < pmg * 6; u += nslot) {
            if (u < pmg * 4) { const int pm = x * pmg + (u >> 2), pn = u & 3; RowDense ra{hbA, D, pm * 256, MTOT - 1}; EpiQKV e{rstd, bias, cs, qkv, pm * 256, pn * 256};
                gemm_tile<8, 4, 2, 4, false>(lds, ra, Wt + (size_t)pn * 256 * D, D, D / 32, e);
            } else if (u < pmg * 5) { const int pm = x * pmg + (u - pmg * 4); RowDense ra{hbA, D, pm * 256, MTOT - 1}; EpiQKV e{rstd, bias, cs, qkv, pm * 256, 1024};
                gemm_tile<4, 4, 4, 2, false>(lds, ra, Wt + (size_t)1024 * D, D, D / 32, e);
            } else { const int pm = x * pmg + (u - pmg * 5); RowDense ra{hbA, D, pm * 256, MTOT - 1}; EpiV0 e{rstd, bias, vt0, pm * 256, 1152};
                gemm_tile<4, 4, 4, 2, true>(lds, ra, Wt + (size_t)1152 * D, D, D / 32, e);
            }
        }
        const int mu = bid - (nblk - 6);
        if (mu >= 0 && mu < 4) { RowDense ra{hbA, D, MREAL, MTOT - 1}; EpiQKV e{rstd, bias, cs, qkv, MREAL, mu * 256};
            gemm_tile<1, 4, 2, 4, false>(lds, ra, Wt + (size_t)mu * 256 * D, D, D / 32, e);
        } else if (mu == 4) { RowDense ra{hbA, D, MREAL, MTOT - 1}; EpiQKV e{rstd, bias, cs, qkv, MREAL, 1024};
            gemm_tile<1, 4, 4, 2, false>(lds, ra, Wt + (size_t)1024 * D, D, D / 32, e);
        } else if (mu == 5) { RowDense ra{hbA, D, MREAL, MTOT - 1}; EpiV0 e{rstd, bias, vt0, MREAL, 1152};
            gemm_tile<1, 4, 4, 2, true>(lds, ra, Wt + (size_t)1152 * D, D, D / 32, e);
        }
    }
    SEAM(PH_QKV);
    if (IN(PH_SWA)) REP(PH_SWA) swa_phase(lds, (const bf16_t*)(ws + B_QKV), (const bf16_t*)(ws + B_VT0), a.in[7], (bf16_t*)(ws + B_O0), bid, nblk);
    SEAM(PH_SWA);
    if (IN(PH_OPROJ0)) REP(PH_OPROJ0) {
        const float* bias = a.in[9]; bf16_t* hb = (bf16_t*)(ws + W2_HB);
        gemm_phase<false, false>(lds, (const bf16_t*)(ws + B_O0), D, (const bf16_t*)(ws + W2_WO0), D, 0, 4, bid, nblk, [=](int m0, int n0) { return EpiRes{bias, hb, m0, n0}; });
    }
    SEAM(PH_OPROJ0);
    if (IN(PH_ROUTE0) && PROBE_PHASE == PH_ROUTE0) { route_phase(lds, (const bf16_t*)(ws + W2_HB), (const float*)(ws + W2_WRF), a.in[17], a.in[19], (float*)(ws + W2_RSTD), (int*)(ws + WS_CTL) + 4096,
                    (int*)(ws + W2_LIST), (float*)(ws + W2_WSLOT), bid, nblk); xcd_barrier(bar); }
    if (IN(PH_ROUTE0))
        route_phase(lds, (const bf16_t*)(ws + W2_HB), (const float*)(ws + W2_WRF), a.in[17], a.in[19], (float*)(ws + W2_RSTD), (int*)(ws + WS_CTL),
                    (int*)(ws + W2_LIST), (float*)(ws + W2_WSLOT), bid, nblk);
    SEAM(PH_ROUTE0);
    if (IN(PH_MOE0)) REP(PH_MOE0) moe_phase(lds, (int*)(ws + WS_CTL), (const int*)(ws + W2_LIST), (const bf16_t*)(ws + W2_HB), (const float*)(ws + W2_RSTD), (const float*)(ws + W2_WSLOT),
                               (const bf16_t*)(ws + C_W0), (const bf16_t*)(ws + C_W0 + MOE_WGU_BYTES), (bf16_t*)(ws + B_Y0), bid, nblk);
    SEAM(PH_MOE0);
    if (IN(PH_COMBINE)) REP(PH_COMBINE) combine_phase((bf16_t*)(ws + W2_HB), (const bf16_t*)(ws + B_Y0), (float*)(ws + W2_RSTD), bid, nblk);
    SEAM(PH_COMBINE);
    if (IN(PH_WIN)) REP(PH_WIN) {
        const float* rstd = (const float*)(ws + W2_RSTD); float* cbuf = (float*)(ws + B_CBUF);
        gemm_phase<false, true>(lds, (const bf16_t*)(ws + W2_HB), D, (const bf16_t*)(ws + W2_WIN), D, 0, 4, bid, nblk, [=](int m0, int n0) { return EpiWin{rstd, cbuf, m0, n0}; });
    }
    SEAM(PH_WIN);
    if (IN(PH_CEPI)) REP(PH_CEPI) cepi_phase((const float*)(ws + B_CBUF), (const float2*)(ws + WS_ROPE), (bf16_t*)(ws + B_CQN), (bf16_t*)(ws + B_CKVN), (bf16_t*)(ws + WS_KPE), bid, nblk);
    SEAM(PH_CEPI);
    if (IN(PH_UQKV)) REP(PH_UQKV) {
        const float2* cs = (const float2*)(ws + WS_ROPE); bf16_t* Q1 = (bf16_t*)(ws + C_Q1); bf16_t* K1 = (bf16_t*)(ws + C_K1); bf16_t* V1 = (bf16_t*)(ws + C_V1);
        { const int gt = bid * NTHR + tid, ngt = nblk * NTHR;
          for (int idx = gt; idx < 2 * 48 * 1024; idx += ngt) { const int b = idx / (48 * 1024), r = idx % (48 * 1024); K1[((size_t)b * LP + 8208) * 1024 + r] = 0; }
          for (int idx = gt; idx < 2 * 16 * 64 * 48; idx += ngt) { const int rr = idx / 48, c = idx % 48; V1[(size_t)rr * LP + 8208 + c] = 0; } }
        gemm_phase<false, false>(lds, (const bf16_t*)(ws + B_CQN), 256, (const bf16_t*)(ws + W2_WUQ), 256, 0, 6, bid, nblk, [=](int m0, int n0) { return EpiUQ{cs, Q1, m0, n0}; });
        gemm_phase<false, false>(lds, (const bf16_t*)(ws + B_CKVN), 128, (const bf16_t*)(ws + W2_WUKV), 128, 0, 4, bid, nblk, [=](int m0, int n0) { return EpiK1{K1, m0, n0}; });
        gemm_phase<true, false>(lds, (const bf16_t*)(ws + B_CKVN), 128, (const bf16_t*)(ws + W2_WUKV), 128, 4, 8, bid, nblk, [=](int m0, int n0) { return EpiV1{V1, m0, n0}; });
    }
    SEAM(PH_UQKV);
    if (IN(PH_MLA)) REP(100) {
        moe_weight_items(a.in[20] + (size_t)NE * D * DE, a.in[21] + (size_t)NE * D * DE, a.in[22] + (size_t)NE * DE * D, a.in[3] + D, (bf16_t*)(ws + B_W1), (bf16_t*)(ws + B_W1 + MOE_WGU_BYTES),
                         (LAS float*)lds, bid, nblk);
    }
    if (IN(PH_MLA)) REP(PH_MLA) mla_phase(lds, (const bf16_t*)(ws + C_Q1), (const bf16_t*)(ws + C_K1), (const bf16_t*)(ws + WS_KPE), (const bf16_t*)(ws + C_V1), (bf16_t*)(ws + B_O1), bid, nblk);
    SEAM(PH_MLA);
    if (IN(PH_OPROJ1)) REP(PH_OPROJ1) {
        bf16_t* hb = (bf16_t*)(ws + W2_HB);
        gemm_phase<false, false>(lds, (const bf16_t*)(ws + B_O1), D, (const bf16_t*)(ws + W2_WO1), D, 0, 4, bid, nblk, [=](int m0, int n0) { return EpiRes{nullptr, hb, m0, n0}; });
    }
    SEAM(PH_OPROJ1);
    if (IN(PH_ROUTE1))
        route_phase(lds, (const bf16_t*)(ws + W2_HB), (const float*)(ws + W2_WRF) + 36 * 1024, a.in[17] + 4, a.in[19] + 32, (float*)(ws + W2_RSTD), (int*)(ws + WS_CTL) + 2048,
                    (int*)(ws + W2_LIST), (float*)(ws + W2_WSLOT), bid, nblk);
    SEAM(PH_ROUTE1);
    if (IN(PH_MOE1)) REP(PH_MOE1) moe_phase(lds, (int*)(ws + WS_CTL) + 2048, (const int*)(ws + W2_LIST), (const bf16_t*)(ws + W2_HB), (const float*)(ws + W2_RSTD), (const float*)(ws + W2_WSLOT),
                               (const bf16_t*)(ws + B_W1), (const bf16_t*)(ws + B_W1 + MOE_WGU_BYTES), (bf16_t*)(ws + C_Y1), bid, nblk);
    SEAM(PH_MOE1);
    if (IN(PH_FINAL)) REP(PH_FINAL) final_phase((const bf16_t*)(ws + W2_HB), (const bf16_t*)(ws + C_Y1), a.in[4], a.out, bid, nblk);
    if (PROBE_PHASE == 501) { xcd_barrier(bar);
        for (int i = 0; i < 4; ++i) gemm_phase<false, false>(lds, (const bf16_t*)(ws + B_O1), D, (const bf16_t*)(ws + W2_WO1), D, 0, 4, bid, nblk, [=](int m0, int n0) { return EpiNull{m0, n0}; }); }
    if (PROBE_PHASE == 503) { xcd_barrier(bar); }
    if (PROBE_PHASE >= 600) { STAMP(PH_N);
        if (bid == 0 && tid == 0) { const unsigned long long* ts = (const unsigned long long*)(ws + 512 * 1024);
            const unsigned long long d = __hip_atomic_load(ts + (PROBE_PHASE - 600 + 1), __ATOMIC_RELAXED, __HIP_MEMORY_SCOPE_AGENT) - __hip_atomic_load(ts + (PROBE_PHASE - 600), __ATOMIC_RELAXED, __HIP_MEMORY_SCOPE_AGENT);
            const unsigned long long t0 = __builtin_amdgcn_s_memrealtime();
            while (__builtin_amdgcn_s_memrealtime() - t0 < 8ull * d) __builtin_amdgcn_s_sleep(8); } }
#undef IN
#undef SEAM
}

static void run_mega(hipStream_t s, const MArgs& base, int lo, int hi, int grid) {
    MArgs a = base; a.ph_lo = lo; a.ph_hi = hi; a.li = lo;
    hipLaunchKernelGGL(mega, dim3(grid), dim3(NTHR), LDS_BYTES, s, a);
}
extern "C" void kernel_launch(void* const* d_in, const int* in_sizes, int n_in, void* d_out, int out_size, void* d_ws, size_t ws_size, hipStream_t stream) {
    static int grid = 0;
    if (grid == 0) {
        if (n_in != 23 || ws_size < WS_END) { fprintf(stderr, "kernel_launch: unexpected n_in %d or ws_size %zu\n", n_in, ws_size); grid = -1; return; }
        if (hipFuncSetAttribute((const void*)mega, hipFuncAttributeMaxDynamicSharedMemorySize, LDS_BYTES) != hipSuccess) { fprintf(stderr, "hipFuncSetAttribute failed\n"); grid = -1; return; }
        int dev = 0, cus = 0, per_cu = 0;
        (void)hipGetDevice(&dev); (void)hipDeviceGetAttribute(&cus, hipDeviceAttributeMultiprocessorCount, dev);
        (void)hipOccupancyMaxActiveBlocksPerMultiprocessor(&per_cu, (const void*)mega, NTHR, LDS_BYTES);
        if (per_cu < 1) { fprintf(stderr, "occupancy query says %d blocks/CU\n", per_cu); }
        (void)hipGetLastError();
        grid = cus;
    }
    if (grid < 0) return;
    (void)in_sizes; (void)out_size;
    unsigned char* ws = (unsigned char*)d_ws;
    MArgs base{}; for (int i = 0; i < 23; ++i) base.in[i] = (const float*)d_in[i]; base.out = (float*)d_out; base.ws = ws;
    (void)hipMemsetAsync(ws + WS_CTL, 0, 1 * MiB, stream);
    run_mega(stream, base, 0, PH_N, grid);
}
```

```cpp
#include <hip/hip_runtime.h>
#ifndef PROBE_PHASE
#define PROBE_PHASE -1
#endif
#include <cstdio>
#include <cstdint>

typedef unsigned short bf16_t;

constexpr int D = 1024, SEQ = 8192, NB = 2, NMETA = 16;
constexpr int MREAL = NB * SEQ;
constexpr int MTOT = MREAL + NB * NMETA;
constexpr int LPOS = NMETA + SEQ;
constexpr int NQKV = 1280;
constexpr int NE = 32, DE = 256;
constexpr int CAP = MTOT * 2;
constexpr float EPS = 1e-6f;

__device__ __forceinline__ float bf2f(bf16_t v) { return __uint_as_float(((unsigned)v) << 16); }
__device__ __forceinline__ bf16_t f2bf(float f) { unsigned u = __float_as_uint(f); u += 0x7fffu + ((u >> 16) & 1u); return (bf16_t)(u >> 16); }
__device__ __forceinline__ int row_pos(int row) { return row < MREAL ? NMETA + (row & (SEQ - 1)) : ((row - MREAL) & (NMETA - 1)); }
__device__ __forceinline__ int row_batch(int row) { return row < MREAL ? (row >> 13) : ((row - MREAL) >> 4); }
constexpr int LP = 8256;
__device__ __forceinline__ int perm16(int p) { const int qd = (p >> 2) & 3; return (p & ~12) | ((((qd & 1) << 1) | (qd >> 1)) << 2); }
__device__ __forceinline__ float wave_sum(float v) {
#pragma unroll
    for (int o = 1; o < 64; o <<= 1) v += __shfl_xor(v, o);
    return v;
}

constexpr size_t MiB = 1u << 20;
constexpr size_t WS_CTL = 0;
constexpr size_t WS_ROPE = 1 * MiB;
constexpr size_t WS_END = 256 * MiB;

#define LAS __attribute__((address_space(3)))
#define GAS __attribute__((address_space(1)))
typedef short bf16x8 __attribute__((ext_vector_type(8)));
typedef float f32x4 __attribute__((ext_vector_type(4)));
typedef unsigned u32x4 __attribute__((ext_vector_type(4)));
typedef unsigned u32x2 __attribute__((ext_vector_type(2)));
constexpr int NTHR = 512, NWAVE = 8;
constexpr int LDS_MISC = 162816;
constexpr int LDS_BYTES = LDS_MISC + 1024;

constexpr size_t WS_BAR = 64 * 1024;
constexpr size_t WS_KPE = 3 * MiB + 256 * 1024;
constexpr size_t W2_RSTD = 4 * MiB + 512 * 1024, W2_WSLOT = W2_RSTD + 80 * 1024, W2_EID = W2_WSLOT + 144 * 1024;
constexpr size_t W2_LIST = 5 * MiB;
constexpr size_t W2_WRF = 9 * MiB + 256 * 1024;
constexpr size_t W2_WQKV = 10 * MiB;
constexpr size_t W2_WO0 = W2_WQKV + 2560 * 1024;
constexpr size_t W2_WIN = W2_WO0 + 2048 * 1024;
constexpr size_t W2_WUQ = W2_WIN + 1024 * 1024;
constexpr size_t W2_WUKV = W2_WUQ + 768 * 1024;
constexpr size_t W2_WO1 = W2_WUKV + 512 * 1024;
constexpr size_t W2_HB = 20 * MiB;
constexpr size_t W2_RB = 53 * MiB;
constexpr size_t W2_RC = 134 * MiB;
static_assert(W2_EID + (size_t)MTOT * 8 <= W2_LIST && W2_LIST + (size_t)NE * CAP * 4 <= W2_WRF && W2_WO1 + 2 * MiB <= W2_HB && W2_HB + (size_t)MTOT * 2048 <= W2_RB, "fixed map");
constexpr size_t B_QKV = W2_RB, B_O0 = W2_RB + 41 * MiB, B_VT0 = W2_RB + 74 * MiB  , B_Y0 = W2_RB, B_CBUF = W2_RB, B_CQN = W2_RB + 33 * MiB, B_CKVN = W2_RB + 42 * MiB, B_O1 = W2_RB, B_W1 = W2_RB + 33 * MiB;
constexpr size_t C_W0 = W2_RC, C_HF = W2_RC + 48 * MiB, C_Q1 = W2_RC, C_K1 = W2_RC + 49 * MiB, C_V1 = W2_RC + 82 * MiB, C_HF1 = W2_RC, C_Y1 = W2_RC;
static_assert(C_V1 + (size_t)2 * 16 * 64 * LP * 2 <= WS_END && C_K1 + (size_t)2 * LP * 2048 <= C_V1 && B_VT0 + (size_t)2 * 2 * 64 * LP * 2 <= W2_RC && C_HF + (size_t)MTOT * 4096 <= WS_END && B_W1 + 48 * MiB <= W2_RC, "region map");
constexpr size_t MOE_WGU_BYTES = (size_t)NE * 512 * 1024 * 2, MOE_WD_BYTES = (size_t)NE * 1024 * 256 * 2;

struct MArgs { const float* in[23]; float* out; unsigned char* ws; int ph_lo, ph_hi, li, pad; };

__device__ __forceinline__ unsigned pk2(float lo, float hi) { return (unsigned)f2bf(lo) | ((unsigned)f2bf(hi) << 16); }

#define XB_TMO      128
#define XB_XCNT(j)  (256  + 64 * (j))
#define XB_XSUB(j)  (1280 + 64 * (j))
#define XB_XGEN(j)  (2304 + 64 * (j))
#define XB_TOP      3328
#define XB_TOPGEN   3392
#define XCD_BAR_WORDS 3456
#define XB_SPIN_CAP (1u << 18)
__device__ __forceinline__ unsigned xb_ld(unsigned* p)              { return __hip_atomic_load(p, __ATOMIC_RELAXED, __HIP_MEMORY_SCOPE_AGENT); }
__device__ __forceinline__ unsigned xb_add(unsigned* p, unsigned v) { return __hip_atomic_fetch_add(p, v, __ATOMIC_RELAXED, __HIP_MEMORY_SCOPE_AGENT); }
__device__ __forceinline__ unsigned xb_xcc_id() { return (unsigned)__builtin_amdgcn_s_getreg((3 << 11) | 20) & 0xFu; }
#define XB_SPIN(cond, bar) do { unsigned _sp = 0; while (cond) { __builtin_amdgcn_s_sleep(1); \
    if ((++_sp & 255u) == 0u) { if (xb_ld(&(bar)[XB_TMO])) break; if (_sp > XB_SPIN_CAP) { atomicAdd(&(bar)[XB_TMO], 1u); break; } } } } while (0)
struct XcdBarrier { unsigned* bar; unsigned x; volatile LAS unsigned* st; };
__device__ __forceinline__ XcdBarrier xcd_barrier_post(unsigned* bar, volatile LAS unsigned* st) {
    XcdBarrier b; b.bar = bar; b.x = xb_xcc_id(); b.st = st;
    if (threadIdx.x == 0) (void)xb_add(&bar[XB_XCNT(b.x)], 1u);
    return b;
}
__device__ __forceinline__ void xcd_barrier_complete(unsigned* bar, unsigned x, unsigned& nloc, unsigned& nx) {
    const unsigned G = gridDim.x * gridDim.y * gridDim.z;
    unsigned sum, cnt, mine, sp = 0u;
    for (;;) {
        sum = 0u; cnt = 0u; mine = 0u;
#pragma unroll
        for (unsigned j = 0; j < 16; ++j) { const unsigned c = xb_ld(&bar[XB_XCNT(j)]); sum += c; cnt += (c > 0u) ? 1u : 0u; mine = (j == x) ? c : mine; }
        if (sum == G) break;
        __builtin_amdgcn_s_sleep(1);
        if ((++sp & 255u) == 0u) { if (xb_ld(&bar[XB_TMO])) break; if (sp > XB_SPIN_CAP) { atomicAdd(&bar[XB_TMO], 1u); break; } }
    }
    nloc = mine > 0u ? mine : 1u; nx = cnt > 0u ? cnt : 1u;
}
__device__ __forceinline__ void xcd_barrier(const XcdBarrier& b) {
    asm volatile("s_waitcnt vmcnt(0)" ::: "memory");
    __syncthreads();
    if (threadIdx.x == 0) {
        unsigned* bar = b.bar;
        __builtin_amdgcn_s_waitcnt(0);
        unsigned nloc = b.st[0], nx = b.st[1];
        if (nloc == 0u) { xcd_barrier_complete(bar, b.x, nloc, nx); b.st[0] = nloc; b.st[1] = nx; }
        const unsigned old = xb_add(&bar[XB_XSUB(b.x)], 1u);
        const unsigned gen = old / nloc;
        if (old + 1u == (gen + 1u) * nloc) {
            __builtin_amdgcn_fence(__ATOMIC_RELEASE, "agent");
            asm volatile("s_waitcnt vmcnt(0)" ::: "memory");
            const unsigned og = xb_add(&bar[XB_TOP], 1u);
            const unsigned tg = og / nx;
            if (og + 1u == (tg + 1u) * nx) xb_add(&bar[XB_TOPGEN], 1u);
            else XB_SPIN(xb_ld(&bar[XB_TOPGEN]) == tg, bar);
            __builtin_amdgcn_fence(__ATOMIC_ACQUIRE, "agent");
            xb_add(&bar[XB_XGEN(b.x)], 1u);
            asm volatile("s_waitcnt vmcnt(0)" ::: "memory");
        } else {
            XB_SPIN(xb_ld(&bar[XB_XGEN(b.x)]) == gen, bar);
            __builtin_amdgcn_fence(__ATOMIC_ACQUIRE, "agent");
            asm volatile("s_waitcnt vmcnt(0)" ::: "memory");
        }
    }
    __syncthreads();
}

template <int N> __device__ __forceinline__ void wait_vm() { asm volatile("s_waitcnt vmcnt(%0)" :: "n"(N) : "memory"); }
__device__ __forceinline__ int swzF(int g) { return (0x78 >> (2 * g)) & 3; }
constexpr int GT_NS = 4;
template <int MT, int NT, int WM, int WN, bool NSW, class RowA, class Epi, bool NOLD = false>
__device__ __forceinline__ void gemm_tile(LAS unsigned char* lds, const RowA& rowA, const bf16_t* __restrict__ Bt, int ldb  , int nk  , Epi& epi) {
    constexpr int BM = WM * MT * 16, BN = WN * NT * 16, GA = BM / 16, G = (BM + BN) / 16, NG = (G + 7) / 8, GR = G % 8, STAGE = (BM + BN) * 64;
    static_assert(WM * WN == 8 && GT_NS * STAGE <= LDS_MISC && BM % 16 == 0 && BN % 16 == 0, "gemm_tile config");
    const int tid = threadIdx.x, lane = tid & 63, wave = __builtin_amdgcn_readfirstlane(tid >> 6), wm = wave / WN, wn = wave % WN;
    const char* src[NG];
    const int lc = (lane & 3) ^ swzF(lane >> 4);
#pragma unroll
    for (int i = 0; i < NG; ++i) {
        const int g = wave + 8 * i;
        if (g < GA) src[i] = (const char*)rowA(g * 16 + (lane >> 2)) + lc * 16;
        else if (g < G) src[i] = (const char*)(Bt + (size_t)((g - GA) * 16 + (lane >> 2)) * ldb) + lc * 16;
        else src[i] = nullptr;
    }
    f32x4 acc[MT][NT];
#pragma unroll
    for (int mi = 0; mi < MT; ++mi)
#pragma unroll
        for (int ni = 0; ni < NT; ++ni) acc[mi][ni] = (f32x4){0.f, 0.f, 0.f, 0.f};
    const int fro = (lane & 15) * 64 + (((lane >> 4) ^ swzF((lane >> 2) & 3)) << 4);
    constexpr int LM = PROBE_PHASE == 402 ? 2 : 1;
#define GT_STAGE(st, kt) do { _Pragma("unroll") for (int _i = 0; _i < NG; ++_i) { const int _g = wave + 8 * _i; if (_g < G) { \
        __builtin_amdgcn_global_load_lds((const unsigned*)(src[_i] + (size_t)(kt) * 64), (LAS unsigned*)(lds + (st) * STAGE + _g * 1024), 16, 0, 0); \
        if (LM == 2) __builtin_amdgcn_global_load_lds((const unsigned*)(src[_i] + (size_t)(kt) * 64), (LAS unsigned*)(lds + (st) * STAGE + _g * 1024), 16, 0, 0); } } } while (0)
#define GT_WAIT(ntl) do { if (GR == 0 || wave < GR) wait_vm<LM * NG * (ntl)>(); else wait_vm<LM * (NG - 1) * (ntl)>(); } while (0)
    if (!NOLD) { GT_STAGE(0, 0);
    if (nk > 1) GT_STAGE(1, 1);
    if (nk > 2) GT_STAGE(2, 2); }
    int st = 0;
    for (int kt = 0; kt < nk; ++kt) {
        const int rem = nk - 1 - kt;
        if (!NOLD) { if (rem >= 2) GT_WAIT(2); else if (rem == 1) GT_WAIT(1); else GT_WAIT(0); }
        __builtin_amdgcn_s_barrier(); asm volatile("" ::: "memory");
        const bool doload = (!NOLD || PROBE_PHASE == 505) && kt + 3 < nk;
        LAS const unsigned char* sa = lds + st * STAGE + (wm * MT * 16) * 64 + fro;
        LAS const unsigned char* sb = lds + st * STAGE + (BM + wn * NT * 16) * 64 + fro;
        bf16x8 bfr[NT];
#pragma unroll
        for (int ni = 0; ni < NT; ++ni) bfr[ni] = *(LAS const bf16x8*)(sb + ni * 1024);
        constexpr int PG = MT >= 2 ? 2 : 1, NPG = MT / PG;
        constexpr int LPG = (NG + NPG - 1) / NPG;
        bf16x8 afc[PG], afn[PG];
#pragma unroll
        for (int i = 0; i < PG; ++i) afc[i] = *(LAS const bf16x8*)(sa + i * 1024);
#pragma unroll
        for (int pg = 0; pg < NPG; ++pg) {
            if (doload) {
#pragma unroll
                for (int l = 0; l < LPG; ++l) { const int _i = pg * LPG + l; if (_i < NG) { const int _g = wave + 8 * _i; if (_g < G)
                    __builtin_amdgcn_global_load_lds((const unsigned*)(src[_i] + (size_t)(kt + 3) * 64), (LAS unsigned*)(lds + ((st + 3) & 3) * STAGE + _g * 1024), 16, 0, 0); } }
            }
            if (pg + 1 < NPG) {
#pragma unroll
                for (int i = 0; i < PG; ++i) afn[i] = *(LAS const bf16x8*)(sa + ((pg + 1) * PG + i) * 1024);
            }
#pragma unroll
            for (int i = 0; i < PG; ++i) { const int mi = pg * PG + i;
#pragma unroll
                for (int ni = 0; ni < NT; ++ni) {
                    if (NSW) acc[mi][ni] = __builtin_amdgcn_mfma_f32_16x16x32_bf16(afc[i], bfr[ni], acc[mi][ni], 0, 0, 0);
                    else acc[mi][ni] = __builtin_amdgcn_mfma_f32_16x16x32_bf16(bfr[ni], afc[i], acc[mi][ni], 0, 0, 0);
                } }
#pragma unroll
            for (int i = 0; i < PG; ++i) afc[i] = afn[i];
            __builtin_amdgcn_sched_barrier(0);
        }
        st = (st + 1) & 3;
    }
#undef GT_STAGE
#undef GT_WAIT
    epi(acc, wm * MT * 16, wn * NT * 16, lane);
    asm volatile("s_waitcnt lgkmcnt(0)" ::: "memory");
    __syncthreads();
}

struct RowDense { const bf16_t* A; int lda, m0, mlast; __device__ __forceinline__ const bf16_t* operator()(int r) const { int row = m0 + r; row = row > mlast ? mlast : row; return A + (size_t)row * lda; } };

struct EpiQKV {
    const float* rstd; const float* bias; const float2* cs; bf16_t* qkv; int m0, n0;
    template <int MT, int NT> __device__ __forceinline__ void operator()(f32x4 (&acc)[MT][NT], int mb, int nb, int lane) const {
        static_assert(NT == 4, "rope needs a 64-column wave span");
        const int cb = n0 + nb, d0 = (lane >> 4) * 4;
#pragma unroll
        for (int mi = 0; mi < MT; ++mi) {
            const int row = m0 + mb + mi * 16 + (lane & 15);
            if (row < MTOT) {
                const float rs = rstd[row]; const int pos = row_pos(row);
                bf16_t* orow = qkv + (size_t)row * NQKV + cb;
                {
                    const float sc = cb < 1024 ? 0.125f : 1.0f;
#pragma unroll
                    for (int ni = 0; ni < 2; ++ni) {
                        const int d = ni * 16 + d0;
                        const f32x4 b1 = *(const f32x4*)(bias + cb + d), b2 = *(const f32x4*)(bias + cb + 32 + d);
                        float o1[4], o2[4];
#pragma unroll
                        for (int r = 0; r < 4; ++r) {
                            const float2 t = cs[pos * 32 + d + r];
                            const float x1 = acc[mi][ni][r] * rs + b1[r], x2 = acc[mi][ni + 2][r] * rs + b2[r];
                            o1[r] = (x1 * t.x - x2 * t.y) * sc; o2[r] = (x2 * t.x + x1 * t.y) * sc;
                        }
                        *(u32x2*)(orow + d) = (u32x2){pk2(o1[0], o1[1]), pk2(o1[2], o1[3])};
                        *(u32x2*)(orow + 32 + d) = (u32x2){pk2(o2[0], o2[1]), pk2(o2[2], o2[3])};
                    }
                }
            }
        }
    }
};
struct EpiV0 {
    const float* rstd; const float* bias; bf16_t* vt0; int m0, n0;
    template <int MT, int NT> __device__ __forceinline__ void operator()(f32x4 (&acc)[MT][NT], int mb, int nb, int lane) const {
        static_assert(NT == 4, "64-column wave span");
        const int cb = n0 + nb, kh = (cb - 1152) >> 6;
#pragma unroll
        for (int mi = 0; mi < MT; ++mi) {
            const int row0 = m0 + mb + mi * 16 + (lane >> 4) * 4;
            if (row0 < MTOT) {
                const f32x4 rs = *(const f32x4*)(rstd + row0); const int b = row_batch(row0), pp = perm16(row_pos(row0));
#pragma unroll
                for (int ni = 0; ni < NT; ++ni) { const int d = ni * 16 + (lane & 15); const float bb = bias[cb + d];
                    const f32x4 v = acc[mi][ni] * rs + bb;
                    *(u32x2*)(vt0 + (size_t)((b * 2 + kh) * 64 + d) * LP + pp) = (u32x2){pk2(v[0], v[1]), pk2(v[2], v[3])}; }
            }
        }
    }
};
struct EpiRes {
    const float* bias; bf16_t* hb; int m0, n0;
    template <int MT, int NT> __device__ __forceinline__ void operator()(f32x4 (&acc)[MT][NT], int mb, int nb, int lane) const {
#pragma unroll
        for (int mi = 0; mi < MT; ++mi) {
            const int row = m0 + mb + mi * 16 + (lane & 15);
            if (row < MTOT) {
#pragma unroll
                for (int ni = 0; ni < NT; ++ni) {
                    const int col = n0 + nb + ni * 16 + (lane >> 4) * 4;
                    u32x2* p = (u32x2*)(hb + (size_t)row * D + col);
                    const u32x2 h = *p;
                    f32x4 v = acc[mi][ni];
                    if (bias) v += *(const f32x4*)(bias + col);
                    v[0] += __uint_as_float(h.x << 16); v[1] += __uint_as_float(h.x & 0xffff0000u); v[2] += __uint_as_float(h.y << 16); v[3] += __uint_as_float(h.y & 0xffff0000u);
                    *p = (u32x2){pk2(v[0], v[1]), pk2(v[2], v[3])};
                }
            }
        }
    }
};
struct EpiWin {
    const float* rstd; float* cbuf; int m0, n0;
    template <int MT, int NT> __device__ __forceinline__ void operator()(f32x4 (&acc)[MT][NT], int mb, int nb, int lane) const {
#pragma unroll
        for (int mi = 0; mi < MT; ++mi) {
            const int row = m0 + mb + mi * 16 + (lane & 15);
            if (row < MTOT) { const float rs = rstd[row];
#pragma unroll
                for (int ni = 0; ni < NT; ++ni) *(f32x4*)(cbuf + (size_t)row * 512 + n0 + nb + ni * 16 + (lane >> 4) * 4) = acc[mi][ni] * rs; }
        }
    }
};
struct EpiUQ {
    const float2* cs; bf16_t* Q1; int m0, n0;
    template <int MT, int NT> __device__ __forceinline__ void operator()(f32x4 (&acc)[MT][NT], int mb, int nb, int lane) const {
        static_assert(NT == 4, "rope needs whole 32-column blocks per wave");
        const float scale = 0.10206207261596577f * 1.4426950408889634f;
        const int d0 = (lane >> 4) * 4;
#pragma unroll
        for (int mi = 0; mi < MT; ++mi) {
            const int row = m0 + mb + mi * 16 + (lane & 15);
            if (row < MTOT) { const int pos = row_pos(row);
#pragma unroll
                for (int bi = 0; bi < 2; ++bi) {
                    const int gc = n0 + nb + bi * 32; bf16_t* orow = Q1 + (size_t)row * 1536 + gc;
                    f32x4 v1 = acc[mi][2 * bi], v2 = acc[mi][2 * bi + 1];
                    if (((gc >> 5) % 3) == 2) {
#pragma unroll
                        for (int r = 0; r < 4; ++r) { const float2 t = cs[pos * 32 + 2 * (d0 + r)]; const float x1 = v1[r], x2 = v2[r]; v1[r] = x1 * t.x - x2 * t.y; v2[r] = x2 * t.x + x1 * t.y; }
                    }
                    v1 = v1 * scale; v2 = v2 * scale;
                    *(u32x2*)(orow + d0) = (u32x2){pk2(v1[0], v1[1]), pk2(v1[2], v1[3])};
                    *(u32x2*)(orow + 16 + d0) = (u32x2){pk2(v2[0], v2[1]), pk2(v2[2], v2[3])};
                }
            }
        }
    }
};
struct EpiK1 {
    bf16_t* K1; int m0, n0;
    template <int MT, int NT> __device__ __forceinline__ void operator()(f32x4 (&acc)[MT][NT], int mb, int nb, int lane) const {
#pragma unroll
        for (int mi = 0; mi < MT; ++mi) {
            const int row = m0 + mb + mi * 16 + (lane & 15);
            if (row < MTOT) { const size_t kr = (size_t)row_batch(row) * LP + row_pos(row);
#pragma unroll
                for (int ni = 0; ni < NT; ++ni) { const f32x4 v = acc[mi][ni];
                    *(u32x2*)(K1 + kr * D + n0 + nb + ni * 16 + (lane >> 4) * 4) = (u32x2){pk2(v[0], v[1]), pk2(v[2], v[3])}; } }
        }
    }
};
struct EpiV1 {
    bf16_t* VT1; int m0, n0;
    template <int MT, int NT> __device__ __forceinline__ void operator()(f32x4 (&acc)[MT][NT], int mb, int nb, int lane) const {
#pragma unroll
        for (int mi = 0; mi < MT; ++mi) {
            const int row0 = m0 + mb + mi * 16 + (lane >> 4) * 4;
            if (row0 < MTOT) { const int b = row_batch(row0), pp = perm16(row_pos(row0));
#pragma unroll
                for (int ni = 0; ni < NT; ++ni) { const int hd = n0 - 1024 + nb + ni * 16 + (lane & 15); const f32x4 v = acc[mi][ni];
                    *(u32x2*)(VT1 + (size_t)(b * 1024 + hd) * LP + pp) = (u32x2){pk2(v[0], v[1]), pk2(v[2], v[3])}; } }
        }
    }
};

__device__ __forceinline__ void route_phase(LAS unsigned char* lds, const bf16_t* __restrict__ hbr, const float* __restrict__ wrf, const float* __restrict__ bg, const float* __restrict__ br,
                                            float* rstd_out, int* cnt, int* list, float* wslot, int bid, int nblk) {
    const int tid = threadIdx.x, lane = tid & 63, wave = __builtin_amdgcn_readfirstlane(tid >> 6);
    LAS f32x4* wl = (LAS f32x4*)lds;
    LAS int* nrec = (LAS int*)(lds + LDS_MISC + 16); LAS int* bcnt = (LAS int*)(lds + LDS_MISC + 32); LAS int* bbase = (LAS int*)(lds + LDS_MISC + 160); LAS int* rec = (LAS int*)(lds + LDS_MISC + 288);
    for (int i = tid; i < 36 * 256; i += NTHR) wl[i] = *(const f32x4*)(wrf + (size_t)i * 4);
    if (tid < NE) bcnt[tid] = 0;
    if (tid == 0) *nrec = 0;
    __syncthreads();
    for (int row = bid * NWAVE + wave; row < MTOT; row += nblk * NWAVE) {
        f32x4 x[4]; float ss = 0.f;
#pragma unroll
        for (int j = 0; j < 4; ++j) { const u32x2 h = *(const u32x2*)(hbr + (size_t)row * D + j * 256 + lane * 4);
            x[j] = (f32x4){__uint_as_float(h.x << 16), __uint_as_float(h.x & 0xffff0000u), __uint_as_float(h.y << 16), __uint_as_float(h.y & 0xffff0000u)};
            ss += x[j][0] * x[j][0] + x[j][1] * x[j][1] + x[j][2] * x[j][2] + x[j][3] * x[j][3]; }
        ss = wave_sum(ss);
        const float rs = rsqrtf(ss * (1.0f / D) + EPS);
        float lg[4];
#pragma unroll
        for (int c = 0; c < 4; ++c) { float p = 0.f;
#pragma unroll
            for (int j = 0; j < 4; ++j) { const f32x4 w = wl[c * 256 + j * 64 + lane]; p += x[j][0] * w[0] + x[j][1] * w[1] + x[j][2] * w[2] + x[j][3] * w[3]; }
            lg[c] = wave_sum(p) * rs + bg[c]; }
        int gi = 0; float gm = lg[0];
#pragma unroll
        for (int c = 1; c < 4; ++c) if (lg[c] > gm) { gm = lg[c]; gi = c; }
        float gs = 0.f;
#pragma unroll
        for (int c = 0; c < 4; ++c) gs += __expf(lg[c] - gm);
        const float gp = 1.0f / gs;
        gi = __builtin_amdgcn_readfirstlane(gi);
        float e[8];
#pragma unroll
        for (int c = 0; c < 8; ++c) { float p = 0.f;
#pragma unroll
            for (int j = 0; j < 4; ++j) { const f32x4 w = wl[(4 + gi * 8 + c) * 256 + j * 64 + lane]; p += x[j][0] * w[0] + x[j][1] * w[1] + x[j][2] * w[2] + x[j][3] * w[3]; }
            e[c] = wave_sum(p) * rs + br[gi * 8 + c]; }
        int i1 = 0; float v1 = e[0];
#pragma unroll
        for (int c = 1; c < 8; ++c) if (e[c] > v1) { v1 = e[c]; i1 = c; }
        int i2 = -1; float v2 = -3.0e38f;
#pragma unroll
        for (int c = 0; c < 8; ++c) if (c != i1 && e[c] > v2) { v2 = e[c]; i2 = c; }
        if (lane == 0) {
            const float r = __expf(v2 - v1);
            const float w1 = gp / (1.0f + r), w2 = gp * r / (1.0f + r);
            const int e1 = gi * 8 + i1, e2 = gi * 8 + i2;
            const int p1 = atomicAdd((int*)&bcnt[e1], 1), p2 = atomicAdd((int*)&bcnt[e2], 1);
            const int k = atomicAdd((int*)nrec, 2);
            rec[k] = ((row * 2) << 13) | (e1 << 8) | p1; rec[k + 1] = ((row * 2 + 1) << 13) | (e2 << 8) | p2;
            wslot[row * 2] = w1; wslot[row * 2 + 1] = w2; rstd_out[row] = rs;
        }
    }
    __syncthreads();
    if (tid < NE) { const int c = bcnt[tid]; bbase[tid] = c ? __hip_atomic_fetch_add(cnt + tid * 64, c, __ATOMIC_RELAXED, __HIP_MEMORY_SCOPE_AGENT) : 0; }
    __syncthreads();
    for (int k = tid; k < *nrec; k += NTHR) { const int r = rec[k], e = (r >> 8) & 31; list[(size_t)e * CAP + bbase[e] + (r & 255)] = r >> 13; }
    __syncthreads();
}
__device__ __forceinline__ void combine_phase(bf16_t* hb, const bf16_t* __restrict__ ybuf, float* rstd, int bid, int nblk) {
    const int tid = threadIdx.x, lane = tid & 63, wave = tid >> 6;
    for (int row = bid * NWAVE + wave; row < MTOT; row += nblk * NWAVE) {
        float ss = 0.f;
#pragma unroll
        for (int j = 0; j < 4; ++j) { const size_t c = j * 256 + lane * 4;
            const u32x2 h = *(const u32x2*)(hb + (size_t)row * D + c), y0 = *(const u32x2*)(ybuf + (size_t)(row * 2) * D + c), y1 = *(const u32x2*)(ybuf + (size_t)(row * 2 + 1) * D + c);
            float v[4];
            v[0] = __uint_as_float(h.x << 16) + __uint_as_float(y0.x << 16) + __uint_as_float(y1.x << 16);
            v[1] = __uint_as_float(h.x & 0xffff0000u) + __uint_as_float(y0.x & 0xffff0000u) + __uint_as_float(y1.x & 0xffff0000u);
            v[2] = __uint_as_float(h.y << 16) + __uint_as_float(y0.y << 16) + __uint_as_float(y1.y << 16);
            v[3] = __uint_as_float(h.y & 0xffff0000u) + __uint_as_float(y0.y & 0xffff0000u) + __uint_as_float(y1.y & 0xffff0000u);
            ss += v[0] * v[0] + v[1] * v[1] + v[2] * v[2] + v[3] * v[3];
            *(u32x2*)(hb + (size_t)row * D + c) = (u32x2){pk2(v[0], v[1]), pk2(v[2], v[3])}; }
        ss = wave_sum(ss); if (lane == 0) rstd[row] = rsqrtf(ss * (1.0f / D) + EPS);
    }
}
__device__ __forceinline__ void cepi_phase(const float* __restrict__ c, const float2* __restrict__ cs, bf16_t* cqn, bf16_t* ckvn, bf16_t* kpe, int bid, int nblk) {
    const int tid = threadIdx.x, lane = tid & 63, wave = tid >> 6;
    for (int row = bid * NWAVE + wave; row < MTOT; row += nblk * NWAVE) {
        const float* cr = c + (size_t)row * 512;
        const f32x4 q = *(const f32x4*)(cr + lane * 4);
        const float rq = rsqrtf(wave_sum(q[0] * q[0] + q[1] * q[1] + q[2] * q[2] + q[3] * q[3]) * (1.0f / 256) + EPS);
        *(u32x2*)(cqn + (size_t)row * 256 + lane * 4) = (u32x2){pk2(q[0] * rq, q[1] * rq), pk2(q[2] * rq, q[3] * rq)};
        const float k0 = cr[256 + lane], k1 = cr[320 + lane];
        const float rk = rsqrtf(wave_sum(k0 * k0 + k1 * k1) * (1.0f / 128) + EPS);
        ckvn[(size_t)row * 128 + lane] = f2bf(k0 * rk); ckvn[(size_t)row * 128 + 64 + lane] = f2bf(k1 * rk);
        if (lane < 32) { const int i = lane & 15; const float2 t = cs[row_pos(row) * 32 + 2 * i];
            const float x1 = cr[384 + i], x2 = cr[400 + i];
            kpe[((size_t)row_batch(row) * LP + row_pos(row)) * 32 + lane] = f2bf(lane < 16 ? x1 * t.x - x2 * t.y : x2 * t.x + x1 * t.y); }
    }
}
__device__ __forceinline__ void final_phase(const bf16_t* __restrict__ hb, const bf16_t* __restrict__ ybuf, const float* __restrict__ g, float* out, int bid, int nblk) {
    const int tid = threadIdx.x, lane = tid & 63, wave = tid >> 6;
    for (int row = bid * NWAVE + wave; row < MREAL; row += nblk * NWAVE) {
        f32x4 v[4]; float ss = 0.f;
#pragma unroll
        for (int j = 0; j < 4; ++j) { const size_t c = j * 256 + lane * 4;
            const u32x2 h = *(const u32x2*)(hb + (size_t)row * D + c), y0 = *(const u32x2*)(ybuf + (size_t)(row * 2) * D + c), y1 = *(const u32x2*)(ybuf + (size_t)(row * 2 + 1) * D + c);
            v[j][0] = __uint_as_float(h.x << 16) + __uint_as_float(y0.x << 16) + __uint_as_float(y1.x << 16);
            v[j][1] = __uint_as_float(h.x & 0xffff0000u) + __uint_as_float(y0.x & 0xffff0000u) + __uint_as_float(y1.x & 0xffff0000u);
            v[j][2] = __uint_as_float(h.y << 16) + __uint_as_float(y0.y << 16) + __uint_as_float(y1.y << 16);
            v[j][3] = __uint_as_float(h.y & 0xffff0000u) + __uint_as_float(y0.y & 0xffff0000u) + __uint_as_float(y1.y & 0xffff0000u);
            ss += v[j][0] * v[j][0] + v[j][1] * v[j][1] + v[j][2] * v[j][2] + v[j][3] * v[j][3]; }
        const float rs = rsqrtf(wave_sum(ss) * (1.0f / D) + EPS);
#pragma unroll
        for (int j = 0; j < 4; ++j) { const f32x4 gg = *(const f32x4*)(g + j * 256 + lane * 4); *(f32x4*)(out + (size_t)row * D + j * 256 + lane * 4) = v[j] * rs * gg; }
    }
}

typedef float f32x16 __attribute__((ext_vector_type(16)));
constexpr int AT_STAGE = 20480;
__device__ __forceinline__ unsigned cvtpk(float lo, float hi) { typedef float f2 __attribute__((ext_vector_type(2))); typedef __bf16 b2 __attribute__((ext_vector_type(2)));
    f2 v = {lo, hi}; b2 r = __builtin_convertvector(v, b2); return __builtin_bit_cast(unsigned, r); }
__device__ __forceinline__ void mla_unit(LAS unsigned char* lds, int b, int h, int qi, const bf16_t* __restrict__ Q1, const bf16_t* __restrict__ K1, const bf16_t* __restrict__ kpe,
                                         const bf16_t* __restrict__ VT1, bf16_t* o) {
    const int tid = threadIdx.x, lane = tid & 63, wave = __builtin_amdgcn_readfirstlane(tid >> 6), r32 = lane & 31, hi = lane >> 5;
    const size_t qrow = (size_t)b * SEQ + 256 * qi + 32 * wave + r32;
    bf16x8 qf[6];
#pragma unroll
    for (int s = 0; s < 6; ++s) qf[s] = *(const bf16x8*)(Q1 + qrow * 1536 + h * 96 + 16 * s + 8 * hi);
    const int lr = 8 * wave + (lane >> 3);
    const char* ksrc = (const char*)(K1 + ((size_t)b * LP + lr) * 1024 + h * 64) + (((lane & 7) ^ ((lr >> 1) & 7)) << 4);
    const char* vsrc = (const char*)(VT1 + ((size_t)(b * 16 + h) * 64 + lr) * LP) + (((lane & 7) ^ ((lr >> 1) & 7)) << 4);
    const int pr = 16 * wave + (lane >> 2);
    const char* psrc = (const char*)(kpe + ((size_t)b * LP + (pr & 63)) * 32) + (((lane & 3) ^ ((pr >> 2) & 3)) << 4);
#define MLA_ISSUE(j, st) do { \
        __builtin_amdgcn_global_load_lds((const unsigned*)(ksrc + (size_t)(j) * (64 * 2048)), (LAS unsigned*)(lds + (st) * AT_STAGE + wave * 1024), 16, 0, 0); \
        __builtin_amdgcn_global_load_lds((const unsigned*)(vsrc + (size_t)(j) * 128), (LAS unsigned*)(lds + (st) * AT_STAGE + 8192 + wave * 1024), 16, 0, 0); \
        if (wave < 4) __builtin_amdgcn_global_load_lds((const unsigned*)(psrc + (size_t)(j) * (64 * 64)), (LAS unsigned*)(lds + (st) * AT_STAGE + 16384 + wave * 1024), 16, 0, 0); } while (0)
    const int NT = 4 * qi + 5, jmaxw = 4 * qi + ((32 * wave + 47) >> 6);
    const int qp = 16 + 256 * qi + 32 * wave + r32;
    const int koff = r32 * 128, ksw = (r32 >> 1) & 7, poff = 16384 + r32 * 64, psw = (r32 >> 2) & 3, voff = 8192 + r32 * 128;
    f32x16 oacc[2]; oacc[0] = (f32x16){}; oacc[1] = (f32x16){};
    constexpr float MLA_THR = 8.0f;
    float mref = 0.f, lsum = 0.f;
    f32x16 negm = (f32x16){};
    MLA_ISSUE(0, 0);
    if (NT > 1) MLA_ISSUE(1, 1);
    int st = 0;
    for (int j = 0; j < NT; ++j) {
        if (j + 1 < NT) { if (wave < 4) asm volatile("s_waitcnt vmcnt(3)" ::: "memory"); else asm volatile("s_waitcnt vmcnt(2)" ::: "memory"); }
        else asm volatile("s_waitcnt vmcnt(0)" ::: "memory");
        __builtin_amdgcn_s_barrier(); asm volatile("" ::: "memory");
        if (j + 2 < NT) { const int st2 = st >= 1 ? st - 1 : 2; MLA_ISSUE(j + 2, st2); }
        if (j <= jmaxw) {
            LAS const unsigned char* sb = lds + st * AT_STAGE;
            f32x16 p0, p1;
            {
                const bf16x8 k0 = *(LAS const bf16x8*)(sb + koff + ((hi ^ ksw) << 4));
                const bf16x8 k1 = *(LAS const bf16x8*)(sb + 4096 + koff + ((hi ^ ksw) << 4));
                p0 = __builtin_amdgcn_mfma_f32_32x32x16_bf16(k0, qf[0], negm, 0, 0, 0);
                p1 = __builtin_amdgcn_mfma_f32_32x32x16_bf16(k1, qf[0], negm, 0, 0, 0);
            }
#pragma unroll
            for (int s = 1; s < 4; ++s) {
                const bf16x8 k0 = *(LAS const bf16x8*)(sb + koff + (((2 * s + hi) ^ ksw) << 4));
                const bf16x8 k1 = *(LAS const bf16x8*)(sb + 4096 + koff + (((2 * s + hi) ^ ksw) << 4));
                p0 = __builtin_amdgcn_mfma_f32_32x32x16_bf16(k0, qf[s], p0, 0, 0, 0);
                p1 = __builtin_amdgcn_mfma_f32_32x32x16_bf16(k1, qf[s], p1, 0, 0, 0);
            }
#pragma unroll
            for (int s = 0; s < 2; ++s) {
                const bf16x8 k0 = *(LAS const bf16x8*)(sb + poff + (((2 * s + hi) ^ psw) << 4));
                const bf16x8 k1 = *(LAS const bf16x8*)(sb + 2048 + poff + (((2 * s + hi) ^ psw) << 4));
                p0 = __builtin_amdgcn_mfma_f32_32x32x16_bf16(k0, qf[4 + s], p0, 0, 0, 0);
                p1 = __builtin_amdgcn_mfma_f32_32x32x16_bf16(k1, qf[4 + s], p1, 0, 0, 0);
            }
            if (j >= 4 * qi) {
                const int kb0 = 64 * j + 4 * hi;
#pragma unroll
                for (int r = 0; r < 16; ++r) { const int kp = kb0 + (r & 3) + 8 * (r >> 2); if (kp > qp) p0[r] = -1e30f; if (kp + 32 > qp) p1[r] = -1e30f; }
            }
            float tm = fmaxf(p0[0], p1[0]);
#pragma unroll
            for (int r = 1; r < 16; ++r) tm = fmaxf(tm, fmaxf(p0[r], p1[r]));
            tm = fmaxf(tm, __shfl_xor(tm, 32));
            if (j == 0 || __any(tm > MLA_THR)) {
                const float dl = j == 0 ? tm : fmaxf(tm, 0.f);
                mref += dl;
                const float f = __builtin_amdgcn_exp2f(-dl);
                lsum *= f;
#pragma unroll
                for (int r = 0; r < 16; ++r) { oacc[0][r] *= f; oacc[1][r] *= f; p0[r] -= dl; p1[r] -= dl; negm[r] = -mref; }
            }
            float ps = 0.f;
#pragma unroll
            for (int r = 0; r < 16; ++r) { p0[r] = __builtin_amdgcn_exp2f(p0[r]); p1[r] = __builtin_amdgcn_exp2f(p1[r]); ps += p0[r] + p1[r]; }
            lsum += ps;
            u32x4 pf[4];
            pf[0] = (u32x4){cvtpk(p0[0], p0[1]), cvtpk(p0[2], p0[3]), cvtpk(p0[4], p0[5]), cvtpk(p0[6], p0[7])};
            pf[1] = (u32x4){cvtpk(p0[8], p0[9]), cvtpk(p0[10], p0[11]), cvtpk(p0[12], p0[13]), cvtpk(p0[14], p0[15])};
            pf[2] = (u32x4){cvtpk(p1[0], p1[1]), cvtpk(p1[2], p1[3]), cvtpk(p1[4], p1[5]), cvtpk(p1[6], p1[7])};
            pf[3] = (u32x4){cvtpk(p1[8], p1[9]), cvtpk(p1[10], p1[11]), cvtpk(p1[12], p1[13]), cvtpk(p1[14], p1[15])};
#pragma unroll
            for (int s = 0; s < 4; ++s) {
                const bf16x8 v0 = *(LAS const bf16x8*)(sb + voff + (((2 * s + hi) ^ ksw) << 4));
                const bf16x8 v1 = *(LAS const bf16x8*)(sb + 4096 + voff + (((2 * s + hi) ^ ksw) << 4));
                const bf16x8 pb = __builtin_bit_cast(bf16x8, pf[s]);
                oacc[0] = __builtin_amdgcn_mfma_f32_32x32x16_bf16(v0, pb, oacc[0], 0, 0, 0);
                oacc[1] = __builtin_amdgcn_mfma_f32_32x32x16_bf16(v1, pb, oacc[1], 0, 0, 0);
            }
        }
        st = st == 2 ? 0 : st + 1;
    }
#undef MLA_ISSUE
    lsum += __shfl_xor(lsum, 32);
    const float inv = 1.0f / lsum;
    bf16_t* orow = o + qrow * D + h * 64 + 4 * hi;
#pragma unroll
    for (int db = 0; db < 2; ++db)
#pragma unroll
        for (int g = 0; g < 4; ++g)
            *(u32x2*)(orow + 32 * db + 8 * g) = (u32x2){cvtpk(oacc[db][4 * g] * inv, oacc[db][4 * g + 1] * inv), cvtpk(oacc[db][4 * g + 2] * inv, oacc[db][4 * g + 3] * inv)};
    asm volatile("s_waitcnt lgkmcnt(0)" ::: "memory");
    __builtin_amdgcn_s_barrier(); asm volatile("" ::: "memory");
}
__device__ __forceinline__ void mla_meta(int b, int h, const bf16_t* __restrict__ Q1, const bf16_t* __restrict__ K1, const bf16_t* __restrict__ kpe, const bf16_t* __restrict__ VT1, bf16_t* o, int lane) {
    const int qi = lane & 15, part = lane >> 4; const size_t qrow = (size_t)MREAL + b * 16 + qi;
    float q[24];
#pragma unroll
    for (int d = 0; d < 24; ++d) q[d] = bf2f(Q1[qrow * 1536 + h * 96 + 24 * part + d]);
    float sc[16]; float mx = -1e30f;
#pragma unroll
    for (int j = 0; j < 16; ++j) {
        const size_t kr = (size_t)b * LP + j; float s = 0.f;
#pragma unroll
        for (int d = 0; d < 24; ++d) { const int dd = 24 * part + d; const float kv = dd < 64 ? bf2f(K1[kr * D + h * 64 + dd]) : bf2f(kpe[kr * 32 + dd - 64]); s += q[d] * kv; }
        s += __shfl_xor(s, 16); s += __shfl_xor(s, 32);
        sc[j] = j <= qi ? s : -1e30f; mx = fmaxf(mx, sc[j]);
    }
    float l = 0.f;
#pragma unroll
    for (int j = 0; j < 16; ++j) { sc[j] = exp2f(sc[j] - mx); l += sc[j]; }
    const float inv = 1.0f / l;
#pragma unroll
    for (int dd = 0; dd < 16; ++dd) { const int d = 16 * part + dd; float acc = 0.f;
#pragma unroll
        for (int j = 0; j < 16; ++j) acc += sc[j] * bf2f(VT1[((size_t)(b * 16 + h) * 64 + d) * LP + perm16(j)]);
        o[qrow * D + h * 64 + d] = f2bf(acc * inv); }
}
__device__ __forceinline__ void mla_phase(LAS unsigned char* lds, const bf16_t* Q1, const bf16_t* K1, const bf16_t* kpe, const bf16_t* VT1, bf16_t* o, int bid, int nblk) {
    const int v = (nblk % 8 == 0) ? (bid % 8) * (nblk / 8) + bid / 8 : bid;
    for (int vv = v; vv < 256; vv += nblk) {
        const int bh = vv >> 3, s = vv & 7, b = bh >> 4, h = bh & 15;
#pragma unroll 1
        for (int i = 0; i < 4; ++i) { const int qi = (i == 0) ? s : (i == 1) ? 15 - s : (i == 2) ? 16 + s : 31 - s; mla_unit(lds, b, h, qi, Q1, K1, kpe, VT1, o); }
        if (s == 0 && threadIdx.x < 64) mla_meta(b, h, Q1, K1, kpe, VT1, o, threadIdx.x);
    }
}

constexpr int SW_K = 0, SW_V = 36864, SW_VP = 560;
__device__ __forceinline__ void swa_block32(LAS const unsigned char* lds, int rb, int gk0, int nks, int mode, int i_q, const bf16x8 (&qf)[4], float& m, float& lsum, f32x16 (&oacc)[2], int r32, int hi) {
    const float C2 = 1.4426950408889634f;
    const int ksw = (r32 >> 1) & 7;
    f32x16 p = (f32x16){};
#pragma unroll
    for (int s = 0; s < 4; ++s) { const bf16x8 k = *(LAS const bf16x8*)(lds + SW_K + (rb + r32) * 128 + (((2 * s + hi) ^ ksw) << 4)); p = __builtin_amdgcn_mfma_f32_32x32x16_bf16(k, qf[s], p, 0, 0, 0); }
    if (mode != 0) {
        const int jb = ((rb - 32) & 127) + 4 * hi;
#pragma unroll
        for (int r = 0; r < 16; ++r) { const int kk = (r & 3) + 8 * (r >> 2);
            const bool ok = mode == 1 ? (kk + 4 * hi < 16) : mode == 2 ? (jb + kk > i_q) : (jb + kk <= i_q);
            if (!ok) p[r] = -1e30f; }
    }
    float tm = p[0];
#pragma unroll
    for (int r = 1; r < 16; ++r) tm = fmaxf(tm, p[r]);
    tm = fmaxf(tm, __shfl_xor(tm, 32));
    const float mn = fmaxf(m, tm), alpha = __builtin_amdgcn_exp2f((m - mn) * C2), nmc = -mn * C2;
    m = mn;
    float ps = 0.f;
#pragma unroll
    for (int r = 0; r < 16; ++r) { p[r] = __builtin_amdgcn_exp2f(__builtin_fmaf(p[r], C2, nmc)); ps += p[r]; }
    lsum = lsum * alpha + ps;
#pragma unroll
    for (int r = 0; r < 16; ++r) { oacc[0][r] *= alpha; oacc[1][r] *= alpha; }
    u32x4 pf[2];
    pf[0] = (u32x4){cvtpk(p[0], p[1]), cvtpk(p[2], p[3]), cvtpk(p[4], p[5]), cvtpk(p[6], p[7])};
    pf[1] = (u32x4){cvtpk(p[8], p[9]), cvtpk(p[10], p[11]), cvtpk(p[12], p[13]), cvtpk(p[14], p[15])};
#pragma unroll
    for (int ks = 0; ks < 2; ++ks) if (ks < nks) {
        const bf16x8 v0 = *(LAS const bf16x8*)(lds + SW_V + r32 * SW_VP + (gk0 + ks) * 32 + hi * 16);
        const bf16x8 v1 = *(LAS const bf16x8*)(lds + SW_V + (32 + r32) * SW_VP + (gk0 + ks) * 32 + hi * 16);
        const bf16x8 pb = __builtin_bit_cast(bf16x8, pf[ks]);
        oacc[0] = __builtin_amdgcn_mfma_f32_32x32x16_bf16(v0, pb, oacc[0], 0, 0, 0);
        oacc[1] = __builtin_amdgcn_mfma_f32_32x32x16_bf16(v1, pb, oacc[1], 0, 0, 0);
    }
}
__device__ __forceinline__ void swa_unit(LAS unsigned char* lds, int b, int n, int kh, const bf16_t* __restrict__ qkv, const bf16_t* __restrict__ VT0, const float* __restrict__ sinks, bf16_t* o) {
    const int tid = threadIdx.x, lane = tid & 63, wave = __builtin_amdgcn_readfirstlane(tid >> 6), r32 = lane & 31, hi = lane >> 5;
    for (int idx = tid; idx < 2176; idx += NTHR) {
        const int row = idx >> 3, c = idx & 7;
        if (row < 16 || n > 0 || row >= 144) {
            const size_t srow = row < 16 ? (size_t)MREAL + b * 16 + row : (size_t)b * SEQ + 128 * (n - 1) + (row - 16);
            const int lrow = row < 16 ? row : 16 + row;
            const u32x4 v = *(const u32x4*)(qkv + srow * NQKV + 1024 + kh * 64 + c * 8);
            *(LAS u32x4*)(lds + SW_K + lrow * 128 + ((c ^ ((lrow >> 1) & 7)) << 4)) = v;
        }
    }
    for (int idx = tid; idx < 2176; idx += NTHR) {
        const int d = idx / 34, c = idx % 34;
        if (c < 2 || n > 0 || c >= 18) {
            const bf16_t* src = VT0 + (size_t)((b * 2 + kh) * 64 + d) * LP + (c < 2 ? c * 8 : 16 + 128 * (n - 1) + (c - 2) * 8);
            *(LAS u32x4*)(lds + SW_V + d * SW_VP + c * 16) = *(const u32x4*)src;
        }
    }
    __syncthreads();
    const int hq = kh * 8 + wave;
    const float sink = sinks[hq];
#pragma unroll 1
    for (int qs = 0; qs < 4; ++qs) {
        const size_t qrow = (size_t)b * SEQ + 128 * n + 32 * qs + r32;
        bf16x8 qf[4];
#pragma unroll
        for (int s = 0; s < 4; ++s) qf[s] = *(const bf16x8*)(qkv + qrow * NQKV + hq * 64 + 16 * s + 8 * hi);
        f32x16 oacc[2]; oacc[0] = (f32x16){}; oacc[1] = (f32x16){};
        float m = sink, lsum = hi == 0 ? 1.0f : 0.0f;
        const int i_q = 32 * qs + r32;
        swa_block32(lds, 0, 0, 1, 1, i_q, qf, m, lsum, oacc, r32, hi);
        if (n > 0) {
            swa_block32(lds, 32 + 32 * qs, 1 + 2 * qs, 2, 2, i_q, qf, m, lsum, oacc, r32, hi);
#pragma unroll 1
            for (int kb = qs + 1; kb < 4; ++kb) swa_block32(lds, 32 + 32 * kb, 1 + 2 * kb, 2, 0, i_q, qf, m, lsum, oacc, r32, hi);
        }
#pragma unroll 1
        for (int kb = 0; kb < qs; ++kb) swa_block32(lds, 160 + 32 * kb, 9 + 2 * kb, 2, 0, i_q, qf, m, lsum, oacc, r32, hi);
        swa_block32(lds, 160 + 32 * qs, 9 + 2 * qs, 2, 3, i_q, qf, m, lsum, oacc, r32, hi);
        lsum += __shfl_xor(lsum, 32);
        const float inv = 1.0f / lsum;
        bf16_t* orow = o + qrow * D + hq * 64 + 4 * hi;
#pragma unroll
        for (int db = 0; db < 2; ++db)
#pragma unroll
            for (int g = 0; g < 4; ++g)
                *(u32x2*)(orow + 32 * db + 8 * g) = (u32x2){cvtpk(oacc[db][4 * g] * inv, oacc[db][4 * g + 1] * inv), cvtpk(oacc[db][4 * g + 2] * inv, oacc[db][4 * g + 3] * inv)};
    }
    __syncthreads();
}
__device__ __forceinline__ void swa_meta(int b, int hq, const bf16_t* __restrict__ qkv, const bf16_t* __restrict__ VT0, const float* __restrict__ sinks, bf16_t* o, int lane) {
    const int qi = lane & 15, part = lane >> 4, kh = hq >> 3; const size_t qrow = (size_t)MREAL + b * 16 + qi;
    float q[16];
#pragma unroll
    for (int d = 0; d < 16; ++d) q[d] = bf2f(qkv[qrow * NQKV + hq * 64 + 16 * part + d]);
    const float sink = sinks[hq];
    float sc[16]; float mx = sink;
#pragma unroll
    for (int j = 0; j < 16; ++j) {
        const size_t kr = (size_t)MREAL + b * 16 + j; float s = 0.f;
#pragma unroll
        for (int d = 0; d < 16; ++d) s += q[d] * bf2f(qkv[kr * NQKV + 1024 + kh * 64 + 16 * part + d]);
        s += __shfl_xor(s, 16); s += __shfl_xor(s, 32);
        sc[j] = j <= qi ? s : -1e30f; mx = fmaxf(mx, sc[j]);
    }
    float l = __expf(sink - mx);
#pragma unroll
    for (int j = 0; j < 16; ++j) { sc[j] = __expf(sc[j] - mx); l += sc[j]; }
    const float inv = 1.0f / l;
#pragma unroll
    for (int dd = 0; dd < 16; ++dd) { const int d = 16 * part + dd; float acc = 0.f;
#pragma unroll
        for (int j = 0; j < 16; ++j) acc += sc[j] * bf2f(VT0[((size_t)(b * 2 + kh) * 64 + d) * LP + perm16(j)]);
        o[qrow * D + hq * 64 + d] = f2bf(acc * inv); }
}
__device__ __forceinline__ void swa_phase(LAS unsigned char* lds, const bf16_t* qkv, const bf16_t* VT0, const float* sinks, bf16_t* o, int bid, int nblk) {
    for (int u = bid; u < 256; u += nblk) {
        const int b = u >> 7, n = (u >> 1) & 63, kh = u & 1;
        swa_unit(lds, b, n, kh, qkv, VT0, sinks, o);
        if (n == 0) swa_meta(b, kh * 8 + (threadIdx.x >> 6), qkv, VT0, sinks, o, threadIdx.x & 63);
    }
}

template <int MOE_MT>
__device__ __forceinline__ void moe_unit(LAS unsigned char* lds, int e, int s0, int ns, const int* __restrict__ list, const bf16_t* __restrict__ hb, const float* __restrict__ rstd,
                                         const float* __restrict__ wslot, const bf16_t* __restrict__ wgu, const bf16_t* __restrict__ wd, bf16_t* ybuf, unsigned long long* tsb = nullptr) {
#define MSTAMP(i) do { if (PROBE_PHASE >= 600 && tsb && blockIdx.x == 0 && threadIdx.x == 0) tsb[i] = __builtin_amdgcn_s_memrealtime(); } while (0)
    MSTAMP(20);
    constexpr int MOE_BM = 16 * MOE_MT, MOE_ST1 = (MOE_BM + 256) * 128, MOE_HT = MOE_BM * 128, MOE_HLO = 2 * MOE_ST1, MOE_B2 = 2 * MOE_HT, MOE_ST2 = 32768, MOE_INFO = MOE_HLO + 2 * MOE_HT;
    static_assert(MOE_B2 + 2 * MOE_ST2 <= MOE_HLO && MOE_INFO + 3072 <= LDS_MISC, "moe lds");
#define moe_hoff(kt2) ((kt2) < 2 ? MOE_HLO + (kt2) * MOE_HT : ((kt2) - 2) * MOE_HT)
    const int tid = threadIdx.x, lane = tid & 63, wave = __builtin_amdgcn_readfirstlane(tid >> 6);
    LAS int* slotl = (LAS int*)(lds + MOE_INFO); LAS float* rsl = (LAS float*)(lds + MOE_INFO + 1024); LAS float* wl = (LAS float*)(lds + MOE_INFO + 2048);
    if (tid < MOE_BM) { const int sl = list[(size_t)e * CAP + s0 + (tid < ns ? tid : 0)]; slotl[tid] = sl; rsl[tid] = rstd[sl >> 1]; wl[tid] = wslot[sl]; }
    __syncthreads();
    const int lc = (lane & 7) ^ (lane >> 3);
    const int fro = (lane & 15) * 128, fc0 = ((lane >> 4) ^ (lane & 7)) << 4, fc1 = ((4 + (lane >> 4)) ^ (lane & 7)) << 4;
    {
        constexpr int G = (MOE_BM + 256) / 8, GA = MOE_BM / 8, NG = (G + 7) / 8;
        const char* src[NG];
#pragma unroll
        for (int i = 0; i < NG; ++i) { const int g = wave + 8 * i;
            if (g < GA) src[i] = (const char*)(hb + (size_t)(slotl[g * 8 + (lane >> 3)] >> 1) * D) + lc * 16;
            else if (g < G) src[i] = (const char*)(wgu + (size_t)((g - GA) * 8 + (lane >> 3)) * D) + lc * 16;
            else src[i] = nullptr; }
        f32x4 acc[MOE_MT][2];
#pragma unroll
        for (int mi = 0; mi < MOE_MT; ++mi) { acc[mi][0] = (f32x4){0.f, 0.f, 0.f, 0.f}; acc[mi][1] = (f32x4){0.f, 0.f, 0.f, 0.f}; }
#define M1_STAGE(st, step) do { _Pragma("unroll") for (int _i = 0; _i < NG; ++_i) { const int _g = wave + 8 * _i; if (_g < G) \
        __builtin_amdgcn_global_load_lds((const unsigned*)(src[_i] + (size_t)((step) & 15) * 128 + ((_g >= GA && (step) >= 16) ? (size_t)256 * 2048 : 0)), (LAS unsigned*)(lds + (st) * MOE_ST1 + _g * 1024), 16, 0, 0); } } while (0)
        M1_STAGE(0, 0);
        for (int step = 0; step < 32; ++step) {
            asm volatile("s_waitcnt vmcnt(0)" ::: "memory");
            __syncthreads();
            if (step + 1 < 32) M1_STAGE((step + 1) & 1, step + 1);
            LAS const unsigned char* sa = lds + (step & 1) * MOE_ST1 + fro;
            LAS const unsigned char* sb = lds + (step & 1) * MOE_ST1 + (MOE_BM + wave * 32) * 128 + fro;
#pragma unroll
            for (int ks = 0; ks < 2; ++ks) { const int fc = ks ? fc1 : fc0;
                const bf16x8 b0 = *(LAS const bf16x8*)(sb + fc), b1 = *(LAS const bf16x8*)(sb + 2048 + fc);
#pragma unroll
                for (int mi = 0; mi < MOE_MT; ++mi) { const bf16x8 af = *(LAS const bf16x8*)(sa + mi * 2048 + fc);
                    acc[mi][0] = __builtin_amdgcn_mfma_f32_16x16x32_bf16(b0, af, acc[mi][0], 0, 0, 0);
                    acc[mi][1] = __builtin_amdgcn_mfma_f32_16x16x32_bf16(b1, af, acc[mi][1], 0, 0, 0); }
            }
            if ((step & 15) == 15) {
                const int n = 16 * (8 * (step >> 4) + wave) + (lane >> 4) * 4;
                const int csw = ((n & 63) >> 3);
#pragma unroll
                for (int mi = 0; mi < MOE_MT; ++mi) { const int row = mi * 16 + (lane & 15); const float rs = rsl[row]; float hv[4];
#pragma unroll
                    for (int r = 0; r < 4; ++r) { const float g = acc[mi][0][r] * rs, u = acc[mi][1][r] * rs; hv[r] = g / (1.0f + __expf(-g)) * u; }
                    *(LAS u32x2*)(lds + moe_hoff(n >> 6) + row * 128 + ((csw ^ (row & 7)) << 4) + (n & 4) * 2) = (u32x2){pk2(hv[0], hv[1]), pk2(hv[2], hv[3])};
                    acc[mi][0] = (f32x4){0.f, 0.f, 0.f, 0.f}; acc[mi][1] = (f32x4){0.f, 0.f, 0.f, 0.f}; }
            }
        }
#undef M1_STAGE
    }
    __syncthreads();
    MSTAMP(21);
    {
        const char* src2[4];
#pragma unroll
        for (int i = 0; i < 4; ++i) src2[i] = (const char*)(wd + (size_t)((wave + 8 * i) * 8 + (lane >> 3)) * DE) + lc * 16;
        f32x4 acc[MOE_MT][2];
#pragma unroll
        for (int mi = 0; mi < MOE_MT; ++mi) { acc[mi][0] = (f32x4){0.f, 0.f, 0.f, 0.f}; acc[mi][1] = (f32x4){0.f, 0.f, 0.f, 0.f}; }
#define M2_STAGE(st, q) do { _Pragma("unroll") for (int _i = 0; _i < 4; ++_i) \
        __builtin_amdgcn_global_load_lds((const unsigned*)(src2[_i] + (size_t)((q) >> 2) * (256 * 512) + (size_t)((q) & 3) * 128), (LAS unsigned*)(lds + MOE_B2 + (st) * MOE_ST2 + (wave + 8 * _i) * 1024), 16, 0, 0); } while (0)
        M2_STAGE(0, 0);
        for (int q = 0; q < 16; ++q) {
            asm volatile("s_waitcnt vmcnt(0)" ::: "memory");
            __syncthreads();
            if (q + 1 < 16) M2_STAGE((q + 1) & 1, q + 1);
            LAS const unsigned char* sa = lds + moe_hoff(q & 3) + fro;
            LAS const unsigned char* sb = lds + MOE_B2 + (q & 1) * MOE_ST2 + (wave * 32) * 128 + fro;
#pragma unroll
            for (int ks = 0; ks < 2; ++ks) { const int fc = ks ? fc1 : fc0;
                const bf16x8 b0 = *(LAS const bf16x8*)(sb + fc), b1 = *(LAS const bf16x8*)(sb + 2048 + fc);
#pragma unroll
                for (int mi = 0; mi < MOE_MT; ++mi) { const bf16x8 af = *(LAS const bf16x8*)(sa + mi * 2048 + fc);
                    acc[mi][0] = __builtin_amdgcn_mfma_f32_16x16x32_bf16(b0, af, acc[mi][0], 0, 0, 0);
                    acc[mi][1] = __builtin_amdgcn_mfma_f32_16x16x32_bf16(b1, af, acc[mi][1], 0, 0, 0); }
            }
            if ((q & 3) == 3) {
                const int cb = (q >> 2) * 256 + wave * 32 + (lane >> 4) * 4;
#pragma unroll
                for (int mi = 0; mi < MOE_MT; ++mi) { const int row = mi * 16 + (lane & 15);
                    if (row < ns) { const float w = wl[row]; bf16_t* yr = ybuf + (size_t)slotl[row] * D + cb;
#pragma unroll
                        for (int ni = 0; ni < 2; ++ni) { const f32x4 v = acc[mi][ni] * w; *(u32x2*)(yr + ni * 16) = (u32x2){pk2(v[0], v[1]), pk2(v[2], v[3])}; } }
                    acc[mi][0] = (f32x4){0.f, 0.f, 0.f, 0.f}; acc[mi][1] = (f32x4){0.f, 0.f, 0.f, 0.f}; }
            }
        }
#undef M2_STAGE
    }
#undef moe_hoff
    __syncthreads();
    MSTAMP(22);
#undef MSTAMP
}
__device__ __forceinline__ void moe_phase(LAS unsigned char* lds, int* cnt, const int* list, const bf16_t* hb, const float* rstd, const float* wslot, const bf16_t* wgu, const bf16_t* wd, bf16_t* ybuf, int bid, int nblk, unsigned long long* tsb = nullptr) {
    const bool grp = (nblk % 8) == 0;
    int ntile[NE]; int gsum = 0; bool fit = grp;
#pragma unroll
    for (int e = 0; e < NE; ++e) { const int c = __hip_atomic_load(cnt + e * 64, __ATOMIC_RELAXED, __HIP_MEMORY_SCOPE_AGENT); const int bm = c > 8 * 144 ? 160 : 144; ntile[e] = (c + bm - 1) / bm;
        gsum = (e & 3) == 0 ? ntile[e] : gsum + ntile[e]; if ((e & 3) == 3 && gsum > nblk / 8) fit = false; }
    const int x = bid % 8;
    int u = fit ? bid / 8 : (grp ? x * (nblk / 8) + bid / 8 : bid), base = 0;
    const int stride = fit ? nblk / 8 : nblk;
#pragma unroll 1
    for (int e = 0; e < NE; ++e) {
        if (fit && (e >> 2) != x) continue;
        const int c = __hip_atomic_load(cnt + e * 64, __ATOMIC_RELAXED, __HIP_MEMORY_SCOPE_AGENT);
        const bool big = c > 8 * 144; const int bm = big ? 160 : 144, nt = (c + bm - 1) / bm;
        while (u < base + nt) { const int t = u - base; const int ns = c - t * bm < bm ? c - t * bm : bm;
            if (big) moe_unit<10>(lds, e, t * bm, ns, list, hb, rstd, wslot, wgu + (size_t)e * 512 * 1024, wd + (size_t)e * 1024 * 256, ybuf, tsb);
            else moe_unit<9>(lds, e, t * bm, ns, list, hb, rstd, wslot, wgu + (size_t)e * 512 * 1024, wd + (size_t)e * 1024 * 256, ybuf, tsb);
            u += stride; }
        base += nt;
    }
}

template <int MT>
__device__ __forceinline__ void l1proj_unit(LAS unsigned char* lds, int row0, int mrow0, bf16_t* hb, const bf16_t* __restrict__ ybuf, const bf16_t* __restrict__ win_t, const bf16_t* __restrict__ wuq_t,
                                            const bf16_t* __restrict__ wukv_t, const float2* __restrict__ cs, bf16_t* kpe, bf16_t* Q1, bf16_t* K1, bf16_t* VT1) {
    constexpr int BM = 16 * MT, STW = (BM + 512) * 64, KT = BM * 64  , CQN = 0, CKV = 8 * KT, RB = 12 * KT, STB = 32768, PART = 3 * STW;
    static_assert(RB + 3 * STB <= LDS_MISC && PART + 8 * BM * 4 <= LDS_MISC, "l1proj lds");
    const int tid = threadIdx.x, lane = tid & 63, wave = __builtin_amdgcn_readfirstlane(tid >> 6);
    LAS float* rsl = (LAS float*)(lds + LDS_MISC + 256);
#define L1_GROW(r) ((r) < 64 ? row0 + (r) : mrow0 + (r) - 64)
    for (int r = wave; r < BM; r += NWAVE) {
        const size_t grow = L1_GROW(r); float ss = 0.f;
#pragma unroll
        for (int j = 0; j < 4; ++j) { const size_t c = j * 256 + lane * 4;
            const u32x2 h = *(const u32x2*)(hb + grow * D + c), y0 = *(const u32x2*)(ybuf + (grow * 2) * D + c), y1 = *(const u32x2*)(ybuf + (grow * 2 + 1) * D + c);
            float v[4];
            v[0] = __uint_as_float(h.x << 16) + __uint_as_float(y0.x << 16) + __uint_as_float(y1.x << 16);
            v[1] = __uint_as_float(h.x & 0xffff0000u) + __uint_as_float(y0.x & 0xffff0000u) + __uint_as_float(y1.x & 0xffff0000u);
            v[2] = __uint_as_float(h.y << 16) + __uint_as_float(y0.y << 16) + __uint_as_float(y1.y << 16);
            v[3] = __uint_as_float(h.y & 0xffff0000u) + __uint_as_float(y0.y & 0xffff0000u) + __uint_as_float(y1.y & 0xffff0000u);
            ss += v[0] * v[0] + v[1] * v[1] + v[2] * v[2] + v[3] * v[3];
            *(u32x2*)(hb + grow * D + c) = (u32x2){pk2(v[0], v[1]), pk2(v[2], v[3])}; }
        ss = wave_sum(ss); if (lane == 0) rsl[r] = rsqrtf(ss * (1.0f / D) + EPS);
    }
    asm volatile("s_waitcnt vmcnt(0)" ::: "memory");
    __syncthreads();
    const int lc = (lane & 3) ^ swzF(lane >> 4);
    const int fro = (lane & 15) * 64 + (((lane >> 4) ^ swzF((lane >> 2) & 3)) << 4);
    f32x4 acc[MT][4];
#pragma unroll
    for (int mi = 0; mi < MT; ++mi)
#pragma unroll
        for (int ni = 0; ni < 4; ++ni) acc[mi][ni] = (f32x4){0.f, 0.f, 0.f, 0.f};
    {
        const char* srcb[4];
#pragma unroll
        for (int i = 0; i < 4; ++i) srcb[i] = (const char*)(win_t + (size_t)((wave + 8 * i) * 16 + (lane >> 2)) * D) + lc * 16;
        const char* srca = (const char*)(hb + (size_t)L1_GROW((wave < MT ? wave : 0) * 16 + (lane >> 2)) * D) + lc * 16;
#define W_ISSUE(st, kt) do { if (wave < MT) __builtin_amdgcn_global_load_lds((const unsigned*)(srca + (size_t)(kt) * 64), (LAS unsigned*)(lds + (st) * STW + wave * 1024), 16, 0, 16); \
        _Pragma("unroll") for (int _i = 0; _i < 4; ++_i) __builtin_amdgcn_global_load_lds((const unsigned*)(srcb[_i] + (size_t)(kt) * 64), (LAS unsigned*)(lds + (st) * STW + (MT + wave + 8 * _i) * 1024), 16, 0, 0); } while (0)
        W_ISSUE(0, 0); W_ISSUE(1, 1);
        int st = 0;
        for (int kt = 0; kt < 32; ++kt) {
            if (kt + 1 < 32) { if (wave < MT) wait_vm<5>(); else wait_vm<4>(); } else wait_vm<0>();
            __builtin_amdgcn_s_barrier(); asm volatile("" ::: "memory");
            if (kt + 2 < 32) W_ISSUE(st == 0 ? 2 : st - 1, kt + 2);
            LAS const unsigned char* sa = lds + st * STW + fro;
            LAS const unsigned char* sb = lds + st * STW + (BM + wave * 64) * 64 + fro;
            bf16x8 bfr[4];
#pragma unroll
            for (int ni = 0; ni < 4; ++ni) bfr[ni] = *(LAS const bf16x8*)(sb + ni * 1024);
#pragma unroll
            for (int mi = 0; mi < MT; ++mi) { const bf16x8 af = *(LAS const bf16x8*)(sa + mi * 1024);
#pragma unroll
                for (int ni = 0; ni < 4; ++ni) acc[mi][ni] = __builtin_amdgcn_mfma_f32_16x16x32_bf16(bfr[ni], af, acc[mi][ni], 0, 0, 0); }
            st = st == 2 ? 0 : st + 1;
        }
#undef W_ISSUE
    }
    asm volatile("s_waitcnt lgkmcnt(0)" ::: "memory");
    __syncthreads();
    LAS float* part = (LAS float*)(lds + PART);
    int lane_e = lane; asm volatile("" : "+v"(lane_e));
#define lane lane_e
#pragma unroll
    for (int mi = 0; mi < MT; ++mi) { const float rs = rsl[mi * 16 + (lane & 15)]; float ss = 0.f;
#pragma unroll
        for (int ni = 0; ni < 4; ++ni) { acc[mi][ni] = acc[mi][ni] * rs; ss += acc[mi][ni][0] * acc[mi][ni][0] + acc[mi][ni][1] * acc[mi][ni][1] + acc[mi][ni][2] * acc[mi][ni][2] + acc[mi][ni][3] * acc[mi][ni][3]; }
        ss += __shfl_xor(ss, 16); ss += __shfl_xor(ss, 32);
        if (lane < 16) part[wave * BM + mi * 16 + lane] = ss; }
    __syncthreads();
    if (wave < 6) {
#pragma unroll
        for (int mi = 0; mi < MT; ++mi) { const int row = mi * 16 + (lane & 15);
            const float tot = wave < 4 ? (part[row] + part[BM + row]) + (part[2 * BM + row] + part[3 * BM + row]) : part[4 * BM + row] + part[5 * BM + row];
            const float rn = rsqrtf(tot * (wave < 4 ? 1.0f / 256 : 1.0f / 128) + EPS);
#pragma unroll
            for (int ni = 0; ni < 4; ++ni) { const int cc = (wave < 4 ? 64 * wave : 64 * (wave - 4)) + ni * 16 + (lane >> 4) * 4; const f32x4 v = acc[mi][ni] * rn;
                *(LAS u32x2*)(lds + (wave < 4 ? CQN : CKV) + (cc >> 5) * KT + row * 64 + (((((cc & 31) >> 3)) ^ swzF((row >> 2) & 3)) << 4) + (cc & 4) * 2) = (u32x2){pk2(v[0], v[1]), pk2(v[2], v[3])}; } }
    } else if (wave == 6) {
#pragma unroll
        for (int mi = 0; mi < MT; ++mi) { const int row = mi * 16 + (lane & 15); const int grow = L1_GROW(row); const int pos = row_pos(grow), d0 = (lane >> 4) * 4;
            f32x4 o1, o2;
#pragma unroll
            for (int r = 0; r < 4; ++r) { const float2 t = cs[pos * 32 + 2 * (d0 + r)]; const float x1 = acc[mi][0][r], x2 = acc[mi][1][r]; o1[r] = x1 * t.x - x2 * t.y; o2[r] = x2 * t.x + x1 * t.y; }
            bf16_t* kr = kpe + ((size_t)row_batch(grow) * LP + pos) * 32;
            *(u32x2*)(kr + d0) = (u32x2){pk2(o1[0], o1[1]), pk2(o1[2], o1[3])}; *(u32x2*)(kr + 16 + d0) = (u32x2){pk2(o2[0], o2[1]), pk2(o2[2], o2[3])}; }
    }
#undef lane
    __syncthreads();
    const char* srcu[4];
#define U_ISSUE(st, base, pitchB, chunk, kt) do { _Pragma("unroll") for (int _i = 0; _i < 4; ++_i) \
        __builtin_amdgcn_global_load_lds((const unsigned*)(srcu[_i] + (size_t)(chunk) * 512 * (pitchB) + (size_t)(kt) * 64), (LAS unsigned*)(lds + RB + (st) * STB + (wave + 8 * _i) * 1024), 16, 0, 0); } while (0)
    {
#pragma unroll
        for (int i = 0; i < 4; ++i) srcu[i] = (const char*)(wuq_t + (size_t)((wave + 8 * i) * 16 + (lane >> 2)) * 256) + lc * 16;
#pragma unroll
        for (int mi = 0; mi < MT; ++mi)
#pragma unroll
            for (int ni = 0; ni < 4; ++ni) acc[mi][ni] = (f32x4){0.f, 0.f, 0.f, 0.f};
        U_ISSUE(0, 0, 512, 0, 0); U_ISSUE(1, 0, 512, 0, 1);
        int st = 0;
        for (int q = 0; q < 24; ++q) {
            if (q + 1 < 24) wait_vm<4>(); else wait_vm<0>();
            __builtin_amdgcn_s_barrier(); asm volatile("" ::: "memory");
            if (q + 2 < 24) U_ISSUE(st == 0 ? 2 : st - 1, 0, 512, (q + 2) >> 3, (q + 2) & 7);
            LAS const unsigned char* sa = lds + CQN + (q & 7) * KT + fro;
            LAS const unsigned char* sb = lds + RB + st * STB + (wave * 64) * 64 + fro;
            bf16x8 bfr[4];
#pragma unroll
            for (int ni = 0; ni < 4; ++ni) bfr[ni] = *(LAS const bf16x8*)(sb + ni * 1024);
#pragma unroll
            for (int mi = 0; mi < MT; ++mi) { const bf16x8 af = *(LAS const bf16x8*)(sa + mi * 1024);
#pragma unroll
                for (int ni = 0; ni < 4; ++ni) acc[mi][ni] = __builtin_amdgcn_mfma_f32_16x16x32_bf16(bfr[ni], af, acc[mi][ni], 0, 0, 0); }
            if ((q & 7) == 7) {
                int lane_q = lane; asm volatile("" : "+v"(lane_q));
#define lane lane_q
                const float scale = 0.10206207261596577f * 1.4426950408889634f; const int d0 = (lane >> 4) * 4;
#pragma unroll
                for (int mi = 0; mi < MT; ++mi) { const int grow = L1_GROW(mi * 16 + (lane & 15)); const int pos = row_pos(grow);
#pragma unroll
                    for (int bi = 0; bi < 2; ++bi) { const int gc = (q >> 3) * 512 + 64 * wave + bi * 32; bf16_t* orow = Q1 + (size_t)grow * 1536 + gc;
                        f32x4 v1 = acc[mi][2 * bi], v2 = acc[mi][2 * bi + 1];
                        if (((gc >> 5) % 3) == 2) {
#pragma unroll
                            for (int r = 0; r < 4; ++r) { const float2 t = cs[pos * 32 + 2 * (d0 + r)]; const float x1 = v1[r], x2 = v2[r]; v1[r] = x1 * t.x - x2 * t.y; v2[r] = x2 * t.x + x1 * t.y; } }
                        v1 = v1 * scale; v2 = v2 * scale;
                        *(u32x2*)(orow + d0) = (u32x2){pk2(v1[0], v1[1]), pk2(v1[2], v1[3])}; *(u32x2*)(orow + 16 + d0) = (u32x2){pk2(v2[0], v2[1]), pk2(v2[2], v2[3])}; }
#pragma unroll
                    for (int ni = 0; ni < 4; ++ni) acc[mi][ni] = (f32x4){0.f, 0.f, 0.f, 0.f}; }
#undef lane
            }
            st = st == 2 ? 0 : st + 1;
        }
    }
    asm volatile("s_waitcnt lgkmcnt(0)" ::: "memory");
    __syncthreads();
    {
#pragma unroll
        for (int i = 0; i < 4; ++i) srcu[i] = (const char*)(wukv_t + (size_t)((wave + 8 * i) * 16 + (lane >> 2)) * 128) + lc * 16;
#pragma unroll
        for (int mi = 0; mi < MT; ++mi)
#pragma unroll
            for (int ni = 0; ni < 4; ++ni) acc[mi][ni] = (f32x4){0.f, 0.f, 0.f, 0.f};
        U_ISSUE(0, 0, 256, 0, 0); U_ISSUE(1, 0, 256, 0, 1);
        int st = 0;
        for (int q = 0; q < 16; ++q) {
            if (q + 1 < 16) wait_vm<4>(); else wait_vm<0>();
            __builtin_amdgcn_s_barrier(); asm volatile("" ::: "memory");
            if (q + 2 < 16) U_ISSUE(st == 0 ? 2 : st - 1, 0, 256, (q + 2) >> 2, (q + 2) & 3);
            LAS const unsigned char* sa = lds + CKV + (q & 3) * KT + fro;
            LAS const unsigned char* sb = lds + RB + st * STB + (wave * 64) * 64 + fro;
            bf16x8 bfr[4];
#pragma unroll
            for (int ni = 0; ni < 4; ++ni) bfr[ni] = *(LAS const bf16x8*)(sb + ni * 1024);
            if (q < 8) {
#pragma unroll
                for (int mi = 0; mi < MT; ++mi) { const bf16x8 af = *(LAS const bf16x8*)(sa + mi * 1024);
#pragma unroll
                    for (int ni = 0; ni < 4; ++ni) acc[mi][ni] = __builtin_amdgcn_mfma_f32_16x16x32_bf16(bfr[ni], af, acc[mi][ni], 0, 0, 0); }
            } else {
#pragma unroll
                for (int mi = 0; mi < MT; ++mi) { const bf16x8 af = *(LAS const bf16x8*)(sa + mi * 1024);
#pragma unroll
                    for (int ni = 0; ni < 4; ++ni) acc[mi][ni] = __builtin_amdgcn_mfma_f32_16x16x32_bf16(af, bfr[ni], acc[mi][ni], 0, 0, 0); }
            }
            if ((q & 3) == 3) {
                const int ch = q >> 2;
                int lane_k = lane; asm volatile("" : "+v"(lane_k));
#define lane lane_k
                if (ch < 2) {
#pragma unroll
                    for (int mi = 0; mi < MT; ++mi) { const int grow = L1_GROW(mi * 16 + (lane & 15)); const size_t kr = (size_t)row_batch(grow) * LP + row_pos(grow);
#pragma unroll
                        for (int ni = 0; ni < 4; ++ni) { const f32x4 v = acc[mi][ni];
                            *(u32x2*)(K1 + kr * D + 512 * ch + 64 * wave + ni * 16 + (lane >> 4) * 4) = (u32x2){pk2(v[0], v[1]), pk2(v[2], v[3])}; acc[mi][ni] = (f32x4){0.f, 0.f, 0.f, 0.f}; } }
                } else {
#pragma unroll
                    for (int mi = 0; mi < MT; ++mi) { const int grow0 = L1_GROW(mi * 16 + (lane >> 4) * 4); const int b = row_batch(grow0), pp = perm16(row_pos(grow0));
#pragma unroll
                        for (int ni = 0; ni < 4; ++ni) { const int hd = 512 * (ch - 2) + 64 * wave + ni * 16 + (lane & 15); const f32x4 v = acc[mi][ni];
                            *(u32x2*)(VT1 + (size_t)(b * 1024 + hd) * LP + pp) = (u32x2){pk2(v[0], v[1]), pk2(v[2], v[3])}; acc[mi][ni] = (f32x4){0.f, 0.f, 0.f, 0.f}; } }
                }
#undef lane
            }
            st = st == 2 ? 0 : st + 1;
        }
    }
#undef U_ISSUE
#undef L1_GROW
    asm volatile("s_waitcnt lgkmcnt(0)" ::: "memory");
    __syncthreads();
}
__device__ __forceinline__ void l1proj_phase(LAS unsigned char* lds, bf16_t* hb, const bf16_t* ybuf, const bf16_t* win_t, const bf16_t* wuq_t, const bf16_t* wukv_t, const float2* cs, bf16_t* kpe,
                                             bf16_t* Q1, bf16_t* K1, bf16_t* VT1, int bid, int nblk) {
    { const int gt = bid * NTHR + threadIdx.x, ngt = nblk * NTHR;
      for (int idx = gt; idx < 2 * 48 * 1024; idx += ngt) { const int b = idx / (48 * 1024), r = idx % (48 * 1024); K1[((size_t)b * LP + 8208) * 1024 + r] = 0; }
      for (int idx = gt; idx < 2 * 16 * 64 * 48; idx += ngt) { const int rr = idx / 48, c = idx % 48; VT1[(size_t)rr * LP + 8208 + c] = 0; } }
    for (int u = bid; u < 256; u += nblk) {
        if (u >= 254) l1proj_unit<5>(lds, u * 64, MREAL + (u - 254) * 16, hb, ybuf, win_t, wuq_t, wukv_t, cs, kpe, Q1, K1, VT1);
        else l1proj_unit<4>(lds, u * 64, MREAL, hb, ybuf, win_t, wuq_t, wukv_t, cs, kpe, Q1, K1, VT1);
    }
}

struct EpiNull { int m0, n0;
    template <int MT, int NT> __device__ __forceinline__ void operator()(f32x4 (&acc)[MT][NT], int, int, int) const {
#pragma unroll
        for (int mi = 0; mi < MT; ++mi)
#pragma unroll
            for (int ni = 0; ni < NT; ++ni) asm volatile("" :: "v"(acc[mi][ni])); } };
__device__ __forceinline__ void transpose_item(const float* __restrict__ W, int N, const float* __restrict__ gain, bf16_t* dst, int ldk, int drow0, int k0, int n0, LAS float* scr, int lane, int dskip = 0) {
#pragma unroll 8
    for (int i = 0; i < 32; ++i) { const int kk = 2 * i + (lane >> 5); float v = W[(size_t)(k0 + kk) * N + n0 + (lane & 31)]; if (gain) v *= gain[k0 + kk]; scr[kk * 33 + (lane & 31)] = v; }
    asm volatile("s_waitcnt lgkmcnt(0)" ::: "memory");
    const int c = lane & 7;
#pragma unroll
    for (int j = 0; j < 4; ++j) { const int n = (lane >> 3) + 8 * j; const LAS float* s = scr + (8 * c) * 33 + n;
        u32x4 o; o.x = pk2(s[0 * 33], s[1 * 33]); o.y = pk2(s[2 * 33], s[3 * 33]); o.z = pk2(s[4 * 33], s[5 * 33]); o.w = pk2(s[6 * 33], s[7 * 33]);
        *(u32x4*)(dst + (size_t)(drow0 + n + (n >= 16 ? dskip : 0)) * ldk + k0 + 8 * c) = o; }
    asm volatile("s_waitcnt lgkmcnt(0)" ::: "memory");
}
__device__ __forceinline__ void moe_convert_item(const float* __restrict__ src, int pitch  , const float* __restrict__ gain  , bf16_t* dst, int ldk, int kind  , int nrow0, LAS float* T) {
    const int tid = threadIdx.x;
#pragma unroll
    for (int i = 0; i < 8; ++i) { const int idx = tid + i * NTHR, k = idx >> 6, c4 = idx & 63;
        f32x4 v = *(const f32x4*)(src + (size_t)k * pitch + c4 * 4); if (gain) v = v * gain[k];
        LAS float* t = T + k * 257 + c4 * 4; t[0] = v[0]; t[1] = v[1]; t[2] = v[2]; t[3] = v[3]; }
    __syncthreads();
#pragma unroll
    for (int i = 0; i < 4; ++i) { const int idx = tid + i * NTHR, kc = idx & 7, n = idx >> 3;
        const LAS float* t = T + (8 * kc) * 257 + n;
        u32x4 o; o.x = pk2(t[0], t[257]); o.y = pk2(t[2 * 257], t[3 * 257]); o.z = pk2(t[4 * 257], t[5 * 257]); o.w = pk2(t[6 * 257], t[7 * 257]);
        const int row = kind == 2 ? nrow0 + n : (n >> 4) * 32 + kind * 16 + (n & 15);
        *(u32x4*)(dst + (size_t)row * ldk + 8 * kc) = o; }
    __syncthreads();
}
__device__ __forceinline__ void moe_weight_items(const float* wgate, const float* wup, const float* wdown, const float* gain, bf16_t* wgu_t, bf16_t* wd_t, LAS float* T, int bid, int nblk) {
    for (int it = bid; it < NE * 48; it += nblk) {
        const int e = it / 48, r = it % 48, which = r >> 4, q = r & 15;
        if (which < 2) moe_convert_item((which ? wup : wgate) + (size_t)e * D * DE + (size_t)q * 64 * DE, DE, gain + q * 64, wgu_t + (size_t)e * 512 * 1024 + q * 64, 1024, which, 0, T);
        else { const int kb = q >> 2, nb = q & 3;
            moe_convert_item(wdown + (size_t)e * DE * D + (size_t)kb * 64 * D + nb * 256, D, nullptr, wd_t + (size_t)e * 1024 * 256 + kb * 64, 256, 2, nb * 256, T); }
    }
}
__device__ __forceinline__ void p0_prologue(const MArgs& a, LAS unsigned char* lds, int bid, int nblk) {
    const int tid = threadIdx.x, lane = tid & 63, wave = __builtin_amdgcn_readfirstlane(tid >> 6);
    const int gw = bid * NWAVE + wave, ngw = nblk * NWAVE, gt = bid * NTHR + tid, ngt = nblk * NTHR;
    unsigned char* ws = a.ws;
    float2* cs = (float2*)(ws + WS_ROPE);
    for (int _r = 0; _r < (PROBE_PHASE == 301 ? 2 : 1); ++_r)
    for (int idx = gt; idx < LPOS * 32; idx += ngt) { const int pos = idx >> 5, i = idx & 31; const float inv = 1.0f / powf(10000.0f, (float)(2 * i) / 64.0f); float s, c; sincosf((float)pos * inv, &s, &c); cs[idx] = make_float2(c, s); }
    float* wrf = (float*)(ws + W2_WRF);
    for (int idx = gt; idx < 2 * 36 * 1024; idx += ngt) { const int l = idx / (36 * 1024), j = (idx >> 10) % 36, k = idx & 1023;
        const float g = a.in[3][l * D + k]; wrf[idx] = g * (j < 4 ? a.in[16][(size_t)l * D * 4 + k * 4 + j] : a.in[18][(size_t)l * D * 32 + k * 32 + (j - 4)]); }
    { u32x4* z = (u32x4*)(ws + W2_WIN + (size_t)416 * 1024 * 2); for (int idx = gt; idx < 96 * 1024 * 2 / 16; idx += ngt) z[idx] = (u32x4){0u, 0u, 0u, 0u}; }
    { bf16_t* kpe = (bf16_t*)(ws + WS_KPE); for (int idx = gt; idx < 2 * 48 * 32; idx += ngt) { const int b = idx / (48 * 32), r = idx % (48 * 32); kpe[((size_t)b * LP + 8208) * 32 + r] = 0; }
      bf16_t* vt0 = (bf16_t*)(ws + B_VT0); for (int idx = gt; idx < 2 * 2 * 64 * 48; idx += ngt) { const int rr = idx / 48, c = idx % 48; vt0[(size_t)rr * LP + 8208 + c] = 0; } }
    { bf16_t* hb = (bf16_t*)(ws + W2_HB); float* rstd = (float*)(ws + W2_RSTD);
      for (int _r = 0; _r < (PROBE_PHASE == 303 ? 2 : 1); ++_r)
      for (int row = gw; row < MTOT; row += ngw) {
        const float* src = row < MREAL ? a.in[0] + (size_t)row * D : a.in[1] + (size_t)row_pos(row) * D;
        float ss = 0.f;
#pragma unroll
        for (int j = 0; j < 4; ++j) { const f32x4 v = *(const f32x4*)(src + j * 256 + lane * 4); ss += v[0] * v[0] + v[1] * v[1] + v[2] * v[2] + v[3] * v[3];
            *(u32x2*)(hb + (size_t)row * D + j * 256 + lane * 4) = (u32x2){pk2(v[0], v[1]), pk2(v[2], v[3])}; }
        ss = wave_sum(ss); if (lane == 0) rstd[row] = rsqrtf(ss * (1.0f / D) + EPS);
      } }
    LAS float* scr = (LAS float*)(lds + wave * 16384);
    for (int _r = 0; _r < (PROBE_PHASE == 304 ? 2 : 1); ++_r)
    for (int it = gw; it < 2192; it += ngw) {
        int r = it;
        if (r < 640) { transpose_item(a.in[5], NQKV, a.in[2], (bf16_t*)(ws + W2_WQKV), 1024, (r % 40) * 32, (r / 40) * 64, (r % 40) * 32, scr, lane); continue; } r -= 640;
        if (r < 512) { transpose_item(a.in[8], D, nullptr, (bf16_t*)(ws + W2_WO0), 1024, (r & 31) * 32, (r >> 5) * 64, (r & 31) * 32, scr, lane); continue; } r -= 512;
        if (r < 208) { transpose_item(a.in[10], 416, a.in[2] + D, (bf16_t*)(ws + W2_WIN), 1024, (r % 13) * 32, (r / 13) * 64, (r % 13) * 32, scr, lane); continue; } r -= 208;
        if (r < 192) { transpose_item(a.in[13], 1536, a.in[11], (bf16_t*)(ws + W2_WUQ), 256, (r % 48) * 32, (r / 48) * 64, (r % 48) * 32, scr, lane); continue; } r -= 192;
        if (r < 128) { const int nb32 = r & 63, hh = nb32 >> 2, part = nb32 & 3;
            transpose_item(a.in[14], 2048, a.in[12], (bf16_t*)(ws + W2_WUKV), 128, part < 2 ? hh * 64 + part * 32 : 1024 + hh * 64 + (part - 2) * 32, (r >> 6) * 64, nb32 * 32, scr, lane); continue; } r -= 128;
        transpose_item(a.in[15], D, nullptr, (bf16_t*)(ws + W2_WO1), 1024, (r & 31) * 32, (r >> 5) * 64, (r & 31) * 32, scr, lane);
    }
    __syncthreads();
    moe_weight_items(a.in[20], a.in[21], a.in[22], a.in[3], (bf16_t*)(ws + C_W0), (bf16_t*)(ws + C_W0 + MOE_WGU_BYTES), (LAS float*)lds, bid, nblk);
}

template <bool NSW, bool HALFN, class MakeEpi>
__device__ __forceinline__ void gemm_phase(LAS unsigned char* lds, const bf16_t* A, int lda, const bf16_t* Bt, int K, int pn0, int pn1, int bid, int nblk, const MakeEpi& mk) {
    constexpr int BN = HALFN ? 128 : 256;
    const int ntn = pn1 - pn0;
    const bool grp = (nblk % 8) == 0;
    const int x = grp ? bid % 8 : 0, j = grp ? bid / 8 : bid, nslot = grp ? nblk / 8 : nblk, pmg = grp ? 8 : 64;
    for (int u = j; u < pmg * ntn; u += nslot) {
        const int pm = x * pmg + u / ntn, pn = pn0 + u % ntn;
        RowDense ra{A, lda, pm * 256, MTOT - 1}; auto e = mk(pm * 256, pn * BN);
        if (HALFN) gemm_tile<4, 4, 4, 2, NSW>(lds, ra, Bt + (size_t)pn * BN * K, K, K / 32, e);
        else gemm_tile<8, 4, 2, 4, NSW>(lds, ra, Bt + (size_t)pn * BN * K, K, K / 32, e);
    }
    const int nfull = (pmg * ntn + nslot - 1) / nslot;
    for (int pn = pn0; pn < pn1; ++pn) {
        const int owner = (pn - pn0) * 37 % nblk;
        if (bid == owner) { RowDense ra{A, lda, MREAL, MTOT - 1}; auto e = mk(MREAL, pn * BN);
            if (HALFN) gemm_tile<1, 4, 4, 2, NSW>(lds, ra, Bt + (size_t)pn * BN * K, K, K / 32, e);
            else gemm_tile<1, 4, 2, 4, NSW>(lds, ra, Bt + (size_t)pn * BN * K, K, K / 32, e); }
    }
    (void)nfull;
}

constexpr int PH_PROLOGUE = 0, PH_QKV = 1, PH_SWA = 2, PH_OPROJ0 = 3, PH_ROUTE0 = 4, PH_MOE0 = 5, PH_COMBINE = 6, PH_WIN = 7, PH_CEPI = 8, PH_UQKV = 9, PH_MLA = 10, PH_OPROJ1 = 11, PH_ROUTE1 = 12, PH_MOE1 = 13, PH_FINAL = 14, PH_N = 15;
__global__ void __launch_bounds__(NTHR, 2) mega(MArgs a) {
    extern __shared__ __attribute__((aligned(16))) unsigned char lds_raw[];
    LAS unsigned char* lds = (LAS unsigned char*)lds_raw;
    const int tid = threadIdx.x, bid = blockIdx.x, nblk = gridDim.x;
    volatile LAS unsigned* misc = (volatile LAS unsigned*)(lds + LDS_MISC);
    if (tid < 64) misc[tid] = 0u;
    __syncthreads();
    unsigned char* ws = a.ws;
    XcdBarrier bar = xcd_barrier_post((unsigned*)(ws + WS_BAR) + a.li * XCD_BAR_WORDS, misc);
    if (tid == 0) misc[4] = xb_add((unsigned*)(ws + 32 * 1024) + 64 * bar.x, 1u);
    const int lo = a.ph_lo, hi = a.ph_hi;
#define IN(k) (lo <= (k) && (k) < hi)
#define REP(k) for (int _rep = 0; _rep < ((k) == PROBE_PHASE ? 2 : 1); ++_rep, (void)((k) == PROBE_PHASE && _rep == 1 ? (xcd_barrier(bar), 0) : 0))
#define STAMP(i) do { if (PROBE_PHASE >= 600 && bid == 0 && tid == 0) ((unsigned long long*)(ws + 512 * 1024))[i] = __builtin_amdgcn_s_memrealtime(); } while (0)
#define SEAM(k) do { if (IN(k) && IN((k) + 1)) xcd_barrier(bar); STAMP((k) + 1); } while (0)
    STAMP(0);
    if (PROBE_PHASE == 200) { for (int i = 0; i < 10; ++i) xcd_barrier(bar); }
    if (IN(PH_PROLOGUE)) REP(PH_PROLOGUE) p0_prologue(a, lds, bid, nblk);
    SEAM(PH_PROLOGUE);
    int vbid = bid;
    if (IN(PH_PROLOGUE) && IN(PH_QKV)) {
        if (tid == 0) { bool ok = (nblk % 8) == 0 && bar.x < 8;
            for (int j = 0; j < 8; ++j) ok = ok && xb_ld((unsigned*)(ws + 32 * 1024) + 64 * j) == (unsigned)(nblk / 8);
            misc[5] = ok ? misc[4] * 8u + bar.x : (unsigned)bid; }
        __syncthreads();
        vbid = __builtin_amdgcn_readfirstlane((int)misc[5]);
    }
#define bid vbid
    if (IN(PH_QKV)) REP(PH_QKV) {
        const float* rstd = (const float*)(ws + W2_RSTD); const float* bias = a.in[6]; const float2* cs = (const float2*)(ws + WS_ROPE); bf16_t* qkv = (bf16_t*)(ws + B_QKV); bf16_t* vt0 = (bf16_t*)(ws + B_VT0);
        const bf16_t* hbA = (const bf16_t*)(ws + W2_HB); const bf16_t* Wt = (const bf16_t*)(ws + W2_WQKV);
        const bool grp = (nblk % 8) == 0; const int x = grp ? bid % 8 : 0, j = grp ? bid / 8 : bid, nslot = grp ? nblk / 8 : nblk, pmg = grp ? 8 : 64;
        for (int u = j; u < pmg * 6; u += nslot) {
            if (u < pmg * 4) { const int pm = x * pmg + (u >> 2), pn = u & 3; RowDense ra{hbA, D, pm * 256, MTOT - 1}; EpiQKV e{rstd, bias, cs, qkv, pm * 256, pn * 256};
                gemm_tile<8, 4, 2, 4, false>(lds, ra, Wt + (size_t)pn * 256 * D, D, D / 32, e);
            } else if (u < pmg * 5) { const int pm = x * pmg + (u - pmg * 4); RowDense ra{hbA, D, pm * 256, MTOT - 1}; EpiQKV e{rstd, bias, cs, qkv, pm * 256, 1024};
                gemm_tile<4, 4, 4, 2, false>(lds, ra, Wt + (size_t)1024 * D, D, D / 32, e);
            } else { const int pm = x * pmg + (u - pmg * 5); RowDense ra{hbA, D, pm * 256, MTOT - 1}; EpiV0 e{rstd, bias, vt0, pm * 256, 1152};
                gemm_tile<4, 4, 4, 2, true>(lds, ra, Wt + (size_t)1152 * D, D, D / 32, e);
            }
        }
        const int mu = bid - (nblk - 6);
        if (mu >= 0 && mu < 4) { RowDense ra{hbA, D, MREAL, MTOT - 1}; EpiQKV e{rstd, bias, cs, qkv, MREAL, mu * 256};
            gemm_tile<1, 4, 2, 4, false>(lds, ra, Wt + (size_t)mu * 256 * D, D, D / 32, e);
        } else if (mu == 4) { RowDense ra{hbA, D, MREAL, MTOT - 1}; EpiQKV e{rstd, bias, cs, qkv, MREAL, 1024};
            gemm_tile<1, 4, 4, 2, false>(lds, ra, Wt + (size_t)1024 * D, D, D / 32, e);
        } else if (mu == 5) { RowDense ra{hbA, D, MREAL, MTOT - 1}; EpiV0 e{rstd, bias, vt0, MREAL, 1152};
            gemm_tile<1, 4, 4, 2, true>(lds, ra, Wt + (size_t)1152 * D, D, D / 32, e);
        }
    }
    SEAM(PH_QKV);
    if (IN(PH_SWA)) REP(PH_SWA) swa_phase(lds, (const bf16_t*)(ws + B_QKV), (const bf16_t*)(ws + B_VT0), a.in[7], (bf16_t*)(ws + B_O0), bid, nblk);
    SEAM(PH_SWA);
    if (IN(PH_OPROJ0)) REP(PH_OPROJ0) {
        const float* bias = a.in[9]; bf16_t* hb = (bf16_t*)(ws + W2_HB);
        gemm_phase<false, false>(lds, (const bf16_t*)(ws + B_O0), D, (const bf16_t*)(ws + W2_WO0), D, 0, 4, bid, nblk, [=](int m0, int n0) { return EpiRes{bias, hb, m0, n0}; });
    }
    SEAM(PH_OPROJ0);
    if (IN(PH_ROUTE0) && PROBE_PHASE == PH_ROUTE0) { route_phase(lds, (const bf16_t*)(ws + W2_HB), (const float*)(ws + W2_WRF), a.in[17], a.in[19], (float*)(ws + W2_RSTD), (int*)(ws + WS_CTL) + 4096,
                    (int*)(ws + W2_LIST), (float*)(ws + W2_WSLOT), bid, nblk); xcd_barrier(bar); }
    if (IN(PH_ROUTE0))
        route_phase(lds, (const bf16_t*)(ws + W2_HB), (const float*)(ws + W2_WRF), a.in[17], a.in[19], (float*)(ws + W2_RSTD), (int*)(ws + WS_CTL),
                    (int*)(ws + W2_LIST), (float*)(ws + W2_WSLOT), bid, nblk);
    SEAM(PH_ROUTE0);
    if (IN(PH_MOE0)) REP(PH_MOE0) moe_phase(lds, (int*)(ws + WS_CTL), (const int*)(ws + W2_LIST), (const bf16_t*)(ws + W2_HB), (const float*)(ws + W2_RSTD), (const float*)(ws + W2_WSLOT),
                               (const bf16_t*)(ws + C_W0), (const bf16_t*)(ws + C_W0 + MOE_WGU_BYTES), (bf16_t*)(ws + B_Y0), bid, nblk, (unsigned long long*)(ws + 512 * 1024));
    SEAM(PH_MOE0);
    if (IN(PH_COMBINE)) l1proj_phase(lds, (bf16_t*)(ws + W2_HB), (const bf16_t*)(ws + B_Y0), (const bf16_t*)(ws + W2_WIN), (const bf16_t*)(ws + W2_WUQ), (const bf16_t*)(ws + W2_WUKV),
                                     (const float2*)(ws + WS_ROPE), (bf16_t*)(ws + WS_KPE), (bf16_t*)(ws + C_Q1), (bf16_t*)(ws + C_K1), (bf16_t*)(ws + C_V1), bid, nblk);
    STAMP(PH_WIN); STAMP(PH_CEPI); STAMP(PH_UQKV);
    SEAM(PH_UQKV);
    if (IN(PH_MLA)) REP(100) {
        moe_weight_items(a.in[20] + (size_t)NE * D * DE, a.in[21] + (size_t)NE * D * DE, a.in[22] + (size_t)NE * DE * D, a.in[3] + D, (bf16_t*)(ws + B_W1), (bf16_t*)(ws + B_W1 + MOE_WGU_BYTES),
                         (LAS float*)lds, bid, nblk);
    }
    if (IN(PH_MLA)) REP(PH_MLA) mla_phase(lds, (const bf16_t*)(ws + C_Q1), (const bf16_t*)(ws + C_K1), (const bf16_t*)(ws + WS_KPE), (const bf16_t*)(ws + C_V1), (bf16_t*)(ws + B_O1), bid, nblk);
    SEAM(PH_MLA);
    if (IN(PH_OPROJ1)) REP(PH_OPROJ1) {
        bf16_t* hb = (bf16_t*)(ws + W2_HB);
        gemm_phase<false, false>(lds, (const bf16_t*)(ws + B_O1), D, (const bf16_t*)(ws + W2_WO1), D, 0, 4, bid, nblk, [=](int m0, int n0) { return EpiRes{nullptr, hb, m0, n0}; });
    }
    SEAM(PH_OPROJ1);
    if (IN(PH_ROUTE1))
        route_phase(lds, (const bf16_t*)(ws + W2_HB), (const float*)(ws + W2_WRF) + 36 * 1024, a.in[17] + 4, a.in[19] + 32, (float*)(ws + W2_RSTD), (int*)(ws + WS_CTL) + 2048,
                    (int*)(ws + W2_LIST), (float*)(ws + W2_WSLOT), bid, nblk);
    SEAM(PH_ROUTE1);
    if (IN(PH_MOE1)) REP(PH_MOE1) moe_phase(lds, (int*)(ws + WS_CTL) + 2048, (const int*)(ws + W2_LIST), (const bf16_t*)(ws + W2_HB), (const float*)(ws + W2_RSTD), (const float*)(ws + W2_WSLOT),
                               (const bf16_t*)(ws + B_W1), (const bf16_t*)(ws + B_W1 + MOE_WGU_BYTES), (bf16_t*)(ws + C_Y1), bid, nblk);
    SEAM(PH_MOE1);
    if (IN(PH_FINAL)) REP(PH_FINAL) final_phase((const bf16_t*)(ws + W2_HB), (const bf16_t*)(ws + C_Y1), a.in[4], a.out, bid, nblk);
    if (PROBE_PHASE == 501) { xcd_barrier(bar);
        for (int i = 0; i < 4; ++i) gemm_phase<false, false>(lds, (const bf16_t*)(ws + B_O1), D, (const bf16_t*)(ws + W2_WO1), D, 0, 4, bid, nblk, [=](int m0, int n0) { return EpiNull{m0, n0}; }); }
    if (PROBE_PHASE == 504 || PROBE_PHASE == 505) { xcd_barrier(bar);
        for (int i = 0; i < 4; ++i) { RowDense ra{(const bf16_t*)(ws + B_O1), D, 0, MTOT - 1}; EpiNull e{0, 0};
            gemm_tile<8, 4, 2, 4, false, RowDense, EpiNull, true>(lds, ra, (const bf16_t*)(ws + W2_WO1), D, 32, e); } }
    if (PROBE_PHASE >= 701 && PROBE_PHASE <= 706) { xcd_barrier(bar);
        const int lane = tid & 63, wave = __builtin_amdgcn_readfirstlane(tid >> 6);
        const unsigned char* base = ws + W2_WIN;
        if (PROBE_PHASE == 703 || PROBE_PHASE == 704) base = ws + W2_RB + (size_t)(bid % 64) * MiB;
        if (PROBE_PHASE == 705) base = ws + W2_RB + (size_t)(bid % 8) * MiB;
        if (PROBE_PHASE == 706) base = ws + W2_HB + (size_t)bid * (MiB / 2);
        const char* src[4];
        for (int i = 0; i < 4; ++i) src[i] = (const char*)base + (size_t)((wave + 8 * i) * 16 + (lane >> 2)) * 2048 + (lane & 3) * 16;
        const bool nobar = PROBE_PHASE == 702 || PROBE_PHASE == 704;
        const int nstep = 256, wrap = PROBE_PHASE == 706 ? 16 : 32;
#define P_ISSUE(stg, k) do { for (int _i = 0; _i < 4; ++_i) __builtin_amdgcn_global_load_lds((const unsigned*)(src[_i] + (size_t)((k) % wrap) * 64 + (size_t)(((k) % wrap) >> 5) * 0), (LAS unsigned*)(lds + (stg) * 32768 + (wave + 8 * _i) * 1024), 16, 0, 0); } while (0)
        P_ISSUE(0, 0); P_ISSUE(1, 1);
        int st = 0;
        for (int k = 0; k < nstep; ++k) {
            if (k + 1 < nstep) wait_vm<4>(); else wait_vm<0>();
            if (!nobar) { __builtin_amdgcn_s_barrier(); asm volatile("" ::: "memory"); }
            if (k + 2 < nstep) P_ISSUE(st == 0 ? 2 : st - 1, k + 2);
            st = st == 2 ? 0 : st + 1;
        }
#undef P_ISSUE
        __syncthreads();
    }
    if (PROBE_PHASE == 503) { xcd_barrier(bar); }
    if (PROBE_PHASE >= 600) { STAMP(PH_N);
        if (bid == 0 && tid == 0) { const unsigned long long* ts = (const unsigned long long*)(ws + 512 * 1024);
            const unsigned long long d = __hip_atomic_load(ts + (PROBE_PHASE - 600 + 1), __ATOMIC_RELAXED, __HIP_MEMORY_SCOPE_AGENT) - __hip_atomic_load(ts + (PROBE_PHASE - 600), __ATOMIC_RELAXED, __HIP_MEMORY_SCOPE_AGENT);
            const unsigned long long t0 = __builtin_amdgcn_s_memrealtime();
            while (__builtin_amdgcn_s_memrealtime() - t0 < 8ull * d) __builtin_amdgcn_s_sleep(8); } }
#undef bid
#undef IN
#undef SEAM
}

static void run_mega(hipStream_t s, const MArgs& base, int lo, int hi, int grid) {
    MArgs a = base; a.ph_lo = lo; a.ph_hi = hi; a.li = lo;
    hipLaunchKernelGGL(mega, dim3(grid), dim3(NTHR), LDS_BYTES, s, a);
}
extern "C" void kernel_launch(void* const* d_in, const int* in_sizes, int n_in, void* d_out, int out_size, void* d_ws, size_t ws_size, hipStream_t stream) {
    static int grid = 0;
    if (grid == 0) {
        if (n_in != 23 || ws_size < WS_END) { fprintf(stderr, "kernel_launch: unexpected n_in %d or ws_size %zu\n", n_in, ws_size); grid = -1; return; }
        if (hipFuncSetAttribute((const void*)mega, hipFuncAttributeMaxDynamicSharedMemorySize, LDS_BYTES) != hipSuccess) { fprintf(stderr, "hipFuncSetAttribute failed\n"); grid = -1; return; }
        int dev = 0, cus = 0, per_cu = 0;
        (void)hipGetDevice(&dev); (void)hipDeviceGetAttribute(&cus, hipDeviceAttributeMultiprocessorCount, dev);
        (void)hipOccupancyMaxActiveBlocksPerMultiprocessor(&per_cu, (const void*)mega, NTHR, LDS_BYTES);
        if (per_cu < 1) { fprintf(stderr, "occupancy query says %d blocks/CU\n", per_cu); }
        (void)hipGetLastError();
        grid = cus;
    }
    if (grid < 0) return;
    (void)in_sizes; (void)out_size;
    unsigned char* ws = (unsigned char*)d_ws;
    MArgs base{}; for (int i = 0; i < 23; ++i) base.in[i] = (const float*)d_in[i]; base.out = (float*)d_out; base.ws = ws;
    (void)hipMemsetAsync(ws + WS_CTL, 0, 1 * MiB, stream);
    run_mega(stream, base, 0, PH_N, grid);
}
```

```cpp
#include <hip/hip_runtime.h>
#ifndef PROBE_PHASE
#define PROBE_PHASE -1
#endif
#include <cstdio>
#include <cstdint>

typedef unsigned short bf16_t;

constexpr int D = 1024, SEQ = 8192, NB = 2, NMETA = 16;
constexpr int MREAL = NB * SEQ;
constexpr int MTOT = MREAL + NB * NMETA;
constexpr int LPOS = NMETA + SEQ;
constexpr int NQKV = 1280;
constexpr int NE = 32, DE = 256;
constexpr int CAP = MTOT * 2;
constexpr float EPS = 1e-6f;

__device__ __forceinline__ float bf2f(bf16_t v) { return __uint_as_float(((unsigned)v) << 16); }
__device__ __forceinline__ bf16_t f2bf(float f) { unsigned u = __float_as_uint(f); u += 0x7fffu + ((u >> 16) & 1u); return (bf16_t)(u >> 16); }
__device__ __forceinline__ int row_pos(int row) { return row < MREAL ? NMETA + (row & (SEQ - 1)) : ((row - MREAL) & (NMETA - 1)); }
__device__ __forceinline__ int row_batch(int row) { return row < MREAL ? (row >> 13) : ((row - MREAL) >> 4); }
constexpr int LP = 8256;
__device__ __forceinline__ int perm16(int p) { const int qd = (p >> 2) & 3; return (p & ~12) | ((((qd & 1) << 1) | (qd >> 1)) << 2); }
__device__ __forceinline__ float wave_sum(float v) {
#pragma unroll
    for (int o = 1; o < 64; o <<= 1) v += __shfl_xor(v, o);
    return v;
}

constexpr size_t MiB = 1u << 20;
constexpr size_t WS_CTL = 0;
constexpr size_t WS_ROPE = 1 * MiB;
constexpr size_t WS_END = 256 * MiB;

#define LAS __attribute__((address_space(3)))
#define GAS __attribute__((address_space(1)))
typedef short bf16x8 __attribute__((ext_vector_type(8)));
typedef float f32x4 __attribute__((ext_vector_type(4)));
typedef unsigned u32x4 __attribute__((ext_vector_type(4)));
typedef unsigned u32x2 __attribute__((ext_vector_type(2)));
constexpr int NTHR = 512, NWAVE = 8;
constexpr int LDS_MISC = 162816;
constexpr int LDS_BYTES = LDS_MISC + 1024;

constexpr size_t WS_BAR = 64 * 1024;
constexpr size_t WS_KPE = 3 * MiB + 256 * 1024;
constexpr size_t W2_RSTD = 4 * MiB + 512 * 1024, W2_WSLOT = W2_RSTD + 80 * 1024, W2_EID = W2_WSLOT + 144 * 1024;
constexpr size_t W2_LIST = 5 * MiB;
constexpr size_t W2_WRF = 9 * MiB + 256 * 1024;
constexpr size_t W2_WQKV = 10 * MiB;
constexpr size_t W2_WO0 = W2_WQKV + 2560 * 1024;
constexpr size_t W2_WIN = W2_WO0 + 2048 * 1024;
constexpr size_t W2_WUQ = W2_WIN + 1024 * 1024;
constexpr size_t W2_WUKV = W2_WUQ + 768 * 1024;
constexpr size_t W2_WO1 = W2_WUKV + 512 * 1024;
constexpr size_t W2_HB = 20 * MiB;
constexpr size_t W2_RB = 53 * MiB;
constexpr size_t W2_RC = 134 * MiB;
static_assert(W2_EID + (size_t)MTOT * 8 <= W2_LIST && W2_LIST + (size_t)NE * CAP * 4 <= W2_WRF && W2_WO1 + 2 * MiB <= W2_HB && W2_HB + (size_t)MTOT * 2048 <= W2_RB, "fixed map");
constexpr size_t B_QKV = W2_RB, B_O0 = W2_RB + 41 * MiB, B_VT0 = W2_RB + 74 * MiB  , B_Y0 = W2_RB, B_CBUF = W2_RB, B_CQN = W2_RB + 33 * MiB, B_CKVN = W2_RB + 42 * MiB, B_O1 = W2_RB, B_W1 = W2_RB + 33 * MiB;
constexpr size_t C_W0 = W2_RC, C_HF = W2_RC + 48 * MiB, C_Q1 = W2_RC, C_K1 = W2_RC + 49 * MiB, C_V1 = W2_RC + 82 * MiB, C_HF1 = W2_RC, C_Y1 = W2_RC;
static_assert(C_V1 + (size_t)2 * 16 * 64 * LP * 2 <= WS_END && C_K1 + (size_t)2 * LP * 2048 <= C_V1 && B_VT0 + (size_t)2 * 2 * 64 * LP * 2 <= W2_RC && C_HF + (size_t)MTOT * 4096 <= WS_END && B_W1 + 48 * MiB <= W2_RC, "region map");
constexpr size_t MOE_WGU_BYTES = (size_t)NE * 512 * 1024 * 2, MOE_WD_BYTES = (size_t)NE * 1024 * 256 * 2;

struct MArgs { const float* in[23]; float* out; unsigned char* ws; int ph_lo, ph_hi, li, pad; };

__device__ __forceinline__ unsigned pk2(float lo, float hi) { return (unsigned)f2bf(lo) | ((unsigned)f2bf(hi) << 16); }

#define XB_TMO      128
#define XB_XCNT(j)  (256  + 64 * (j))
#define XB_XSUB(j)  (1280 + 64 * (j))
#define XB_XGEN(j)  (2304 + 64 * (j))
#define XB_TOP      3328
#define XB_TOPGEN   3392
#define XCD_BAR_WORDS 3456
#define XB_SPIN_CAP (1u << 18)
__device__ __forceinline__ unsigned xb_ld(unsigned* p)              { return __hip_atomic_load(p, __ATOMIC_RELAXED, __HIP_MEMORY_SCOPE_AGENT); }
__device__ __forceinline__ unsigned xb_add(unsigned* p, unsigned v) { return __hip_atomic_fetch_add(p, v, __ATOMIC_RELAXED, __HIP_MEMORY_SCOPE_AGENT); }
__device__ __forceinline__ unsigned xb_xcc_id() { return (unsigned)__builtin_amdgcn_s_getreg((3 << 11) | 20) & 0xFu; }
#define XB_SPIN(cond, bar) do { unsigned _sp = 0; while (cond) { __builtin_amdgcn_s_sleep(1); \
    if ((++_sp & 255u) == 0u) { if (xb_ld(&(bar)[XB_TMO])) break; if (_sp > XB_SPIN_CAP) { atomicAdd(&(bar)[XB_TMO], 1u); break; } } } } while (0)
struct XcdBarrier { unsigned* bar; unsigned x; volatile LAS unsigned* st; };
__device__ __forceinline__ XcdBarrier xcd_barrier_post(unsigned* bar, volatile LAS unsigned* st) {
    XcdBarrier b; b.bar = bar; b.x = xb_xcc_id(); b.st = st;
    if (threadIdx.x == 0) (void)xb_add(&bar[XB_XCNT(b.x)], 1u);
    return b;
}
__device__ __forceinline__ void xcd_barrier_complete(unsigned* bar, unsigned x, unsigned& nloc, unsigned& nx) {
    const unsigned G = gridDim.x * gridDim.y * gridDim.z;
    unsigned sum, cnt, mine, sp = 0u;
    for (;;) {
        sum = 0u; cnt = 0u; mine = 0u;
#pragma unroll
        for (unsigned j = 0; j < 16; ++j) { const unsigned c = xb_ld(&bar[XB_XCNT(j)]); sum += c; cnt += (c > 0u) ? 1u : 0u; mine = (j == x) ? c : mine; }
        if (sum == G) break;
        __builtin_amdgcn_s_sleep(1);
        if ((++sp & 255u) == 0u) { if (xb_ld(&bar[XB_TMO])) break; if (sp > XB_SPIN_CAP) { atomicAdd(&bar[XB_TMO], 1u); break; } }
    }
    nloc = mine > 0u ? mine : 1u; nx = cnt > 0u ? cnt : 1u;
}
__device__ __forceinline__ void xcd_barrier(const XcdBarrier& b) {
    asm volatile("s_waitcnt vmcnt(0)" ::: "memory");
    __syncthreads();
    if (threadIdx.x == 0) {
        unsigned* bar = b.bar;
        __builtin_amdgcn_s_waitcnt(0);
        unsigned nloc = b.st[0], nx = b.st[1];
        if (nloc == 0u) { xcd_barrier_complete(bar, b.x, nloc, nx); b.st[0] = nloc; b.st[1] = nx; }
        const unsigned old = xb_add(&bar[XB_XSUB(b.x)], 1u);
        const unsigned gen = old / nloc;
        if (old + 1u == (gen + 1u) * nloc) {
            __builtin_amdgcn_fence(__ATOMIC_RELEASE, "agent");
            asm volatile("s_waitcnt vmcnt(0)" ::: "memory");
            const unsigned og = xb_add(&bar[XB_TOP], 1u);
            const unsigned tg = og / nx;
            if (og + 1u == (tg + 1u) * nx) xb_add(&bar[XB_TOPGEN], 1u);
            else XB_SPIN(xb_ld(&bar[XB_TOPGEN]) == tg, bar);
            __builtin_amdgcn_fence(__ATOMIC_ACQUIRE, "agent");
            xb_add(&bar[XB_XGEN(b.x)], 1u);
            asm volatile("s_waitcnt vmcnt(0)" ::: "memory");
        } else {
            XB_SPIN(xb_ld(&bar[XB_XGEN(b.x)]) == gen, bar);
            __builtin_amdgcn_fence(__ATOMIC_ACQUIRE, "agent");
            asm volatile("s_waitcnt vmcnt(0)" ::: "memory");
        }
    }
    __syncthreads();
}

template <int N> __device__ __forceinline__ void wait_vm() { asm volatile("s_waitcnt vmcnt(%0)" :: "n"(N) : "memory"); }
__device__ __forceinline__ int swzF(int g) { return (0x78 >> (2 * g)) & 3; }
constexpr int GT_NS = 4;
template <int MT, int NT, int WM, int WN, bool NSW, class RowA, class Epi, bool NOLD = false>
__device__ __forceinline__ void gemm_tile(LAS unsigned char* lds, const RowA& rowA, const bf16_t* __restrict__ Bt, int ldb  , int nk  , Epi& epi) {
    constexpr int BM = WM * MT * 16, BN = WN * NT * 16, GA = BM / 16, G = (BM + BN) / 16, NG = (G + 7) / 8, GR = G % 8, STAGE = (BM + BN) * 64;
    static_assert(WM * WN == 8 && GT_NS * STAGE <= LDS_MISC && BM % 16 == 0 && BN % 16 == 0, "gemm_tile config");
    const int tid = threadIdx.x, lane = tid & 63, wave = __builtin_amdgcn_readfirstlane(tid >> 6), wm = wave / WN, wn = wave % WN;
    const char* src[NG];
    const int lc = (lane & 3) ^ swzF(lane >> 4);
#pragma unroll
    for (int i = 0; i < NG; ++i) {
        const int g = wave + 8 * i;
        if (g < GA) src[i] = (const char*)rowA(g * 16 + (lane >> 2)) + lc * 16;
        else if (g < G) src[i] = (const char*)(Bt + (size_t)((g - GA) * 16 + (lane >> 2)) * ldb) + lc * 16;
        else src[i] = nullptr;
    }
    f32x4 acc[MT][NT];
#pragma unroll
    for (int mi = 0; mi < MT; ++mi)
#pragma unroll
        for (int ni = 0; ni < NT; ++ni) acc[mi][ni] = (f32x4){0.f, 0.f, 0.f, 0.f};
    const int fro = (lane & 15) * 64 + (((lane >> 4) ^ swzF((lane >> 2) & 3)) << 4);
    constexpr int LM = PROBE_PHASE == 402 ? 2 : 1;
#define GT_STAGE(st, kt) do { _Pragma("unroll") for (int _i = 0; _i < NG; ++_i) { const int _g = wave + 8 * _i; if (_g < G) { \
        __builtin_amdgcn_global_load_lds((const unsigned*)(src[_i] + (size_t)(kt) * 64), (LAS unsigned*)(lds + (st) * STAGE + _g * 1024), 16, 0, 0); \
        if (LM == 2) __builtin_amdgcn_global_load_lds((const unsigned*)(src[_i] + (size_t)(kt) * 64), (LAS unsigned*)(lds + (st) * STAGE + _g * 1024), 16, 0, 0); } } } while (0)
#define GT_WAIT(ntl) do { if (GR == 0 || wave < GR) wait_vm<LM * NG * (ntl)>(); else wait_vm<LM * (NG - 1) * (ntl)>(); } while (0)
    if (!NOLD) { GT_STAGE(0, 0);
    if (nk > 1) GT_STAGE(1, 1);
    if (nk > 2) GT_STAGE(2, 2); }
    int st = 0;
    for (int kt = 0; kt < nk; ++kt) {
        const int rem = nk - 1 - kt;
        if (!NOLD) { if (rem >= 2) GT_WAIT(2); else if (rem == 1) GT_WAIT(1); else GT_WAIT(0); }
        __builtin_amdgcn_s_barrier(); asm volatile("" ::: "memory");
        const bool doload = (!NOLD || PROBE_PHASE == 505) && kt + 3 < nk;
        LAS const unsigned char* sa = lds + st * STAGE + (wm * MT * 16) * 64 + fro;
        LAS const unsigned char* sb = lds + st * STAGE + (BM + wn * NT * 16) * 64 + fro;
        bf16x8 bfr[NT];
#pragma unroll
        for (int ni = 0; ni < NT; ++ni) bfr[ni] = *(LAS const bf16x8*)(sb + ni * 1024);
        constexpr int PG = MT >= 2 ? 2 : 1, NPG = MT / PG;
        constexpr int LPG = (NG + NPG - 1) / NPG;
        bf16x8 afc[PG], afn[PG];
#pragma unroll
        for (int i = 0; i < PG; ++i) afc[i] = *(LAS const bf16x8*)(sa + i * 1024);
#pragma unroll
        for (int pg = 0; pg < NPG; ++pg) {
            if (doload) {
#pragma unroll
                for (int l = 0; l < LPG; ++l) { const int _i = pg * LPG + l; if (_i < NG) { const int _g = wave + 8 * _i; if (_g < G)
                    __builtin_amdgcn_global_load_lds((const unsigned*)(src[_i] + (size_t)(kt + 3) * 64), (LAS unsigned*)(lds + ((st + 3) & 3) * STAGE + _g * 1024), 16, 0, 0); } }
            }
            if (pg + 1 < NPG) {
#pragma unroll
                for (int i = 0; i < PG; ++i) afn[i] = *(LAS const bf16x8*)(sa + ((pg + 1) * PG + i) * 1024);
            }
#pragma unroll
            for (int i = 0; i < PG; ++i) { const int mi = pg * PG + i;
#pragma unroll
                for (int ni = 0; ni < NT; ++ni) {
                    if (NSW) acc[mi][ni] = __builtin_amdgcn_mfma_f32_16x16x32_bf16(afc[i], bfr[ni], acc[mi][ni], 0, 0, 0);
                    else acc[mi][ni] = __builtin_amdgcn_mfma_f32_16x16x32_bf16(bfr[ni], afc[i], acc[mi][ni], 0, 0, 0);
                } }
#pragma unroll
            for (int i = 0; i < PG; ++i) afc[i] = afn[i];
            __builtin_amdgcn_sched_barrier(0);
        }
        st = (st + 1) & 3;
    }
#undef GT_STAGE
#undef GT_WAIT
    epi(acc, wm * MT * 16, wn * NT * 16, lane);
    asm volatile("s_waitcnt lgkmcnt(0)" ::: "memory");
    __syncthreads();
}

struct RowDense { const bf16_t* A; int lda, m0, mlast; __device__ __forceinline__ const bf16_t* operator()(int r) const { int row = m0 + r; row = row > mlast ? mlast : row; return A + (size_t)row * lda; } };

struct EpiQKV {
    const float* rstd; const float* bias; const float2* cs; bf16_t* qkv; int m0, n0;
    template <int MT, int NT> __device__ __forceinline__ void operator()(f32x4 (&acc)[MT][NT], int mb, int nb, int lane) const {
        static_assert(NT == 4, "rope needs a 64-column wave span");
        const int cb = n0 + nb, d0 = (lane >> 4) * 4;
#pragma unroll
        for (int mi = 0; mi < MT; ++mi) {
            const int row = m0 + mb + mi * 16 + (lane & 15);
            if (row < MTOT) {
                const float rs = rstd[row]; const int pos = row_pos(row);
                bf16_t* orow = qkv + (size_t)row * NQKV + cb;
                {
                    const float sc = cb < 1024 ? 0.125f : 1.0f;
#pragma unroll
                    for (int ni = 0; ni < 2; ++ni) {
                        const int d = ni * 16 + d0;
                        const f32x4 b1 = *(const f32x4*)(bias + cb + d), b2 = *(const f32x4*)(bias + cb + 32 + d);
                        float o1[4], o2[4];
#pragma unroll
                        for (int r = 0; r < 4; ++r) {
                            const float2 t = cs[pos * 32 + d + r];
                            const float x1 = acc[mi][ni][r] * rs + b1[r], x2 = acc[mi][ni + 2][r] * rs + b2[r];
                            o1[r] = (x1 * t.x - x2 * t.y) * sc; o2[r] = (x2 * t.x + x1 * t.y) * sc;
                        }
                        *(u32x2*)(orow + d) = (u32x2){pk2(o1[0], o1[1]), pk2(o1[2], o1[3])};
                        *(u32x2*)(orow + 32 + d) = (u32x2){pk2(o2[0], o2[1]), pk2(o2[2], o2[3])};
                    }
                }
            }
        }
    }
};
struct EpiV0 {
    const float* rstd; const float* bias; bf16_t* vt0; int m0, n0;
    template <int MT, int NT> __device__ __forceinline__ void operator()(f32x4 (&acc)[MT][NT], int mb, int nb, int lane) const {
        static_assert(NT == 4, "64-column wave span");
        const int cb = n0 + nb, kh = (cb - 1152) >> 6;
#pragma unroll
        for (int mi = 0; mi < MT; ++mi) {
            const int row0 = m0 + mb + mi * 16 + (lane >> 4) * 4;
            if (row0 < MTOT) {
                const f32x4 rs = *(const f32x4*)(rstd + row0); const int b = row_batch(row0), pp = perm16(row_pos(row0));
#pragma unroll
                for (int ni = 0; ni < NT; ++ni) { const int d = ni * 16 + (lane & 15); const float bb = bias[cb + d];
                    const f32x4 v = acc[mi][ni] * rs + bb;
                    *(u32x2*)(vt0 + (size_t)((b * 2 + kh) * 64 + d) * LP + pp) = (u32x2){pk2(v[0], v[1]), pk2(v[2], v[3])}; }
            }
        }
    }
};
struct EpiRes {
    const float* bias; bf16_t* hb; int m0, n0;
    template <int MT, int NT> __device__ __forceinline__ void operator()(f32x4 (&acc)[MT][NT], int mb, int nb, int lane) const {
#pragma unroll
        for (int mi = 0; mi < MT; ++mi) {
            const int row = m0 + mb + mi * 16 + (lane & 15);
            if (row < MTOT) {
#pragma unroll
                for (int ni = 0; ni < NT; ++ni) {
                    const int col = n0 + nb + ni * 16 + (lane >> 4) * 4;
                    u32x2* p = (u32x2*)(hb + (size_t)row * D + col);
                    const u32x2 h = *p;
                    f32x4 v = acc[mi][ni];
                    if (bias) v += *(const f32x4*)(bias + col);
                    v[0] += __uint_as_float(h.x << 16); v[1] += __uint_as_float(h.x & 0xffff0000u); v[2] += __uint_as_float(h.y << 16); v[3] += __uint_as_float(h.y & 0xffff0000u);
                    *p = (u32x2){pk2(v[0], v[1]), pk2(v[2], v[3])};
                }
            }
        }
    }
};
__device__ __forceinline__ void route_phase(LAS unsigned char* lds, const bf16_t* __restrict__ hbr, const float* __restrict__ wrf, const float* __restrict__ bg, const float* __restrict__ br,
                                            float* rstd_out, int* cnt, int* list, float* wslot, int bid, int nblk) {
    const int tid = threadIdx.x, lane = tid & 63, wave = __builtin_amdgcn_readfirstlane(tid >> 6);
    LAS f32x4* wl = (LAS f32x4*)lds;
    LAS int* nrec = (LAS int*)(lds + LDS_MISC + 16); LAS int* bcnt = (LAS int*)(lds + LDS_MISC + 32); LAS int* bbase = (LAS int*)(lds + LDS_MISC + 160); LAS int* rec = (LAS int*)(lds + LDS_MISC + 288);
    for (int i = tid; i < 36 * 256; i += NTHR) wl[i] = *(const f32x4*)(wrf + (size_t)i * 4);
    if (tid < NE) bcnt[tid] = 0;
    if (tid == 0) *nrec = 0;
    __syncthreads();
    for (int row = bid * NWAVE + wave; row < MTOT; row += nblk * NWAVE) {
        f32x4 x[4]; float ss = 0.f;
#pragma unroll
        for (int j = 0; j < 4; ++j) { const u32x2 h = *(const u32x2*)(hbr + (size_t)row * D + j * 256 + lane * 4);
            x[j] = (f32x4){__uint_as_float(h.x << 16), __uint_as_float(h.x & 0xffff0000u), __uint_as_float(h.y << 16), __uint_as_float(h.y & 0xffff0000u)};
            ss += x[j][0] * x[j][0] + x[j][1] * x[j][1] + x[j][2] * x[j][2] + x[j][3] * x[j][3]; }
        ss = wave_sum(ss);
        const float rs = rsqrtf(ss * (1.0f / D) + EPS);
        float lg[4];
#pragma unroll
        for (int c = 0; c < 4; ++c) { float p = 0.f;
#pragma unroll
            for (int j = 0; j < 4; ++j) { const f32x4 w = wl[c * 256 + j * 64 + lane]; p += x[j][0] * w[0] + x[j][1] * w[1] + x[j][2] * w[2] + x[j][3] * w[3]; }
            lg[c] = wave_sum(p) * rs + bg[c]; }
        int gi = 0; float gm = lg[0];
#pragma unroll
        for (int c = 1; c < 4; ++c) if (lg[c] > gm) { gm = lg[c]; gi = c; }
        float gs = 0.f;
#pragma unroll
        for (int c = 0; c < 4; ++c) gs += __expf(lg[c] - gm);
        const float gp = 1.0f / gs;
        gi = __builtin_amdgcn_readfirstlane(gi);
        float e[8];
#pragma unroll
        for (int c = 0; c < 8; ++c) { float p = 0.f;
#pragma unroll
            for (int j = 0; j < 4; ++j) { const f32x4 w = wl[(4 + gi * 8 + c) * 256 + j * 64 + lane]; p += x[j][0] * w[0] + x[j][1] * w[1] + x[j][2] * w[2] + x[j][3] * w[3]; }
            e[c] = wave_sum(p) * rs + br[gi * 8 + c]; }
        int i1 = 0; float v1 = e[0];
#pragma unroll
        for (int c = 1; c < 8; ++c) if (e[c] > v1) { v1 = e[c]; i1 = c; }
        int i2 = -1; float v2 = -3.0e38f;
#pragma unroll
        for (int c = 0; c < 8; ++c) if (c != i1 && e[c] > v2) { v2 = e[c]; i2 = c; }
        if (lane == 0) {
            const float r = __expf(v2 - v1);
            const float w1 = gp / (1.0f + r), w2 = gp * r / (1.0f + r);
            const int e1 = gi * 8 + i1, e2 = gi * 8 + i2;
            const int p1 = atomicAdd((int*)&bcnt[e1], 1), p2 = atomicAdd((int*)&bcnt[e2], 1);
            const int k = atomicAdd((int*)nrec, 2);
            rec[k] = ((row * 2) << 13) | (e1 << 8) | p1; rec[k + 1] = ((row * 2 + 1) << 13) | (e2 << 8) | p2;
            wslot[row * 2] = w1; wslot[row * 2 + 1] = w2; rstd_out[row] = rs;
        }
    }
    __syncthreads();
    if (tid < NE) { const int c = bcnt[tid]; bbase[tid] = c ? __hip_atomic_fetch_add(cnt + tid * 64, c, __ATOMIC_RELAXED, __HIP_MEMORY_SCOPE_AGENT) : 0; }
    __syncthreads();
    for (int k = tid; k < *nrec; k += NTHR) { const int r = rec[k], e = (r >> 8) & 31; list[(size_t)e * CAP + bbase[e] + (r & 255)] = r >> 13; }
    __syncthreads();
}
__device__ __forceinline__ void final_phase(const bf16_t* __restrict__ hb, const bf16_t* __restrict__ ybuf, const float* __restrict__ g, float* out, int bid, int nblk) {
    const int tid = threadIdx.x, lane = tid & 63, wave = tid >> 6;
    for (int row = bid * NWAVE + wave; row < MREAL; row += nblk * NWAVE) {
        f32x4 v[4]; float ss = 0.f;
#pragma unroll
        for (int j = 0; j < 4; ++j) { const size_t c = j * 256 + lane * 4;
            const u32x2 h = *(const u32x2*)(hb + (size_t)row * D + c), y0 = *(const u32x2*)(ybuf + (size_t)(row * 2) * D + c), y1 = *(const u32x2*)(ybuf + (size_t)(row * 2 + 1) * D + c);
            v[j][0] = __uint_as_float(h.x << 16) + __uint_as_float(y0.x << 16) + __uint_as_float(y1.x << 16);
            v[j][1] = __uint_as_float(h.x & 0xffff0000u) + __uint_as_float(y0.x & 0xffff0000u) + __uint_as_float(y1.x & 0xffff0000u);
            v[j][2] = __uint_as_float(h.y << 16) + __uint_as_float(y0.y << 16) + __uint_as_float(y1.y << 16);
            v[j][3] = __uint_as_float(h.y & 0xffff0000u) + __uint_as_float(y0.y & 0xffff0000u) + __uint_as_float(y1.y & 0xffff0000u);
            ss += v[j][0] * v[j][0] + v[j][1] * v[j][1] + v[j][2] * v[j][2] + v[j][3] * v[j][3]; }
        const float rs = rsqrtf(wave_sum(ss) * (1.0f / D) + EPS);
#pragma unroll
        for (int j = 0; j < 4; ++j) { const f32x4 gg = *(const f32x4*)(g + j * 256 + lane * 4); *(f32x4*)(out + (size_t)row * D + j * 256 + lane * 4) = v[j] * rs * gg; }
    }
}

typedef float f32x16 __attribute__((ext_vector_type(16)));
constexpr int AT_STAGE = 20480;
__device__ __forceinline__ unsigned cvtpk(float lo, float hi) { typedef float f2 __attribute__((ext_vector_type(2))); typedef __bf16 b2 __attribute__((ext_vector_type(2)));
    f2 v = {lo, hi}; b2 r = __builtin_convertvector(v, b2); return __builtin_bit_cast(unsigned, r); }
__device__ __forceinline__ void mla_unit(LAS unsigned char* lds, int b, int h, int qi, const bf16_t* __restrict__ Q1, const bf16_t* __restrict__ K1, const bf16_t* __restrict__ kpe,
                                         const bf16_t* __restrict__ VT1, bf16_t* o) {
    const int tid = threadIdx.x, lane = tid & 63, wave = __builtin_amdgcn_readfirstlane(tid >> 6), r32 = lane & 31, hi = lane >> 5;
    const size_t qrow = (size_t)b * SEQ + 256 * qi + 32 * wave + r32;
    bf16x8 qf[6];
#pragma unroll
    for (int s = 0; s < 6; ++s) qf[s] = *(const bf16x8*)(Q1 + qrow * 1536 + h * 96 + 16 * s + 8 * hi);
    const int lr = 8 * wave + (lane >> 3);
    const char* ksrc = (const char*)(K1 + ((size_t)b * LP + lr) * 1024 + h * 64) + (((lane & 7) ^ ((lr >> 1) & 7)) << 4);
    const char* vsrc = (const char*)(VT1 + ((size_t)(b * 16 + h) * 64 + lr) * LP) + (((lane & 7) ^ ((lr >> 1) & 7)) << 4);
    const int pr = 16 * wave + (lane >> 2);
    const char* psrc = (const char*)(kpe + ((size_t)b * LP + (pr & 63)) * 32) + (((lane & 3) ^ ((pr >> 2) & 3)) << 4);
#define MLA_ISSUE(j, st) do { \
        __builtin_amdgcn_global_load_lds((const unsigned*)(ksrc + (size_t)(j) * (64 * 2048)), (LAS unsigned*)(lds + (st) * AT_STAGE + wave * 1024), 16, 0, 0); \
        __builtin_amdgcn_global_load_lds((const unsigned*)(vsrc + (size_t)(j) * 128), (LAS unsigned*)(lds + (st) * AT_STAGE + 8192 + wave * 1024), 16, 0, 0); \
        if (wave < 4) __builtin_amdgcn_global_load_lds((const unsigned*)(psrc + (size_t)(j) * (64 * 64)), (LAS unsigned*)(lds + (st) * AT_STAGE + 16384 + wave * 1024), 16, 0, 0); } while (0)
    const int NT = 4 * qi + 5, jmaxw = 4 * qi + ((32 * wave + 47) >> 6);
    const int qp = 16 + 256 * qi + 32 * wave + r32;
    const int koff = r32 * 128, ksw = (r32 >> 1) & 7, poff = 16384 + r32 * 64, psw = (r32 >> 2) & 3, voff = 8192 + r32 * 128;
    f32x16 oacc[2]; oacc[0] = (f32x16){}; oacc[1] = (f32x16){};
    constexpr float MLA_THR = 8.0f;
    float mref = 0.f, lsum = 0.f;
    f32x16 negm = (f32x16){};
    MLA_ISSUE(0, 0);
    if (NT > 1) MLA_ISSUE(1, 1);
    int st = 0;
    for (int j = 0; j < NT; ++j) {
        if (j + 1 < NT) { if (wave < 4) asm volatile("s_waitcnt vmcnt(3)" ::: "memory"); else asm volatile("s_waitcnt vmcnt(2)" ::: "memory"); }
        else asm volatile("s_waitcnt vmcnt(0)" ::: "memory");
        __builtin_amdgcn_s_barrier(); asm volatile("" ::: "memory");
        if (j + 2 < NT) { const int st2 = st >= 1 ? st - 1 : 2; MLA_ISSUE(j + 2, st2); }
        if (j <= jmaxw) {
            LAS const unsigned char* sb = lds + st * AT_STAGE;
            f32x16 p0, p1;
            {
                const bf16x8 k0 = *(LAS const bf16x8*)(sb + koff + ((hi ^ ksw) << 4));
                const bf16x8 k1 = *(LAS const bf16x8*)(sb + 4096 + koff + ((hi ^ ksw) << 4));
                p0 = __builtin_amdgcn_mfma_f32_32x32x16_bf16(k0, qf[0], negm, 0, 0, 0);
                p1 = __builtin_amdgcn_mfma_f32_32x32x16_bf16(k1, qf[0], negm, 0, 0, 0);
            }
#pragma unroll
            for (int s = 1; s < 4; ++s) {
                const bf16x8 k0 = *(LAS const bf16x8*)(sb + koff + (((2 * s + hi) ^ ksw) << 4));
                const bf16x8 k1 = *(LAS const bf16x8*)(sb + 4096 + koff + (((2 * s + hi) ^ ksw) << 4));
                p0 = __builtin_amdgcn_mfma_f32_32x32x16_bf16(k0, qf[s], p0, 0, 0, 0);
                p1 = __builtin_amdgcn_mfma_f32_32x32x16_bf16(k1, qf[s], p1, 0, 0, 0);
            }
#pragma unroll
            for (int s = 0; s < 2; ++s) {
                const bf16x8 k0 = *(LAS const bf16x8*)(sb + poff + (((2 * s + hi) ^ psw) << 4));
                const bf16x8 k1 = *(LAS const bf16x8*)(sb + 2048 + poff + (((2 * s + hi) ^ psw) << 4));
                p0 = __builtin_amdgcn_mfma_f32_32x32x16_bf16(k0, qf[4 + s], p0, 0, 0, 0);
                p1 = __builtin_amdgcn_mfma_f32_32x32x16_bf16(k1, qf[4 + s], p1, 0, 0, 0);
            }
            if (j >= 4 * qi) {
                const int kb0 = 64 * j + 4 * hi;
#pragma unroll
                for (int r = 0; r < 16; ++r) { const int kp = kb0 + (r & 3) + 8 * (r >> 2); if (kp > qp) p0[r] = -1e30f; if (kp + 32 > qp) p1[r] = -1e30f; }
            }
            float tm = fmaxf(p0[0], p1[0]);
#pragma unroll
            for (int r = 1; r < 16; ++r) tm = fmaxf(tm, fmaxf(p0[r], p1[r]));
            tm = fmaxf(tm, __shfl_xor(tm, 32));
            if (j == 0 || __any(tm > MLA_THR)) {
                const float dl = j == 0 ? tm : fmaxf(tm, 0.f);
                mref += dl;
                const float f = __builtin_amdgcn_exp2f(-dl);
                lsum *= f;
#pragma unroll
                for (int r = 0; r < 16; ++r) { oacc[0][r] *= f; oacc[1][r] *= f; p0[r] -= dl; p1[r] -= dl; negm[r] = -mref; }
            }
            float ps = 0.f;
#pragma unroll
            for (int r = 0; r < 16; ++r) { p0[r] = __builtin_amdgcn_exp2f(p0[r]); p1[r] = __builtin_amdgcn_exp2f(p1[r]); ps += p0[r] + p1[r]; }
            lsum += ps;
            u32x4 pf[4];
            pf[0] = (u32x4){cvtpk(p0[0], p0[1]), cvtpk(p0[2], p0[3]), cvtpk(p0[4], p0[5]), cvtpk(p0[6], p0[7])};
            pf[1] = (u32x4){cvtpk(p0[8], p0[9]), cvtpk(p0[10], p0[11]), cvtpk(p0[12], p0[13]), cvtpk(p0[14], p0[15])};
            pf[2] = (u32x4){cvtpk(p1[0], p1[1]), cvtpk(p1[2], p1[3]), cvtpk(p1[4], p1[5]), cvtpk(p1[6], p1[7])};
            pf[3] = (u32x4){cvtpk(p1[8], p1[9]), cvtpk(p1[10], p1[11]), cvtpk(p1[12], p1[13]), cvtpk(p1[14], p1[15])};
#pragma unroll
            for (int s = 0; s < 4; ++s) {
                const bf16x8 v0 = *(LAS const bf16x8*)(sb + voff + (((2 * s + hi) ^ ksw) << 4));
                const bf16x8 v1 = *(LAS const bf16x8*)(sb + 4096 + voff + (((2 * s + hi) ^ ksw) << 4));
                const bf16x8 pb = __builtin_bit_cast(bf16x8, pf[s]);
                oacc[0] = __builtin_amdgcn_mfma_f32_32x32x16_bf16(v0, pb, oacc[0], 0, 0, 0);
                oacc[1] = __builtin_amdgcn_mfma_f32_32x32x16_bf16(v1, pb, oacc[1], 0, 0, 0);
            }
        }
        st = st == 2 ? 0 : st + 1;
    }
#undef MLA_ISSUE
    lsum += __shfl_xor(lsum, 32);
    const float inv = 1.0f / lsum;
    bf16_t* orow = o + qrow * D + h * 64 + 4 * hi;
#pragma unroll
    for (int db = 0; db < 2; ++db)
#pragma unroll
        for (int g = 0; g < 4; ++g)
            *(u32x2*)(orow + 32 * db + 8 * g) = (u32x2){cvtpk(oacc[db][4 * g] * inv, oacc[db][4 * g + 1] * inv), cvtpk(oacc[db][4 * g + 2] * inv, oacc[db][4 * g + 3] * inv)};
    asm volatile("s_waitcnt lgkmcnt(0)" ::: "memory");
    __builtin_amdgcn_s_barrier(); asm volatile("" ::: "memory");
}
__device__ __forceinline__ void mla_meta(int b, int h, const bf16_t* __restrict__ Q1, const bf16_t* __restrict__ K1, const bf16_t* __restrict__ kpe, const bf16_t* __restrict__ VT1, bf16_t* o, int lane) {
    const int qi = lane & 15, part = lane >> 4; const size_t qrow = (size_t)MREAL + b * 16 + qi;
    float q[24];
#pragma unroll
    for (int d = 0; d < 24; ++d) q[d] = bf2f(Q1[qrow * 1536 + h * 96 + 24 * part + d]);
    float sc[16]; float mx = -1e30f;
#pragma unroll
    for (int j = 0; j < 16; ++j) {
        const size_t kr = (size_t)b * LP + j; float s = 0.f;
#pragma unroll
        for (int d = 0; d < 24; ++d) { const int dd = 24 * part + d; const float kv = dd < 64 ? bf2f(K1[kr * D + h * 64 + dd]) : bf2f(kpe[kr * 32 + dd - 64]); s += q[d] * kv; }
        s += __shfl_xor(s, 16); s += __shfl_xor(s, 32);
        sc[j] = j <= qi ? s : -1e30f; mx = fmaxf(mx, sc[j]);
    }
    float l = 0.f;
#pragma unroll
    for (int j = 0; j < 16; ++j) { sc[j] = exp2f(sc[j] - mx); l += sc[j]; }
    const float inv = 1.0f / l;
#pragma unroll
    for (int dd = 0; dd < 16; ++dd) { const int d = 16 * part + dd; float acc = 0.f;
#pragma unroll
        for (int j = 0; j < 16; ++j) acc += sc[j] * bf2f(VT1[((size_t)(b * 16 + h) * 64 + d) * LP + perm16(j)]);
        o[qrow * D + h * 64 + d] = f2bf(acc * inv); }
}
__device__ __forceinline__ void mla_phase(LAS unsigned char* lds, const bf16_t* Q1, const bf16_t* K1, const bf16_t* kpe, const bf16_t* VT1, bf16_t* o, int bid, int nblk) {
    const int v = (nblk % 8 == 0) ? (bid % 8) * (nblk / 8) + bid / 8 : bid;
    for (int vv = v; vv < 256; vv += nblk) {
        const int bh = vv >> 3, s = vv & 7, b = bh >> 4, h = bh & 15;
#pragma unroll 1
        for (int i = 0; i < 4; ++i) { const int qi = (i == 0) ? s : (i == 1) ? 15 - s : (i == 2) ? 16 + s : 31 - s; mla_unit(lds, b, h, qi, Q1, K1, kpe, VT1, o); }
        if (s == 0 && threadIdx.x < 64) mla_meta(b, h, Q1, K1, kpe, VT1, o, threadIdx.x);
    }
}

constexpr int SW_K = 0, SW_V = 36864, SW_VP = 560;
__device__ __forceinline__ void swa_block32(LAS const unsigned char* lds, int rb, int gk0, int nks, int mode, int i_q, const bf16x8 (&qf)[4], float& m, float& lsum, f32x16 (&oacc)[2], int r32, int hi) {
    const float C2 = 1.4426950408889634f;
    const int ksw = (r32 >> 1) & 7;
    f32x16 p = (f32x16){};
#pragma unroll
    for (int s = 0; s < 4; ++s) { const bf16x8 k = *(LAS const bf16x8*)(lds + SW_K + (rb + r32) * 128 + (((2 * s + hi) ^ ksw) << 4)); p = __builtin_amdgcn_mfma_f32_32x32x16_bf16(k, qf[s], p, 0, 0, 0); }
    if (mode != 0) {
        const int jb = ((rb - 32) & 127) + 4 * hi;
#pragma unroll
        for (int r = 0; r < 16; ++r) { const int kk = (r & 3) + 8 * (r >> 2);
            const bool ok = mode == 1 ? (kk + 4 * hi < 16) : mode == 2 ? (jb + kk > i_q) : (jb + kk <= i_q);
            if (!ok) p[r] = -1e30f; }
    }
    float tm = p[0];
#pragma unroll
    for (int r = 1; r < 16; ++r) tm = fmaxf(tm, p[r]);
    tm = fmaxf(tm, __shfl_xor(tm, 32));
    const float mn = fmaxf(m, tm), alpha = __builtin_amdgcn_exp2f((m - mn) * C2), nmc = -mn * C2;
    m = mn;
    float ps = 0.f;
#pragma unroll
    for (int r = 0; r < 16; ++r) { p[r] = __builtin_amdgcn_exp2f(__builtin_fmaf(p[r], C2, nmc)); ps += p[r]; }
    lsum = lsum * alpha + ps;
#pragma unroll
    for (int r = 0; r < 16; ++r) { oacc[0][r] *= alpha; oacc[1][r] *= alpha; }
    u32x4 pf[2];
    pf[0] = (u32x4){cvtpk(p[0], p[1]), cvtpk(p[2], p[3]), cvtpk(p[4], p[5]), cvtpk(p[6], p[7])};
    pf[1] = (u32x4){cvtpk(p[8], p[9]), cvtpk(p[10], p[11]), cvtpk(p[12], p[13]), cvtpk(p[14], p[15])};
#pragma unroll
    for (int ks = 0; ks < 2; ++ks) if (ks < nks) {
        const bf16x8 v0 = *(LAS const bf16x8*)(lds + SW_V + r32 * SW_VP + (gk0 + ks) * 32 + hi * 16);
        const bf16x8 v1 = *(LAS const bf16x8*)(lds + SW_V + (32 + r32) * SW_VP + (gk0 + ks) * 32 + hi * 16);
        const bf16x8 pb = __builtin_bit_cast(bf16x8, pf[ks]);
        oacc[0] = __builtin_amdgcn_mfma_f32_32x32x16_bf16(v0, pb, oacc[0], 0, 0, 0);
        oacc[1] = __builtin_amdgcn_mfma_f32_32x32x16_bf16(v1, pb, oacc[1], 0, 0, 0);
    }
}
__device__ __forceinline__ void swa_unit(LAS unsigned char* lds, int b, int n, int kh, const bf16_t* __restrict__ qkv, const bf16_t* __restrict__ VT0, const float* __restrict__ sinks, bf16_t* o) {
    const int tid = threadIdx.x, lane = tid & 63, wave = __builtin_amdgcn_readfirstlane(tid >> 6), r32 = lane & 31, hi = lane >> 5;
    for (int idx = tid; idx < 2176; idx += NTHR) {
        const int row = idx >> 3, c = idx & 7;
        if (row < 16 || n > 0 || row >= 144) {
            const size_t srow = row < 16 ? (size_t)MREAL + b * 16 + row : (size_t)b * SEQ + 128 * (n - 1) + (row - 16);
            const int lrow = row < 16 ? row : 16 + row;
            const u32x4 v = *(const u32x4*)(qkv + srow * NQKV + 1024 + kh * 64 + c * 8);
            *(LAS u32x4*)(lds + SW_K + lrow * 128 + ((c ^ ((lrow >> 1) & 7)) << 4)) = v;
        }
    }
    for (int idx = tid; idx < 2176; idx += NTHR) {
        const int d = idx / 34, c = idx % 34;
        if (c < 2 || n > 0 || c >= 18) {
            const bf16_t* src = VT0 + (size_t)((b * 2 + kh) * 64 + d) * LP + (c < 2 ? c * 8 : 16 + 128 * (n - 1) + (c - 2) * 8);
            *(LAS u32x4*)(lds + SW_V + d * SW_VP + c * 16) = *(const u32x4*)src;
        }
    }
    __syncthreads();
    const int hq = kh * 8 + wave;
    const float sink = sinks[hq];
#pragma unroll 1
    for (int qs = 0; qs < 4; ++qs) {
        const size_t qrow = (size_t)b * SEQ + 128 * n + 32 * qs + r32;
        bf16x8 qf[4];
#pragma unroll
        for (int s = 0; s < 4; ++s) qf[s] = *(const bf16x8*)(qkv + qrow * NQKV + hq * 64 + 16 * s + 8 * hi);
        f32x16 oacc[2]; oacc[0] = (f32x16){}; oacc[1] = (f32x16){};
        float m = sink, lsum = hi == 0 ? 1.0f : 0.0f;
        const int i_q = 32 * qs + r32;
        swa_block32(lds, 0, 0, 1, 1, i_q, qf, m, lsum, oacc, r32, hi);
        if (n > 0) {
            swa_block32(lds, 32 + 32 * qs, 1 + 2 * qs, 2, 2, i_q, qf, m, lsum, oacc, r32, hi);
#pragma unroll 1
            for (int kb = qs + 1; kb < 4; ++kb) swa_block32(lds, 32 + 32 * kb, 1 + 2 * kb, 2, 0, i_q, qf, m, lsum, oacc, r32, hi);
        }
#pragma unroll 1
        for (int kb = 0; kb < qs; ++kb) swa_block32(lds, 160 + 32 * kb, 9 + 2 * kb, 2, 0, i_q, qf, m, lsum, oacc, r32, hi);
        swa_block32(lds, 160 + 32 * qs, 9 + 2 * qs, 2, 3, i_q, qf, m, lsum, oacc, r32, hi);
        lsum += __shfl_xor(lsum, 32);
        const float inv = 1.0f / lsum;
        bf16_t* orow = o + qrow * D + hq * 64 + 4 * hi;
#pragma unroll
        for (int db = 0; db < 2; ++db)
#pragma unroll
            for (int g = 0; g < 4; ++g)
                *(u32x2*)(orow + 32 * db + 8 * g) = (u32x2){cvtpk(oacc[db][4 * g] * inv, oacc[db][4 * g + 1] * inv), cvtpk(oacc[db][4 * g + 2] * inv, oacc[db][4 * g + 3] * inv)};
    }
    __syncthreads();
}
__device__ __forceinline__ void swa_meta(int b, int hq, const bf16_t* __restrict__ qkv, const bf16_t* __restrict__ VT0, const float* __restrict__ sinks, bf16_t* o, int lane) {
    const int qi = lane & 15, part = lane >> 4, kh = hq >> 3; const size_t qrow = (size_t)MREAL + b * 16 + qi;
    float q[16];
#pragma unroll
    for (int d = 0; d < 16; ++d) q[d] = bf2f(qkv[qrow * NQKV + hq * 64 + 16 * part + d]);
    const float sink = sinks[hq];
    float sc[16]; float mx = sink;
#pragma unroll
    for (int j = 0; j < 16; ++j) {
        const size_t kr = (size_t)MREAL + b * 16 + j; float s = 0.f;
#pragma unroll
        for (int d = 0; d < 16; ++d) s += q[d] * bf2f(qkv[kr * NQKV + 1024 + kh * 64 + 16 * part + d]);
        s += __shfl_xor(s, 16); s += __shfl_xor(s, 32);
        sc[j] = j <= qi ? s : -1e30f; mx = fmaxf(mx, sc[j]);
    }
    float l = __expf(sink - mx);
#pragma unroll
    for (int j = 0; j < 16; ++j) { sc[j] = __expf(sc[j] - mx); l += sc[j]; }
    const float inv = 1.0f / l;
#pragma unroll
    for (int dd = 0; dd < 16; ++dd) { const int d = 16 * part + dd; float acc = 0.f;
#pragma unroll
        for (int j = 0; j < 16; ++j) acc += sc[j] * bf2f(VT0[((size_t)(b * 2 + kh) * 64 + d) * LP + perm16(j)]);
        o[qrow * D + hq * 64 + d] = f2bf(acc * inv); }
}
__device__ __forceinline__ void swa_phase(LAS unsigned char* lds, const bf16_t* qkv, const bf16_t* VT0, const float* sinks, bf16_t* o, int bid, int nblk) {
    for (int u = bid; u < 256; u += nblk) {
        const int b = u >> 7, n = (u >> 1) & 63, kh = u & 1;
        swa_unit(lds, b, n, kh, qkv, VT0, sinks, o);
        if (n == 0) swa_meta(b, kh * 8 + (threadIdx.x >> 6), qkv, VT0, sinks, o, threadIdx.x & 63);
    }
}

template <int MOE_MT>
__device__ __forceinline__ void moe_unit(LAS unsigned char* lds, int e, int s0, int ns, const int* __restrict__ list, const bf16_t* __restrict__ hb, const float* __restrict__ rstd,
                                         const float* __restrict__ wslot, const bf16_t* __restrict__ wgu, const bf16_t* __restrict__ wd, bf16_t* ybuf, unsigned long long* tsb = nullptr) {
#define MSTAMP(i) do { if (PROBE_PHASE >= 600 && tsb && blockIdx.x == 0 && threadIdx.x == 0) tsb[i] = __builtin_amdgcn_s_memrealtime(); } while (0)
    MSTAMP(20);
    constexpr int MOE_BM = 16 * MOE_MT, MOE_ST1 = (MOE_BM + 256) * 128, MOE_HT = MOE_BM * 128, MOE_HLO = 2 * MOE_ST1, MOE_B2 = 2 * MOE_HT, MOE_ST2 = 32768, MOE_INFO = MOE_HLO + 2 * MOE_HT;
    static_assert(MOE_B2 + 2 * MOE_ST2 <= MOE_HLO && MOE_INFO + 3072 <= LDS_MISC, "moe lds");
#define moe_hoff(kt2) ((kt2) < 2 ? MOE_HLO + (kt2) * MOE_HT : ((kt2) - 2) * MOE_HT)
    const int tid = threadIdx.x, lane = tid & 63, wave = __builtin_amdgcn_readfirstlane(tid >> 6);
    LAS int* slotl = (LAS int*)(lds + MOE_INFO); LAS float* rsl = (LAS float*)(lds + MOE_INFO + 1024); LAS float* wl = (LAS float*)(lds + MOE_INFO + 2048);
    if (tid < MOE_BM) { const int sl = list[(size_t)e * CAP + s0 + (tid < ns ? tid : 0)]; slotl[tid] = sl; rsl[tid] = rstd[sl >> 1]; wl[tid] = wslot[sl]; }
    __syncthreads();
    const int lc = (lane & 7) ^ (lane >> 3);
    const int fro = (lane & 15) * 128, fc0 = ((lane >> 4) ^ (lane & 7)) << 4, fc1 = ((4 + (lane >> 4)) ^ (lane & 7)) << 4;
    {
        constexpr int G = (MOE_BM + 256) / 8, GA = MOE_BM / 8, NG = (G + 7) / 8;
        const char* src[NG];
#pragma unroll
        for (int i = 0; i < NG; ++i) { const int g = wave + 8 * i;
            if (g < GA) src[i] = (const char*)(hb + (size_t)(slotl[g * 8 + (lane >> 3)] >> 1) * D) + lc * 16;
            else if (g < G) src[i] = (const char*)(wgu + (size_t)((g - GA) * 8 + (lane >> 3)) * D) + lc * 16;
            else src[i] = nullptr; }
        f32x4 acc[MOE_MT][2];
#pragma unroll
        for (int mi = 0; mi < MOE_MT; ++mi) { acc[mi][0] = (f32x4){0.f, 0.f, 0.f, 0.f}; acc[mi][1] = (f32x4){0.f, 0.f, 0.f, 0.f}; }
#define M1_STAGE(st, step) do { _Pragma("unroll") for (int _i = 0; _i < NG; ++_i) { const int _g = wave + 8 * _i; if (_g < G) \
        __builtin_amdgcn_global_load_lds((const unsigned*)(src[_i] + (size_t)((step) & 15) * 128 + ((_g >= GA && (step) >= 16) ? (size_t)256 * 2048 : 0)), (LAS unsigned*)(lds + (st) * MOE_ST1 + _g * 1024), 16, 0, 0); } } while (0)
        M1_STAGE(0, 0);
        for (int step = 0; step < 32; ++step) {
            asm volatile("s_waitcnt vmcnt(0)" ::: "memory");
            __syncthreads();
            if (step + 1 < 32) M1_STAGE((step + 1) & 1, step + 1);
            LAS const unsigned char* sa = lds + (step & 1) * MOE_ST1 + fro;
            LAS const unsigned char* sb = lds + (step & 1) * MOE_ST1 + (MOE_BM + wave * 32) * 128 + fro;
#pragma unroll
            for (int ks = 0; ks < 2; ++ks) { const int fc = ks ? fc1 : fc0;
                const bf16x8 b0 = *(LAS const bf16x8*)(sb + fc), b1 = *(LAS const bf16x8*)(sb + 2048 + fc);
#pragma unroll
                for (int mi = 0; mi < MOE_MT; ++mi) { const bf16x8 af = *(LAS const bf16x8*)(sa + mi * 2048 + fc);
                    acc[mi][0] = __builtin_amdgcn_mfma_f32_16x16x32_bf16(b0, af, acc[mi][0], 0, 0, 0);
                    acc[mi][1] = __builtin_amdgcn_mfma_f32_16x16x32_bf16(b1, af, acc[mi][1], 0, 0, 0); }
            }
            if ((step & 15) == 15) {
                const int n = 16 * (8 * (step >> 4) + wave) + (lane >> 4) * 4;
                const int csw = ((n & 63) >> 3);
#pragma unroll
                for (int mi = 0; mi < MOE_MT; ++mi) { const int row = mi * 16 + (lane & 15); const float rs = rsl[row]; float hv[4];
#pragma unroll
                    for (int r = 0; r < 4; ++r) { const float g = acc[mi][0][r] * rs, u = acc[mi][1][r] * rs; hv[r] = g / (1.0f + __expf(-g)) * u; }
                    *(LAS u32x2*)(lds + moe_hoff(n >> 6) + row * 128 + ((csw ^ (row & 7)) << 4) + (n & 4) * 2) = (u32x2){pk2(hv[0], hv[1]), pk2(hv[2], hv[3])};
                    acc[mi][0] = (f32x4){0.f, 0.f, 0.f, 0.f}; acc[mi][1] = (f32x4){0.f, 0.f, 0.f, 0.f}; }
            }
        }
#undef M1_STAGE
    }
    __syncthreads();
    MSTAMP(21);
    {
        const char* src2[4];
#pragma unroll
        for (int i = 0; i < 4; ++i) src2[i] = (const char*)(wd + (size_t)((wave + 8 * i) * 8 + (lane >> 3)) * DE) + lc * 16;
        f32x4 acc[MOE_MT][2];
#pragma unroll
        for (int mi = 0; mi < MOE_MT; ++mi) { acc[mi][0] = (f32x4){0.f, 0.f, 0.f, 0.f}; acc[mi][1] = (f32x4){0.f, 0.f, 0.f, 0.f}; }
#define M2_STAGE(st, q) do { _Pragma("unroll") for (int _i = 0; _i < 4; ++_i) \
        __builtin_amdgcn_global_load_lds((const unsigned*)(src2[_i] + (size_t)((q) >> 2) * (256 * 512) + (size_t)((q) & 3) * 128), (LAS unsigned*)(lds + MOE_B2 + (st) * MOE_ST2 + (wave + 8 * _i) * 1024), 16, 0, 0); } while (0)
        M2_STAGE(0, 0);
        for (int q = 0; q < 16; ++q) {
            asm volatile("s_waitcnt vmcnt(0)" ::: "memory");
            __syncthreads();
            if (q + 1 < 16) M2_STAGE((q + 1) & 1, q + 1);
            LAS const unsigned char* sa = lds + moe_hoff(q & 3) + fro;
            LAS const unsigned char* sb = lds + MOE_B2 + (q & 1) * MOE_ST2 + (wave * 32) * 128 + fro;
#pragma unroll
            for (int ks = 0; ks < 2; ++ks) { const int fc = ks ? fc1 : fc0;
                const bf16x8 b0 = *(LAS const bf16x8*)(sb + fc), b1 = *(LAS const bf16x8*)(sb + 2048 + fc);
#pragma unroll
                for (int mi = 0; mi < MOE_MT; ++mi) { const bf16x8 af = *(LAS const bf16x8*)(sa + mi * 2048 + fc);
                    acc[mi][0] = __builtin_amdgcn_mfma_f32_16x16x32_bf16(b0, af, acc[mi][0], 0, 0, 0);
                    acc[mi][1] = __builtin_amdgcn_mfma_f32_16x16x32_bf16(b1, af, acc[mi][1], 0, 0, 0); }
            }
            if ((q & 3) == 3) {
                const int cb = (q >> 2) * 256 + wave * 32 + (lane >> 4) * 4;
#pragma unroll
                for (int mi = 0; mi < MOE_MT; ++mi) { const int row = mi * 16 + (lane & 15);
                    if (row < ns) { const float w = wl[row]; bf16_t* yr = ybuf + (size_t)slotl[row] * D + cb;
#pragma unroll
                        for (int ni = 0; ni < 2; ++ni) { const f32x4 v = acc[mi][ni] * w; *(u32x2*)(yr + ni * 16) = (u32x2){pk2(v[0], v[1]), pk2(v[2], v[3])}; } }
                    acc[mi][0] = (f32x4){0.f, 0.f, 0.f, 0.f}; acc[mi][1] = (f32x4){0.f, 0.f, 0.f, 0.f}; }
            }
        }
#undef M2_STAGE
    }
#undef moe_hoff
    __syncthreads();
    MSTAMP(22);
#undef MSTAMP
}
__device__ __forceinline__ void moe_phase(LAS unsigned char* lds, int* cnt, const int* list, const bf16_t* hb, const float* rstd, const float* wslot, const bf16_t* wgu, const bf16_t* wd, bf16_t* ybuf, int bid, int nblk, unsigned long long* tsb = nullptr) {
    const bool grp = (nblk % 8) == 0;
    int ntile[NE]; int gsum = 0; bool fit = grp;
#pragma unroll
    for (int e = 0; e < NE; ++e) { const int c = __hip_atomic_load(cnt + e * 64, __ATOMIC_RELAXED, __HIP_MEMORY_SCOPE_AGENT); const int bm = c > 8 * 144 ? 160 : 144; ntile[e] = (c + bm - 1) / bm;
        gsum = (e & 3) == 0 ? ntile[e] : gsum + ntile[e]; if ((e & 3) == 3 && gsum > nblk / 8) fit = false; }
    const int x = bid % 8;
    int u = fit ? bid / 8 : (grp ? x * (nblk / 8) + bid / 8 : bid), base = 0;
    const int stride = fit ? nblk / 8 : nblk;
#pragma unroll 1
    for (int e = 0; e < NE; ++e) {
        if (fit && (e >> 2) != x) continue;
        const int c = __hip_atomic_load(cnt + e * 64, __ATOMIC_RELAXED, __HIP_MEMORY_SCOPE_AGENT);
        const bool big = c > 8 * 144; const int bm = big ? 160 : 144, nt = (c + bm - 1) / bm;
        while (u < base + nt) { const int t = u - base; const int ns = c - t * bm < bm ? c - t * bm : bm;
            if (big) moe_unit<10>(lds, e, t * bm, ns, list, hb, rstd, wslot, wgu + (size_t)e * 512 * 1024, wd + (size_t)e * 1024 * 256, ybuf, tsb);
            else moe_unit<9>(lds, e, t * bm, ns, list, hb, rstd, wslot, wgu + (size_t)e * 512 * 1024, wd + (size_t)e * 1024 * 256, ybuf, tsb);
            u += stride; }
        base += nt;
    }
}

template <int MT>
__device__ __forceinline__ void l1proj_unit(LAS unsigned char* lds, int row0, int mrow0, bf16_t* hb, const bf16_t* __restrict__ ybuf, const bf16_t* __restrict__ win_t, const bf16_t* __restrict__ wuq_t,
                                            const bf16_t* __restrict__ wukv_t, const float2* __restrict__ cs, bf16_t* kpe, bf16_t* Q1, bf16_t* K1, bf16_t* VT1) {
    constexpr int BM = 16 * MT, STW = (BM + 512) * 64, KT = BM * 64  , CQN = 0, CKV = 8 * KT, RB = 12 * KT, STB = 32768, PART = 3 * STW;
    static_assert(RB + 3 * STB <= LDS_MISC && PART + 8 * BM * 4 <= LDS_MISC, "l1proj lds");
    const int tid = threadIdx.x, lane = tid & 63, wave = __builtin_amdgcn_readfirstlane(tid >> 6);
    LAS float* rsl = (LAS float*)(lds + LDS_MISC + 256);
#define L1_GROW(r) ((r) < 64 ? row0 + (r) : mrow0 + (r) - 64)
    for (int r = wave; r < BM; r += NWAVE) {
        const size_t grow = L1_GROW(r); float ss = 0.f;
#pragma unroll
        for (int j = 0; j < 4; ++j) { const size_t c = j * 256 + lane * 4;
            const u32x2 h = *(const u32x2*)(hb + grow * D + c), y0 = *(const u32x2*)(ybuf + (grow * 2) * D + c), y1 = *(const u32x2*)(ybuf + (grow * 2 + 1) * D + c);
            float v[4];
            v[0] = __uint_as_float(h.x << 16) + __uint_as_float(y0.x << 16) + __uint_as_float(y1.x << 16);
            v[1] = __uint_as_float(h.x & 0xffff0000u) + __uint_as_float(y0.x & 0xffff0000u) + __uint_as_float(y1.x & 0xffff0000u);
            v[2] = __uint_as_float(h.y << 16) + __uint_as_float(y0.y << 16) + __uint_as_float(y1.y << 16);
            v[3] = __uint_as_float(h.y & 0xffff0000u) + __uint_as_float(y0.y & 0xffff0000u) + __uint_as_float(y1.y & 0xffff0000u);
            ss += v[0] * v[0] + v[1] * v[1] + v[2] * v[2] + v[3] * v[3];
            *(u32x2*)(hb + grow * D + c) = (u32x2){pk2(v[0], v[1]), pk2(v[2], v[3])}; }
        ss = wave_sum(ss); if (lane == 0) rsl[r] = rsqrtf(ss * (1.0f / D) + EPS);
    }
    asm volatile("s_waitcnt vmcnt(0)" ::: "memory");
    __syncthreads();
    const int lc = (lane & 3) ^ swzF(lane >> 4);
    const int fro = (lane & 15) * 64 + (((lane >> 4) ^ swzF((lane >> 2) & 3)) << 4);
    f32x4 acc[MT][4];
#pragma unroll
    for (int mi = 0; mi < MT; ++mi)
#pragma unroll
        for (int ni = 0; ni < 4; ++ni) acc[mi][ni] = (f32x4){0.f, 0.f, 0.f, 0.f};
    {
        const char* srcb[4];
#pragma unroll
        for (int i = 0; i < 4; ++i) srcb[i] = (const char*)(win_t + (size_t)((wave + 8 * i) * 16 + (lane >> 2)) * D) + lc * 16;
        const char* srca = (const char*)(hb + (size_t)L1_GROW((wave < MT ? wave : 0) * 16 + (lane >> 2)) * D) + lc * 16;
#define W_ISSUE(st, kt) do { if (wave < MT) __builtin_amdgcn_global_load_lds((const unsigned*)(srca + (size_t)(kt) * 64), (LAS unsigned*)(lds + (st) * STW + wave * 1024), 16, 0, 16); \
        _Pragma("unroll") for (int _i = 0; _i < 4; ++_i) __builtin_amdgcn_global_load_lds((const unsigned*)(srcb[_i] + (size_t)(kt) * 64), (LAS unsigned*)(lds + (st) * STW + (MT + wave + 8 * _i) * 1024), 16, 0, 0); } while (0)
        W_ISSUE(0, 0); W_ISSUE(1, 1);
        int st = 0;
        for (int kt = 0; kt < 32; ++kt) {
            if (kt + 1 < 32) { if (wave < MT) wait_vm<5>(); else wait_vm<4>(); } else wait_vm<0>();
            __builtin_amdgcn_s_barrier(); asm volatile("" ::: "memory");
            if (kt + 2 < 32) W_ISSUE(st == 0 ? 2 : st - 1, kt + 2);
            LAS const unsigned char* sa = lds + st * STW + fro;
            LAS const unsigned char* sb = lds + st * STW + (BM + wave * 64) * 64 + fro;
            bf16x8 bfr[4];
#pragma unroll
            for (int ni = 0; ni < 4; ++ni) bfr[ni] = *(LAS const bf16x8*)(sb + ni * 1024);
#pragma unroll
            for (int mi = 0; mi < MT; ++mi) { const bf16x8 af = *(LAS const bf16x8*)(sa + mi * 1024);
#pragma unroll
                for (int ni = 0; ni < 4; ++ni) acc[mi][ni] = __builtin_amdgcn_mfma_f32_16x16x32_bf16(bfr[ni], af, acc[mi][ni], 0, 0, 0); }
            st = st == 2 ? 0 : st + 1;
        }
#undef W_ISSUE
    }
    asm volatile("s_waitcnt lgkmcnt(0)" ::: "memory");
    __syncthreads();
    LAS float* part = (LAS float*)(lds + PART);
    int lane_e = lane; asm volatile("" : "+v"(lane_e));
#define lane lane_e
#pragma unroll
    for (int mi = 0; mi < MT; ++mi) { const float rs = rsl[mi * 16 + (lane & 15)]; float ss = 0.f;
#pragma unroll
        for (int ni = 0; ni < 4; ++ni) { acc[mi][ni] = acc[mi][ni] * rs; ss += acc[mi][ni][0] * acc[mi][ni][0] + acc[mi][ni][1] * acc[mi][ni][1] + acc[mi][ni][2] * acc[mi][ni][2] + acc[mi][ni][3] * acc[mi][ni][3]; }
        ss += __shfl_xor(ss, 16); ss += __shfl_xor(ss, 32);
        if (lane < 16) part[wave * BM + mi * 16 + lane] = ss; }
    __syncthreads();
    if (wave < 6) {
#pragma unroll
        for (int mi = 0; mi < MT; ++mi) { const int row = mi * 16 + (lane & 15);
            const float tot = wave < 4 ? (part[row] + part[BM + row]) + (part[2 * BM + row] + part[3 * BM + row]) : part[4 * BM + row] + part[5 * BM + row];
            const float rn = rsqrtf(tot * (wave < 4 ? 1.0f / 256 : 1.0f / 128) + EPS);
#pragma unroll
            for (int ni = 0; ni < 4; ++ni) { const int cc = (wave < 4 ? 64 * wave : 64 * (wave - 4)) + ni * 16 + (lane >> 4) * 4; const f32x4 v = acc[mi][ni] * rn;
                *(LAS u32x2*)(lds + (wave < 4 ? CQN : CKV) + (cc >> 5) * KT + row * 64 + (((((cc & 31) >> 3)) ^ swzF((row >> 2) & 3)) << 4) + (cc & 4) * 2) = (u32x2){pk2(v[0], v[1]), pk2(v[2], v[3])}; } }
    } else if (wave == 6) {
#pragma unroll
        for (int mi = 0; mi < MT; ++mi) { const int row = mi * 16 + (lane & 15); const int grow = L1_GROW(row); const int pos = row_pos(grow), d0 = (lane >> 4) * 4;
            f32x4 o1, o2;
#pragma unroll
            for (int r = 0; r < 4; ++r) { const float2 t = cs[pos * 32 + 2 * (d0 + r)]; const float x1 = acc[mi][0][r], x2 = acc[mi][1][r]; o1[r] = x1 * t.x - x2 * t.y; o2[r] = x2 * t.x + x1 * t.y; }
            bf16_t* kr = kpe + ((size_t)row_batch(grow) * LP + pos) * 32;
            *(u32x2*)(kr + d0) = (u32x2){pk2(o1[0], o1[1]), pk2(o1[2], o1[3])}; *(u32x2*)(kr + 16 + d0) = (u32x2){pk2(o2[0], o2[1]), pk2(o2[2], o2[3])}; }
    }
#undef lane
    __syncthreads();
    const char* srcu[4];
#define U_ISSUE(st, base, pitchB, chunk, kt) do { _Pragma("unroll") for (int _i = 0; _i < 4; ++_i) \
        __builtin_amdgcn_global_load_lds((const unsigned*)(srcu[_i] + (size_t)(chunk) * 512 * (pitchB) + (size_t)(kt) * 64), (LAS unsigned*)(lds + RB + (st) * STB + (wave + 8 * _i) * 1024), 16, 0, 0); } while (0)
    {
#pragma unroll
        for (int i = 0; i < 4; ++i) srcu[i] = (const char*)(wuq_t + (size_t)((wave + 8 * i) * 16 + (lane >> 2)) * 256) + lc * 16;
#pragma unroll
        for (int mi = 0; mi < MT; ++mi)
#pragma unroll
            for (int ni = 0; ni < 4; ++ni) acc[mi][ni] = (f32x4){0.f, 0.f, 0.f, 0.f};
        U_ISSUE(0, 0, 512, 0, 0); U_ISSUE(1, 0, 512, 0, 1);
        int st = 0;
        for (int q = 0; q < 24; ++q) {
            if (q + 1 < 24) wait_vm<4>(); else wait_vm<0>();
            __builtin_amdgcn_s_barrier(); asm volatile("" ::: "memory");
            if (q + 2 < 24) U_ISSUE(st == 0 ? 2 : st - 1, 0, 512, (q + 2) >> 3, (q + 2) & 7);
            LAS const unsigned char* sa = lds + CQN + (q & 7) * KT + fro;
            LAS const unsigned char* sb = lds + RB + st * STB + (wave * 64) * 64 + fro;
            bf16x8 bfr[4];
#pragma unroll
            for (int ni = 0; ni < 4; ++ni) bfr[ni] = *(LAS const bf16x8*)(sb + ni * 1024);
#pragma unroll
            for (int mi = 0; mi < MT; ++mi) { const bf16x8 af = *(LAS const bf16x8*)(sa + mi * 1024);
#pragma unroll
                for (int ni = 0; ni < 4; ++ni) acc[mi][ni] = __builtin_amdgcn_mfma_f32_16x16x32_bf16(bfr[ni], af, acc[mi][ni], 0, 0, 0); }
            if ((q & 7) == 7) {
                int lane_q = lane; asm volatile("" : "+v"(lane_q));
#define lane lane_q
                const float scale = 0.10206207261596577f * 1.4426950408889634f; const int d0 = (lane >> 4) * 4;
#pragma unroll
                for (int mi = 0; mi < MT; ++mi) { const int grow = L1_GROW(mi * 16 + (lane & 15)); const int pos = row_pos(grow);
#pragma unroll
                    for (int bi = 0; bi < 2; ++bi) { const int gc = (q >> 3) * 512 + 64 * wave + bi * 32; bf16_t* orow = Q1 + (size_t)grow * 1536 + gc;
                        f32x4 v1 = acc[mi][2 * bi], v2 = acc[mi][2 * bi + 1];
                        if (((gc >> 5) % 3) == 2) {
#pragma unroll
                            for (int r = 0; r < 4; ++r) { const float2 t = cs[pos * 32 + 2 * (d0 + r)]; const float x1 = v1[r], x2 = v2[r]; v1[r] = x1 * t.x - x2 * t.y; v2[r] = x2 * t.x + x1 * t.y; } }
                        v1 = v1 * scale; v2 = v2 * scale;
                        *(u32x2*)(orow + d0) = (u32x2){pk2(v1[0], v1[1]), pk2(v1[2], v1[3])}; *(u32x2*)(orow + 16 + d0) = (u32x2){pk2(v2[0], v2[1]), pk2(v2[2], v2[3])}; }
#pragma unroll
                    for (int ni = 0; ni < 4; ++ni) acc[mi][ni] = (f32x4){0.f, 0.f, 0.f, 0.f}; }
#undef lane
            }
            st = st == 2 ? 0 : st + 1;
        }
    }
    asm volatile("s_waitcnt lgkmcnt(0)" ::: "memory");
    __syncthreads();
    {
#pragma unroll
        for (int i = 0; i < 4; ++i) srcu[i] = (const char*)(wukv_t + (size_t)((wave + 8 * i) * 16 + (lane >> 2)) * 128) + lc * 16;
#pragma unroll
        for (int mi = 0; mi < MT; ++mi)
#pragma unroll
            for (int ni = 0; ni < 4; ++ni) acc[mi][ni] = (f32x4){0.f, 0.f, 0.f, 0.f};
        U_ISSUE(0, 0, 256, 0, 0); U_ISSUE(1, 0, 256, 0, 1);
        int st = 0;
        for (int q = 0; q < 16; ++q) {
            if (q + 1 < 16) wait_vm<4>(); else wait_vm<0>();
            __builtin_amdgcn_s_barrier(); asm volatile("" ::: "memory");
            if (q + 2 < 16) U_ISSUE(st == 0 ? 2 : st - 1, 0, 256, (q + 2) >> 2, (q + 2) & 3);
            LAS const unsigned char* sa = lds + CKV + (q & 3) * KT + fro;
            LAS const unsigned char* sb = lds + RB + st * STB + (wave * 64) * 64 + fro;
            bf16x8 bfr[4];
#pragma unroll
            for (int ni = 0; ni < 4; ++ni) bfr[ni] = *(LAS const bf16x8*)(sb + ni * 1024);
            if (q < 8) {
#pragma unroll
                for (int mi = 0; mi < MT; ++mi) { const bf16x8 af = *(LAS const bf16x8*)(sa + mi * 1024);
#pragma unroll
                    for (int ni = 0; ni < 4; ++ni) acc[mi][ni] = __builtin_amdgcn_mfma_f32_16x16x32_bf16(bfr[ni], af, acc[mi][ni], 0, 0, 0); }
            } else {
#pragma unroll
                for (int mi = 0; mi < MT; ++mi) { const bf16x8 af = *(LAS const bf16x8*)(sa + mi * 1024);
#pragma unroll
                    for (int ni = 0; ni < 4; ++ni) acc[mi][ni] = __builtin_amdgcn_mfma_f32_16x16x32_bf16(af, bfr[ni], acc[mi][ni], 0, 0, 0); }
            }
            if ((q & 3) == 3) {
                const int ch = q >> 2;
                int lane_k = lane; asm volatile("" : "+v"(lane_k));
#define lane lane_k
                if (ch < 2) {
#pragma unroll
                    for (int mi = 0; mi < MT; ++mi) { const int grow = L1_GROW(mi * 16 + (lane & 15)); const size_t kr = (size_t)row_batch(grow) * LP + row_pos(grow);
#pragma unroll
                        for (int ni = 0; ni < 4; ++ni) { const f32x4 v = acc[mi][ni];
                            *(u32x2*)(K1 + kr * D + 512 * ch + 64 * wave + ni * 16 + (lane >> 4) * 4) = (u32x2){pk2(v[0], v[1]), pk2(v[2], v[3])}; acc[mi][ni] = (f32x4){0.f, 0.f, 0.f, 0.f}; } }
                } else {
#pragma unroll
                    for (int mi = 0; mi < MT; ++mi) { const int grow0 = L1_GROW(mi * 16 + (lane >> 4) * 4); const int b = row_batch(grow0), pp = perm16(row_pos(grow0));
#pragma unroll
                        for (int ni = 0; ni < 4; ++ni) { const int hd = 512 * (ch - 2) + 64 * wave + ni * 16 + (lane & 15); const f32x4 v = acc[mi][ni];
                            *(u32x2*)(VT1 + (size_t)(b * 1024 + hd) * LP + pp) = (u32x2){pk2(v[0], v[1]), pk2(v[2], v[3])}; acc[mi][ni] = (f32x4){0.f, 0.f, 0.f, 0.f}; } }
                }
#undef lane
            }
            st = st == 2 ? 0 : st + 1;
        }
    }
#undef U_ISSUE
#undef L1_GROW
    asm volatile("s_waitcnt lgkmcnt(0)" ::: "memory");
    __syncthreads();
}
__device__ __forceinline__ void l1proj_phase(LAS unsigned char* lds, bf16_t* hb, const bf16_t* ybuf, const bf16_t* win_t, const bf16_t* wuq_t, const bf16_t* wukv_t, const float2* cs, bf16_t* kpe,
                                             bf16_t* Q1, bf16_t* K1, bf16_t* VT1, int bid, int nblk) {
    { const int gt = bid * NTHR + threadIdx.x, ngt = nblk * NTHR;
      for (int idx = gt; idx < 2 * 48 * 1024; idx += ngt) { const int b = idx / (48 * 1024), r = idx % (48 * 1024); K1[((size_t)b * LP + 8208) * 1024 + r] = 0; }
      for (int idx = gt; idx < 2 * 16 * 64 * 48; idx += ngt) { const int rr = idx / 48, c = idx % 48; VT1[(size_t)rr * LP + 8208 + c] = 0; } }
    for (int u = bid; u < 256; u += nblk) {
        if (u >= 254) l1proj_unit<5>(lds, u * 64, MREAL + (u - 254) * 16, hb, ybuf, win_t, wuq_t, wukv_t, cs, kpe, Q1, K1, VT1);
        else l1proj_unit<4>(lds, u * 64, MREAL, hb, ybuf, win_t, wuq_t, wukv_t, cs, kpe, Q1, K1, VT1);
    }
}

struct EpiNull { int m0, n0;
    template <int MT, int NT> __device__ __forceinline__ void operator()(f32x4 (&acc)[MT][NT], int, int, int) const {
#pragma unroll
        for (int mi = 0; mi < MT; ++mi)
#pragma unroll
            for (int ni = 0; ni < NT; ++ni) asm volatile("" :: "v"(acc[mi][ni])); } };
__device__ __forceinline__ void transpose_item(const float* __restrict__ W, int N, const float* __restrict__ gain, bf16_t* dst, int ldk, int drow0, int k0, int n0, LAS float* scr, int lane, int dskip = 0) {
#pragma unroll 8
    for (int i = 0; i < 32; ++i) { const int kk = 2 * i + (lane >> 5); float v = W[(size_t)(k0 + kk) * N + n0 + (lane & 31)]; if (gain) v *= gain[k0 + kk]; scr[kk * 33 + (lane & 31)] = v; }
    asm volatile("s_waitcnt lgkmcnt(0)" ::: "memory");
    const int c = lane & 7;
#pragma unroll
    for (int j = 0; j < 4; ++j) { const int n = (lane >> 3) + 8 * j; const LAS float* s = scr + (8 * c) * 33 + n;
        u32x4 o; o.x = pk2(s[0 * 33], s[1 * 33]); o.y = pk2(s[2 * 33], s[3 * 33]); o.z = pk2(s[4 * 33], s[5 * 33]); o.w = pk2(s[6 * 33], s[7 * 33]);
        *(u32x4*)(dst + (size_t)(drow0 + n + (n >= 16 ? dskip : 0)) * ldk + k0 + 8 * c) = o; }
    asm volatile("s_waitcnt lgkmcnt(0)" ::: "memory");
}
__device__ __forceinline__ void moe_convert_item(const float* __restrict__ src, int pitch  , const float* __restrict__ gain  , bf16_t* dst, int ldk, int kind  , int nrow0, LAS float* T) {
    const int tid = threadIdx.x;
#pragma unroll
    for (int i = 0; i < 8; ++i) { const int idx = tid + i * NTHR, k = idx >> 6, c4 = idx & 63;
        f32x4 v = *(const f32x4*)(src + (size_t)k * pitch + c4 * 4); if (gain) v = v * gain[k];
        LAS float* t = T + k * 257 + c4 * 4; t[0] = v[0]; t[1] = v[1]; t[2] = v[2]; t[3] = v[3]; }
    __syncthreads();
#pragma unroll
    for (int i = 0; i < 4; ++i) { const int idx = tid + i * NTHR, kc = idx & 7, n = idx >> 3;
        const LAS float* t = T + (8 * kc) * 257 + n;
        u32x4 o; o.x = pk2(t[0], t[257]); o.y = pk2(t[2 * 257], t[3 * 257]); o.z = pk2(t[4 * 257], t[5 * 257]); o.w = pk2(t[6 * 257], t[7 * 257]);
        const int row = kind == 2 ? nrow0 + n : (n >> 4) * 32 + kind * 16 + (n & 15);
        *(u32x4*)(dst + (size_t)row * ldk + 8 * kc) = o; }
    __syncthreads();
}
__device__ __forceinline__ void moe_weight_items(const float* wgate, const float* wup, const float* wdown, const float* gain, bf16_t* wgu_t, bf16_t* wd_t, LAS float* T, int bid, int nblk) {
    for (int it = bid; it < NE * 48; it += nblk) {
        const int e = it / 48, r = it % 48, which = r >> 4, q = r & 15;
        if (which < 2) moe_convert_item((which ? wup : wgate) + (size_t)e * D * DE + (size_t)q * 64 * DE, DE, gain + q * 64, wgu_t + (size_t)e * 512 * 1024 + q * 64, 1024, which, 0, T);
        else { const int kb = q >> 2, nb = q & 3;
            moe_convert_item(wdown + (size_t)e * DE * D + (size_t)kb * 64 * D + nb * 256, D, nullptr, wd_t + (size_t)e * 1024 * 256 + kb * 64, 256, 2, nb * 256, T); }
    }
}
__device__ __forceinline__ void p0_prologue(const MArgs& a, LAS unsigned char* lds, int bid, int nblk) {
    const int tid = threadIdx.x, lane = tid & 63, wave = __builtin_amdgcn_readfirstlane(tid >> 6);
    const int gw = bid * NWAVE + wave, ngw = nblk * NWAVE, gt = bid * NTHR + tid, ngt = nblk * NTHR;
    unsigned char* ws = a.ws;
    float2* cs = (float2*)(ws + WS_ROPE);
    for (int _r = 0; _r < (PROBE_PHASE == 301 ? 2 : 1); ++_r)
    for (int idx = gt; idx < LPOS * 32; idx += ngt) { const int pos = idx >> 5, i = idx & 31; const float inv = 1.0f / powf(10000.0f, (float)(2 * i) / 64.0f); float s, c; sincosf((float)pos * inv, &s, &c); cs[idx] = make_float2(c, s); }
    float* wrf = (float*)(ws + W2_WRF);
    for (int idx = gt; idx < 2 * 36 * 1024; idx += ngt) { const int l = idx / (36 * 1024), j = (idx >> 10) % 36, k = idx & 1023;
        const float g = a.in[3][l * D + k]; wrf[idx] = g * (j < 4 ? a.in[16][(size_t)l * D * 4 + k * 4 + j] : a.in[18][(size_t)l * D * 32 + k * 32 + (j - 4)]); }
    { u32x4* z = (u32x4*)(ws + W2_WIN + (size_t)416 * 1024 * 2); for (int idx = gt; idx < 96 * 1024 * 2 / 16; idx += ngt) z[idx] = (u32x4){0u, 0u, 0u, 0u}; }
    { bf16_t* kpe = (bf16_t*)(ws + WS_KPE); for (int idx = gt; idx < 2 * 48 * 32; idx += ngt) { const int b = idx / (48 * 32), r = idx % (48 * 32); kpe[((size_t)b * LP + 8208) * 32 + r] = 0; }
      bf16_t* vt0 = (bf16_t*)(ws + B_VT0); for (int idx = gt; idx < 2 * 2 * 64 * 48; idx += ngt) { const int rr = idx / 48, c = idx % 48; vt0[(size_t)rr * LP + 8208 + c] = 0; } }
    { bf16_t* hb = (bf16_t*)(ws + W2_HB); float* rstd = (float*)(ws + W2_RSTD);
      for (int _r = 0; _r < (PROBE_PHASE == 303 ? 2 : 1); ++_r)
      for (int row = gw; row < MTOT; row += ngw) {
        const float* src = row < MREAL ? a.in[0] + (size_t)row * D : a.in[1] + (size_t)row_pos(row) * D;
        float ss = 0.f;
#pragma unroll
        for (int j = 0; j < 4; ++j) { const f32x4 v = *(const f32x4*)(src + j * 256 + lane * 4); ss += v[0] * v[0] + v[1] * v[1] + v[2] * v[2] + v[3] * v[3];
            *(u32x2*)(hb + (size_t)row * D + j * 256 + lane * 4) = (u32x2){pk2(v[0], v[1]), pk2(v[2], v[3])}; }
        ss = wave_sum(ss); if (lane == 0) rstd[row] = rsqrtf(ss * (1.0f / D) + EPS);
      } }
    LAS float* scr = (LAS float*)(lds + wave * 16384);
    for (int _r = 0; _r < (PROBE_PHASE == 304 ? 2 : 1); ++_r)
    for (int it = gw; it < 2192; it += ngw) {
        int r = it;
        if (r < 640) { transpose_item(a.in[5], NQKV, a.in[2], (bf16_t*)(ws + W2_WQKV), 1024, (r % 40) * 32, (r / 40) * 64, (r % 40) * 32, scr, lane); continue; } r -= 640;
        if (r < 512) { transpose_item(a.in[8], D, nullptr, (bf16_t*)(ws + W2_WO0), 1024, (r & 31) * 32, (r >> 5) * 64, (r & 31) * 32, scr, lane); continue; } r -= 512;
        if (r < 208) { transpose_item(a.in[10], 416, a.in[2] + D, (bf16_t*)(ws + W2_WIN), 1024, (r % 13) * 32, (r / 13) * 64, (r % 13) * 32, scr, lane); continue; } r -= 208;
        if (r < 192) { transpose_item(a.in[13], 1536, a.in[11], (bf16_t*)(ws + W2_WUQ), 256, (r % 48) * 32, (r / 48) * 64, (r % 48) * 32, scr, lane); continue; } r -= 192;
        if (r < 128) { const int nb32 = r & 63, hh = nb32 >> 2, part = nb32 & 3;
            transpose_item(a.in[14], 2048, a.in[12], (bf16_t*)(ws + W2_WUKV), 128, part < 2 ? hh * 64 + part * 32 : 1024 + hh * 64 + (part - 2) * 32, (r >> 6) * 64, nb32 * 32, scr, lane); continue; } r -= 128;
        transpose_item(a.in[15], D, nullptr, (bf16_t*)(ws + W2_WO1), 1024, (r & 31) * 32, (r >> 5) * 64, (r & 31) * 32, scr, lane);
    }
    __syncthreads();
    moe_weight_items(a.in[20], a.in[21], a.in[22], a.in[3], (bf16_t*)(ws + C_W0), (bf16_t*)(ws + C_W0 + MOE_WGU_BYTES), (LAS float*)lds, bid, nblk);
}

template <bool NSW, bool HALFN, class MakeEpi>
__device__ __forceinline__ void gemm_phase(LAS unsigned char* lds, const bf16_t* A, int lda, const bf16_t* Bt, int K, int pn0, int pn1, int bid, int nblk, const MakeEpi& mk) {
    constexpr int BN = HALFN ? 128 : 256;
    const int ntn = pn1 - pn0;
    const bool grp = (nblk % 8) == 0;
    const int x = grp ? bid % 8 : 0, j = grp ? bid / 8 : bid, nslot = grp ? nblk / 8 : nblk, pmg = grp ? 8 : 64;
    for (int u = j; u < pmg * ntn; u += nslot) {
        const int pm = x * pmg + u / ntn, pn = pn0 + u % ntn;
        RowDense ra{A, lda, pm * 256, MTOT - 1}; auto e = mk(pm * 256, pn * BN);
        if (HALFN) gemm_tile<4, 4, 4, 2, NSW>(lds, ra, Bt + (size_t)pn * BN * K, K, K / 32, e);
        else gemm_tile<8, 4, 2, 4, NSW>(lds, ra, Bt + (size_t)pn * BN * K, K, K / 32, e);
    }
    const int nfull = (pmg * ntn + nslot - 1) / nslot;
    for (int pn = pn0; pn < pn1; ++pn) {
        const int owner = (pn - pn0) * 37 % nblk;
        if (bid == owner) { RowDense ra{A, lda, MREAL, MTOT - 1}; auto e = mk(MREAL, pn * BN);
            if (HALFN) gemm_tile<1, 4, 4, 2, NSW>(lds, ra, Bt + (size_t)pn * BN * K, K, K / 32, e);
            else gemm_tile<1, 4, 2, 4, NSW>(lds, ra, Bt + (size_t)pn * BN * K, K, K / 32, e); }
    }
    (void)nfull;
}

constexpr int PH_PROLOGUE = 0, PH_QKV = 1, PH_SWA = 2, PH_OPROJ0 = 3, PH_ROUTE0 = 4, PH_MOE0 = 5, PH_COMBINE = 6, PH_WIN = 7, PH_CEPI = 8, PH_UQKV = 9, PH_MLA = 10, PH_OPROJ1 = 11, PH_ROUTE1 = 12, PH_MOE1 = 13, PH_FINAL = 14, PH_N = 15;
__global__ void __launch_bounds__(NTHR, 2) mega(MArgs a) {
    extern __shared__ __attribute__((aligned(16))) unsigned char lds_raw[];
    LAS unsigned char* lds = (LAS unsigned char*)lds_raw;
    const int tid = threadIdx.x, bid = blockIdx.x, nblk = gridDim.x;
    volatile LAS unsigned* misc = (volatile LAS unsigned*)(lds + LDS_MISC);
    if (tid < 64) misc[tid] = 0u;
    __syncthreads();
    unsigned char* ws = a.ws;
    XcdBarrier bar = xcd_barrier_post((unsigned*)(ws + WS_BAR) + a.li * XCD_BAR_WORDS, misc);
    if (tid == 0) misc[4] = xb_add((unsigned*)(ws + 32 * 1024) + 64 * bar.x, 1u);
    const int lo = a.ph_lo, hi = a.ph_hi;
#define IN(k) (lo <= (k) && (k) < hi)
#define REP(k) for (int _rep = 0; _rep < ((k) == PROBE_PHASE ? 2 : 1); ++_rep, (void)((k) == PROBE_PHASE && _rep == 1 ? (xcd_barrier(bar), 0) : 0))
#define STAMP(i) do { if (PROBE_PHASE >= 600 && bid == 0 && tid == 0) ((unsigned long long*)(ws + 512 * 1024))[i] = __builtin_amdgcn_s_memrealtime(); } while (0)
#define SEAM(k) do { if (IN(k) && IN((k) + 1)) xcd_barrier(bar); STAMP((k) + 1); } while (0)
    STAMP(0);
    if (IN(PH_PROLOGUE)) REP(PH_PROLOGUE) p0_prologue(a, lds, bid, nblk);
    SEAM(PH_PROLOGUE);
    int vbid = bid;
    if (IN(PH_PROLOGUE) && IN(PH_QKV)) {
        if (tid == 0) { bool ok = (nblk % 8) == 0 && bar.x < 8;
            for (int j = 0; j < 8; ++j) ok = ok && xb_ld((unsigned*)(ws + 32 * 1024) + 64 * j) == (unsigned)(nblk / 8);
            misc[5] = ok ? misc[4] * 8u + bar.x : (unsigned)bid; }
        __syncthreads();
        vbid = __builtin_amdgcn_readfirstlane((int)misc[5]);
    }
#define bid vbid
    if (IN(PH_QKV)) REP(PH_QKV) {
        const float* rstd = (const float*)(ws + W2_RSTD); const float* bias = a.in[6]; const float2* cs = (const float2*)(ws + WS_ROPE); bf16_t* qkv = (bf16_t*)(ws + B_QKV); bf16_t* vt0 = (bf16_t*)(ws + B_VT0);
        const bf16_t* hbA = (const bf16_t*)(ws + W2_HB); const bf16_t* Wt = (const bf16_t*)(ws + W2_WQKV);
        const bool grp = (nblk % 8) == 0; const int x = grp ? bid % 8 : 0, j = grp ? bid / 8 : bid, nslot = grp ? nblk / 8 : nblk, pmg = grp ? 8 : 64;
        for (int u = j; u < pmg * 6; u += nslot) {
            if (u < pmg * 4) { const int pm = x * pmg + (u >> 2), pn = u & 3; RowDense ra{hbA, D, pm * 256, MTOT - 1}; EpiQKV e{rstd, bias, cs, qkv, pm * 256, pn * 256};
                gemm_tile<8, 4, 2, 4, false>(lds, ra, Wt + (size_t)pn * 256 * D, D, D / 32, e);
            } else if (u < pmg * 5) { const int pm = x * pmg + (u - pmg * 4); RowDense ra{hbA, D, pm * 256, MTOT - 1}; EpiQKV e{rstd, bias, cs, qkv, pm * 256, 1024};
                gemm_tile<4, 4, 4, 2, false>(lds, ra, Wt + (size_t)1024 * D, D, D / 32, e);
            } else { const int pm = x * pmg + (u - pmg * 5); RowDense ra{hbA, D, pm * 256, MTOT - 1}; EpiV0 e{rstd, bias, vt0, pm * 256, 1152};
                gemm_tile<4, 4, 4, 2, true>(lds, ra, Wt + (size_t)1152 * D, D, D / 32, e);
            }
        }
        const int mu = bid - (nblk - 6);
        if (mu >= 0 && mu < 4) { RowDense ra{hbA, D, MREAL, MTOT - 1}; EpiQKV e{rstd, bias, cs, qkv, MREAL, mu * 256};
            gemm_tile<1, 4, 2, 4, false>(lds, ra, Wt + (size_t)mu * 256 * D, D, D / 32, e);
        } else if (mu == 4) { RowDense ra{hbA, D, MREAL, MTOT - 1}; EpiQKV e{rstd, bias, cs, qkv, MREAL, 1024};
            gemm_tile<1, 4, 4, 2, false>(lds, ra, Wt + (size_t)1024 * D, D, D / 32, e);
        } else if (mu == 5) { RowDense ra{hbA, D, MREAL, MTOT - 1}; EpiV0 e{rstd, bias, vt0, MREAL, 1152};
            gemm_tile<1, 4, 4, 2, true>(lds, ra, Wt + (size_t)1152 * D, D, D / 32, e);
        }
    }
    SEAM(PH_QKV);
    if (IN(PH_SWA)) REP(PH_SWA) swa_phase(lds, (const bf16_t*)(ws + B_QKV), (const bf16_t*)(ws + B_VT0), a.in[7], (bf16_t*)(ws + B_O0), bid, nblk);
    SEAM(PH_SWA);
    if (IN(PH_OPROJ0)) REP(PH_OPROJ0) {
        const float* bias = a.in[9]; bf16_t* hb = (bf16_t*)(ws + W2_HB);
        gemm_phase<false, false>(lds, (const bf16_t*)(ws + B_O0), D, (const bf16_t*)(ws + W2_WO0), D, 0, 4, bid, nblk, [=](int m0, int n0) { return EpiRes{bias, hb, m0, n0}; });
    }
    SEAM(PH_OPROJ0);
    if (IN(PH_ROUTE0))
        route_phase(lds, (const bf16_t*)(ws + W2_HB), (const float*)(ws + W2_WRF), a.in[17], a.in[19], (float*)(ws + W2_RSTD), (int*)(ws + WS_CTL),
                    (int*)(ws + W2_LIST), (float*)(ws + W2_WSLOT), bid, nblk);
    SEAM(PH_ROUTE0);
    if (IN(PH_MOE0)) REP(PH_MOE0) moe_phase(lds, (int*)(ws + WS_CTL), (const int*)(ws + W2_LIST), (const bf16_t*)(ws + W2_HB), (const float*)(ws + W2_RSTD), (const float*)(ws + W2_WSLOT),
                               (const bf16_t*)(ws + C_W0), (const bf16_t*)(ws + C_W0 + MOE_WGU_BYTES), (bf16_t*)(ws + B_Y0), bid, nblk, (unsigned long long*)(ws + 512 * 1024));
    SEAM(PH_MOE0);
    if (IN(PH_COMBINE)) l1proj_phase(lds, (bf16_t*)(ws + W2_HB), (const bf16_t*)(ws + B_Y0), (const bf16_t*)(ws + W2_WIN), (const bf16_t*)(ws + W2_WUQ), (const bf16_t*)(ws + W2_WUKV),
                                     (const float2*)(ws + WS_ROPE), (bf16_t*)(ws + WS_KPE), (bf16_t*)(ws + C_Q1), (bf16_t*)(ws + C_K1), (bf16_t*)(ws + C_V1), bid, nblk);
    STAMP(PH_WIN); STAMP(PH_CEPI); STAMP(PH_UQKV);
    SEAM(PH_UQKV);
    if (IN(PH_MLA)) REP(100) {
        moe_weight_items(a.in[20] + (size_t)NE * D * DE, a.in[21] + (size_t)NE * D * DE, a.in[22] + (size_t)NE * DE * D, a.in[3] + D, (bf16_t*)(ws + B_W1), (bf16_t*)(ws + B_W1 + MOE_WGU_BYTES),
                         (LAS float*)lds, bid, nblk);
    }
    if (IN(PH_MLA)) REP(PH_MLA) mla_phase(lds, (const bf16_t*)(ws + C_Q1), (const bf16_t*)(ws + C_K1), (const bf16_t*)(ws + WS_KPE), (const bf16_t*)(ws + C_V1), (bf16_t*)(ws + B_O1), bid, nblk);
    SEAM(PH_MLA);
    if (IN(PH_OPROJ1)) REP(PH_OPROJ1) {
        bf16_t* hb = (bf16_t*)(ws + W2_HB);
        gemm_phase<false, false>(lds, (const bf16_t*)(ws + B_O1), D, (const bf16_t*)(ws + W2_WO1), D, 0, 4, bid, nblk, [=](int m0, int n0) { return EpiRes{nullptr, hb, m0, n0}; });
    }
    SEAM(PH_OPROJ1);
    if (IN(PH_ROUTE1))
        route_phase(lds, (const bf16_t*)(ws + W2_HB), (const float*)(ws + W2_WRF) + 36 * 1024, a.in[17] + 4, a.in[19] + 32, (float*)(ws + W2_RSTD), (int*)(ws + WS_CTL) + 2048,
                    (int*)(ws + W2_LIST), (float*)(ws + W2_WSLOT), bid, nblk);
    SEAM(PH_ROUTE1);
    if (IN(PH_MOE1)) REP(PH_MOE1) moe_phase(lds, (int*)(ws + WS_CTL) + 2048, (const int*)(ws + W2_LIST), (const bf16_t*)(ws + W2_HB), (const float*)(ws + W2_RSTD), (const float*)(ws + W2_WSLOT),
                               (const bf16_t*)(ws + B_W1), (const bf16_t*)(ws + B_W1 + MOE_WGU_BYTES), (bf16_t*)(ws + C_Y1), bid, nblk);
    SEAM(PH_MOE1);
    if (IN(PH_FINAL)) REP(PH_FINAL) final_phase((const bf16_t*)(ws + W2_HB), (const bf16_t*)(ws + C_Y1), a.in[4], a.out, bid, nblk);
#undef bid
#undef IN
#undef SEAM
}

static void run_mega(hipStream_t s, const MArgs& base, int lo, int hi, int grid) {
    MArgs a = base; a.ph_lo = lo; a.ph_hi = hi; a.li = lo;
    hipLaunchKernelGGL(mega, dim3(grid), dim3(NTHR), LDS_BYTES, s, a);
}
extern "C" void kernel_launch(void* const* d_in, const int* in_sizes, int n_in, void* d_out, int out_size, void* d_ws, size_t ws_size, hipStream_t stream) {
    static int grid = 0;
    if (grid == 0) {
        if (n_in != 23 || ws_size < WS_END) { fprintf(stderr, "kernel_launch: unexpected n_in %d or ws_size %zu\n", n_in, ws_size); grid = -1; return; }
        if (hipFuncSetAttribute((const void*)mega, hipFuncAttributeMaxDynamicSharedMemorySize, LDS_BYTES) != hipSuccess) { fprintf(stderr, "hipFuncSetAttribute failed\n"); grid = -1; return; }
        int dev = 0, cus = 0, per_cu = 0;
        (void)hipGetDevice(&dev); (void)hipDeviceGetAttribute(&cus, hipDeviceAttributeMultiprocessorCount, dev);
        (void)hipOccupancyMaxActiveBlocksPerMultiprocessor(&per_cu, (const void*)mega, NTHR, LDS_BYTES);
        if (per_cu < 1) { fprintf(stderr, "occupancy query says %d blocks/CU\n", per_cu); }
        (void)hipGetLastError();
        grid = cus;
    }
    if (grid < 0) return;
    (void)in_sizes; (void)out_size;
    unsigned char* ws = (unsigned char*)d_ws;
    MArgs base{}; for (int i = 0; i < 23; ++i) base.in[i] = (const float*)d_in[i]; base.out = (float*)d_out; base.ws = ws;
    (void)hipMemsetAsync(ws + WS_CTL, 0, 1 * MiB, stream);
    run_mega(stream, base, 0, PH_N, grid);
}
```

```cpp
#include <hip/hip_runtime.h>
#ifndef PROBE_PHASE
#define PROBE_PHASE -1
#endif
#include <cstdio>
#include <cstdint>

typedef unsigned short bf16_t;

constexpr int D = 1024, SEQ = 8192, NB = 2, NMETA = 16;
constexpr int MREAL = NB * SEQ;
constexpr int MTOT = MREAL + NB * NMETA;
constexpr int LPOS = NMETA + SEQ;
constexpr int NQKV = 1280;
constexpr int NE = 32, DE = 256;
constexpr int CAP = MTOT * 2;
constexpr float EPS = 1e-6f;

__device__ __forceinline__ float bf2f(bf16_t v) { return __uint_as_float(((unsigned)v) << 16); }
__device__ __forceinline__ bf16_t f2bf(float f) { unsigned u = __float_as_uint(f); u += 0x7fffu + ((u >> 16) & 1u); return (bf16_t)(u >> 16); }
__device__ __forceinline__ int row_pos(int row) { return row < MREAL ? NMETA + (row & (SEQ - 1)) : ((row - MREAL) & (NMETA - 1)); }
__device__ __forceinline__ int row_batch(int row) { return row < MREAL ? (row >> 13) : ((row - MREAL) >> 4); }
constexpr int LP = 8256;
__device__ __forceinline__ int perm16(int p) { const int qd = (p >> 2) & 3; return (p & ~12) | ((((qd & 1) << 1) | (qd >> 1)) << 2); }
__device__ __forceinline__ float wave_sum(float v) {
#pragma unroll
    for (int o = 1; o < 64; o <<= 1) v += __shfl_xor(v, o);
    return v;
}

constexpr size_t MiB = 1u << 20;
constexpr size_t WS_CTL = 0;
constexpr size_t WS_ROPE = 1 * MiB;
constexpr size_t WS_END = 256 * MiB;

#define LAS __attribute__((address_space(3)))
#define GAS __attribute__((address_space(1)))
typedef short bf16x8 __attribute__((ext_vector_type(8)));
typedef float f32x4 __attribute__((ext_vector_type(4)));
typedef unsigned u32x4 __attribute__((ext_vector_type(4)));
typedef unsigned u32x2 __attribute__((ext_vector_type(2)));
constexpr int NTHR = 512, NWAVE = 8;
constexpr int LDS_MISC = 162816;
constexpr int LDS_BYTES = LDS_MISC + 1024;

constexpr size_t WS_BAR = 64 * 1024;
constexpr size_t WS_KPE = 3 * MiB + 256 * 1024;
constexpr size_t W2_RSTD = 4 * MiB + 512 * 1024, W2_WSLOT = W2_RSTD + 80 * 1024, W2_EID = W2_WSLOT + 144 * 1024;
constexpr size_t W2_LIST = 5 * MiB;
constexpr size_t W2_WRF = 9 * MiB + 256 * 1024;
constexpr size_t W2_WQKV = 10 * MiB;
constexpr size_t W2_WO0 = W2_WQKV + 2560 * 1024;
constexpr size_t W2_WIN = W2_WO0 + 2048 * 1024;
constexpr size_t W2_WUQ = W2_WIN + 1024 * 1024;
constexpr size_t W2_WUKV = W2_WUQ + 768 * 1024;
constexpr size_t W2_WO1 = W2_WUKV + 512 * 1024;
constexpr size_t W2_HB = 20 * MiB;
constexpr size_t W2_RB = 53 * MiB;
constexpr size_t W2_RC = 134 * MiB;
static_assert(W2_EID + (size_t)MTOT * 8 <= W2_LIST && W2_LIST + (size_t)NE * CAP * 4 <= W2_WRF && W2_WO1 + 2 * MiB <= W2_HB && W2_HB + (size_t)MTOT * 2048 <= W2_RB, "fixed map");
constexpr size_t B_QKV = W2_RB, B_O0 = W2_RB + 41 * MiB, B_VT0 = W2_RB + 74 * MiB  , B_Y0 = W2_RB, B_CBUF = W2_RB, B_CQN = W2_RB + 33 * MiB, B_CKVN = W2_RB + 42 * MiB, B_O1 = W2_RB, B_W1 = W2_RB + 33 * MiB;
constexpr size_t C_W0 = W2_RC, C_HF = W2_RC + 48 * MiB, C_Q1 = W2_RC, C_K1 = W2_RC + 49 * MiB, C_V1 = W2_RC + 82 * MiB, C_HF1 = W2_RC, C_Y1 = W2_RC;
static_assert(C_V1 + (size_t)2 * 16 * 64 * LP * 2 <= WS_END && C_K1 + (size_t)2 * LP * 2048 <= C_V1 && B_VT0 + (size_t)2 * 2 * 64 * LP * 2 <= W2_RC && C_HF + (size_t)MTOT * 4096 <= WS_END && B_W1 + 48 * MiB <= W2_RC, "region map");
constexpr size_t MOE_WGU_BYTES = (size_t)NE * 512 * 1024 * 2, MOE_WD_BYTES = (size_t)NE * 1024 * 256 * 2;

struct MArgs { const float* in[23]; float* out; unsigned char* ws; int ph_lo, ph_hi, li, pad; };

__device__ __forceinline__ unsigned pk2(float lo, float hi) { return (unsigned)f2bf(lo) | ((unsigned)f2bf(hi) << 16); }

#define XB_TMO      128
#define XB_XCNT(j)  (256  + 64 * (j))
#define XB_XSUB(j)  (1280 + 64 * (j))
#define XB_XGEN(j)  (2304 + 64 * (j))
#define XB_TOP      3328
#define XB_TOPGEN   3392
#define XCD_BAR_WORDS 3456
#define XB_SPIN_CAP (1u << 18)
__device__ __forceinline__ unsigned xb_ld(unsigned* p)              { return __hip_atomic_load(p, __ATOMIC_RELAXED, __HIP_MEMORY_SCOPE_AGENT); }
__device__ __forceinline__ unsigned xb_add(unsigned* p, unsigned v) { return __hip_atomic_fetch_add(p, v, __ATOMIC_RELAXED, __HIP_MEMORY_SCOPE_AGENT); }
__device__ __forceinline__ unsigned xb_xcc_id() { return (unsigned)__builtin_amdgcn_s_getreg((3 << 11) | 20) & 0xFu; }
#define XB_SPIN(cond, bar) do { unsigned _sp = 0; while (cond) { __builtin_amdgcn_s_sleep(1); \
    if ((++_sp & 255u) == 0u) { if (xb_ld(&(bar)[XB_TMO])) break; if (_sp > XB_SPIN_CAP) { atomicAdd(&(bar)[XB_TMO], 1u); break; } } } } while (0)
struct XcdBarrier { unsigned* bar; unsigned x; volatile LAS unsigned* st; };
__device__ __forceinline__ XcdBarrier xcd_barrier_post(unsigned* bar, volatile LAS unsigned* st) {
    XcdBarrier b; b.bar = bar; b.x = xb_xcc_id(); b.st = st;
    if (threadIdx.x == 0) (void)xb_add(&bar[XB_XCNT(b.x)], 1u);
    return b;
}
__device__ __forceinline__ void xcd_barrier_complete(unsigned* bar, unsigned x, unsigned& nloc, unsigned& nx) {
    const unsigned G = gridDim.x * gridDim.y * gridDim.z;
    unsigned sum, cnt, mine, sp = 0u;
    for (;;) {
        sum = 0u; cnt = 0u; mine = 0u;
#pragma unroll
        for (unsigned j = 0; j < 16; ++j) { const unsigned c = xb_ld(&bar[XB_XCNT(j)]); sum += c; cnt += (c > 0u) ? 1u : 0u; mine = (j == x) ? c : mine; }
        if (sum == G) break;
        __builtin_amdgcn_s_sleep(1);
        if ((++sp & 255u) == 0u) { if (xb_ld(&bar[XB_TMO])) break; if (sp > XB_SPIN_CAP) { atomicAdd(&bar[XB_TMO], 1u); break; } }
    }
    nloc = mine > 0u ? mine : 1u; nx = cnt > 0u ? cnt : 1u;
}
__device__ __forceinline__ void xcd_barrier(const XcdBarrier& b) {
    asm volatile("s_waitcnt vmcnt(0)" ::: "memory");
    __syncthreads();
    if (threadIdx.x == 0) {
        unsigned* bar = b.bar;
        __builtin_amdgcn_s_waitcnt(0);
        unsigned nloc = b.st[0], nx = b.st[1];
        if (nloc == 0u) { xcd_barrier_complete(bar, b.x, nloc, nx); b.st[0] = nloc; b.st[1] = nx; }
        const unsigned old = xb_add(&bar[XB_XSUB(b.x)], 1u);
        const unsigned gen = old / nloc;
        if (old + 1u == (gen + 1u) * nloc) {
            __builtin_amdgcn_fence(__ATOMIC_RELEASE, "agent");
            asm volatile("s_waitcnt vmcnt(0)" ::: "memory");
            const unsigned og = xb_add(&bar[XB_TOP], 1u);
            const unsigned tg = og / nx;
            if (og + 1u == (tg + 1u) * nx) xb_add(&bar[XB_TOPGEN], 1u);
            else XB_SPIN(xb_ld(&bar[XB_TOPGEN]) == tg, bar);
            __builtin_amdgcn_fence(__ATOMIC_ACQUIRE, "agent");
            xb_add(&bar[XB_XGEN(b.x)], 1u);
            asm volatile("s_waitcnt vmcnt(0)" ::: "memory");
        } else {
            XB_SPIN(xb_ld(&bar[XB_XGEN(b.x)]) == gen, bar);
            __builtin_amdgcn_fence(__ATOMIC_ACQUIRE, "agent");
            asm volatile("s_waitcnt vmcnt(0)" ::: "memory");
        }
    }
    __syncthreads();
}

template <int N> __device__ __forceinline__ void wait_vm() { asm volatile("s_waitcnt vmcnt(%0)" :: "n"(N) : "memory"); }
__device__ __forceinline__ int swzF(int g) { return (0x78 >> (2 * g)) & 3; }
constexpr int GT_NS = 4;
template <int MT, int NT, int WM, int WN, bool NSW, class RowA, class Epi, bool NOLD = false>
__device__ __forceinline__ void gemm_tile(LAS unsigned char* lds, const RowA& rowA, const bf16_t* __restrict__ Bt, int ldb  , int nk  , Epi& epi) {
    constexpr int BM = WM * MT * 16, BN = WN * NT * 16, GA = BM / 16, G = (BM + BN) / 16, NG = (G + 7) / 8, GR = G % 8, STAGE = (BM + BN) * 64;
    static_assert(WM * WN == 8 && GT_NS * STAGE <= LDS_MISC && BM % 16 == 0 && BN % 16 == 0, "gemm_tile config");
    const int tid = threadIdx.x, lane = tid & 63, wave = __builtin_amdgcn_readfirstlane(tid >> 6), wm = wave / WN, wn = wave % WN;
    const char* src[NG];
    const int lc = (lane & 3) ^ swzF(lane >> 4);
#pragma unroll
    for (int i = 0; i < NG; ++i) {
        const int g = wave + 8 * i;
        if (g < GA) src[i] = (const char*)rowA(g * 16 + (lane >> 2)) + lc * 16;
        else if (g < G) src[i] = (const char*)(Bt + (size_t)((g - GA) * 16 + (lane >> 2)) * ldb) + lc * 16;
        else src[i] = nullptr;
    }
    f32x4 acc[MT][NT];
#pragma unroll
    for (int mi = 0; mi < MT; ++mi)
#pragma unroll
        for (int ni = 0; ni < NT; ++ni) acc[mi][ni] = (f32x4){0.f, 0.f, 0.f, 0.f};
    const int fro = (lane & 15) * 64 + (((lane >> 4) ^ swzF((lane >> 2) & 3)) << 4);
    constexpr int LM = PROBE_PHASE == 402 ? 2 : 1;
#define GT_STAGE(st, kt) do { _Pragma("unroll") for (int _i = 0; _i < NG; ++_i) { const int _g = wave + 8 * _i; if (_g < G) { \
        __builtin_amdgcn_global_load_lds((const unsigned*)(src[_i] + (size_t)(kt) * 64), (LAS unsigned*)(lds + (st) * STAGE + _g * 1024), 16, 0, 0); \
        if (LM == 2) __builtin_amdgcn_global_load_lds((const unsigned*)(src[_i] + (size_t)(kt) * 64), (LAS unsigned*)(lds + (st) * STAGE + _g * 1024), 16, 0, 0); } } } while (0)
#define GT_WAIT(ntl) do { if (GR == 0 || wave < GR) wait_vm<LM * NG * (ntl)>(); else wait_vm<LM * (NG - 1) * (ntl)>(); } while (0)
    if (!NOLD) { GT_STAGE(0, 0);
    if (nk > 1) GT_STAGE(1, 1);
    if (nk > 2) GT_STAGE(2, 2); }
    int st = 0;
    for (int kt = 0; kt < nk; ++kt) {
        const int rem = nk - 1 - kt;
        if (!NOLD) { if (rem >= 2) GT_WAIT(2); else if (rem == 1) GT_WAIT(1); else GT_WAIT(0); }
        __builtin_amdgcn_s_barrier(); asm volatile("" ::: "memory");
        const bool doload = (!NOLD || PROBE_PHASE == 505) && kt + 3 < nk;
        LAS const unsigned char* sa = lds + st * STAGE + (wm * MT * 16) * 64 + fro;
        LAS const unsigned char* sb = lds + st * STAGE + (BM + wn * NT * 16) * 64 + fro;
        bf16x8 bfr[NT];
#pragma unroll
        for (int ni = 0; ni < NT; ++ni) bfr[ni] = *(LAS const bf16x8*)(sb + ni * 1024);
        constexpr int PG = MT >= 2 ? 2 : 1, NPG = MT / PG;
        constexpr int LPG = (NG + NPG - 1) / NPG;
        bf16x8 afc[PG], afn[PG];
#pragma unroll
        for (int i = 0; i < PG; ++i) afc[i] = *(LAS const bf16x8*)(sa + i * 1024);
#pragma unroll
        for (int pg = 0; pg < NPG; ++pg) {
            if (doload) {
#pragma unroll
                for (int l = 0; l < LPG; ++l) { const int _i = pg * LPG + l; if (_i < NG) { const int _g = wave + 8 * _i; if (_g < G)
                    __builtin_amdgcn_global_load_lds((const unsigned*)(src[_i] + (size_t)(kt + 3) * 64), (LAS unsigned*)(lds + ((st + 3) & 3) * STAGE + _g * 1024), 16, 0, 0); } }
            }
            if (pg + 1 < NPG) {
#pragma unroll
                for (int i = 0; i < PG; ++i) afn[i] = *(LAS const bf16x8*)(sa + ((pg + 1) * PG + i) * 1024);
            }
#pragma unroll
            for (int i = 0; i < PG; ++i) { const int mi = pg * PG + i;
#pragma unroll
                for (int ni = 0; ni < NT; ++ni) {
                    if (NSW) acc[mi][ni] = __builtin_amdgcn_mfma_f32_16x16x32_bf16(afc[i], bfr[ni], acc[mi][ni], 0, 0, 0);
                    else acc[mi][ni] = __builtin_amdgcn_mfma_f32_16x16x32_bf16(bfr[ni], afc[i], acc[mi][ni], 0, 0, 0);
                } }
#pragma unroll
            for (int i = 0; i < PG; ++i) afc[i] = afn[i];
            __builtin_amdgcn_sched_barrier(0);
        }
        st = (st + 1) & 3;
    }
#undef GT_STAGE
#undef GT_WAIT
    epi(acc, wm * MT * 16, wn * NT * 16, lane);
    asm volatile("s_waitcnt lgkmcnt(0)" ::: "memory");
    __syncthreads();
}

struct RowDense { const bf16_t* A; int lda, m0, mlast; __device__ __forceinline__ const bf16_t* operator()(int r) const { int row = m0 + r; row = row > mlast ? mlast : row; return A + (size_t)row * lda; } };

struct EpiQKV {
    const float* rstd; const float* bias; const float2* cs; bf16_t* qkv; int m0, n0;
    template <int MT, int NT> __device__ __forceinline__ void operator()(f32x4 (&acc)[MT][NT], int mb, int nb, int lane) const {
        static_assert(NT == 4, "rope needs a 64-column wave span");
        const int cb = n0 + nb, d0 = (lane >> 4) * 4;
#pragma unroll
        for (int mi = 0; mi < MT; ++mi) {
            const int row = m0 + mb + mi * 16 + (lane & 15);
            if (row < MTOT) {
                const float rs = rstd[row]; const int pos = row_pos(row);
                bf16_t* orow = qkv + (size_t)row * NQKV + cb;
                {
                    const float sc = cb < 1024 ? 0.125f : 1.0f;
#pragma unroll
                    for (int ni = 0; ni < 2; ++ni) {
                        const int d = ni * 16 + d0;
                        const f32x4 b1 = *(const f32x4*)(bias + cb + d), b2 = *(const f32x4*)(bias + cb + 32 + d);
                        float o1[4], o2[4];
#pragma unroll
                        for (int r = 0; r < 4; ++r) {
                            const float2 t = cs[pos * 32 + d + r];
                            const float x1 = acc[mi][ni][r] * rs + b1[r], x2 = acc[mi][ni + 2][r] * rs + b2[r];
                            o1[r] = (x1 * t.x - x2 * t.y) * sc; o2[r] = (x2 * t.x + x1 * t.y) * sc;
                        }
                        *(u32x2*)(orow + d) = (u32x2){pk2(o1[0], o1[1]), pk2(o1[2], o1[3])};
                        *(u32x2*)(orow + 32 + d) = (u32x2){pk2(o2[0], o2[1]), pk2(o2[2], o2[3])};
                    }
                }
            }
        }
    }
};
struct EpiV0 {
    const float* rstd; const float* bias; bf16_t* vt0; int m0, n0;
    template <int MT, int NT> __device__ __forceinline__ void operator()(f32x4 (&acc)[MT][NT], int mb, int nb, int lane) const {
        static_assert(NT == 4, "64-column wave span");
        const int cb = n0 + nb, kh = (cb - 1152) >> 6;
#pragma unroll
        for (int mi = 0; mi < MT; ++mi) {
            const int row0 = m0 + mb + mi * 16 + (lane >> 4) * 4;
            if (row0 < MTOT) {
                const f32x4 rs = *(const f32x4*)(rstd + row0); const int b = row_batch(row0), pp = perm16(row_pos(row0));
#pragma unroll
                for (int ni = 0; ni < NT; ++ni) { const int d = ni * 16 + (lane & 15); const float bb = bias[cb + d];
                    const f32x4 v = acc[mi][ni] * rs + bb;
                    *(u32x2*)(vt0 + (size_t)((b * 2 + kh) * 64 + d) * LP + pp) = (u32x2){pk2(v[0], v[1]), pk2(v[2], v[3])}; }
            }
        }
    }
};
struct EpiRes {
    const float* bias; bf16_t* hb; int m0, n0;
    template <int MT, int NT> __device__ __forceinline__ void operator()(f32x4 (&acc)[MT][NT], int mb, int nb, int lane) const {
#pragma unroll
        for (int mi = 0; mi < MT; ++mi) {
            const int row = m0 + mb + mi * 16 + (lane & 15);
            if (row < MTOT) {
#pragma unroll
                for (int ni = 0; ni < NT; ++ni) {
                    const int col = n0 + nb + ni * 16 + (lane >> 4) * 4;
                    u32x2* p = (u32x2*)(hb + (size_t)row * D + col);
                    const u32x2 h = *p;
                    f32x4 v = acc[mi][ni];
                    if (bias) v += *(const f32x4*)(bias + col);
                    v[0] += __uint_as_float(h.x << 16); v[1] += __uint_as_float(h.x & 0xffff0000u); v[2] += __uint_as_float(h.y << 16); v[3] += __uint_as_float(h.y & 0xffff0000u);
                    *p = (u32x2){pk2(v[0], v[1]), pk2(v[2], v[3])};
                }
            }
        }
    }
};
__device__ __forceinline__ void route_phase(LAS unsigned char* lds, const bf16_t* __restrict__ hbr, const float* __restrict__ wrf, const float* __restrict__ bg, const float* __restrict__ br,
                                            float* rstd_out, int* cnt, int* list, float* wslot, int bid, int nblk) {
    const int tid = threadIdx.x, lane = tid & 63, wave = __builtin_amdgcn_readfirstlane(tid >> 6);
    LAS f32x4* wl = (LAS f32x4*)lds;
    LAS int* nrec = (LAS int*)(lds + LDS_MISC + 16); LAS int* bcnt = (LAS int*)(lds + LDS_MISC + 32); LAS int* bbase = (LAS int*)(lds + LDS_MISC + 160); LAS int* rec = (LAS int*)(lds + LDS_MISC + 288);
    for (int i = tid; i < 36 * 256; i += NTHR) wl[i] = *(const f32x4*)(wrf + (size_t)i * 4);
    if (tid < NE) bcnt[tid] = 0;
    if (tid == 0) *nrec = 0;
    __syncthreads();
    for (int row = bid * NWAVE + wave; row < MTOT; row += nblk * NWAVE) {
        f32x4 x[4]; float ss = 0.f;
#pragma unroll
        for (int j = 0; j < 4; ++j) { const u32x2 h = *(const u32x2*)(hbr + (size_t)row * D + j * 256 + lane * 4);
            x[j] = (f32x4){__uint_as_float(h.x << 16), __uint_as_float(h.x & 0xffff0000u), __uint_as_float(h.y << 16), __uint_as_float(h.y & 0xffff0000u)};
            ss += x[j][0] * x[j][0] + x[j][1] * x[j][1] + x[j][2] * x[j][2] + x[j][3] * x[j][3]; }
        ss = wave_sum(ss);
        const float rs = rsqrtf(ss * (1.0f / D) + EPS);
        float lg[4];
#pragma unroll
        for (int c = 0; c < 4; ++c) { float p = 0.f;
#pragma unroll
            for (int j = 0; j < 4; ++j) { const f32x4 w = wl[c * 256 + j * 64 + lane]; p += x[j][0] * w[0] + x[j][1] * w[1] + x[j][2] * w[2] + x[j][3] * w[3]; }
            lg[c] = wave_sum(p) * rs + bg[c]; }
        int gi = 0; float gm = lg[0];
#pragma unroll
        for (int c = 1; c < 4; ++c) if (lg[c] > gm) { gm = lg[c]; gi = c; }
        float gs = 0.f;
#pragma unroll
        for (int c = 0; c < 4; ++c) gs += __expf(lg[c] - gm);
        const float gp = 1.0f / gs;
        gi = __builtin_amdgcn_readfirstlane(gi);
        float e[8];
#pragma unroll
        for (int c = 0; c < 8; ++c) { float p = 0.f;
#pragma unroll
            for (int j = 0; j < 4; ++j) { const f32x4 w = wl[(4 + gi * 8 + c) * 256 + j * 64 + lane]; p += x[j][0] * w[0] + x[j][1] * w[1] + x[j][2] * w[2] + x[j][3] * w[3]; }
            e[c] = wave_sum(p) * rs + br[gi * 8 + c]; }
        int i1 = 0; float v1 = e[0];
#pragma unroll
        for (int c = 1; c < 8; ++c) if (e[c] > v1) { v1 = e[c]; i1 = c; }
        int i2 = -1; float v2 = -3.0e38f;
#pragma unroll
        for (int c = 0; c < 8; ++c) if (c != i1 && e[c] > v2) { v2 = e[c]; i2 = c; }
        if (lane == 0) {
            const float r = __expf(v2 - v1);
            const float w1 = gp / (1.0f + r), w2 = gp * r / (1.0f + r);
            const int e1 = gi * 8 + i1, e2 = gi * 8 + i2;
            const int p1 = atomicAdd((int*)&bcnt[e1], 1), p2 = atomicAdd((int*)&bcnt[e2], 1);
            const int k = atomicAdd((int*)nrec, 2);
            rec[k] = ((row * 2) << 13) | (e1 << 8) | p1; rec[k + 1] = ((row * 2 + 1) << 13) | (e2 << 8) | p2;
            wslot[row * 2] = w1; wslot[row * 2 + 1] = w2; rstd_out[row] = rs;
        }
    }
    __syncthreads();
    if (tid < NE) { const int c = bcnt[tid]; bbase[tid] = c ? __hip_atomic_fetch_add(cnt + tid * 64, c, __ATOMIC_RELAXED, __HIP_MEMORY_SCOPE_AGENT) : 0; }
    __syncthreads();
    for (int k = tid; k < *nrec; k += NTHR) { const int r = rec[k], e = (r >> 8) & 31; list[(size_t)e * CAP + bbase[e] + (r & 255)] = r >> 13; }
    __syncthreads();
}
__device__ __forceinline__ void final_phase(const bf16_t* __restrict__ hb, const bf16_t* __restrict__ ybuf, const float* __restrict__ g, float* out, int bid, int nblk) {
    const int tid = threadIdx.x, lane = tid & 63, wave = tid >> 6;
    for (int row = bid * NWAVE + wave; row < MREAL; row += nblk * NWAVE) {
        f32x4 v[4]; float ss = 0.f;
#pragma unroll
        for (int j = 0; j < 4; ++j) { const size_t c = j * 256 + lane * 4;
            const u32x2 h = *(const u32x2*)(hb + (size_t)row * D + c), y0 = *(const u32x2*)(ybuf + (size_t)(row * 2) * D + c), y1 = *(const u32x2*)(ybuf + (size_t)(row * 2 + 1) * D + c);
            v[j][0] = __uint_as_float(h.x << 16) + __uint_as_float(y0.x << 16) + __uint_as_float(y1.x << 16);
            v[j][1] = __uint_as_float(h.x & 0xffff0000u) + __uint_as_float(y0.x & 0xffff0000u) + __uint_as_float(y1.x & 0xffff0000u);
            v[j][2] = __uint_as_float(h.y << 16) + __uint_as_float(y0.y << 16) + __uint_as_float(y1.y << 16);
            v[j][3] = __uint_as_float(h.y & 0xffff0000u) + __uint_as_float(y0.y & 0xffff0000u) + __uint_as_float(y1.y & 0xffff0000u);
            ss += v[j][0] * v[j][0] + v[j][1] * v[j][1] + v[j][2] * v[j][2] + v[j][3] * v[j][3]; }
        const float rs = rsqrtf(wave_sum(ss) * (1.0f / D) + EPS);
#pragma unroll
        for (int j = 0; j < 4; ++j) { const f32x4 gg = *(const f32x4*)(g + j * 256 + lane * 4); *(f32x4*)(out + (size_t)row * D + j * 256 + lane * 4) = v[j] * rs * gg; }
    }
}

typedef float f32x16 __attribute__((ext_vector_type(16)));
constexpr int AT_STAGE = 20480;
__device__ __forceinline__ unsigned cvtpk(float lo, float hi) { typedef float f2 __attribute__((ext_vector_type(2))); typedef __bf16 b2 __attribute__((ext_vector_type(2)));
    f2 v = {lo, hi}; b2 r = __builtin_convertvector(v, b2); return __builtin_bit_cast(unsigned, r); }
__device__ __forceinline__ void mla_unit(LAS unsigned char* lds, int b, int h, int qi, const bf16_t* __restrict__ Q1, const bf16_t* __restrict__ K1, const bf16_t* __restrict__ kpe,
                                         const bf16_t* __restrict__ VT1, bf16_t* o) {
    const int tid = threadIdx.x, lane = tid & 63, wave = __builtin_amdgcn_readfirstlane(tid >> 6), r32 = lane & 31, hi = lane >> 5;
    const size_t qrow = (size_t)b * SEQ + 256 * qi + 32 * wave + r32;
    bf16x8 qf[6];
#pragma unroll
    for (int s = 0; s < 6; ++s) qf[s] = *(const bf16x8*)(Q1 + qrow * 1536 + h * 96 + 16 * s + 8 * hi);
    const int lr = 8 * wave + (lane >> 3);
    const char* ksrc = (const char*)(K1 + ((size_t)b * LP + lr) * 1024 + h * 64) + (((lane & 7) ^ ((lr >> 1) & 7)) << 4);
    const char* vsrc = (const char*)(VT1 + ((size_t)(b * 16 + h) * 64 + lr) * LP) + (((lane & 7) ^ ((lr >> 1) & 7)) << 4);
    const int pr = 16 * wave + (lane >> 2);
    const char* psrc = (const char*)(kpe + ((size_t)b * LP + (pr & 63)) * 32) + (((lane & 3) ^ ((pr >> 2) & 3)) << 4);
#define MLA_ISSUE(j, st) do { \
        __builtin_amdgcn_global_load_lds((const unsigned*)(ksrc + (size_t)(j) * (64 * 2048)), (LAS unsigned*)(lds + (st) * AT_STAGE + wave * 1024), 16, 0, 0); \
        __builtin_amdgcn_global_load_lds((const unsigned*)(vsrc + (size_t)(j) * 128), (LAS unsigned*)(lds + (st) * AT_STAGE + 8192 + wave * 1024), 16, 0, 0); \
        if (wave < 4) __builtin_amdgcn_global_load_lds((const unsigned*)(psrc + (size_t)(j) * (64 * 64)), (LAS unsigned*)(lds + (st) * AT_STAGE + 16384 + wave * 1024), 16, 0, 0); } while (0)
    const int NT = 4 * qi + 5, jmaxw = 4 * qi + ((32 * wave + 47) >> 6);
    const int qp = 16 + 256 * qi + 32 * wave + r32;
    const int koff = r32 * 128, ksw = (r32 >> 1) & 7, poff = 16384 + r32 * 64, psw = (r32 >> 2) & 3, voff = 8192 + r32 * 128;
    f32x16 oacc[2]; oacc[0] = (f32x16){}; oacc[1] = (f32x16){};
    constexpr float MLA_THR = 8.0f;
    float mref = 0.f, lsum = 0.f;
    f32x16 negm = (f32x16){};
    MLA_ISSUE(0, 0);
    if (NT > 1) MLA_ISSUE(1, 1);
    int st = 0;
    for (int j = 0; j < NT; ++j) {
        if (j + 1 < NT) { if (wave < 4) asm volatile("s_waitcnt vmcnt(3)" ::: "memory"); else asm volatile("s_waitcnt vmcnt(2)" ::: "memory"); }
        else asm volatile("s_waitcnt vmcnt(0)" ::: "memory");
        __builtin_amdgcn_s_barrier(); asm volatile("" ::: "memory");
        if (j + 2 < NT) { const int st2 = st >= 1 ? st - 1 : 2; MLA_ISSUE(j + 2, st2); }
        if (j <= jmaxw) {
            LAS const unsigned char* sb = lds + st * AT_STAGE;
            f32x16 p0, p1;
            {
                const bf16x8 k0 = *(LAS const bf16x8*)(sb + koff + ((hi ^ ksw) << 4));
                const bf16x8 k1 = *(LAS const bf16x8*)(sb + 4096 + koff + ((hi ^ ksw) << 4));
                p0 = __builtin_amdgcn_mfma_f32_32x32x16_bf16(k0, qf[0], negm, 0, 0, 0);
                p1 = __builtin_amdgcn_mfma_f32_32x32x16_bf16(k1, qf[0], negm, 0, 0, 0);
            }
#pragma unroll
            for (int s = 1; s < 4; ++s) {
                const bf16x8 k0 = *(LAS const bf16x8*)(sb + koff + (((2 * s + hi) ^ ksw) << 4));
                const bf16x8 k1 = *(LAS const bf16x8*)(sb + 4096 + koff + (((2 * s + hi) ^ ksw) << 4));
                p0 = __builtin_amdgcn_mfma_f32_32x32x16_bf16(k0, qf[s], p0, 0, 0, 0);
                p1 = __builtin_amdgcn_mfma_f32_32x32x16_bf16(k1, qf[s], p1, 0, 0, 0);
            }
#pragma unroll
            for (int s = 0; s < 2; ++s) {
                const bf16x8 k0 = *(LAS const bf16x8*)(sb + poff + (((2 * s + hi) ^ psw) << 4));
                const bf16x8 k1 = *(LAS const bf16x8*)(sb + 2048 + poff + (((2 * s + hi) ^ psw) << 4));
                p0 = __builtin_amdgcn_mfma_f32_32x32x16_bf16(k0, qf[4 + s], p0, 0, 0, 0);
                p1 = __builtin_amdgcn_mfma_f32_32x32x16_bf16(k1, qf[4 + s], p1, 0, 0, 0);
            }
            if (j >= 4 * qi) {
                const int kb0 = 64 * j + 4 * hi;
#pragma unroll
                for (int r = 0; r < 16; ++r) { const int kp = kb0 + (r & 3) + 8 * (r >> 2); if (kp > qp) p0[r] = -1e30f; if (kp + 32 > qp) p1[r] = -1e30f; }
            }
            float tm = fmaxf(p0[0], p1[0]);
#pragma unroll
            for (int r = 1; r < 16; ++r) tm = fmaxf(tm, fmaxf(p0[r], p1[r]));
            tm = fmaxf(tm, __shfl_xor(tm, 32));
            if (j == 0 || __any(tm > MLA_THR)) {
                const float dl = j == 0 ? tm : fmaxf(tm, 0.f);
                mref += dl;
                const float f = __builtin_amdgcn_exp2f(-dl);
                lsum *= f;
#pragma unroll
                for (int r = 0; r < 16; ++r) { oacc[0][r] *= f; oacc[1][r] *= f; p0[r] -= dl; p1[r] -= dl; negm[r] = -mref; }
            }
            float ps = 0.f;
#pragma unroll
            for (int r = 0; r < 16; ++r) { p0[r] = __builtin_amdgcn_exp2f(p0[r]); p1[r] = __builtin_amdgcn_exp2f(p1[r]); ps += p0[r] + p1[r]; }
            lsum += ps;
            u32x4 pf[4];
            pf[0] = (u32x4){cvtpk(p0[0], p0[1]), cvtpk(p0[2], p0[3]), cvtpk(p0[4], p0[5]), cvtpk(p0[6], p0[7])};
            pf[1] = (u32x4){cvtpk(p0[8], p0[9]), cvtpk(p0[10], p0[11]), cvtpk(p0[12], p0[13]), cvtpk(p0[14], p0[15])};
            pf[2] = (u32x4){cvtpk(p1[0], p1[1]), cvtpk(p1[2], p1[3]), cvtpk(p1[4], p1[5]), cvtpk(p1[6], p1[7])};
            pf[3] = (u32x4){cvtpk(p1[8], p1[9]), cvtpk(p1[10], p1[11]), cvtpk(p1[12], p1[13]), cvtpk(p1[14], p1[15])};
#pragma unroll
            for (int s = 0; s < 4; ++s) {
                const bf16x8 v0 = *(LAS const bf16x8*)(sb + voff + (((2 * s + hi) ^ ksw) << 4));
                const bf16x8 v1 = *(LAS const bf16x8*)(sb + 4096 + voff + (((2 * s + hi) ^ ksw) << 4));
                const bf16x8 pb = __builtin_bit_cast(bf16x8, pf[s]);
                oacc[0] = __builtin_amdgcn_mfma_f32_32x32x16_bf16(v0, pb, oacc[0], 0, 0, 0);
                oacc[1] = __builtin_amdgcn_mfma_f32_32x32x16_bf16(v1, pb, oacc[1], 0, 0, 0);
            }
        }
        st = st == 2 ? 0 : st + 1;
    }
#undef MLA_ISSUE
    lsum += __shfl_xor(lsum, 32);
    const float inv = 1.0f / lsum;
    bf16_t* orow = o + qrow * D + h * 64 + 4 * hi;
#pragma unroll
    for (int db = 0; db < 2; ++db)
#pragma unroll
        for (int g = 0; g < 4; ++g)
            *(u32x2*)(orow + 32 * db + 8 * g) = (u32x2){cvtpk(oacc[db][4 * g] * inv, oacc[db][4 * g + 1] * inv), cvtpk(oacc[db][4 * g + 2] * inv, oacc[db][4 * g + 3] * inv)};
    asm volatile("s_waitcnt lgkmcnt(0)" ::: "memory");
    __builtin_amdgcn_s_barrier(); asm volatile("" ::: "memory");
}
__device__ __forceinline__ void mla_meta(int b, int h, const bf16_t* __restrict__ Q1, const bf16_t* __restrict__ K1, const bf16_t* __restrict__ kpe, const bf16_t* __restrict__ VT1, bf16_t* o, int lane) {
    const int qi = lane & 15, part = lane >> 4; const size_t qrow = (size_t)MREAL + b * 16 + qi;
    float q[24];
#pragma unroll
    for (int d = 0; d < 24; ++d) q[d] = bf2f(Q1[qrow * 1536 + h * 96 + 24 * part + d]);
    float sc[16]; float mx = -1e30f;
#pragma unroll
    for (int j = 0; j < 16; ++j) {
        const size_t kr = (size_t)b * LP + j; float s = 0.f;
#pragma unroll
        for (int d = 0; d < 24; ++d) { const int dd = 24 * part + d; const float kv = dd < 64 ? bf2f(K1[kr * D + h * 64 + dd]) : bf2f(kpe[kr * 32 + dd - 64]); s += q[d] * kv; }
        s += __shfl_xor(s, 16); s += __shfl_xor(s, 32);
        sc[j] = j <= qi ? s : -1e30f; mx = fmaxf(mx, sc[j]);
    }
    float l = 0.f;
#pragma unroll
    for (int j = 0; j < 16; ++j) { sc[j] = exp2f(sc[j] - mx); l += sc[j]; }
    const float inv = 1.0f / l;
#pragma unroll
    for (int dd = 0; dd < 16; ++dd) { const int d = 16 * part + dd; float acc = 0.f;
#pragma unroll
        for (int j = 0; j < 16; ++j) acc += sc[j] * bf2f(VT1[((size_t)(b * 16 + h) * 64 + d) * LP + perm16(j)]);
        o[qrow * D + h * 64 + d] = f2bf(acc * inv); }
}
__device__ __forceinline__ void mla_phase(LAS unsigned char* lds, const bf16_t* Q1, const bf16_t* K1, const bf16_t* kpe, const bf16_t* VT1, bf16_t* o, int bid, int nblk) {
    const int v = (nblk % 8 == 0) ? (bid % 8) * (nblk / 8) + bid / 8 : bid;
    for (int vv = v; vv < 256; vv += nblk) {
        const int bh = vv >> 3, s = vv & 7, b = bh >> 4, h = bh & 15;
#pragma unroll 1
        for (int i = 0; i < 4; ++i) { const int qi = (i == 0) ? s : (i == 1) ? 15 - s : (i == 2) ? 16 + s : 31 - s; mla_unit(lds, b, h, qi, Q1, K1, kpe, VT1, o); }
        if (s == 0 && threadIdx.x < 64) mla_meta(b, h, Q1, K1, kpe, VT1, o, threadIdx.x);
    }
}

constexpr int SW_K = 0, SW_V = 36864, SW_VP = 560;
__device__ __forceinline__ void swa_block32(LAS const unsigned char* lds, int rb, int gk0, int nks, int mode, int i_q, const bf16x8 (&qf)[4], float& m, float& lsum, f32x16 (&oacc)[2], int r32, int hi) {
    const float C2 = 1.4426950408889634f;
    const int ksw = (r32 >> 1) & 7;
    f32x16 p = (f32x16){};
#pragma unroll
    for (int s = 0; s < 4; ++s) { const bf16x8 k = *(LAS const bf16x8*)(lds + SW_K + (rb + r32) * 128 + (((2 * s + hi) ^ ksw) << 4)); p = __builtin_amdgcn_mfma_f32_32x32x16_bf16(k, qf[s], p, 0, 0, 0); }
    if (mode != 0) {
        const int jb = ((rb - 32) & 127) + 4 * hi;
#pragma unroll
        for (int r = 0; r < 16; ++r) { const int kk = (r & 3) + 8 * (r >> 2);
            const bool ok = mode == 1 ? (kk + 4 * hi < 16) : mode == 2 ? (jb + kk > i_q) : (jb + kk <= i_q);
            if (!ok) p[r] = -1e30f; }
    }
    float tm = p[0];
#pragma unroll
    for (int r = 1; r < 16; ++r) tm = fmaxf(tm, p[r]);
    tm = fmaxf(tm, __shfl_xor(tm, 32));
    const float mn = fmaxf(m, tm), alpha = __builtin_amdgcn_exp2f((m - mn) * C2), nmc = -mn * C2;
    m = mn;
    float ps = 0.f;
#pragma unroll
    for (int r = 0; r < 16; ++r) { p[r] = __builtin_amdgcn_exp2f(__builtin_fmaf(p[r], C2, nmc)); ps += p[r]; }
    lsum = lsum * alpha + ps;
#pragma unroll
    for (int r = 0; r < 16; ++r) { oacc[0][r] *= alpha; oacc[1][r] *= alpha; }
    u32x4 pf[2];
    pf[0] = (u32x4){cvtpk(p[0], p[1]), cvtpk(p[2], p[3]), cvtpk(p[4], p[5]), cvtpk(p[6], p[7])};
    pf[1] = (u32x4){cvtpk(p[8], p[9]), cvtpk(p[10], p[11]), cvtpk(p[12], p[13]), cvtpk(p[14], p[15])};
#pragma unroll
    for (int ks = 0; ks < 2; ++ks) if (ks < nks) {
        const bf16x8 v0 = *(LAS const bf16x8*)(lds + SW_V + r32 * SW_VP + (gk0 + ks) * 32 + hi * 16);
        const bf16x8 v1 = *(LAS const bf16x8*)(lds + SW_V + (32 + r32) * SW_VP + (gk0 + ks) * 32 + hi * 16);
        const bf16x8 pb = __builtin_bit_cast(bf16x8, pf[ks]);
        oacc[0] = __builtin_amdgcn_mfma_f32_32x32x16_bf16(v0, pb, oacc[0], 0, 0, 0);
        oacc[1] = __builtin_amdgcn_mfma_f32_32x32x16_bf16(v1, pb, oacc[1], 0, 0, 0);
    }
}
__device__ __forceinline__ void swa_unit(LAS unsigned char* lds, int b, int n, int kh, const bf16_t* __restrict__ qkv, const bf16_t* __restrict__ VT0, const float* __restrict__ sinks, bf16_t* o) {
    const int tid = threadIdx.x, lane = tid & 63, wave = __builtin_amdgcn_readfirstlane(tid >> 6), r32 = lane & 31, hi = lane >> 5;
    for (int idx = tid; idx < 2176; idx += NTHR) {
        const int row = idx >> 3, c = idx & 7;
        if (row < 16 || n > 0 || row >= 144) {
            const size_t srow = row < 16 ? (size_t)MREAL + b * 16 + row : (size_t)b * SEQ + 128 * (n - 1) + (row - 16);
            const int lrow = row < 16 ? row : 16 + row;
            const u32x4 v = *(const u32x4*)(qkv + srow * NQKV + 1024 + kh * 64 + c * 8);
            *(LAS u32x4*)(lds + SW_K + lrow * 128 + ((c ^ ((lrow >> 1) & 7)) << 4)) = v;
        }
    }
    for (int idx = tid; idx < 2176; idx += NTHR) {
        const int d = idx / 34, c = idx % 34;
        if (c < 2 || n > 0 || c >= 18) {
            const bf16_t* src = VT0 + (size_t)((b * 2 + kh) * 64 + d) * LP + (c < 2 ? c * 8 : 16 + 128 * (n - 1) + (c - 2) * 8);
            *(LAS u32x4*)(lds + SW_V + d * SW_VP + c * 16) = *(const u32x4*)src;
        }
    }
    __syncthreads();
    const int hq = kh * 8 + wave;
    const float sink = sinks[hq];
#pragma unroll 1
    for (int qs = 0; qs < 4; ++qs) {
        const size_t qrow = (size_t)b * SEQ + 128 * n + 32 * qs + r32;
        bf16x8 qf[4];
#pragma unroll
        for (int s = 0; s < 4; ++s) qf[s] = *(const bf16x8*)(qkv + qrow * NQKV + hq * 64 + 16 * s + 8 * hi);
        f32x16 oacc[2]; oacc[0] = (f32x16){}; oacc[1] = (f32x16){};
        float m = sink, lsum = hi == 0 ? 1.0f : 0.0f;
        const int i_q = 32 * qs + r32;
        swa_block32(lds, 0, 0, 1, 1, i_q, qf, m, lsum, oacc, r32, hi);
        if (n > 0) {
            swa_block32(lds, 32 + 32 * qs, 1 + 2 * qs, 2, 2, i_q, qf, m, lsum, oacc, r32, hi);
#pragma unroll 1
            for (int kb = qs + 1; kb < 4; ++kb) swa_block32(lds, 32 + 32 * kb, 1 + 2 * kb, 2, 0, i_q, qf, m, lsum, oacc, r32, hi);
        }
#pragma unroll 1
        for (int kb = 0; kb < qs; ++kb) swa_block32(lds, 160 + 32 * kb, 9 + 2 * kb, 2, 0, i_q, qf, m, lsum, oacc, r32, hi);
        swa_block32(lds, 160 + 32 * qs, 9 + 2 * qs, 2, 3, i_q, qf, m, lsum, oacc, r32, hi);
        lsum += __shfl_xor(lsum, 32);
        const float inv = 1.0f / lsum;
        bf16_t* orow = o + qrow * D + hq * 64 + 4 * hi;
#pragma unroll
        for (int db = 0; db < 2; ++db)
#pragma unroll
            for (int g = 0; g < 4; ++g)
                *(u32x2*)(orow + 32 * db + 8 * g) = (u32x2){cvtpk(oacc[db][4 * g] * inv, oacc[db][4 * g + 1] * inv), cvtpk(oacc[db][4 * g + 2] * inv, oacc[db][4 * g + 3] * inv)};
    }
    __syncthreads();
}
__device__ __forceinline__ void swa_meta(int b, int hq, const bf16_t* __restrict__ qkv, const bf16_t* __restrict__ VT0, const float* __restrict__ sinks, bf16_t* o, int lane) {
    const int qi = lane & 15, part = lane >> 4, kh = hq >> 3; const size_t qrow = (size_t)MREAL + b * 16 + qi;
    float q[16];
#pragma unroll
    for (int d = 0; d < 16; ++d) q[d] = bf2f(qkv[qrow * NQKV + hq * 64 + 16 * part + d]);
    const float sink = sinks[hq];
    float sc[16]; float mx = sink;
#pragma unroll
    for (int j = 0; j < 16; ++j) {
        const size_t kr = (size_t)MREAL + b * 16 + j; float s = 0.f;
#pragma unroll
        for (int d = 0; d < 16; ++d) s += q[d] * bf2f(qkv[kr * NQKV + 1024 + kh * 64 + 16 * part + d]);
        s += __shfl_xor(s, 16); s += __shfl_xor(s, 32);
        sc[j] = j <= qi ? s : -1e30f; mx = fmaxf(mx, sc[j]);
    }
    float l = __expf(sink - mx);
#pragma unroll
    for (int j = 0; j < 16; ++j) { sc[j] = __expf(sc[j] - mx); l += sc[j]; }
    const float inv = 1.0f / l;
#pragma unroll
    for (int dd = 0; dd < 16; ++dd) { const int d = 16 * part + dd; float acc = 0.f;
#pragma unroll
        for (int j = 0; j < 16; ++j) acc += sc[j] * bf2f(VT0[((size_t)(b * 2 + kh) * 64 + d) * LP + perm16(j)]);
        o[qrow * D + hq * 64 + d] = f2bf(acc * inv); }
}
__device__ __forceinline__ void swa_phase(LAS unsigned char* lds, const bf16_t* qkv, const bf16_t* VT0, const float* sinks, bf16_t* o, int bid, int nblk) {
    for (int u = bid; u < 256; u += nblk) {
        const int b = u >> 7, n = (u >> 1) & 63, kh = u & 1;
        swa_unit(lds, b, n, kh, qkv, VT0, sinks, o);
        if (n == 0) swa_meta(b, kh * 8 + (threadIdx.x >> 6), qkv, VT0, sinks, o, threadIdx.x & 63);
    }
}

template <int MOE_MT>
__device__ __forceinline__ void moe_unit(LAS unsigned char* lds, int e, int s0, int ns, const int* __restrict__ list, const bf16_t* __restrict__ hb, const float* __restrict__ rstd,
                                         const float* __restrict__ wslot, const bf16_t* __restrict__ wgu, const bf16_t* __restrict__ wd, bf16_t* ybuf, unsigned long long* tsb = nullptr) {
#define MSTAMP(i) do { if (PROBE_PHASE >= 600 && tsb && blockIdx.x == 0 && threadIdx.x == 0) tsb[i] = __builtin_amdgcn_s_memrealtime(); } while (0)
    MSTAMP(20);
    constexpr int MOE_BM = 16 * MOE_MT, MOE_HT = MOE_BM * 128, MOE_B2 = 2 * MOE_HT, MOE_ST2 = 32768, MOE_HLO = MOE_B2 + 2 * MOE_ST2, MOE_INFO = MOE_HLO + 2 * MOE_HT;
    static_assert(MOE_B2 + 2 * MOE_ST2 <= MOE_HLO && MOE_INFO + 3072 <= LDS_MISC, "moe lds");
#define moe_hoff(kt2) ((kt2) < 2 ? MOE_HLO + (kt2) * MOE_HT : ((kt2) - 2) * MOE_HT)
    const int tid = threadIdx.x, lane = tid & 63, wave = __builtin_amdgcn_readfirstlane(tid >> 6);
    LAS int* slotl = (LAS int*)(lds + MOE_INFO); LAS float* rsl = (LAS float*)(lds + MOE_INFO + 1024); LAS float* wl = (LAS float*)(lds + MOE_INFO + 2048);
    if (tid < MOE_BM) { const int sl = list[(size_t)e * CAP + s0 + (tid < ns ? tid : 0)]; slotl[tid] = sl; rsl[tid] = rstd[sl >> 1]; wl[tid] = wslot[sl]; }
    __syncthreads();
    const int lc = (lane & 7) ^ (lane >> 3);
    const int fro = (lane & 15) * 128, fc0 = ((lane >> 4) ^ (lane & 7)) << 4, fc1 = ((4 + (lane >> 4)) ^ (lane & 7)) << 4;
    {
        constexpr int ST = (MOE_BM + 512) * 64, GA = MOE_BM / 16, G = GA + 32, NG = (G + 7) / 8;
        static_assert(2 * ST <= MOE_HLO && 2 * MOE_HT <= ST, "moe gemm1 lds");
        const int lc4 = (lane & 3) ^ swzF(lane >> 4);
        const int fro32 = (lane & 15) * 64 + (((lane >> 4) ^ swzF((lane >> 2) & 3)) << 4);
        const char* src[NG];
#pragma unroll
        for (int i = 0; i < NG; ++i) { const int g = wave + 8 * i;
            if (g < GA) src[i] = (const char*)(hb + (size_t)(slotl[g * 16 + (lane >> 2)] >> 1) * D) + lc4 * 16;
            else if (g < G) src[i] = (const char*)(wgu + (size_t)((g - GA) * 16 + (lane >> 2)) * D) + lc4 * 16;
            else src[i] = nullptr; }
        f32x4 acc[MOE_MT][4];
#pragma unroll
        for (int mi = 0; mi < MOE_MT; ++mi)
#pragma unroll
            for (int ni = 0; ni < 4; ++ni) acc[mi][ni] = (f32x4){0.f, 0.f, 0.f, 0.f};
#define M1_STAGE(st, step) do { _Pragma("unroll") for (int _i = 0; _i < NG; ++_i) { const int _g = wave + 8 * _i; if (_g < G) \
        __builtin_amdgcn_global_load_lds((const unsigned*)(src[_i] + (size_t)(step) * 64), (LAS unsigned*)(lds + (st) * ST + _g * 1024), 16, 0, 0); } } while (0)
        M1_STAGE(0, 0);
        for (int step = 0; step < 32; ++step) {
            asm volatile("s_waitcnt vmcnt(0)" ::: "memory");
            __syncthreads();
            if (step + 1 < 32) M1_STAGE((step + 1) & 1, step + 1);
            LAS const unsigned char* sa = lds + (step & 1) * ST + fro32;
            LAS const unsigned char* sb = lds + (step & 1) * ST + (MOE_BM + wave * 64) * 64 + fro32;
            bf16x8 bfr[4];
#pragma unroll
            for (int ni = 0; ni < 4; ++ni) bfr[ni] = *(LAS const bf16x8*)(sb + ni * 1024);
#pragma unroll
            for (int mi = 0; mi < MOE_MT; ++mi) { const bf16x8 af = *(LAS const bf16x8*)(sa + mi * 1024);
#pragma unroll
                for (int ni = 0; ni < 4; ++ni) acc[mi][ni] = __builtin_amdgcn_mfma_f32_16x16x32_bf16(bfr[ni], af, acc[mi][ni], 0, 0, 0); }
        }
#undef M1_STAGE
        int lane_h = threadIdx.x & 63; asm volatile("" : "+v"(lane_h));
#define lane lane_h
#pragma unroll
        for (int p = 0; p < 2; ++p) {
            const int n = 32 * wave + 16 * p + (lane >> 4) * 4;
            const int csw = ((n & 63) >> 3);
#pragma unroll
            for (int mi = 0; mi < MOE_MT; ++mi) { const int row = mi * 16 + (lane & 15); const float rs = rsl[row]; float hv[4];
#pragma unroll
                for (int r = 0; r < 4; ++r) { const float g = acc[mi][2 * p][r] * rs, u = acc[mi][2 * p + 1][r] * rs; hv[r] = g / (1.0f + __expf(-g)) * u; }
                *(LAS u32x2*)(lds + moe_hoff(n >> 6) + row * 128 + ((csw ^ (row & 7)) << 4) + (n & 4) * 2) = (u32x2){pk2(hv[0], hv[1]), pk2(hv[2], hv[3])}; }
        }
#undef lane
    }
    __syncthreads();
    MSTAMP(21);
    {
        const char* src2[4];
#pragma unroll
        for (int i = 0; i < 4; ++i) src2[i] = (const char*)(wd + (size_t)((wave + 8 * i) * 8 + (lane >> 3)) * DE) + lc * 16;
        f32x4 acc[MOE_MT][2];
#pragma unroll
        for (int mi = 0; mi < MOE_MT; ++mi) { acc[mi][0] = (f32x4){0.f, 0.f, 0.f, 0.f}; acc[mi][1] = (f32x4){0.f, 0.f, 0.f, 0.f}; }
#define M2_STAGE(st, q) do { _Pragma("unroll") for (int _i = 0; _i < 4; ++_i) \
        __builtin_amdgcn_global_load_lds((const unsigned*)(src2[_i] + (size_t)((q) >> 2) * (256 * 512) + (size_t)((q) & 3) * 128), (LAS unsigned*)(lds + MOE_B2 + (st) * MOE_ST2 + (wave + 8 * _i) * 1024), 16, 0, 0); } while (0)
        M2_STAGE(0, 0);
        for (int q = 0; q < 16; ++q) {
            asm volatile("s_waitcnt vmcnt(0)" ::: "memory");
            __syncthreads();
            if (q + 1 < 16) M2_STAGE((q + 1) & 1, q + 1);
            LAS const unsigned char* sa = lds + moe_hoff(q & 3) + fro;
            LAS const unsigned char* sb = lds + MOE_B2 + (q & 1) * MOE_ST2 + (wave * 32) * 128 + fro;
#pragma unroll
            for (int ks = 0; ks < 2; ++ks) { const int fc = ks ? fc1 : fc0;
                const bf16x8 b0 = *(LAS const bf16x8*)(sb + fc), b1 = *(LAS const bf16x8*)(sb + 2048 + fc);
#pragma unroll
                for (int mi = 0; mi < MOE_MT; ++mi) { const bf16x8 af = *(LAS const bf16x8*)(sa + mi * 2048 + fc);
                    acc[mi][0] = __builtin_amdgcn_mfma_f32_16x16x32_bf16(b0, af, acc[mi][0], 0, 0, 0);
                    acc[mi][1] = __builtin_amdgcn_mfma_f32_16x16x32_bf16(b1, af, acc[mi][1], 0, 0, 0); }
            }
            if ((q & 3) == 3) {
                const int cb = (q >> 2) * 256 + wave * 32 + (lane >> 4) * 4;
#pragma unroll
                for (int mi = 0; mi < MOE_MT; ++mi) { const int row = mi * 16 + (lane & 15);
                    if (row < ns) { const float w = wl[row]; bf16_t* yr = ybuf + (size_t)slotl[row] * D + cb;
#pragma unroll
                        for (int ni = 0; ni < 2; ++ni) { const f32x4 v = acc[mi][ni] * w; *(u32x2*)(yr + ni * 16) = (u32x2){pk2(v[0], v[1]), pk2(v[2], v[3])}; } }
                    acc[mi][0] = (f32x4){0.f, 0.f, 0.f, 0.f}; acc[mi][1] = (f32x4){0.f, 0.f, 0.f, 0.f}; }
            }
        }
#undef M2_STAGE
    }
#undef moe_hoff
    __syncthreads();
    MSTAMP(22);
#undef MSTAMP
}
__device__ __forceinline__ void moe_phase(LAS unsigned char* lds, int* cnt, const int* list, const bf16_t* hb, const float* rstd, const float* wslot, const bf16_t* wgu, const bf16_t* wd, bf16_t* ybuf, int bid, int nblk, unsigned long long* tsb = nullptr) {
    const bool grp = (nblk % 8) == 0;
    int ntile[NE]; int gsum = 0; bool fit = grp;
#pragma unroll
    for (int e = 0; e < NE; ++e) { const int c = __hip_atomic_load(cnt + e * 64, __ATOMIC_RELAXED, __HIP_MEMORY_SCOPE_AGENT); const int bm = 144; ntile[e] = (c + bm - 1) / bm;
        gsum = (e & 3) == 0 ? ntile[e] : gsum + ntile[e]; if ((e & 3) == 3 && gsum > nblk / 8) fit = false; }
    const int x = bid % 8;
    int u = fit ? bid / 8 : (grp ? x * (nblk / 8) + bid / 8 : bid), base = 0;
    const int stride = fit ? nblk / 8 : nblk;
#pragma unroll 1
    for (int e = 0; e < NE; ++e) {
        if (fit && (e >> 2) != x) continue;
        const int c = __hip_atomic_load(cnt + e * 64, __ATOMIC_RELAXED, __HIP_MEMORY_SCOPE_AGENT);
        const bool big = false; const int bm = 144, nt = (c + bm - 1) / bm;
        while (u < base + nt) { const int t = u - base; const int ns = c - t * bm < bm ? c - t * bm : bm;
            moe_unit<9>(lds, e, t * bm, ns, list, hb, rstd, wslot, wgu + (size_t)e * 512 * 1024, wd + (size_t)e * 1024 * 256, ybuf, tsb);
            u += stride; }
        base += nt;
    }
}

template <int MT>
__device__ __forceinline__ void l1proj_unit(LAS unsigned char* lds, int row0, int mrow0, bf16_t* hb, const bf16_t* __restrict__ ybuf, const bf16_t* __restrict__ win_t, const bf16_t* __restrict__ wuq_t,
                                            const bf16_t* __restrict__ wukv_t, const float2* __restrict__ cs, bf16_t* kpe, bf16_t* Q1, bf16_t* K1, bf16_t* VT1) {
    constexpr int BM = 16 * MT, STW = (BM + 512) * 64, KT = BM * 64  , CQN = 0, CKV = 8 * KT, RB = 12 * KT, STB = 32768, PART = 3 * STW;
    static_assert(RB + 3 * STB <= LDS_MISC && PART + 8 * BM * 4 <= LDS_MISC, "l1proj lds");
    const int tid = threadIdx.x, lane = tid & 63, wave = __builtin_amdgcn_readfirstlane(tid >> 6);
    LAS float* rsl = (LAS float*)(lds + LDS_MISC + 256);
#define L1_GROW(r) ((r) < 64 ? row0 + (r) : mrow0 + (r) - 64)
    for (int r = wave; r < BM; r += NWAVE) {
        const size_t grow = L1_GROW(r); float ss = 0.f;
#pragma unroll
        for (int j = 0; j < 4; ++j) { const size_t c = j * 256 + lane * 4;
            const u32x2 h = *(const u32x2*)(hb + grow * D + c), y0 = *(const u32x2*)(ybuf + (grow * 2) * D + c), y1 = *(const u32x2*)(ybuf + (grow * 2 + 1) * D + c);
            float v[4];
            v[0] = __uint_as_float(h.x << 16) + __uint_as_float(y0.x << 16) + __uint_as_float(y1.x << 16);
            v[1] = __uint_as_float(h.x & 0xffff0000u) + __uint_as_float(y0.x & 0xffff0000u) + __uint_as_float(y1.x & 0xffff0000u);
            v[2] = __uint_as_float(h.y << 16) + __uint_as_float(y0.y << 16) + __uint_as_float(y1.y << 16);
            v[3] = __uint_as_float(h.y & 0xffff0000u) + __uint_as_float(y0.y & 0xffff0000u) + __uint_as_float(y1.y & 0xffff0000u);
            ss += v[0] * v[0] + v[1] * v[1] + v[2] * v[2] + v[3] * v[3];
            *(u32x2*)(hb + grow * D + c) = (u32x2){pk2(v[0], v[1]), pk2(v[2], v[3])}; }
        ss = wave_sum(ss); if (lane == 0) rsl[r] = rsqrtf(ss * (1.0f / D) + EPS);
    }
    asm volatile("s_waitcnt vmcnt(0)" ::: "memory");
    __syncthreads();
    const int lc = (lane & 3) ^ swzF(lane >> 4);
    const int fro = (lane & 15) * 64 + (((lane >> 4) ^ swzF((lane >> 2) & 3)) << 4);
    f32x4 acc[MT][4];
#pragma unroll
    for (int mi = 0; mi < MT; ++mi)
#pragma unroll
        for (int ni = 0; ni < 4; ++ni) acc[mi][ni] = (f32x4){0.f, 0.f, 0.f, 0.f};
    {
        const char* srcb[4];
#pragma unroll
        for (int i = 0; i < 4; ++i) srcb[i] = (const char*)(win_t + (size_t)((wave + 8 * i) * 16 + (lane >> 2)) * D) + lc * 16;
        const char* srca = (const char*)(hb + (size_t)L1_GROW((wave < MT ? wave : 0) * 16 + (lane >> 2)) * D) + lc * 16;
#define W_ISSUE(st, kt) do { if (wave < MT) __builtin_amdgcn_global_load_lds((const unsigned*)(srca + (size_t)(kt) * 64), (LAS unsigned*)(lds + (st) * STW + wave * 1024), 16, 0, 16); \
        _Pragma("unroll") for (int _i = 0; _i < 4; ++_i) __builtin_amdgcn_global_load_lds((const unsigned*)(srcb[_i] + (size_t)(kt) * 64), (LAS unsigned*)(lds + (st) * STW + (MT + wave + 8 * _i) * 1024), 16, 0, 0); } while (0)
        W_ISSUE(0, 0); W_ISSUE(1, 1);
        int st = 0;
        for (int kt = 0; kt < 32; ++kt) {
            if (kt + 1 < 32) { if (wave < MT) wait_vm<5>(); else wait_vm<4>(); } else wait_vm<0>();
            __builtin_amdgcn_s_barrier(); asm volatile("" ::: "memory");
            if (kt + 2 < 32) W_ISSUE(st == 0 ? 2 : st - 1, kt + 2);
            LAS const unsigned char* sa = lds + st * STW + fro;
            LAS const unsigned char* sb = lds + st * STW + (BM + wave * 64) * 64 + fro;
            bf16x8 bfr[4];
#pragma unroll
            for (int ni = 0; ni < 4; ++ni) bfr[ni] = *(LAS const bf16x8*)(sb + ni * 1024);
#pragma unroll
            for (int mi = 0; mi < MT; ++mi) { const bf16x8 af = *(LAS const bf16x8*)(sa + mi * 1024);
#pragma unroll
                for (int ni = 0; ni < 4; ++ni) acc[mi][ni] = __builtin_amdgcn_mfma_f32_16x16x32_bf16(bfr[ni], af, acc[mi][ni], 0, 0, 0); }
            st = st == 2 ? 0 : st + 1;
        }
#undef W_ISSUE
    }
    asm volatile("s_waitcnt lgkmcnt(0)" ::: "memory");
    __syncthreads();
    LAS float* part = (LAS float*)(lds + PART);
    int lane_e = lane; asm volatile("" : "+v"(lane_e));
#define lane lane_e
#pragma unroll
    for (int mi = 0; mi < MT; ++mi) { const float rs = rsl[mi * 16 + (lane & 15)]; float ss = 0.f;
#pragma unroll
        for (int ni = 0; ni < 4; ++ni) { acc[mi][ni] = acc[mi][ni] * rs; ss += acc[mi][ni][0] * acc[mi][ni][0] + acc[mi][ni][1] * acc[mi][ni][1] + acc[mi][ni][2] * acc[mi][ni][2] + acc[mi][ni][3] * acc[mi][ni][3]; }
        ss += __shfl_xor(ss, 16); ss += __shfl_xor(ss, 32);
        if (lane < 16) part[wave * BM + mi * 16 + lane] = ss; }
    __syncthreads();
    if (wave < 6) {
#pragma unroll
        for (int mi = 0; mi < MT; ++mi) { const int row = mi * 16 + (lane & 15);
            const float tot = wave < 4 ? (part[row] + part[BM + row]) + (part[2 * BM + row] + part[3 * BM + row]) : part[4 * BM + row] + part[5 * BM + row];
            const float rn = rsqrtf(tot * (wave < 4 ? 1.0f / 256 : 1.0f / 128) + EPS);
#pragma unroll
            for (int ni = 0; ni < 4; ++ni) { const int cc = (wave < 4 ? 64 * wave : 64 * (wave - 4)) + ni * 16 + (lane >> 4) * 4; const f32x4 v = acc[mi][ni] * rn;
                *(LAS u32x2*)(lds + (wave < 4 ? CQN : CKV) + (cc >> 5) * KT + row * 64 + (((((cc & 31) >> 3)) ^ swzF((row >> 2) & 3)) << 4) + (cc & 4) * 2) = (u32x2){pk2(v[0], v[1]), pk2(v[2], v[3])}; } }
    } else if (wave == 6) {
#pragma unroll
        for (int mi = 0; mi < MT; ++mi) { const int row = mi * 16 + (lane & 15); const int grow = L1_GROW(row); const int pos = row_pos(grow), d0 = (lane >> 4) * 4;
            f32x4 o1, o2;
#pragma unroll
            for (int r = 0; r < 4; ++r) { const float2 t = cs[pos * 32 + 2 * (d0 + r)]; const float x1 = acc[mi][0][r], x2 = acc[mi][1][r]; o1[r] = x1 * t.x - x2 * t.y; o2[r] = x2 * t.x + x1 * t.y; }
            bf16_t* kr = kpe + ((size_t)row_batch(grow) * LP + pos) * 32;
            *(u32x2*)(kr + d0) = (u32x2){pk2(o1[0], o1[1]), pk2(o1[2], o1[3])}; *(u32x2*)(kr + 16 + d0) = (u32x2){pk2(o2[0], o2[1]), pk2(o2[2], o2[3])}; }
    }
#undef lane
    __syncthreads();
    const char* srcu[4];
#define U_ISSUE(st, base, pitchB, chunk, kt) do { _Pragma("unroll") for (int _i = 0; _i < 4; ++_i) \
        __builtin_amdgcn_global_load_lds((const unsigned*)(srcu[_i] + (size_t)(chunk) * 512 * (pitchB) + (size_t)(kt) * 64), (LAS unsigned*)(lds + RB + (st) * STB + (wave + 8 * _i) * 1024), 16, 0, 0); } while (0)
    {
#pragma unroll
        for (int i = 0; i < 4; ++i) srcu[i] = (const char*)(wuq_t + (size_t)((wave + 8 * i) * 16 + (lane >> 2)) * 256) + lc * 16;
#pragma unroll
        for (int mi = 0; mi < MT; ++mi)
#pragma unroll
            for (int ni = 0; ni < 4; ++ni) acc[mi][ni] = (f32x4){0.f, 0.f, 0.f, 0.f};
        U_ISSUE(0, 0, 512, 0, 0); U_ISSUE(1, 0, 512, 0, 1);
        int st = 0;
        for (int q = 0; q < 24; ++q) {
            if (q + 1 < 24) wait_vm<4>(); else wait_vm<0>();
            __builtin_amdgcn_s_barrier(); asm volatile("" ::: "memory");
            if (q + 2 < 24) U_ISSUE(st == 0 ? 2 : st - 1, 0, 512, (q + 2) >> 3, (q + 2) & 7);
            LAS const unsigned char* sa = lds + CQN + (q & 7) * KT + fro;
            LAS const unsigned char* sb = lds + RB + st * STB + (wave * 64) * 64 + fro;
            bf16x8 bfr[4];
#pragma unroll
            for (int ni = 0; ni < 4; ++ni) bfr[ni] = *(LAS const bf16x8*)(sb + ni * 1024);
#pragma unroll
            for (int mi = 0; mi < MT; ++mi) { const bf16x8 af = *(LAS const bf16x8*)(sa + mi * 1024);
#pragma unroll
                for (int ni = 0; ni < 4; ++ni) acc[mi][ni] = __builtin_amdgcn_mfma_f32_16x16x32_bf16(bfr[ni], af, acc[mi][ni], 0, 0, 0); }
            if ((q & 7) == 7) {
                int lane_q = lane; asm volatile("" : "+v"(lane_q));
#define lane lane_q
                const float scale = 0.10206207261596577f * 1.4426950408889634f; const int d0 = (lane >> 4) * 4;
#pragma unroll
                for (int mi = 0; mi < MT; ++mi) { const int grow = L1_GROW(mi * 16 + (lane & 15)); const int pos = row_pos(grow);
#pragma unroll
                    for (int bi = 0; bi < 2; ++bi) { const int gc = (q >> 3) * 512 + 64 * wave + bi * 32; bf16_t* orow = Q1 + (size_t)grow * 1536 + gc;
                        f32x4 v1 = acc[mi][2 * bi], v2 = acc[mi][2 * bi + 1];
                        if (((gc >> 5) % 3) == 2) {
#pragma unroll
                            for (int r = 0; r < 4; ++r) { const float2 t = cs[pos * 32 + 2 * (d0 + r)]; const float x1 = v1[r], x2 = v2[r]; v1[r] = x1 * t.x - x2 * t.y; v2[r] = x2 * t.x + x1 * t.y; } }
                        v1 = v1 * scale; v2 = v2 * scale;
                        *(u32x2*)(orow + d0) = (u32x2){pk2(v1[0], v1[1]), pk2(v1[2], v1[3])}; *(u32x2*)(orow + 16 + d0) = (u32x2){pk2(v2[0], v2[1]), pk2(v2[2], v2[3])}; }
#pragma unroll
                    for (int ni = 0; ni < 4; ++ni) acc[mi][ni] = (f32x4){0.f, 0.f, 0.f, 0.f}; }
#undef lane
            }
            st = st == 2 ? 0 : st + 1;
        }
    }
    asm volatile("s_waitcnt lgkmcnt(0)" ::: "memory");
    __syncthreads();
    {
#pragma unroll
        for (int i = 0; i < 4; ++i) srcu[i] = (const char*)(wukv_t + (size_t)((wave + 8 * i) * 16 + (lane >> 2)) * 128) + lc * 16;
#pragma unroll
        for (int mi = 0; mi < MT; ++mi)
#pragma unroll
            for (int ni = 0; ni < 4; ++ni) acc[mi][ni] = (f32x4){0.f, 0.f, 0.f, 0.f};
        U_ISSUE(0, 0, 256, 0, 0); U_ISSUE(1, 0, 256, 0, 1);
        int st = 0;
        for (int q = 0; q < 16; ++q) {
            if (q + 1 < 16) wait_vm<4>(); else wait_vm<0>();
            __builtin_amdgcn_s_barrier(); asm volatile("" ::: "memory");
            if (q + 2 < 16) U_ISSUE(st == 0 ? 2 : st - 1, 0, 256, (q + 2) >> 2, (q + 2) & 3);
            LAS const unsigned char* sa = lds + CKV + (q & 3) * KT + fro;
            LAS const unsigned char* sb = lds + RB + st * STB + (wave * 64) * 64 + fro;
            bf16x8 bfr[4];
#pragma unroll
            for (int ni = 0; ni < 4; ++ni) bfr[ni] = *(LAS const bf16x8*)(sb + ni * 1024);
            if (q < 8) {
#pragma unroll
                for (int mi = 0; mi < MT; ++mi) { const bf16x8 af = *(LAS const bf16x8*)(sa + mi * 1024);
#pragma unroll
                    for (int ni = 0; ni < 4; ++ni) acc[mi][ni] = __builtin_amdgcn_mfma_f32_16x16x32_bf16(bfr[ni], af, acc[mi][ni], 0, 0, 0); }
            } else {
#pragma unroll
                for (int mi = 0; mi < MT; ++mi) { const bf16x8 af = *(LAS const bf16x8*)(sa + mi * 1024);
#pragma unroll
                    for (int ni = 0; ni < 4; ++ni) acc[mi][ni] = __builtin_amdgcn_mfma_f32_16x16x32_bf16(af, bfr[ni], acc[mi][ni], 0, 0, 0); }
            }
            if ((q & 3) == 3) {
                const int ch = q >> 2;
                int lane_k = lane; asm volatile("" : "+v"(lane_k));
#define lane lane_k
                if (ch < 2) {
#pragma unroll
                    for (int mi = 0; mi < MT; ++mi) { const int grow = L1_GROW(mi * 16 + (lane & 15)); const size_t kr = (size_t)row_batch(grow) * LP + row_pos(grow);
#pragma unroll
                        for (int ni = 0; ni < 4; ++ni) { const f32x4 v = acc[mi][ni];
                            *(u32x2*)(K1 + kr * D + 512 * ch + 64 * wave + ni * 16 + (lane >> 4) * 4) = (u32x2){pk2(v[0], v[1]), pk2(v[2], v[3])}; acc[mi][ni] = (f32x4){0.f, 0.f, 0.f, 0.f}; } }
                } else {
#pragma unroll
                    for (int mi = 0; mi < MT; ++mi) { const int grow0 = L1_GROW(mi * 16 + (lane >> 4) * 4); const int b = row_batch(grow0), pp = perm16(row_pos(grow0));
#pragma unroll
                        for (int ni = 0; ni < 4; ++ni) { const int hd = 512 * (ch - 2) + 64 * wave + ni * 16 + (lane & 15); const f32x4 v = acc[mi][ni];
                            *(u32x2*)(VT1 + (size_t)(b * 1024 + hd) * LP + pp) = (u32x2){pk2(v[0], v[1]), pk2(v[2], v[3])}; acc[mi][ni] = (f32x4){0.f, 0.f, 0.f, 0.f}; } }
                }
#undef lane
            }
            st = st == 2 ? 0 : st + 1;
        }
    }
#undef U_ISSUE
#undef L1_GROW
    asm volatile("s_waitcnt lgkmcnt(0)" ::: "memory");
    __syncthreads();
}
__device__ __forceinline__ void l1proj_phase(LAS unsigned char* lds, bf16_t* hb, const bf16_t* ybuf, const bf16_t* win_t, const bf16_t* wuq_t, const bf16_t* wukv_t, const float2* cs, bf16_t* kpe,
                                             bf16_t* Q1, bf16_t* K1, bf16_t* VT1, int bid, int nblk) {
    { const int gt = bid * NTHR + threadIdx.x, ngt = nblk * NTHR;
      for (int idx = gt; idx < 2 * 48 * 1024; idx += ngt) { const int b = idx / (48 * 1024), r = idx % (48 * 1024); K1[((size_t)b * LP + 8208) * 1024 + r] = 0; }
      for (int idx = gt; idx < 2 * 16 * 64 * 48; idx += ngt) { const int rr = idx / 48, c = idx % 48; VT1[(size_t)rr * LP + 8208 + c] = 0; } }
    for (int u = bid; u < 256; u += nblk) {
        if (u >= 254) l1proj_unit<5>(lds, u * 64, MREAL + (u - 254) * 16, hb, ybuf, win_t, wuq_t, wukv_t, cs, kpe, Q1, K1, VT1);
        else l1proj_unit<4>(lds, u * 64, MREAL, hb, ybuf, win_t, wuq_t, wukv_t, cs, kpe, Q1, K1, VT1);
    }
}

struct EpiNull { int m0, n0;
    template <int MT, int NT> __device__ __forceinline__ void operator()(f32x4 (&acc)[MT][NT], int, int, int) const {
#pragma unroll
        for (int mi = 0; mi < MT; ++mi)
#pragma unroll
            for (int ni = 0; ni < NT; ++ni) asm volatile("" :: "v"(acc[mi][ni])); } };
__device__ __forceinline__ void transpose_item(const float* __restrict__ W, int N, const float* __restrict__ gain, bf16_t* dst, int ldk, int drow0, int k0, int n0, LAS float* scr, int lane, int dskip = 0) {
#pragma unroll 8
    for (int i = 0; i < 32; ++i) { const int kk = 2 * i + (lane >> 5); float v = W[(size_t)(k0 + kk) * N + n0 + (lane & 31)]; if (gain) v *= gain[k0 + kk]; scr[kk * 33 + (lane & 31)] = v; }
    asm volatile("s_waitcnt lgkmcnt(0)" ::: "memory");
    const int c = lane & 7;
#pragma unroll
    for (int j = 0; j < 4; ++j) { const int n = (lane >> 3) + 8 * j; const LAS float* s = scr + (8 * c) * 33 + n;
        u32x4 o; o.x = pk2(s[0 * 33], s[1 * 33]); o.y = pk2(s[2 * 33], s[3 * 33]); o.z = pk2(s[4 * 33], s[5 * 33]); o.w = pk2(s[6 * 33], s[7 * 33]);
        *(u32x4*)(dst + (size_t)(drow0 + n + (n >= 16 ? dskip : 0)) * ldk + k0 + 8 * c) = o; }
    asm volatile("s_waitcnt lgkmcnt(0)" ::: "memory");
}
__device__ __forceinline__ void moe_convert_item(const float* __restrict__ src, int pitch  , const float* __restrict__ gain  , bf16_t* dst, int ldk, int kind  , int nrow0, LAS float* T) {
    const int tid = threadIdx.x;
#pragma unroll
    for (int i = 0; i < 8; ++i) { const int idx = tid + i * NTHR, k = idx >> 6, c4 = idx & 63;
        f32x4 v = *(const f32x4*)(src + (size_t)k * pitch + c4 * 4); if (gain) v = v * gain[k];
        LAS float* t = T + k * 257 + c4 * 4; t[0] = v[0]; t[1] = v[1]; t[2] = v[2]; t[3] = v[3]; }
    __syncthreads();
#pragma unroll
    for (int i = 0; i < 4; ++i) { const int idx = tid + i * NTHR, kc = idx & 7, n = idx >> 3;
        const LAS float* t = T + (8 * kc) * 257 + n;
        u32x4 o; o.x = pk2(t[0], t[257]); o.y = pk2(t[2 * 257], t[3 * 257]); o.z = pk2(t[4 * 257], t[5 * 257]); o.w = pk2(t[6 * 257], t[7 * 257]);
        const int row = kind == 2 ? nrow0 + n : (n >> 4) * 32 + kind * 16 + (n & 15);
        *(u32x4*)(dst + (size_t)row * ldk + 8 * kc) = o; }
    __syncthreads();
}
__device__ __forceinline__ void moe_weight_items(const float* wgate, const float* wup, const float* wdown, const float* gain, bf16_t* wgu_t, bf16_t* wd_t, LAS float* T, int bid, int nblk) {
    for (int it = bid; it < NE * 48; it += nblk) {
        const int e = it / 48, r = it % 48, which = r >> 4, q = r & 15;
        if (which < 2) moe_convert_item((which ? wup : wgate) + (size_t)e * D * DE + (size_t)q * 64 * DE, DE, gain + q * 64, wgu_t + (size_t)e * 512 * 1024 + q * 64, 1024, which, 0, T);
        else { const int kb = q >> 2, nb = q & 3;
            moe_convert_item(wdown + (size_t)e * DE * D + (size_t)kb * 64 * D + nb * 256, D, nullptr, wd_t + (size_t)e * 1024 * 256 + kb * 64, 256, 2, nb * 256, T); }
    }
}
__device__ __forceinline__ void p0_prologue(const MArgs& a, LAS unsigned char* lds, int bid, int nblk) {
    const int tid = threadIdx.x, lane = tid & 63, wave = __builtin_amdgcn_readfirstlane(tid >> 6);
    const int gw = bid * NWAVE + wave, ngw = nblk * NWAVE, gt = bid * NTHR + tid, ngt = nblk * NTHR;
    unsigned char* ws = a.ws;
    float2* cs = (float2*)(ws + WS_ROPE);
    for (int _r = 0; _r < (PROBE_PHASE == 301 ? 2 : 1); ++_r)
    for (int idx = gt; idx < LPOS * 32; idx += ngt) { const int pos = idx >> 5, i = idx & 31; const float inv = 1.0f / powf(10000.0f, (float)(2 * i) / 64.0f); float s, c; sincosf((float)pos * inv, &s, &c); cs[idx] = make_float2(c, s); }
    float* wrf = (float*)(ws + W2_WRF);
    for (int idx = gt; idx < 2 * 36 * 1024; idx += ngt) { const int l = idx / (36 * 1024), j = (idx >> 10) % 36, k = idx & 1023;
        const float g = a.in[3][l * D + k]; wrf[idx] = g * (j < 4 ? a.in[16][(size_t)l * D * 4 + k * 4 + j] : a.in[18][(size_t)l * D * 32 + k * 32 + (j - 4)]); }
    { u32x4* z = (u32x4*)(ws + W2_WIN + (size_t)416 * 1024 * 2); for (int idx = gt; idx < 96 * 1024 * 2 / 16; idx += ngt) z[idx] = (u32x4){0u, 0u, 0u, 0u}; }
    { bf16_t* kpe = (bf16_t*)(ws + WS_KPE); for (int idx = gt; idx < 2 * 48 * 32; idx += ngt) { const int b = idx / (48 * 32), r = idx % (48 * 32); kpe[((size_t)b * LP + 8208) * 32 + r] = 0; }
      bf16_t* vt0 = (bf16_t*)(ws + B_VT0); for (int idx = gt; idx < 2 * 2 * 64 * 48; idx += ngt) { const int rr = idx / 48, c = idx % 48; vt0[(size_t)rr * LP + 8208 + c] = 0; } }
    { bf16_t* hb = (bf16_t*)(ws + W2_HB); float* rstd = (float*)(ws + W2_RSTD);
      for (int _r = 0; _r < (PROBE_PHASE == 303 ? 2 : 1); ++_r)
      for (int row = gw; row < MTOT; row += ngw) {
        const float* src = row < MREAL ? a.in[0] + (size_t)row * D : a.in[1] + (size_t)row_pos(row) * D;
        float ss = 0.f;
#pragma unroll
        for (int j = 0; j < 4; ++j) { const f32x4 v = *(const f32x4*)(src + j * 256 + lane * 4); ss += v[0] * v[0] + v[1] * v[1] + v[2] * v[2] + v[3] * v[3];
            *(u32x2*)(hb + (size_t)row * D + j * 256 + lane * 4) = (u32x2){pk2(v[0], v[1]), pk2(v[2], v[3])}; }
        ss = wave_sum(ss); if (lane == 0) rstd[row] = rsqrtf(ss * (1.0f / D) + EPS);
      } }
    LAS float* scr = (LAS float*)(lds + wave * 16384);
    for (int _r = 0; _r < (PROBE_PHASE == 304 ? 2 : 1); ++_r)
    for (int it = gw; it < 2192; it += ngw) {
        int r = it;
        if (r < 640) { transpose_item(a.in[5], NQKV, a.in[2], (bf16_t*)(ws + W2_WQKV), 1024, (r % 40) * 32, (r / 40) * 64, (r % 40) * 32, scr, lane); continue; } r -= 640;
        if (r < 512) { transpose_item(a.in[8], D, nullptr, (bf16_t*)(ws + W2_WO0), 1024, (r & 31) * 32, (r >> 5) * 64, (r & 31) * 32, scr, lane); continue; } r -= 512;
        if (r < 208) { transpose_item(a.in[10], 416, a.in[2] + D, (bf16_t*)(ws + W2_WIN), 1024, (r % 13) * 32, (r / 13) * 64, (r % 13) * 32, scr, lane); continue; } r -= 208;
        if (r < 192) { transpose_item(a.in[13], 1536, a.in[11], (bf16_t*)(ws + W2_WUQ), 256, (r % 48) * 32, (r / 48) * 64, (r % 48) * 32, scr, lane); continue; } r -= 192;
        if (r < 128) { const int nb32 = r & 63, hh = nb32 >> 2, part = nb32 & 3;
            transpose_item(a.in[14], 2048, a.in[12], (bf16_t*)(ws + W2_WUKV), 128, part < 2 ? hh * 64 + part * 32 : 1024 + hh * 64 + (part - 2) * 32, (r >> 6) * 64, nb32 * 32, scr, lane); continue; } r -= 128;
        transpose_item(a.in[15], D, nullptr, (bf16_t*)(ws + W2_WO1), 1024, (r & 31) * 32, (r >> 5) * 64, (r & 31) * 32, scr, lane);
    }
    __syncthreads();
    moe_weight_items(a.in[20], a.in[21], a.in[22], a.in[3], (bf16_t*)(ws + C_W0), (bf16_t*)(ws + C_W0 + MOE_WGU_BYTES), (LAS float*)lds, bid, nblk);
}

template <bool NSW, bool HALFN, class MakeEpi>
__device__ __forceinline__ void gemm_phase(LAS unsigned char* lds, const bf16_t* A, int lda, const bf16_t* Bt, int K, int pn0, int pn1, int bid, int nblk, const MakeEpi& mk) {
    constexpr int BN = HALFN ? 128 : 256;
    const int ntn = pn1 - pn0;
    const bool grp = (nblk % 8) == 0;
    const int x = grp ? bid % 8 : 0, j = grp ? bid / 8 : bid, nslot = grp ? nblk / 8 : nblk, pmg = grp ? 8 : 64;
    for (int u = j; u < pmg * ntn; u += nslot) {
        const int pm = x * pmg + u / ntn, pn = pn0 + u % ntn;
        RowDense ra{A, lda, pm * 256, MTOT - 1}; auto e = mk(pm * 256, pn * BN);
        if (HALFN) gemm_tile<4, 4, 4, 2, NSW>(lds, ra, Bt + (size_t)pn * BN * K, K, K / 32, e);
        else gemm_tile<8, 4, 2, 4, NSW>(lds, ra, Bt + (size_t)pn * BN * K, K, K / 32, e);
    }
    const int nfull = (pmg * ntn + nslot - 1) / nslot;
    for (int pn = pn0; pn < pn1; ++pn) {
        const int owner = (pn - pn0) * 37 % nblk;
        if (bid == owner) { RowDense ra{A, lda, MREAL, MTOT - 1}; auto e = mk(MREAL, pn * BN);
            if (HALFN) gemm_tile<1, 4, 4, 2, NSW>(lds, ra, Bt + (size_t)pn * BN * K, K, K / 32, e);
            else gemm_tile<1, 4, 2, 4, NSW>(lds, ra, Bt + (size_t)pn * BN * K, K, K / 32, e); }
    }
    (void)nfull;
}

constexpr int PH_PROLOGUE = 0, PH_QKV = 1, PH_SWA = 2, PH_OPROJ0 = 3, PH_ROUTE0 = 4, PH_MOE0 = 5, PH_COMBINE = 6, PH_WIN = 7, PH_CEPI = 8, PH_UQKV = 9, PH_MLA = 10, PH_OPROJ1 = 11, PH_ROUTE1 = 12, PH_MOE1 = 13, PH_FINAL = 14, PH_N = 15;
__global__ void __launch_bounds__(NTHR, 2) mega(MArgs a) {
    extern __shared__ __attribute__((aligned(16))) unsigned char lds_raw[];
    LAS unsigned char* lds = (LAS unsigned char*)lds_raw;
    const int tid = threadIdx.x, bid = blockIdx.x, nblk = gridDim.x;
    volatile LAS unsigned* misc = (volatile LAS unsigned*)(lds + LDS_MISC);
    if (tid < 64) misc[tid] = 0u;
    __syncthreads();
    unsigned char* ws = a.ws;
    XcdBarrier bar = xcd_barrier_post((unsigned*)(ws + WS_BAR) + a.li * XCD_BAR_WORDS, misc);
    if (tid == 0) misc[4] = xb_add((unsigned*)(ws + 32 * 1024) + 64 * bar.x, 1u);
    const int lo = a.ph_lo, hi = a.ph_hi;
#define IN(k) (lo <= (k) && (k) < hi)
#define REP(k) for (int _rep = 0; _rep < ((k) == PROBE_PHASE ? 2 : 1); ++_rep, (void)((k) == PROBE_PHASE && _rep == 1 ? (xcd_barrier(bar), 0) : 0))
#define STAMP(i) do { if (PROBE_PHASE >= 600 && bid == 0 && tid == 0) ((unsigned long long*)(ws + 512 * 1024))[i] = __builtin_amdgcn_s_memrealtime(); } while (0)
#define SEAM(k) do { if (IN(k) && IN((k) + 1)) xcd_barrier(bar); STAMP((k) + 1); } while (0)
    STAMP(0);
    if (IN(PH_PROLOGUE)) REP(PH_PROLOGUE) p0_prologue(a, lds, bid, nblk);
    SEAM(PH_PROLOGUE);
    int vbid = bid;
    if (IN(PH_PROLOGUE) && IN(PH_QKV)) {
        if (tid == 0) { bool ok = (nblk % 8) == 0 && bar.x < 8;
            for (int j = 0; j < 8; ++j) ok = ok && xb_ld((unsigned*)(ws + 32 * 1024) + 64 * j) == (unsigned)(nblk / 8);
            misc[5] = ok ? misc[4] * 8u + bar.x : (unsigned)bid; }
        __syncthreads();
        vbid = __builtin_amdgcn_readfirstlane((int)misc[5]);
    }
#define bid vbid
    if (IN(PH_QKV)) REP(PH_QKV) {
        const float* rstd = (const float*)(ws + W2_RSTD); const float* bias = a.in[6]; const float2* cs = (const float2*)(ws + WS_ROPE); bf16_t* qkv = (bf16_t*)(ws + B_QKV); bf16_t* vt0 = (bf16_t*)(ws + B_VT0);
        const bf16_t* hbA = (const bf16_t*)(ws + W2_HB); const bf16_t* Wt = (const bf16_t*)(ws + W2_WQKV);
        const bool grp = (nblk % 8) == 0; const int x = grp ? bid % 8 : 0, j = grp ? bid / 8 : bid, nslot = grp ? nblk / 8 : nblk, pmg = grp ? 8 : 64;
        for (int u = j; u < pmg * 6; u += nslot) {
            if (u < pmg * 4) { const int pm = x * pmg + (u >> 2), pn = u & 3; RowDense ra{hbA, D, pm * 256, MTOT - 1}; EpiQKV e{rstd, bias, cs, qkv, pm * 256, pn * 256};
                gemm_tile<8, 4, 2, 4, false>(lds, ra, Wt + (size_t)pn * 256 * D, D, D / 32, e);
            } else if (u < pmg * 5) { const int pm = x * pmg + (u - pmg * 4); RowDense ra{hbA, D, pm * 256, MTOT - 1}; EpiQKV e{rstd, bias, cs, qkv, pm * 256, 1024};
                gemm_tile<4, 4, 4, 2, false>(lds, ra, Wt + (size_t)1024 * D, D, D / 32, e);
            } else { const int pm = x * pmg + (u - pmg * 5); RowDense ra{hbA, D, pm * 256, MTOT - 1}; EpiV0 e{rstd, bias, vt0, pm * 256, 1152};
                gemm_tile<4, 4, 4, 2, true>(lds, ra, Wt + (size_t)1152 * D, D, D / 32, e);
            }
        }
        const int mu = bid - (nblk - 6);
        if (mu >= 0 && mu < 4) { RowDense ra{hbA, D, MREAL, MTOT - 1}; EpiQKV e{rstd, bias, cs, qkv, MREAL, mu * 256};
            gemm_tile<1, 4, 2, 4, false>(lds, ra, Wt + (size_t)mu * 256 * D, D, D / 32, e);
        } else if (mu == 4) { RowDense ra{hbA, D, MREAL, MTOT - 1}; EpiQKV e{rstd, bias, cs, qkv, MREAL, 1024};
            gemm_tile<1, 4, 4, 2, false>(lds, ra, Wt + (size_t)1024 * D, D, D / 32, e);
        } else if (mu == 5) { RowDense ra{hbA, D, MREAL, MTOT - 1}; EpiV0 e{rstd, bias, vt0, MREAL, 1152};
            gemm_tile<1, 4, 4, 2, true>(lds, ra, Wt + (size_t)1152 * D, D, D / 32, e);
        }
    }
    SEAM(PH_QKV);
    if (IN(PH_SWA)) REP(PH_SWA) swa_phase(lds, (const bf16_t*)(ws + B_QKV), (const bf16_t*)(ws + B_VT0), a.in[7], (bf16_t*)(ws + B_O0), bid, nblk);
    SEAM(PH_SWA);
    if (IN(PH_OPROJ0)) REP(PH_OPROJ0) {
        const float* bias = a.in[9]; bf16_t* hb = (bf16_t*)(ws + W2_HB);
        gemm_phase<false, false>(lds, (const bf16_t*)(ws + B_O0), D, (const bf16_t*)(ws + W2_WO0), D, 0, 4, bid, nblk, [=](int m0, int n0) { return EpiRes{bias, hb, m0, n0}; });
    }
    SEAM(PH_OPROJ0);
    if (IN(PH_ROUTE0))
        route_phase(lds, (const bf16_t*)(ws + W2_HB), (const float*)(ws + W2_WRF), a.in[17], a.in[19], (float*)(ws + W2_RSTD), (int*)(ws + WS_CTL),
                    (int*)(ws + W2_LIST), (float*)(ws + W2_WSLOT), bid, nblk);
    SEAM(PH_ROUTE0);
    if (IN(PH_MOE0)) REP(PH_MOE0) moe_phase(lds, (int*)(ws + WS_CTL), (const int*)(ws + W2_LIST), (const bf16_t*)(ws + W2_HB), (const float*)(ws + W2_RSTD), (const float*)(ws + W2_WSLOT),
                               (const bf16_t*)(ws + C_W0), (const bf16_t*)(ws + C_W0 + MOE_WGU_BYTES), (bf16_t*)(ws + B_Y0), bid, nblk, (unsigned long long*)(ws + 512 * 1024));
    SEAM(PH_MOE0);
    if (IN(PH_COMBINE)) l1proj_phase(lds, (bf16_t*)(ws + W2_HB), (const bf16_t*)(ws + B_Y0), (const bf16_t*)(ws + W2_WIN), (const bf16_t*)(ws + W2_WUQ), (const bf16_t*)(ws + W2_WUKV),
                                     (const float2*)(ws + WS_ROPE), (bf16_t*)(ws + WS_KPE), (bf16_t*)(ws + C_Q1), (bf16_t*)(ws + C_K1), (bf16_t*)(ws + C_V1), bid, nblk);
    STAMP(PH_WIN); STAMP(PH_CEPI); STAMP(PH_UQKV);
    SEAM(PH_UQKV);
    if (IN(PH_MLA)) REP(100) {
        moe_weight_items(a.in[20] + (size_t)NE * D * DE, a.in[21] + (size_t)NE * D * DE, a.in[22] + (size_t)NE * DE * D, a.in[3] + D, (bf16_t*)(ws + B_W1), (bf16_t*)(ws + B_W1 + MOE_WGU_BYTES),
                         (LAS float*)lds, bid, nblk);
    }
    if (IN(PH_MLA)) REP(PH_MLA) mla_phase(lds, (const bf16_t*)(ws + C_Q1), (const bf16_t*)(ws + C_K1), (const bf16_t*)(ws + WS_KPE), (const bf16_t*)(ws + C_V1), (bf16_t*)(ws + B_O1), bid, nblk);
    SEAM(PH_MLA);
    if (IN(PH_OPROJ1)) REP(PH_OPROJ1) {
        bf16_t* hb = (bf16_t*)(ws + W2_HB);
        gemm_phase<false, false>(lds, (const bf16_t*)(ws + B_O1), D, (const bf16_t*)(ws + W2_WO1), D, 0, 4, bid, nblk, [=](int m0, int n0) { return EpiRes{nullptr, hb, m0, n0}; });
    }
    SEAM(PH_OPROJ1);
    if (IN(PH_ROUTE1))
        route_phase(lds, (const bf16_t*)(ws + W2_HB), (const float*)(ws + W2_WRF) + 36 * 1024, a.in[17] + 4, a.in[19] + 32, (float*)(ws + W2_RSTD), (int*)(ws + WS_CTL) + 2048,
                    (int*)(ws + W2_LIST), (float*)(ws + W2_WSLOT), bid, nblk);
    SEAM(PH_ROUTE1);
    if (IN(PH_MOE1)) REP(PH_MOE1) moe_phase(lds, (int*)(ws + WS_CTL) + 2048, (const int*)(ws + W2_LIST), (const bf16_t*)(ws + W2_HB), (const float*)(ws + W2_RSTD), (const float*)(ws + W2_WSLOT),
                               (const bf16_t*)(ws + B_W1), (const bf16_t*)(ws + B_W1 + MOE_WGU_BYTES), (bf16_t*)(ws + C_Y1), bid, nblk);
    SEAM(PH_MOE1);
    if (IN(PH_FINAL)) REP(PH_FINAL) final_phase((const bf16_t*)(ws + W2_HB), (const bf16_t*)(ws + C_Y1), a.in[4], a.out, bid, nblk);
#undef bid
#undef IN
#undef SEAM
}

static void run_mega(hipStream_t s, const MArgs& base, int lo, int hi, int grid) {
    MArgs a = base; a.ph_lo = lo; a.ph_hi = hi; a.li = lo;
    hipLaunchKernelGGL(mega, dim3(grid), dim3(NTHR), LDS_BYTES, s, a);
}
extern "C" void kernel_launch(void* const* d_in, const int* in_sizes, int n_in, void* d_out, int out_size, void* d_ws, size_t ws_size, hipStream_t stream) {
    static int grid = 0;
    if (grid == 0) {
        if (n_in != 23 || ws_size < WS_END) { fprintf(stderr, "kernel_launch: unexpected n_in %d or ws_size %zu\n", n_in, ws_size); grid = -1; return; }
        if (hipFuncSetAttribute((const void*)mega, hipFuncAttributeMaxDynamicSharedMemorySize, LDS_BYTES) != hipSuccess) { fprintf(stderr, "hipFuncSetAttribute failed\n"); grid = -1; return; }
        int dev = 0, cus = 0, per_cu = 0;
        (void)hipGetDevice(&dev); (void)hipDeviceGetAttribute(&cus, hipDeviceAttributeMultiprocessorCount, dev);
        (void)hipOccupancyMaxActiveBlocksPerMultiprocessor(&per_cu, (const void*)mega, NTHR, LDS_BYTES);
        if (per_cu < 1) { fprintf(stderr, "occupancy query says %d blocks/CU\n", per_cu); }
        (void)hipGetLastError();
        grid = cus;
    }
    if (grid < 0) return;
    (void)in_sizes; (void)out_size;
    unsigned char* ws = (unsigned char*)d_ws;
    MArgs base{}; for (int i = 0; i < 23; ++i) base.in[i] = (const float*)d_in[i]; base.out = (float*)d_out; base.ws = ws;
    (void)hipMemsetAsync(ws + WS_CTL, 0, 1 * MiB, stream);
    run_mega(stream, base, 0, PH_N, grid);
}
```

```cpp
#include <hip/hip_runtime.h>
#ifndef PROBE_PHASE
#define PROBE_PHASE -1
#endif
#include <cstdio>
#include <cstdint>

typedef unsigned short bf16_t;

constexpr int D = 1024, SEQ = 8192, NB = 2, NMETA = 16;
constexpr int MREAL = NB * SEQ;
constexpr int MTOT = MREAL + NB * NMETA;
constexpr int LPOS = NMETA + SEQ;
constexpr int NQKV = 1280;
constexpr int NE = 32, DE = 256;
constexpr int CAP = MTOT * 2;
constexpr float EPS = 1e-6f;

__device__ __forceinline__ float bf2f(bf16_t v) { return __uint_as_float(((unsigned)v) << 16); }
__device__ __forceinline__ bf16_t f2bf(float f) { unsigned u = __float_as_uint(f); u += 0x7fffu + ((u >> 16) & 1u); return (bf16_t)(u >> 16); }
__device__ __forceinline__ int row_pos(int row) { return row < MREAL ? NMETA + (row & (SEQ - 1)) : ((row - MREAL) & (NMETA - 1)); }
__device__ __forceinline__ int row_batch(int row) { return row < MREAL ? (row >> 13) : ((row - MREAL) >> 4); }
constexpr int LP = 8256;
__device__ __forceinline__ int perm16(int p) { const int qd = (p >> 2) & 3; return (p & ~12) | ((((qd & 1) << 1) | (qd >> 1)) << 2); }
__device__ __forceinline__ float wave_sum(float v) {
#pragma unroll
    for (int o = 1; o < 64; o <<= 1) v += __shfl_xor(v, o);
    return v;
}

constexpr size_t MiB = 1u << 20;
constexpr size_t WS_CTL = 0;
constexpr size_t WS_ROPE = 1 * MiB;
constexpr size_t WS_END = 256 * MiB;

#define LAS __attribute__((address_space(3)))
#define GAS __attribute__((address_space(1)))
typedef short bf16x8 __attribute__((ext_vector_type(8)));
typedef float f32x4 __attribute__((ext_vector_type(4)));
typedef unsigned u32x4 __attribute__((ext_vector_type(4)));
typedef unsigned u32x2 __attribute__((ext_vector_type(2)));
constexpr int NTHR = 512, NWAVE = 8;
constexpr int LDS_MISC = 162816;
constexpr int LDS_BYTES = LDS_MISC + 1024;

constexpr size_t WS_BAR = 64 * 1024;
constexpr size_t WS_KPE = 3 * MiB + 256 * 1024;
constexpr size_t W2_RSTD = 4 * MiB + 512 * 1024, W2_WSLOT = W2_RSTD + 80 * 1024, W2_EID = W2_WSLOT + 144 * 1024;
constexpr size_t W2_LIST = 5 * MiB;
constexpr size_t W2_WRF = 9 * MiB + 256 * 1024;
constexpr size_t W2_WQKV = 10 * MiB;
constexpr size_t W2_WO0 = W2_WQKV + 2560 * 1024;
constexpr size_t W2_WIN = W2_WO0 + 2048 * 1024;
constexpr size_t W2_WUQ = W2_WIN + 1024 * 1024;
constexpr size_t W2_WUKV = W2_WUQ + 768 * 1024;
constexpr size_t W2_WO1 = W2_WUKV + 512 * 1024;
constexpr size_t W2_HB = 20 * MiB;
constexpr size_t W2_RB = 53 * MiB;
constexpr size_t W2_RC = 134 * MiB;
static_assert(W2_EID + (size_t)MTOT * 8 <= W2_LIST && W2_LIST + (size_t)NE * CAP * 4 <= W2_WRF && W2_WO1 + 2 * MiB <= W2_HB && W2_HB + (size_t)MTOT * 2048 <= W2_RB, "fixed map");
constexpr size_t B_QKV = W2_RB, B_O0 = W2_RB + 41 * MiB, B_VT0 = W2_RB + 74 * MiB  , B_Y0 = W2_RB, B_CBUF = W2_RB, B_CQN = W2_RB + 33 * MiB, B_CKVN = W2_RB + 42 * MiB, B_O1 = W2_RB, B_W1 = W2_RB + 33 * MiB;
constexpr size_t C_W0 = W2_RC, C_HF = W2_RC + 48 * MiB, C_Q1 = W2_RC, C_K1 = W2_RC + 49 * MiB, C_V1 = W2_RC + 82 * MiB, C_HF1 = W2_RC, C_Y1 = W2_RC;
static_assert(C_V1 + (size_t)2 * 16 * 64 * LP * 2 <= WS_END && C_K1 + (size_t)2 * LP * 2048 <= C_V1 && B_VT0 + (size_t)2 * 2 * 64 * LP * 2 <= W2_RC && C_HF + (size_t)MTOT * 4096 <= WS_END && B_W1 + 48 * MiB <= W2_RC, "region map");
constexpr size_t MOE_WGU_BYTES = (size_t)NE * 512 * 1024 * 2, MOE_WD_BYTES = (size_t)NE * 1024 * 256 * 2;

struct MArgs { const float* in[23]; float* out; unsigned char* ws; int ph_lo, ph_hi, li, pad; };

__device__ __forceinline__ unsigned pk2(float lo, float hi) { return (unsigned)f2bf(lo) | ((unsigned)f2bf(hi) << 16); }

#define XB_TMO      128
#define XB_XCNT(j)  (256  + 64 * (j))
#define XB_XSUB(j)  (1280 + 64 * (j))
#define XB_XGEN(j)  (2304 + 64 * (j))
#define XB_TOP      3328
#define XB_TOPGEN   3392
#define XCD_BAR_WORDS 3456
#define XB_SPIN_CAP (1u << 18)
__device__ __forceinline__ unsigned xb_ld(unsigned* p)              { return __hip_atomic_load(p, __ATOMIC_RELAXED, __HIP_MEMORY_SCOPE_AGENT); }
__device__ __forceinline__ unsigned xb_add(unsigned* p, unsigned v) { return __hip_atomic_fetch_add(p, v, __ATOMIC_RELAXED, __HIP_MEMORY_SCOPE_AGENT); }
__device__ __forceinline__ unsigned xb_xcc_id() { return (unsigned)__builtin_amdgcn_s_getreg((3 << 11) | 20) & 0xFu; }
#define XB_SPIN(cond, bar) do { unsigned _sp = 0; while (cond) { __builtin_amdgcn_s_sleep(1); \
    if ((++_sp & 255u) == 0u) { if (xb_ld(&(bar)[XB_TMO])) break; if (_sp > XB_SPIN_CAP) { atomicAdd(&(bar)[XB_TMO], 1u); break; } } } } while (0)
struct XcdBarrier { unsigned* bar; unsigned x; volatile LAS unsigned* st; };
__device__ __forceinline__ XcdBarrier xcd_barrier_post(unsigned* bar, volatile LAS unsigned* st) {
    XcdBarrier b; b.bar = bar; b.x = xb_xcc_id(); b.st = st;
    if (threadIdx.x == 0) (void)xb_add(&bar[XB_XCNT(b.x)], 1u);
    return b;
}
__device__ __forceinline__ void xcd_barrier_complete(unsigned* bar, unsigned x, unsigned& nloc, unsigned& nx) {
    const unsigned G = gridDim.x * gridDim.y * gridDim.z;
    unsigned sum, cnt, mine, sp = 0u;
    for (;;) {
        sum = 0u; cnt = 0u; mine = 0u;
#pragma unroll
        for (unsigned j = 0; j < 16; ++j) { const unsigned c = xb_ld(&bar[XB_XCNT(j)]); sum += c; cnt += (c > 0u) ? 1u : 0u; mine = (j == x) ? c : mine; }
        if (sum == G) break;
        __builtin_amdgcn_s_sleep(1);
        if ((++sp & 255u) == 0u) { if (xb_ld(&bar[XB_TMO])) break; if (sp > XB_SPIN_CAP) { atomicAdd(&bar[XB_TMO], 1u); break; } }
    }
    nloc = mine > 0u ? mine : 1u; nx = cnt > 0u ? cnt : 1u;
}
__device__ __forceinline__ void xcd_barrier(const XcdBarrier& b) {
    asm volatile("s_waitcnt vmcnt(0)" ::: "memory");
    __syncthreads();
    if (threadIdx.x == 0) {
        unsigned* bar = b.bar;
        __builtin_amdgcn_s_waitcnt(0);
        unsigned nloc = b.st[0], nx = b.st[1];
        if (nloc == 0u) { xcd_barrier_complete(bar, b.x, nloc, nx); b.st[0] = nloc; b.st[1] = nx; }
        const unsigned old = xb_add(&bar[XB_XSUB(b.x)], 1u);
        const unsigned gen = old / nloc;
        if (old + 1u == (gen + 1u) * nloc) {
            __builtin_amdgcn_fence(__ATOMIC_RELEASE, "agent");
            asm volatile("s_waitcnt vmcnt(0)" ::: "memory");
            const unsigned og = xb_add(&bar[XB_TOP], 1u);
            const unsigned tg = og / nx;
            if (og + 1u == (tg + 1u) * nx) xb_add(&bar[XB_TOPGEN], 1u);
            else XB_SPIN(xb_ld(&bar[XB_TOPGEN]) == tg, bar);
            __builtin_amdgcn_fence(__ATOMIC_ACQUIRE, "agent");
            xb_add(&bar[XB_XGEN(b.x)], 1u);
            asm volatile("s_waitcnt vmcnt(0)" ::: "memory");
        } else {
            XB_SPIN(xb_ld(&bar[XB_XGEN(b.x)]) == gen, bar);
            __builtin_amdgcn_fence(__ATOMIC_ACQUIRE, "agent");
            asm volatile("s_waitcnt vmcnt(0)" ::: "memory");
        }
    }
    __syncthreads();
}

template <int N> __device__ __forceinline__ void wait_vm() { asm volatile("s_waitcnt vmcnt(%0)" :: "n"(N) : "memory"); }
__device__ __forceinline__ int swzF(int g) { return (0x78 >> (2 * g)) & 3; }
constexpr int GT_NS = 4;
template <int MT, int NT, int WM, int WN, bool NSW, class RowA, class Epi, bool NOLD = false>
__device__ __forceinline__ void gemm_tile(LAS unsigned char* lds, const RowA& rowA, const bf16_t* __restrict__ Bt, int ldb  , int nk  , Epi& epi) {
    constexpr int BM = WM * MT * 16, BN = WN * NT * 16, GA = BM / 16, G = (BM + BN) / 16, NG = (G + 7) / 8, GR = G % 8, STAGE = (BM + BN) * 64;
    static_assert(WM * WN == 8 && GT_NS * STAGE <= LDS_MISC && BM % 16 == 0 && BN % 16 == 0, "gemm_tile config");
    const int tid = threadIdx.x, lane = tid & 63, wave = __builtin_amdgcn_readfirstlane(tid >> 6), wm = wave / WN, wn = wave % WN;
    const char* src[NG];
    const int lc = (lane & 3) ^ swzF(lane >> 4);
#pragma unroll
    for (int i = 0; i < NG; ++i) {
        const int g = wave + 8 * i;
        if (g < GA) src[i] = (const char*)rowA(g * 16 + (lane >> 2)) + lc * 16;
        else if (g < G) src[i] = (const char*)(Bt + (size_t)((g - GA) * 16 + (lane >> 2)) * ldb) + lc * 16;
        else src[i] = nullptr;
    }
    f32x4 acc[MT][NT];
#pragma unroll
    for (int mi = 0; mi < MT; ++mi)
#pragma unroll
        for (int ni = 0; ni < NT; ++ni) acc[mi][ni] = (f32x4){0.f, 0.f, 0.f, 0.f};
    const int fro = (lane & 15) * 64 + (((lane >> 4) ^ swzF((lane >> 2) & 3)) << 4);
    constexpr int LM = PROBE_PHASE == 402 ? 2 : 1;
#define GT_STAGE(st, kt) do { _Pragma("unroll") for (int _i = 0; _i < NG; ++_i) { const int _g = wave + 8 * _i; if (_g < G) { \
        __builtin_amdgcn_global_load_lds((const unsigned*)(src[_i] + (size_t)(kt) * 64), (LAS unsigned*)(lds + (st) * STAGE + _g * 1024), 16, 0, 0); \
        if (LM == 2) __builtin_amdgcn_global_load_lds((const unsigned*)(src[_i] + (size_t)(kt) * 64), (LAS unsigned*)(lds + (st) * STAGE + _g * 1024), 16, 0, 0); } } } while (0)
#define GT_WAIT(ntl) do { if (GR == 0 || wave < GR) wait_vm<LM * NG * (ntl)>(); else wait_vm<LM * (NG - 1) * (ntl)>(); } while (0)
    if (!NOLD) { GT_STAGE(0, 0);
    if (nk > 1) GT_STAGE(1, 1);
    if (nk > 2) GT_STAGE(2, 2); }
    int st = 0;
    for (int kt = 0; kt < nk; ++kt) {
        const int rem = nk - 1 - kt;
        if (!NOLD) { if (rem >= 2) GT_WAIT(2); else if (rem == 1) GT_WAIT(1); else GT_WAIT(0); }
        __builtin_amdgcn_s_barrier(); asm volatile("" ::: "memory");
        const bool doload = (!NOLD || PROBE_PHASE == 505) && kt + 3 < nk;
        LAS const unsigned char* sa = lds + st * STAGE + (wm * MT * 16) * 64 + fro;
        LAS const unsigned char* sb = lds + st * STAGE + (BM + wn * NT * 16) * 64 + fro;
        bf16x8 bfr[NT];
#pragma unroll
        for (int ni = 0; ni < NT; ++ni) bfr[ni] = *(LAS const bf16x8*)(sb + ni * 1024);
        constexpr int PG = MT >= 2 ? 2 : 1, NPG = MT / PG;
        constexpr int LPG = (NG + NPG - 1) / NPG;
        bf16x8 afc[PG], afn[PG];
#pragma unroll
        for (int i = 0; i < PG; ++i) afc[i] = *(LAS const bf16x8*)(sa + i * 1024);
#pragma unroll
        for (int pg = 0; pg < NPG; ++pg) {
            if (doload) {
#pragma unroll
                for (int l = 0; l < LPG; ++l) { const int _i = pg * LPG + l; if (_i < NG) { const int _g = wave + 8 * _i; if (_g < G)
                    __builtin_amdgcn_global_load_lds((const unsigned*)(src[_i] + (size_t)(kt + 3) * 64), (LAS unsigned*)(lds + ((st + 3) & 3) * STAGE + _g * 1024), 16, 0, 0); } }
            }
            if (pg + 1 < NPG) {
#pragma unroll
                for (int i = 0; i < PG; ++i) afn[i] = *(LAS const bf16x8*)(sa + ((pg + 1) * PG + i) * 1024);
            }
#pragma unroll
            for (int i = 0; i < PG; ++i) { const int mi = pg * PG + i;
#pragma unroll
                for (int ni = 0; ni < NT; ++ni) {
                    if (NSW) acc[mi][ni] = __builtin_amdgcn_mfma_f32_16x16x32_bf16(afc[i], bfr[ni], acc[mi][ni], 0, 0, 0);
                    else acc[mi][ni] = __builtin_amdgcn_mfma_f32_16x16x32_bf16(bfr[ni], afc[i], acc[mi][ni], 0, 0, 0);
                } }
#pragma unroll
            for (int i = 0; i < PG; ++i) afc[i] = afn[i];
            __builtin_amdgcn_sched_barrier(0);
        }
        st = (st + 1) & 3;
    }
#undef GT_STAGE
#undef GT_WAIT
    epi(acc, wm * MT * 16, wn * NT * 16, lane);
    asm volatile("s_waitcnt lgkmcnt(0)" ::: "memory");
    __syncthreads();
}

struct RowDense { const bf16_t* A; int lda, m0, mlast; __device__ __forceinline__ const bf16_t* operator()(int r) const { int row = m0 + r; row = row > mlast ? mlast : row; return A + (size_t)row * lda; } };

struct EpiQKV {
    const float* rstd; const float* bias; const float2* cs; bf16_t* qkv; int m0, n0;
    template <int MT, int NT> __device__ __forceinline__ void operator()(f32x4 (&acc)[MT][NT], int mb, int nb, int lane) const {
        static_assert(NT == 4, "rope needs a 64-column wave span");
        const int cb = n0 + nb, d0 = (lane >> 4) * 4;
#pragma unroll
        for (int mi = 0; mi < MT; ++mi) {
            const int row = m0 + mb + mi * 16 + (lane & 15);
            if (row < MTOT) {
                const float rs = rstd[row]; const int pos = row_pos(row);
                bf16_t* orow = qkv + (size_t)row * NQKV + cb;
                {
                    const float sc = cb < 1024 ? 0.125f : 1.0f;
#pragma unroll
                    for (int ni = 0; ni < 2; ++ni) {
                        const int d = ni * 16 + d0;
                        const f32x4 b1 = *(const f32x4*)(bias + cb + d), b2 = *(const f32x4*)(bias + cb + 32 + d);
                        float o1[4], o2[4];
#pragma unroll
                        for (int r = 0; r < 4; ++r) {
                            const float2 t = cs[pos * 32 + d + r];
                            const float x1 = acc[mi][ni][r] * rs + b1[r], x2 = acc[mi][ni + 2][r] * rs + b2[r];
                            o1[r] = (x1 * t.x - x2 * t.y) * sc; o2[r] = (x2 * t.x + x1 * t.y) * sc;
                        }
                        *(u32x2*)(orow + d) = (u32x2){pk2(o1[0], o1[1]), pk2(o1[2], o1[3])};
                        *(u32x2*)(orow + 32 + d) = (u32x2){pk2(o2[0], o2[1]), pk2(o2[2], o2[3])};
                    }
                }
            }
        }
    }
};
struct EpiV0 {
    const float* rstd; const float* bias; bf16_t* vt0; int m0, n0;
    template <int MT, int NT> __device__ __forceinline__ void operator()(f32x4 (&acc)[MT][NT], int mb, int nb, int lane) const {
        static_assert(NT == 4, "64-column wave span");
        const int cb = n0 + nb, kh = (cb - 1152) >> 6;
#pragma unroll
        for (int mi = 0; mi < MT; ++mi) {
            const int row0 = m0 + mb + mi * 16 + (lane >> 4) * 4;
            if (row0 < MTOT) {
                const f32x4 rs = *(const f32x4*)(rstd + row0); const int b = row_batch(row0), pp = perm16(row_pos(row0));
#pragma unroll
                for (int ni = 0; ni < NT; ++ni) { const int d = ni * 16 + (lane & 15); const float bb = bias[cb + d];
                    const f32x4 v = acc[mi][ni] * rs + bb;
                    *(u32x2*)(vt0 + (size_t)((b * 2 + kh) * 64 + d) * LP + pp) = (u32x2){pk2(v[0], v[1]), pk2(v[2], v[3])}; }
            }
        }
    }
};
struct EpiRes {
    const float* bias; bf16_t* hb; int m0, n0;
    template <int MT, int NT> __device__ __forceinline__ void operator()(f32x4 (&acc)[MT][NT], int mb, int nb, int lane) const {
#pragma unroll
        for (int mi = 0; mi < MT; ++mi) {
            const int row = m0 + mb + mi * 16 + (lane & 15);
            if (row < MTOT) {
#pragma unroll
                for (int ni = 0; ni < NT; ++ni) {
                    const int col = n0 + nb + ni * 16 + (lane >> 4) * 4;
                    u32x2* p = (u32x2*)(hb + (size_t)row * D + col);
                    const u32x2 h = *p;
                    f32x4 v = acc[mi][ni];
                    if (bias) v += *(const f32x4*)(bias + col);
                    v[0] += __uint_as_float(h.x << 16); v[1] += __uint_as_float(h.x & 0xffff0000u); v[2] += __uint_as_float(h.y << 16); v[3] += __uint_as_float(h.y & 0xffff0000u);
                    *p = (u32x2){pk2(v[0], v[1]), pk2(v[2], v[3])};
                }
            }
        }
    }
};
__device__ __forceinline__ void route_phase(LAS unsigned char* lds, const bf16_t* __restrict__ hbr, const float* __restrict__ wrf, const float* __restrict__ bg, const float* __restrict__ br,
                                            float* rstd_out, int* cnt, int* list, float* wslot, int bid, int nblk) {
    const int tid = threadIdx.x, lane = tid & 63, wave = __builtin_amdgcn_readfirstlane(tid >> 6);
    LAS f32x4* wl = (LAS f32x4*)lds;
    LAS int* nrec = (LAS int*)(lds + LDS_MISC + 16); LAS int* bcnt = (LAS int*)(lds + LDS_MISC + 32); LAS int* bbase = (LAS int*)(lds + LDS_MISC + 160); LAS int* rec = (LAS int*)(lds + LDS_MISC + 288);
    for (int i = tid; i < 36 * 256; i += NTHR) wl[i] = *(const f32x4*)(wrf + (size_t)i * 4);
    if (tid < NE) bcnt[tid] = 0;
    if (tid == 0) *nrec = 0;
    __syncthreads();
    for (int row = bid * NWAVE + wave; row < MTOT; row += nblk * NWAVE) {
        f32x4 x[4]; float ss = 0.f;
#pragma unroll
        for (int j = 0; j < 4; ++j) { const u32x2 h = *(const u32x2*)(hbr + (size_t)row * D + j * 256 + lane * 4);
            x[j] = (f32x4){__uint_as_float(h.x << 16), __uint_as_float(h.x & 0xffff0000u), __uint_as_float(h.y << 16), __uint_as_float(h.y & 0xffff0000u)};
            ss += x[j][0] * x[j][0] + x[j][1] * x[j][1] + x[j][2] * x[j][2] + x[j][3] * x[j][3]; }
        ss = wave_sum(ss);
        const float rs = rsqrtf(ss * (1.0f / D) + EPS);
        float lg[4];
#pragma unroll
        for (int c = 0; c < 4; ++c) { float p = 0.f;
#pragma unroll
            for (int j = 0; j < 4; ++j) { const f32x4 w = wl[c * 256 + j * 64 + lane]; p += x[j][0] * w[0] + x[j][1] * w[1] + x[j][2] * w[2] + x[j][3] * w[3]; }
            lg[c] = wave_sum(p) * rs + bg[c]; }
        int gi = 0; float gm = lg[0];
#pragma unroll
        for (int c = 1; c < 4; ++c) if (lg[c] > gm) { gm = lg[c]; gi = c; }
        float gs = 0.f;
#pragma unroll
        for (int c = 0; c < 4; ++c) gs += __expf(lg[c] - gm);
        const float gp = 1.0f / gs;
        gi = __builtin_amdgcn_readfirstlane(gi);
        float e[8];
#pragma unroll
        for (int c = 0; c < 8; ++c) { float p = 0.f;
#pragma unroll
            for (int j = 0; j < 4; ++j) { const f32x4 w = wl[(4 + gi * 8 + c) * 256 + j * 64 + lane]; p += x[j][0] * w[0] + x[j][1] * w[1] + x[j][2] * w[2] + x[j][3] * w[3]; }
            e[c] = wave_sum(p) * rs + br[gi * 8 + c]; }
        int i1 = 0; float v1 = e[0];
#pragma unroll
        for (int c = 1; c < 8; ++c) if (e[c] > v1) { v1 = e[c]; i1 = c; }
        int i2 = -1; float v2 = -3.0e38f;
#pragma unroll
        for (int c = 0; c < 8; ++c) if (c != i1 && e[c] > v2) { v2 = e[c]; i2 = c; }
        if (lane == 0) {
            const float r = __expf(v2 - v1);
            const float w1 = gp / (1.0f + r), w2 = gp * r / (1.0f + r);
            const int e1 = gi * 8 + i1, e2 = gi * 8 + i2;
            const int p1 = atomicAdd((int*)&bcnt[e1], 1), p2 = atomicAdd((int*)&bcnt[e2], 1);
            const int k = atomicAdd((int*)nrec, 2);
            rec[k] = ((row * 2) << 13) | (e1 << 8) | p1; rec[k + 1] = ((row * 2 + 1) << 13) | (e2 << 8) | p2;
            wslot[row * 2] = w1; wslot[row * 2 + 1] = w2; rstd_out[row] = rs;
        }
    }
    __syncthreads();
    if (tid < NE) { const int c = bcnt[tid]; bbase[tid] = c ? __hip_atomic_fetch_add(cnt + tid * 64, c, __ATOMIC_RELAXED, __HIP_MEMORY_SCOPE_AGENT) : 0; }
    __syncthreads();
    for (int k = tid; k < *nrec; k += NTHR) { const int r = rec[k], e = (r >> 8) & 31; list[(size_t)e * CAP + bbase[e] + (r & 255)] = r >> 13; }
    __syncthreads();
}
__device__ __forceinline__ void final_phase(const bf16_t* __restrict__ hb, const bf16_t* __restrict__ ybuf, const float* __restrict__ g, float* out, int bid, int nblk) {
    const int tid = threadIdx.x, lane = tid & 63, wave = tid >> 6;
    for (int row = bid * NWAVE + wave; row < MREAL; row += nblk * NWAVE) {
        f32x4 v[4]; float ss = 0.f;
#pragma unroll
        for (int j = 0; j < 4; ++j) { const size_t c = j * 256 + lane * 4;
            const u32x2 h = *(const u32x2*)(hb + (size_t)row * D + c), y0 = *(const u32x2*)(ybuf + (size_t)(row * 2) * D + c), y1 = *(const u32x2*)(ybuf + (size_t)(row * 2 + 1) * D + c);
            v[j][0] = __uint_as_float(h.x << 16) + __uint_as_float(y0.x << 16) + __uint_as_float(y1.x << 16);
            v[j][1] = __uint_as_float(h.x & 0xffff0000u) + __uint_as_float(y0.x & 0xffff0000u) + __uint_as_float(y1.x & 0xffff0000u);
            v[j][2] = __uint_as_float(h.y << 16) + __uint_as_float(y0.y << 16) + __uint_as_float(y1.y << 16);
            v[j][3] = __uint_as_float(h.y & 0xffff0000u) + __uint_as_float(y0.y & 0xffff0000u) + __uint_as_float(y1.y & 0xffff0000u);
            ss += v[j][0] * v[j][0] + v[j][1] * v[j][1] + v[j][2] * v[j][2] + v[j][3] * v[j][3]; }
        const float rs = rsqrtf(wave_sum(ss) * (1.0f / D) + EPS);
#pragma unroll
        for (int j = 0; j < 4; ++j) { const f32x4 gg = *(const f32x4*)(g + j * 256 + lane * 4); *(f32x4*)(out + (size_t)row * D + j * 256 + lane * 4) = v[j] * rs * gg; }
    }
}

typedef float f32x16 __attribute__((ext_vector_type(16)));
constexpr int AT_STAGE = 20480;
__device__ __forceinline__ unsigned cvtpk(float lo, float hi) { typedef float f2 __attribute__((ext_vector_type(2))); typedef __bf16 b2 __attribute__((ext_vector_type(2)));
    f2 v = {lo, hi}; b2 r = __builtin_convertvector(v, b2); return __builtin_bit_cast(unsigned, r); }
__device__ __forceinline__ void mla_unit(LAS unsigned char* lds, int b, int h, int qi, const bf16_t* __restrict__ Q1, const bf16_t* __restrict__ K1, const bf16_t* __restrict__ kpe,
                                         const bf16_t* __restrict__ VT1, bf16_t* o) {
    const int tid = threadIdx.x, lane = tid & 63, wave = __builtin_amdgcn_readfirstlane(tid >> 6), r32 = lane & 31, hi = lane >> 5;
    const size_t qrow = (size_t)b * SEQ + 256 * qi + 32 * wave + r32;
    bf16x8 qf[6];
#pragma unroll
    for (int s = 0; s < 6; ++s) qf[s] = *(const bf16x8*)(Q1 + qrow * 1536 + h * 96 + 16 * s + 8 * hi);
    const int lr = 8 * wave + (lane >> 3);
    const char* ksrc = (const char*)(K1 + ((size_t)b * LP + lr) * 1024 + h * 64) + (((lane & 7) ^ ((lr >> 1) & 7)) << 4);
    const char* vsrc = (const char*)(VT1 + ((size_t)(b * 16 + h) * 64 + lr) * LP) + (((lane & 7) ^ ((lr >> 1) & 7)) << 4);
    const int pr = 16 * wave + (lane >> 2);
    const char* psrc = (const char*)(kpe + ((size_t)b * LP + (pr & 63)) * 32) + (((lane & 3) ^ ((pr >> 2) & 3)) << 4);
#define MLA_ISSUE(j, st) do { \
        __builtin_amdgcn_global_load_lds((const unsigned*)(ksrc + (size_t)(j) * (64 * 2048)), (LAS unsigned*)(lds + (st) * AT_STAGE + wave * 1024), 16, 0, 0); \
        __builtin_amdgcn_global_load_lds((const unsigned*)(vsrc + (size_t)(j) * 128), (LAS unsigned*)(lds + (st) * AT_STAGE + 8192 + wave * 1024), 16, 0, 0); \
        if (wave < 4) __builtin_amdgcn_global_load_lds((const unsigned*)(psrc + (size_t)(j) * (64 * 64)), (LAS unsigned*)(lds + (st) * AT_STAGE + 16384 + wave * 1024), 16, 0, 0); } while (0)
    const int NT = 4 * qi + 5, jmaxw = 4 * qi + ((32 * wave + 47) >> 6);
    const int qp = 16 + 256 * qi + 32 * wave + r32;
    const int koff = r32 * 128, ksw = (r32 >> 1) & 7, poff = 16384 + r32 * 64, psw = (r32 >> 2) & 3, voff = 8192 + r32 * 128;
    f32x16 oacc[2]; oacc[0] = (f32x16){}; oacc[1] = (f32x16){};
    constexpr float MLA_THR = 8.0f;
    float mref = 0.f, lsum = 0.f;
    f32x16 negm = (f32x16){};
    MLA_ISSUE(0, 0);
    if (NT > 1) MLA_ISSUE(1, 1);
    int st = 0;
    for (int j = 0; j < NT; ++j) {
        if (j + 1 < NT) { if (wave < 4) asm volatile("s_waitcnt vmcnt(3)" ::: "memory"); else asm volatile("s_waitcnt vmcnt(2)" ::: "memory"); }
        else asm volatile("s_waitcnt vmcnt(0)" ::: "memory");
        __builtin_amdgcn_s_barrier(); asm volatile("" ::: "memory");
        if (j + 2 < NT) { const int st2 = st >= 1 ? st - 1 : 2; MLA_ISSUE(j + 2, st2); }
        if (j <= jmaxw) {
            LAS const unsigned char* sb = lds + st * AT_STAGE;
            f32x16 p0, p1;
            {
                const bf16x8 k0 = *(LAS const bf16x8*)(sb + koff + ((hi ^ ksw) << 4));
                const bf16x8 k1 = *(LAS const bf16x8*)(sb + 4096 + koff + ((hi ^ ksw) << 4));
                p0 = __builtin_amdgcn_mfma_f32_32x32x16_bf16(k0, qf[0], negm, 0, 0, 0);
                p1 = __builtin_amdgcn_mfma_f32_32x32x16_bf16(k1, qf[0], negm, 0, 0, 0);
            }
#pragma unroll
            for (int s = 1; s < 4; ++s) {
                const bf16x8 k0 = *(LAS const bf16x8*)(sb + koff + (((2 * s + hi) ^ ksw) << 4));
                const bf16x8 k1 = *(LAS const bf16x8*)(sb + 4096 + koff + (((2 * s + hi) ^ ksw) << 4));
                p0 = __builtin_amdgcn_mfma_f32_32x32x16_bf16(k0, qf[s], p0, 0, 0, 0);
                p1 = __builtin_amdgcn_mfma_f32_32x32x16_bf16(k1, qf[s], p1, 0, 0, 0);
            }
#pragma unroll
            for (int s = 0; s < 2; ++s) {
                const bf16x8 k0 = *(LAS const bf16x8*)(sb + poff + (((2 * s + hi) ^ psw) << 4));
                const bf16x8 k1 = *(LAS const bf16x8*)(sb + 2048 + poff + (((2 * s + hi) ^ psw) << 4));
                p0 = __builtin_amdgcn_mfma_f32_32x32x16_bf16(k0, qf[4 + s], p0, 0, 0, 0);
                p1 = __builtin_amdgcn_mfma_f32_32x32x16_bf16(k1, qf[4 + s], p1, 0, 0, 0);
            }
            if (j >= 4 * qi) {
                const int kb0 = 64 * j + 4 * hi;
#pragma unroll
                for (int r = 0; r < 16; ++r) { const int kp = kb0 + (r & 3) + 8 * (r >> 2); if (kp > qp) p0[r] = -1e30f; if (kp + 32 > qp) p1[r] = -1e30f; }
            }
            float tm = fmaxf(p0[0], p1[0]);
#pragma unroll
            for (int r = 1; r < 16; ++r) tm = fmaxf(tm, fmaxf(p0[r], p1[r]));
            tm = fmaxf(tm, __shfl_xor(tm, 32));
            if (j == 0 || __any(tm > MLA_THR)) {
                const float dl = j == 0 ? tm : fmaxf(tm, 0.f);
                mref += dl;
                const float f = __builtin_amdgcn_exp2f(-dl);
                lsum *= f;
#pragma unroll
                for (int r = 0; r < 16; ++r) { oacc[0][r] *= f; oacc[1][r] *= f; p0[r] -= dl; p1[r] -= dl; negm[r] = -mref; }
            }
            float ps = 0.f;
#pragma unroll
            for (int r = 0; r < 16; ++r) { p0[r] = __builtin_amdgcn_exp2f(p0[r]); p1[r] = __builtin_amdgcn_exp2f(p1[r]); ps += p0[r] + p1[r]; }
            lsum += ps;
            u32x4 pf[4];
            pf[0] = (u32x4){cvtpk(p0[0], p0[1]), cvtpk(p0[2], p0[3]), cvtpk(p0[4], p0[5]), cvtpk(p0[6], p0[7])};
            pf[1] = (u32x4){cvtpk(p0[8], p0[9]), cvtpk(p0[10], p0[11]), cvtpk(p0[12], p0[13]), cvtpk(p0[14], p0[15])};
            pf[2] = (u32x4){cvtpk(p1[0], p1[1]), cvtpk(p1[2], p1[3]), cvtpk(p1[4], p1[5]), cvtpk(p1[6], p1[7])};
            pf[3] = (u32x4){cvtpk(p1[8], p1[9]), cvtpk(p1[10], p1[11]), cvtpk(p1[12], p1[13]), cvtpk(p1[14], p1[15])};
#pragma unroll
            for (int s = 0; s < 4; ++s) {
                const bf16x8 v0 = *(LAS const bf16x8*)(sb + voff + (((2 * s + hi) ^ ksw) << 4));
                const bf16x8 v1 = *(LAS const bf16x8*)(sb + 4096 + voff + (((2 * s + hi) ^ ksw) << 4));
                const bf16x8 pb = __builtin_bit_cast(bf16x8, pf[s]);
                oacc[0] = __builtin_amdgcn_mfma_f32_32x32x16_bf16(v0, pb, oacc[0], 0, 0, 0);
                oacc[1] = __builtin_amdgcn_mfma_f32_32x32x16_bf16(v1, pb, oacc[1], 0, 0, 0);
            }
        }
        st = st == 2 ? 0 : st + 1;
    }
#undef MLA_ISSUE
    lsum += __shfl_xor(lsum, 32);
    const float inv = 1.0f / lsum;
    bf16_t* orow = o + qrow * D + h * 64 + 4 * hi;
#pragma unroll
    for (int db = 0; db < 2; ++db)
#pragma unroll
        for (int g = 0; g < 4; ++g)
            *(u32x2*)(orow + 32 * db + 8 * g) = (u32x2){cvtpk(oacc[db][4 * g] * inv, oacc[db][4 * g + 1] * inv), cvtpk(oacc[db][4 * g + 2] * inv, oacc[db][4 * g + 3] * inv)};
    asm volatile("s_waitcnt lgkmcnt(0)" ::: "memory");
    __builtin_amdgcn_s_barrier(); asm volatile("" ::: "memory");
}
__device__ __forceinline__ void mla_meta(int b, int h, const bf16_t* __restrict__ Q1, const bf16_t* __restrict__ K1, const bf16_t* __restrict__ kpe, const bf16_t* __restrict__ VT1, bf16_t* o, int lane) {
    const int qi = lane & 15, part = lane >> 4; const size_t qrow = (size_t)MREAL + b * 16 + qi;
    float q[24];
#pragma unroll
    for (int d = 0; d < 24; ++d) q[d] = bf2f(Q1[qrow * 1536 + h * 96 + 24 * part + d]);
    float sc[16]; float mx = -1e30f;
#pragma unroll
    for (int j = 0; j < 16; ++j) {
        const size_t kr = (size_t)b * LP + j; float s = 0.f;
#pragma unroll
        for (int d = 0; d < 24; ++d) { const int dd = 24 * part + d; const float kv = dd < 64 ? bf2f(K1[kr * D + h * 64 + dd]) : bf2f(kpe[kr * 32 + dd - 64]); s += q[d] * kv; }
        s += __shfl_xor(s, 16); s += __shfl_xor(s, 32);
        sc[j] = j <= qi ? s : -1e30f; mx = fmaxf(mx, sc[j]);
    }
    float l = 0.f;
#pragma unroll
    for (int j = 0; j < 16; ++j) { sc[j] = exp2f(sc[j] - mx); l += sc[j]; }
    const float inv = 1.0f / l;
#pragma unroll
    for (int dd = 0; dd < 16; ++dd) { const int d = 16 * part + dd; float acc = 0.f;
#pragma unroll
        for (int j = 0; j < 16; ++j) acc += sc[j] * bf2f(VT1[((size_t)(b * 16 + h) * 64 + d) * LP + perm16(j)]);
        o[qrow * D + h * 64 + d] = f2bf(acc * inv); }
}
__device__ __forceinline__ void mla_phase(LAS unsigned char* lds, const bf16_t* Q1, const bf16_t* K1, const bf16_t* kpe, const bf16_t* VT1, bf16_t* o, int bid, int nblk) {
    const int v = (nblk % 8 == 0) ? (bid % 8) * (nblk / 8) + bid / 8 : bid;
    for (int vv = v; vv < 256; vv += nblk) {
        const int bh = vv >> 3, s = vv & 7, b = bh >> 4, h = bh & 15;
#pragma unroll 1
        for (int i = 0; i < 4; ++i) { const int qi = (i == 0) ? s : (i == 1) ? 15 - s : (i == 2) ? 16 + s : 31 - s; mla_unit(lds, b, h, qi, Q1, K1, kpe, VT1, o); }
        if (s == 0 && threadIdx.x < 64) mla_meta(b, h, Q1, K1, kpe, VT1, o, threadIdx.x);
    }
}

constexpr int SW_K = 0, SW_V = 36864, SW_VP = 560;
__device__ __forceinline__ void swa_block32(LAS const unsigned char* lds, int rb, int gk0, int nks, int mode, int i_q, const bf16x8 (&qf)[4], float& m, float& lsum, f32x16 (&oacc)[2], int r32, int hi) {
    const float C2 = 1.4426950408889634f;
    const int ksw = (r32 >> 1) & 7;
    f32x16 p = (f32x16){};
#pragma unroll
    for (int s = 0; s < 4; ++s) { const bf16x8 k = *(LAS const bf16x8*)(lds + SW_K + (rb + r32) * 128 + (((2 * s + hi) ^ ksw) << 4)); p = __builtin_amdgcn_mfma_f32_32x32x16_bf16(k, qf[s], p, 0, 0, 0); }
    if (mode != 0) {
        const int jb = ((rb - 32) & 127) + 4 * hi;
#pragma unroll
        for (int r = 0; r < 16; ++r) { const int kk = (r & 3) + 8 * (r >> 2);
            const bool ok = mode == 1 ? (kk + 4 * hi < 16) : mode == 2 ? (jb + kk > i_q) : (jb + kk <= i_q);
            if (!ok) p[r] = -1e30f; }
    }
    float tm = p[0];
#pragma unroll
    for (int r = 1; r < 16; ++r) tm = fmaxf(tm, p[r]);
    tm = fmaxf(tm, __shfl_xor(tm, 32));
    const float mn = fmaxf(m, tm), alpha = __builtin_amdgcn_exp2f((m - mn) * C2), nmc = -mn * C2;
    m = mn;
    float ps = 0.f;
#pragma unroll
    for (int r = 0; r < 16; ++r) { p[r] = __builtin_amdgcn_exp2f(__builtin_fmaf(p[r], C2, nmc)); ps += p[r]; }
    lsum = lsum * alpha + ps;
#pragma unroll
    for (int r = 0; r < 16; ++r) { oacc[0][r] *= alpha; oacc[1][r] *= alpha; }
    u32x4 pf[2];
    pf[0] = (u32x4){cvtpk(p[0], p[1]), cvtpk(p[2], p[3]), cvtpk(p[4], p[5]), cvtpk(p[6], p[7])};
    pf[1] = (u32x4){cvtpk(p[8], p[9]), cvtpk(p[10], p[11]), cvtpk(p[12], p[13]), cvtpk(p[14], p[15])};
#pragma unroll
    for (int ks = 0; ks < 2; ++ks) if (ks < nks) {
        const bf16x8 v0 = *(LAS const bf16x8*)(lds + SW_V + r32 * SW_VP + (gk0 + ks) * 32 + hi * 16);
        const bf16x8 v1 = *(LAS const bf16x8*)(lds + SW_V + (32 + r32) * SW_VP + (gk0 + ks) * 32 + hi * 16);
        const bf16x8 pb = __builtin_bit_cast(bf16x8, pf[ks]);
        oacc[0] = __builtin_amdgcn_mfma_f32_32x32x16_bf16(v0, pb, oacc[0], 0, 0, 0);
        oacc[1] = __builtin_amdgcn_mfma_f32_32x32x16_bf16(v1, pb, oacc[1], 0, 0, 0);
    }
}
__device__ __forceinline__ void swa_unit(LAS unsigned char* lds, int b, int n, int kh, const bf16_t* __restrict__ qkv, const bf16_t* __restrict__ VT0, const float* __restrict__ sinks, bf16_t* o) {
    const int tid = threadIdx.x, lane = tid & 63, wave = __builtin_amdgcn_readfirstlane(tid >> 6), r32 = lane & 31, hi = lane >> 5;
    for (int idx = tid; idx < 2176; idx += NTHR) {
        const int row = idx >> 3, c = idx & 7;
        if (row < 16 || n > 0 || row >= 144) {
            const size_t srow = row < 16 ? (size_t)MREAL + b * 16 + row : (size_t)b * SEQ + 128 * (n - 1) + (row - 16);
            const int lrow = row < 16 ? row : 16 + row;
            const u32x4 v = *(const u32x4*)(qkv + srow * NQKV + 1024 + kh * 64 + c * 8);
            *(LAS u32x4*)(lds + SW_K + lrow * 128 + ((c ^ ((lrow >> 1) & 7)) << 4)) = v;
        }
    }
    for (int idx = tid; idx < 2176; idx += NTHR) {
        const int d = idx / 34, c = idx % 34;
        if (c < 2 || n > 0 || c >= 18) {
            const bf16_t* src = VT0 + (size_t)((b * 2 + kh) * 64 + d) * LP + (c < 2 ? c * 8 : 16 + 128 * (n - 1) + (c - 2) * 8);
            *(LAS u32x4*)(lds + SW_V + d * SW_VP + c * 16) = *(const u32x4*)src;
        }
    }
    __syncthreads();
    const int hq = kh * 8 + wave;
    const float sink = sinks[hq];
#pragma unroll 1
    for (int qs = 0; qs < 4; ++qs) {
        const size_t qrow = (size_t)b * SEQ + 128 * n + 32 * qs + r32;
        bf16x8 qf[4];
#pragma unroll
        for (int s = 0; s < 4; ++s) qf[s] = *(const bf16x8*)(qkv + qrow * NQKV + hq * 64 + 16 * s + 8 * hi);
        f32x16 oacc[2]; oacc[0] = (f32x16){}; oacc[1] = (f32x16){};
        float m = sink, lsum = hi == 0 ? 1.0f : 0.0f;
        const int i_q = 32 * qs + r32;
        swa_block32(lds, 0, 0, 1, 1, i_q, qf, m, lsum, oacc, r32, hi);
        if (n > 0) {
            swa_block32(lds, 32 + 32 * qs, 1 + 2 * qs, 2, 2, i_q, qf, m, lsum, oacc, r32, hi);
#pragma unroll 1
            for (int kb = qs + 1; kb < 4; ++kb) swa_block32(lds, 32 + 32 * kb, 1 + 2 * kb, 2, 0, i_q, qf, m, lsum, oacc, r32, hi);
        }
#pragma unroll 1
        for (int kb = 0; kb < qs; ++kb) swa_block32(lds, 160 + 32 * kb, 9 + 2 * kb, 2, 0, i_q, qf, m, lsum, oacc, r32, hi);
        swa_block32(lds, 160 + 32 * qs, 9 + 2 * qs, 2, 3, i_q, qf, m, lsum, oacc, r32, hi);
        lsum += __shfl_xor(lsum, 32);
        const float inv = 1.0f / lsum;
        bf16_t* orow = o + qrow * D + hq * 64 + 4 * hi;
#pragma unroll
        for (int db = 0; db < 2; ++db)
#pragma unroll
            for (int g = 0; g < 4; ++g)
                *(u32x2*)(orow + 32 * db + 8 * g) = (u32x2){cvtpk(oacc[db][4 * g] * inv, oacc[db][4 * g + 1] * inv), cvtpk(oacc[db][4 * g + 2] * inv, oacc[db][4 * g + 3] * inv)};
    }
    __syncthreads();
}
__device__ __forceinline__ void swa_meta(int b, int hq, const bf16_t* __restrict__ qkv, const bf16_t* __restrict__ VT0, const float* __restrict__ sinks, bf16_t* o, int lane) {
    const int qi = lane & 15, part = lane >> 4, kh = hq >> 3; const size_t qrow = (size_t)MREAL + b * 16 + qi;
    float q[16];
#pragma unroll
    for (int d = 0; d < 16; ++d) q[d] = bf2f(qkv[qrow * NQKV + hq * 64 + 16 * part + d]);
    const float sink = sinks[hq];
    float sc[16]; float mx = sink;
#pragma unroll
    for (int j = 0; j < 16; ++j) {
        const size_t kr = (size_t)MREAL + b * 16 + j; float s = 0.f;
#pragma unroll
        for (int d = 0; d < 16; ++d) s += q[d] * bf2f(qkv[kr * NQKV + 1024 + kh * 64 + 16 * part + d]);
        s += __shfl_xor(s, 16); s += __shfl_xor(s, 32);
        sc[j] = j <= qi ? s : -1e30f; mx = fmaxf(mx, sc[j]);
    }
    float l = __expf(sink - mx);
#pragma unroll
    for (int j = 0; j < 16; ++j) { sc[j] = __expf(sc[j] - mx); l += sc[j]; }
    const float inv = 1.0f / l;
#pragma unroll
    for (int dd = 0; dd < 16; ++dd) { const int d = 16 * part + dd; float acc = 0.f;
#pragma unroll
        for (int j = 0; j < 16; ++j) acc += sc[j] * bf2f(VT0[((size_t)(b * 2 + kh) * 64 + d) * LP + perm16(j)]);
        o[qrow * D + hq * 64 + d] = f2bf(acc * inv); }
}
__device__ __forceinline__ void swa_phase(LAS unsigned char* lds, const bf16_t* qkv, const bf16_t* VT0, const float* sinks, bf16_t* o, int bid, int nblk) {
    for (int u = bid; u < 256; u += nblk) {
        const int b = u >> 7, n = (u >> 1) & 63, kh = u & 1;
        swa_unit(lds, b, n, kh, qkv, VT0, sinks, o);
        if (n == 0) swa_meta(b, kh * 8 + (threadIdx.x >> 6), qkv, VT0, sinks, o, threadIdx.x & 63);
    }
}

template <int MOE_MT>
__device__ __forceinline__ void moe_unit(LAS unsigned char* lds, int e, int s0, int ns, const int* __restrict__ list, const bf16_t* __restrict__ hb, const float* __restrict__ rstd,
                                         const float* __restrict__ wslot, const bf16_t* __restrict__ wgu, const bf16_t* __restrict__ wd, bf16_t* ybuf, unsigned long long* tsb = nullptr) {
#define MSTAMP(i) do { if (PROBE_PHASE >= 600 && tsb && blockIdx.x == 0 && threadIdx.x == 0) tsb[i] = __builtin_amdgcn_s_memrealtime(); } while (0)
    MSTAMP(20);
    constexpr int MOE_BM = 16 * MOE_MT, MOE_HT = MOE_BM * 128, MOE_B2 = 2 * MOE_HT, MOE_ST2 = 32768, MOE_HLO = MOE_B2 + 2 * MOE_ST2, MOE_INFO = MOE_HLO + 2 * MOE_HT;
    static_assert(MOE_B2 + 2 * MOE_ST2 <= MOE_HLO && MOE_INFO + 3072 <= LDS_MISC, "moe lds");
#define moe_hoff(kt2) ((kt2) < 2 ? MOE_HLO + (kt2) * MOE_HT : ((kt2) - 2) * MOE_HT)
    const int tid = threadIdx.x, lane = tid & 63, wave = __builtin_amdgcn_readfirstlane(tid >> 6);
    LAS int* slotl = (LAS int*)(lds + MOE_INFO); LAS float* rsl = (LAS float*)(lds + MOE_INFO + 1024); LAS float* wl = (LAS float*)(lds + MOE_INFO + 2048);
    if (tid < MOE_BM) { const int sl = list[(size_t)e * CAP + s0 + (tid < ns ? tid : 0)]; slotl[tid] = sl; rsl[tid] = rstd[sl >> 1]; wl[tid] = wslot[sl]; }
    __syncthreads();
    const int lc = (lane & 7) ^ (lane >> 3);
    const int fro = (lane & 15) * 128, fc0 = ((lane >> 4) ^ (lane & 7)) << 4, fc1 = ((4 + (lane >> 4)) ^ (lane & 7)) << 4;
    {
        constexpr int ST = (MOE_BM + 512) * 64, GA = MOE_BM / 16, G = GA + 32, NG = (G + 7) / 8;
        static_assert(2 * ST <= MOE_HLO && 2 * MOE_HT <= ST, "moe gemm1 lds");
        const int lc4 = (lane & 3) ^ swzF(lane >> 4);
        const int fro32 = (lane & 15) * 64 + (((lane >> 4) ^ swzF((lane >> 2) & 3)) << 4);
        const char* src[NG];
#pragma unroll
        for (int i = 0; i < NG; ++i) { const int g = wave + 8 * i;
            if (g < GA) src[i] = (const char*)(hb + (size_t)(slotl[g * 16 + (lane >> 2)] >> 1) * D) + lc4 * 16;
            else if (g < G) src[i] = (const char*)(wgu + (size_t)((g - GA) * 16 + (lane >> 2)) * D) + lc4 * 16;
            else src[i] = nullptr; }
        f32x4 acc[MOE_MT][4];
#pragma unroll
        for (int mi = 0; mi < MOE_MT; ++mi)
#pragma unroll
            for (int ni = 0; ni < 4; ++ni) acc[mi][ni] = (f32x4){0.f, 0.f, 0.f, 0.f};
#define M1_STAGE(st, step) do { _Pragma("unroll") for (int _i = 0; _i < NG; ++_i) { const int _g = wave + 8 * _i; if (_g < G) \
        __builtin_amdgcn_global_load_lds((const unsigned*)(src[_i] + (size_t)(step) * 64), (LAS unsigned*)(lds + (st) * ST + _g * 1024), 16, 0, 0); } } while (0)
        M1_STAGE(0, 0);
        for (int step = 0; step < 32; ++step) {
            asm volatile("s_waitcnt vmcnt(0)" ::: "memory");
            __syncthreads();
            if (step + 1 < 32) M1_STAGE((step + 1) & 1, step + 1);
            LAS const unsigned char* sa = lds + (step & 1) * ST + fro32;
            LAS const unsigned char* sb = lds + (step & 1) * ST + (MOE_BM + wave * 64) * 64 + fro32;
            bf16x8 bfr[4];
#pragma unroll
            for (int ni = 0; ni < 4; ++ni) bfr[ni] = *(LAS const bf16x8*)(sb + ni * 1024);
#pragma unroll
            for (int mi = 0; mi < MOE_MT; ++mi) { const bf16x8 af = *(LAS const bf16x8*)(sa + mi * 1024);
#pragma unroll
                for (int ni = 0; ni < 4; ++ni) acc[mi][ni] = __builtin_amdgcn_mfma_f32_16x16x32_bf16(bfr[ni], af, acc[mi][ni], 0, 0, 0); }
        }
#undef M1_STAGE
        int lane_h = threadIdx.x & 63; asm volatile("" : "+v"(lane_h));
#define lane lane_h
#pragma unroll
        for (int p = 0; p < 2; ++p) {
            const int n = 32 * wave + 16 * p + (lane >> 4) * 4;
            const int csw = ((n & 63) >> 3);
#pragma unroll
            for (int mi = 0; mi < MOE_MT; ++mi) { const int row = mi * 16 + (lane & 15); const float rs = rsl[row]; float hv[4];
#pragma unroll
                for (int r = 0; r < 4; ++r) { const float g = acc[mi][2 * p][r] * rs, u = acc[mi][2 * p + 1][r] * rs; hv[r] = g / (1.0f + __expf(-g)) * u; }
                *(LAS u32x2*)(lds + moe_hoff(n >> 6) + row * 128 + ((csw ^ (row & 7)) << 4) + (n & 4) * 2) = (u32x2){pk2(hv[0], hv[1]), pk2(hv[2], hv[3])}; }
        }
#undef lane
    }
    __syncthreads();
    MSTAMP(21);
    {
        const char* src2[4];
#pragma unroll
        for (int i = 0; i < 4; ++i) src2[i] = (const char*)(wd + (size_t)((wave + 8 * i) * 8 + (lane >> 3)) * DE) + lc * 16;
        f32x4 acc[MOE_MT][2];
#pragma unroll
        for (int mi = 0; mi < MOE_MT; ++mi) { acc[mi][0] = (f32x4){0.f, 0.f, 0.f, 0.f}; acc[mi][1] = (f32x4){0.f, 0.f, 0.f, 0.f}; }
#define M2_STAGE(st, q) do { _Pragma("unroll") for (int _i = 0; _i < 4; ++_i) \
        __builtin_amdgcn_global_load_lds((const unsigned*)(src2[_i] + (size_t)((q) >> 2) * (256 * 512) + (size_t)((q) & 3) * 128), (LAS unsigned*)(lds + MOE_B2 + (st) * MOE_ST2 + (wave + 8 * _i) * 1024), 16, 0, 0); } while (0)
        M2_STAGE(0, 0);
        for (int q = 0; q < 16; ++q) {
            asm volatile("s_waitcnt vmcnt(0)" ::: "memory");
            __syncthreads();
            if (q + 1 < 16) M2_STAGE((q + 1) & 1, q + 1);
            LAS const unsigned char* sa = lds + moe_hoff(q & 3) + fro;
            LAS const unsigned char* sb = lds + MOE_B2 + (q & 1) * MOE_ST2 + (wave * 32) * 128 + fro;
#pragma unroll
            for (int ks = 0; ks < 2; ++ks) { const int fc = ks ? fc1 : fc0;
                const bf16x8 b0 = *(LAS const bf16x8*)(sb + fc), b1 = *(LAS const bf16x8*)(sb + 2048 + fc);
#pragma unroll
                for (int mi = 0; mi < MOE_MT; ++mi) { const bf16x8 af = *(LAS const bf16x8*)(sa + mi * 2048 + fc);
                    acc[mi][0] = __builtin_amdgcn_mfma_f32_16x16x32_bf16(b0, af, acc[mi][0], 0, 0, 0);
                    acc[mi][1] = __builtin_amdgcn_mfma_f32_16x16x32_bf16(b1, af, acc[mi][1], 0, 0, 0); }
            }
            if ((q & 3) == 3) {
                const int cb = (q >> 2) * 256 + wave * 32 + (lane >> 4) * 4;
#pragma unroll
                for (int mi = 0; mi < MOE_MT; ++mi) { const int row = mi * 16 + (lane & 15);
                    if (row < ns) { const float w = wl[row]; bf16_t* yr = ybuf + (size_t)slotl[row] * D + cb;
#pragma unroll
                        for (int ni = 0; ni < 2; ++ni) { const f32x4 v = acc[mi][ni] * w; *(u32x2*)(yr + ni * 16) = (u32x2){pk2(v[0], v[1]), pk2(v[2], v[3])}; } }
                    acc[mi][0] = (f32x4){0.f, 0.f, 0.f, 0.f}; acc[mi][1] = (f32x4){0.f, 0.f, 0.f, 0.f}; }
            }
        }
#undef M2_STAGE
    }
#undef moe_hoff
    __syncthreads();
    MSTAMP(22);
#undef MSTAMP
}
__device__ __forceinline__ void moe_phase(LAS unsigned char* lds, int* cnt, const int* list, const bf16_t* hb, const float* rstd, const float* wslot, const bf16_t* wgu, const bf16_t* wd, bf16_t* ybuf, int bid, int nblk, unsigned long long* tsb = nullptr) {
    const bool grp = (nblk % 8) == 0;
    int ntile[NE]; int gsum = 0; bool fit = grp;
#pragma unroll
    for (int e = 0; e < NE; ++e) { const int c = __hip_atomic_load(cnt + e * 64, __ATOMIC_RELAXED, __HIP_MEMORY_SCOPE_AGENT); const int bm = 144; ntile[e] = (c + bm - 1) / bm;
        gsum = (e & 3) == 0 ? ntile[e] : gsum + ntile[e]; if ((e & 3) == 3 && gsum > nblk / 8) fit = false; }
    const int x = bid % 8;
    int u = fit ? bid / 8 : (grp ? x * (nblk / 8) + bid / 8 : bid), base = 0;
    const int stride = fit ? nblk / 8 : nblk;
#pragma unroll 1
    for (int e = 0; e < NE; ++e) {
        if (fit && (e >> 2) != x) continue;
        const int c = __hip_atomic_load(cnt + e * 64, __ATOMIC_RELAXED, __HIP_MEMORY_SCOPE_AGENT);
        const bool big = false; const int bm = 144, nt = (c + bm - 1) / bm;
        while (u < base + nt) { const int t = u - base; const int ns = c - t * bm < bm ? c - t * bm : bm;
            moe_unit<9>(lds, e, t * bm, ns, list, hb, rstd, wslot, wgu + (size_t)e * 512 * 1024, wd + (size_t)e * 1024 * 256, ybuf, tsb);
            u += stride; }
        base += nt;
    }
}

template <int MT>
__device__ __forceinline__ void l1proj_unit(LAS unsigned char* lds, int row0, int mrow0, bf16_t* hb, const bf16_t* __restrict__ ybuf, const bf16_t* __restrict__ win_t, const bf16_t* __restrict__ wuq_t,
                                            const bf16_t* __restrict__ wukv_t, const float2* __restrict__ cs, bf16_t* kpe, bf16_t* Q1, bf16_t* K1, bf16_t* VT1) {
    constexpr int BM = 16 * MT, STW = (BM + 512) * 64, KT = BM * 64  , CQN = 0, CKV = 8 * KT, RB = 12 * KT, STB = 32768, PART = 3 * STW;
    static_assert(RB + 3 * STB <= LDS_MISC && PART + 8 * BM * 4 <= LDS_MISC, "l1proj lds");
    const int tid = threadIdx.x, lane = tid & 63, wave = __builtin_amdgcn_readfirstlane(tid >> 6);
    LAS float* rsl = (LAS float*)(lds + LDS_MISC + 256);
#define L1_GROW(r) ((r) < 64 ? row0 + (r) : mrow0 + (r) - 64)
    for (int r = wave; r < BM; r += NWAVE) {
        const size_t grow = L1_GROW(r); float ss = 0.f;
#pragma unroll
        for (int j = 0; j < 4; ++j) { const size_t c = j * 256 + lane * 4;
            const u32x2 h = *(const u32x2*)(hb + grow * D + c), y0 = *(const u32x2*)(ybuf + (grow * 2) * D + c), y1 = *(const u32x2*)(ybuf + (grow * 2 + 1) * D + c);
            float v[4];
            v[0] = __uint_as_float(h.x << 16) + __uint_as_float(y0.x << 16) + __uint_as_float(y1.x << 16);
            v[1] = __uint_as_float(h.x & 0xffff0000u) + __uint_as_float(y0.x & 0xffff0000u) + __uint_as_float(y1.x & 0xffff0000u);
            v[2] = __uint_as_float(h.y << 16) + __uint_as_float(y0.y << 16) + __uint_as_float(y1.y << 16);
            v[3] = __uint_as_float(h.y & 0xffff0000u) + __uint_as_float(y0.y & 0xffff0000u) + __uint_as_float(y1.y & 0xffff0000u);
            ss += v[0] * v[0] + v[1] * v[1] + v[2] * v[2] + v[3] * v[3];
            *(u32x2*)(hb + grow * D + c) = (u32x2){pk2(v[0], v[1]), pk2(v[2], v[3])}; }
        ss = wave_sum(ss); if (lane == 0) rsl[r] = rsqrtf(ss * (1.0f / D) + EPS);
    }
    asm volatile("s_waitcnt vmcnt(0)" ::: "memory");
    __syncthreads();
    const int lc = (lane & 3) ^ swzF(lane >> 4);
    const int fro = (lane & 15) * 64 + (((lane >> 4) ^ swzF((lane >> 2) & 3)) << 4);
    f32x4 acc[MT][4];
#pragma unroll
    for (int mi = 0; mi < MT; ++mi)
#pragma unroll
        for (int ni = 0; ni < 4; ++ni) acc[mi][ni] = (f32x4){0.f, 0.f, 0.f, 0.f};
    {
        const char* srcb[4];
#pragma unroll
        for (int i = 0; i < 4; ++i) srcb[i] = (const char*)(win_t + (size_t)((wave + 8 * i) * 16 + (lane >> 2)) * D) + lc * 16;
        const char* srca = (const char*)(hb + (size_t)L1_GROW((wave < MT ? wave : 0) * 16 + (lane >> 2)) * D) + lc * 16;
#define W_ISSUE(st, kt) do { if (wave < MT) __builtin_amdgcn_global_load_lds((const unsigned*)(srca + (size_t)(kt) * 64), (LAS unsigned*)(lds + (st) * STW + wave * 1024), 16, 0, 16); \
        _Pragma("unroll") for (int _i = 0; _i < 4; ++_i) __builtin_amdgcn_global_load_lds((const unsigned*)(srcb[_i] + (size_t)(kt) * 64), (LAS unsigned*)(lds + (st) * STW + (MT + wave + 8 * _i) * 1024), 16, 0, 0); } while (0)
        W_ISSUE(0, 0); W_ISSUE(1, 1);
        int st = 0;
        for (int kt = 0; kt < 32; ++kt) {
            if (kt + 1 < 32) { if (wave < MT) wait_vm<5>(); else wait_vm<4>(); } else wait_vm<0>();
            __builtin_amdgcn_s_barrier(); asm volatile("" ::: "memory");
            if (kt + 2 < 32) W_ISSUE(st == 0 ? 2 : st - 1, kt + 2);
            LAS const unsigned char* sa = lds + st * STW + fro;
            LAS const unsigned char* sb = lds + st * STW + (BM + wave * 64) * 64 + fro;
            bf16x8 bfr[4];
#pragma unroll
            for (int ni = 0; ni < 4; ++ni) bfr[ni] = *(LAS const bf16x8*)(sb + ni * 1024);
#pragma unroll
            for (int mi = 0; mi < MT; ++mi) { const bf16x8 af = *(LAS const bf16x8*)(sa + mi * 1024);
#pragma unroll
                for (int ni = 0; ni < 4; ++ni) acc[mi][ni] = __builtin_amdgcn_mfma_f32_16x16x32_bf16(bfr[ni], af, acc[mi][ni], 0, 0, 0); }
            st = st == 2 ? 0 : st + 1;
        }
#undef W_ISSUE
    }
    asm volatile("s_waitcnt lgkmcnt(0)" ::: "memory");
    __syncthreads();
    LAS float* part = (LAS float*)(lds + PART);
    int lane_e = lane; asm volatile("" : "+v"(lane_e));
#define lane lane_e
#pragma unroll
    for (int mi = 0; mi < MT; ++mi) { const float rs = rsl[mi * 16 + (lane & 15)]; float ss = 0.f;
#pragma unroll
        for (int ni = 0; ni < 4; ++ni) { acc[mi][ni] = acc[mi][ni] * rs; ss += acc[mi][ni][0] * acc[mi][ni][0] + acc[mi][ni][1] * acc[mi][ni][1] + acc[mi][ni][2] * acc[mi][ni][2] + acc[mi][ni][3] * acc[mi][ni][3]; }
        ss += __shfl_xor(ss, 16); ss += __shfl_xor(ss, 32);
        if (lane < 16) part[wave * BM + mi * 16 + lane] = ss; }
    __syncthreads();
    if (wave < 6) {
#pragma unroll
        for (int mi = 0; mi < MT; ++mi) { const int row = mi * 16 + (lane & 15);
            const float tot = wave < 4 ? (part[row] + part[BM + row]) + (part[2 * BM + row] + part[3 * BM + row]) : part[4 * BM + row] + part[5 * BM + row];
            const float rn = rsqrtf(tot * (wave < 4 ? 1.0f / 256 : 1.0f / 128) + EPS);
#pragma unroll
            for (int ni = 0; ni < 4; ++ni) { const int cc = (wave < 4 ? 64 * wave : 64 * (wave - 4)) + ni * 16 + (lane >> 4) * 4; const f32x4 v = acc[mi][ni] * rn;
                *(LAS u32x2*)(lds + (wave < 4 ? CQN : CKV) + (cc >> 5) * KT + row * 64 + (((((cc & 31) >> 3)) ^ swzF((row >> 2) & 3)) << 4) + (cc & 4) * 2) = (u32x2){pk2(v[0], v[1]), pk2(v[2], v[3])}; } }
    } else if (wave == 6) {
#pragma unroll
        for (int mi = 0; mi < MT; ++mi) { const int row = mi * 16 + (lane & 15); const int grow = L1_GROW(row); const int pos = row_pos(grow), d0 = (lane >> 4) * 4;
            f32x4 o1, o2;
#pragma unroll
            for (int r = 0; r < 4; ++r) { const float2 t = cs[pos * 32 + 2 * (d0 + r)]; const float x1 = acc[mi][0][r], x2 = acc[mi][1][r]; o1[r] = x1 * t.x - x2 * t.y; o2[r] = x2 * t.x + x1 * t.y; }
            bf16_t* kr = kpe + ((size_t)row_batch(grow) * LP + pos) * 32;
            *(u32x2*)(kr + d0) = (u32x2){pk2(o1[0], o1[1]), pk2(o1[2], o1[3])}; *(u32x2*)(kr + 16 + d0) = (u32x2){pk2(o2[0], o2[1]), pk2(o2[2], o2[3])}; }
    }
#undef lane
    __syncthreads();
    const char* srcu[4];
#define U_ISSUE(st, base, pitchB, chunk, kt) do { _Pragma("unroll") for (int _i = 0; _i < 4; ++_i) \
        __builtin_amdgcn_global_load_lds((const unsigned*)(srcu[_i] + (size_t)(chunk) * 512 * (pitchB) + (size_t)(kt) * 64), (LAS unsigned*)(lds + RB + (st) * STB + (wave + 8 * _i) * 1024), 16, 0, 0); } while (0)
    {
#pragma unroll
        for (int i = 0; i < 4; ++i) srcu[i] = (const char*)(wuq_t + (size_t)((wave + 8 * i) * 16 + (lane >> 2)) * 256) + lc * 16;
#pragma unroll
        for (int mi = 0; mi < MT; ++mi)
#pragma unroll
            for (int ni = 0; ni < 4; ++ni) acc[mi][ni] = (f32x4){0.f, 0.f, 0.f, 0.f};
        U_ISSUE(0, 0, 512, 0, 0); U_ISSUE(1, 0, 512, 0, 1);
        int st = 0;
        for (int q = 0; q < 24; ++q) {
            if (q + 1 < 24) wait_vm<4>(); else wait_vm<0>();
            __builtin_amdgcn_s_barrier(); asm volatile("" ::: "memory");
            if (q + 2 < 24) U_ISSUE(st == 0 ? 2 : st - 1, 0, 512, (q + 2) >> 3, (q + 2) & 7);
            LAS const unsigned char* sa = lds + CQN + (q & 7) * KT + fro;
            LAS const unsigned char* sb = lds + RB + st * STB + (wave * 64) * 64 + fro;
            bf16x8 bfr[4];
#pragma unroll
            for (int ni = 0; ni < 4; ++ni) bfr[ni] = *(LAS const bf16x8*)(sb + ni * 1024);
#pragma unroll
            for (int mi = 0; mi < MT; ++mi) { const bf16x8 af = *(LAS const bf16x8*)(sa + mi * 1024);
#pragma unroll
                for (int ni = 0; ni < 4; ++ni) acc[mi][ni] = __builtin_amdgcn_mfma_f32_16x16x32_bf16(bfr[ni], af, acc[mi][ni], 0, 0, 0); }
            if ((q & 7) == 7) {
                int lane_q = lane; asm volatile("" : "+v"(lane_q));
#define lane lane_q
                const float scale = 0.10206207261596577f * 1.4426950408889634f; const int d0 = (lane >> 4) * 4;
#pragma unroll
                for (int mi = 0; mi < MT; ++mi) { const int grow = L1_GROW(mi * 16 + (lane & 15)); const int pos = row_pos(grow);
#pragma unroll
                    for (int bi = 0; bi < 2; ++bi) { const int gc = (q >> 3) * 512 + 64 * wave + bi * 32; bf16_t* orow = Q1 + (size_t)grow * 1536 + gc;
                        f32x4 v1 = acc[mi][2 * bi], v2 = acc[mi][2 * bi + 1];
                        if (((gc >> 5) % 3) == 2) {
#pragma unroll
                            for (int r = 0; r < 4; ++r) { const float2 t = cs[pos * 32 + 2 * (d0 + r)]; const float x1 = v1[r], x2 = v2[r]; v1[r] = x1 * t.x - x2 * t.y; v2[r] = x2 * t.x + x1 * t.y; } }
                        v1 = v1 * scale; v2 = v2 * scale;
                        *(u32x2*)(orow + d0) = (u32x2){pk2(v1[0], v1[1]), pk2(v1[2], v1[3])}; *(u32x2*)(orow + 16 + d0) = (u32x2){pk2(v2[0], v2[1]), pk2(v2[2], v2[3])}; }
#pragma unroll
                    for (int ni = 0; ni < 4; ++ni) acc[mi][ni] = (f32x4){0.f, 0.f, 0.f, 0.f}; }
#undef lane
            }
            st = st == 2 ? 0 : st + 1;
        }
    }
    asm volatile("s_waitcnt lgkmcnt(0)" ::: "memory");
    __syncthreads();
    {
#pragma unroll
        for (int i = 0; i < 4; ++i) srcu[i] = (const char*)(wukv_t + (size_t)((wave + 8 * i) * 16 + (lane >> 2)) * 128) + lc * 16;
#pragma unroll
        for (int mi = 0; mi < MT; ++mi)
#pragma unroll
            for (int ni = 0; ni < 4; ++ni) acc[mi][ni] = (f32x4){0.f, 0.f, 0.f, 0.f};
        U_ISSUE(0, 0, 256, 0, 0); U_ISSUE(1, 0, 256, 0, 1);
        int st = 0;
        for (int q = 0; q < 16; ++q) {
            if (q + 1 < 16) wait_vm<4>(); else wait_vm<0>();
            __builtin_amdgcn_s_barrier(); asm volatile("" ::: "memory");
            if (q + 2 < 16) U_ISSUE(st == 0 ? 2 : st - 1, 0, 256, (q + 2) >> 2, (q + 2) & 3);
            LAS const unsigned char* sa = lds + CKV + (q & 3) * KT + fro;
            LAS const unsigned char* sb = lds + RB + st * STB + (wave * 64) * 64 + fro;
            bf16x8 bfr[4];
#pragma unroll
            for (int ni = 0; ni < 4; ++ni) bfr[ni] = *(LAS const bf16x8*)(sb + ni * 1024);
            if (q < 8) {
#pragma unroll
                for (int mi = 0; mi < MT; ++mi) { const bf16x8 af = *(LAS const bf16x8*)(sa + mi * 1024);
#pragma unroll
                    for (int ni = 0; ni < 4; ++ni) acc[mi][ni] = __builtin_amdgcn_mfma_f32_16x16x32_bf16(bfr[ni], af, acc[mi][ni], 0, 0, 0); }
            } else {
#pragma unroll
                for (int mi = 0; mi < MT; ++mi) { const bf16x8 af = *(LAS const bf16x8*)(sa + mi * 1024);
#pragma unroll
                    for (int ni = 0; ni < 4; ++ni) acc[mi][ni] = __builtin_amdgcn_mfma_f32_16x16x32_bf16(af, bfr[ni], acc[mi][ni], 0, 0, 0); }
            }
            if ((q & 3) == 3) {
                const int ch = q >> 2;
                int lane_k = lane; asm volatile("" : "+v"(lane_k));
#define lane lane_k
                if (ch < 2) {
#pragma unroll
                    for (int mi = 0; mi < MT; ++mi) { const int grow = L1_GROW(mi * 16 + (lane & 15)); const size_t kr = (size_t)row_batch(grow) * LP + row_pos(grow);
#pragma unroll
                        for (int ni = 0; ni < 4; ++ni) { const f32x4 v = acc[mi][ni];
                            *(u32x2*)(K1 + kr * D + 512 * ch + 64 * wave + ni * 16 + (lane >> 4) * 4) = (u32x2){pk2(v[0], v[1]), pk2(v[2], v[3])}; acc[mi][ni] = (f32x4){0.f, 0.f, 0.f, 0.f}; } }
                } else {
#pragma unroll
                    for (int mi = 0; mi < MT; ++mi) { const int grow0 = L1_GROW(mi * 16 + (lane >> 4) * 4); const int b = row_batch(grow0), pp = perm16(row_pos(grow0));
#pragma unroll
                        for (int ni = 0; ni < 4; ++ni) { const int hd = 512 * (ch - 2) + 64 * wave + ni * 16 + (lane & 15); const f32x4 v = acc[mi][ni];
                            *(u32x2*)(VT1 + (size_t)(b * 1024 + hd) * LP + pp) = (u32x2){pk2(v[0], v[1]), pk2(v[2], v[3])}; acc[mi][ni] = (f32x4){0.f, 0.f, 0.f, 0.f}; } }
                }
#undef lane
            }
            st = st == 2 ? 0 : st + 1;
        }
    }
#undef U_ISSUE
#undef L1_GROW
    asm volatile("s_waitcnt lgkmcnt(0)" ::: "memory");
    __syncthreads();
}
__device__ __forceinline__ void l1proj_phase(LAS unsigned char* lds, bf16_t* hb, const bf16_t* ybuf, const bf16_t* win_t, const bf16_t* wuq_t, const bf16_t* wukv_t, const float2* cs, bf16_t* kpe,
                                             bf16_t* Q1, bf16_t* K1, bf16_t* VT1, int bid, int nblk) {
    { const int gt = bid * NTHR + threadIdx.x, ngt = nblk * NTHR;
      for (int idx = gt; idx < 2 * 48 * 1024; idx += ngt) { const int b = idx / (48 * 1024), r = idx % (48 * 1024); K1[((size_t)b * LP + 8208) * 1024 + r] = 0; }
      for (int idx = gt; idx < 2 * 16 * 64 * 48; idx += ngt) { const int rr = idx / 48, c = idx % 48; VT1[(size_t)rr * LP + 8208 + c] = 0; } }
    for (int u = bid; u < 256; u += nblk) {
        if (u >= 254) l1proj_unit<5>(lds, u * 64, MREAL + (u - 254) * 16, hb, ybuf, win_t, wuq_t, wukv_t, cs, kpe, Q1, K1, VT1);
        else l1proj_unit<4>(lds, u * 64, MREAL, hb, ybuf, win_t, wuq_t, wukv_t, cs, kpe, Q1, K1, VT1);
    }
}

struct EpiNull { int m0, n0;
    template <int MT, int NT> __device__ __forceinline__ void operator()(f32x4 (&acc)[MT][NT], int, int, int) const {
#pragma unroll
        for (int mi = 0; mi < MT; ++mi)
#pragma unroll
            for (int ni = 0; ni < NT; ++ni) asm volatile("" :: "v"(acc[mi][ni])); } };
__device__ __forceinline__ void transpose_item(const float* __restrict__ W, int N, const float* __restrict__ gain, bf16_t* dst, int ldk, int drow0, int k0, int n0, LAS float* scr, int lane, int dskip = 0) {
#pragma unroll 8
    for (int i = 0; i < 32; ++i) { const int kk = 2 * i + (lane >> 5); float v = W[(size_t)(k0 + kk) * N + n0 + (lane & 31)]; if (gain) v *= gain[k0 + kk]; scr[kk * 33 + (lane & 31)] = v; }
    asm volatile("s_waitcnt lgkmcnt(0)" ::: "memory");
    const int c = lane & 7;
#pragma unroll
    for (int j = 0; j < 4; ++j) { const int n = (lane >> 3) + 8 * j; const LAS float* s = scr + (8 * c) * 33 + n;
        u32x4 o; o.x = pk2(s[0 * 33], s[1 * 33]); o.y = pk2(s[2 * 33], s[3 * 33]); o.z = pk2(s[4 * 33], s[5 * 33]); o.w = pk2(s[6 * 33], s[7 * 33]);
        *(u32x4*)(dst + (size_t)(drow0 + n + (n >= 16 ? dskip : 0)) * ldk + k0 + 8 * c) = o; }
    asm volatile("s_waitcnt lgkmcnt(0)" ::: "memory");
}
__device__ __forceinline__ void moe_convert_item(const float* __restrict__ src, int pitch  , const float* __restrict__ gain  , bf16_t* dst, int ldk, int kind  , int nrow0, LAS float* T) {
    const int tid = threadIdx.x;
#pragma unroll
    for (int i = 0; i < 8; ++i) { const int idx = tid + i * NTHR, k = idx >> 6, c4 = idx & 63;
        f32x4 v = *(const f32x4*)(src + (size_t)k * pitch + c4 * 4); if (gain) v = v * gain[k];
        LAS float* t = T + k * 257 + c4 * 4; t[0] = v[0]; t[1] = v[1]; t[2] = v[2]; t[3] = v[3]; }
    __syncthreads();
#pragma unroll
    for (int i = 0; i < 4; ++i) { const int idx = tid + i * NTHR, kc = idx & 7, n = idx >> 3;
        const LAS float* t = T + (8 * kc) * 257 + n;
        u32x4 o; o.x = pk2(t[0], t[257]); o.y = pk2(t[2 * 257], t[3 * 257]); o.z = pk2(t[4 * 257], t[5 * 257]); o.w = pk2(t[6 * 257], t[7 * 257]);
        const int row = kind == 2 ? nrow0 + n : (n >> 4) * 32 + kind * 16 + (n & 15);
        *(u32x4*)(dst + (size_t)row * ldk + 8 * kc) = o; }
    __syncthreads();
}
__device__ __forceinline__ void moe_weight_items(const float* wgate, const float* wup, const float* wdown, const float* gain, bf16_t* wgu_t, bf16_t* wd_t, LAS float* T, int bid, int nblk) {
    for (int it = bid; it < NE * 48; it += nblk) {
        const int e = it / 48, r = it % 48, which = r >> 4, q = r & 15;
        if (which < 2) moe_convert_item((which ? wup : wgate) + (size_t)e * D * DE + (size_t)q * 64 * DE, DE, gain + q * 64, wgu_t + (size_t)e * 512 * 1024 + q * 64, 1024, which, 0, T);
        else { const int kb = q >> 2, nb = q & 3;
            moe_convert_item(wdown + (size_t)e * DE * D + (size_t)kb * 64 * D + nb * 256, D, nullptr, wd_t + (size_t)e * 1024 * 256 + kb * 64, 256, 2, nb * 256, T); }
    }
}
__device__ __forceinline__ void p0_prologue(const MArgs& a, LAS unsigned char* lds, int bid, int nblk) {
    const int tid = threadIdx.x, lane = tid & 63, wave = __builtin_amdgcn_readfirstlane(tid >> 6);
    const int gw = bid * NWAVE + wave, ngw = nblk * NWAVE, gt = bid * NTHR + tid, ngt = nblk * NTHR;
    unsigned char* ws = a.ws;
    float2* cs = (float2*)(ws + WS_ROPE);
    for (int _r = 0; _r < (PROBE_PHASE == 301 ? 2 : 1); ++_r)
    for (int idx = gt; idx < LPOS * 32; idx += ngt) { const int pos = idx >> 5, i = idx & 31; const float inv = 1.0f / powf(10000.0f, (float)(2 * i) / 64.0f); float s, c; sincosf((float)pos * inv, &s, &c); cs[idx] = make_float2(c, s); }
    float* wrf = (float*)(ws + W2_WRF);
    for (int idx = gt; idx < 2 * 36 * 1024; idx += ngt) { const int l = idx / (36 * 1024), j = (idx >> 10) % 36, k = idx & 1023;
        const float g = a.in[3][l * D + k]; wrf[idx] = g * (j < 4 ? a.in[16][(size_t)l * D * 4 + k * 4 + j] : a.in[18][(size_t)l * D * 32 + k * 32 + (j - 4)]); }
    { u32x4* z = (u32x4*)(ws + W2_WIN + (size_t)416 * 1024 * 2); for (int idx = gt; idx < 96 * 1024 * 2 / 16; idx += ngt) z[idx] = (u32x4){0u, 0u, 0u, 0u}; }
    { bf16_t* kpe = (bf16_t*)(ws + WS_KPE); for (int idx = gt; idx < 2 * 48 * 32; idx += ngt) { const int b = idx / (48 * 32), r = idx % (48 * 32); kpe[((size_t)b * LP + 8208) * 32 + r] = 0; }
      bf16_t* vt0 = (bf16_t*)(ws + B_VT0); for (int idx = gt; idx < 2 * 2 * 64 * 48; idx += ngt) { const int rr = idx / 48, c = idx % 48; vt0[(size_t)rr * LP + 8208 + c] = 0; } }
    { bf16_t* hb = (bf16_t*)(ws + W2_HB); float* rstd = (float*)(ws + W2_RSTD);
      for (int _r = 0; _r < (PROBE_PHASE == 303 ? 2 : 1); ++_r)
      for (int row = gw; row < MTOT; row += ngw) {
        const float* src = row < MREAL ? a.in[0] + (size_t)row * D : a.in[1] + (size_t)row_pos(row) * D;
        float ss = 0.f;
#pragma unroll
        for (int j = 0; j < 4; ++j) { const f32x4 v = *(const f32x4*)(src + j * 256 + lane * 4); ss += v[0] * v[0] + v[1] * v[1] + v[2] * v[2] + v[3] * v[3];
            *(u32x2*)(hb + (size_t)row * D + j * 256 + lane * 4) = (u32x2){pk2(v[0], v[1]), pk2(v[2], v[3])}; }
        ss = wave_sum(ss); if (lane == 0) rstd[row] = rsqrtf(ss * (1.0f / D) + EPS);
      } }
    LAS float* scr = (LAS float*)(lds + wave * 16384);
    for (int _r = 0; _r < (PROBE_PHASE == 304 ? 2 : 1); ++_r)
    for (int it = gw; it < 2192; it += ngw) {
        int r = it;
        if (r < 640) { transpose_item(a.in[5], NQKV, a.in[2], (bf16_t*)(ws + W2_WQKV), 1024, (r % 40) * 32, (r / 40) * 64, (r % 40) * 32, scr, lane); continue; } r -= 640;
        if (r < 512) { transpose_item(a.in[8], D, nullptr, (bf16_t*)(ws + W2_WO0), 1024, (r & 31) * 32, (r >> 5) * 64, (r & 31) * 32, scr, lane); continue; } r -= 512;
        if (r < 208) { transpose_item(a.in[10], 416, a.in[2] + D, (bf16_t*)(ws + W2_WIN), 1024, (r % 13) * 32, (r / 13) * 64, (r % 13) * 32, scr, lane); continue; } r -= 208;
        if (r < 192) { transpose_item(a.in[13], 1536, a.in[11], (bf16_t*)(ws + W2_WUQ), 256, (r % 48) * 32, (r / 48) * 64, (r % 48) * 32, scr, lane); continue; } r -= 192;
        if (r < 128) { const int nb32 = r & 63, hh = nb32 >> 2, part = nb32 & 3;
            transpose_item(a.in[14], 2048, a.in[12], (bf16_t*)(ws + W2_WUKV), 128, part < 2 ? hh * 64 + part * 32 : 1024 + hh * 64 + (part - 2) * 32, (r >> 6) * 64, nb32 * 32, scr, lane); continue; } r -= 128;
        transpose_item(a.in[15], D, nullptr, (bf16_t*)(ws + W2_WO1), 1024, (r & 31) * 32, (r >> 5) * 64, (r & 31) * 32, scr, lane);
    }
    __syncthreads();
    moe_weight_items(a.in[20], a.in[21], a.in[22], a.in[3], (bf16_t*)(ws + C_W0), (bf16_t*)(ws + C_W0 + MOE_WGU_BYTES), (LAS float*)lds, bid, nblk);
}

template <bool NSW, bool HALFN, class MakeEpi>
__device__ __forceinline__ void gemm_phase(LAS unsigned char* lds, const bf16_t* A, int lda, const bf16_t* Bt, int K, int pn0, int pn1, int bid, int nblk, const MakeEpi& mk) {
    constexpr int BN = HALFN ? 128 : 256;
    const int ntn = pn1 - pn0;
    const bool grp = (nblk % 8) == 0;
    const int x = grp ? bid % 8 : 0, j = grp ? bid / 8 : bid, nslot = grp ? nblk / 8 : nblk, pmg = grp ? 8 : 64;
    for (int u = j; u < pmg * ntn; u += nslot) {
        const int pm = x * pmg + u / ntn, pn = pn0 + u % ntn;
        RowDense ra{A, lda, pm * 256, MTOT - 1}; auto e = mk(pm * 256, pn * BN);
        if (HALFN) gemm_tile<4, 4, 4, 2, NSW>(lds, ra, Bt + (size_t)pn * BN * K, K, K / 32, e);
        else gemm_tile<8, 4, 2, 4, NSW>(lds, ra, Bt + (size_t)pn * BN * K, K, K / 32, e);
    }
    const int nfull = (pmg * ntn + nslot - 1) / nslot;
    for (int pn = pn0; pn < pn1; ++pn) {
        const int owner = (pn - pn0) * 37 % nblk;
        if (bid == owner) { RowDense ra{A, lda, MREAL, MTOT - 1}; auto e = mk(MREAL, pn * BN);
            if (HALFN) gemm_tile<1, 4, 4, 2, NSW>(lds, ra, Bt + (size_t)pn * BN * K, K, K / 32, e);
            else gemm_tile<1, 4, 2, 4, NSW>(lds, ra, Bt + (size_t)pn * BN * K, K, K / 32, e); }
    }
    (void)nfull;
}

constexpr int PH_PROLOGUE = 0, PH_QKV = 1, PH_SWA = 2, PH_OPROJ0 = 3, PH_ROUTE0 = 4, PH_MOE0 = 5, PH_COMBINE = 6, PH_WIN = 7, PH_CEPI = 8, PH_UQKV = 9, PH_MLA = 10, PH_OPROJ1 = 11, PH_ROUTE1 = 12, PH_MOE1 = 13, PH_FINAL = 14, PH_N = 15;
__global__ void __launch_bounds__(NTHR, 2) mega(MArgs a) {
    extern __shared__ __attribute__((aligned(16))) unsigned char lds_raw[];
    LAS unsigned char* lds = (LAS unsigned char*)lds_raw;
    const int tid = threadIdx.x, bid = blockIdx.x, nblk = gridDim.x;
    volatile LAS unsigned* misc = (volatile LAS unsigned*)(lds + LDS_MISC);
    if (tid < 64) misc[tid] = 0u;
    __syncthreads();
    unsigned char* ws = a.ws;
    XcdBarrier bar = xcd_barrier_post((unsigned*)(ws + WS_BAR) + a.li * XCD_BAR_WORDS, misc);
    if (tid == 0) misc[4] = xb_add((unsigned*)(ws + 32 * 1024) + 64 * bar.x, 1u);
    const int lo = a.ph_lo, hi = a.ph_hi;
#define IN(k) (lo <= (k) && (k) < hi)
#define REP(k) for (int _rep = 0; _rep < ((k) == PROBE_PHASE ? 2 : 1); ++_rep, (void)((k) == PROBE_PHASE && _rep == 1 ? (xcd_barrier(bar), 0) : 0))
#define STAMP(i) do { if (PROBE_PHASE >= 600 && bid == 0 && tid == 0) ((unsigned long long*)(ws + 512 * 1024))[i] = __builtin_amdgcn_s_memrealtime(); } while (0)
#define SEAM(k) do { if (IN(k) && IN((k) + 1)) xcd_barrier(bar); STAMP((k) + 1); } while (0)
    STAMP(0);
    if (IN(PH_PROLOGUE)) REP(PH_PROLOGUE) p0_prologue(a, lds, bid, nblk);
    SEAM(PH_PROLOGUE);
    int vbid = bid;
    if (IN(PH_PROLOGUE) && IN(PH_QKV)) {
        if (tid == 0) { bool ok = (nblk % 8) == 0 && bar.x < 8;
            for (int j = 0; j < 8; ++j) ok = ok && xb_ld((unsigned*)(ws + 32 * 1024) + 64 * j) == (unsigned)(nblk / 8);
            misc[5] = ok ? misc[4] * 8u + bar.x : (unsigned)bid; }
        __syncthreads();
        vbid = __builtin_amdgcn_readfirstlane((int)misc[5]);
    }
#define bid vbid
    if (IN(PH_QKV)) REP(PH_QKV) {
        const float* rstd = (const float*)(ws + W2_RSTD); const float* bias = a.in[6]; const float2* cs = (const float2*)(ws + WS_ROPE); bf16_t* qkv = (bf16_t*)(ws + B_QKV); bf16_t* vt0 = (bf16_t*)(ws + B_VT0);
        const bf16_t* hbA = (const bf16_t*)(ws + W2_HB); const bf16_t* Wt = (const bf16_t*)(ws + W2_WQKV);
        const bool grp = (nblk % 8) == 0; const int x = grp ? bid % 8 : 0, j = grp ? bid / 8 : bid, nslot = grp ? nblk / 8 : nblk, pmg = grp ? 8 : 64;
        for (int u = j; u < pmg * 6; u += nslot) {
            if (u < pmg * 4) { const int pm = x * pmg + (u >> 2), pn = u & 3; RowDense ra{hbA, D, pm * 256, MTOT - 1}; EpiQKV e{rstd, bias, cs, qkv, pm * 256, pn * 256};
                gemm_tile<8, 4, 2, 4, false>(lds, ra, Wt + (size_t)pn * 256 * D, D, D / 32, e);
            } else if (u < pmg * 5) { const int pm = x * pmg + (u - pmg * 4); RowDense ra{hbA, D, pm * 256, MTOT - 1}; EpiQKV e{rstd, bias, cs, qkv, pm * 256, 1024};
                gemm_tile<4, 4, 4, 2, false>(lds, ra, Wt + (size_t)1024 * D, D, D / 32, e);
            } else { const int pm = x * pmg + (u - pmg * 5); RowDense ra{hbA, D, pm * 256, MTOT - 1}; EpiV0 e{rstd, bias, vt0, pm * 256, 1152};
                gemm_tile<4, 4, 4, 2, true>(lds, ra, Wt + (size_t)1152 * D, D, D / 32, e);
            }
        }
        const int mu = bid - (nblk - 6);
        if (mu >= 0 && mu < 4) { RowDense ra{hbA, D, MREAL, MTOT - 1}; EpiQKV e{rstd, bias, cs, qkv, MREAL, mu * 256};
            gemm_tile<1, 4, 2, 4, false>(lds, ra, Wt + (size_t)mu * 256 * D, D, D / 32, e);
        } else if (mu == 4) { RowDense ra{hbA, D, MREAL, MTOT - 1}; EpiQKV e{rstd, bias, cs, qkv, MREAL, 1024};
            gemm_tile<1, 4, 4, 2, false>(lds, ra, Wt + (size_t)1024 * D, D, D / 32, e);
        } else if (mu == 5) { RowDense ra{hbA, D, MREAL, MTOT - 1}; EpiV0 e{rstd, bias, vt0, MREAL, 1152};
            gemm_tile<1, 4, 4, 2, true>(lds, ra, Wt + (size_t)1152 * D, D, D / 32, e);
        }
    }
    SEAM(PH_QKV);
    if (IN(PH_SWA)) REP(PH_SWA) swa_phase(lds, (const bf16_t*)(ws + B_QKV), (const bf16_t*)(ws + B_VT0), a.in[7], (bf16_t*)(ws + B_O0), bid, nblk);
    SEAM(PH_SWA);
    if (IN(PH_OPROJ0)) REP(PH_OPROJ0) {
        const float* bias = a.in[9]; bf16_t* hb = (bf16_t*)(ws + W2_HB);
        gemm_phase<false, false>(lds, (const bf16_t*)(ws + B_O0), D, (const bf16_t*)(ws + W2_WO0), D, 0, 4, bid, nblk, [=](int m0, int n0) { return EpiRes{bias, hb, m0, n0}; });
    }
    SEAM(PH_OPROJ0);
    if (IN(PH_ROUTE0))
        route_phase(lds, (const bf16_t*)(ws + W2_HB), (const float*)(ws + W2_WRF), a.in[17], a.in[19], (float*)(ws + W2_RSTD), (int*)(ws + WS_CTL),
                    (int*)(ws + W2_LIST), (float*)(ws + W2_WSLOT), bid, nblk);
    SEAM(PH_ROUTE0);
    if (IN(PH_MOE0)) REP(PH_MOE0) moe_phase(lds, (int*)(ws + WS_CTL), (const int*)(ws + W2_LIST), (const bf16_t*)(ws + W2_HB), (const float*)(ws + W2_RSTD), (const float*)(ws + W2_WSLOT),
                               (const bf16_t*)(ws + C_W0), (const bf16_t*)(ws + C_W0 + MOE_WGU_BYTES), (bf16_t*)(ws + B_Y0), bid, nblk, (unsigned long long*)(ws + 512 * 1024));
    SEAM(PH_MOE0);
    if (IN(PH_COMBINE)) l1proj_phase(lds, (bf16_t*)(ws + W2_HB), (const bf16_t*)(ws + B_Y0), (const bf16_t*)(ws + W2_WIN), (const bf16_t*)(ws + W2_WUQ), (const bf16_t*)(ws + W2_WUKV),
                                     (const float2*)(ws + WS_ROPE), (bf16_t*)(ws + WS_KPE), (bf16_t*)(ws + C_Q1), (bf16_t*)(ws + C_K1), (bf16_t*)(ws + C_V1), bid, nblk);
    STAMP(PH_WIN); STAMP(PH_CEPI); STAMP(PH_UQKV);
    SEAM(PH_UQKV);
    if (IN(PH_MLA)) REP(100) {
        moe_weight_items(a.in[20] + (size_t)NE * D * DE, a.in[21] + (size_t)NE * D * DE, a.in[22] + (size_t)NE * DE * D, a.in[3] + D, (bf16_t*)(ws + B_W1), (bf16_t*)(ws + B_W1 + MOE_WGU_BYTES),
                         (LAS float*)lds, bid, nblk);
    }
    if (IN(PH_MLA)) REP(PH_MLA) mla_phase(lds, (const bf16_t*)(ws + C_Q1), (const bf16_t*)(ws + C_K1), (const bf16_t*)(ws + WS_KPE), (const bf16_t*)(ws + C_V1), (bf16_t*)(ws + B_O1), bid, nblk);
    SEAM(PH_MLA);
    if (IN(PH_OPROJ1)) REP(PH_OPROJ1) {
        bf16_t* hb = (bf16_t*)(ws + W2_HB);
        gemm_phase<false, false>(lds, (const bf16_t*)(ws + B_O1), D, (const bf16_t*)(ws + W2_WO1), D, 0, 4, bid, nblk, [=](int m0, int n0) { return EpiRes{nullptr, hb, m0, n0}; });
    }
    SEAM(PH_OPROJ1);
    if (IN(PH_ROUTE1))
        route_phase(lds, (const bf16_t*)(ws + W2_HB), (const float*)(ws + W2_WRF) + 36 * 1024, a.in[17] + 4, a.in[19] + 32, (float*)(ws + W2_RSTD), (int*)(ws + WS_CTL) + 2048,
                    (int*)(ws + W2_LIST), (float*)(ws + W2_WSLOT), bid, nblk);
    SEAM(PH_ROUTE1);
    if (IN(PH_MOE1)) REP(PH_MOE1) moe_phase(lds, (int*)(ws + WS_CTL) + 2048, (const int*)(ws + W2_LIST), (const bf16_t*)(ws + W2_HB), (const float*)(ws + W2_RSTD), (const float*)(ws + W2_WSLOT),
                               (const bf16_t*)(ws + B_W1), (const bf16_t*)(ws + B_W1 + MOE_WGU_BYTES), (bf16_t*)(ws + C_Y1), bid, nblk);
    SEAM(PH_MOE1);
    if (IN(PH_FINAL)) REP(PH_FINAL) final_phase((const bf16_t*)(ws + W2_HB), (const bf16_t*)(ws + C_Y1), a.in[4], a.out, bid, nblk);
#undef bid
#undef IN
#undef SEAM
}

static void run_mega(hipStream_t s, const MArgs& base, int lo, int hi, int grid) {
    MArgs a = base; a.ph_lo = lo; a.ph_hi = hi; a.li = lo;
    hipLaunchKernelGGL(mega, dim3(grid), dim3(NTHR), LDS_BYTES, s, a);
}
extern "C" void kernel_launch(void* const* d_in, const int* in_sizes, int n_in, void* d_out, int out_size, void* d_ws, size_t ws_size, hipStream_t stream) {
    static int grid = 0;
    if (grid == 0) {
        if (n_in != 23 || ws_size < WS_END) { fprintf(stderr, "kernel_launch: unexpected n_in %d or ws_size %zu\n", n_in, ws_size); grid = -1; return; }
        if (hipFuncSetAttribute((const void*)mega, hipFuncAttributeMaxDynamicSharedMemorySize, LDS_BYTES) != hipSuccess) { fprintf(stderr, "hipFuncSetAttribute failed\n"); grid = -1; return; }
        int dev = 0, cus = 0, per_cu = 0;
        (void)hipGetDevice(&dev); (void)hipDeviceGetAttribute(&cus, hipDeviceAttributeMultiprocessorCount, dev);
        (void)hipOccupancyMaxActiveBlocksPerMultiprocessor(&per_cu, (const void*)mega, NTHR, LDS_BYTES);
        (void)hipGetLastError();
        if (per_cu < 1 || cus < 8) { fprintf(stderr, "kernel_launch: occupancy query reports %d workgroups/CU on %d CUs for %d threads + %d B LDS; nothing launched\n", per_cu, cus, NTHR, LDS_BYTES); grid = -1; return; }
        grid = cus;
    }
    if (grid < 0) return;
    (void)in_sizes; (void)out_size;
    unsigned char* ws = (unsigned char*)d_ws;
    MArgs base{}; for (int i = 0; i < 23; ++i) base.in[i] = (const float*)d_in[i]; base.out = (float*)d_out; base.ws = ws;
    (void)hipMemsetAsync(ws + WS_CTL, 0, 1 * MiB, stream);
    run_mega(stream, base, 0, PH_N, grid);
}
```

```cpp
#include <hip/hip_runtime.h>
#ifndef PROBE_PHASE
#define PROBE_PHASE -1
#endif
#include <cstdio>
#include <cstdint>

typedef unsigned short bf16_t;

constexpr int D = 1024, SEQ = 8192, NB = 2, NMETA = 16;
constexpr int MREAL = NB * SEQ;
constexpr int MTOT = MREAL + NB * NMETA;
constexpr int LPOS = NMETA + SEQ;
constexpr int NQKV = 1280;
constexpr int NE = 32, DE = 256;
constexpr int CAP = MTOT * 2;
constexpr float EPS = 1e-6f;

__device__ __forceinline__ float bf2f(bf16_t v) { return __uint_as_float(((unsigned)v) << 16); }
__device__ __forceinline__ bf16_t f2bf(float f) { unsigned u = __float_as_uint(f); u += 0x7fffu + ((u >> 16) & 1u); return (bf16_t)(u >> 16); }
__device__ __forceinline__ int row_pos(int row) { return row < MREAL ? NMETA + (row & (SEQ - 1)) : ((row - MREAL) & (NMETA - 1)); }
__device__ __forceinline__ int row_batch(int row) { return row < MREAL ? (row >> 13) : ((row - MREAL) >> 4); }
constexpr int LP = 8256;
__device__ __forceinline__ int perm16(int p) { const int qd = (p >> 2) & 3; return (p & ~12) | ((((qd & 1) << 1) | (qd >> 1)) << 2); }
__device__ __forceinline__ float wave_sum(float v) {
#pragma unroll
    for (int o = 1; o < 64; o <<= 1) v += __shfl_xor(v, o);
    return v;
}

constexpr size_t MiB = 1u << 20;
constexpr size_t WS_CTL = 0;
constexpr size_t WS_ROPE = 1 * MiB;
constexpr size_t WS_END = 256 * MiB;

#define LAS __attribute__((address_space(3)))
#define GAS __attribute__((address_space(1)))
typedef short bf16x8 __attribute__((ext_vector_type(8)));
typedef float f32x4 __attribute__((ext_vector_type(4)));
typedef unsigned u32x4 __attribute__((ext_vector_type(4)));
typedef unsigned u32x2 __attribute__((ext_vector_type(2)));
constexpr int NTHR = 512, NWAVE = 8;
constexpr int LDS_MISC = 162816;
constexpr int LDS_BYTES = LDS_MISC + 1024;

constexpr size_t WS_BAR = 64 * 1024;
constexpr size_t WS_KPE = 3 * MiB + 256 * 1024;
constexpr size_t W2_RSTD = 4 * MiB + 512 * 1024, W2_WSLOT = W2_RSTD + 80 * 1024, W2_EID = W2_WSLOT + 144 * 1024;
constexpr size_t W2_LIST = 5 * MiB;
constexpr size_t W2_WRF = 9 * MiB + 256 * 1024;
constexpr size_t W2_WQKV = 10 * MiB;
constexpr size_t W2_WO0 = W2_WQKV + 2560 * 1024;
constexpr size_t W2_WIN = W2_WO0 + 2048 * 1024;
constexpr size_t W2_WUQ = W2_WIN + 1024 * 1024;
constexpr size_t W2_WUKV = W2_WUQ + 768 * 1024;
constexpr size_t W2_WO1 = W2_WUKV + 512 * 1024;
constexpr size_t W2_HB = 20 * MiB;
constexpr size_t W2_RB = 53 * MiB;
constexpr size_t W2_RC = 134 * MiB;
static_assert(W2_EID + (size_t)MTOT * 8 <= W2_LIST && W2_LIST + (size_t)NE * CAP * 4 <= W2_WRF && W2_WO1 + 2 * MiB <= W2_HB && W2_HB + (size_t)MTOT * 2048 <= W2_RB, "fixed map");
constexpr size_t B_QKV = W2_RB, B_O0 = W2_RB + 41 * MiB, B_VT0 = W2_RB + 74 * MiB  , B_Y0 = W2_RB, B_CBUF = W2_RB, B_CQN = W2_RB + 33 * MiB, B_CKVN = W2_RB + 42 * MiB, B_O1 = W2_RB, B_W1 = W2_RB + 33 * MiB;
constexpr size_t C_W0 = W2_RC, C_HF = W2_RC + 48 * MiB, C_Q1 = W2_RC, C_K1 = W2_RC + 49 * MiB, C_V1 = W2_RC + 82 * MiB, C_HF1 = W2_RC, C_Y1 = W2_RC;
static_assert(C_V1 + (size_t)2 * 16 * 64 * LP * 2 <= WS_END && C_K1 + (size_t)2 * LP * 2048 <= C_V1 && B_VT0 + (size_t)2 * 2 * 64 * LP * 2 <= W2_RC && C_HF + (size_t)MTOT * 4096 <= WS_END && B_W1 + 48 * MiB <= W2_RC, "region map");
constexpr size_t MOE_WGU_BYTES = (size_t)NE * 512 * 1024 * 2, MOE_WD_BYTES = (size_t)NE * 1024 * 256 * 2;

struct MArgs { const float* in[23]; float* out; unsigned char* ws; int ph_lo, ph_hi, li, pad; };

__device__ __forceinline__ unsigned pk2(float lo, float hi) { return (unsigned)f2bf(lo) | ((unsigned)f2bf(hi) << 16); }

#define XB_TMO      128
#define XB_XCNT(j)  (256  + 64 * (j))
#define XB_XSUB(j)  (1280 + 64 * (j))
#define XB_XGEN(j)  (2304 + 64 * (j))
#define XB_TOP      3328
#define XB_TOPGEN   3392
#define XCD_BAR_WORDS 3456
#define XB_SPIN_CAP (1u << 18)
__device__ __forceinline__ unsigned xb_ld(unsigned* p)              { return __hip_atomic_load(p, __ATOMIC_RELAXED, __HIP_MEMORY_SCOPE_AGENT); }
__device__ __forceinline__ unsigned xb_add(unsigned* p, unsigned v) { return __hip_atomic_fetch_add(p, v, __ATOMIC_RELAXED, __HIP_MEMORY_SCOPE_AGENT); }
__device__ __forceinline__ unsigned xb_xcc_id() { return (unsigned)__builtin_amdgcn_s_getreg((3 << 11) | 20) & 0xFu; }
#define XB_SPIN(cond, bar) do { unsigned _sp = 0; while (cond) { __builtin_amdgcn_s_sleep(1); \
    if ((++_sp & 255u) == 0u) { if (xb_ld(&(bar)[XB_TMO])) break; if (_sp > XB_SPIN_CAP) { atomicAdd(&(bar)[XB_TMO], 1u); break; } } } } while (0)
struct XcdBarrier { unsigned* bar; unsigned x; volatile LAS unsigned* st; };
__device__ __forceinline__ XcdBarrier xcd_barrier_post(unsigned* bar, volatile LAS unsigned* st) {
    XcdBarrier b; b.bar = bar; b.x = xb_xcc_id(); b.st = st;
    if (threadIdx.x == 0) (void)xb_add(&bar[XB_XCNT(b.x)], 1u);
    return b;
}
__device__ __forceinline__ void xcd_barrier_complete(unsigned* bar, unsigned x, unsigned& nloc, unsigned& nx) {
    const unsigned G = gridDim.x * gridDim.y * gridDim.z;
    unsigned sum, cnt, mine, sp = 0u;
    for (;;) {
        sum = 0u; cnt = 0u; mine = 0u;
#pragma unroll
        for (unsigned j = 0; j < 16; ++j) { const unsigned c = xb_ld(&bar[XB_XCNT(j)]); sum += c; cnt += (c > 0u) ? 1u : 0u; mine = (j == x) ? c : mine; }
        if (sum == G) break;
        __builtin_amdgcn_s_sleep(1);
        if ((++sp & 255u) == 0u) { if (xb_ld(&bar[XB_TMO])) break; if (sp > XB_SPIN_CAP) { atomicAdd(&bar[XB_TMO], 1u); break; } }
    }
    nloc = mine > 0u ? mine : 1u; nx = cnt > 0u ? cnt : 1u;
}
__device__ __forceinline__ void xcd_barrier(const XcdBarrier& b) {
    asm volatile("s_waitcnt vmcnt(0)" ::: "memory");
    __syncthreads();
    if (threadIdx.x == 0) {
        unsigned* bar = b.bar;
        __builtin_amdgcn_s_waitcnt(0);
        unsigned nloc = b.st[0], nx = b.st[1];
        if (nloc == 0u) { xcd_barrier_complete(bar, b.x, nloc, nx); b.st[0] = nloc; b.st[1] = nx; }
        const unsigned old = xb_add(&bar[XB_XSUB(b.x)], 1u);
        const unsigned gen = old / nloc;
        if (old + 1u == (gen + 1u) * nloc) {
            __builtin_amdgcn_fence(__ATOMIC_RELEASE, "agent");
            asm volatile("s_waitcnt vmcnt(0)" ::: "memory");
            const unsigned og = xb_add(&bar[XB_TOP], 1u);
            const unsigned tg = og / nx;
            if (og + 1u == (tg + 1u) * nx) xb_add(&bar[XB_TOPGEN], 1u);
            else XB_SPIN(xb_ld(&bar[XB_TOPGEN]) == tg, bar);
            __builtin_amdgcn_fence(__ATOMIC_ACQUIRE, "agent");
            xb_add(&bar[XB_XGEN(b.x)], 1u);
            asm volatile("s_waitcnt vmcnt(0)" ::: "memory");
        } else {
            XB_SPIN(xb_ld(&bar[XB_XGEN(b.x)]) == gen, bar);
            __builtin_amdgcn_fence(__ATOMIC_ACQUIRE, "agent");
            asm volatile("s_waitcnt vmcnt(0)" ::: "memory");
        }
    }
    __syncthreads();
}

template <int N> __device__ __forceinline__ void wait_vm() { asm volatile("s_waitcnt vmcnt(%0)" :: "n"(N) : "memory"); }
__device__ __forceinline__ int swzF(int g) { return (0x78 >> (2 * g)) & 3; }
constexpr int GT_NS = 4;
template <int MT, int NT, int WM, int WN, bool NSW, class RowA, class Epi, bool NOLD = false>
__device__ __forceinline__ void gemm_tile(LAS unsigned char* lds, const RowA& rowA, const bf16_t* __restrict__ Bt, int ldb  , int nk  , Epi& epi) {
    constexpr int BM = WM * MT * 16, BN = WN * NT * 16, GA = BM / 16, G = (BM + BN) / 16, NG = (G + 7) / 8, GR = G % 8, STAGE = (BM + BN) * 64;
    static_assert(WM * WN == 8 && GT_NS * STAGE <= LDS_MISC && BM % 16 == 0 && BN % 16 == 0, "gemm_tile config");
    const int tid = threadIdx.x, lane = tid & 63, wave = __builtin_amdgcn_readfirstlane(tid >> 6), wm = wave / WN, wn = wave % WN;
    const char* src[NG];
    const int lc = (lane & 3) ^ swzF(lane >> 4);
#pragma unroll
    for (int i = 0; i < NG; ++i) {
        const int g = wave + 8 * i;
        if (g < GA) src[i] = (const char*)rowA(g * 16 + (lane >> 2)) + lc * 16;
        else if (g < G) src[i] = (const char*)(Bt + (size_t)((g - GA) * 16 + (lane >> 2)) * ldb) + lc * 16;
        else src[i] = nullptr;
    }
    f32x4 acc[MT][NT];
#pragma unroll
    for (int mi = 0; mi < MT; ++mi)
#pragma unroll
        for (int ni = 0; ni < NT; ++ni) acc[mi][ni] = (f32x4){0.f, 0.f, 0.f, 0.f};
    const int fro = (lane & 15) * 64 + (((lane >> 4) ^ swzF((lane >> 2) & 3)) << 4);
    constexpr int LM = PROBE_PHASE == 402 ? 2 : 1;
#define GT_STAGE(st, kt) do { _Pragma("unroll") for (int _i = 0; _i < NG; ++_i) { const int _g = wave + 8 * _i; if (_g < G) { \
        __builtin_amdgcn_global_load_lds((const unsigned*)(src[_i] + (size_t)(kt) * 64), (LAS unsigned*)(lds + (st) * STAGE + _g * 1024), 16, 0, 0); \
        if (LM == 2) __builtin_amdgcn_global_load_lds((const unsigned*)(src[_i] + (size_t)(kt) * 64), (LAS unsigned*)(lds + (st) * STAGE + _g * 1024), 16, 0, 0); } } } while (0)
#define GT_WAIT(ntl) do { if (GR == 0 || wave < GR) wait_vm<LM * NG * (ntl)>(); else wait_vm<LM * (NG - 1) * (ntl)>(); } while (0)
    if (!NOLD) { GT_STAGE(0, 0);
    if (nk > 1) GT_STAGE(1, 1);
    if (nk > 2) GT_STAGE(2, 2); }
    int st = 0;
    for (int kt = 0; kt < nk; ++kt) {
        const int rem = nk - 1 - kt;
        if (!NOLD) { if (rem >= 2) GT_WAIT(2); else if (rem == 1) GT_WAIT(1); else GT_WAIT(0); }
        __builtin_amdgcn_s_barrier(); asm volatile("" ::: "memory");
        const bool doload = (!NOLD || PROBE_PHASE == 505) && kt + 3 < nk;
        LAS const unsigned char* sa = lds + st * STAGE + (wm * MT * 16) * 64 + fro;
        LAS const unsigned char* sb = lds + st * STAGE + (BM + wn * NT * 16) * 64 + fro;
        bf16x8 bfr[NT];
#pragma unroll
        for (int ni = 0; ni < NT; ++ni) bfr[ni] = *(LAS const bf16x8*)(sb + ni * 1024);
        constexpr int PG = MT >= 2 ? 2 : 1, NPG = MT / PG;
        constexpr int LPG = (NG + NPG - 1) / NPG;
        bf16x8 afc[PG], afn[PG];
#pragma unroll
        for (int i = 0; i < PG; ++i) afc[i] = *(LAS const bf16x8*)(sa + i * 1024);
#pragma unroll
        for (int pg = 0; pg < NPG; ++pg) {
            if (doload) {
#pragma unroll
                for (int l = 0; l < LPG; ++l) { const int _i = pg * LPG + l; if (_i < NG) { const int _g = wave + 8 * _i; if (_g < G)
                    __builtin_amdgcn_global_load_lds((const unsigned*)(src[_i] + (size_t)(kt + 3) * 64), (LAS unsigned*)(lds + ((st + 3) & 3) * STAGE + _g * 1024), 16, 0, 0); } }
            }
            if (pg + 1 < NPG) {
#pragma unroll
                for (int i = 0; i < PG; ++i) afn[i] = *(LAS const bf16x8*)(sa + ((pg + 1) * PG + i) * 1024);
            }
#pragma unroll
            for (int i = 0; i < PG; ++i) { const int mi = pg * PG + i;
#pragma unroll
                for (int ni = 0; ni < NT; ++ni) {
                    if (NSW) acc[mi][ni] = __builtin_amdgcn_mfma_f32_16x16x32_bf16(afc[i], bfr[ni], acc[mi][ni], 0, 0, 0);
                    else acc[mi][ni] = __builtin_amdgcn_mfma_f32_16x16x32_bf16(bfr[ni], afc[i], acc[mi][ni], 0, 0, 0);
                } }
#pragma unroll
            for (int i = 0; i < PG; ++i) afc[i] = afn[i];
            __builtin_amdgcn_sched_barrier(0);
        }
        st = (st + 1) & 3;
    }
#undef GT_STAGE
#undef GT_WAIT
    epi(acc, wm * MT * 16, wn * NT * 16, lane);
    asm volatile("s_waitcnt lgkmcnt(0)" ::: "memory");
    __syncthreads();
}

struct RowDense { const bf16_t* A; int lda, m0, mlast; __device__ __forceinline__ const bf16_t* operator()(int r) const { int row = m0 + r; row = row > mlast ? mlast : row; return A + (size_t)row * lda; } };

struct EpiQKV {
    const float* rstd; const float* bias; const float2* cs; bf16_t* qkv; int m0, n0;
    template <int MT, int NT> __device__ __forceinline__ void operator()(f32x4 (&acc)[MT][NT], int mb, int nb, int lane) const {
        static_assert(NT == 4, "rope needs a 64-column wave span");
        const int cb = n0 + nb, d0 = (lane >> 4) * 4;
#pragma unroll
        for (int mi = 0; mi < MT; ++mi) {
            const int row = m0 + mb + mi * 16 + (lane & 15);
            if (row < MTOT) {
                const float rs = rstd[row]; const int pos = row_pos(row);
                bf16_t* orow = qkv + (size_t)row * NQKV + cb;
                {
                    const float sc = cb < 1024 ? 0.125f : 1.0f;
#pragma unroll
                    for (int ni = 0; ni < 2; ++ni) {
                        const int d = ni * 16 + d0;
                        const f32x4 b1 = *(const f32x4*)(bias + cb + d), b2 = *(const f32x4*)(bias + cb + 32 + d);
                        float o1[4], o2[4];
#pragma unroll
                        for (int r = 0; r < 4; ++r) {
                            const float2 t = cs[pos * 32 + d + r];
                            const float x1 = acc[mi][ni][r] * rs + b1[r], x2 = acc[mi][ni + 2][r] * rs + b2[r];
                            o1[r] = (x1 * t.x - x2 * t.y) * sc; o2[r] = (x2 * t.x + x1 * t.y) * sc;
                        }
                        *(u32x2*)(orow + d) = (u32x2){pk2(o1[0], o1[1]), pk2(o1[2], o1[3])};
                        *(u32x2*)(orow + 32 + d) = (u32x2){pk2(o2[0], o2[1]), pk2(o2[2], o2[3])};
                    }
                }
            }
        }
    }
};
struct EpiV0 {
    const float* rstd; const float* bias; bf16_t* vt0; int m0, n0;
    template <int MT, int NT> __device__ __forceinline__ void operator()(f32x4 (&acc)[MT][NT], int mb, int nb, int lane) const {
        static_assert(NT == 4, "64-column wave span");
        const int cb = n0 + nb, kh = (cb - 1152) >> 6;
#pragma unroll
        for (int mi = 0; mi < MT; ++mi) {
            const int row0 = m0 + mb + mi * 16 + (lane >> 4) * 4;
            if (row0 < MTOT) {
                const f32x4 rs = *(const f32x4*)(rstd + row0); const int b = row_batch(row0), pp = perm16(row_pos(row0));
#pragma unroll
                for (int ni = 0; ni < NT; ++ni) { const int d = ni * 16 + (lane & 15); const float bb = bias[cb + d];
                    const f32x4 v = acc[mi][ni] * rs + bb;
                    *(u32x2*)(vt0 + (size_t)((b * 2 + kh) * 64 + d) * LP + pp) = (u32x2){pk2(v[0], v[1]), pk2(v[2], v[3])}; }
            }
        }
    }
};
struct EpiRes {
    const float* bias; bf16_t* hb; int m0, n0;
    template <int MT, int NT> __device__ __forceinline__ void operator()(f32x4 (&acc)[MT][NT], int mb, int nb, int lane) const {
#pragma unroll
        for (int mi = 0; mi < MT; ++mi) {
            const int row = m0 + mb + mi * 16 + (lane & 15);
            if (row < MTOT) {
#pragma unroll
                for (int ni = 0; ni < NT; ++ni) {
                    const int col = n0 + nb + ni * 16 + (lane >> 4) * 4;
                    u32x2* p = (u32x2*)(hb + (size_t)row * D + col);
                    const u32x2 h = *p;
                    f32x4 v = acc[mi][ni];
                    if (bias) v += *(const f32x4*)(bias + col);
                    v[0] += __uint_as_float(h.x << 16); v[1] += __uint_as_float(h.x & 0xffff0000u); v[2] += __uint_as_float(h.y << 16); v[3] += __uint_as_float(h.y & 0xffff0000u);
                    *p = (u32x2){pk2(v[0], v[1]), pk2(v[2], v[3])};
                }
            }
        }
    }
};
__device__ __forceinline__ void route_phase(LAS unsigned char* lds, const bf16_t* __restrict__ hbr, const float* __restrict__ wrf, const float* __restrict__ bg, const float* __restrict__ br,
                                            float* rstd_out, int* cnt, int* list, float* wslot, int bid, int nblk) {
    const int tid = threadIdx.x, lane = tid & 63, wave = __builtin_amdgcn_readfirstlane(tid >> 6);
    LAS f32x4* wl = (LAS f32x4*)lds;
    LAS int* nrec = (LAS int*)(lds + LDS_MISC + 16); LAS int* bcnt = (LAS int*)(lds + LDS_MISC + 32); LAS int* bbase = (LAS int*)(lds + LDS_MISC + 160); LAS int* rec = (LAS int*)(lds + LDS_MISC + 288);
    for (int i = tid; i < 36 * 256; i += NTHR) wl[i] = *(const f32x4*)(wrf + (size_t)i * 4);
    if (tid < NE) bcnt[tid] = 0;
    if (tid == 0) *nrec = 0;
    __syncthreads();
    for (int row = bid * NWAVE + wave; row < MTOT; row += nblk * NWAVE) {
        f32x4 x[4]; float ss = 0.f;
#pragma unroll
        for (int j = 0; j < 4; ++j) { const u32x2 h = *(const u32x2*)(hbr + (size_t)row * D + j * 256 + lane * 4);
            x[j] = (f32x4){__uint_as_float(h.x << 16), __uint_as_float(h.x & 0xffff0000u), __uint_as_float(h.y << 16), __uint_as_float(h.y & 0xffff0000u)};
            ss += x[j][0] * x[j][0] + x[j][1] * x[j][1] + x[j][2] * x[j][2] + x[j][3] * x[j][3]; }
        ss = wave_sum(ss);
        const float rs = rsqrtf(ss * (1.0f / D) + EPS);
        float lg[4];
#pragma unroll
        for (int c = 0; c < 4; ++c) { float p = 0.f;
#pragma unroll
            for (int j = 0; j < 4; ++j) { const f32x4 w = wl[c * 256 + j * 64 + lane]; p += x[j][0] * w[0] + x[j][1] * w[1] + x[j][2] * w[2] + x[j][3] * w[3]; }
            lg[c] = wave_sum(p) * rs + bg[c]; }
        int gi = 0; float gm = lg[0];
#pragma unroll
        for (int c = 1; c < 4; ++c) if (lg[c] > gm) { gm = lg[c]; gi = c; }
        float gs = 0.f;
#pragma unroll
        for (int c = 0; c < 4; ++c) gs += __expf(lg[c] - gm);
        const float gp = 1.0f / gs;
        gi = __builtin_amdgcn_readfirstlane(gi);
        float e[8];
#pragma unroll
        for (int c = 0; c < 8; ++c) { float p = 0.f;
#pragma unroll
            for (int j = 0; j < 4; ++j) { const f32x4 w = wl[(4 + gi * 8 + c) * 256 + j * 64 + lane]; p += x[j][0] * w[0] + x[j][1] * w[1] + x[j][2] * w[2] + x[j][3] * w[3]; }
            e[c] = wave_sum(p) * rs + br[gi * 8 + c]; }
        int i1 = 0; float v1 = e[0];
#pragma unroll
        for (int c = 1; c < 8; ++c) if (e[c] > v1) { v1 = e[c]; i1 = c; }
        int i2 = -1; float v2 = -3.0e38f;
#pragma unroll
        for (int c = 0; c < 8; ++c) if (c != i1 && e[c] > v2) { v2 = e[c]; i2 = c; }
        if (lane == 0) {
            const float r = __expf(v2 - v1);
            const float w1 = gp / (1.0f + r), w2 = gp * r / (1.0f + r);
            const int e1 = gi * 8 + i1, e2 = gi * 8 + i2;
            const int p1 = atomicAdd((int*)&bcnt[e1], 1), p2 = atomicAdd((int*)&bcnt[e2], 1);
            const int k = atomicAdd((int*)nrec, 2);
            rec[k] = ((row * 2) << 13) | (e1 << 8) | p1; rec[k + 1] = ((row * 2 + 1) << 13) | (e2 << 8) | p2;
            wslot[row * 2] = w1; wslot[row * 2 + 1] = w2; rstd_out[row] = rs;
        }
    }
    __syncthreads();
    if (tid < NE) { const int c = bcnt[tid]; bbase[tid] = c ? __hip_atomic_fetch_add(cnt + tid * 64, c, __ATOMIC_RELAXED, __HIP_MEMORY_SCOPE_AGENT) : 0; }
    __syncthreads();
    for (int k = tid; k < *nrec; k += NTHR) { const int r = rec[k], e = (r >> 8) & 31; list[(size_t)e * CAP + bbase[e] + (r & 255)] = r >> 13; }
    __syncthreads();
}
__device__ __forceinline__ void final_phase(const bf16_t* __restrict__ hb, const bf16_t* __restrict__ ybuf, const float* __restrict__ g, float* out, int bid, int nblk) {
    const int tid = threadIdx.x, lane = tid & 63, wave = tid >> 6;
    for (int row = bid * NWAVE + wave; row < MREAL; row += nblk * NWAVE) {
        f32x4 v[4]; float ss = 0.f;
#pragma unroll
        for (int j = 0; j < 4; ++j) { const size_t c = j * 256 + lane * 4;
            const u32x2 h = *(const u32x2*)(hb + (size_t)row * D + c), y0 = *(const u32x2*)(ybuf + (size_t)(row * 2) * D + c), y1 = *(const u32x2*)(ybuf + (size_t)(row * 2 + 1) * D + c);
            v[j][0] = __uint_as_float(h.x << 16) + __uint_as_float(y0.x << 16) + __uint_as_float(y1.x << 16);
            v[j][1] = __uint_as_float(h.x & 0xffff0000u) + __uint_as_float(y0.x & 0xffff0000u) + __uint_as_float(y1.x & 0xffff0000u);
            v[j][2] = __uint_as_float(h.y << 16) + __uint_as_float(y0.y << 16) + __uint_as_float(y1.y << 16);
            v[j][3] = __uint_as_float(h.y & 0xffff0000u) + __uint_as_float(y0.y & 0xffff0000u) + __uint_as_float(y1.y & 0xffff0000u);
            ss += v[j][0] * v[j][0] + v[j][1] * v[j][1] + v[j][2] * v[j][2] + v[j][3] * v[j][3]; }
        const float rs = rsqrtf(wave_sum(ss) * (1.0f / D) + EPS);
#pragma unroll
        for (int j = 0; j < 4; ++j) { const f32x4 gg = *(const f32x4*)(g + j * 256 + lane * 4); *(f32x4*)(out + (size_t)row * D + j * 256 + lane * 4) = v[j] * rs * gg; }
    }
}

typedef float f32x16 __attribute__((ext_vector_type(16)));
constexpr int AT_STAGE = 20480;
__device__ __forceinline__ unsigned cvtpk(float lo, float hi) { typedef float f2 __attribute__((ext_vector_type(2))); typedef __bf16 b2 __attribute__((ext_vector_type(2)));
    f2 v = {lo, hi}; b2 r = __builtin_convertvector(v, b2); return __builtin_bit_cast(unsigned, r); }
__device__ __forceinline__ void mla_unit(LAS unsigned char* lds, int b, int h, int qi, const bf16_t* __restrict__ Q1, const bf16_t* __restrict__ K1, const bf16_t* __restrict__ kpe,
                                         const bf16_t* __restrict__ VT1, bf16_t* o) {
    const int tid = threadIdx.x, lane = tid & 63, wave = __builtin_amdgcn_readfirstlane(tid >> 6), r32 = lane & 31, hi = lane >> 5;
    const size_t qrow = (size_t)b * SEQ + 256 * qi + 32 * wave + r32;
    bf16x8 qf[6];
#pragma unroll
    for (int s = 0; s < 6; ++s) qf[s] = *(const bf16x8*)(Q1 + qrow * 1536 + h * 96 + 16 * s + 8 * hi);
    const int lr = 8 * wave + (lane >> 3);
    const char* ksrc = (const char*)(K1 + ((size_t)b * LP + lr) * 1024 + h * 64) + (((lane & 7) ^ ((lr >> 1) & 7)) << 4);
    const char* vsrc = (const char*)(VT1 + ((size_t)(b * 16 + h) * 64 + lr) * LP) + (((lane & 7) ^ ((lr >> 1) & 7)) << 4);
    const int pr = 16 * wave + (lane >> 2);
    const char* psrc = (const char*)(kpe + ((size_t)b * LP + (pr & 63)) * 32) + (((lane & 3) ^ ((pr >> 2) & 3)) << 4);
#define MLA_ISSUE(j, st) do { \
        __builtin_amdgcn_global_load_lds((const unsigned*)(ksrc + (size_t)(j) * (64 * 2048)), (LAS unsigned*)(lds + (st) * AT_STAGE + wave * 1024), 16, 0, 0); \
        __builtin_amdgcn_global_load_lds((const unsigned*)(vsrc + (size_t)(j) * 128), (LAS unsigned*)(lds + (st) * AT_STAGE + 8192 + wave * 1024), 16, 0, 0); \
        if (wave < 4) __builtin_amdgcn_global_load_lds((const unsigned*)(psrc + (size_t)(j) * (64 * 64)), (LAS unsigned*)(lds + (st) * AT_STAGE + 16384 + wave * 1024), 16, 0, 0); } while (0)
    const int NT = 4 * qi + 5, jmaxw = 4 * qi + ((32 * wave + 47) >> 6);
    const int qp = 16 + 256 * qi + 32 * wave + r32;
    const int koff = r32 * 128, ksw = (r32 >> 1) & 7, poff = 16384 + r32 * 64, psw = (r32 >> 2) & 3, voff = 8192 + r32 * 128;
    f32x16 oacc[2]; oacc[0] = (f32x16){}; oacc[1] = (f32x16){};
    constexpr float MLA_THR = 8.0f;
    float mref = 0.f, lsum = 0.f;
    f32x16 negm = (f32x16){};
    MLA_ISSUE(0, 0);
    if (NT > 1) MLA_ISSUE(1, 1);
    int st = 0;
    for (int j = 0; j < NT; ++j) {
        if (j + 1 < NT) { if (wave < 4) asm volatile("s_waitcnt vmcnt(3)" ::: "memory"); else asm volatile("s_waitcnt vmcnt(2)" ::: "memory"); }
        else asm volatile("s_waitcnt vmcnt(0)" ::: "memory");
        __builtin_amdgcn_s_barrier(); asm volatile("" ::: "memory");
        if (j + 2 < NT) { const int st2 = st >= 1 ? st - 1 : 2; MLA_ISSUE(j + 2, st2); }
        if (j <= jmaxw) {
            LAS const unsigned char* sb = lds + st * AT_STAGE;
            f32x16 p0, p1;
            {
                const bf16x8 k0 = *(LAS const bf16x8*)(sb + koff + ((hi ^ ksw) << 4));
                const bf16x8 k1 = *(LAS const bf16x8*)(sb + 4096 + koff + ((hi ^ ksw) << 4));
                p0 = __builtin_amdgcn_mfma_f32_32x32x16_bf16(k0, qf[0], negm, 0, 0, 0);
                p1 = __builtin_amdgcn_mfma_f32_32x32x16_bf16(k1, qf[0], negm, 0, 0, 0);
            }
#pragma unroll
            for (int s = 1; s < 4; ++s) {
                const bf16x8 k0 = *(LAS const bf16x8*)(sb + koff + (((2 * s + hi) ^ ksw) << 4));
                const bf16x8 k1 = *(LAS const bf16x8*)(sb + 4096 + koff + (((2 * s + hi) ^ ksw) << 4));
                p0 = __builtin_amdgcn_mfma_f32_32x32x16_bf16(k0, qf[s], p0, 0, 0, 0);
                p1 = __builtin_amdgcn_mfma_f32_32x32x16_bf16(k1, qf[s], p1, 0, 0, 0);
            }
#pragma unroll
            for (int s = 0; s < 2; ++s) {
                const bf16x8 k0 = *(LAS const bf16x8*)(sb + poff + (((2 * s + hi) ^ psw) << 4));
                const bf16x8 k1 = *(LAS const bf16x8*)(sb + 2048 + poff + (((2 * s + hi) ^ psw) << 4));
                p0 = __builtin_amdgcn_mfma_f32_32x32x16_bf16(k0, qf[4 + s], p0, 0, 0, 0);
                p1 = __builtin_amdgcn_mfma_f32_32x32x16_bf16(k1, qf[4 + s], p1, 0, 0, 0);
            }
            if (j >= 4 * qi) {
                const int kb0 = 64 * j + 4 * hi;
#pragma unroll
                for (int r = 0; r < 16; ++r) { const int kp = kb0 + (r & 3) + 8 * (r >> 2); if (kp > qp) p0[r] = -1e30f; if (kp + 32 > qp) p1[r] = -1e30f; }
            }
            float tm = fmaxf(p0[0], p1[0]);
#pragma unroll
            for (int r = 1; r < 16; ++r) tm = fmaxf(tm, fmaxf(p0[r], p1[r]));
            tm = fmaxf(tm, __shfl_xor(tm, 32));
            if (j == 0 || __any(tm > MLA_THR)) {
                const float dl = j == 0 ? tm : fmaxf(tm, 0.f);
                mref += dl;
                const float f = __builtin_amdgcn_exp2f(-dl);
                lsum *= f;
#pragma unroll
                for (int r = 0; r < 16; ++r) { oacc[0][r] *= f; oacc[1][r] *= f; p0[r] -= dl; p1[r] -= dl; negm[r] = -mref; }
            }
            float ps = 0.f;
#pragma unroll
            for (int r = 0; r < 16; ++r) { p0[r] = __builtin_amdgcn_exp2f(p0[r]); p1[r] = __builtin_amdgcn_exp2f(p1[r]); ps += p0[r] + p1[r]; }
            lsum += ps;
            u32x4 pf[4];
            pf[0] = (u32x4){cvtpk(p0[0], p0[1]), cvtpk(p0[2], p0[3]), cvtpk(p0[4], p0[5]), cvtpk(p0[6], p0[7])};
            pf[1] = (u32x4){cvtpk(p0[8], p0[9]), cvtpk(p0[10], p0[11]), cvtpk(p0[12], p0[13]), cvtpk(p0[14], p0[15])};
            pf[2] = (u32x4){cvtpk(p1[0], p1[1]), cvtpk(p1[2], p1[3]), cvtpk(p1[4], p1[5]), cvtpk(p1[6], p1[7])};
            pf[3] = (u32x4){cvtpk(p1[8], p1[9]), cvtpk(p1[10], p1[11]), cvtpk(p1[12], p1[13]), cvtpk(p1[14], p1[15])};
#pragma unroll
            for (int s = 0; s < 4; ++s) {
                const bf16x8 v0 = *(LAS const bf16x8*)(sb + voff + (((2 * s + hi) ^ ksw) << 4));
                const bf16x8 v1 = *(LAS const bf16x8*)(sb + 4096 + voff + (((2 * s + hi) ^ ksw) << 4));
                const bf16x8 pb = __builtin_bit_cast(bf16x8, pf[s]);
                oacc[0] = __builtin_amdgcn_mfma_f32_32x32x16_bf16(v0, pb, oacc[0], 0, 0, 0);
                oacc[1] = __builtin_amdgcn_mfma_f32_32x32x16_bf16(v1, pb, oacc[1], 0, 0, 0);
            }
        }
        st = st == 2 ? 0 : st + 1;
    }
#undef MLA_ISSUE
    lsum += __shfl_xor(lsum, 32);
    const float inv = 1.0f / lsum;
    bf16_t* orow = o + qrow * D + h * 64 + 4 * hi;
#pragma unroll
    for (int db = 0; db < 2; ++db)
#pragma unroll
        for (int g = 0; g < 4; ++g)
            *(u32x2*)(orow + 32 * db + 8 * g) = (u32x2){cvtpk(oacc[db][4 * g] * inv, oacc[db][4 * g + 1] * inv), cvtpk(oacc[db][4 * g + 2] * inv, oacc[db][4 * g + 3] * inv)};
    asm volatile("s_waitcnt lgkmcnt(0)" ::: "memory");
    __builtin_amdgcn_s_barrier(); asm volatile("" ::: "memory");
}
__device__ __forceinline__ void mla_meta(int b, int h, const bf16_t* __restrict__ Q1, const bf16_t* __restrict__ K1, const bf16_t* __restrict__ kpe, const bf16_t* __restrict__ VT1, bf16_t* o, int lane) {
    const int qi = lane & 15, part = lane >> 4; const size_t qrow = (size_t)MREAL + b * 16 + qi;
    float q[24];
#pragma unroll
    for (int d = 0; d < 24; ++d) q[d] = bf2f(Q1[qrow * 1536 + h * 96 + 24 * part + d]);
    float sc[16]; float mx = -1e30f;
#pragma unroll
    for (int j = 0; j < 16; ++j) {
        const size_t kr = (size_t)b * LP + j; float s = 0.f;
#pragma unroll
        for (int d = 0; d < 24; ++d) { const int dd = 24 * part + d; const float kv = dd < 64 ? bf2f(K1[kr * D + h * 64 + dd]) : bf2f(kpe[kr * 32 + dd - 64]); s += q[d] * kv; }
        s += __shfl_xor(s, 16); s += __shfl_xor(s, 32);
        sc[j] = j <= qi ? s : -1e30f; mx = fmaxf(mx, sc[j]);
    }
    float l = 0.f;
#pragma unroll
    for (int j = 0; j < 16; ++j) { sc[j] = exp2f(sc[j] - mx); l += sc[j]; }
    const float inv = 1.0f / l;
#pragma unroll
    for (int dd = 0; dd < 16; ++dd) { const int d = 16 * part + dd; float acc = 0.f;
#pragma unroll
        for (int j = 0; j < 16; ++j) acc += sc[j] * bf2f(VT1[((size_t)(b * 16 + h) * 64 + d) * LP + perm16(j)]);
        o[qrow * D + h * 64 + d] = f2bf(acc * inv); }
}
__device__ __forceinline__ void mla_phase(LAS unsigned char* lds, const bf16_t* Q1, const bf16_t* K1, const bf16_t* kpe, const bf16_t* VT1, bf16_t* o, int bid, int nblk) {
    const int v = (nblk % 8 == 0) ? (bid % 8) * (nblk / 8) + bid / 8 : bid;
    for (int vv = v; vv < 256; vv += nblk) {
        const int bh = vv >> 3, s = vv & 7, b = bh >> 4, h = bh & 15;
#pragma unroll 1
        for (int i = 0; i < 4; ++i) { const int qi = (i == 0) ? s : (i == 1) ? 15 - s : (i == 2) ? 16 + s : 31 - s; mla_unit(lds, b, h, qi, Q1, K1, kpe, VT1, o); }
        if (s == 0 && threadIdx.x < 64) mla_meta(b, h, Q1, K1, kpe, VT1, o, threadIdx.x);
    }
}

constexpr int SW_K = 0, SW_V = 36864, SW_VP = 560;
__device__ __forceinline__ void swa_block32(LAS const unsigned char* lds, int rb, int gk0, int nks, int mode, int i_q, const bf16x8 (&qf)[4], float& m, float& lsum, f32x16 (&oacc)[2], int r32, int hi) {
    const float C2 = 1.4426950408889634f;
    const int ksw = (r32 >> 1) & 7;
    f32x16 p = (f32x16){};
#pragma unroll
    for (int s = 0; s < 4; ++s) { const bf16x8 k = *(LAS const bf16x8*)(lds + SW_K + (rb + r32) * 128 + (((2 * s + hi) ^ ksw) << 4)); p = __builtin_amdgcn_mfma_f32_32x32x16_bf16(k, qf[s], p, 0, 0, 0); }
    if (mode != 0) {
        const int jb = ((rb - 32) & 127) + 4 * hi;
#pragma unroll
        for (int r = 0; r < 16; ++r) { const int kk = (r & 3) + 8 * (r >> 2);
            const bool ok = mode == 1 ? (kk + 4 * hi < 16) : mode == 2 ? (jb + kk > i_q) : (jb + kk <= i_q);
            if (!ok) p[r] = -1e30f; }
    }
    float tm = p[0];
#pragma unroll
    for (int r = 1; r < 16; ++r) tm = fmaxf(tm, p[r]);
    tm = fmaxf(tm, __shfl_xor(tm, 32));
    const float mn = fmaxf(m, tm), alpha = __builtin_amdgcn_exp2f((m - mn) * C2), nmc = -mn * C2;
    m = mn;
    float ps = 0.f;
#pragma unroll
    for (int r = 0; r < 16; ++r) { p[r] = __builtin_amdgcn_exp2f(__builtin_fmaf(p[r], C2, nmc)); ps += p[r]; }
    lsum = lsum * alpha + ps;
#pragma unroll
    for (int r = 0; r < 16; ++r) { oacc[0][r] *= alpha; oacc[1][r] *= alpha; }
    u32x4 pf[2];
    pf[0] = (u32x4){cvtpk(p[0], p[1]), cvtpk(p[2], p[3]), cvtpk(p[4], p[5]), cvtpk(p[6], p[7])};
    pf[1] = (u32x4){cvtpk(p[8], p[9]), cvtpk(p[10], p[11]), cvtpk(p[12], p[13]), cvtpk(p[14], p[15])};
#pragma unroll
    for (int ks = 0; ks < 2; ++ks) if (ks < nks) {
        const bf16x8 v0 = *(LAS const bf16x8*)(lds + SW_V + r32 * SW_VP + (gk0 + ks) * 32 + hi * 16);
        const bf16x8 v1 = *(LAS const bf16x8*)(lds + SW_V + (32 + r32) * SW_VP + (gk0 + ks) * 32 + hi * 16);
        const bf16x8 pb = __builtin_bit_cast(bf16x8, pf[ks]);
        oacc[0] = __builtin_amdgcn_mfma_f32_32x32x16_bf16(v0, pb, oacc[0], 0, 0, 0);
        oacc[1] = __builtin_amdgcn_mfma_f32_32x32x16_bf16(v1, pb, oacc[1], 0, 0, 0);
    }
}
__device__ __forceinline__ void swa_unit(LAS unsigned char* lds, int b, int n, int kh, const bf16_t* __restrict__ qkv, const bf16_t* __restrict__ VT0, const float* __restrict__ sinks, bf16_t* o) {
    const int tid = threadIdx.x, lane = tid & 63, wave = __builtin_amdgcn_readfirstlane(tid >> 6), r32 = lane & 31, hi = lane >> 5;
    for (int idx = tid; idx < 2176; idx += NTHR) {
        const int row = idx >> 3, c = idx & 7;
        if (row < 16 || n > 0 || row >= 144) {
            const size_t srow = row < 16 ? (size_t)MREAL + b * 16 + row : (size_t)b * SEQ + 128 * (n - 1) + (row - 16);
            const int lrow = row < 16 ? row : 16 + row;
            const u32x4 v = *(const u32x4*)(qkv + srow * NQKV + 1024 + kh * 64 + c * 8);
            *(LAS u32x4*)(lds + SW_K + lrow * 128 + ((c ^ ((lrow >> 1) & 7)) << 4)) = v;
        }
    }
    for (int idx = tid; idx < 2176; idx += NTHR) {
        const int d = idx / 34, c = idx % 34;
        if (c < 2 || n > 0 || c >= 18) {
            const bf16_t* src = VT0 + (size_t)((b * 2 + kh) * 64 + d) * LP + (c < 2 ? c * 8 : 16 + 128 * (n - 1) + (c - 2) * 8);
            *(LAS u32x4*)(lds + SW_V + d * SW_VP + c * 16) = *(const u32x4*)src;
        }
    }
    __syncthreads();
    const int hq = kh * 8 + wave;
    const float sink = sinks[hq];
#pragma unroll 1
    for (int qs = 0; qs < 4; ++qs) {
        const size_t qrow = (size_t)b * SEQ + 128 * n + 32 * qs + r32;
        bf16x8 qf[4];
#pragma unroll
        for (int s = 0; s < 4; ++s) qf[s] = *(const bf16x8*)(qkv + qrow * NQKV + hq * 64 + 16 * s + 8 * hi);
        f32x16 oacc[2]; oacc[0] = (f32x16){}; oacc[1] = (f32x16){};
        float m = sink, lsum = hi == 0 ? 1.0f : 0.0f;
        const int i_q = 32 * qs + r32;
        swa_block32(lds, 0, 0, 1, 1, i_q, qf, m, lsum, oacc, r32, hi);
        if (n > 0) {
            swa_block32(lds, 32 + 32 * qs, 1 + 2 * qs, 2, 2, i_q, qf, m, lsum, oacc, r32, hi);
#pragma unroll 1
            for (int kb = qs + 1; kb < 4; ++kb) swa_block32(lds, 32 + 32 * kb, 1 + 2 * kb, 2, 0, i_q, qf, m, lsum, oacc, r32, hi);
        }
#pragma unroll 1
        for (int kb = 0; kb < qs; ++kb) swa_block32(lds, 160 + 32 * kb, 9 + 2 * kb, 2, 0, i_q, qf, m, lsum, oacc, r32, hi);
        swa_block32(lds, 160 + 32 * qs, 9 + 2 * qs, 2, 3, i_q, qf, m, lsum, oacc, r32, hi);
        lsum += __shfl_xor(lsum, 32);
        const float inv = 1.0f / lsum;
        bf16_t* orow = o + qrow * D + hq * 64 + 4 * hi;
#pragma unroll
        for (int db = 0; db < 2; ++db)
#pragma unroll
            for (int g = 0; g < 4; ++g)
                *(u32x2*)(orow + 32 * db + 8 * g) = (u32x2){cvtpk(oacc[db][4 * g] * inv, oacc[db][4 * g + 1] * inv), cvtpk(oacc[db][4 * g + 2] * inv, oacc[db][4 * g + 3] * inv)};
    }
    __syncthreads();
}
__device__ __forceinline__ void swa_meta(int b, int hq, const bf16_t* __restrict__ qkv, const bf16_t* __restrict__ VT0, const float* __restrict__ sinks, bf16_t* o, int lane) {
    const int qi = lane & 15, part = lane >> 4, kh = hq >> 3; const size_t qrow = (size_t)MREAL + b * 16 + qi;
    float q[16];
#pragma unroll
    for (int d = 0; d < 16; ++d) q[d] = bf2f(qkv[qrow * NQKV + hq * 64 + 16 * part + d]);
    const float sink = sinks[hq];
    float sc[16]; float mx = sink;
#pragma unroll
    for (int j = 0; j < 16; ++j) {
        const size_t kr = (size_t)MREAL + b * 16 + j; float s = 0.f;
#pragma unroll
        for (int d = 0; d < 16; ++d) s += q[d] * bf2f(qkv[kr * NQKV + 1024 + kh * 64 + 16 * part + d]);
        s += __shfl_xor(s, 16); s += __shfl_xor(s, 32);
        sc[j] = j <= qi ? s : -1e30f; mx = fmaxf(mx, sc[j]);
    }
    float l = __expf(sink - mx);
#pragma unroll
    for (int j = 0; j < 16; ++j) { sc[j] = __expf(sc[j] - mx); l += sc[j]; }
    const float inv = 1.0f / l;
#pragma unroll
    for (int dd = 0; dd < 16; ++dd) { const int d = 16 * part + dd; float acc = 0.f;
#pragma unroll
        for (int j = 0; j < 16; ++j) acc += sc[j] * bf2f(VT0[((size_t)(b * 2 + kh) * 64 + d) * LP + perm16(j)]);
        o[qrow * D + hq * 64 + d] = f2bf(acc * inv); }
}
__device__ __forceinline__ void swa_phase(LAS unsigned char* lds, const bf16_t* qkv, const bf16_t* VT0, const float* sinks, bf16_t* o, int bid, int nblk) {
    for (int u = bid; u < 256; u += nblk) {
        const int b = u >> 7, n = (u >> 1) & 63, kh = u & 1;
        swa_unit(lds, b, n, kh, qkv, VT0, sinks, o);
        if (n == 0) swa_meta(b, kh * 8 + (threadIdx.x >> 6), qkv, VT0, sinks, o, threadIdx.x & 63);
    }
}

template <int MOE_MT>
__device__ __forceinline__ void moe_unit(LAS unsigned char* lds, int e, int s0, int ns, const int* __restrict__ list, const bf16_t* __restrict__ hb, const float* __restrict__ rstd,
                                         const float* __restrict__ wslot, const bf16_t* __restrict__ wgu, const bf16_t* __restrict__ wd, bf16_t* ybuf, unsigned long long* tsb = nullptr) {
#define MSTAMP(i) do { if (PROBE_PHASE >= 600 && tsb && blockIdx.x == 0 && threadIdx.x == 0) tsb[i] = __builtin_amdgcn_s_memrealtime(); } while (0)
    MSTAMP(20);
    constexpr int MOE_BM = 16 * MOE_MT, MOE_HT = MOE_BM * 128, MOE_B2 = 2 * MOE_HT, MOE_ST2 = 32768, MOE_HLO = MOE_B2 + 2 * MOE_ST2, MOE_INFO = MOE_HLO + 2 * MOE_HT;
    static_assert(MOE_B2 + 2 * MOE_ST2 <= MOE_HLO && MOE_INFO + 3072 <= LDS_MISC, "moe lds");
#define moe_hoff(kt2) ((kt2) < 2 ? MOE_HLO + (kt2) * MOE_HT : ((kt2) - 2) * MOE_HT)
    const int tid = threadIdx.x, lane = tid & 63, wave = __builtin_amdgcn_readfirstlane(tid >> 6);
    LAS int* slotl = (LAS int*)(lds + MOE_INFO); LAS float* rsl = (LAS float*)(lds + MOE_INFO + 1024); LAS float* wl = (LAS float*)(lds + MOE_INFO + 2048);
    if (tid < MOE_BM) { const int sl = list[(size_t)e * CAP + s0 + (tid < ns ? tid : 0)]; slotl[tid] = sl; rsl[tid] = rstd[sl >> 1]; wl[tid] = wslot[sl]; }
    __syncthreads();
    const int lc = (lane & 7) ^ (lane >> 3);
    const int fro = (lane & 15) * 128, fc0 = ((lane >> 4) ^ (lane & 7)) << 4, fc1 = ((4 + (lane >> 4)) ^ (lane & 7)) << 4;
    {
        constexpr int ST = (MOE_BM + 512) * 64, GA = MOE_BM / 16, G = GA + 32, NG = (G + 7) / 8;
        static_assert(2 * ST <= MOE_HLO && 2 * MOE_HT <= ST, "moe gemm1 lds");
        const int lc4 = (lane & 3) ^ swzF(lane >> 4);
        const int fro32 = (lane & 15) * 64 + (((lane >> 4) ^ swzF((lane >> 2) & 3)) << 4);
        const char* src[NG];
#pragma unroll
        for (int i = 0; i < NG; ++i) { const int g = wave + 8 * i;
            if (g < GA) src[i] = (const char*)(hb + (size_t)(slotl[g * 16 + (lane >> 2)] >> 1) * D) + lc4 * 16;
            else if (g < G) src[i] = (const char*)(wgu + (size_t)((g - GA) * 16 + (lane >> 2)) * D) + lc4 * 16;
            else src[i] = nullptr; }
        f32x4 acc[MOE_MT][4];
#pragma unroll
        for (int mi = 0; mi < MOE_MT; ++mi)
#pragma unroll
            for (int ni = 0; ni < 4; ++ni) acc[mi][ni] = (f32x4){0.f, 0.f, 0.f, 0.f};
#define M1_STAGE(st, step) do { _Pragma("unroll") for (int _i = 0; _i < NG; ++_i) { const int _g = wave + 8 * _i; if (_g < G) \
        __builtin_amdgcn_global_load_lds((const unsigned*)(src[_i] + (size_t)(step) * 64), (LAS unsigned*)(lds + (st) * ST + _g * 1024), 16, 0, 0); } } while (0)
        M1_STAGE(0, 0);
        for (int step = 0; step < 32; ++step) {
            asm volatile("s_waitcnt vmcnt(0)" ::: "memory");
            __syncthreads();
            if (step + 1 < 32) M1_STAGE((step + 1) & 1, step + 1);
            LAS const unsigned char* sa = lds + (step & 1) * ST + fro32;
            LAS const unsigned char* sb = lds + (step & 1) * ST + (MOE_BM + wave * 64) * 64 + fro32;
            bf16x8 bfr[4];
#pragma unroll
            for (int ni = 0; ni < 4; ++ni) bfr[ni] = *(LAS const bf16x8*)(sb + ni * 1024);
#pragma unroll
            for (int mi = 0; mi < MOE_MT; ++mi) { const bf16x8 af = *(LAS const bf16x8*)(sa + mi * 1024);
#pragma unroll
                for (int ni = 0; ni < 4; ++ni) acc[mi][ni] = __builtin_amdgcn_mfma_f32_16x16x32_bf16(bfr[ni], af, acc[mi][ni], 0, 0, 0); }
        }
#undef M1_STAGE
        int lane_h = threadIdx.x & 63; asm volatile("" : "+v"(lane_h));
#define lane lane_h
#pragma unroll
        for (int p = 0; p < 2; ++p) {
            const int n = 32 * wave + 16 * p + (lane >> 4) * 4;
            const int csw = ((n & 63) >> 3);
#pragma unroll
            for (int mi = 0; mi < MOE_MT; ++mi) { const int row = mi * 16 + (lane & 15); const float rs = rsl[row]; float hv[4];
#pragma unroll
                for (int r = 0; r < 4; ++r) { const float g = acc[mi][2 * p][r] * rs, u = acc[mi][2 * p + 1][r] * rs; hv[r] = g / (1.0f + __expf(-g)) * u; }
                *(LAS u32x2*)(lds + moe_hoff(n >> 6) + row * 128 + ((csw ^ (row & 7)) << 4) + (n & 4) * 2) = (u32x2){pk2(hv[0], hv[1]), pk2(hv[2], hv[3])}; }
        }
#undef lane
    }
    __syncthreads();
    MSTAMP(21);
    {
        const char* src2[4];
#pragma unroll
        for (int i = 0; i < 4; ++i) src2[i] = (const char*)(wd + (size_t)((wave + 8 * i) * 8 + (lane >> 3)) * DE) + lc * 16;
        f32x4 acc[MOE_MT][2];
#pragma unroll
        for (int mi = 0; mi < MOE_MT; ++mi) { acc[mi][0] = (f32x4){0.f, 0.f, 0.f, 0.f}; acc[mi][1] = (f32x4){0.f, 0.f, 0.f, 0.f}; }
#define M2_STAGE(st, q) do { _Pragma("unroll") for (int _i = 0; _i < 4; ++_i) \
        __builtin_amdgcn_global_load_lds((const unsigned*)(src2[_i] + (size_t)((q) >> 2) * (256 * 512) + (size_t)((q) & 3) * 128), (LAS unsigned*)(lds + MOE_B2 + (st) * MOE_ST2 + (wave + 8 * _i) * 1024), 16, 0, 0); } while (0)
        M2_STAGE(0, 0);
        for (int q = 0; q < 16; ++q) {
            asm volatile("s_waitcnt vmcnt(0)" ::: "memory");
            __syncthreads();
            if (q + 1 < 16) M2_STAGE((q + 1) & 1, q + 1);
            LAS const unsigned char* sa = lds + moe_hoff(q & 3) + fro;
            LAS const unsigned char* sb = lds + MOE_B2 + (q & 1) * MOE_ST2 + (wave * 32) * 128 + fro;
#pragma unroll
            for (int ks = 0; ks < 2; ++ks) { const int fc = ks ? fc1 : fc0;
                const bf16x8 b0 = *(LAS const bf16x8*)(sb + fc), b1 = *(LAS const bf16x8*)(sb + 2048 + fc);
#pragma unroll
                for (int mi = 0; mi < MOE_MT; ++mi) { const bf16x8 af = *(LAS const bf16x8*)(sa + mi * 2048 + fc);
                    acc[mi][0] = __builtin_amdgcn_mfma_f32_16x16x32_bf16(b0, af, acc[mi][0], 0, 0, 0);
                    acc[mi][1] = __builtin_amdgcn_mfma_f32_16x16x32_bf16(b1, af, acc[mi][1], 0, 0, 0); }
            }
            if ((q & 3) == 3) {
                const int cb = (q >> 2) * 256 + wave * 32 + (lane >> 4) * 4;
#pragma unroll
                for (int mi = 0; mi < MOE_MT; ++mi) { const int row = mi * 16 + (lane & 15);
                    if (row < ns) { const float w = wl[row]; bf16_t* yr = ybuf + (size_t)slotl[row] * D + cb;
#pragma unroll
                        for (int ni = 0; ni < 2; ++ni) { const f32x4 v = acc[mi][ni] * w; *(u32x2*)(yr + ni * 16) = (u32x2){pk2(v[0], v[1]), pk2(v[2], v[3])}; } }
                    acc[mi][0] = (f32x4){0.f, 0.f, 0.f, 0.f}; acc[mi][1] = (f32x4){0.f, 0.f, 0.f, 0.f}; }
            }
        }
#undef M2_STAGE
    }
#undef moe_hoff
    __syncthreads();
    MSTAMP(22);
#undef MSTAMP
}
__device__ __forceinline__ void moe_phase(LAS unsigned char* lds, int* cnt, const int* list, const bf16_t* hb, const float* rstd, const float* wslot, const bf16_t* wgu, const bf16_t* wd, bf16_t* ybuf, int bid, int nblk, unsigned long long* tsb = nullptr) {
    const bool grp = (nblk % 8) == 0;
    int ntile[NE]; int gsum = 0; bool fit = grp;
#pragma unroll
    for (int e = 0; e < NE; ++e) { const int c = __hip_atomic_load(cnt + e * 64, __ATOMIC_RELAXED, __HIP_MEMORY_SCOPE_AGENT); const int bm = 144; ntile[e] = (c + bm - 1) / bm;
        gsum = (e & 3) == 0 ? ntile[e] : gsum + ntile[e]; if ((e & 3) == 3 && gsum > nblk / 8) fit = false; }
    const int x = bid % 8;
    int u = fit ? bid / 8 : (grp ? x * (nblk / 8) + bid / 8 : bid), base = 0;
    const int stride = fit ? nblk / 8 : nblk;
#pragma unroll 1
    for (int e = 0; e < NE; ++e) {
        if (fit && (e >> 2) != x) continue;
        const int c = __hip_atomic_load(cnt + e * 64, __ATOMIC_RELAXED, __HIP_MEMORY_SCOPE_AGENT);
        const bool big = false; const int bm = 144, nt = (c + bm - 1) / bm;
        while (u < base + nt) { const int t = u - base; const int ns = c - t * bm < bm ? c - t * bm : bm;
            moe_unit<9>(lds, e, t * bm, ns, list, hb, rstd, wslot, wgu + (size_t)e * 512 * 1024, wd + (size_t)e * 1024 * 256, ybuf, tsb);
            u += stride; }
        base += nt;
    }
}

template <int MT>
__device__ __forceinline__ void l1proj_unit(LAS unsigned char* lds, int row0, int mrow0, bf16_t* hb, const bf16_t* __restrict__ ybuf, const bf16_t* __restrict__ win_t, const bf16_t* __restrict__ wuq_t,
                                            const bf16_t* __restrict__ wukv_t, const float2* __restrict__ cs, bf16_t* kpe, bf16_t* Q1, bf16_t* K1, bf16_t* VT1) {
    constexpr int BM = 16 * MT, STW = (BM + 512) * 64, KT = BM * 64  , CQN = 0, CKV = 8 * KT, RB = 12 * KT, STB = 32768, PART = 3 * STW;
    static_assert(RB + 3 * STB <= LDS_MISC && PART + 8 * BM * 4 <= LDS_MISC, "l1proj lds");
    const int tid = threadIdx.x, lane = tid & 63, wave = __builtin_amdgcn_readfirstlane(tid >> 6);
    LAS float* rsl = (LAS float*)(lds + LDS_MISC + 256);
#define L1_GROW(r) ((r) < 64 ? row0 + (r) : mrow0 + (r) - 64)
    for (int r = wave; r < BM; r += NWAVE) {
        const size_t grow = L1_GROW(r); float ss = 0.f;
#pragma unroll
        for (int j = 0; j < 4; ++j) { const size_t c = j * 256 + lane * 4;
            const u32x2 h = *(const u32x2*)(hb + grow * D + c), y0 = *(const u32x2*)(ybuf + (grow * 2) * D + c), y1 = *(const u32x2*)(ybuf + (grow * 2 + 1) * D + c);
            float v[4];
            v[0] = __uint_as_float(h.x << 16) + __uint_as_float(y0.x << 16) + __uint_as_float(y1.x << 16);
            v[1] = __uint_as_float(h.x & 0xffff0000u) + __uint_as_float(y0.x & 0xffff0000u) + __uint_as_float(y1.x & 0xffff0000u);
            v[2] = __uint_as_float(h.y << 16) + __uint_as_float(y0.y << 16) + __uint_as_float(y1.y << 16);
            v[3] = __uint_as_float(h.y & 0xffff0000u) + __uint_as_float(y0.y & 0xffff0000u) + __uint_as_float(y1.y & 0xffff0000u);
            ss += v[0] * v[0] + v[1] * v[1] + v[2] * v[2] + v[3] * v[3];
            *(u32x2*)(hb + grow * D + c) = (u32x2){pk2(v[0], v[1]), pk2(v[2], v[3])}; }
        ss = wave_sum(ss); if (lane == 0) rsl[r] = rsqrtf(ss * (1.0f / D) + EPS);
    }
    asm volatile("s_waitcnt vmcnt(0)" ::: "memory");
    __syncthreads();
    const int lc = (lane & 3) ^ swzF(lane >> 4);
    const int fro = (lane & 15) * 64 + (((lane >> 4) ^ swzF((lane >> 2) & 3)) << 4);
    f32x4 acc[MT][4];
#pragma unroll
    for (int mi = 0; mi < MT; ++mi)
#pragma unroll
        for (int ni = 0; ni < 4; ++ni) acc[mi][ni] = (f32x4){0.f, 0.f, 0.f, 0.f};
    {
        const char* srcb[4];
#pragma unroll
        for (int i = 0; i < 4; ++i) srcb[i] = (const char*)(win_t + (size_t)((wave + 8 * i) * 16 + (lane >> 2)) * D) + lc * 16;
        const char* srca = (const char*)(hb + (size_t)L1_GROW((wave < MT ? wave : 0) * 16 + (lane >> 2)) * D) + lc * 16;
#define W_ISSUE(st, kt) do { if (wave < MT) __builtin_amdgcn_global_load_lds((const unsigned*)(srca + (size_t)(kt) * 64), (LAS unsigned*)(lds + (st) * STW + wave * 1024), 16, 0, 16); \
        _Pragma("unroll") for (int _i = 0; _i < 4; ++_i) __builtin_amdgcn_global_load_lds((const unsigned*)(srcb[_i] + (size_t)(kt) * 64), (LAS unsigned*)(lds + (st) * STW + (MT + wave + 8 * _i) * 1024), 16, 0, 0); } while (0)
        W_ISSUE(0, 0); W_ISSUE(1, 1);
        int st = 0;
        for (int kt = 0; kt < 32; ++kt) {
            if (kt + 1 < 32) { if (wave < MT) wait_vm<5>(); else wait_vm<4>(); } else wait_vm<0>();
            __builtin_amdgcn_s_barrier(); asm volatile("" ::: "memory");
            if (kt + 2 < 32) W_ISSUE(st == 0 ? 2 : st - 1, kt + 2);
            LAS const unsigned char* sa = lds + st * STW + fro;
            LAS const unsigned char* sb = lds + st * STW + (BM + wave * 64) * 64 + fro;
            bf16x8 bfr[4];
#pragma unroll
            for (int ni = 0; ni < 4; ++ni) bfr[ni] = *(LAS const bf16x8*)(sb + ni * 1024);
#pragma unroll
            for (int mi = 0; mi < MT; ++mi) { const bf16x8 af = *(LAS const bf16x8*)(sa + mi * 1024);
#pragma unroll
                for (int ni = 0; ni < 4; ++ni) acc[mi][ni] = __builtin_amdgcn_mfma_f32_16x16x32_bf16(bfr[ni], af, acc[mi][ni], 0, 0, 0); }
            st = st == 2 ? 0 : st + 1;
        }
#undef W_ISSUE
    }
    asm volatile("s_waitcnt lgkmcnt(0)" ::: "memory");
    __syncthreads();
    LAS float* part = (LAS float*)(lds + PART);
    int lane_e = lane; asm volatile("" : "+v"(lane_e));
#define lane lane_e
#pragma unroll
    for (int mi = 0; mi < MT; ++mi) { const float rs = rsl[mi * 16 + (lane & 15)]; float ss = 0.f;
#pragma unroll
        for (int ni = 0; ni < 4; ++ni) { acc[mi][ni] = acc[mi][ni] * rs; ss += acc[mi][ni][0] * acc[mi][ni][0] + acc[mi][ni][1] * acc[mi][ni][1] + acc[mi][ni][2] * acc[mi][ni][2] + acc[mi][ni][3] * acc[mi][ni][3]; }
        ss += __shfl_xor(ss, 16); ss += __shfl_xor(ss, 32);
        if (lane < 16) part[wave * BM + mi * 16 + lane] = ss; }
    __syncthreads();
    if (wave < 6) {
#pragma unroll
        for (int mi = 0; mi < MT; ++mi) { const int row = mi * 16 + (lane & 15);
            const float tot = wave < 4 ? (part[row] + part[BM + row]) + (part[2 * BM + row] + part[3 * BM + row]) : part[4 * BM + row] + part[5 * BM + row];
            const float rn = rsqrtf(tot * (wave < 4 ? 1.0f / 256 : 1.0f / 128) + EPS);
#pragma unroll
            for (int ni = 0; ni < 4; ++ni) { const int cc = (wave < 4 ? 64 * wave : 64 * (wave - 4)) + ni * 16 + (lane >> 4) * 4; const f32x4 v = acc[mi][ni] * rn;
                *(LAS u32x2*)(lds + (wave < 4 ? CQN : CKV) + (cc >> 5) * KT + row * 64 + (((((cc & 31) >> 3)) ^ swzF((row >> 2) & 3)) << 4) + (cc & 4) * 2) = (u32x2){pk2(v[0], v[1]), pk2(v[2], v[3])}; } }
    } else if (wave == 6) {
#pragma unroll
        for (int mi = 0; mi < MT; ++mi) { const int row = mi * 16 + (lane & 15); const int grow = L1_GROW(row); const int pos = row_pos(grow), d0 = (lane >> 4) * 4;
            f32x4 o1, o2;
#pragma unroll
            for (int r = 0; r < 4; ++r) { const float2 t = cs[pos * 32 + 2 * (d0 + r)]; const float x1 = acc[mi][0][r], x2 = acc[mi][1][r]; o1[r] = x1 * t.x - x2 * t.y; o2[r] = x2 * t.x + x1 * t.y; }
            bf16_t* kr = kpe + ((size_t)row_batch(grow) * LP + pos) * 32;
            *(u32x2*)(kr + d0) = (u32x2){pk2(o1[0], o1[1]), pk2(o1[2], o1[3])}; *(u32x2*)(kr + 16 + d0) = (u32x2){pk2(o2[0], o2[1]), pk2(o2[2], o2[3])}; }
    }
#undef lane
    __syncthreads();
    const char* srcu[4];
#define U_ISSUE(st, base, pitchB, chunk, kt) do { _Pragma("unroll") for (int _i = 0; _i < 4; ++_i) \
        __builtin_amdgcn_global_load_lds((const unsigned*)(srcu[_i] + (size_t)(chunk) * 512 * (pitchB) + (size_t)(kt) * 64), (LAS unsigned*)(lds + RB + (st) * STB + (wave + 8 * _i) * 1024), 16, 0, 0); } while (0)
    {
#pragma unroll
        for (int i = 0; i < 4; ++i) srcu[i] = (const char*)(wuq_t + (size_t)((wave + 8 * i) * 16 + (lane >> 2)) * 256) + lc * 16;
#pragma unroll
        for (int mi = 0; mi < MT; ++mi)
#pragma unroll
            for (int ni = 0; ni < 4; ++ni) acc[mi][ni] = (f32x4){0.f, 0.f, 0.f, 0.f};
        U_ISSUE(0, 0, 512, 0, 0); U_ISSUE(1, 0, 512, 0, 1);
        int st = 0;
        for (int q = 0; q < 24; ++q) {
            if (q + 1 < 24) wait_vm<4>(); else wait_vm<0>();
            __builtin_amdgcn_s_barrier(); asm volatile("" ::: "memory");
            if (q + 2 < 24) U_ISSUE(st == 0 ? 2 : st - 1, 0, 512, (q + 2) >> 3, (q + 2) & 7);
            LAS const unsigned char* sa = lds + CQN + (q & 7) * KT + fro;
            LAS const unsigned char* sb = lds + RB + st * STB + (wave * 64) * 64 + fro;
            bf16x8 bfr[4];
#pragma unroll
            for (int ni = 0; ni < 4; ++ni) bfr[ni] = *(LAS const bf16x8*)(sb + ni * 1024);
#pragma unroll
            for (int mi = 0; mi < MT; ++mi) { const bf16x8 af = *(LAS const bf16x8*)(sa + mi * 1024);
#pragma unroll
                for (int ni = 0; ni < 4; ++ni) acc[mi][ni] = __builtin_amdgcn_mfma_f32_16x16x32_bf16(bfr[ni], af, acc[mi][ni], 0, 0, 0); }
            if ((q & 7) == 7) {
                int lane_q = lane; asm volatile("" : "+v"(lane_q));
#define lane lane_q
                const float scale = 0.10206207261596577f * 1.4426950408889634f; const int d0 = (lane >> 4) * 4;
#pragma unroll
                for (int mi = 0; mi < MT; ++mi) { const int grow = L1_GROW(mi * 16 + (lane & 15)); const int pos = row_pos(grow);
#pragma unroll
                    for (int bi = 0; bi < 2; ++bi) { const int gc = (q >> 3) * 512 + 64 * wave + bi * 32; bf16_t* orow = Q1 + (size_t)grow * 1536 + gc;
                        f32x4 v1 = acc[mi][2 * bi], v2 = acc[mi][2 * bi + 1];
                        if (((gc >> 5) % 3) == 2) {
#pragma unroll
                            for (int r = 0; r < 4; ++r) { const float2 t = cs[pos * 32 + 2 * (d0 + r)]; const float x1 = v1[r], x2 = v2[r]; v1[r] = x1 * t.x - x2 * t.y; v2[r] = x2 * t.x + x1 * t.y; } }
                        v1 = v1 * scale; v2 = v2 * scale;
                        *(u32x2*)(orow + d0) = (u32x2){pk2(v1[0], v1[1]), pk2(v1[2], v1[3])}; *(u32x2*)(orow + 16 + d0) = (u32x2){pk2(v2[0], v2[1]), pk2(v2[2], v2[3])}; }
#pragma unroll
                    for (int ni = 0; ni < 4; ++ni) acc[mi][ni] = (f32x4){0.f, 0.f, 0.f, 0.f}; }
#undef lane
            }
            st = st == 2 ? 0 : st + 1;
        }
    }
    asm volatile("s_waitcnt lgkmcnt(0)" ::: "memory");
    __syncthreads();
    {
#pragma unroll
        for (int i = 0; i < 4; ++i) srcu[i] = (const char*)(wukv_t + (size_t)((wave + 8 * i) * 16 + (lane >> 2)) * 128) + lc * 16;
#pragma unroll
        for (int mi = 0; mi < MT; ++mi)
#pragma unroll
            for (int ni = 0; ni < 4; ++ni) acc[mi][ni] = (f32x4){0.f, 0.f, 0.f, 0.f};
        U_ISSUE(0, 0, 256, 0, 0); U_ISSUE(1, 0, 256, 0, 1);
        int st = 0;
        for (int q = 0; q < 16; ++q) {
            if (q + 1 < 16) wait_vm<4>(); else wait_vm<0>();
            __builtin_amdgcn_s_barrier(); asm volatile("" ::: "memory");
            if (q + 2 < 16) U_ISSUE(st == 0 ? 2 : st - 1, 0, 256, (q + 2) >> 2, (q + 2) & 3);
            LAS const unsigned char* sa = lds + CKV + (q & 3) * KT + fro;
            LAS const unsigned char* sb = lds + RB + st * STB + (wave * 64) * 64 + fro;
            bf16x8 bfr[4];
#pragma unroll
            for (int ni = 0; ni < 4; ++ni) bfr[ni] = *(LAS const bf16x8*)(sb + ni * 1024);
            if (q < 8) {
#pragma unroll
                for (int mi = 0; mi < MT; ++mi) { const bf16x8 af = *(LAS const bf16x8*)(sa + mi * 1024);
#pragma unroll
                    for (int ni = 0; ni < 4; ++ni) acc[mi][ni] = __builtin_amdgcn_mfma_f32_16x16x32_bf16(bfr[ni], af, acc[mi][ni], 0, 0, 0); }
            } else {
#pragma unroll
                for (int mi = 0; mi < MT; ++mi) { const bf16x8 af = *(LAS const bf16x8*)(sa + mi * 1024);
#pragma unroll
                    for (int ni = 0; ni < 4; ++ni) acc[mi][ni] = __builtin_amdgcn_mfma_f32_16x16x32_bf16(af, bfr[ni], acc[mi][ni], 0, 0, 0); }
            }
            if ((q & 3) == 3) {
                const int ch = q >> 2;
                int lane_k = lane; asm volatile("" : "+v"(lane_k));
#define lane lane_k
                if (ch < 2) {
#pragma unroll
                    for (int mi = 0; mi < MT; ++mi) { const int grow = L1_GROW(mi * 16 + (lane & 15)); const size_t kr = (size_t)row_batch(grow) * LP + row_pos(grow);
#pragma unroll
                        for (int ni = 0; ni < 4; ++ni) { const f32x4 v = acc[mi][ni];
                            *(u32x2*)(K1 + kr * D + 512 * ch + 64 * wave + ni * 16 + (lane >> 4) * 4) = (u32x2){pk2(v[0], v[1]), pk2(v[2], v[3])}; acc[mi][ni] = (f32x4){0.f, 0.f, 0.f, 0.f}; } }
                } else {
#pragma unroll
                    for (int mi = 0; mi < MT; ++mi) { const int grow0 = L1_GROW(mi * 16 + (lane >> 4) * 4); const int b = row_batch(grow0), pp = perm16(row_pos(grow0));
#pragma unroll
                        for (int ni = 0; ni < 4; ++ni) { const int hd = 512 * (ch - 2) + 64 * wave + ni * 16 + (lane & 15); const f32x4 v = acc[mi][ni];
                            *(u32x2*)(VT1 + (size_t)(b * 1024 + hd) * LP + pp) = (u32x2){pk2(v[0], v[1]), pk2(v[2], v[3])}; acc[mi][ni] = (f32x4){0.f, 0.f, 0.f, 0.f}; } }
                }
#undef lane
            }
            st = st == 2 ? 0 : st + 1;
        }
    }
#undef U_ISSUE
#undef L1_GROW
    asm volatile("s_waitcnt lgkmcnt(0)" ::: "memory");
    __syncthreads();
}
__device__ __forceinline__ void l1proj_phase(LAS unsigned char* lds, bf16_t* hb, const bf16_t* ybuf, const bf16_t* win_t, const bf16_t* wuq_t, const bf16_t* wukv_t, const float2* cs, bf16_t* kpe,
                                             bf16_t* Q1, bf16_t* K1, bf16_t* VT1, int bid, int nblk) {
    { const int gt = bid * NTHR + threadIdx.x, ngt = nblk * NTHR;
      for (int idx = gt; idx < 2 * 48 * 1024; idx += ngt) { const int b = idx / (48 * 1024), r = idx % (48 * 1024); K1[((size_t)b * LP + 8208) * 1024 + r] = 0; }
      for (int idx = gt; idx < 2 * 16 * 64 * 48; idx += ngt) { const int rr = idx / 48, c = idx % 48; VT1[(size_t)rr * LP + 8208 + c] = 0; } }
    for (int u = bid; u < 256; u += nblk) {
        if (u >= 254) l1proj_unit<5>(lds, u * 64, MREAL + (u - 254) * 16, hb, ybuf, win_t, wuq_t, wukv_t, cs, kpe, Q1, K1, VT1);
        else l1proj_unit<4>(lds, u * 64, MREAL, hb, ybuf, win_t, wuq_t, wukv_t, cs, kpe, Q1, K1, VT1);
    }
}

struct EpiNull { int m0, n0;
    template <int MT, int NT> __device__ __forceinline__ void operator()(f32x4 (&acc)[MT][NT], int, int, int) const {
#pragma unroll
        for (int mi = 0; mi < MT; ++mi)
#pragma unroll
            for (int ni = 0; ni < NT; ++ni) asm volatile("" :: "v"(acc[mi][ni])); } };
__device__ __forceinline__ void transpose_item(const float* __restrict__ W, int N, const float* __restrict__ gain, bf16_t* dst, int ldk, int drow0, int k0, int n0, LAS float* scr, int lane, int dskip = 0) {
#pragma unroll 8
    for (int i = 0; i < 32; ++i) { const int kk = 2 * i + (lane >> 5); float v = W[(size_t)(k0 + kk) * N + n0 + (lane & 31)]; if (gain) v *= gain[k0 + kk]; scr[kk * 33 + (lane & 31)] = v; }
    asm volatile("s_waitcnt lgkmcnt(0)" ::: "memory");
    const int c = lane & 7;
#pragma unroll
    for (int j = 0; j < 4; ++j) { const int n = (lane >> 3) + 8 * j; const LAS float* s = scr + (8 * c) * 33 + n;
        u32x4 o; o.x = pk2(s[0 * 33], s[1 * 33]); o.y = pk2(s[2 * 33], s[3 * 33]); o.z = pk2(s[4 * 33], s[5 * 33]); o.w = pk2(s[6 * 33], s[7 * 33]);
        *(u32x4*)(dst + (size_t)(drow0 + n + (n >= 16 ? dskip : 0)) * ldk + k0 + 8 * c) = o; }
    asm volatile("s_waitcnt lgkmcnt(0)" ::: "memory");
}
struct MoeItem { const float* src; const float* gain; bf16_t* dst; int pitch, ldk, kind, nrow0; };
__device__ __forceinline__ MoeItem moe_item(int it, const float* wgate, const float* wup, const float* wdown, const float* gain, bf16_t* wgu_t, bf16_t* wd_t) {
    const int e = it / 48, r = it % 48, which = r >> 4, q = r & 15; MoeItem d;
    if (which < 2) { d.src = (which ? wup : wgate) + (size_t)e * D * DE + (size_t)q * 64 * DE; d.gain = gain + q * 64; d.dst = wgu_t + (size_t)e * 512 * 1024 + q * 64; d.pitch = DE; d.ldk = 1024; d.kind = which; d.nrow0 = 0; }
    else { const int kb = q >> 2, nb = q & 3; d.src = wdown + (size_t)e * DE * D + (size_t)kb * 64 * D + nb * 256; d.gain = nullptr; d.dst = wd_t + (size_t)e * 1024 * 256 + kb * 64; d.pitch = D; d.ldk = 256; d.kind = 2; d.nrow0 = nb * 256; }
    return d;
}
__device__ __forceinline__ void moe_weight_items(const float* wgate, const float* wup, const float* wdown, const float* gain, bf16_t* wgu_t, bf16_t* wd_t, LAS float* T, int bid, int nblk) {
    const int tid = threadIdx.x;
    f32x4 R[8];
    int it = bid;
    if (it >= NE * 48) return;
    MoeItem cur = moe_item(it, wgate, wup, wdown, gain, wgu_t, wd_t);
#pragma unroll
    for (int i = 0; i < 8; ++i) { const int idx = tid + i * NTHR; R[i] = *(const f32x4*)(cur.src + (size_t)(idx >> 6) * cur.pitch + (idx & 63) * 4); }
    for (;;) {
#pragma unroll
        for (int i = 0; i < 8; ++i) { const int idx = tid + i * NTHR, k = idx >> 6, c4 = idx & 63; f32x4 v = R[i]; if (cur.gain) v = v * cur.gain[k];
            LAS float* t = T + k * 257 + c4 * 4; t[0] = v[0]; t[1] = v[1]; t[2] = v[2]; t[3] = v[3]; }
        __syncthreads();
        const int nit = it + nblk; const bool more = nit < NE * 48;
        MoeItem nxt = cur;
        if (more) { nxt = moe_item(nit, wgate, wup, wdown, gain, wgu_t, wd_t);
#pragma unroll
            for (int i = 0; i < 8; ++i) { const int idx = tid + i * NTHR; R[i] = *(const f32x4*)(nxt.src + (size_t)(idx >> 6) * nxt.pitch + (idx & 63) * 4); } }
#pragma unroll
        for (int i = 0; i < 4; ++i) { const int idx = tid + i * NTHR, kc = idx & 7, n = idx >> 3;
            const LAS float* t = T + (8 * kc) * 257 + n;
            u32x4 o; o.x = pk2(t[0], t[257]); o.y = pk2(t[2 * 257], t[3 * 257]); o.z = pk2(t[4 * 257], t[5 * 257]); o.w = pk2(t[6 * 257], t[7 * 257]);
            const int row = cur.kind == 2 ? cur.nrow0 + n : (n >> 4) * 32 + cur.kind * 16 + (n & 15);
            *(u32x4*)(cur.dst + (size_t)row * cur.ldk + 8 * kc) = o; }
        __syncthreads();
        if (!more) break;
        cur = nxt; it = nit;
    }
}
__device__ __forceinline__ void p0_prologue(const MArgs& a, LAS unsigned char* lds, int bid, int nblk) {
    const int tid = threadIdx.x, lane = tid & 63, wave = __builtin_amdgcn_readfirstlane(tid >> 6);
    const int gw = bid * NWAVE + wave, ngw = nblk * NWAVE, gt = bid * NTHR + tid, ngt = nblk * NTHR;
    unsigned char* ws = a.ws;
    float2* cs = (float2*)(ws + WS_ROPE);
    for (int _r = 0; _r < (PROBE_PHASE == 301 ? 2 : 1); ++_r)
    for (int idx = gt; idx < LPOS * 32; idx += ngt) { const int pos = idx >> 5, i = idx & 31; const float inv = 1.0f / powf(10000.0f, (float)(2 * i) / 64.0f); float s, c; sincosf((float)pos * inv, &s, &c); cs[idx] = make_float2(c, s); }
    float* wrf = (float*)(ws + W2_WRF);
    for (int idx = gt; idx < 2 * 36 * 1024; idx += ngt) { const int l = idx / (36 * 1024), j = (idx >> 10) % 36, k = idx & 1023;
        const float g = a.in[3][l * D + k]; wrf[idx] = g * (j < 4 ? a.in[16][(size_t)l * D * 4 + k * 4 + j] : a.in[18][(size_t)l * D * 32 + k * 32 + (j - 4)]); }
    { u32x4* z = (u32x4*)(ws + W2_WIN + (size_t)416 * 1024 * 2); for (int idx = gt; idx < 96 * 1024 * 2 / 16; idx += ngt) z[idx] = (u32x4){0u, 0u, 0u, 0u}; }
    { bf16_t* kpe = (bf16_t*)(ws + WS_KPE); for (int idx = gt; idx < 2 * 48 * 32; idx += ngt) { const int b = idx / (48 * 32), r = idx % (48 * 32); kpe[((size_t)b * LP + 8208) * 32 + r] = 0; }
      bf16_t* vt0 = (bf16_t*)(ws + B_VT0); for (int idx = gt; idx < 2 * 2 * 64 * 48; idx += ngt) { const int rr = idx / 48, c = idx % 48; vt0[(size_t)rr * LP + 8208 + c] = 0; } }
    { bf16_t* hb = (bf16_t*)(ws + W2_HB); float* rstd = (float*)(ws + W2_RSTD);
      for (int _r = 0; _r < (PROBE_PHASE == 303 ? 2 : 1); ++_r)
      for (int row = gw; row < MTOT; row += ngw) {
        const float* src = row < MREAL ? a.in[0] + (size_t)row * D : a.in[1] + (size_t)row_pos(row) * D;
        float ss = 0.f;
#pragma unroll
        for (int j = 0; j < 4; ++j) { const f32x4 v = *(const f32x4*)(src + j * 256 + lane * 4); ss += v[0] * v[0] + v[1] * v[1] + v[2] * v[2] + v[3] * v[3];
            *(u32x2*)(hb + (size_t)row * D + j * 256 + lane * 4) = (u32x2){pk2(v[0], v[1]), pk2(v[2], v[3])}; }
        ss = wave_sum(ss); if (lane == 0) rstd[row] = rsqrtf(ss * (1.0f / D) + EPS);
      } }
    LAS float* scr = (LAS float*)(lds + wave * 16384);
    for (int _r = 0; _r < (PROBE_PHASE == 304 ? 2 : 1); ++_r)
    for (int it = gw; it < 2192; it += ngw) {
        int r = it;
        if (r < 640) { transpose_item(a.in[5], NQKV, a.in[2], (bf16_t*)(ws + W2_WQKV), 1024, (r % 40) * 32, (r / 40) * 64, (r % 40) * 32, scr, lane); continue; } r -= 640;
        if (r < 512) { transpose_item(a.in[8], D, nullptr, (bf16_t*)(ws + W2_WO0), 1024, (r & 31) * 32, (r >> 5) * 64, (r & 31) * 32, scr, lane); continue; } r -= 512;
        if (r < 208) { transpose_item(a.in[10], 416, a.in[2] + D, (bf16_t*)(ws + W2_WIN), 1024, (r % 13) * 32, (r / 13) * 64, (r % 13) * 32, scr, lane); continue; } r -= 208;
        if (r < 192) { transpose_item(a.in[13], 1536, a.in[11], (bf16_t*)(ws + W2_WUQ), 256, (r % 48) * 32, (r / 48) * 64, (r % 48) * 32, scr, lane); continue; } r -= 192;
        if (r < 128) { const int nb32 = r & 63, hh = nb32 >> 2, part = nb32 & 3;
            transpose_item(a.in[14], 2048, a.in[12], (bf16_t*)(ws + W2_WUKV), 128, part < 2 ? hh * 64 + part * 32 : 1024 + hh * 64 + (part - 2) * 32, (r >> 6) * 64, nb32 * 32, scr, lane); continue; } r -= 128;
        transpose_item(a.in[15], D, nullptr, (bf16_t*)(ws + W2_WO1), 1024, (r & 31) * 32, (r >> 5) * 64, (r & 31) * 32, scr, lane);
    }
    __syncthreads();
    moe_weight_items(a.in[20], a.in[21], a.in[22], a.in[3], (bf16_t*)(ws + C_W0), (bf16_t*)(ws + C_W0 + MOE_WGU_BYTES), (LAS float*)lds, bid, nblk);
}

template <bool NSW, bool HALFN, class MakeEpi>
__device__ __forceinline__ void gemm_phase(LAS unsigned char* lds, const bf16_t* A, int lda, const bf16_t* Bt, int K, int pn0, int pn1, int bid, int nblk, const MakeEpi& mk) {
    constexpr int BN = HALFN ? 128 : 256;
    const int ntn = pn1 - pn0;
    const bool grp = (nblk % 8) == 0;
    const int x = grp ? bid % 8 : 0, j = grp ? bid / 8 : bid, nslot = grp ? nblk / 8 : nblk, pmg = grp ? 8 : 64;
    for (int u = j; u < pmg * ntn; u += nslot) {
        const int pm = x * pmg + u / ntn, pn = pn0 + u % ntn;
        RowDense ra{A, lda, pm * 256, MTOT - 1}; auto e = mk(pm * 256, pn * BN);
        if (HALFN) gemm_tile<4, 4, 4, 2, NSW>(lds, ra, Bt + (size_t)pn * BN * K, K, K / 32, e);
        else gemm_tile<8, 4, 2, 4, NSW>(lds, ra, Bt + (size_t)pn * BN * K, K, K / 32, e);
    }
    const int nfull = (pmg * ntn + nslot - 1) / nslot;
    for (int pn = pn0; pn < pn1; ++pn) {
        const int owner = (pn - pn0) * 37 % nblk;
        if (bid == owner) { RowDense ra{A, lda, MREAL, MTOT - 1}; auto e = mk(MREAL, pn * BN);
            if (HALFN) gemm_tile<1, 4, 4, 2, NSW>(lds, ra, Bt + (size_t)pn * BN * K, K, K / 32, e);
            else gemm_tile<1, 4, 2, 4, NSW>(lds, ra, Bt + (size_t)pn * BN * K, K, K / 32, e); }
    }
    (void)nfull;
}

constexpr int PH_PROLOGUE = 0, PH_QKV = 1, PH_SWA = 2, PH_OPROJ0 = 3, PH_ROUTE0 = 4, PH_MOE0 = 5, PH_COMBINE = 6, PH_WIN = 7, PH_CEPI = 8, PH_UQKV = 9, PH_MLA = 10, PH_OPROJ1 = 11, PH_ROUTE1 = 12, PH_MOE1 = 13, PH_FINAL = 14, PH_N = 15;
__global__ void __launch_bounds__(NTHR, 2) mega(MArgs a) {
    extern __shared__ __attribute__((aligned(16))) unsigned char lds_raw[];
    LAS unsigned char* lds = (LAS unsigned char*)lds_raw;
    const int tid = threadIdx.x, bid = blockIdx.x, nblk = gridDim.x;
    volatile LAS unsigned* misc = (volatile LAS unsigned*)(lds + LDS_MISC);
    if (tid < 64) misc[tid] = 0u;
    __syncthreads();
    unsigned char* ws = a.ws;
    XcdBarrier bar = xcd_barrier_post((unsigned*)(ws + WS_BAR) + a.li * XCD_BAR_WORDS, misc);
    if (tid == 0) misc[4] = xb_add((unsigned*)(ws + 32 * 1024) + 64 * bar.x, 1u);
    const int lo = a.ph_lo, hi = a.ph_hi;
#define IN(k) (lo <= (k) && (k) < hi)
#define REP(k) for (int _rep = 0; _rep < ((k) == PROBE_PHASE ? 2 : 1); ++_rep, (void)((k) == PROBE_PHASE && _rep == 1 ? (xcd_barrier(bar), 0) : 0))
#define STAMP(i) do { if (PROBE_PHASE >= 600 && bid == 0 && tid == 0) ((unsigned long long*)(ws + 512 * 1024))[i] = __builtin_amdgcn_s_memrealtime(); } while (0)
#define SEAM(k) do { if (IN(k) && IN((k) + 1)) xcd_barrier(bar); STAMP((k) + 1); } while (0)
    STAMP(0);
    if (IN(PH_PROLOGUE)) REP(PH_PROLOGUE) p0_prologue(a, lds, bid, nblk);
    SEAM(PH_PROLOGUE);
    int vbid = bid;
    if (IN(PH_PROLOGUE) && IN(PH_QKV)) {
        if (tid == 0) { bool ok = (nblk % 8) == 0 && bar.x < 8;
            for (int j = 0; j < 8; ++j) ok = ok && xb_ld((unsigned*)(ws + 32 * 1024) + 64 * j) == (unsigned)(nblk / 8);
            misc[5] = ok ? misc[4] * 8u + bar.x : (unsigned)bid; }
        __syncthreads();
        vbid = __builtin_amdgcn_readfirstlane((int)misc[5]);
    }
#define bid vbid
    if (IN(PH_QKV)) REP(PH_QKV) {
        const float* rstd = (const float*)(ws + W2_RSTD); const float* bias = a.in[6]; const float2* cs = (const float2*)(ws + WS_ROPE); bf16_t* qkv = (bf16_t*)(ws + B_QKV); bf16_t* vt0 = (bf16_t*)(ws + B_VT0);
        const bf16_t* hbA = (const bf16_t*)(ws + W2_HB); const bf16_t* Wt = (const bf16_t*)(ws + W2_WQKV);
        const bool grp = (nblk % 8) == 0; const int x = grp ? bid % 8 : 0, j = grp ? bid / 8 : bid, nslot = grp ? nblk / 8 : nblk, pmg = grp ? 8 : 64;
        for (int u = j; u < pmg * 6; u += nslot) {
            if (u < pmg * 4) { const int pm = x * pmg + (u >> 2), pn = u & 3; RowDense ra{hbA, D, pm * 256, MTOT - 1}; EpiQKV e{rstd, bias, cs, qkv, pm * 256, pn * 256};
                gemm_tile<8, 4, 2, 4, false>(lds, ra, Wt + (size_t)pn * 256 * D, D, D / 32, e);
            } else if (u < pmg * 5) { const int pm = x * pmg + (u - pmg * 4); RowDense ra{hbA, D, pm * 256, MTOT - 1}; EpiQKV e{rstd, bias, cs, qkv, pm * 256, 1024};
                gemm_tile<4, 4, 4, 2, false>(lds, ra, Wt + (size_t)1024 * D, D, D / 32, e);
            } else { const int pm = x * pmg + (u - pmg * 5); RowDense ra{hbA, D, pm * 256, MTOT - 1}; EpiV0 e{rstd, bias, vt0, pm * 256, 1152};
                gemm_tile<4, 4, 4, 2, true>(lds, ra, Wt + (size_t)1152 * D, D, D / 32, e);
            }
        }
        const int mu = bid - (nblk - 6);
        if (mu >= 0 && mu < 4) { RowDense ra{hbA, D, MREAL, MTOT - 1}; EpiQKV e{rstd, bias, cs, qkv, MREAL, mu * 256};
            gemm_tile<1, 4, 2, 4, false>(lds, ra, Wt + (size_t)mu * 256 * D, D, D / 32, e);
        } else if (mu == 4) { RowDense ra{hbA, D, MREAL, MTOT - 1}; EpiQKV e{rstd, bias, cs, qkv, MREAL, 1024};
            gemm_tile<1, 4, 4, 2, false>(lds, ra, Wt + (size_t)1024 * D, D, D / 32, e);
        } else if (mu == 5) { RowDense ra{hbA, D, MREAL, MTOT - 1}; EpiV0 e{rstd, bias, vt0, MREAL, 1152};
            gemm_tile<1, 4, 4, 2, true>(lds, ra, Wt + (size_t)1152 * D, D, D / 32, e);
        }
    }
    SEAM(PH_QKV);
    if (IN(PH_SWA)) REP(PH_SWA) swa_phase(lds, (const bf16_t*)(ws + B_QKV), (const bf16_t*)(ws + B_VT0), a.in[7], (bf16_t*)(ws + B_O0), bid, nblk);
    SEAM(PH_SWA);
    if (IN(PH_OPROJ0)) REP(PH_OPROJ0) {
        const float* bias = a.in[9]; bf16_t* hb = (bf16_t*)(ws + W2_HB);
        gemm_phase<false, false>(lds, (const bf16_t*)(ws + B_O0), D, (const bf16_t*)(ws + W2_WO0), D, 0, 4, bid, nblk, [=](int m0, int n0) { return EpiRes{bias, hb, m0, n0}; });
    }
    SEAM(PH_OPROJ0);
    if (IN(PH_ROUTE0))
        route_phase(lds, (const bf16_t*)(ws + W2_HB), (const float*)(ws + W2_WRF), a.in[17], a.in[19], (float*)(ws + W2_RSTD), (int*)(ws + WS_CTL),
                    (int*)(ws + W2_LIST), (float*)(ws + W2_WSLOT), bid, nblk);
    SEAM(PH_ROUTE0);
    if (IN(PH_MOE0)) REP(PH_MOE0) moe_phase(lds, (int*)(ws + WS_CTL), (const int*)(ws + W2_LIST), (const bf16_t*)(ws + W2_HB), (const float*)(ws + W2_RSTD), (const float*)(ws + W2_WSLOT),
                               (const bf16_t*)(ws + C_W0), (const bf16_t*)(ws + C_W0 + MOE_WGU_BYTES), (bf16_t*)(ws + B_Y0), bid, nblk, (unsigned long long*)(ws + 512 * 1024));
    SEAM(PH_MOE0);
    if (IN(PH_COMBINE)) l1proj_phase(lds, (bf16_t*)(ws + W2_HB), (const bf16_t*)(ws + B_Y0), (const bf16_t*)(ws + W2_WIN), (const bf16_t*)(ws + W2_WUQ), (const bf16_t*)(ws + W2_WUKV),
                                     (const float2*)(ws + WS_ROPE), (bf16_t*)(ws + WS_KPE), (bf16_t*)(ws + C_Q1), (bf16_t*)(ws + C_K1), (bf16_t*)(ws + C_V1), bid, nblk);
    STAMP(PH_WIN); STAMP(PH_CEPI); STAMP(PH_UQKV);
    SEAM(PH_UQKV);
    if (IN(PH_MLA)) REP(100) {
        moe_weight_items(a.in[20] + (size_t)NE * D * DE, a.in[21] + (size_t)NE * D * DE, a.in[22] + (size_t)NE * DE * D, a.in[3] + D, (bf16_t*)(ws + B_W1), (bf16_t*)(ws + B_W1 + MOE_WGU_BYTES),
                         (LAS float*)lds, bid, nblk);
    }
    if (IN(PH_MLA)) REP(PH_MLA) mla_phase(lds, (const bf16_t*)(ws + C_Q1), (const bf16_t*)(ws + C_K1), (const bf16_t*)(ws + WS_KPE), (const bf16_t*)(ws + C_V1), (bf16_t*)(ws + B_O1), bid, nblk);
    SEAM(PH_MLA);
    if (IN(PH_OPROJ1)) REP(PH_OPROJ1) {
        bf16_t* hb = (bf16_t*)(ws + W2_HB);
        gemm_phase<false, false>(lds, (const bf16_t*)(ws + B_O1), D, (const bf16_t*)(ws + W2_WO1), D, 0, 4, bid, nblk, [=](int m0, int n0) { return EpiRes{nullptr, hb, m0, n0}; });
    }
    SEAM(PH_OPROJ1);
    if (IN(PH_ROUTE1))
        route_phase(lds, (const bf16_t*)(ws + W2_HB), (const float*)(ws + W2_WRF) + 36 * 1024, a.in[17] + 4, a.in[19] + 32, (float*)(ws + W2_RSTD), (int*)(ws + WS_CTL) + 2048,
                    (int*)(ws + W2_LIST), (float*)(ws + W2_WSLOT), bid, nblk);
    SEAM(PH_ROUTE1);
    if (IN(PH_MOE1)) REP(PH_MOE1) moe_phase(lds, (int*)(ws + WS_CTL) + 2048, (const int*)(ws + W2_LIST), (const bf16_t*)(ws + W2_HB), (const float*)(ws + W2_RSTD), (const float*)(ws + W2_WSLOT),
                               (const bf16_t*)(ws + B_W1), (const bf16_t*)(ws + B_W1 + MOE_WGU_BYTES), (bf16_t*)(ws + C_Y1), bid, nblk);
    SEAM(PH_MOE1);
    if (IN(PH_FINAL)) REP(PH_FINAL) final_phase((const bf16_t*)(ws + W2_HB), (const bf16_t*)(ws + C_Y1), a.in[4], a.out, bid, nblk);
#undef bid
#undef IN
#undef SEAM
}

static void run_mega(hipStream_t s, const MArgs& base, int lo, int hi, int grid) {
    MArgs a = base; a.ph_lo = lo; a.ph_hi = hi; a.li = lo;
    hipLaunchKernelGGL(mega, dim3(grid), dim3(NTHR), LDS_BYTES, s, a);
}
extern "C" void kernel_launch(void* const* d_in, const int* in_sizes, int n_in, void* d_out, int out_size, void* d_ws, size_t ws_size, hipStream_t stream) {
    static int grid = 0;
    if (grid == 0) {
        if (n_in != 23 || ws_size < WS_END) { fprintf(stderr, "kernel_launch: unexpected n_in %d or ws_size %zu\n", n_in, ws_size); grid = -1; return; }
        if (hipFuncSetAttribute((const void*)mega, hipFuncAttributeMaxDynamicSharedMemorySize, LDS_BYTES) != hipSuccess) { fprintf(stderr, "hipFuncSetAttribute failed\n"); grid = -1; return; }
        int dev = 0, cus = 0, per_cu = 0;
        (void)hipGetDevice(&dev); (void)hipDeviceGetAttribute(&cus, hipDeviceAttributeMultiprocessorCount, dev);
        (void)hipOccupancyMaxActiveBlocksPerMultiprocessor(&per_cu, (const void*)mega, NTHR, LDS_BYTES);
        (void)hipGetLastError();
        if (per_cu < 1 || cus < 8) { fprintf(stderr, "kernel_launch: occupancy query reports %d workgroups/CU on %d CUs for %d threads + %d B LDS; nothing launched\n", per_cu, cus, NTHR, LDS_BYTES); grid = -1; return; }
        grid = cus;
    }
    if (grid < 0) return;
    (void)in_sizes; (void)out_size;
    unsigned char* ws = (unsigned char*)d_ws;
    MArgs base{}; for (int i = 0; i < 23; ++i) base.in[i] = (const float*)d_in[i]; base.out = (float*)d_out; base.ws = ws;
    (void)hipMemsetAsync(ws + WS_CTL, 0, 1 * MiB, stream);
    run_mega(stream, base, 0, PH_N, grid);
}
```

```cpp
#include <hip/hip_runtime.h>
#ifndef PROBE_PHASE
#define PROBE_PHASE -1
#endif
#include <cstdio>
#include <cstdint>

typedef unsigned short bf16_t;

constexpr int D = 1024, SEQ = 8192, NB = 2, NMETA = 16;
constexpr int MREAL = NB * SEQ;
constexpr int MTOT = MREAL + NB * NMETA;
constexpr int LPOS = NMETA + SEQ;
constexpr int NQKV = 1280;
constexpr int NE = 32, DE = 256;
constexpr int CAP = MTOT * 2;
constexpr float EPS = 1e-6f;

__device__ __forceinline__ float bf2f(bf16_t v) { return __uint_as_float(((unsigned)v) << 16); }
__device__ __forceinline__ bf16_t f2bf(float f) { unsigned u = __float_as_uint(f); u += 0x7fffu + ((u >> 16) & 1u); return (bf16_t)(u >> 16); }
__device__ __forceinline__ int row_pos(int row) { return row < MREAL ? NMETA + (row & (SEQ - 1)) : ((row - MREAL) & (NMETA - 1)); }
__device__ __forceinline__ int row_batch(int row) { return row < MREAL ? (row >> 13) : ((row - MREAL) >> 4); }
constexpr int LP = 8256;
__device__ __forceinline__ int perm16(int p) { const int qd = (p >> 2) & 3; return (p & ~12) | ((((qd & 1) << 1) | (qd >> 1)) << 2); }
__device__ __forceinline__ float wave_sum(float v) {
#pragma unroll
    for (int o = 1; o < 64; o <<= 1) v += __shfl_xor(v, o);
    return v;
}

constexpr size_t MiB = 1u << 20;
constexpr size_t WS_CTL = 0;
constexpr size_t WS_ROPE = 1 * MiB;
constexpr size_t WS_END = 256 * MiB;

#define LAS __attribute__((address_space(3)))
#define GAS __attribute__((address_space(1)))
typedef short bf16x8 __attribute__((ext_vector_type(8)));
typedef float f32x4 __attribute__((ext_vector_type(4)));
typedef unsigned u32x4 __attribute__((ext_vector_type(4)));
typedef unsigned u32x2 __attribute__((ext_vector_type(2)));
constexpr int NTHR = 512, NWAVE = 8;
constexpr int LDS_MISC = 162816;
constexpr int LDS_BYTES = LDS_MISC + 1024;

constexpr size_t WS_BAR = 64 * 1024;
constexpr size_t WS_KPE = 3 * MiB + 256 * 1024;
constexpr size_t W2_RSTD = 4 * MiB + 512 * 1024, W2_WSLOT = W2_RSTD + 80 * 1024, W2_EID = W2_WSLOT + 144 * 1024;
constexpr size_t W2_LIST = 5 * MiB;
constexpr size_t W2_WRF = 9 * MiB + 256 * 1024;
constexpr size_t W2_WQKV = 10 * MiB;
constexpr size_t W2_WO0 = W2_WQKV + 2560 * 1024;
constexpr size_t W2_WIN = W2_WO0 + 2048 * 1024;
constexpr size_t W2_WUQ = W2_WIN + 1024 * 1024;
constexpr size_t W2_WUKV = W2_WUQ + 768 * 1024;
constexpr size_t W2_WO1 = W2_WUKV + 512 * 1024;
constexpr size_t W2_HB = 20 * MiB;
constexpr size_t W2_RB = 53 * MiB;
constexpr size_t W2_RC = 134 * MiB;
static_assert(W2_EID + (size_t)MTOT * 8 <= W2_LIST && W2_LIST + (size_t)NE * CAP * 4 <= W2_WRF && W2_WO1 + 2 * MiB <= W2_HB && W2_HB + (size_t)MTOT * 2048 <= W2_RB, "fixed map");
constexpr size_t B_QKV = W2_RB, B_O0 = W2_RB + 41 * MiB, B_VT0 = W2_RB + 74 * MiB  , B_Y0 = W2_RB, B_CBUF = W2_RB, B_CQN = W2_RB + 33 * MiB, B_CKVN = W2_RB + 42 * MiB, B_O1 = W2_RB, B_W1 = W2_RB + 33 * MiB;
constexpr size_t C_W0 = W2_RC, C_HF = W2_RC + 48 * MiB, C_Q1 = W2_RC, C_K1 = W2_RC + 49 * MiB, C_V1 = W2_RC + 82 * MiB, C_HF1 = W2_RC, C_Y1 = W2_RC;
static_assert(C_V1 + (size_t)2 * 16 * 64 * LP * 2 <= WS_END && C_K1 + (size_t)2 * LP * 2048 <= C_V1 && B_VT0 + (size_t)2 * 2 * 64 * LP * 2 <= W2_RC && C_HF + (size_t)MTOT * 4096 <= WS_END && B_W1 + 48 * MiB <= W2_RC, "region map");
constexpr size_t MOE_WGU_BYTES = (size_t)NE * 512 * 1024 * 2, MOE_WD_BYTES = (size_t)NE * 1024 * 256 * 2;

struct MArgs { const float* in[23]; float* out; unsigned char* ws; int ph_lo, ph_hi, li, pad; };

__device__ __forceinline__ unsigned pk2(float lo, float hi) { return (unsigned)f2bf(lo) | ((unsigned)f2bf(hi) << 16); }

#define XB_TMO      128
#define XB_XCNT(j)  (256  + 64 * (j))
#define XB_XSUB(j)  (1280 + 64 * (j))
#define XB_XGEN(j)  (2304 + 64 * (j))
#define XB_TOP      3328
#define XB_TOPGEN   3392
#define XCD_BAR_WORDS 3456
#define XB_SPIN_CAP (1u << 18)
__device__ __forceinline__ unsigned xb_ld(unsigned* p)              { return __hip_atomic_load(p, __ATOMIC_RELAXED, __HIP_MEMORY_SCOPE_AGENT); }
__device__ __forceinline__ unsigned xb_add(unsigned* p, unsigned v) { return __hip_atomic_fetch_add(p, v, __ATOMIC_RELAXED, __HIP_MEMORY_SCOPE_AGENT); }
__device__ __forceinline__ unsigned xb_xcc_id() { return (unsigned)__builtin_amdgcn_s_getreg((3 << 11) | 20) & 0xFu; }
#define XB_SPIN(cond, bar) do { unsigned _sp = 0; while (cond) { __builtin_amdgcn_s_sleep(1); \
    if ((++_sp & 255u) == 0u) { if (xb_ld(&(bar)[XB_TMO])) break; if (_sp > XB_SPIN_CAP) { atomicAdd(&(bar)[XB_TMO], 1u); break; } } } } while (0)
struct XcdBarrier { unsigned* bar; unsigned x; volatile LAS unsigned* st; };
__device__ __forceinline__ XcdBarrier xcd_barrier_post(unsigned* bar, volatile LAS unsigned* st) {
    XcdBarrier b; b.bar = bar; b.x = xb_xcc_id(); b.st = st;
    if (threadIdx.x == 0) (void)xb_add(&bar[XB_XCNT(b.x)], 1u);
    return b;
}
__device__ __forceinline__ void xcd_barrier_complete(unsigned* bar, unsigned x, unsigned& nloc, unsigned& nx) {
    const unsigned G = gridDim.x * gridDim.y * gridDim.z;
    unsigned sum, cnt, mine, sp = 0u;
    for (;;) {
        sum = 0u; cnt = 0u; mine = 0u;
#pragma unroll
        for (unsigned j = 0; j < 16; ++j) { const unsigned c = xb_ld(&bar[XB_XCNT(j)]); sum += c; cnt += (c > 0u) ? 1u : 0u; mine = (j == x) ? c : mine; }
        if (sum == G) break;
        __builtin_amdgcn_s_sleep(1);
        if ((++sp & 255u) == 0u) { if (xb_ld(&bar[XB_TMO])) break; if (sp > XB_SPIN_CAP) { atomicAdd(&bar[XB_TMO], 1u); break; } }
    }
    nloc = mine > 0u ? mine : 1u; nx = cnt > 0u ? cnt : 1u;
}
__device__ __forceinline__ void xcd_barrier(const XcdBarrier& b) {
    asm volatile("s_waitcnt vmcnt(0)" ::: "memory");
    __syncthreads();
    if (threadIdx.x == 0) {
        unsigned* bar = b.bar;
        __builtin_amdgcn_s_waitcnt(0);
        unsigned nloc = b.st[0], nx = b.st[1];
        if (nloc == 0u) { xcd_barrier_complete(bar, b.x, nloc, nx); b.st[0] = nloc; b.st[1] = nx; }
        const unsigned old = xb_add(&bar[XB_XSUB(b.x)], 1u);
        const unsigned gen = old / nloc;
        if (old + 1u == (gen + 1u) * nloc) {
            __builtin_amdgcn_fence(__ATOMIC_RELEASE, "agent");
            asm volatile("s_waitcnt vmcnt(0)" ::: "memory");
            const unsigned og = xb_add(&bar[XB_TOP], 1u);
            const unsigned tg = og / nx;
            if (og + 1u == (tg + 1u) * nx) xb_add(&bar[XB_TOPGEN], 1u);
            else XB_SPIN(xb_ld(&bar[XB_TOPGEN]) == tg, bar);
            __builtin_amdgcn_fence(__ATOMIC_ACQUIRE, "agent");
            xb_add(&bar[XB_XGEN(b.x)], 1u);
            asm volatile("s_waitcnt vmcnt(0)" ::: "memory");
        } else {
            XB_SPIN(xb_ld(&bar[XB_XGEN(b.x)]) == gen, bar);
            __builtin_amdgcn_fence(__ATOMIC_ACQUIRE, "agent");
            asm volatile("s_waitcnt vmcnt(0)" ::: "memory");
        }
    }
    __syncthreads();
}

template <int N> __device__ __forceinline__ void wait_vm() { asm volatile("s_waitcnt vmcnt(%0)" :: "n"(N) : "memory"); }
__device__ __forceinline__ int swzF(int g) { return (0x78 >> (2 * g)) & 3; }
constexpr int GT_NS = 4;
template <int MT, int NT, int WM, int WN, bool NSW, class RowA, class Epi, bool NOLD = false>
__device__ __forceinline__ void gemm_tile(LAS unsigned char* lds, const RowA& rowA, const bf16_t* __restrict__ Bt, int ldb  , int nk  , Epi& epi) {
    constexpr int BM = WM * MT * 16, BN = WN * NT * 16, GA = BM / 16, G = (BM + BN) / 16, NG = (G + 7) / 8, GR = G % 8, STAGE = (BM + BN) * 64;
    static_assert(WM * WN == 8 && GT_NS * STAGE <= LDS_MISC && BM % 16 == 0 && BN % 16 == 0, "gemm_tile config");
    const int tid = threadIdx.x, lane = tid & 63, wave = __builtin_amdgcn_readfirstlane(tid >> 6), wm = wave / WN, wn = wave % WN;
    const char* src[NG];
    const int lc = (lane & 3) ^ swzF(lane >> 4);
#pragma unroll
    for (int i = 0; i < NG; ++i) {
        const int g = wave + 8 * i;
        if (g < GA) src[i] = (const char*)rowA(g * 16 + (lane >> 2)) + lc * 16;
        else if (g < G) src[i] = (const char*)(Bt + (size_t)((g - GA) * 16 + (lane >> 2)) * ldb) + lc * 16;
        else src[i] = nullptr;
    }
    f32x4 acc[MT][NT];
#pragma unroll
    for (int mi = 0; mi < MT; ++mi)
#pragma unroll
        for (int ni = 0; ni < NT; ++ni) acc[mi][ni] = (f32x4){0.f, 0.f, 0.f, 0.f};
    const int fro = (lane & 15) * 64 + (((lane >> 4) ^ swzF((lane >> 2) & 3)) << 4);
    constexpr int LM = PROBE_PHASE == 402 ? 2 : 1;
#define GT_STAGE(st, kt) do { _Pragma("unroll") for (int _i = 0; _i < NG; ++_i) { const int _g = wave + 8 * _i; if (_g < G) { \
        __builtin_amdgcn_global_load_lds((const unsigned*)(src[_i] + (size_t)(kt) * 64), (LAS unsigned*)(lds + (st) * STAGE + _g * 1024), 16, 0, 0); \
        if (LM == 2) __builtin_amdgcn_global_load_lds((const unsigned*)(src[_i] + (size_t)(kt) * 64), (LAS unsigned*)(lds + (st) * STAGE + _g * 1024), 16, 0, 0); } } } while (0)
#define GT_WAIT(ntl) do { if (GR == 0 || wave < GR) wait_vm<LM * NG * (ntl)>(); else wait_vm<LM * (NG - 1) * (ntl)>(); } while (0)
    if (!NOLD) { GT_STAGE(0, 0);
    if (nk > 1) GT_STAGE(1, 1);
    if (nk > 2) GT_STAGE(2, 2); }
    int st = 0;
    for (int kt = 0; kt < nk; ++kt) {
        const int rem = nk - 1 - kt;
        if (!NOLD) { if (rem >= 2) GT_WAIT(2); else if (rem == 1) GT_WAIT(1); else GT_WAIT(0); }
        __builtin_amdgcn_s_barrier(); asm volatile("" ::: "memory");
        const bool doload = (!NOLD || PROBE_PHASE == 505) && kt + 3 < nk;
        LAS const unsigned char* sa = lds + st * STAGE + (wm * MT * 16) * 64 + fro;
        LAS const unsigned char* sb = lds + st * STAGE + (BM + wn * NT * 16) * 64 + fro;
        bf16x8 bfr[NT];
#pragma unroll
        for (int ni = 0; ni < NT; ++ni) bfr[ni] = *(LAS const bf16x8*)(sb + ni * 1024);
        constexpr int PG = MT >= 2 ? 2 : 1, NPG = MT / PG;
        constexpr int LPG = (NG + NPG - 1) / NPG;
        bf16x8 afc[PG], afn[PG];
#pragma unroll
        for (int i = 0; i < PG; ++i) afc[i] = *(LAS const bf16x8*)(sa + i * 1024);
#pragma unroll
        for (int pg = 0; pg < NPG; ++pg) {
            if (doload) {
#pragma unroll
                for (int l = 0; l < LPG; ++l) { const int _i = pg * LPG + l; if (_i < NG) { const int _g = wave + 8 * _i; if (_g < G)
                    __builtin_amdgcn_global_load_lds((const unsigned*)(src[_i] + (size_t)(kt + 3) * 64), (LAS unsigned*)(lds + ((st + 3) & 3) * STAGE + _g * 1024), 16, 0, 0); } }
            }
            if (pg + 1 < NPG) {
#pragma unroll
                for (int i = 0; i < PG; ++i) afn[i] = *(LAS const bf16x8*)(sa + ((pg + 1) * PG + i) * 1024);
            }
#pragma unroll
            for (int i = 0; i < PG; ++i) { const int mi = pg * PG + i;
#pragma unroll
                for (int ni = 0; ni < NT; ++ni) {
                    if (NSW) acc[mi][ni] = __builtin_amdgcn_mfma_f32_16x16x32_bf16(afc[i], bfr[ni], acc[mi][ni], 0, 0, 0);
                    else acc[mi][ni] = __builtin_amdgcn_mfma_f32_16x16x32_bf16(bfr[ni], afc[i], acc[mi][ni], 0, 0, 0);
                } }
#pragma unroll
            for (int i = 0; i < PG; ++i) afc[i] = afn[i];
            __builtin_amdgcn_sched_barrier(0);
        }
        st = (st + 1) & 3;
    }
#undef GT_STAGE
#undef GT_WAIT
    epi(acc, wm * MT * 16, wn * NT * 16, lane);
    asm volatile("s_waitcnt lgkmcnt(0)" ::: "memory");
    __syncthreads();
}

struct RowDense { const bf16_t* A; int lda, m0, mlast; __device__ __forceinline__ const bf16_t* operator()(int r) const { int row = m0 + r; row = row > mlast ? mlast : row; return A + (size_t)row * lda; } };

namespace pg8 {
#define PG8_LAS __attribute__((address_space(3)))
typedef unsigned short bf16_t;
typedef short bf16x8 __attribute__((ext_vector_type(8)));
typedef float f32x4 __attribute__((ext_vector_type(4)));
typedef unsigned u32x4 __attribute__((ext_vector_type(4)));
constexpr int BM = 256, BK = 64, HALF = 128, HTB = HALF * BK * 2  , STAGE_BYTES = 8 * HTB, NXCD = 8, WGM = 8;

__host__ __device__ __forceinline__ int lds_byte(int r, int c) { const int st = (r >> 4) * 2 + (c >> 5), rr = r & 15, cc = c & 31, ob = rr * 64 + cc * 2; return st * 1024 + (ob ^ (((ob >> 9) & 1) << 5)); }
__host__ __device__ __forceinline__ void stage_rc(int b, int& R, int& C) { const int st = b / 1024, sb = b % 1024, swz = sb ^ (((sb >> 9) & 1) << 5); R = (st >> 1) * 16 + swz / 64; C = (st & 1) * 32 + (swz % 64) / 2; }
__host__ __device__ __forceinline__ int perm32(int rho) { const int n = rho >> 4, i = rho & 15; return 8 * (i >> 2) + 4 * n + (i & 3); }

struct Unit { int pm, pn; };
struct Gemm { const bf16_t* A; const bf16_t* Bt; int M, N, K; };

struct StaticOrder {
    int nM, nN, nwg, G, c;
    __host__ __device__ void init(int M, int N, int G_, int c_) { nM = M / BM; nN = N / BM; nwg = nM * nN; G = G_; c = c_; }
    __host__ __device__ bool next(int i, Unit& u) const {
        const long L = (long)i * G + c; if (L >= nwg) return false;
        int wgid = (int)L; { const int q = nwg / NXCD, r = nwg % NXCD, xcd = wgid % NXCD, off = wgid / NXCD; wgid = (xcd < r ? xcd * (q + 1) : r * (q + 1) + (xcd - r) * q) + off; }
        const int nig = WGM * nN, gid = wgid / nig, fm = gid * WGM, gsz = (nM - fm) < WGM ? (nM - fm) : WGM;
        u.pm = fm + ((wgid % nig) % gsz); u.pn = (wgid % nig) / gsz; return true;
    }
    __device__ __forceinline__ void a_ready(const Unit&) const {}
    __device__ __forceinline__ void done(const Unit&) const {}
};


template <class Epi, class Sched, bool ALIGN_EPI = false, bool SP2 = false>
__device__ __forceinline__ void gemm_phase(PG8_LAS unsigned char* lds, const Gemm g, const Sched& S, const Epi& E) {
    const int tid = threadIdx.x, wid = __builtin_amdgcn_readfirstlane(tid >> 6), lane = tid & 63, wr = wid >> 2, wc = wid & 3, fr = lane & 15, fq = lane >> 4;
    const int K = g.K, nt = K / BK;
    unsigned voffA[2], voffB[2];
#pragma unroll
    for (int i = 0; i < 2; ++i) { int R, C; stage_rc(tid * 16 + i * 8192, R, C); const int Rb = Epi::PERM ? ((R & ~31) + perm32(R & 31)) : R;
        voffA[i] = (unsigned)(R * K + C) * 2u; voffB[i] = (unsigned)(Rb * K + C) * 2u; }
    const size_t kstep = (size_t)(BK * 2);
    const size_t hstep = (size_t)HALF * K * 2;
    const size_t tstep = 2 * hstep;
    const unsigned ldsw = (unsigned)wid * 1024u;
    const int aoff = lds_byte(wr * 64 + fr, fq * 8), boff = lds_byte(wc * 32 + fr, fq * 8);
#define PG8_SA(b, h) (((b) * 2 + (h)) * HTB)
#define PG8_SB(b, h) ((4 + (b) * 2 + (h)) * HTB)
#define PG8_STAGE(bufoff, gbase, voff) do { _Pragma("unroll") for (int _i = 0; _i < 2; ++_i) \
        __builtin_amdgcn_global_load_lds((const unsigned*)((const char*)(gbase) + (voff)[_i]), (PG8_LAS unsigned*)(lds + (bufoff) + ldsw + _i * 8192), 16, 0, 0); } while (0)
#define PG8_LDA(dst, b, h) do { _Pragma("unroll") for (int m = 0; m < 4; ++m) _Pragma("unroll") for (int k = 0; k < 2; ++k) dst[m][k] = *(const PG8_LAS bf16x8*)(lds + PG8_SA(b, h) + aoff + m * 2048 + k * 1024); } while (0)
#define PG8_LDB(dst, b, h) do { _Pragma("unroll") for (int n = 0; n < 2; ++n) _Pragma("unroll") for (int k = 0; k < 2; ++k) dst[n][k] = *(const PG8_LAS bf16x8*)(lds + PG8_SB(b, h) + boff + n * 2048 + k * 1024); } while (0)
#define PG8_MMA(ai, bj, At, Bt) do { __builtin_amdgcn_s_setprio(1); _Pragma("unroll") for (int m = 0; m < 4; ++m) _Pragma("unroll") for (int n = 0; n < 2; ++n) _Pragma("unroll") for (int k = 0; k < 2; ++k) \
        acc[ai][bj][m][n] = __builtin_amdgcn_mfma_f32_16x16x32_bf16(Bt[n][k], At[m][k], acc[ai][bj][m][n], 0, 0, 0); __builtin_amdgcn_s_setprio(0); } while (0)
#define PG8_WAIT_V(n) asm volatile("s_waitcnt vmcnt(" #n ")" ::: "memory")
#define PG8_WAIT_L(n) asm volatile("s_waitcnt lgkmcnt(" #n ")" ::: "memory")
#define PG8_BAR __builtin_amdgcn_s_barrier()
#define PG8_SCHED __builtin_amdgcn_sched_barrier(0)
    Unit cur, nxt; int ui = 0;
    if (!S.next(0, cur)) return;
    f32x4 acc[2][2][4][2];
#pragma unroll
    for (int a = 0; a < 2; ++a)
#pragma unroll
        for (int b = 0; b < 2; ++b)
#pragma unroll
            for (int m = 0; m < 4; ++m)
#pragma unroll
                for (int n = 0; n < 2; ++n) acc[a][b][m][n] = (f32x4){0.f, 0.f, 0.f, 0.f};
    bf16x8 At[4][2], B0[2][2], B1[2][2];
    const char* cA = (const char*)g.A + (size_t)cur.pm * tstep; const char* cB = (const char*)g.Bt + (size_t)cur.pn * tstep;
    S.a_ready(cur);
    if constexpr (SP2) {
        PG8_STAGE(PG8_SB(0, 0), cB, voffB); PG8_STAGE(PG8_SB(0, 1), cB + hstep, voffB); PG8_STAGE(PG8_SA(0, 0), cA, voffA); PG8_STAGE(PG8_SA(0, 1), cA + hstep, voffA);
        if (wr == 1) PG8_BAR;
        PG8_WAIT_V(2); PG8_BAR;
        PG8_STAGE(PG8_SB(1, 0), cB + kstep, voffB); PG8_STAGE(PG8_SA(1, 0), cA + kstep, voffA); PG8_STAGE(PG8_SB(1, 1), cB + hstep + kstep, voffB);
        PG8_WAIT_V(6); PG8_BAR;
    } else {
        PG8_STAGE(PG8_SB(0, 0), cB, voffB); PG8_STAGE(PG8_SA(0, 0), cA, voffA); PG8_STAGE(PG8_SB(0, 1), cB + hstep, voffB); PG8_STAGE(PG8_SA(0, 1), cA + hstep, voffA);
        if (wr == 1) PG8_BAR;
        PG8_WAIT_V(4); PG8_BAR;
        PG8_STAGE(PG8_SB(1, 0), cB + kstep, voffB); PG8_STAGE(PG8_SA(1, 0), cA + kstep, voffA); PG8_STAGE(PG8_SB(1, 1), cB + hstep + kstep, voffB);
        PG8_WAIT_V(6); PG8_BAR;
    }
    for (;;) {
        const bool has_next = S.next(ui + 1, nxt);
        const char* nA = has_next ? (const char*)g.A + (size_t)nxt.pm * tstep : cA; const char* nB = has_next ? (const char*)g.Bt + (size_t)nxt.pn * tstep : cB;
        for (int t = 0; t < nt; t += 2) {
            const bool last = (t == nt - 2);
            const char* a1 = cA + (size_t)(t + 1) * kstep;
            const char* a2 = last ? nA : cA + (size_t)(t + 2) * kstep; const char* b2 = last ? nB : cB + (size_t)(t + 2) * kstep;
            const char* a3 = a2 + kstep; const char* b3 = b2 + kstep;
            if (last && has_next) S.a_ready(nxt);
            if constexpr (SP2) {
            PG8_LDB(B0, 0, 0); PG8_LDB(B1, 0, 1); PG8_SCHED; PG8_LDA(At, 0, 0); PG8_STAGE(PG8_SA(1, 1), a1 + hstep, voffA);
            PG8_WAIT_V(8); PG8_WAIT_L(0); PG8_BAR; PG8_MMA(0, 0, At, B0); PG8_MMA(0, 1, At, B1); PG8_BAR; PG8_SCHED;
            PG8_LDA(At, 0, 1); PG8_STAGE(PG8_SB(0, 0), b2, voffB); PG8_STAGE(PG8_SB(0, 1), b2 + hstep, voffB); PG8_STAGE(PG8_SA(0, 0), a2, voffA);
            PG8_WAIT_V(8); PG8_WAIT_L(0); PG8_BAR; PG8_MMA(1, 0, At, B0); PG8_MMA(1, 1, At, B1); PG8_BAR; PG8_SCHED;
            PG8_LDB(B0, 1, 0); PG8_LDB(B1, 1, 1); PG8_SCHED; PG8_LDA(At, 1, 0); PG8_STAGE(PG8_SA(0, 1), a2 + hstep, voffA);
            PG8_WAIT_V(8); PG8_WAIT_L(0); PG8_BAR; PG8_MMA(0, 0, At, B0); PG8_MMA(0, 1, At, B1); PG8_BAR; PG8_SCHED;
            PG8_LDA(At, 1, 1); PG8_STAGE(PG8_SB(1, 0), b3, voffB); PG8_STAGE(PG8_SB(1, 1), b3 + hstep, voffB); PG8_STAGE(PG8_SA(1, 0), a3, voffA);
            PG8_WAIT_V(8); PG8_WAIT_L(0); PG8_BAR; PG8_MMA(1, 0, At, B0); PG8_MMA(1, 1, At, B1); PG8_BAR; PG8_SCHED;
            } else {
            PG8_LDB(B0, 0, 0); PG8_SCHED; PG8_LDA(At, 0, 0); PG8_STAGE(PG8_SA(1, 1), a1 + hstep, voffA);
            PG8_WAIT_L(8); PG8_BAR; PG8_WAIT_L(0); PG8_MMA(0, 0, At, B0); PG8_BAR; PG8_SCHED;
            PG8_LDB(B1, 0, 1); PG8_STAGE(PG8_SB(0, 0), b2, voffB);
            PG8_BAR; PG8_WAIT_L(0); PG8_MMA(0, 1, At, B1); PG8_BAR;
            PG8_LDA(At, 0, 1); PG8_STAGE(PG8_SA(0, 0), a2, voffA);
            PG8_BAR; PG8_WAIT_L(0); PG8_MMA(1, 0, At, B0); PG8_BAR; PG8_SCHED;
            PG8_STAGE(PG8_SB(0, 1), b2 + hstep, voffB);
            PG8_WAIT_V(6); PG8_BAR; PG8_MMA(1, 1, At, B1); PG8_BAR;
            PG8_LDB(B0, 1, 0); PG8_SCHED; PG8_LDA(At, 1, 0); PG8_STAGE(PG8_SA(0, 1), a2 + hstep, voffA);
            PG8_WAIT_L(8); PG8_BAR; PG8_WAIT_L(0); PG8_MMA(0, 0, At, B0); PG8_BAR; PG8_SCHED;
            PG8_LDB(B1, 1, 1); PG8_STAGE(PG8_SB(1, 0), b3, voffB);
            PG8_BAR; PG8_WAIT_L(0); PG8_MMA(0, 1, At, B1); PG8_BAR;
            PG8_LDA(At, 1, 1); PG8_STAGE(PG8_SA(1, 0), a3, voffA);
            PG8_BAR; PG8_WAIT_L(0); PG8_MMA(1, 0, At, B0); PG8_BAR; PG8_SCHED;
            PG8_STAGE(PG8_SB(1, 1), b3 + hstep, voffB);
            PG8_WAIT_V(6); PG8_BAR; PG8_MMA(1, 1, At, B1); PG8_BAR;
            }
        }
        if constexpr (ALIGN_EPI) { if (wr == 0) PG8_BAR; }
        if constexpr (!Epi::AFTER_DRAIN) { E(acc, cur, wr, wc, fr, fq); S.done(cur); }
        if (!has_next) break;
#pragma unroll
        for (int a = 0; a < 2; ++a)
#pragma unroll
            for (int b = 0; b < 2; ++b)
#pragma unroll
                for (int m = 0; m < 4; ++m)
#pragma unroll
                    for (int n = 0; n < 2; ++n) acc[a][b][m][n] = (f32x4){0.f, 0.f, 0.f, 0.f};
        cur = nxt; cA = nA; cB = nB; ++ui;
        if constexpr (ALIGN_EPI) { if (wr == 1) PG8_BAR; }
    }
    PG8_WAIT_V(0);
    if constexpr (!ALIGN_EPI) { if (wr == 0) PG8_BAR; }
    PG8_BAR;
    if constexpr (Epi::AFTER_DRAIN) { E.fused(acc, cur, wr, wc, fr, fq, lds, wid, lane); S.done(cur); }
#undef PG8_SA
#undef PG8_SB
#undef PG8_STAGE
#undef PG8_LDA
#undef PG8_LDB
#undef PG8_MMA
#undef PG8_WAIT_V
#undef PG8_WAIT_L
#undef PG8_BAR
#undef PG8_SCHED
}
}

struct PgEpiRes {
    static constexpr bool PERM = false, AFTER_DRAIN = false;
    const float* bias; unsigned short* hb;
    __device__ __forceinline__ void operator()(const pg8::f32x4 (&acc)[2][2][4][2], const pg8::Unit& u, int wr, int wc, int fr, int fq) const {
#pragma unroll
        for (int ai = 0; ai < 2; ++ai)
#pragma unroll
            for (int m = 0; m < 4; ++m) { const int row = u.pm * 256 + ai * 128 + wr * 64 + m * 16 + fr;
#pragma unroll
                for (int bj = 0; bj < 2; ++bj)
#pragma unroll
                    for (int n = 0; n < 2; ++n) { const int col = u.pn * 256 + bj * 128 + wc * 32 + n * 16 + fq * 4;
                        u32x2* p = (u32x2*)(hb + (size_t)row * D + col); const u32x2 h = *p; pg8::f32x4 v = acc[ai][bj][m][n];
                        if (bias) v += *(const pg8::f32x4*)(bias + col);
                        v[0] += __uint_as_float(h.x << 16); v[1] += __uint_as_float(h.x & 0xffff0000u); v[2] += __uint_as_float(h.y << 16); v[3] += __uint_as_float(h.y & 0xffff0000u);
                        *p = (u32x2){pk2(v[0], v[1]), pk2(v[2], v[3])}; } }
    }
};
struct PgEpiQ {
    static constexpr bool PERM = false, AFTER_DRAIN = false;
    const float* rstd; const float* bias; const float2* cs; unsigned short* qkv;
    __device__ __forceinline__ void operator()(const pg8::f32x4 (&acc)[2][2][4][2], const pg8::Unit& u, int wr, int wc, int fr, int fq) const {
#pragma unroll
        for (int ai = 0; ai < 2; ++ai)
#pragma unroll
            for (int m = 0; m < 4; ++m) { const int row = u.pm * 256 + ai * 128 + wr * 64 + m * 16 + fr; const float rs = rstd[row]; const int pos = row_pos(row);
#pragma unroll
                for (int bj = 0; bj < 2; ++bj) { const int g = 8 * u.pn + 4 * bj + wc, hh = g >> 1, d = 16 * (g & 1) + 4 * fq;
                    const pg8::f32x4 b1 = *(const pg8::f32x4*)(bias + 64 * hh + d), b2 = *(const pg8::f32x4*)(bias + 64 * hh + 32 + d);
                    float o1[4], o2[4];
#pragma unroll
                    for (int r = 0; r < 4; ++r) { const float2 t = cs[pos * 32 + d + r]; const float x1 = acc[ai][bj][m][0][r] * rs + b1[r], x2 = acc[ai][bj][m][1][r] * rs + b2[r];
                        o1[r] = (x1 * t.x - x2 * t.y) * 0.125f; o2[r] = (x2 * t.x + x1 * t.y) * 0.125f; }
                    unsigned short* orow = qkv + (size_t)row * NQKV + 64 * hh + d;
                    *(u32x2*)orow = (u32x2){pk2(o1[0], o1[1]), pk2(o1[2], o1[3])}; *(u32x2*)(orow + 32) = (u32x2){pk2(o2[0], o2[1]), pk2(o2[2], o2[3])}; } }
    }
};

struct EpiQKV {
    const float* rstd; const float* bias; const float2* cs; bf16_t* qkv; int m0, n0; bool perm;
    template <int MT, int NT> __device__ __forceinline__ void operator()(f32x4 (&acc)[MT][NT], int mb, int nb, int lane) const {
        static_assert(NT == 4, "rope needs a 64-column wave span");
        const int cb = n0 + nb, d0 = (lane >> 4) * 4;
#pragma unroll
        for (int mi = 0; mi < MT; ++mi) {
            const int row = m0 + mb + mi * 16 + (lane & 15);
            if (row < MTOT) {
                const float rs = rstd[row]; const int pos = row_pos(row);
                bf16_t* orow = qkv + (size_t)row * NQKV + cb;
                {
                    const float sc = cb < 1024 ? 0.125f : 1.0f;
#pragma unroll
                    for (int ni = 0; ni < 2; ++ni) {
                        const int d = ni * 16 + d0;
                        const f32x4 b1 = *(const f32x4*)(bias + cb + d), b2 = *(const f32x4*)(bias + cb + 32 + d);
                        const f32x4 a1 = perm ? acc[mi][2 * ni] : acc[mi][ni], a2 = perm ? acc[mi][2 * ni + 1] : acc[mi][ni + 2];
                        float o1[4], o2[4];
#pragma unroll
                        for (int r = 0; r < 4; ++r) {
                            const float2 t = cs[pos * 32 + d + r];
                            const float x1 = a1[r] * rs + b1[r], x2 = a2[r] * rs + b2[r];
                            o1[r] = (x1 * t.x - x2 * t.y) * sc; o2[r] = (x2 * t.x + x1 * t.y) * sc;
                        }
                        *(u32x2*)(orow + d) = (u32x2){pk2(o1[0], o1[1]), pk2(o1[2], o1[3])};
                        *(u32x2*)(orow + 32 + d) = (u32x2){pk2(o2[0], o2[1]), pk2(o2[2], o2[3])};
                    }
                }
            }
        }
    }
};
struct EpiV0 {
    const float* rstd; const float* bias; bf16_t* vt0; int m0, n0;
    template <int MT, int NT> __device__ __forceinline__ void operator()(f32x4 (&acc)[MT][NT], int mb, int nb, int lane) const {
        static_assert(NT == 4, "64-column wave span");
        const int cb = n0 + nb, kh = (cb - 1152) >> 6;
#pragma unroll
        for (int mi = 0; mi < MT; ++mi) {
            const int row0 = m0 + mb + mi * 16 + (lane >> 4) * 4;
            if (row0 < MTOT) {
                const f32x4 rs = *(const f32x4*)(rstd + row0); const int b = row_batch(row0), pp = perm16(row_pos(row0));
#pragma unroll
                for (int ni = 0; ni < NT; ++ni) { const int d = ni * 16 + (lane & 15); const float bb = bias[cb + d];
                    const f32x4 v = acc[mi][ni] * rs + bb;
                    *(u32x2*)(vt0 + (size_t)((b * 2 + kh) * 64 + d) * LP + pp) = (u32x2){pk2(v[0], v[1]), pk2(v[2], v[3])}; }
            }
        }
    }
};
struct EpiRes {
    const float* bias; bf16_t* hb; int m0, n0;
    template <int MT, int NT> __device__ __forceinline__ void operator()(f32x4 (&acc)[MT][NT], int mb, int nb, int lane) const {
#pragma unroll
        for (int mi = 0; mi < MT; ++mi) {
            const int row = m0 + mb + mi * 16 + (lane & 15);
            if (row < MTOT) {
#pragma unroll
                for (int ni = 0; ni < NT; ++ni) {
                    const int col = n0 + nb + ni * 16 + (lane >> 4) * 4;
                    u32x2* p = (u32x2*)(hb + (size_t)row * D + col);
                    const u32x2 h = *p;
                    f32x4 v = acc[mi][ni];
                    if (bias) v += *(const f32x4*)(bias + col);
                    v[0] += __uint_as_float(h.x << 16); v[1] += __uint_as_float(h.x & 0xffff0000u); v[2] += __uint_as_float(h.y << 16); v[3] += __uint_as_float(h.y & 0xffff0000u);
                    *p = (u32x2){pk2(v[0], v[1]), pk2(v[2], v[3])};
                }
            }
        }
    }
};
__device__ __forceinline__ void route_phase(LAS unsigned char* lds, const bf16_t* __restrict__ hbr, const float* __restrict__ wrf, const float* __restrict__ bg, const float* __restrict__ br,
                                            float* rstd_out, int* cnt, int* list, float* wslot, int bid, int nblk) {
    const int tid = threadIdx.x, lane = tid & 63, wave = __builtin_amdgcn_readfirstlane(tid >> 6);
    LAS f32x4* wl = (LAS f32x4*)lds;
    LAS int* nrec = (LAS int*)(lds + LDS_MISC + 16); LAS int* bcnt = (LAS int*)(lds + LDS_MISC + 32); LAS int* bbase = (LAS int*)(lds + LDS_MISC + 160); LAS int* rec = (LAS int*)(lds + LDS_MISC + 288);
    for (int i = tid; i < 36 * 256; i += NTHR) wl[i] = *(const f32x4*)(wrf + (size_t)i * 4);
    if (tid < NE) bcnt[tid] = 0;
    if (tid == 0) *nrec = 0;
    __syncthreads();
    for (int row = bid * NWAVE + wave; row < MTOT; row += nblk * NWAVE) {
        f32x4 x[4]; float ss = 0.f;
#pragma unroll
        for (int j = 0; j < 4; ++j) { const u32x2 h = *(const u32x2*)(hbr + (size_t)row * D + j * 256 + lane * 4);
            x[j] = (f32x4){__uint_as_float(h.x << 16), __uint_as_float(h.x & 0xffff0000u), __uint_as_float(h.y << 16), __uint_as_float(h.y & 0xffff0000u)};
            ss += x[j][0] * x[j][0] + x[j][1] * x[j][1] + x[j][2] * x[j][2] + x[j][3] * x[j][3]; }
        ss = wave_sum(ss);
        const float rs = rsqrtf(ss * (1.0f / D) + EPS);
        float lg[4];
#pragma unroll
        for (int c = 0; c < 4; ++c) { float p = 0.f;
#pragma unroll
            for (int j = 0; j < 4; ++j) { const f32x4 w = wl[c * 256 + j * 64 + lane]; p += x[j][0] * w[0] + x[j][1] * w[1] + x[j][2] * w[2] + x[j][3] * w[3]; }
            lg[c] = wave_sum(p) * rs + bg[c]; }
        int gi = 0; float gm = lg[0];
#pragma unroll
        for (int c = 1; c < 4; ++c) if (lg[c] > gm) { gm = lg[c]; gi = c; }
        float gs = 0.f;
#pragma unroll
        for (int c = 0; c < 4; ++c) gs += __expf(lg[c] - gm);
        const float gp = 1.0f / gs;
        gi = __builtin_amdgcn_readfirstlane(gi);
        float e[8];
#pragma unroll
        for (int c = 0; c < 8; ++c) { float p = 0.f;
#pragma unroll
            for (int j = 0; j < 4; ++j) { const f32x4 w = wl[(4 + gi * 8 + c) * 256 + j * 64 + lane]; p += x[j][0] * w[0] + x[j][1] * w[1] + x[j][2] * w[2] + x[j][3] * w[3]; }
            e[c] = wave_sum(p) * rs + br[gi * 8 + c]; }
        int i1 = 0; float v1 = e[0];
#pragma unroll
        for (int c = 1; c < 8; ++c) if (e[c] > v1) { v1 = e[c]; i1 = c; }
        int i2 = -1; float v2 = -3.0e38f;
#pragma unroll
        for (int c = 0; c < 8; ++c) if (c != i1 && e[c] > v2) { v2 = e[c]; i2 = c; }
        if (lane == 0) {
            const float r = __expf(v2 - v1);
            const float w1 = gp / (1.0f + r), w2 = gp * r / (1.0f + r);
            const int e1 = gi * 8 + i1, e2 = gi * 8 + i2;
            const int p1 = atomicAdd((int*)&bcnt[e1], 1), p2 = atomicAdd((int*)&bcnt[e2], 1);
            const int k = atomicAdd((int*)nrec, 2);
            rec[k] = ((row * 2) << 13) | (e1 << 8) | p1; rec[k + 1] = ((row * 2 + 1) << 13) | (e2 << 8) | p2;
            wslot[row * 2] = w1; wslot[row * 2 + 1] = w2; rstd_out[row] = rs;
        }
    }
    __syncthreads();
    if (tid < NE) { const int c = bcnt[tid]; bbase[tid] = c ? __hip_atomic_fetch_add(cnt + tid * 64, c, __ATOMIC_RELAXED, __HIP_MEMORY_SCOPE_AGENT) : 0; }
    __syncthreads();
    for (int k = tid; k < *nrec; k += NTHR) { const int r = rec[k], e = (r >> 8) & 31; list[(size_t)e * CAP + bbase[e] + (r & 255)] = r >> 13; }
    __syncthreads();
}
__device__ __forceinline__ void final_phase(const bf16_t* __restrict__ hb, const bf16_t* __restrict__ ybuf, const float* __restrict__ g, float* out, int bid, int nblk) {
    const int tid = threadIdx.x, lane = tid & 63, wave = tid >> 6;
    for (int row = bid * NWAVE + wave; row < MREAL; row += nblk * NWAVE) {
        f32x4 v[4]; float ss = 0.f;
#pragma unroll
        for (int j = 0; j < 4; ++j) { const size_t c = j * 256 + lane * 4;
            const u32x2 h = *(const u32x2*)(hb + (size_t)row * D + c), y0 = *(const u32x2*)(ybuf + (size_t)(row * 2) * D + c), y1 = *(const u32x2*)(ybuf + (size_t)(row * 2 + 1) * D + c);
            v[j][0] = __uint_as_float(h.x << 16) + __uint_as_float(y0.x << 16) + __uint_as_float(y1.x << 16);
            v[j][1] = __uint_as_float(h.x & 0xffff0000u) + __uint_as_float(y0.x & 0xffff0000u) + __uint_as_float(y1.x & 0xffff0000u);
            v[j][2] = __uint_as_float(h.y << 16) + __uint_as_float(y0.y << 16) + __uint_as_float(y1.y << 16);
            v[j][3] = __uint_as_float(h.y & 0xffff0000u) + __uint_as_float(y0.y & 0xffff0000u) + __uint_as_float(y1.y & 0xffff0000u);
            ss += v[j][0] * v[j][0] + v[j][1] * v[j][1] + v[j][2] * v[j][2] + v[j][3] * v[j][3]; }
        const float rs = rsqrtf(wave_sum(ss) * (1.0f / D) + EPS);
#pragma unroll
        for (int j = 0; j < 4; ++j) { const f32x4 gg = *(const f32x4*)(g + j * 256 + lane * 4); *(f32x4*)(out + (size_t)row * D + j * 256 + lane * 4) = v[j] * rs * gg; }
    }
}

typedef float f32x16 __attribute__((ext_vector_type(16)));
constexpr int AT_STAGE = 20480;
__device__ __forceinline__ unsigned cvtpk(float lo, float hi) { typedef float f2 __attribute__((ext_vector_type(2))); typedef __bf16 b2 __attribute__((ext_vector_type(2)));
    f2 v = {lo, hi}; b2 r = __builtin_convertvector(v, b2); return __builtin_bit_cast(unsigned, r); }
__device__ __forceinline__ void mla_unit(LAS unsigned char* lds, int b, int h, int qi, const bf16_t* __restrict__ Q1, const bf16_t* __restrict__ K1, const bf16_t* __restrict__ kpe,
                                         const bf16_t* __restrict__ VT1, bf16_t* o) {
    const int tid = threadIdx.x, lane = tid & 63, wave = __builtin_amdgcn_readfirstlane(tid >> 6), r32 = lane & 31, hi = lane >> 5;
    const size_t qrow = (size_t)b * SEQ + 256 * qi + 32 * wave + r32;
    bf16x8 qf[6];
#pragma unroll
    for (int s = 0; s < 6; ++s) qf[s] = *(const bf16x8*)(Q1 + qrow * 1536 + h * 96 + 16 * s + 8 * hi);
    const int lr = 8 * wave + (lane >> 3);
    const char* ksrc = (const char*)(K1 + ((size_t)b * LP + lr) * 1024 + h * 64) + (((lane & 7) ^ ((lr >> 1) & 7)) << 4);
    const char* vsrc = (const char*)(VT1 + ((size_t)(b * 16 + h) * 64 + lr) * LP) + (((lane & 7) ^ ((lr >> 1) & 7)) << 4);
    const int pr = 16 * wave + (lane >> 2);
    const char* psrc = (const char*)(kpe + ((size_t)b * LP + (pr & 63)) * 32) + (((lane & 3) ^ ((pr >> 2) & 3)) << 4);
#define MLA_ISSUE(j, st) do { \
        __builtin_amdgcn_global_load_lds((const unsigned*)(ksrc + (size_t)(j) * (64 * 2048)), (LAS unsigned*)(lds + (st) * AT_STAGE + wave * 1024), 16, 0, 0); \
        __builtin_amdgcn_global_load_lds((const unsigned*)(vsrc + (size_t)(j) * 128), (LAS unsigned*)(lds + (st) * AT_STAGE + 8192 + wave * 1024), 16, 0, 0); \
        if (wave < 4) __builtin_amdgcn_global_load_lds((const unsigned*)(psrc + (size_t)(j) * (64 * 64)), (LAS unsigned*)(lds + (st) * AT_STAGE + 16384 + wave * 1024), 16, 0, 0); } while (0)
    const int NT = 4 * qi + 5, jmaxw = 4 * qi + ((32 * wave + 47) >> 6);
    const int qp = 16 + 256 * qi + 32 * wave + r32;
    const int koff = r32 * 128, ksw = (r32 >> 1) & 7, poff = 16384 + r32 * 64, psw = (r32 >> 2) & 3, voff = 8192 + r32 * 128;
    f32x16 oacc[2]; oacc[0] = (f32x16){}; oacc[1] = (f32x16){};
    constexpr float MLA_THR = 8.0f;
    float mref = 0.f, lsum = 0.f;
    f32x16 negm = (f32x16){};
    MLA_ISSUE(0, 0);
    if (NT > 1) MLA_ISSUE(1, 1);
    int st = 0;
    for (int j = 0; j < NT; ++j) {
        if (j + 1 < NT) { if (wave < 4) asm volatile("s_waitcnt vmcnt(3)" ::: "memory"); else asm volatile("s_waitcnt vmcnt(2)" ::: "memory"); }
        else asm volatile("s_waitcnt vmcnt(0)" ::: "memory");
        __builtin_amdgcn_s_barrier(); asm volatile("" ::: "memory");
        if (j + 2 < NT) { const int st2 = st >= 1 ? st - 1 : 2; MLA_ISSUE(j + 2, st2); }
        if (j <= jmaxw) {
            LAS const unsigned char* sb = lds + st * AT_STAGE;
            f32x16 p0, p1;
            {
                const bf16x8 k0 = *(LAS const bf16x8*)(sb + koff + ((hi ^ ksw) << 4));
                const bf16x8 k1 = *(LAS const bf16x8*)(sb + 4096 + koff + ((hi ^ ksw) << 4));
                p0 = __builtin_amdgcn_mfma_f32_32x32x16_bf16(k0, qf[0], negm, 0, 0, 0);
                p1 = __builtin_amdgcn_mfma_f32_32x32x16_bf16(k1, qf[0], negm, 0, 0, 0);
            }
#pragma unroll
            for (int s = 1; s < 4; ++s) {
                const bf16x8 k0 = *(LAS const bf16x8*)(sb + koff + (((2 * s + hi) ^ ksw) << 4));
                const bf16x8 k1 = *(LAS const bf16x8*)(sb + 4096 + koff + (((2 * s + hi) ^ ksw) << 4));
                p0 = __builtin_amdgcn_mfma_f32_32x32x16_bf16(k0, qf[s], p0, 0, 0, 0);
                p1 = __builtin_amdgcn_mfma_f32_32x32x16_bf16(k1, qf[s], p1, 0, 0, 0);
            }
#pragma unroll
            for (int s = 0; s < 2; ++s) {
                const bf16x8 k0 = *(LAS const bf16x8*)(sb + poff + (((2 * s + hi) ^ psw) << 4));
                const bf16x8 k1 = *(LAS const bf16x8*)(sb + 2048 + poff + (((2 * s + hi) ^ psw) << 4));
                p0 = __builtin_amdgcn_mfma_f32_32x32x16_bf16(k0, qf[4 + s], p0, 0, 0, 0);
                p1 = __builtin_amdgcn_mfma_f32_32x32x16_bf16(k1, qf[4 + s], p1, 0, 0, 0);
            }
            if (j >= 4 * qi) {
                const int kb0 = 64 * j + 4 * hi;
#pragma unroll
                for (int r = 0; r < 16; ++r) { const int kp = kb0 + (r & 3) + 8 * (r >> 2); if (kp > qp) p0[r] = -1e30f; if (kp + 32 > qp) p1[r] = -1e30f; }
            }
            float tm = fmaxf(p0[0], p1[0]);
#pragma unroll
            for (int r = 1; r < 16; ++r) tm = fmaxf(tm, fmaxf(p0[r], p1[r]));
            tm = fmaxf(tm, __shfl_xor(tm, 32));
            if (j == 0 || __any(tm > MLA_THR)) {
                const float dl = j == 0 ? tm : fmaxf(tm, 0.f);
                mref += dl;
                const float f = __builtin_amdgcn_exp2f(-dl);
                lsum *= f;
#pragma unroll
                for (int r = 0; r < 16; ++r) { oacc[0][r] *= f; oacc[1][r] *= f; p0[r] -= dl; p1[r] -= dl; negm[r] = -mref; }
            }
            float ps = 0.f;
#pragma unroll
            for (int r = 0; r < 16; ++r) { p0[r] = __builtin_amdgcn_exp2f(p0[r]); p1[r] = __builtin_amdgcn_exp2f(p1[r]); ps += p0[r] + p1[r]; }
            lsum += ps;
            u32x4 pf[4];
            pf[0] = (u32x4){cvtpk(p0[0], p0[1]), cvtpk(p0[2], p0[3]), cvtpk(p0[4], p0[5]), cvtpk(p0[6], p0[7])};
            pf[1] = (u32x4){cvtpk(p0[8], p0[9]), cvtpk(p0[10], p0[11]), cvtpk(p0[12], p0[13]), cvtpk(p0[14], p0[15])};
            pf[2] = (u32x4){cvtpk(p1[0], p1[1]), cvtpk(p1[2], p1[3]), cvtpk(p1[4], p1[5]), cvtpk(p1[6], p1[7])};
            pf[3] = (u32x4){cvtpk(p1[8], p1[9]), cvtpk(p1[10], p1[11]), cvtpk(p1[12], p1[13]), cvtpk(p1[14], p1[15])};
#pragma unroll
            for (int s = 0; s < 4; ++s) {
                const bf16x8 v0 = *(LAS const bf16x8*)(sb + voff + (((2 * s + hi) ^ ksw) << 4));
                const bf16x8 v1 = *(LAS const bf16x8*)(sb + 4096 + voff + (((2 * s + hi) ^ ksw) << 4));
                const bf16x8 pb = __builtin_bit_cast(bf16x8, pf[s]);
                oacc[0] = __builtin_amdgcn_mfma_f32_32x32x16_bf16(v0, pb, oacc[0], 0, 0, 0);
                oacc[1] = __builtin_amdgcn_mfma_f32_32x32x16_bf16(v1, pb, oacc[1], 0, 0, 0);
            }
        }
        st = st == 2 ? 0 : st + 1;
    }
#undef MLA_ISSUE
    lsum += __shfl_xor(lsum, 32);
    const float inv = 1.0f / lsum;
    bf16_t* orow = o + qrow * D + h * 64 + 4 * hi;
#pragma unroll
    for (int db = 0; db < 2; ++db)
#pragma unroll
        for (int g = 0; g < 4; ++g)
            *(u32x2*)(orow + 32 * db + 8 * g) = (u32x2){cvtpk(oacc[db][4 * g] * inv, oacc[db][4 * g + 1] * inv), cvtpk(oacc[db][4 * g + 2] * inv, oacc[db][4 * g + 3] * inv)};
    asm volatile("s_waitcnt lgkmcnt(0)" ::: "memory");
    __builtin_amdgcn_s_barrier(); asm volatile("" ::: "memory");
}
__device__ __forceinline__ void mla_meta(int b, int h, const bf16_t* __restrict__ Q1, const bf16_t* __restrict__ K1, const bf16_t* __restrict__ kpe, const bf16_t* __restrict__ VT1, bf16_t* o, int lane) {
    const int qi = lane & 15, part = lane >> 4; const size_t qrow = (size_t)MREAL + b * 16 + qi;
    float q[24];
#pragma unroll
    for (int d = 0; d < 24; ++d) q[d] = bf2f(Q1[qrow * 1536 + h * 96 + 24 * part + d]);
    float sc[16]; float mx = -1e30f;
#pragma unroll
    for (int j = 0; j < 16; ++j) {
        const size_t kr = (size_t)b * LP + j; float s = 0.f;
#pragma unroll
        for (int d = 0; d < 24; ++d) { const int dd = 24 * part + d; const float kv = dd < 64 ? bf2f(K1[kr * D + h * 64 + dd]) : bf2f(kpe[kr * 32 + dd - 64]); s += q[d] * kv; }
        s += __shfl_xor(s, 16); s += __shfl_xor(s, 32);
        sc[j] = j <= qi ? s : -1e30f; mx = fmaxf(mx, sc[j]);
    }
    float l = 0.f;
#pragma unroll
    for (int j = 0; j < 16; ++j) { sc[j] = exp2f(sc[j] - mx); l += sc[j]; }
    const float inv = 1.0f / l;
#pragma unroll
    for (int dd = 0; dd < 16; ++dd) { const int d = 16 * part + dd; float acc = 0.f;
#pragma unroll
        for (int j = 0; j < 16; ++j) acc += sc[j] * bf2f(VT1[((size_t)(b * 16 + h) * 64 + d) * LP + perm16(j)]);
        o[qrow * D + h * 64 + d] = f2bf(acc * inv); }
}
__device__ __forceinline__ void mla_phase(LAS unsigned char* lds, const bf16_t* Q1, const bf16_t* K1, const bf16_t* kpe, const bf16_t* VT1, bf16_t* o, int bid, int nblk) {
    const int v = (nblk % 8 == 0) ? (bid % 8) * (nblk / 8) + bid / 8 : bid;
    for (int vv = v; vv < 256; vv += nblk) {
        const int bh = vv >> 3, s = vv & 7, b = bh >> 4, h = bh & 15;
#pragma unroll 1
        for (int i = 0; i < 4; ++i) { const int qi = (i == 0) ? s : (i == 1) ? 15 - s : (i == 2) ? 16 + s : 31 - s; mla_unit(lds, b, h, qi, Q1, K1, kpe, VT1, o); }
        if (s == 0 && threadIdx.x < 64) mla_meta(b, h, Q1, K1, kpe, VT1, o, threadIdx.x);
    }
}

constexpr int SW_K = 0, SW_V = 36864, SW_VP = 560;
__device__ __forceinline__ void swa_block32(LAS const unsigned char* lds, int rb, int gk0, int nks, int mode, int i_q, const bf16x8 (&qf)[4], float& m, float& lsum, f32x16 (&oacc)[2], int r32, int hi) {
    const float C2 = 1.4426950408889634f;
    const int ksw = (r32 >> 1) & 7;
    f32x16 p = (f32x16){};
#pragma unroll
    for (int s = 0; s < 4; ++s) { const bf16x8 k = *(LAS const bf16x8*)(lds + SW_K + (rb + r32) * 128 + (((2 * s + hi) ^ ksw) << 4)); p = __builtin_amdgcn_mfma_f32_32x32x16_bf16(k, qf[s], p, 0, 0, 0); }
    if (mode != 0) {
        const int jb = ((rb - 32) & 127) + 4 * hi;
#pragma unroll
        for (int r = 0; r < 16; ++r) { const int kk = (r & 3) + 8 * (r >> 2);
            const bool ok = mode == 1 ? (kk + 4 * hi < 16) : mode == 2 ? (jb + kk > i_q) : (jb + kk <= i_q);
            if (!ok) p[r] = -1e30f; }
    }
    float tm = p[0];
#pragma unroll
    for (int r = 1; r < 16; ++r) tm = fmaxf(tm, p[r]);
    tm = fmaxf(tm, __shfl_xor(tm, 32));
    const float mn = fmaxf(m, tm), alpha = __builtin_amdgcn_exp2f((m - mn) * C2), nmc = -mn * C2;
    m = mn;
    float ps = 0.f;
#pragma unroll
    for (int r = 0; r < 16; ++r) { p[r] = __builtin_amdgcn_exp2f(__builtin_fmaf(p[r], C2, nmc)); ps += p[r]; }
    lsum = lsum * alpha + ps;
#pragma unroll
    for (int r = 0; r < 16; ++r) { oacc[0][r] *= alpha; oacc[1][r] *= alpha; }
    u32x4 pf[2];
    pf[0] = (u32x4){cvtpk(p[0], p[1]), cvtpk(p[2], p[3]), cvtpk(p[4], p[5]), cvtpk(p[6], p[7])};
    pf[1] = (u32x4){cvtpk(p[8], p[9]), cvtpk(p[10], p[11]), cvtpk(p[12], p[13]), cvtpk(p[14], p[15])};
#pragma unroll
    for (int ks = 0; ks < 2; ++ks) if (ks < nks) {
        const bf16x8 v0 = *(LAS const bf16x8*)(lds + SW_V + r32 * SW_VP + (gk0 + ks) * 32 + hi * 16);
        const bf16x8 v1 = *(LAS const bf16x8*)(lds + SW_V + (32 + r32) * SW_VP + (gk0 + ks) * 32 + hi * 16);
        const bf16x8 pb = __builtin_bit_cast(bf16x8, pf[ks]);
        oacc[0] = __builtin_amdgcn_mfma_f32_32x32x16_bf16(v0, pb, oacc[0], 0, 0, 0);
        oacc[1] = __builtin_amdgcn_mfma_f32_32x32x16_bf16(v1, pb, oacc[1], 0, 0, 0);
    }
}
__device__ __forceinline__ void swa_unit(LAS unsigned char* lds, int b, int n, int kh, const bf16_t* __restrict__ qkv, const bf16_t* __restrict__ VT0, const float* __restrict__ sinks, bf16_t* o) {
    const int tid = threadIdx.x, lane = tid & 63, wave = __builtin_amdgcn_readfirstlane(tid >> 6), r32 = lane & 31, hi = lane >> 5;
    for (int idx = tid; idx < 2176; idx += NTHR) {
        const int row = idx >> 3, c = idx & 7;
        if (row < 16 || n > 0 || row >= 144) {
            const size_t srow = row < 16 ? (size_t)MREAL + b * 16 + row : (size_t)b * SEQ + 128 * (n - 1) + (row - 16);
            const int lrow = row < 16 ? row : 16 + row;
            const u32x4 v = *(const u32x4*)(qkv + srow * NQKV + 1024 + kh * 64 + c * 8);
            *(LAS u32x4*)(lds + SW_K + lrow * 128 + ((c ^ ((lrow >> 1) & 7)) << 4)) = v;
        }
    }
    for (int idx = tid; idx < 2176; idx += NTHR) {
        const int d = idx / 34, c = idx % 34;
        if (c < 2 || n > 0 || c >= 18) {
            const bf16_t* src = VT0 + (size_t)((b * 2 + kh) * 64 + d) * LP + (c < 2 ? c * 8 : 16 + 128 * (n - 1) + (c - 2) * 8);
            *(LAS u32x4*)(lds + SW_V + d * SW_VP + c * 16) = *(const u32x4*)src;
        }
    }
    __syncthreads();
    const int hq = kh * 8 + wave;
    const float sink = sinks[hq];
#pragma unroll 1
    for (int qs = 0; qs < 4; ++qs) {
        const size_t qrow = (size_t)b * SEQ + 128 * n + 32 * qs + r32;
        bf16x8 qf[4];
#pragma unroll
        for (int s = 0; s < 4; ++s) qf[s] = *(const bf16x8*)(qkv + qrow * NQKV + hq * 64 + 16 * s + 8 * hi);
        f32x16 oacc[2]; oacc[0] = (f32x16){}; oacc[1] = (f32x16){};
        float m = sink, lsum = hi == 0 ? 1.0f : 0.0f;
        const int i_q = 32 * qs + r32;
        swa_block32(lds, 0, 0, 1, 1, i_q, qf, m, lsum, oacc, r32, hi);
        if (n > 0) {
            swa_block32(lds, 32 + 32 * qs, 1 + 2 * qs, 2, 2, i_q, qf, m, lsum, oacc, r32, hi);
#pragma unroll 1
            for (int kb = qs + 1; kb < 4; ++kb) swa_block32(lds, 32 + 32 * kb, 1 + 2 * kb, 2, 0, i_q, qf, m, lsum, oacc, r32, hi);
        }
#pragma unroll 1
        for (int kb = 0; kb < qs; ++kb) swa_block32(lds, 160 + 32 * kb, 9 + 2 * kb, 2, 0, i_q, qf, m, lsum, oacc, r32, hi);
        swa_block32(lds, 160 + 32 * qs, 9 + 2 * qs, 2, 3, i_q, qf, m, lsum, oacc, r32, hi);
        lsum += __shfl_xor(lsum, 32);
        const float inv = 1.0f / lsum;
        bf16_t* orow = o + qrow * D + hq * 64 + 4 * hi;
#pragma unroll
        for (int db = 0; db < 2; ++db)
#pragma unroll
            for (int g = 0; g < 4; ++g)
                *(u32x2*)(orow + 32 * db + 8 * g) = (u32x2){cvtpk(oacc[db][4 * g] * inv, oacc[db][4 * g + 1] * inv), cvtpk(oacc[db][4 * g + 2] * inv, oacc[db][4 * g + 3] * inv)};
    }
    __syncthreads();
}
__device__ __forceinline__ void swa_meta(int b, int hq, const bf16_t* __restrict__ qkv, const bf16_t* __restrict__ VT0, const float* __restrict__ sinks, bf16_t* o, int lane) {
    const int qi = lane & 15, part = lane >> 4, kh = hq >> 3; const size_t qrow = (size_t)MREAL + b * 16 + qi;
    float q[16];
#pragma unroll
    for (int d = 0; d < 16; ++d) q[d] = bf2f(qkv[qrow * NQKV + hq * 64 + 16 * part + d]);
    const float sink = sinks[hq];
    float sc[16]; float mx = sink;
#pragma unroll
    for (int j = 0; j < 16; ++j) {
        const size_t kr = (size_t)MREAL + b * 16 + j; float s = 0.f;
#pragma unroll
        for (int d = 0; d < 16; ++d) s += q[d] * bf2f(qkv[kr * NQKV + 1024 + kh * 64 + 16 * part + d]);
        s += __shfl_xor(s, 16); s += __shfl_xor(s, 32);
        sc[j] = j <= qi ? s : -1e30f; mx = fmaxf(mx, sc[j]);
    }
    float l = __expf(sink - mx);
#pragma unroll
    for (int j = 0; j < 16; ++j) { sc[j] = __expf(sc[j] - mx); l += sc[j]; }
    const float inv = 1.0f / l;
#pragma unroll
    for (int dd = 0; dd < 16; ++dd) { const int d = 16 * part + dd; float acc = 0.f;
#pragma unroll
        for (int j = 0; j < 16; ++j) acc += sc[j] * bf2f(VT0[((size_t)(b * 2 + kh) * 64 + d) * LP + perm16(j)]);
        o[qrow * D + hq * 64 + d] = f2bf(acc * inv); }
}
__device__ __forceinline__ void swa_phase(LAS unsigned char* lds, const bf16_t* qkv, const bf16_t* VT0, const float* sinks, bf16_t* o, int bid, int nblk) {
    for (int u = bid; u < 256; u += nblk) {
        const int b = u >> 7, n = (u >> 1) & 63, kh = u & 1;
        swa_unit(lds, b, n, kh, qkv, VT0, sinks, o);
        if (n == 0) swa_meta(b, kh * 8 + (threadIdx.x >> 6), qkv, VT0, sinks, o, threadIdx.x & 63);
    }
}

template <int MOE_MT>
__device__ __forceinline__ void moe_unit(LAS unsigned char* lds, int e, int s0, int ns, const int* __restrict__ list, const bf16_t* __restrict__ hb, const float* __restrict__ rstd,
                                         const float* __restrict__ wslot, const bf16_t* __restrict__ wgu, const bf16_t* __restrict__ wd, bf16_t* ybuf, unsigned long long* tsb = nullptr) {
#define MSTAMP(i) do { if (PROBE_PHASE >= 600 && tsb && blockIdx.x == 0 && threadIdx.x == 0) tsb[i] = __builtin_amdgcn_s_memrealtime(); } while (0)
    MSTAMP(20);
    constexpr int MOE_BM = 16 * MOE_MT, MOE_HT = MOE_BM * 128, MOE_B2 = 2 * MOE_HT, MOE_ST2 = 32768, MOE_HLO = MOE_B2 + 2 * MOE_ST2, MOE_INFO = MOE_HLO + 2 * MOE_HT;
    static_assert(MOE_B2 + 2 * MOE_ST2 <= MOE_HLO && MOE_INFO + 3072 <= LDS_MISC, "moe lds");
#define moe_hoff(kt2) ((kt2) < 2 ? MOE_HLO + (kt2) * MOE_HT : ((kt2) - 2) * MOE_HT)
    const int tid = threadIdx.x, lane = tid & 63, wave = __builtin_amdgcn_readfirstlane(tid >> 6);
    LAS int* slotl = (LAS int*)(lds + MOE_INFO); LAS float* rsl = (LAS float*)(lds + MOE_INFO + 1024); LAS float* wl = (LAS float*)(lds + MOE_INFO + 2048);
    if (tid < MOE_BM) { const int sl = list[(size_t)e * CAP + s0 + (tid < ns ? tid : 0)]; slotl[tid] = sl; rsl[tid] = rstd[sl >> 1]; wl[tid] = wslot[sl]; }
    __syncthreads();
    const int lc = (lane & 7) ^ (lane >> 3);
    const int fro = (lane & 15) * 128, fc0 = ((lane >> 4) ^ (lane & 7)) << 4, fc1 = ((4 + (lane >> 4)) ^ (lane & 7)) << 4;
    {
        constexpr int ST = (MOE_BM + 512) * 64, GA = MOE_BM / 16, G = GA + 32, NG = (G + 7) / 8;
        static_assert(2 * ST <= MOE_HLO && 2 * MOE_HT <= ST, "moe gemm1 lds");
        const int lc4 = (lane & 3) ^ swzF(lane >> 4);
        const int fro32 = (lane & 15) * 64 + (((lane >> 4) ^ swzF((lane >> 2) & 3)) << 4);
        const char* src[NG];
#pragma unroll
        for (int i = 0; i < NG; ++i) { const int g = wave + 8 * i;
            if (g < GA) src[i] = (const char*)(hb + (size_t)(slotl[g * 16 + (lane >> 2)] >> 1) * D) + lc4 * 16;
            else if (g < G) src[i] = (const char*)(wgu + (size_t)((g - GA) * 16 + (lane >> 2)) * D) + lc4 * 16;
            else src[i] = nullptr; }
        f32x4 acc[MOE_MT][4];
#pragma unroll
        for (int mi = 0; mi < MOE_MT; ++mi)
#pragma unroll
            for (int ni = 0; ni < 4; ++ni) acc[mi][ni] = (f32x4){0.f, 0.f, 0.f, 0.f};
#define M1_STAGE(st, step) do { _Pragma("unroll") for (int _i = 0; _i < NG; ++_i) { const int _g = wave + 8 * _i; if (_g < G) \
        __builtin_amdgcn_global_load_lds((const unsigned*)(src[_i] + (size_t)(step) * 64), (LAS unsigned*)(lds + (st) * ST + _g * 1024), 16, 0, 0); } } while (0)
        M1_STAGE(0, 0);
        for (int step = 0; step < 32; ++step) {
            asm volatile("s_waitcnt vmcnt(0)" ::: "memory");
            __syncthreads();
            if (step + 1 < 32) M1_STAGE((step + 1) & 1, step + 1);
            LAS const unsigned char* sa = lds + (step & 1) * ST + fro32;
            LAS const unsigned char* sb = lds + (step & 1) * ST + (MOE_BM + wave * 64) * 64 + fro32;
            bf16x8 bfr[4];
#pragma unroll
            for (int ni = 0; ni < 4; ++ni) bfr[ni] = *(LAS const bf16x8*)(sb + ni * 1024);
#pragma unroll
            for (int mi = 0; mi < MOE_MT; ++mi) { const bf16x8 af = *(LAS const bf16x8*)(sa + mi * 1024);
#pragma unroll
                for (int ni = 0; ni < 4; ++ni) acc[mi][ni] = __builtin_amdgcn_mfma_f32_16x16x32_bf16(bfr[ni], af, acc[mi][ni], 0, 0, 0); }
        }
#undef M1_STAGE
        int lane_h = threadIdx.x & 63; asm volatile("" : "+v"(lane_h));
#define lane lane_h
#pragma unroll
        for (int p = 0; p < 2; ++p) {
            const int n = 32 * wave + 16 * p + (lane >> 4) * 4;
            const int csw = ((n & 63) >> 3);
#pragma unroll
            for (int mi = 0; mi < MOE_MT; ++mi) { const int row = mi * 16 + (lane & 15); const float rs = rsl[row]; float hv[4];
#pragma unroll
                for (int r = 0; r < 4; ++r) { const float g = acc[mi][2 * p][r] * rs, u = acc[mi][2 * p + 1][r] * rs; hv[r] = g / (1.0f + __expf(-g)) * u; }
                *(LAS u32x2*)(lds + moe_hoff(n >> 6) + row * 128 + ((csw ^ (row & 7)) << 4) + (n & 4) * 2) = (u32x2){pk2(hv[0], hv[1]), pk2(hv[2], hv[3])}; }
        }
#undef lane
    }
    __syncthreads();
    MSTAMP(21);
    {
        const char* src2[4];
#pragma unroll
        for (int i = 0; i < 4; ++i) src2[i] = (const char*)(wd + (size_t)((wave + 8 * i) * 8 + (lane >> 3)) * DE) + lc * 16;
        f32x4 acc[MOE_MT][2];
#pragma unroll
        for (int mi = 0; mi < MOE_MT; ++mi) { acc[mi][0] = (f32x4){0.f, 0.f, 0.f, 0.f}; acc[mi][1] = (f32x4){0.f, 0.f, 0.f, 0.f}; }
#define M2_STAGE(st, q) do { _Pragma("unroll") for (int _i = 0; _i < 4; ++_i) \
        __builtin_amdgcn_global_load_lds((const unsigned*)(src2[_i] + (size_t)((q) >> 2) * (256 * 512) + (size_t)((q) & 3) * 128), (LAS unsigned*)(lds + MOE_B2 + (st) * MOE_ST2 + (wave + 8 * _i) * 1024), 16, 0, 0); } while (0)
        M2_STAGE(0, 0);
        for (int q = 0; q < 16; ++q) {
            asm volatile("s_waitcnt vmcnt(0)" ::: "memory");
            __syncthreads();
            if (q + 1 < 16) M2_STAGE((q + 1) & 1, q + 1);
            LAS const unsigned char* sa = lds + moe_hoff(q & 3) + fro;
            LAS const unsigned char* sb = lds + MOE_B2 + (q & 1) * MOE_ST2 + (wave * 32) * 128 + fro;
#pragma unroll
            for (int ks = 0; ks < 2; ++ks) { const int fc = ks ? fc1 : fc0;
                const bf16x8 b0 = *(LAS const bf16x8*)(sb + fc), b1 = *(LAS const bf16x8*)(sb + 2048 + fc);
#pragma unroll
                for (int mi = 0; mi < MOE_MT; ++mi) { const bf16x8 af = *(LAS const bf16x8*)(sa + mi * 2048 + fc);
                    acc[mi][0] = __builtin_amdgcn_mfma_f32_16x16x32_bf16(b0, af, acc[mi][0], 0, 0, 0);
                    acc[mi][1] = __builtin_amdgcn_mfma_f32_16x16x32_bf16(b1, af, acc[mi][1], 0, 0, 0); }
            }
            if ((q & 3) == 3) {
                const int cb = (q >> 2) * 256 + wave * 32 + (lane >> 4) * 4;
#pragma unroll
                for (int mi = 0; mi < MOE_MT; ++mi) { const int row = mi * 16 + (lane & 15);
                    if (row < ns) { const float w = wl[row]; bf16_t* yr = ybuf + (size_t)slotl[row] * D + cb;
#pragma unroll
                        for (int ni = 0; ni < 2; ++ni) { const f32x4 v = acc[mi][ni] * w; *(u32x2*)(yr + ni * 16) = (u32x2){pk2(v[0], v[1]), pk2(v[2], v[3])}; } }
                    acc[mi][0] = (f32x4){0.f, 0.f, 0.f, 0.f}; acc[mi][1] = (f32x4){0.f, 0.f, 0.f, 0.f}; }
            }
        }
#undef M2_STAGE
    }
#undef moe_hoff
    __syncthreads();
    MSTAMP(22);
#undef MSTAMP
}
__device__ __forceinline__ void moe_phase(LAS unsigned char* lds, int* cnt, const int* list, const bf16_t* hb, const float* rstd, const float* wslot, const bf16_t* wgu, const bf16_t* wd, bf16_t* ybuf, int bid, int nblk, unsigned long long* tsb = nullptr) {
    const bool grp = (nblk % 8) == 0;
    int ntile[NE]; int gsum = 0; bool fit = grp;
#pragma unroll
    for (int e = 0; e < NE; ++e) { const int c = __hip_atomic_load(cnt + e * 64, __ATOMIC_RELAXED, __HIP_MEMORY_SCOPE_AGENT); const int bm = 144; ntile[e] = (c + bm - 1) / bm;
        gsum = (e & 3) == 0 ? ntile[e] : gsum + ntile[e]; if ((e & 3) == 3 && gsum > nblk / 8) fit = false; }
    const int x = bid % 8;
    int u = fit ? bid / 8 : (grp ? x * (nblk / 8) + bid / 8 : bid), base = 0;
    const int stride = fit ? nblk / 8 : nblk;
#pragma unroll 1
    for (int e = 0; e < NE; ++e) {
        if (fit && (e >> 2) != x) continue;
        const int c = __hip_atomic_load(cnt + e * 64, __ATOMIC_RELAXED, __HIP_MEMORY_SCOPE_AGENT);
        const bool big = false; const int bm = 144, nt = (c + bm - 1) / bm;
        while (u < base + nt) { const int t = u - base; const int ns = c - t * bm < bm ? c - t * bm : bm;
            moe_unit<9>(lds, e, t * bm, ns, list, hb, rstd, wslot, wgu + (size_t)e * 512 * 1024, wd + (size_t)e * 1024 * 256, ybuf, tsb);
            u += stride; }
        base += nt;
    }
}

template <int MT>
__device__ __forceinline__ void l1proj_unit(LAS unsigned char* lds, int row0, int mrow0, bf16_t* hb, const bf16_t* __restrict__ ybuf, const bf16_t* __restrict__ win_t, const bf16_t* __restrict__ wuq_t,
                                            const bf16_t* __restrict__ wukv_t, const float2* __restrict__ cs, bf16_t* kpe, bf16_t* Q1, bf16_t* K1, bf16_t* VT1) {
    constexpr int BM = 16 * MT, STW = (BM + 512) * 64, KT = BM * 64  , CQN = 0, CKV = 8 * KT, RB = 12 * KT, STB = 32768, PART = 3 * STW;
    static_assert(RB + 3 * STB <= LDS_MISC && PART + 8 * BM * 4 <= LDS_MISC, "l1proj lds");
    const int tid = threadIdx.x, lane = tid & 63, wave = __builtin_amdgcn_readfirstlane(tid >> 6);
    LAS float* rsl = (LAS float*)(lds + LDS_MISC + 256);
#define L1_GROW(r) ((r) < 64 ? row0 + (r) : mrow0 + (r) - 64)
    for (int r = wave; r < BM; r += NWAVE) {
        const size_t grow = L1_GROW(r); float ss = 0.f;
#pragma unroll
        for (int j = 0; j < 4; ++j) { const size_t c = j * 256 + lane * 4;
            const u32x2 h = *(const u32x2*)(hb + grow * D + c), y0 = *(const u32x2*)(ybuf + (grow * 2) * D + c), y1 = *(const u32x2*)(ybuf + (grow * 2 + 1) * D + c);
            float v[4];
            v[0] = __uint_as_float(h.x << 16) + __uint_as_float(y0.x << 16) + __uint_as_float(y1.x << 16);
            v[1] = __uint_as_float(h.x & 0xffff0000u) + __uint_as_float(y0.x & 0xffff0000u) + __uint_as_float(y1.x & 0xffff0000u);
            v[2] = __uint_as_float(h.y << 16) + __uint_as_float(y0.y << 16) + __uint_as_float(y1.y << 16);
            v[3] = __uint_as_float(h.y & 0xffff0000u) + __uint_as_float(y0.y & 0xffff0000u) + __uint_as_float(y1.y & 0xffff0000u);
            ss += v[0] * v[0] + v[1] * v[1] + v[2] * v[2] + v[3] * v[3];
            *(u32x2*)(hb + grow * D + c) = (u32x2){pk2(v[0], v[1]), pk2(v[2], v[3])}; }
        ss = wave_sum(ss); if (lane == 0) rsl[r] = rsqrtf(ss * (1.0f / D) + EPS);
    }
    asm volatile("s_waitcnt vmcnt(0)" ::: "memory");
    __syncthreads();
    const int lc = (lane & 3) ^ swzF(lane >> 4);
    const int fro = (lane & 15) * 64 + (((lane >> 4) ^ swzF((lane >> 2) & 3)) << 4);
    f32x4 acc[MT][4];
#pragma unroll
    for (int mi = 0; mi < MT; ++mi)
#pragma unroll
        for (int ni = 0; ni < 4; ++ni) acc[mi][ni] = (f32x4){0.f, 0.f, 0.f, 0.f};
    {
        const char* srcb[4];
#pragma unroll
        for (int i = 0; i < 4; ++i) srcb[i] = (const char*)(win_t + (size_t)((wave + 8 * i) * 16 + (lane >> 2)) * D) + lc * 16;
        const char* srca = (const char*)(hb + (size_t)L1_GROW((wave < MT ? wave : 0) * 16 + (lane >> 2)) * D) + lc * 16;
#define W_ISSUE(st, kt) do { if (wave < MT) __builtin_amdgcn_global_load_lds((const unsigned*)(srca + (size_t)(kt) * 64), (LAS unsigned*)(lds + (st) * STW + wave * 1024), 16, 0, 16); \
        _Pragma("unroll") for (int _i = 0; _i < 4; ++_i) __builtin_amdgcn_global_load_lds((const unsigned*)(srcb[_i] + (size_t)(kt) * 64), (LAS unsigned*)(lds + (st) * STW + (MT + wave + 8 * _i) * 1024), 16, 0, 0); } while (0)
        W_ISSUE(0, 0); W_ISSUE(1, 1);
        int st = 0;
        for (int kt = 0; kt < 32; ++kt) {
            if (kt + 1 < 32) { if (wave < MT) wait_vm<5>(); else wait_vm<4>(); } else wait_vm<0>();
            __builtin_amdgcn_s_barrier(); asm volatile("" ::: "memory");
            if (kt + 2 < 32) W_ISSUE(st == 0 ? 2 : st - 1, kt + 2);
            LAS const unsigned char* sa = lds + st * STW + fro;
            LAS const unsigned char* sb = lds + st * STW + (BM + wave * 64) * 64 + fro;
            bf16x8 bfr[4];
#pragma unroll
            for (int ni = 0; ni < 4; ++ni) bfr[ni] = *(LAS const bf16x8*)(sb + ni * 1024);
#pragma unroll
            for (int mi = 0; mi < MT; ++mi) { const bf16x8 af = *(LAS const bf16x8*)(sa + mi * 1024);
#pragma unroll
                for (int ni = 0; ni < 4; ++ni) acc[mi][ni] = __builtin_amdgcn_mfma_f32_16x16x32_bf16(bfr[ni], af, acc[mi][ni], 0, 0, 0); }
            st = st == 2 ? 0 : st + 1;
        }
#undef W_ISSUE
    }
    asm volatile("s_waitcnt lgkmcnt(0)" ::: "memory");
    __syncthreads();
    LAS float* part = (LAS float*)(lds + PART);
    int lane_e = lane; asm volatile("" : "+v"(lane_e));
#define lane lane_e
#pragma unroll
    for (int mi = 0; mi < MT; ++mi) { const float rs = rsl[mi * 16 + (lane & 15)]; float ss = 0.f;
#pragma unroll
        for (int ni = 0; ni < 4; ++ni) { acc[mi][ni] = acc[mi][ni] * rs; ss += acc[mi][ni][0] * acc[mi][ni][0] + acc[mi][ni][1] * acc[mi][ni][1] + acc[mi][ni][2] * acc[mi][ni][2] + acc[mi][ni][3] * acc[mi][ni][3]; }
        ss += __shfl_xor(ss, 16); ss += __shfl_xor(ss, 32);
        if (lane < 16) part[wave * BM + mi * 16 + lane] = ss; }
    __syncthreads();
    if (wave < 6) {
#pragma unroll
        for (int mi = 0; mi < MT; ++mi) { const int row = mi * 16 + (lane & 15);
            const float tot = wave < 4 ? (part[row] + part[BM + row]) + (part[2 * BM + row] + part[3 * BM + row]) : part[4 * BM + row] + part[5 * BM + row];
            const float rn = rsqrtf(tot * (wave < 4 ? 1.0f / 256 : 1.0f / 128) + EPS);
#pragma unroll
            for (int ni = 0; ni < 4; ++ni) { const int cc = (wave < 4 ? 64 * wave : 64 * (wave - 4)) + ni * 16 + (lane >> 4) * 4; const f32x4 v = acc[mi][ni] * rn;
                *(LAS u32x2*)(lds + (wave < 4 ? CQN : CKV) + (cc >> 5) * KT + row * 64 + (((((cc & 31) >> 3)) ^ swzF((row >> 2) & 3)) << 4) + (cc & 4) * 2) = (u32x2){pk2(v[0], v[1]), pk2(v[2], v[3])}; } }
    } else if (wave == 6) {
#pragma unroll
        for (int mi = 0; mi < MT; ++mi) { const int row = mi * 16 + (lane & 15); const int grow = L1_GROW(row); const int pos = row_pos(grow), d0 = (lane >> 4) * 4;
            f32x4 o1, o2;
#pragma unroll
            for (int r = 0; r < 4; ++r) { const float2 t = cs[pos * 32 + 2 * (d0 + r)]; const float x1 = acc[mi][0][r], x2 = acc[mi][1][r]; o1[r] = x1 * t.x - x2 * t.y; o2[r] = x2 * t.x + x1 * t.y; }
            bf16_t* kr = kpe + ((size_t)row_batch(grow) * LP + pos) * 32;
            *(u32x2*)(kr + d0) = (u32x2){pk2(o1[0], o1[1]), pk2(o1[2], o1[3])}; *(u32x2*)(kr + 16 + d0) = (u32x2){pk2(o2[0], o2[1]), pk2(o2[2], o2[3])}; }
    }
#undef lane
    __syncthreads();
    const char* srcu[4];
#define U_ISSUE(st, base, pitchB, chunk, kt) do { _Pragma("unroll") for (int _i = 0; _i < 4; ++_i) \
        __builtin_amdgcn_global_load_lds((const unsigned*)(srcu[_i] + (size_t)(chunk) * 512 * (pitchB) + (size_t)(kt) * 64), (LAS unsigned*)(lds + RB + (st) * STB + (wave + 8 * _i) * 1024), 16, 0, 0); } while (0)
    {
#pragma unroll
        for (int i = 0; i < 4; ++i) srcu[i] = (const char*)(wuq_t + (size_t)((wave + 8 * i) * 16 + (lane >> 2)) * 256) + lc * 16;
#pragma unroll
        for (int mi = 0; mi < MT; ++mi)
#pragma unroll
            for (int ni = 0; ni < 4; ++ni) acc[mi][ni] = (f32x4){0.f, 0.f, 0.f, 0.f};
        U_ISSUE(0, 0, 512, 0, 0); U_ISSUE(1, 0, 512, 0, 1);
        int st = 0;
        for (int q = 0; q < 24; ++q) {
            if (q + 1 < 24) wait_vm<4>(); else wait_vm<0>();
            __builtin_amdgcn_s_barrier(); asm volatile("" ::: "memory");
            if (q + 2 < 24) U_ISSUE(st == 0 ? 2 : st - 1, 0, 512, (q + 2) >> 3, (q + 2) & 7);
            LAS const unsigned char* sa = lds + CQN + (q & 7) * KT + fro;
            LAS const unsigned char* sb = lds + RB + st * STB + (wave * 64) * 64 + fro;
            bf16x8 bfr[4];
#pragma unroll
            for (int ni = 0; ni < 4; ++ni) bfr[ni] = *(LAS const bf16x8*)(sb + ni * 1024);
#pragma unroll
            for (int mi = 0; mi < MT; ++mi) { const bf16x8 af = *(LAS const bf16x8*)(sa + mi * 1024);
#pragma unroll
                for (int ni = 0; ni < 4; ++ni) acc[mi][ni] = __builtin_amdgcn_mfma_f32_16x16x32_bf16(bfr[ni], af, acc[mi][ni], 0, 0, 0); }
            if ((q & 7) == 7) {
                int lane_q = lane; asm volatile("" : "+v"(lane_q));
#define lane lane_q
                const float scale = 0.10206207261596577f * 1.4426950408889634f; const int d0 = (lane >> 4) * 4;
#pragma unroll
                for (int mi = 0; mi < MT; ++mi) { const int grow = L1_GROW(mi * 16 + (lane & 15)); const int pos = row_pos(grow);
#pragma unroll
                    for (int bi = 0; bi < 2; ++bi) { const int gc = (q >> 3) * 512 + 64 * wave + bi * 32; bf16_t* orow = Q1 + (size_t)grow * 1536 + gc;
                        f32x4 v1 = acc[mi][2 * bi], v2 = acc[mi][2 * bi + 1];
                        if (((gc >> 5) % 3) == 2) {
#pragma unroll
                            for (int r = 0; r < 4; ++r) { const float2 t = cs[pos * 32 + 2 * (d0 + r)]; const float x1 = v1[r], x2 = v2[r]; v1[r] = x1 * t.x - x2 * t.y; v2[r] = x2 * t.x + x1 * t.y; } }
                        v1 = v1 * scale; v2 = v2 * scale;
                        *(u32x2*)(orow + d0) = (u32x2){pk2(v1[0], v1[1]), pk2(v1[2], v1[3])}; *(u32x2*)(orow + 16 + d0) = (u32x2){pk2(v2[0], v2[1]), pk2(v2[2], v2[3])}; }
#pragma unroll
                    for (int ni = 0; ni < 4; ++ni) acc[mi][ni] = (f32x4){0.f, 0.f, 0.f, 0.f}; }
#undef lane
            }
            st = st == 2 ? 0 : st + 1;
        }
    }
    asm volatile("s_waitcnt lgkmcnt(0)" ::: "memory");
    __syncthreads();
    {
#pragma unroll
        for (int i = 0; i < 4; ++i) srcu[i] = (const char*)(wukv_t + (size_t)((wave + 8 * i) * 16 + (lane >> 2)) * 128) + lc * 16;
#pragma unroll
        for (int mi = 0; mi < MT; ++mi)
#pragma unroll
            for (int ni = 0; ni < 4; ++ni) acc[mi][ni] = (f32x4){0.f, 0.f, 0.f, 0.f};
        U_ISSUE(0, 0, 256, 0, 0); U_ISSUE(1, 0, 256, 0, 1);
        int st = 0;
        for (int q = 0; q < 16; ++q) {
            if (q + 1 < 16) wait_vm<4>(); else wait_vm<0>();
            __builtin_amdgcn_s_barrier(); asm volatile("" ::: "memory");
            if (q + 2 < 16) U_ISSUE(st == 0 ? 2 : st - 1, 0, 256, (q + 2) >> 2, (q + 2) & 3);
            LAS const unsigned char* sa = lds + CKV + (q & 3) * KT + fro;
            LAS const unsigned char* sb = lds + RB + st * STB + (wave * 64) * 64 + fro;
            bf16x8 bfr[4];
#pragma unroll
            for (int ni = 0; ni < 4; ++ni) bfr[ni] = *(LAS const bf16x8*)(sb + ni * 1024);
            if (q < 8) {
#pragma unroll
                for (int mi = 0; mi < MT; ++mi) { const bf16x8 af = *(LAS const bf16x8*)(sa + mi * 1024);
#pragma unroll
                    for (int ni = 0; ni < 4; ++ni) acc[mi][ni] = __builtin_amdgcn_mfma_f32_16x16x32_bf16(bfr[ni], af, acc[mi][ni], 0, 0, 0); }
            } else {
#pragma unroll
                for (int mi = 0; mi < MT; ++mi) { const bf16x8 af = *(LAS const bf16x8*)(sa + mi * 1024);
#pragma unroll
                    for (int ni = 0; ni < 4; ++ni) acc[mi][ni] = __builtin_amdgcn_mfma_f32_16x16x32_bf16(af, bfr[ni], acc[mi][ni], 0, 0, 0); }
            }
            if ((q & 3) == 3) {
                const int ch = q >> 2;
                int lane_k = lane; asm volatile("" : "+v"(lane_k));
#define lane lane_k
                if (ch < 2) {
#pragma unroll
                    for (int mi = 0; mi < MT; ++mi) { const int grow = L1_GROW(mi * 16 + (lane & 15)); const size_t kr = (size_t)row_batch(grow) * LP + row_pos(grow);
#pragma unroll
                        for (int ni = 0; ni < 4; ++ni) { const f32x4 v = acc[mi][ni];
                            *(u32x2*)(K1 + kr * D + 512 * ch + 64 * wave + ni * 16 + (lane >> 4) * 4) = (u32x2){pk2(v[0], v[1]), pk2(v[2], v[3])}; acc[mi][ni] = (f32x4){0.f, 0.f, 0.f, 0.f}; } }
                } else {
#pragma unroll
                    for (int mi = 0; mi < MT; ++mi) { const int grow0 = L1_GROW(mi * 16 + (lane >> 4) * 4); const int b = row_batch(grow0), pp = perm16(row_pos(grow0));
#pragma unroll
                        for (int ni = 0; ni < 4; ++ni) { const int hd = 512 * (ch - 2) + 64 * wave + ni * 16 + (lane & 15); const f32x4 v = acc[mi][ni];
                            *(u32x2*)(VT1 + (size_t)(b * 1024 + hd) * LP + pp) = (u32x2){pk2(v[0], v[1]), pk2(v[2], v[3])}; acc[mi][ni] = (f32x4){0.f, 0.f, 0.f, 0.f}; } }
                }
#undef lane
            }
            st = st == 2 ? 0 : st + 1;
        }
    }
#undef U_ISSUE
#undef L1_GROW
    asm volatile("s_waitcnt lgkmcnt(0)" ::: "memory");
    __syncthreads();
}
__device__ __forceinline__ void l1proj_phase(LAS unsigned char* lds, bf16_t* hb, const bf16_t* ybuf, const bf16_t* win_t, const bf16_t* wuq_t, const bf16_t* wukv_t, const float2* cs, bf16_t* kpe,
                                             bf16_t* Q1, bf16_t* K1, bf16_t* VT1, int bid, int nblk) {
    { const int gt = bid * NTHR + threadIdx.x, ngt = nblk * NTHR;
      for (int idx = gt; idx < 2 * 48 * 1024; idx += ngt) { const int b = idx / (48 * 1024), r = idx % (48 * 1024); K1[((size_t)b * LP + 8208) * 1024 + r] = 0; }
      for (int idx = gt; idx < 2 * 16 * 64 * 48; idx += ngt) { const int rr = idx / 48, c = idx % 48; VT1[(size_t)rr * LP + 8208 + c] = 0; } }
    for (int u = bid; u < 256; u += nblk) {
        if (u >= 254) l1proj_unit<5>(lds, u * 64, MREAL + (u - 254) * 16, hb, ybuf, win_t, wuq_t, wukv_t, cs, kpe, Q1, K1, VT1);
        else l1proj_unit<4>(lds, u * 64, MREAL, hb, ybuf, win_t, wuq_t, wukv_t, cs, kpe, Q1, K1, VT1);
    }
}

struct EpiNull { int m0, n0;
    template <int MT, int NT> __device__ __forceinline__ void operator()(f32x4 (&acc)[MT][NT], int, int, int) const {
#pragma unroll
        for (int mi = 0; mi < MT; ++mi)
#pragma unroll
            for (int ni = 0; ni < NT; ++ni) asm volatile("" :: "v"(acc[mi][ni])); } };
__device__ __forceinline__ void transpose_item(const float* __restrict__ W, int N, const float* __restrict__ gain, bf16_t* dst, int ldk, int drow0, int k0, int n0, LAS float* scr, int lane, int dskip = 0) {
#pragma unroll 8
    for (int i = 0; i < 32; ++i) { const int kk = 2 * i + (lane >> 5); float v = W[(size_t)(k0 + kk) * N + n0 + (lane & 31)]; if (gain) v *= gain[k0 + kk]; scr[kk * 33 + (lane & 31)] = v; }
    asm volatile("s_waitcnt lgkmcnt(0)" ::: "memory");
    const int c = lane & 7;
#pragma unroll
    for (int j = 0; j < 4; ++j) { const int n = (lane >> 3) + 8 * j; const LAS float* s = scr + (8 * c) * 33 + n;
        u32x4 o; o.x = pk2(s[0 * 33], s[1 * 33]); o.y = pk2(s[2 * 33], s[3 * 33]); o.z = pk2(s[4 * 33], s[5 * 33]); o.w = pk2(s[6 * 33], s[7 * 33]);
        *(u32x4*)(dst + (size_t)(drow0 + n + (n >= 16 ? dskip : 0)) * ldk + k0 + 8 * c) = o; }
    asm volatile("s_waitcnt lgkmcnt(0)" ::: "memory");
}
struct MoeItem { const float* src; const float* gain; bf16_t* dst; int pitch, ldk, kind, nrow0; };
__device__ __forceinline__ MoeItem moe_item(int it, const float* wgate, const float* wup, const float* wdown, const float* gain, bf16_t* wgu_t, bf16_t* wd_t) {
    const int e = it / 48, r = it % 48, which = r >> 4, q = r & 15; MoeItem d;
    if (which < 2) { d.src = (which ? wup : wgate) + (size_t)e * D * DE + (size_t)q * 64 * DE; d.gain = gain + q * 64; d.dst = wgu_t + (size_t)e * 512 * 1024 + q * 64; d.pitch = DE; d.ldk = 1024; d.kind = which; d.nrow0 = 0; }
    else { const int kb = q >> 2, nb = q & 3; d.src = wdown + (size_t)e * DE * D + (size_t)kb * 64 * D + nb * 256; d.gain = nullptr; d.dst = wd_t + (size_t)e * 1024 * 256 + kb * 64; d.pitch = D; d.ldk = 256; d.kind = 2; d.nrow0 = nb * 256; }
    return d;
}
__device__ __forceinline__ void moe_weight_items(const float* wgate, const float* wup, const float* wdown, const float* gain, bf16_t* wgu_t, bf16_t* wd_t, LAS float* T, int bid, int nblk) {
    const int tid = threadIdx.x;
    f32x4 R[8];
    int it = bid;
    if (it >= NE * 48) return;
    MoeItem cur = moe_item(it, wgate, wup, wdown, gain, wgu_t, wd_t);
#pragma unroll
    for (int i = 0; i < 8; ++i) { const int idx = tid + i * NTHR; R[i] = *(const f32x4*)(cur.src + (size_t)(idx >> 6) * cur.pitch + (idx & 63) * 4); }
    for (;;) {
#pragma unroll
        for (int i = 0; i < 8; ++i) { const int idx = tid + i * NTHR, k = idx >> 6, c4 = idx & 63; f32x4 v = R[i]; if (cur.gain) v = v * cur.gain[k];
            LAS float* t = T + k * 257 + c4 * 4; t[0] = v[0]; t[1] = v[1]; t[2] = v[2]; t[3] = v[3]; }
        __syncthreads();
        const int nit = it + nblk; const bool more = nit < NE * 48;
        MoeItem nxt = cur;
        if (more) { nxt = moe_item(nit, wgate, wup, wdown, gain, wgu_t, wd_t);
#pragma unroll
            for (int i = 0; i < 8; ++i) { const int idx = tid + i * NTHR; R[i] = *(const f32x4*)(nxt.src + (size_t)(idx >> 6) * nxt.pitch + (idx & 63) * 4); } }
#pragma unroll
        for (int i = 0; i < 4; ++i) { const int idx = tid + i * NTHR, kc = idx & 7, n = idx >> 3;
            const LAS float* t = T + (8 * kc) * 257 + n;
            u32x4 o; o.x = pk2(t[0], t[257]); o.y = pk2(t[2 * 257], t[3 * 257]); o.z = pk2(t[4 * 257], t[5 * 257]); o.w = pk2(t[6 * 257], t[7 * 257]);
            const int row = cur.kind == 2 ? cur.nrow0 + n : (n >> 4) * 32 + cur.kind * 16 + (n & 15);
            *(u32x4*)(cur.dst + (size_t)row * cur.ldk + 8 * kc) = o; }
        __syncthreads();
        if (!more) break;
        cur = nxt; it = nit;
    }
}
__device__ __forceinline__ void p0_prologue(const MArgs& a, LAS unsigned char* lds, int bid, int nblk) {
    const int tid = threadIdx.x, lane = tid & 63, wave = __builtin_amdgcn_readfirstlane(tid >> 6);
    const int gw = bid * NWAVE + wave, ngw = nblk * NWAVE, gt = bid * NTHR + tid, ngt = nblk * NTHR;
    unsigned char* ws = a.ws;
    float2* cs = (float2*)(ws + WS_ROPE);
    for (int _r = 0; _r < (PROBE_PHASE == 301 ? 2 : 1); ++_r)
    for (int idx = gt; idx < LPOS * 32; idx += ngt) { const int pos = idx >> 5, i = idx & 31; const float inv = 1.0f / powf(10000.0f, (float)(2 * i) / 64.0f); float s, c; sincosf((float)pos * inv, &s, &c); cs[idx] = make_float2(c, s); }
    float* wrf = (float*)(ws + W2_WRF);
    for (int idx = gt; idx < 2 * 36 * 1024; idx += ngt) { const int l = idx / (36 * 1024), j = (idx >> 10) % 36, k = idx & 1023;
        const float g = a.in[3][l * D + k]; wrf[idx] = g * (j < 4 ? a.in[16][(size_t)l * D * 4 + k * 4 + j] : a.in[18][(size_t)l * D * 32 + k * 32 + (j - 4)]); }
    { u32x4* z = (u32x4*)(ws + W2_WIN + (size_t)416 * 1024 * 2); for (int idx = gt; idx < 96 * 1024 * 2 / 16; idx += ngt) z[idx] = (u32x4){0u, 0u, 0u, 0u}; }
    { bf16_t* kpe = (bf16_t*)(ws + WS_KPE); for (int idx = gt; idx < 2 * 48 * 32; idx += ngt) { const int b = idx / (48 * 32), r = idx % (48 * 32); kpe[((size_t)b * LP + 8208) * 32 + r] = 0; }
      bf16_t* vt0 = (bf16_t*)(ws + B_VT0); for (int idx = gt; idx < 2 * 2 * 64 * 48; idx += ngt) { const int rr = idx / 48, c = idx % 48; vt0[(size_t)rr * LP + 8208 + c] = 0; } }
    { bf16_t* hb = (bf16_t*)(ws + W2_HB); float* rstd = (float*)(ws + W2_RSTD);
      for (int _r = 0; _r < (PROBE_PHASE == 303 ? 2 : 1); ++_r)
      for (int row = gw; row < MTOT; row += ngw) {
        const float* src = row < MREAL ? a.in[0] + (size_t)row * D : a.in[1] + (size_t)row_pos(row) * D;
        float ss = 0.f;
#pragma unroll
        for (int j = 0; j < 4; ++j) { const f32x4 v = *(const f32x4*)(src + j * 256 + lane * 4); ss += v[0] * v[0] + v[1] * v[1] + v[2] * v[2] + v[3] * v[3];
            *(u32x2*)(hb + (size_t)row * D + j * 256 + lane * 4) = (u32x2){pk2(v[0], v[1]), pk2(v[2], v[3])}; }
        ss = wave_sum(ss); if (lane == 0) rstd[row] = rsqrtf(ss * (1.0f / D) + EPS);
      } }
    LAS float* scr = (LAS float*)(lds + wave * 16384);
    for (int _r = 0; _r < (PROBE_PHASE == 304 ? 2 : 1); ++_r)
    for (int it = gw; it < 2192; it += ngw) {
        int r = it;
        if (r < 640) { const int nb = r % 40;
            transpose_item(a.in[5], NQKV, a.in[2], (bf16_t*)(ws + W2_WQKV), 1024, nb < 32 ? 64 * (nb >> 1) + 16 * (nb & 1) : nb * 32, (r / 40) * 64, nb * 32, scr, lane, nb < 32 ? 16 : 0); continue; } r -= 640;
        if (r < 512) { transpose_item(a.in[8], D, nullptr, (bf16_t*)(ws + W2_WO0), 1024, (r & 31) * 32, (r >> 5) * 64, (r & 31) * 32, scr, lane); continue; } r -= 512;
        if (r < 208) { transpose_item(a.in[10], 416, a.in[2] + D, (bf16_t*)(ws + W2_WIN), 1024, (r % 13) * 32, (r / 13) * 64, (r % 13) * 32, scr, lane); continue; } r -= 208;
        if (r < 192) { transpose_item(a.in[13], 1536, a.in[11], (bf16_t*)(ws + W2_WUQ), 256, (r % 48) * 32, (r / 48) * 64, (r % 48) * 32, scr, lane); continue; } r -= 192;
        if (r < 128) { const int nb32 = r & 63, hh = nb32 >> 2, part = nb32 & 3;
            transpose_item(a.in[14], 2048, a.in[12], (bf16_t*)(ws + W2_WUKV), 128, part < 2 ? hh * 64 + part * 32 : 1024 + hh * 64 + (part - 2) * 32, (r >> 6) * 64, nb32 * 32, scr, lane); continue; } r -= 128;
        transpose_item(a.in[15], D, nullptr, (bf16_t*)(ws + W2_WO1), 1024, (r & 31) * 32, (r >> 5) * 64, (r & 31) * 32, scr, lane);
    }
    __syncthreads();
    moe_weight_items(a.in[20], a.in[21], a.in[22], a.in[3], (bf16_t*)(ws + C_W0), (bf16_t*)(ws + C_W0 + MOE_WGU_BYTES), (LAS float*)lds, bid, nblk);
}

template <bool NSW, bool HALFN, class MakeEpi>
__device__ __forceinline__ void gemm_phase(LAS unsigned char* lds, const bf16_t* A, int lda, const bf16_t* Bt, int K, int pn0, int pn1, int bid, int nblk, const MakeEpi& mk) {
    constexpr int BN = HALFN ? 128 : 256;
    const int ntn = pn1 - pn0;
    const bool grp = (nblk % 8) == 0;
    const int x = grp ? bid % 8 : 0, j = grp ? bid / 8 : bid, nslot = grp ? nblk / 8 : nblk, pmg = grp ? 8 : 64;
    for (int u = j; u < pmg * ntn; u += nslot) {
        const int pm = x * pmg + u / ntn, pn = pn0 + u % ntn;
        RowDense ra{A, lda, pm * 256, MTOT - 1}; auto e = mk(pm * 256, pn * BN);
        if (HALFN) gemm_tile<4, 4, 4, 2, NSW>(lds, ra, Bt + (size_t)pn * BN * K, K, K / 32, e);
        else gemm_tile<8, 4, 2, 4, NSW>(lds, ra, Bt + (size_t)pn * BN * K, K, K / 32, e);
    }
    const int nfull = (pmg * ntn + nslot - 1) / nslot;
    for (int pn = pn0; pn < pn1; ++pn) {
        const int owner = (pn - pn0) * 37 % nblk;
        if (bid == owner) { RowDense ra{A, lda, MREAL, MTOT - 1}; auto e = mk(MREAL, pn * BN);
            if (HALFN) gemm_tile<1, 4, 4, 2, NSW>(lds, ra, Bt + (size_t)pn * BN * K, K, K / 32, e);
            else gemm_tile<1, 4, 2, 4, NSW>(lds, ra, Bt + (size_t)pn * BN * K, K, K / 32, e); }
    }
    (void)nfull;
}

constexpr int PH_PROLOGUE = 0, PH_QKV = 1, PH_SWA = 2, PH_OPROJ0 = 3, PH_ROUTE0 = 4, PH_MOE0 = 5, PH_COMBINE = 6, PH_WIN = 7, PH_CEPI = 8, PH_UQKV = 9, PH_MLA = 10, PH_OPROJ1 = 11, PH_ROUTE1 = 12, PH_MOE1 = 13, PH_FINAL = 14, PH_N = 15;
__global__ void __launch_bounds__(NTHR, 2) mega(MArgs a) {
    extern __shared__ __attribute__((aligned(16))) unsigned char lds_raw[];
    LAS unsigned char* lds = (LAS unsigned char*)lds_raw;
    const int tid = threadIdx.x, bid = blockIdx.x, nblk = gridDim.x;
    volatile LAS unsigned* misc = (volatile LAS unsigned*)(lds + LDS_MISC);
    if (tid < 64) misc[tid] = 0u;
    __syncthreads();
    unsigned char* ws = a.ws;
    XcdBarrier bar = xcd_barrier_post((unsigned*)(ws + WS_BAR) + a.li * XCD_BAR_WORDS, misc);
    if (tid == 0) misc[4] = xb_add((unsigned*)(ws + 32 * 1024) + 64 * bar.x, 1u);
    const int lo = a.ph_lo, hi = a.ph_hi;
#define IN(k) (lo <= (k) && (k) < hi)
#define REP(k) for (int _rep = 0; _rep < ((k) == PROBE_PHASE ? 2 : 1); ++_rep, (void)((k) == PROBE_PHASE && _rep == 1 ? (xcd_barrier(bar), 0) : 0))
#define STAMP(i) do { if (PROBE_PHASE >= 600 && bid == 0 && tid == 0) ((unsigned long long*)(ws + 512 * 1024))[i] = __builtin_amdgcn_s_memrealtime(); } while (0)
#define SEAM(k) do { if (IN(k) && IN((k) + 1)) xcd_barrier(bar); STAMP((k) + 1); } while (0)
    STAMP(0);
    if (IN(PH_PROLOGUE)) REP(PH_PROLOGUE) p0_prologue(a, lds, bid, nblk);
    SEAM(PH_PROLOGUE);
    int vbid = bid;
    if (IN(PH_PROLOGUE) && IN(PH_QKV)) {
        if (tid == 0) { bool ok = (nblk % 8) == 0 && bar.x < 8;
            for (int j = 0; j < 8; ++j) ok = ok && xb_ld((unsigned*)(ws + 32 * 1024) + 64 * j) == (unsigned)(nblk / 8);
            misc[5] = ok ? misc[4] * 8u + bar.x : (unsigned)bid; }
        __syncthreads();
        vbid = __builtin_amdgcn_readfirstlane((int)misc[5]);
    }
#define bid vbid
    if (IN(PH_QKV)) REP(PH_QKV) {
        const float* rstd = (const float*)(ws + W2_RSTD); const float* bias = a.in[6]; const float2* cs = (const float2*)(ws + WS_ROPE); bf16_t* qkv = (bf16_t*)(ws + B_QKV); bf16_t* vt0 = (bf16_t*)(ws + B_VT0);
        const bf16_t* hbA = (const bf16_t*)(ws + W2_HB); const bf16_t* Wt = (const bf16_t*)(ws + W2_WQKV);
        const bool grp = (nblk % 8) == 0; const int x = grp ? bid % 8 : 0, j = grp ? bid / 8 : bid, nslot = grp ? nblk / 8 : nblk, pmg = grp ? 8 : 64;
        const bool usepg = nblk == 256;
        if (usepg) { pg8::Gemm g{hbA, Wt, MREAL, 1024, D}; pg8::StaticOrder S; S.init(MREAL, 1024, nblk, bid);
            PgEpiQ E{rstd, bias, cs, qkv};
            pg8::gemm_phase<PgEpiQ, pg8::StaticOrder, true, true>(lds, g, S, E); }
        for (int u = usepg ? pmg * 4 + j : j; u < pmg * 6; u += nslot) {
            if (u < pmg * 4) { const int pm = x * pmg + (u >> 2), pn = u & 3; RowDense ra{hbA, D, pm * 256, MTOT - 1}; EpiQKV e{rstd, bias, cs, qkv, pm * 256, pn * 256, true};
                gemm_tile<8, 4, 2, 4, false>(lds, ra, Wt + (size_t)pn * 256 * D, D, D / 32, e);
            } else if (u < pmg * 5) { const int pm = x * pmg + (u - pmg * 4); RowDense ra{hbA, D, pm * 256, MTOT - 1}; EpiQKV e{rstd, bias, cs, qkv, pm * 256, 1024, false};
                gemm_tile<4, 4, 4, 2, false>(lds, ra, Wt + (size_t)1024 * D, D, D / 32, e);
            } else { const int pm = x * pmg + (u - pmg * 5); RowDense ra{hbA, D, pm * 256, MTOT - 1}; EpiV0 e{rstd, bias, vt0, pm * 256, 1152};
                gemm_tile<4, 4, 4, 2, true>(lds, ra, Wt + (size_t)1152 * D, D, D / 32, e);
            }
        }
        const int mu = bid - (nblk - 6);
        if (mu >= 0 && mu < 4) { RowDense ra{hbA, D, MREAL, MTOT - 1}; EpiQKV e{rstd, bias, cs, qkv, MREAL, mu * 256, true};
            gemm_tile<1, 4, 2, 4, false>(lds, ra, Wt + (size_t)mu * 256 * D, D, D / 32, e);
        } else if (mu == 4) { RowDense ra{hbA, D, MREAL, MTOT - 1}; EpiQKV e{rstd, bias, cs, qkv, MREAL, 1024, false};
            gemm_tile<1, 4, 4, 2, false>(lds, ra, Wt + (size_t)1024 * D, D, D / 32, e);
        } else if (mu == 5) { RowDense ra{hbA, D, MREAL, MTOT - 1}; EpiV0 e{rstd, bias, vt0, MREAL, 1152};
            gemm_tile<1, 4, 4, 2, true>(lds, ra, Wt + (size_t)1152 * D, D, D / 32, e);
        }
    }
    SEAM(PH_QKV);
    if (IN(PH_SWA)) REP(PH_SWA) swa_phase(lds, (const bf16_t*)(ws + B_QKV), (const bf16_t*)(ws + B_VT0), a.in[7], (bf16_t*)(ws + B_O0), bid, nblk);
    SEAM(PH_SWA);
    if (IN(PH_OPROJ0)) REP(PH_OPROJ0) {
        const float* bias = a.in[9]; bf16_t* hb = (bf16_t*)(ws + W2_HB);
        if (nblk == 256) { pg8::Gemm g{(const bf16_t*)(ws + B_O0), (const bf16_t*)(ws + W2_WO0), MREAL, D, D}; pg8::StaticOrder S; S.init(MREAL, D, nblk, bid); PgEpiRes E{bias, hb};
            pg8::gemm_phase<PgEpiRes, pg8::StaticOrder, true, true>(lds, g, S, E);
            for (int pn = 0; pn < 4; ++pn) if (bid == pn * 37) { RowDense ra{(const bf16_t*)(ws + B_O0), D, MREAL, MTOT - 1}; EpiRes e{bias, hb, MREAL, pn * 256};
                gemm_tile<1, 4, 2, 4, false>(lds, ra, (const bf16_t*)(ws + W2_WO0) + (size_t)pn * 256 * D, D, D / 32, e); }
        } else
        gemm_phase<false, false>(lds, (const bf16_t*)(ws + B_O0), D, (const bf16_t*)(ws + W2_WO0), D, 0, 4, bid, nblk, [=](int m0, int n0) { return EpiRes{bias, hb, m0, n0}; });
    }
    SEAM(PH_OPROJ0);
    if (IN(PH_ROUTE0))
        route_phase(lds, (const bf16_t*)(ws + W2_HB), (const float*)(ws + W2_WRF), a.in[17], a.in[19], (float*)(ws + W2_RSTD), (int*)(ws + WS_CTL),
                    (int*)(ws + W2_LIST), (float*)(ws + W2_WSLOT), bid, nblk);
    SEAM(PH_ROUTE0);
    if (IN(PH_MOE0)) REP(PH_MOE0) moe_phase(lds, (int*)(ws + WS_CTL), (const int*)(ws + W2_LIST), (const bf16_t*)(ws + W2_HB), (const float*)(ws + W2_RSTD), (const float*)(ws + W2_WSLOT),
                               (const bf16_t*)(ws + C_W0), (const bf16_t*)(ws + C_W0 + MOE_WGU_BYTES), (bf16_t*)(ws + B_Y0), bid, nblk, (unsigned long long*)(ws + 512 * 1024));
    SEAM(PH_MOE0);
    if (IN(PH_COMBINE)) l1proj_phase(lds, (bf16_t*)(ws + W2_HB), (const bf16_t*)(ws + B_Y0), (const bf16_t*)(ws + W2_WIN), (const bf16_t*)(ws + W2_WUQ), (const bf16_t*)(ws + W2_WUKV),
                                     (const float2*)(ws + WS_ROPE), (bf16_t*)(ws + WS_KPE), (bf16_t*)(ws + C_Q1), (bf16_t*)(ws + C_K1), (bf16_t*)(ws + C_V1), bid, nblk);
    STAMP(PH_WIN); STAMP(PH_CEPI); STAMP(PH_UQKV);
    SEAM(PH_UQKV);
    if (IN(PH_MLA)) REP(100) {
        moe_weight_items(a.in[20] + (size_t)NE * D * DE, a.in[21] + (size_t)NE * D * DE, a.in[22] + (size_t)NE * DE * D, a.in[3] + D, (bf16_t*)(ws + B_W1), (bf16_t*)(ws + B_W1 + MOE_WGU_BYTES),
                         (LAS float*)lds, bid, nblk);
    }
    if (IN(PH_MLA)) REP(PH_MLA) mla_phase(lds, (const bf16_t*)(ws + C_Q1), (const bf16_t*)(ws + C_K1), (const bf16_t*)(ws + WS_KPE), (const bf16_t*)(ws + C_V1), (bf16_t*)(ws + B_O1), bid, nblk);
    SEAM(PH_MLA);
    if (IN(PH_OPROJ1)) REP(PH_OPROJ1) {
        bf16_t* hb = (bf16_t*)(ws + W2_HB);
        if (nblk == 256) { pg8::Gemm g{(const bf16_t*)(ws + B_O1), (const bf16_t*)(ws + W2_WO1), MREAL, D, D}; pg8::StaticOrder S; S.init(MREAL, D, nblk, bid); PgEpiRes E{nullptr, hb};
            pg8::gemm_phase<PgEpiRes, pg8::StaticOrder, true, true>(lds, g, S, E);
            for (int pn = 0; pn < 4; ++pn) if (bid == pn * 37) { RowDense ra{(const bf16_t*)(ws + B_O1), D, MREAL, MTOT - 1}; EpiRes e{nullptr, hb, MREAL, pn * 256};
                gemm_tile<1, 4, 2, 4, false>(lds, ra, (const bf16_t*)(ws + W2_WO1) + (size_t)pn * 256 * D, D, D / 32, e); }
        } else
        gemm_phase<false, false>(lds, (const bf16_t*)(ws + B_O1), D, (const bf16_t*)(ws + W2_WO1), D, 0, 4, bid, nblk, [=](int m0, int n0) { return EpiRes{nullptr, hb, m0, n0}; });
    }
    SEAM(PH_OPROJ1);
    if (IN(PH_ROUTE1))
        route_phase(lds, (const bf16_t*)(ws + W2_HB), (const float*)(ws + W2_WRF) + 36 * 1024, a.in[17] + 4, a.in[19] + 32, (float*)(ws + W2_RSTD), (int*)(ws + WS_CTL) + 2048,
                    (int*)(ws + W2_LIST), (float*)(ws + W2_WSLOT), bid, nblk);
    SEAM(PH_ROUTE1);
    if (IN(PH_MOE1)) REP(PH_MOE1) moe_phase(lds, (int*)(ws + WS_CTL) + 2048, (const int*)(ws + W2_LIST), (const bf16_t*)(ws + W2_HB), (const float*)(ws + W2_RSTD), (const float*)(ws + W2_WSLOT),
                               (const bf16_t*)(ws + B_W1), (const bf16_t*)(ws + B_W1 + MOE_WGU_BYTES), (bf16_t*)(ws + C_Y1), bid, nblk);
    SEAM(PH_MOE1);
    if (IN(PH_FINAL)) REP(PH_FINAL) final_phase((const bf16_t*)(ws + W2_HB), (const bf16_t*)(ws + C_Y1), a.in[4], a.out, bid, nblk);
#undef bid
#undef IN
#undef SEAM
}

static void run_mega(hipStream_t s, const MArgs& base, int lo, int hi, int grid) {
    MArgs a = base; a.ph_lo = lo; a.ph_hi = hi; a.li = lo;
    hipLaunchKernelGGL(mega, dim3(grid), dim3(NTHR), LDS_BYTES, s, a);
}
extern "C" void kernel_launch(void* const* d_in, const int* in_sizes, int n_in, void* d_out, int out_size, void* d_ws, size_t ws_size, hipStream_t stream) {
    static int grid = 0;
    if (grid == 0) {
        if (n_in != 23 || ws_size < WS_END) { fprintf(stderr, "kernel_launch: unexpected n_in %d or ws_size %zu\n", n_in, ws_size); grid = -1; return; }
        if (hipFuncSetAttribute((const void*)mega, hipFuncAttributeMaxDynamicSharedMemorySize, LDS_BYTES) != hipSuccess) { fprintf(stderr, "hipFuncSetAttribute failed\n"); grid = -1; return; }
        int dev = 0, cus = 0, per_cu = 0;
        (void)hipGetDevice(&dev); (void)hipDeviceGetAttribute(&cus, hipDeviceAttributeMultiprocessorCount, dev);
        (void)hipOccupancyMaxActiveBlocksPerMultiprocessor(&per_cu, (const void*)mega, NTHR, LDS_BYTES);
        (void)hipGetLastError();
        if (per_cu < 1 || cus < 8) { fprintf(stderr, "kernel_launch: occupancy query reports %d workgroups/CU on %d CUs for %d threads + %d B LDS; nothing launched\n", per_cu, cus, NTHR, LDS_BYTES); grid = -1; return; }
        grid = cus;
    }
    if (grid < 0) return;
    (void)in_sizes; (void)out_size;
    unsigned char* ws = (unsigned char*)d_ws;
    MArgs base{}; for (int i = 0; i < 23; ++i) base.in[i] = (const float*)d_in[i]; base.out = (float*)d_out; base.ws = ws;
    (void)hipMemsetAsync(ws + WS_CTL, 0, 1 * MiB, stream);
    run_mega(stream, base, 0, PH_N, grid);
}
```

```cpp
#include <hip/hip_runtime.h>
#ifndef PROBE_PHASE
#define PROBE_PHASE -1
#endif
#include <cstdio>
#include <cstdint>

typedef unsigned short bf16_t;

constexpr int D = 1024, SEQ = 8192, NB = 2, NMETA = 16;
constexpr int MREAL = NB * SEQ;
constexpr int MTOT = MREAL + NB * NMETA;
constexpr int LPOS = NMETA + SEQ;
constexpr int NQKV = 1280;
constexpr int NE = 32, DE = 256;
constexpr int CAP = MTOT * 2;
constexpr float EPS = 1e-6f;

__device__ __forceinline__ float bf2f(bf16_t v) { return __uint_as_float(((unsigned)v) << 16); }
__device__ __forceinline__ bf16_t f2bf(float f) { unsigned u = __float_as_uint(f); u += 0x7fffu + ((u >> 16) & 1u); return (bf16_t)(u >> 16); }
__device__ __forceinline__ int row_pos(int row) { return row < MREAL ? NMETA + (row & (SEQ - 1)) : ((row - MREAL) & (NMETA - 1)); }
__device__ __forceinline__ int row_batch(int row) { return row < MREAL ? (row >> 13) : ((row - MREAL) >> 4); }
constexpr int LP = 8256;
__device__ __forceinline__ int perm16(int p) { const int qd = (p >> 2) & 3; return (p & ~12) | ((((qd & 1) << 1) | (qd >> 1)) << 2); }
__device__ __forceinline__ float wave_sum(float v) {
#pragma unroll
    for (int o = 1; o < 64; o <<= 1) v += __shfl_xor(v, o);
    return v;
}

constexpr size_t MiB = 1u << 20;
constexpr size_t WS_CTL = 0;
constexpr size_t WS_ROPE = 1 * MiB;
constexpr size_t WS_END = 256 * MiB;

#define LAS __attribute__((address_space(3)))
#define GAS __attribute__((address_space(1)))
typedef short bf16x8 __attribute__((ext_vector_type(8)));
typedef float f32x4 __attribute__((ext_vector_type(4)));
typedef unsigned u32x4 __attribute__((ext_vector_type(4)));
typedef unsigned u32x2 __attribute__((ext_vector_type(2)));
constexpr int NTHR = 512, NWAVE = 8;
constexpr int LDS_MISC = 162816;
constexpr int LDS_BYTES = LDS_MISC + 1024;

constexpr size_t WS_BAR = 64 * 1024;
constexpr size_t WS_KPE = 3 * MiB + 256 * 1024;
constexpr size_t W2_RSTD = 4 * MiB + 512 * 1024, W2_WSLOT = W2_RSTD + 80 * 1024, W2_EID = W2_WSLOT + 144 * 1024;
constexpr size_t W2_LIST = 5 * MiB;
constexpr size_t W2_WRF = 9 * MiB + 256 * 1024;
constexpr size_t W2_WQKV = 10 * MiB;
constexpr size_t W2_WO0 = W2_WQKV + 2560 * 1024;
constexpr size_t W2_WIN = W2_WO0 + 2048 * 1024;
constexpr size_t W2_WUQ = W2_WIN + 1024 * 1024;
constexpr size_t W2_WUKV = W2_WUQ + 768 * 1024;
constexpr size_t W2_WO1 = W2_WUKV + 512 * 1024;
constexpr size_t W2_HB = 20 * MiB;
constexpr size_t W2_RB = 53 * MiB;
constexpr size_t W2_RC = 134 * MiB;
static_assert(W2_EID + (size_t)MTOT * 8 <= W2_LIST && W2_LIST + (size_t)NE * CAP * 4 <= W2_WRF && W2_WO1 + 2 * MiB <= W2_HB && W2_HB + (size_t)MTOT * 2048 <= W2_RB, "fixed map");
constexpr size_t B_QKV = W2_RB, B_O0 = W2_RB + 41 * MiB, B_VT0 = W2_RB + 74 * MiB  , B_Y0 = W2_RB, B_CBUF = W2_RB, B_CQN = W2_RB + 33 * MiB, B_CKVN = W2_RB + 42 * MiB, B_O1 = W2_RB, B_W1 = W2_RB + 33 * MiB;
constexpr size_t C_W0 = W2_RC, C_HF = W2_RC + 48 * MiB, C_Q1 = W2_RC, C_K1 = W2_RC + 49 * MiB, C_V1 = W2_RC + 82 * MiB, C_HF1 = W2_RC, C_Y1 = W2_RC;
static_assert(C_V1 + (size_t)2 * 16 * 64 * LP * 2 <= WS_END && C_K1 + (size_t)2 * LP * 2048 <= C_V1 && B_VT0 + (size_t)2 * 2 * 64 * LP * 2 <= W2_RC && C_HF + (size_t)MTOT * 4096 <= WS_END && B_W1 + 48 * MiB <= W2_RC, "region map");
constexpr size_t MOE_WGU_BYTES = (size_t)NE * 512 * 1024 * 2, MOE_WD_BYTES = (size_t)NE * 1024 * 256 * 2;

struct MArgs { const float* in[23]; float* out; unsigned char* ws; int ph_lo, ph_hi, li, pad; };

__device__ __forceinline__ unsigned pk2(float lo, float hi) { return (unsigned)f2bf(lo) | ((unsigned)f2bf(hi) << 16); }

#define XB_TMO      128
#define XB_XCNT(j)  (256  + 64 * (j))
#define XB_XSUB(j)  (1280 + 64 * (j))
#define XB_XGEN(j)  (2304 + 64 * (j))
#define XB_TOP      3328
#define XB_TOPGEN   3392
#define XCD_BAR_WORDS 3456
#define XB_SPIN_CAP (1u << 18)
__device__ __forceinline__ unsigned xb_ld(unsigned* p)              { return __hip_atomic_load(p, __ATOMIC_RELAXED, __HIP_MEMORY_SCOPE_AGENT); }
__device__ __forceinline__ unsigned xb_add(unsigned* p, unsigned v) { return __hip_atomic_fetch_add(p, v, __ATOMIC_RELAXED, __HIP_MEMORY_SCOPE_AGENT); }
__device__ __forceinline__ unsigned xb_xcc_id() { return (unsigned)__builtin_amdgcn_s_getreg((3 << 11) | 20) & 0xFu; }
#define XB_SPIN(cond, bar) do { unsigned _sp = 0; while (cond) { __builtin_amdgcn_s_sleep(1); \
    if ((++_sp & 255u) == 0u) { if (xb_ld(&(bar)[XB_TMO])) break; if (_sp > XB_SPIN_CAP) { atomicAdd(&(bar)[XB_TMO], 1u); break; } } } } while (0)
struct XcdBarrier { unsigned* bar; unsigned x; volatile LAS unsigned* st; };
__device__ __forceinline__ XcdBarrier xcd_barrier_post(unsigned* bar, volatile LAS unsigned* st) {
    XcdBarrier b; b.bar = bar; b.x = xb_xcc_id(); b.st = st;
    if (threadIdx.x == 0) (void)xb_add(&bar[XB_XCNT(b.x)], 1u);
    return b;
}
__device__ __forceinline__ void xcd_barrier_complete(unsigned* bar, unsigned x, unsigned& nloc, unsigned& nx) {
    const unsigned G = gridDim.x * gridDim.y * gridDim.z;
    unsigned sum, cnt, mine, sp = 0u;
    for (;;) {
        sum = 0u; cnt = 0u; mine = 0u;
#pragma unroll
        for (unsigned j = 0; j < 16; ++j) { const unsigned c = xb_ld(&bar[XB_XCNT(j)]); sum += c; cnt += (c > 0u) ? 1u : 0u; mine = (j == x) ? c : mine; }
        if (sum == G) break;
        __builtin_amdgcn_s_sleep(1);
        if ((++sp & 255u) == 0u) { if (xb_ld(&bar[XB_TMO])) break; if (sp > XB_SPIN_CAP) { atomicAdd(&bar[XB_TMO], 1u); break; } }
    }
    nloc = mine > 0u ? mine : 1u; nx = cnt > 0u ? cnt : 1u;
}
__device__ __forceinline__ void xcd_barrier(const XcdBarrier& b) {
    asm volatile("s_waitcnt vmcnt(0)" ::: "memory");
    __syncthreads();
    if (threadIdx.x == 0) {
        unsigned* bar = b.bar;
        __builtin_amdgcn_s_waitcnt(0);
        unsigned nloc = b.st[0], nx = b.st[1];
        if (nloc == 0u) { xcd_barrier_complete(bar, b.x, nloc, nx); b.st[0] = nloc; b.st[1] = nx; }
        const unsigned old = xb_add(&bar[XB_XSUB(b.x)], 1u);
        const unsigned gen = old / nloc;
        if (old + 1u == (gen + 1u) * nloc) {
            __builtin_amdgcn_fence(__ATOMIC_RELEASE, "agent");
            asm volatile("s_waitcnt vmcnt(0)" ::: "memory");
            const unsigned og = xb_add(&bar[XB_TOP], 1u);
            const unsigned tg = og / nx;
            if (og + 1u == (tg + 1u) * nx) xb_add(&bar[XB_TOPGEN], 1u);
            else XB_SPIN(xb_ld(&bar[XB_TOPGEN]) == tg, bar);
            __builtin_amdgcn_fence(__ATOMIC_ACQUIRE, "agent");
            xb_add(&bar[XB_XGEN(b.x)], 1u);
            asm volatile("s_waitcnt vmcnt(0)" ::: "memory");
        } else {
            XB_SPIN(xb_ld(&bar[XB_XGEN(b.x)]) == gen, bar);
            __builtin_amdgcn_fence(__ATOMIC_ACQUIRE, "agent");
            asm volatile("s_waitcnt vmcnt(0)" ::: "memory");
        }
    }
    __syncthreads();
}

template <int N> __device__ __forceinline__ void wait_vm() { asm volatile("s_waitcnt vmcnt(%0)" :: "n"(N) : "memory"); }
__device__ __forceinline__ int swzF(int g) { return (0x78 >> (2 * g)) & 3; }
constexpr int GT_NS = 4;
template <int MT, int NT, int WM, int WN, bool NSW, class RowA, class Epi, bool NOLD = false>
__device__ __forceinline__ void gemm_tile(LAS unsigned char* lds, const RowA& rowA, const bf16_t* __restrict__ Bt, int ldb  , int nk  , Epi& epi) {
    constexpr int BM = WM * MT * 16, BN = WN * NT * 16, GA = BM / 16, G = (BM + BN) / 16, NG = (G + 7) / 8, GR = G % 8, STAGE = (BM + BN) * 64;
    static_assert(WM * WN == 8 && GT_NS * STAGE <= LDS_MISC && BM % 16 == 0 && BN % 16 == 0, "gemm_tile config");
    const int tid = threadIdx.x, lane = tid & 63, wave = __builtin_amdgcn_readfirstlane(tid >> 6), wm = wave / WN, wn = wave % WN;
    const char* src[NG];
    const int lc = (lane & 3) ^ swzF(lane >> 4);
#pragma unroll
    for (int i = 0; i < NG; ++i) {
        const int g = wave + 8 * i;
        if (g < GA) src[i] = (const char*)rowA(g * 16 + (lane >> 2)) + lc * 16;
        else if (g < G) src[i] = (const char*)(Bt + (size_t)((g - GA) * 16 + (lane >> 2)) * ldb) + lc * 16;
        else src[i] = nullptr;
    }
    f32x4 acc[MT][NT];
#pragma unroll
    for (int mi = 0; mi < MT; ++mi)
#pragma unroll
        for (int ni = 0; ni < NT; ++ni) acc[mi][ni] = (f32x4){0.f, 0.f, 0.f, 0.f};
    const int fro = (lane & 15) * 64 + (((lane >> 4) ^ swzF((lane >> 2) & 3)) << 4);
    constexpr int LM = PROBE_PHASE == 402 ? 2 : 1;
#define GT_STAGE(st, kt) do { _Pragma("unroll") for (int _i = 0; _i < NG; ++_i) { const int _g = wave + 8 * _i; if (_g < G) { \
        __builtin_amdgcn_global_load_lds((const unsigned*)(src[_i] + (size_t)(kt) * 64), (LAS unsigned*)(lds + (st) * STAGE + _g * 1024), 16, 0, 0); \
        if (LM == 2) __builtin_amdgcn_global_load_lds((const unsigned*)(src[_i] + (size_t)(kt) * 64), (LAS unsigned*)(lds + (st) * STAGE + _g * 1024), 16, 0, 0); } } } while (0)
#define GT_WAIT(ntl) do { if (GR == 0 || wave < GR) wait_vm<LM * NG * (ntl)>(); else wait_vm<LM * (NG - 1) * (ntl)>(); } while (0)
    if (!NOLD) { GT_STAGE(0, 0);
    if (nk > 1) GT_STAGE(1, 1);
    if (nk > 2) GT_STAGE(2, 2); }
    int st = 0;
    for (int kt = 0; kt < nk; ++kt) {
        const int rem = nk - 1 - kt;
        if (!NOLD) { if (rem >= 2) GT_WAIT(2); else if (rem == 1) GT_WAIT(1); else GT_WAIT(0); }
        __builtin_amdgcn_s_barrier(); asm volatile("" ::: "memory");
        const bool doload = (!NOLD || PROBE_PHASE == 505) && kt + 3 < nk;
        LAS const unsigned char* sa = lds + st * STAGE + (wm * MT * 16) * 64 + fro;
        LAS const unsigned char* sb = lds + st * STAGE + (BM + wn * NT * 16) * 64 + fro;
        bf16x8 bfr[NT];
#pragma unroll
        for (int ni = 0; ni < NT; ++ni) bfr[ni] = *(LAS const bf16x8*)(sb + ni * 1024);
        constexpr int PG = MT >= 2 ? 2 : 1, NPG = MT / PG;
        constexpr int LPG = (NG + NPG - 1) / NPG;
        bf16x8 afc[PG], afn[PG];
#pragma unroll
        for (int i = 0; i < PG; ++i) afc[i] = *(LAS const bf16x8*)(sa + i * 1024);
#pragma unroll
        for (int pg = 0; pg < NPG; ++pg) {
            if (doload) {
#pragma unroll
                for (int l = 0; l < LPG; ++l) { const int _i = pg * LPG + l; if (_i < NG) { const int _g = wave + 8 * _i; if (_g < G)
                    __builtin_amdgcn_global_load_lds((const unsigned*)(src[_i] + (size_t)(kt + 3) * 64), (LAS unsigned*)(lds + ((st + 3) & 3) * STAGE + _g * 1024), 16, 0, 0); } }
            }
            if (pg + 1 < NPG) {
#pragma unroll
                for (int i = 0; i < PG; ++i) afn[i] = *(LAS const bf16x8*)(sa + ((pg + 1) * PG + i) * 1024);
            }
#pragma unroll
            for (int i = 0; i < PG; ++i) { const int mi = pg * PG + i;
#pragma unroll
                for (int ni = 0; ni < NT; ++ni) {
                    if (NSW) acc[mi][ni] = __builtin_amdgcn_mfma_f32_16x16x32_bf16(afc[i], bfr[ni], acc[mi][ni], 0, 0, 0);
                    else acc[mi][ni] = __builtin_amdgcn_mfma_f32_16x16x32_bf16(bfr[ni], afc[i], acc[mi][ni], 0, 0, 0);
                } }
#pragma unroll
            for (int i = 0; i < PG; ++i) afc[i] = afn[i];
            __builtin_amdgcn_sched_barrier(0);
        }
        st = (st + 1) & 3;
    }
#undef GT_STAGE
#undef GT_WAIT
    epi(acc, wm * MT * 16, wn * NT * 16, lane);
    asm volatile("s_waitcnt lgkmcnt(0)" ::: "memory");
    __syncthreads();
}

struct RowDense { const bf16_t* A; int lda, m0, mlast; __device__ __forceinline__ const bf16_t* operator()(int r) const { int row = m0 + r; row = row > mlast ? mlast : row; return A + (size_t)row * lda; } };

namespace pg8 {
#define PG8_LAS __attribute__((address_space(3)))
typedef unsigned short bf16_t;
typedef short bf16x8 __attribute__((ext_vector_type(8)));
typedef float f32x4 __attribute__((ext_vector_type(4)));
typedef unsigned u32x4 __attribute__((ext_vector_type(4)));
constexpr int BM = 256, BK = 64, HALF = 128, HTB = HALF * BK * 2  , STAGE_BYTES = 8 * HTB, NXCD = 8, WGM = 8;

__host__ __device__ __forceinline__ int lds_byte(int r, int c) { const int st = (r >> 4) * 2 + (c >> 5), rr = r & 15, cc = c & 31, ob = rr * 64 + cc * 2; return st * 1024 + (ob ^ (((ob >> 9) & 1) << 5)); }
__host__ __device__ __forceinline__ void stage_rc(int b, int& R, int& C) { const int st = b / 1024, sb = b % 1024, swz = sb ^ (((sb >> 9) & 1) << 5); R = (st >> 1) * 16 + swz / 64; C = (st & 1) * 32 + (swz % 64) / 2; }
__host__ __device__ __forceinline__ int perm32(int rho) { const int n = rho >> 4, i = rho & 15; return 8 * (i >> 2) + 4 * n + (i & 3); }

struct Unit { int pm, pn; };
struct Gemm { const bf16_t* A; const bf16_t* Bt; int M, N, K; };

struct StaticOrder {
    int nM, nN, nwg, G, c;
    __host__ __device__ void init(int M, int N, int G_, int c_) { nM = M / BM; nN = N / BM; nwg = nM * nN; G = G_; c = c_; }
    __host__ __device__ bool next(int i, Unit& u) const {
        const long L = (long)i * G + c; if (L >= nwg) return false;
        int wgid = (int)L; { const int q = nwg / NXCD, r = nwg % NXCD, xcd = wgid % NXCD, off = wgid / NXCD; wgid = (xcd < r ? xcd * (q + 1) : r * (q + 1) + (xcd - r) * q) + off; }
        const int nig = WGM * nN, gid = wgid / nig, fm = gid * WGM, gsz = (nM - fm) < WGM ? (nM - fm) : WGM;
        u.pm = fm + ((wgid % nig) % gsz); u.pn = (wgid % nig) / gsz; return true;
    }
    __device__ __forceinline__ void a_ready(const Unit&) const {}
    __device__ __forceinline__ void done(const Unit&) const {}
};


template <class Epi, class Sched, bool ALIGN_EPI = false, bool SP2 = false>
__device__ __forceinline__ void gemm_phase(PG8_LAS unsigned char* lds, const Gemm g, const Sched& S, const Epi& E) {
    const int tid = threadIdx.x, wid = __builtin_amdgcn_readfirstlane(tid >> 6), lane = tid & 63, wr = wid >> 2, wc = wid & 3, fr = lane & 15, fq = lane >> 4;
    const int K = g.K, nt = K / BK;
    unsigned voffA[2], voffB[2];
#pragma unroll
    for (int i = 0; i < 2; ++i) { int R, C; stage_rc(tid * 16 + i * 8192, R, C); const int Rb = Epi::PERM ? ((R & ~31) + perm32(R & 31)) : R;
        voffA[i] = (unsigned)(R * K + C) * 2u; voffB[i] = (unsigned)(Rb * K + C) * 2u; }
    const size_t kstep = (size_t)(BK * 2);
    const size_t hstep = (size_t)HALF * K * 2;
    const size_t tstep = 2 * hstep;
    const unsigned ldsw = (unsigned)wid * 1024u;
    const int aoff = lds_byte(wr * 64 + fr, fq * 8), boff = lds_byte(wc * 32 + fr, fq * 8);
#define PG8_SA(b, h) (((b) * 2 + (h)) * HTB)
#define PG8_SB(b, h) ((4 + (b) * 2 + (h)) * HTB)
#define PG8_STAGE(bufoff, gbase, voff) do { _Pragma("unroll") for (int _i = 0; _i < 2; ++_i) \
        __builtin_amdgcn_global_load_lds((const unsigned*)((const char*)(gbase) + (voff)[_i]), (PG8_LAS unsigned*)(lds + (bufoff) + ldsw + _i * 8192), 16, 0, 0); } while (0)
#define PG8_LDA(dst, b, h) do { _Pragma("unroll") for (int m = 0; m < 4; ++m) _Pragma("unroll") for (int k = 0; k < 2; ++k) dst[m][k] = *(const PG8_LAS bf16x8*)(lds + PG8_SA(b, h) + aoff + m * 2048 + k * 1024); } while (0)
#define PG8_LDB(dst, b, h) do { _Pragma("unroll") for (int n = 0; n < 2; ++n) _Pragma("unroll") for (int k = 0; k < 2; ++k) dst[n][k] = *(const PG8_LAS bf16x8*)(lds + PG8_SB(b, h) + boff + n * 2048 + k * 1024); } while (0)
#define PG8_MMA(ai, bj, At, Bt) do { __builtin_amdgcn_s_setprio(1); _Pragma("unroll") for (int m = 0; m < 4; ++m) _Pragma("unroll") for (int n = 0; n < 2; ++n) _Pragma("unroll") for (int k = 0; k < 2; ++k) \
        acc[ai][bj][m][n] = __builtin_amdgcn_mfma_f32_16x16x32_bf16(Bt[n][k], At[m][k], acc[ai][bj][m][n], 0, 0, 0); __builtin_amdgcn_s_setprio(0); } while (0)
#define PG8_WAIT_V(n) asm volatile("s_waitcnt vmcnt(" #n ")" ::: "memory")
#define PG8_WAIT_L(n) asm volatile("s_waitcnt lgkmcnt(" #n ")" ::: "memory")
#define PG8_BAR __builtin_amdgcn_s_barrier()
#define PG8_SCHED __builtin_amdgcn_sched_barrier(0)
    Unit cur, nxt; int ui = 0;
    if (!S.next(0, cur)) return;
    f32x4 acc[2][2][4][2];
#pragma unroll
    for (int a = 0; a < 2; ++a)
#pragma unroll
        for (int b = 0; b < 2; ++b)
#pragma unroll
            for (int m = 0; m < 4; ++m)
#pragma unroll
                for (int n = 0; n < 2; ++n) acc[a][b][m][n] = (f32x4){0.f, 0.f, 0.f, 0.f};
    bf16x8 At[4][2], B0[2][2], B1[2][2];
    const char* cA = (const char*)g.A + (size_t)cur.pm * tstep; const char* cB = (const char*)g.Bt + (size_t)cur.pn * tstep;
    S.a_ready(cur);
    if constexpr (SP2) {
        PG8_STAGE(PG8_SB(0, 0), cB, voffB); PG8_STAGE(PG8_SB(0, 1), cB + hstep, voffB); PG8_STAGE(PG8_SA(0, 0), cA, voffA); PG8_STAGE(PG8_SA(0, 1), cA + hstep, voffA);
        if (wr == 1) PG8_BAR;
        PG8_WAIT_V(2); PG8_BAR;
        PG8_STAGE(PG8_SB(1, 0), cB + kstep, voffB); PG8_STAGE(PG8_SA(1, 0), cA + kstep, voffA); PG8_STAGE(PG8_SB(1, 1), cB + hstep + kstep, voffB);
        PG8_WAIT_V(6); PG8_BAR;
    } else {
        PG8_STAGE(PG8_SB(0, 0), cB, voffB); PG8_STAGE(PG8_SA(0, 0), cA, voffA); PG8_STAGE(PG8_SB(0, 1), cB + hstep, voffB); PG8_STAGE(PG8_SA(0, 1), cA + hstep, voffA);
        if (wr == 1) PG8_BAR;
        PG8_WAIT_V(4); PG8_BAR;
        PG8_STAGE(PG8_SB(1, 0), cB + kstep, voffB); PG8_STAGE(PG8_SA(1, 0), cA + kstep, voffA); PG8_STAGE(PG8_SB(1, 1), cB + hstep + kstep, voffB);
        PG8_WAIT_V(6); PG8_BAR;
    }
    for (;;) {
        const bool has_next = S.next(ui + 1, nxt);
        const char* nA = has_next ? (const char*)g.A + (size_t)nxt.pm * tstep : cA; const char* nB = has_next ? (const char*)g.Bt + (size_t)nxt.pn * tstep : cB;
        for (int t = 0; t < nt; t += 2) {
            const bool last = (t == nt - 2);
            const char* a1 = cA + (size_t)(t + 1) * kstep;
            const char* a2 = last ? nA : cA + (size_t)(t + 2) * kstep; const char* b2 = last ? nB : cB + (size_t)(t + 2) * kstep;
            const char* a3 = a2 + kstep; const char* b3 = b2 + kstep;
            if (last && has_next) S.a_ready(nxt);
            if constexpr (SP2) {
            PG8_LDB(B0, 0, 0); PG8_LDB(B1, 0, 1); PG8_SCHED; PG8_LDA(At, 0, 0); PG8_STAGE(PG8_SA(1, 1), a1 + hstep, voffA);
            PG8_WAIT_V(8); PG8_WAIT_L(0); PG8_BAR; PG8_MMA(0, 0, At, B0); PG8_MMA(0, 1, At, B1); PG8_BAR; PG8_SCHED;
            PG8_LDA(At, 0, 1); PG8_STAGE(PG8_SB(0, 0), b2, voffB); PG8_STAGE(PG8_SB(0, 1), b2 + hstep, voffB); PG8_STAGE(PG8_SA(0, 0), a2, voffA);
            PG8_WAIT_V(8); PG8_WAIT_L(0); PG8_BAR; PG8_MMA(1, 0, At, B0); PG8_MMA(1, 1, At, B1); PG8_BAR; PG8_SCHED;
            PG8_LDB(B0, 1, 0); PG8_LDB(B1, 1, 1); PG8_SCHED; PG8_LDA(At, 1, 0); PG8_STAGE(PG8_SA(0, 1), a2 + hstep, voffA);
            PG8_WAIT_V(8); PG8_WAIT_L(0); PG8_BAR; PG8_MMA(0, 0, At, B0); PG8_MMA(0, 1, At, B1); PG8_BAR; PG8_SCHED;
            PG8_LDA(At, 1, 1); PG8_STAGE(PG8_SB(1, 0), b3, voffB); PG8_STAGE(PG8_SB(1, 1), b3 + hstep, voffB); PG8_STAGE(PG8_SA(1, 0), a3, voffA);
            PG8_WAIT_V(8); PG8_WAIT_L(0); PG8_BAR; PG8_MMA(1, 0, At, B0); PG8_MMA(1, 1, At, B1); PG8_BAR; PG8_SCHED;
            } else {
            PG8_LDB(B0, 0, 0); PG8_SCHED; PG8_LDA(At, 0, 0); PG8_STAGE(PG8_SA(1, 1), a1 + hstep, voffA);
            PG8_WAIT_L(8); PG8_BAR; PG8_WAIT_L(0); PG8_MMA(0, 0, At, B0); PG8_BAR; PG8_SCHED;
            PG8_LDB(B1, 0, 1); PG8_STAGE(PG8_SB(0, 0), b2, voffB);
            PG8_BAR; PG8_WAIT_L(0); PG8_MMA(0, 1, At, B1); PG8_BAR;
            PG8_LDA(At, 0, 1); PG8_STAGE(PG8_SA(0, 0), a2, voffA);
            PG8_BAR; PG8_WAIT_L(0); PG8_MMA(1, 0, At, B0); PG8_BAR; PG8_SCHED;
            PG8_STAGE(PG8_SB(0, 1), b2 + hstep, voffB);
            PG8_WAIT_V(6); PG8_BAR; PG8_MMA(1, 1, At, B1); PG8_BAR;
            PG8_LDB(B0, 1, 0); PG8_SCHED; PG8_LDA(At, 1, 0); PG8_STAGE(PG8_SA(0, 1), a2 + hstep, voffA);
            PG8_WAIT_L(8); PG8_BAR; PG8_WAIT_L(0); PG8_MMA(0, 0, At, B0); PG8_BAR; PG8_SCHED;
            PG8_LDB(B1, 1, 1); PG8_STAGE(PG8_SB(1, 0), b3, voffB);
            PG8_BAR; PG8_WAIT_L(0); PG8_MMA(0, 1, At, B1); PG8_BAR;
            PG8_LDA(At, 1, 1); PG8_STAGE(PG8_SA(1, 0), a3, voffA);
            PG8_BAR; PG8_WAIT_L(0); PG8_MMA(1, 0, At, B0); PG8_BAR; PG8_SCHED;
            PG8_STAGE(PG8_SB(1, 1), b3 + hstep, voffB);
            PG8_WAIT_V(6); PG8_BAR; PG8_MMA(1, 1, At, B1); PG8_BAR;
            }
        }
        if constexpr (ALIGN_EPI) { if (wr == 0) PG8_BAR; }
        if constexpr (!Epi::AFTER_DRAIN) { E(acc, cur, wr, wc, fr, fq); S.done(cur); }
        if (!has_next) break;
#pragma unroll
        for (int a = 0; a < 2; ++a)
#pragma unroll
            for (int b = 0; b < 2; ++b)
#pragma unroll
                for (int m = 0; m < 4; ++m)
#pragma unroll
                    for (int n = 0; n < 2; ++n) acc[a][b][m][n] = (f32x4){0.f, 0.f, 0.f, 0.f};
        cur = nxt; cA = nA; cB = nB; ++ui;
        if constexpr (ALIGN_EPI) { if (wr == 1) PG8_BAR; }
    }
    PG8_WAIT_V(0);
    if constexpr (!ALIGN_EPI) { if (wr == 0) PG8_BAR; }
    PG8_BAR;
    if constexpr (Epi::AFTER_DRAIN) { E.fused(acc, cur, wr, wc, fr, fq, lds, wid, lane); S.done(cur); }
#undef PG8_SA
#undef PG8_SB
#undef PG8_STAGE
#undef PG8_LDA
#undef PG8_LDB
#undef PG8_MMA
#undef PG8_WAIT_V
#undef PG8_WAIT_L
#undef PG8_BAR
#undef PG8_SCHED
}
}

struct PgEpiRes {
    static constexpr bool PERM = false, AFTER_DRAIN = false;
    const float* bias; unsigned short* hb;
    __device__ __forceinline__ void operator()(const pg8::f32x4 (&acc)[2][2][4][2], const pg8::Unit& u, int wr, int wc, int fr, int fq) const {
#pragma unroll
        for (int ai = 0; ai < 2; ++ai)
#pragma unroll
            for (int m = 0; m < 4; ++m) { const int row = u.pm * 256 + ai * 128 + wr * 64 + m * 16 + fr;
#pragma unroll
                for (int bj = 0; bj < 2; ++bj)
#pragma unroll
                    for (int n = 0; n < 2; ++n) { const int col = u.pn * 256 + bj * 128 + wc * 32 + n * 16 + fq * 4;
                        u32x2* p = (u32x2*)(hb + (size_t)row * D + col); const u32x2 h = *p; pg8::f32x4 v = acc[ai][bj][m][n];
                        if (bias) v += *(const pg8::f32x4*)(bias + col);
                        v[0] += __uint_as_float(h.x << 16); v[1] += __uint_as_float(h.x & 0xffff0000u); v[2] += __uint_as_float(h.y << 16); v[3] += __uint_as_float(h.y & 0xffff0000u);
                        *p = (u32x2){pk2(v[0], v[1]), pk2(v[2], v[3])}; } }
    }
};
struct PgEpiQ {
    static constexpr bool PERM = false, AFTER_DRAIN = false;
    const float* rstd; const float* bias; const float2* cs; unsigned short* qkv;
    __device__ __forceinline__ void operator()(const pg8::f32x4 (&acc)[2][2][4][2], const pg8::Unit& u, int wr, int wc, int fr, int fq) const {
#pragma unroll
        for (int ai = 0; ai < 2; ++ai)
#pragma unroll
            for (int m = 0; m < 4; ++m) { const int row = u.pm * 256 + ai * 128 + wr * 64 + m * 16 + fr; const float rs = rstd[row]; const int pos = row_pos(row);
#pragma unroll
                for (int bj = 0; bj < 2; ++bj) { const int g = 8 * u.pn + 4 * bj + wc, hh = g >> 1, d = 16 * (g & 1) + 4 * fq;
                    const pg8::f32x4 b1 = *(const pg8::f32x4*)(bias + 64 * hh + d), b2 = *(const pg8::f32x4*)(bias + 64 * hh + 32 + d);
                    float o1[4], o2[4];
#pragma unroll
                    for (int r = 0; r < 4; ++r) { const float2 t = cs[pos * 32 + d + r]; const float x1 = acc[ai][bj][m][0][r] * rs + b1[r], x2 = acc[ai][bj][m][1][r] * rs + b2[r];
                        o1[r] = (x1 * t.x - x2 * t.y) * 0.125f; o2[r] = (x2 * t.x + x1 * t.y) * 0.125f; }
                    unsigned short* orow = qkv + (size_t)row * NQKV + 64 * hh + d;
                    *(u32x2*)orow = (u32x2){pk2(o1[0], o1[1]), pk2(o1[2], o1[3])}; *(u32x2*)(orow + 32) = (u32x2){pk2(o2[0], o2[1]), pk2(o2[2], o2[3])}; } }
    }
};

struct EpiQKV {
    const float* rstd; const float* bias; const float2* cs; bf16_t* qkv; int m0, n0; bool perm;
    template <int MT, int NT> __device__ __forceinline__ void operator()(f32x4 (&acc)[MT][NT], int mb, int nb, int lane) const {
        static_assert(NT == 4, "rope needs a 64-column wave span");
        const int cb = n0 + nb, d0 = (lane >> 4) * 4;
#pragma unroll
        for (int mi = 0; mi < MT; ++mi) {
            const int row = m0 + mb + mi * 16 + (lane & 15);
            if (row < MTOT) {
                const float rs = rstd[row]; const int pos = row_pos(row);
                bf16_t* orow = qkv + (size_t)row * NQKV + cb;
                {
                    const float sc = cb < 1024 ? 0.125f : 1.0f;
#pragma unroll
                    for (int ni = 0; ni < 2; ++ni) {
                        const int d = ni * 16 + d0;
                        const f32x4 b1 = *(const f32x4*)(bias + cb + d), b2 = *(const f32x4*)(bias + cb + 32 + d);
                        const f32x4 a1 = perm ? acc[mi][2 * ni] : acc[mi][ni], a2 = perm ? acc[mi][2 * ni + 1] : acc[mi][ni + 2];
                        float o1[4], o2[4];
#pragma unroll
                        for (int r = 0; r < 4; ++r) {
                            const float2 t = cs[pos * 32 + d + r];
                            const float x1 = a1[r] * rs + b1[r], x2 = a2[r] * rs + b2[r];
                            o1[r] = (x1 * t.x - x2 * t.y) * sc; o2[r] = (x2 * t.x + x1 * t.y) * sc;
                        }
                        *(u32x2*)(orow + d) = (u32x2){pk2(o1[0], o1[1]), pk2(o1[2], o1[3])};
                        *(u32x2*)(orow + 32 + d) = (u32x2){pk2(o2[0], o2[1]), pk2(o2[2], o2[3])};
                    }
                }
            }
        }
    }
};
struct EpiV0 {
    const float* rstd; const float* bias; bf16_t* vt0; int m0, n0;
    template <int MT, int NT> __device__ __forceinline__ void operator()(f32x4 (&acc)[MT][NT], int mb, int nb, int lane) const {
        static_assert(NT == 4, "64-column wave span");
        const int cb = n0 + nb, kh = (cb - 1152) >> 6;
#pragma unroll
        for (int mi = 0; mi < MT; ++mi) {
            const int row0 = m0 + mb + mi * 16 + (lane >> 4) * 4;
            if (row0 < MTOT) {
                const f32x4 rs = *(const f32x4*)(rstd + row0); const int b = row_batch(row0), pp = perm16(row_pos(row0));
#pragma unroll
                for (int ni = 0; ni < NT; ++ni) { const int d = ni * 16 + (lane & 15); const float bb = bias[cb + d];
                    const f32x4 v = acc[mi][ni] * rs + bb;
                    *(u32x2*)(vt0 + (size_t)((b * 2 + kh) * 64 + d) * LP + pp) = (u32x2){pk2(v[0], v[1]), pk2(v[2], v[3])}; }
            }
        }
    }
};
struct EpiRes {
    const float* bias; bf16_t* hb; int m0, n0;
    template <int MT, int NT> __device__ __forceinline__ void operator()(f32x4 (&acc)[MT][NT], int mb, int nb, int lane) const {
#pragma unroll
        for (int mi = 0; mi < MT; ++mi) {
            const int row = m0 + mb + mi * 16 + (lane & 15);
            if (row < MTOT) {
#pragma unroll
                for (int ni = 0; ni < NT; ++ni) {
                    const int col = n0 + nb + ni * 16 + (lane >> 4) * 4;
                    u32x2* p = (u32x2*)(hb + (size_t)row * D + col);
                    const u32x2 h = *p;
                    f32x4 v = acc[mi][ni];
                    if (bias) v += *(const f32x4*)(bias + col);
                    v[0] += __uint_as_float(h.x << 16); v[1] += __uint_as_float(h.x & 0xffff0000u); v[2] += __uint_as_float(h.y << 16); v[3] += __uint_as_float(h.y & 0xffff0000u);
                    *p = (u32x2){pk2(v[0], v[1]), pk2(v[2], v[3])};
                }
            }
        }
    }
};
__device__ __forceinline__ void route_phase(LAS unsigned char* lds, const bf16_t* __restrict__ hbr, const float* __restrict__ wrf, const float* __restrict__ bg, const float* __restrict__ br,
                                            float* rstd_out, int* cnt, int* list, float* wslot, int bid, int nblk) {
    const int tid = threadIdx.x, lane = tid & 63, wave = __builtin_amdgcn_readfirstlane(tid >> 6);
    LAS f32x4* wl = (LAS f32x4*)lds;
    LAS int* nrec = (LAS int*)(lds + LDS_MISC + 16); LAS int* bcnt = (LAS int*)(lds + LDS_MISC + 32); LAS int* bbase = (LAS int*)(lds + LDS_MISC + 160); LAS int* rec = (LAS int*)(lds + LDS_MISC + 288);
    for (int i = tid; i < 36 * 256; i += NTHR) wl[i] = *(const f32x4*)(wrf + (size_t)i * 4);
    if (tid < NE) bcnt[tid] = 0;
    if (tid == 0) *nrec = 0;
    __syncthreads();
    for (int row = bid * NWAVE + wave; row < MTOT; row += nblk * NWAVE) {
        f32x4 x[4]; float ss = 0.f;
#pragma unroll
        for (int j = 0; j < 4; ++j) { const u32x2 h = *(const u32x2*)(hbr + (size_t)row * D + j * 256 + lane * 4);
            x[j] = (f32x4){__uint_as_float(h.x << 16), __uint_as_float(h.x & 0xffff0000u), __uint_as_float(h.y << 16), __uint_as_float(h.y & 0xffff0000u)};
            ss += x[j][0] * x[j][0] + x[j][1] * x[j][1] + x[j][2] * x[j][2] + x[j][3] * x[j][3]; }
        ss = wave_sum(ss);
        const float rs = rsqrtf(ss * (1.0f / D) + EPS);
        float lg[4];
#pragma unroll
        for (int c = 0; c < 4; ++c) { float p = 0.f;
#pragma unroll
            for (int j = 0; j < 4; ++j) { const f32x4 w = wl[c * 256 + j * 64 + lane]; p += x[j][0] * w[0] + x[j][1] * w[1] + x[j][2] * w[2] + x[j][3] * w[3]; }
            lg[c] = wave_sum(p) * rs + bg[c]; }
        int gi = 0; float gm = lg[0];
#pragma unroll
        for (int c = 1; c < 4; ++c) if (lg[c] > gm) { gm = lg[c]; gi = c; }
        float gs = 0.f;
#pragma unroll
        for (int c = 0; c < 4; ++c) gs += __expf(lg[c] - gm);
        const float gp = 1.0f / gs;
        gi = __builtin_amdgcn_readfirstlane(gi);
        float e[8];
#pragma unroll
        for (int c = 0; c < 8; ++c) { float p = 0.f;
#pragma unroll
            for (int j = 0; j < 4; ++j) { const f32x4 w = wl[(4 + gi * 8 + c) * 256 + j * 64 + lane]; p += x[j][0] * w[0] + x[j][1] * w[1] + x[j][2] * w[2] + x[j][3] * w[3]; }
            e[c] = wave_sum(p) * rs + br[gi * 8 + c]; }
        int i1 = 0; float v1 = e[0];
#pragma unroll
        for (int c = 1; c < 8; ++c) if (e[c] > v1) { v1 = e[c]; i1 = c; }
        int i2 = -1; float v2 = -3.0e38f;
#pragma unroll
        for (int c = 0; c < 8; ++c) if (c != i1 && e[c] > v2) { v2 = e[c]; i2 = c; }
        if (lane == 0) {
            const float r = __expf(v2 - v1);
            const float w1 = gp / (1.0f + r), w2 = gp * r / (1.0f + r);
            const int e1 = gi * 8 + i1, e2 = gi * 8 + i2;
            const int p1 = atomicAdd((int*)&bcnt[e1], 1), p2 = atomicAdd((int*)&bcnt[e2], 1);
            const int k = atomicAdd((int*)nrec, 2);
            rec[k] = ((row * 2) << 13) | (e1 << 8) | p1; rec[k + 1] = ((row * 2 + 1) << 13) | (e2 << 8) | p2;
            wslot[row * 2] = w1; wslot[row * 2 + 1] = w2; rstd_out[row] = rs;
        }
    }
    __syncthreads();
    if (tid < NE) { const int c = bcnt[tid]; bbase[tid] = c ? __hip_atomic_fetch_add(cnt + tid * 64, c, __ATOMIC_RELAXED, __HIP_MEMORY_SCOPE_AGENT) : 0; }
    __syncthreads();
    for (int k = tid; k < *nrec; k += NTHR) { const int r = rec[k], e = (r >> 8) & 31; list[(size_t)e * CAP + bbase[e] + (r & 255)] = r >> 13; }
    __syncthreads();
}
__device__ __forceinline__ void final_phase(const bf16_t* __restrict__ hb, const bf16_t* __restrict__ ybuf, const float* __restrict__ g, float* out, int bid, int nblk) {
    const int tid = threadIdx.x, lane = tid & 63, wave = tid >> 6;
    for (int row = bid * NWAVE + wave; row < MREAL; row += nblk * NWAVE) {
        f32x4 v[4]; float ss = 0.f;
#pragma unroll
        for (int j = 0; j < 4; ++j) { const size_t c = j * 256 + lane * 4;
            const u32x2 h = *(const u32x2*)(hb + (size_t)row * D + c), y0 = *(const u32x2*)(ybuf + (size_t)(row * 2) * D + c), y1 = *(const u32x2*)(ybuf + (size_t)(row * 2 + 1) * D + c);
            v[j][0] = __uint_as_float(h.x << 16) + __uint_as_float(y0.x << 16) + __uint_as_float(y1.x << 16);
            v[j][1] = __uint_as_float(h.x & 0xffff0000u) + __uint_as_float(y0.x & 0xffff0000u) + __uint_as_float(y1.x & 0xffff0000u);
            v[j][2] = __uint_as_float(h.y << 16) + __uint_as_float(y0.y << 16) + __uint_as_float(y1.y << 16);
            v[j][3] = __uint_as_float(h.y & 0xffff0000u) + __uint_as_float(y0.y & 0xffff0000u) + __uint_as_float(y1.y & 0xffff0000u);
            ss += v[j][0] * v[j][0] + v[j][1] * v[j][1] + v[j][2] * v[j][2] + v[j][3] * v[j][3]; }
        const float rs = rsqrtf(wave_sum(ss) * (1.0f / D) + EPS);
#pragma unroll
        for (int j = 0; j < 4; ++j) { const f32x4 gg = *(const f32x4*)(g + j * 256 + lane * 4); *(f32x4*)(out + (size_t)row * D + j * 256 + lane * 4) = v[j] * rs * gg; }
    }
}

typedef float f32x16 __attribute__((ext_vector_type(16)));
constexpr int AT_STAGE = 20480;
__device__ __forceinline__ unsigned cvtpk(float lo, float hi) { typedef float f2 __attribute__((ext_vector_type(2))); typedef __bf16 b2 __attribute__((ext_vector_type(2)));
    f2 v = {lo, hi}; b2 r = __builtin_convertvector(v, b2); return __builtin_bit_cast(unsigned, r); }
__device__ __forceinline__ void mla_unit(LAS unsigned char* lds, int b, int h, int qi, const bf16_t* __restrict__ Q1, const bf16_t* __restrict__ K1, const bf16_t* __restrict__ kpe,
                                         const bf16_t* __restrict__ VT1, bf16_t* o) {
    const int tid = threadIdx.x, lane = tid & 63, wave = __builtin_amdgcn_readfirstlane(tid >> 6), r32 = lane & 31, hi = lane >> 5;
    const size_t qrow = (size_t)b * SEQ + 256 * qi + 32 * wave + r32;
    bf16x8 qf[6];
#pragma unroll
    for (int s = 0; s < 6; ++s) qf[s] = *(const bf16x8*)(Q1 + qrow * 1536 + h * 96 + 16 * s + 8 * hi);
    const int lr = 8 * wave + (lane >> 3);
    const char* ksrc = (const char*)(K1 + ((size_t)b * LP + lr) * 1024 + h * 64) + (((lane & 7) ^ ((lr >> 1) & 7)) << 4);
    const char* vsrc = (const char*)(VT1 + ((size_t)(b * 16 + h) * 64 + lr) * LP) + (((lane & 7) ^ ((lr >> 1) & 7)) << 4);
    const int pr = 16 * wave + (lane >> 2);
    const char* psrc = (const char*)(kpe + ((size_t)b * LP + (pr & 63)) * 32) + (((lane & 3) ^ ((pr >> 2) & 3)) << 4);
#define MLA_ISSUE(j, st) do { \
        __builtin_amdgcn_global_load_lds((const unsigned*)(ksrc + (size_t)(j) * (64 * 2048)), (LAS unsigned*)(lds + (st) * AT_STAGE + wave * 1024), 16, 0, 0); \
        __builtin_amdgcn_global_load_lds((const unsigned*)(vsrc + (size_t)(j) * 128), (LAS unsigned*)(lds + (st) * AT_STAGE + 8192 + wave * 1024), 16, 0, 0); \
        if (wave < 4) __builtin_amdgcn_global_load_lds((const unsigned*)(psrc + (size_t)(j) * (64 * 64)), (LAS unsigned*)(lds + (st) * AT_STAGE + 16384 + wave * 1024), 16, 0, 0); } while (0)
    const int NT = 4 * qi + 5, jmaxw = 4 * qi + ((32 * wave + 47) >> 6);
    const int qp = 16 + 256 * qi + 32 * wave + r32;
    const int koff = r32 * 128, ksw = (r32 >> 1) & 7, poff = 16384 + r32 * 64, psw = (r32 >> 2) & 3, voff = 8192 + r32 * 128;
    f32x16 oacc[2]; oacc[0] = (f32x16){}; oacc[1] = (f32x16){};
    constexpr float MLA_THR = 8.0f;
    float mref = 0.f, lsum = 0.f;
    f32x16 negm = (f32x16){};
    MLA_ISSUE(0, 0);
    if (NT > 1) MLA_ISSUE(1, 1);
    int st = 0;
    for (int j = 0; j < NT; ++j) {
        if (j + 1 < NT) { if (wave < 4) asm volatile("s_waitcnt vmcnt(3)" ::: "memory"); else asm volatile("s_waitcnt vmcnt(2)" ::: "memory"); }
        else asm volatile("s_waitcnt vmcnt(0)" ::: "memory");
        __builtin_amdgcn_s_barrier(); asm volatile("" ::: "memory");
        if (j + 2 < NT) { const int st2 = st >= 1 ? st - 1 : 2; MLA_ISSUE(j + 2, st2); }
        if (j <= jmaxw) {
            LAS const unsigned char* sb = lds + st * AT_STAGE;
            f32x16 p0, p1;
            {
                const bf16x8 k0 = *(LAS const bf16x8*)(sb + koff + ((hi ^ ksw) << 4));
                const bf16x8 k1 = *(LAS const bf16x8*)(sb + 4096 + koff + ((hi ^ ksw) << 4));
                p0 = __builtin_amdgcn_mfma_f32_32x32x16_bf16(k0, qf[0], negm, 0, 0, 0);
                p1 = __builtin_amdgcn_mfma_f32_32x32x16_bf16(k1, qf[0], negm, 0, 0, 0);
            }
#pragma unroll
            for (int s = 1; s < 4; ++s) {
                const bf16x8 k0 = *(LAS const bf16x8*)(sb + koff + (((2 * s + hi) ^ ksw) << 4));
                const bf16x8 k1 = *(LAS const bf16x8*)(sb + 4096 + koff + (((2 * s + hi) ^ ksw) << 4));
                p0 = __builtin_amdgcn_mfma_f32_32x32x16_bf16(k0, qf[s], p0, 0, 0, 0);
                p1 = __builtin_amdgcn_mfma_f32_32x32x16_bf16(k1, qf[s], p1, 0, 0, 0);
            }
#pragma unroll
            for (int s = 0; s < 2; ++s) {
                const bf16x8 k0 = *(LAS const bf16x8*)(sb + poff + (((2 * s + hi) ^ psw) << 4));
                const bf16x8 k1 = *(LAS const bf16x8*)(sb + 2048 + poff + (((2 * s + hi) ^ psw) << 4));
                p0 = __builtin_amdgcn_mfma_f32_32x32x16_bf16(k0, qf[4 + s], p0, 0, 0, 0);
                p1 = __builtin_amdgcn_mfma_f32_32x32x16_bf16(k1, qf[4 + s], p1, 0, 0, 0);
            }
            if (j >= 4 * qi) {
                const int kb0 = 64 * j + 4 * hi;
#pragma unroll
                for (int r = 0; r < 16; ++r) { const int kp = kb0 + (r & 3) + 8 * (r >> 2); if (kp > qp) p0[r] = -1e30f; if (kp + 32 > qp) p1[r] = -1e30f; }
            }
            float tm = fmaxf(p0[0], p1[0]);
#pragma unroll
            for (int r = 1; r < 16; ++r) tm = fmaxf(tm, fmaxf(p0[r], p1[r]));
            tm = fmaxf(tm, __shfl_xor(tm, 32));
            if (j == 0 || __any(tm > MLA_THR)) {
                const float dl = j == 0 ? tm : fmaxf(tm, 0.f);
                mref += dl;
                const float f = __builtin_amdgcn_exp2f(-dl);
                lsum *= f;
#pragma unroll
                for (int r = 0; r < 16; ++r) { oacc[0][r] *= f; oacc[1][r] *= f; p0[r] -= dl; p1[r] -= dl; negm[r] = -mref; }
            }
            float ps = 0.f;
#pragma unroll
            for (int r = 0; r < 16; ++r) { p0[r] = __builtin_amdgcn_exp2f(p0[r]); p1[r] = __builtin_amdgcn_exp2f(p1[r]); ps += p0[r] + p1[r]; }
            lsum += ps;
            u32x4 pf[4];
            pf[0] = (u32x4){cvtpk(p0[0], p0[1]), cvtpk(p0[2], p0[3]), cvtpk(p0[4], p0[5]), cvtpk(p0[6], p0[7])};
            pf[1] = (u32x4){cvtpk(p0[8], p0[9]), cvtpk(p0[10], p0[11]), cvtpk(p0[12], p0[13]), cvtpk(p0[14], p0[15])};
            pf[2] = (u32x4){cvtpk(p1[0], p1[1]), cvtpk(p1[2], p1[3]), cvtpk(p1[4], p1[5]), cvtpk(p1[6], p1[7])};
            pf[3] = (u32x4){cvtpk(p1[8], p1[9]), cvtpk(p1[10], p1[11]), cvtpk(p1[12], p1[13]), cvtpk(p1[14], p1[15])};
#pragma unroll
            for (int s = 0; s < 4; ++s) {
                const bf16x8 v0 = *(LAS const bf16x8*)(sb + voff + (((2 * s + hi) ^ ksw) << 4));
                const bf16x8 v1 = *(LAS const bf16x8*)(sb + 4096 + voff + (((2 * s + hi) ^ ksw) << 4));
                const bf16x8 pb = __builtin_bit_cast(bf16x8, pf[s]);
                oacc[0] = __builtin_amdgcn_mfma_f32_32x32x16_bf16(v0, pb, oacc[0], 0, 0, 0);
                oacc[1] = __builtin_amdgcn_mfma_f32_32x32x16_bf16(v1, pb, oacc[1], 0, 0, 0);
            }
        }
        st = st == 2 ? 0 : st + 1;
    }
#undef MLA_ISSUE
    lsum += __shfl_xor(lsum, 32);
    const float inv = 1.0f / lsum;
    bf16_t* orow = o + qrow * D + h * 64 + 4 * hi;
#pragma unroll
    for (int db = 0; db < 2; ++db)
#pragma unroll
        for (int g = 0; g < 4; ++g)
            *(u32x2*)(orow + 32 * db + 8 * g) = (u32x2){cvtpk(oacc[db][4 * g] * inv, oacc[db][4 * g + 1] * inv), cvtpk(oacc[db][4 * g + 2] * inv, oacc[db][4 * g + 3] * inv)};
    asm volatile("s_waitcnt lgkmcnt(0)" ::: "memory");
    __builtin_amdgcn_s_barrier(); asm volatile("" ::: "memory");
}
__device__ __forceinline__ void unpack8(const u32x4 v, float (&f)[8]) {
    f[0] = __uint_as_float(v.x << 16); f[1] = __uint_as_float(v.x & 0xffff0000u); f[2] = __uint_as_float(v.y << 16); f[3] = __uint_as_float(v.y & 0xffff0000u);
    f[4] = __uint_as_float(v.z << 16); f[5] = __uint_as_float(v.z & 0xffff0000u); f[6] = __uint_as_float(v.w << 16); f[7] = __uint_as_float(v.w & 0xffff0000u);
}
__device__ __forceinline__ void mla_meta(int b, int h, const bf16_t* __restrict__ Q1, const bf16_t* __restrict__ K1, const bf16_t* __restrict__ kpe, const bf16_t* __restrict__ VT1, bf16_t* o, int lane) {
    const int qi = lane & 15, part = lane >> 4; const size_t qrow = (size_t)MREAL + b * 16 + qi;
    float q[24];
#pragma unroll
    for (int c = 0; c < 3; ++c) { float f[8]; unpack8(*(const u32x4*)(Q1 + qrow * 1536 + h * 96 + 24 * part + 8 * c), f);
#pragma unroll
        for (int i = 0; i < 8; ++i) q[8 * c + i] = f[i]; }
    float sc[16]; float mx = -1e30f;
#pragma unroll
    for (int j = 0; j < 16; ++j) {
        const size_t kr = (size_t)b * LP + j; float s = 0.f;
#pragma unroll
        for (int c = 0; c < 3; ++c) { const int g = 24 * part + 8 * c;
            const bf16_t* src = g < 64 ? K1 + kr * D + h * 64 + g : kpe + kr * 32 + (g - 64);
            float f[8]; unpack8(*(const u32x4*)src, f);
#pragma unroll
            for (int i = 0; i < 8; ++i) s += q[8 * c + i] * f[i]; }
        s += __shfl_xor(s, 16); s += __shfl_xor(s, 32);
        sc[j] = j <= qi ? s : -1e30f; mx = fmaxf(mx, sc[j]);
    }
    float l = 0.f;
#pragma unroll
    for (int j = 0; j < 16; ++j) { sc[j] = exp2f(sc[j] - mx); l += sc[j]; }
    const float inv = 1.0f / l;
#pragma unroll
    for (int dd = 0; dd < 16; ++dd) { const int d = 16 * part + dd; const bf16_t* vr = VT1 + ((size_t)(b * 16 + h) * 64 + d) * LP;
        float e[16]; { float f[8]; unpack8(*(const u32x4*)vr, f);
#pragma unroll
            for (int i = 0; i < 8; ++i) e[i] = f[i]; unpack8(*(const u32x4*)(vr + 8), f);
#pragma unroll
            for (int i = 0; i < 8; ++i) e[8 + i] = f[i]; }
        float acc = 0.f;
#pragma unroll
        for (int j = 0; j < 16; ++j) acc += sc[j] * e[(j & 3) | ((((j >> 2) & 1) << 1 | ((j >> 3) & 1)) << 2)];
        o[qrow * D + h * 64 + d] = f2bf(acc * inv); }
}
__device__ __forceinline__ void mla_phase(LAS unsigned char* lds, const bf16_t* Q1, const bf16_t* K1, const bf16_t* kpe, const bf16_t* VT1, bf16_t* o, int bid, int nblk) {
    const int v = (nblk % 8 == 0) ? (bid % 8) * (nblk / 8) + bid / 8 : bid;
    for (int vv = v; vv < 256; vv += nblk) {
        const int bh = vv >> 3, s = vv & 7, b = bh >> 4, h = bh & 15;
#pragma unroll 1
        for (int i = 0; i < 4; ++i) { const int qi = (i == 0) ? s : (i == 1) ? 15 - s : (i == 2) ? 16 + s : 31 - s; mla_unit(lds, b, h, qi, Q1, K1, kpe, VT1, o); }
        if (s == 0 && threadIdx.x < 64) mla_meta(b, h, Q1, K1, kpe, VT1, o, threadIdx.x);
    }
}

constexpr int SW_K = 0, SW_V = 36864, SW_VP = 560;
__device__ __forceinline__ void swa_block32(LAS const unsigned char* lds, int rb, int gk0, int nks, int mode, int i_q, const bf16x8 (&qf)[4], float& m, float& lsum, f32x16 (&oacc)[2], int r32, int hi) {
    const float C2 = 1.4426950408889634f;
    const int ksw = (r32 >> 1) & 7;
    f32x16 p = (f32x16){};
#pragma unroll
    for (int s = 0; s < 4; ++s) { const bf16x8 k = *(LAS const bf16x8*)(lds + SW_K + (rb + r32) * 128 + (((2 * s + hi) ^ ksw) << 4)); p = __builtin_amdgcn_mfma_f32_32x32x16_bf16(k, qf[s], p, 0, 0, 0); }
    if (mode != 0) {
        const int jb = ((rb - 32) & 127) + 4 * hi;
#pragma unroll
        for (int r = 0; r < 16; ++r) { const int kk = (r & 3) + 8 * (r >> 2);
            const bool ok = mode == 1 ? (kk + 4 * hi < 16) : mode == 2 ? (jb + kk > i_q) : (jb + kk <= i_q);
            if (!ok) p[r] = -1e30f; }
    }
    float tm = p[0];
#pragma unroll
    for (int r = 1; r < 16; ++r) tm = fmaxf(tm, p[r]);
    tm = fmaxf(tm, __shfl_xor(tm, 32));
    const float mn = fmaxf(m, tm), alpha = __builtin_amdgcn_exp2f((m - mn) * C2), nmc = -mn * C2;
    m = mn;
    float ps = 0.f;
#pragma unroll
    for (int r = 0; r < 16; ++r) { p[r] = __builtin_amdgcn_exp2f(__builtin_fmaf(p[r], C2, nmc)); ps += p[r]; }
    lsum = lsum * alpha + ps;
#pragma unroll
    for (int r = 0; r < 16; ++r) { oacc[0][r] *= alpha; oacc[1][r] *= alpha; }
    u32x4 pf[2];
    pf[0] = (u32x4){cvtpk(p[0], p[1]), cvtpk(p[2], p[3]), cvtpk(p[4], p[5]), cvtpk(p[6], p[7])};
    pf[1] = (u32x4){cvtpk(p[8], p[9]), cvtpk(p[10], p[11]), cvtpk(p[12], p[13]), cvtpk(p[14], p[15])};
#pragma unroll
    for (int ks = 0; ks < 2; ++ks) if (ks < nks) {
        const bf16x8 v0 = *(LAS const bf16x8*)(lds + SW_V + r32 * SW_VP + (gk0 + ks) * 32 + hi * 16);
        const bf16x8 v1 = *(LAS const bf16x8*)(lds + SW_V + (32 + r32) * SW_VP + (gk0 + ks) * 32 + hi * 16);
        const bf16x8 pb = __builtin_bit_cast(bf16x8, pf[ks]);
        oacc[0] = __builtin_amdgcn_mfma_f32_32x32x16_bf16(v0, pb, oacc[0], 0, 0, 0);
        oacc[1] = __builtin_amdgcn_mfma_f32_32x32x16_bf16(v1, pb, oacc[1], 0, 0, 0);
    }
}
__device__ __forceinline__ void swa_unit(LAS unsigned char* lds, int b, int n, int kh, const bf16_t* __restrict__ qkv, const bf16_t* __restrict__ VT0, const float* __restrict__ sinks, bf16_t* o) {
    const int tid = threadIdx.x, lane = tid & 63, wave = __builtin_amdgcn_readfirstlane(tid >> 6), r32 = lane & 31, hi = lane >> 5;
    for (int idx = tid; idx < 2176; idx += NTHR) {
        const int row = idx >> 3, c = idx & 7;
        if (row < 16 || n > 0 || row >= 144) {
            const size_t srow = row < 16 ? (size_t)MREAL + b * 16 + row : (size_t)b * SEQ + 128 * (n - 1) + (row - 16);
            const int lrow = row < 16 ? row : 16 + row;
            const u32x4 v = *(const u32x4*)(qkv + srow * NQKV + 1024 + kh * 64 + c * 8);
            *(LAS u32x4*)(lds + SW_K + lrow * 128 + ((c ^ ((lrow >> 1) & 7)) << 4)) = v;
        }
    }
    for (int idx = tid; idx < 2176; idx += NTHR) {
        const int d = idx / 34, c = idx % 34;
        if (c < 2 || n > 0 || c >= 18) {
            const bf16_t* src = VT0 + (size_t)((b * 2 + kh) * 64 + d) * LP + (c < 2 ? c * 8 : 16 + 128 * (n - 1) + (c - 2) * 8);
            *(LAS u32x4*)(lds + SW_V + d * SW_VP + c * 16) = *(const u32x4*)src;
        }
    }
    __syncthreads();
    const int hq = kh * 8 + wave;
    const float sink = sinks[hq];
#pragma unroll 1
    for (int qs = 0; qs < 4; ++qs) {
        const size_t qrow = (size_t)b * SEQ + 128 * n + 32 * qs + r32;
        bf16x8 qf[4];
#pragma unroll
        for (int s = 0; s < 4; ++s) qf[s] = *(const bf16x8*)(qkv + qrow * NQKV + hq * 64 + 16 * s + 8 * hi);
        f32x16 oacc[2]; oacc[0] = (f32x16){}; oacc[1] = (f32x16){};
        float m = sink, lsum = hi == 0 ? 1.0f : 0.0f;
        const int i_q = 32 * qs + r32;
        swa_block32(lds, 0, 0, 1, 1, i_q, qf, m, lsum, oacc, r32, hi);
        if (n > 0) {
            swa_block32(lds, 32 + 32 * qs, 1 + 2 * qs, 2, 2, i_q, qf, m, lsum, oacc, r32, hi);
#pragma unroll 1
            for (int kb = qs + 1; kb < 4; ++kb) swa_block32(lds, 32 + 32 * kb, 1 + 2 * kb, 2, 0, i_q, qf, m, lsum, oacc, r32, hi);
        }
#pragma unroll 1
        for (int kb = 0; kb < qs; ++kb) swa_block32(lds, 160 + 32 * kb, 9 + 2 * kb, 2, 0, i_q, qf, m, lsum, oacc, r32, hi);
        swa_block32(lds, 160 + 32 * qs, 9 + 2 * qs, 2, 3, i_q, qf, m, lsum, oacc, r32, hi);
        lsum += __shfl_xor(lsum, 32);
        const float inv = 1.0f / lsum;
        bf16_t* orow = o + qrow * D + hq * 64 + 4 * hi;
#pragma unroll
        for (int db = 0; db < 2; ++db)
#pragma unroll
            for (int g = 0; g < 4; ++g)
                *(u32x2*)(orow + 32 * db + 8 * g) = (u32x2){cvtpk(oacc[db][4 * g] * inv, oacc[db][4 * g + 1] * inv), cvtpk(oacc[db][4 * g + 2] * inv, oacc[db][4 * g + 3] * inv)};
    }
    __syncthreads();
}
__device__ __forceinline__ void swa_meta(int b, int hq, const bf16_t* __restrict__ qkv, const bf16_t* __restrict__ VT0, const float* __restrict__ sinks, bf16_t* o, int lane) {
    const int qi = lane & 15, part = lane >> 4, kh = hq >> 3; const size_t qrow = (size_t)MREAL + b * 16 + qi;
    float q[16];
#pragma unroll
    for (int c = 0; c < 2; ++c) { float f[8]; unpack8(*(const u32x4*)(qkv + qrow * NQKV + hq * 64 + 16 * part + 8 * c), f);
#pragma unroll
        for (int i = 0; i < 8; ++i) q[8 * c + i] = f[i]; }
    const float sink = sinks[hq];
    float sc[16]; float mx = sink;
#pragma unroll
    for (int j = 0; j < 16; ++j) {
        const size_t kr = (size_t)MREAL + b * 16 + j; float s = 0.f;
#pragma unroll
        for (int c = 0; c < 2; ++c) { float f[8]; unpack8(*(const u32x4*)(qkv + kr * NQKV + 1024 + kh * 64 + 16 * part + 8 * c), f);
#pragma unroll
            for (int i = 0; i < 8; ++i) s += q[8 * c + i] * f[i]; }
        s += __shfl_xor(s, 16); s += __shfl_xor(s, 32);
        sc[j] = j <= qi ? s : -1e30f; mx = fmaxf(mx, sc[j]);
    }
    float l = __expf(sink - mx);
#pragma unroll
    for (int j = 0; j < 16; ++j) { sc[j] = __expf(sc[j] - mx); l += sc[j]; }
    const float inv = 1.0f / l;
#pragma unroll
    for (int dd = 0; dd < 16; ++dd) { const int d = 16 * part + dd; const bf16_t* vr = VT0 + ((size_t)(b * 2 + kh) * 64 + d) * LP;
        float e[16]; { float f[8]; unpack8(*(const u32x4*)vr, f);
#pragma unroll
            for (int i = 0; i < 8; ++i) e[i] = f[i]; unpack8(*(const u32x4*)(vr + 8), f);
#pragma unroll
            for (int i = 0; i < 8; ++i) e[8 + i] = f[i]; }
        float acc = 0.f;
#pragma unroll
        for (int j = 0; j < 16; ++j) acc += sc[j] * e[(j & 3) | ((((j >> 2) & 1) << 1 | ((j >> 3) & 1)) << 2)];
        o[qrow * D + hq * 64 + d] = f2bf(acc * inv); }
}
__device__ __forceinline__ void swa_phase(LAS unsigned char* lds, const bf16_t* qkv, const bf16_t* VT0, const float* sinks, bf16_t* o, int bid, int nblk) {
    for (int u = bid; u < 256; u += nblk) {
        const int b = u >> 7, n = (u >> 1) & 63, kh = u & 1;
        swa_unit(lds, b, n, kh, qkv, VT0, sinks, o);
        if (n == 0) swa_meta(b, kh * 8 + (threadIdx.x >> 6), qkv, VT0, sinks, o, threadIdx.x & 63);
    }
}

template <int MOE_MT>
__device__ __forceinline__ void moe_unit(LAS unsigned char* lds, int e, int s0, int ns, const int* __restrict__ list, const bf16_t* __restrict__ hb, const float* __restrict__ rstd,
                                         const float* __restrict__ wslot, const bf16_t* __restrict__ wgu, const bf16_t* __restrict__ wd, bf16_t* ybuf, unsigned long long* tsb = nullptr) {
#define MSTAMP(i) do { if (PROBE_PHASE >= 600 && tsb && blockIdx.x == 0 && threadIdx.x == 0) tsb[i] = __builtin_amdgcn_s_memrealtime(); } while (0)
    MSTAMP(20);
    constexpr int MOE_BM = 16 * MOE_MT, MOE_HT = MOE_BM * 128, MOE_B2 = 2 * MOE_HT, MOE_ST2 = 32768, MOE_HLO = MOE_B2 + 2 * MOE_ST2, MOE_INFO = MOE_HLO + 2 * MOE_HT;
    static_assert(MOE_B2 + 2 * MOE_ST2 <= MOE_HLO && MOE_INFO + 3072 <= LDS_MISC, "moe lds");
#define moe_hoff(kt) ((kt) < 4 ? MOE_HLO + (kt) * (MOE_HT / 2) : ((kt) - 4) * (MOE_HT / 2))
    const int tid = threadIdx.x, lane = tid & 63, wave = __builtin_amdgcn_readfirstlane(tid >> 6);
    LAS int* slotl = (LAS int*)(lds + MOE_INFO); LAS float* rsl = (LAS float*)(lds + MOE_INFO + 1024); LAS float* wl = (LAS float*)(lds + MOE_INFO + 2048);
    if (tid < MOE_BM) { const int sl = list[(size_t)e * CAP + s0 + (tid < ns ? tid : 0)]; slotl[tid] = sl; rsl[tid] = rstd[sl >> 1]; wl[tid] = wslot[sl]; }
    __syncthreads();
    const int lc4 = (lane & 3) ^ swzF(lane >> 4);
    const int fro32 = (lane & 15) * 64 + (((lane >> 4) ^ swzF((lane >> 2) & 3)) << 4);
    {
        constexpr int ST = (MOE_BM + 512) * 64, GA = MOE_BM / 16, G = GA + 32, NG = (G + 7) / 8;
        static_assert(2 * ST <= MOE_HLO && 2 * MOE_HT <= ST, "moe gemm1 lds");
        const char* src[NG];
#pragma unroll
        for (int i = 0; i < NG; ++i) { const int g = wave + 8 * i;
            if (g < GA) src[i] = (const char*)(hb + (size_t)(slotl[g * 16 + (lane >> 2)] >> 1) * D) + lc4 * 16;
            else if (g < G) src[i] = (const char*)(wgu + (size_t)((g - GA) * 16 + (lane >> 2)) * D) + lc4 * 16;
            else src[i] = nullptr; }
        f32x4 acc[MOE_MT][4];
#pragma unroll
        for (int mi = 0; mi < MOE_MT; ++mi)
#pragma unroll
            for (int ni = 0; ni < 4; ++ni) acc[mi][ni] = (f32x4){0.f, 0.f, 0.f, 0.f};
#define M1_STAGE(st, step) do { _Pragma("unroll") for (int _i = 0; _i < NG; ++_i) { const int _g = wave + 8 * _i; if (_g < G) \
        __builtin_amdgcn_global_load_lds((const unsigned*)(src[_i] + (size_t)(step) * 64), (LAS unsigned*)(lds + (st) * ST + _g * 1024), 16, 0, 0); } } while (0)
        M1_STAGE(0, 0);
        for (int step = 0; step < 32; ++step) {
            asm volatile("s_waitcnt vmcnt(0)" ::: "memory");
            __syncthreads();
            if (step + 1 < 32) M1_STAGE((step + 1) & 1, step + 1);
            LAS const unsigned char* sa = lds + (step & 1) * ST + fro32;
            LAS const unsigned char* sb = lds + (step & 1) * ST + (MOE_BM + wave * 64) * 64 + fro32;
            bf16x8 bfr[4];
#pragma unroll
            for (int ni = 0; ni < 4; ++ni) bfr[ni] = *(LAS const bf16x8*)(sb + ni * 1024);
#pragma unroll
            for (int mi = 0; mi < MOE_MT; ++mi) { const bf16x8 af = *(LAS const bf16x8*)(sa + mi * 1024);
#pragma unroll
                for (int ni = 0; ni < 4; ++ni) acc[mi][ni] = __builtin_amdgcn_mfma_f32_16x16x32_bf16(bfr[ni], af, acc[mi][ni], 0, 0, 0); }
        }
#undef M1_STAGE
        int lane_h = threadIdx.x & 63; asm volatile("" : "+v"(lane_h));
#define lane lane_h
#pragma unroll
        for (int p = 0; p < 2; ++p) {
            const int n = 32 * wave + 16 * p + (lane >> 4) * 4;
            const int csw = ((n & 31) >> 3);
#pragma unroll
            for (int mi = 0; mi < MOE_MT; ++mi) { const int row = mi * 16 + (lane & 15); const float rs = rsl[row]; float hv[4];
#pragma unroll
                for (int r = 0; r < 4; ++r) { const float g = acc[mi][2 * p][r] * rs, u = acc[mi][2 * p + 1][r] * rs; hv[r] = g / (1.0f + __expf(-g)) * u; }
                *(LAS u32x2*)(lds + moe_hoff(n >> 5) + row * 64 + ((csw ^ swzF((row >> 2) & 3)) << 4) + (n & 4) * 2) = (u32x2){pk2(hv[0], hv[1]), pk2(hv[2], hv[3])}; }
        }
#undef lane
    }
    __syncthreads();
    MSTAMP(21);
    {
        const char* src2[4];
#pragma unroll
        for (int i = 0; i < 4; ++i) src2[i] = (const char*)(wd + (size_t)((wave + 8 * i) * 16 + (lane >> 2)) * DE) + lc4 * 16;
        f32x4 acc[MOE_MT][4];
#pragma unroll
        for (int mi = 0; mi < MOE_MT; ++mi)
#pragma unroll
            for (int ni = 0; ni < 4; ++ni) acc[mi][ni] = (f32x4){0.f, 0.f, 0.f, 0.f};
#define M2_STAGE(st, q) do { _Pragma("unroll") for (int _i = 0; _i < 4; ++_i) \
        __builtin_amdgcn_global_load_lds((const unsigned*)(src2[_i] + (size_t)((q) >> 3) * (512 * 512) + (size_t)((q) & 7) * 64), (LAS unsigned*)(lds + MOE_B2 + (st) * MOE_ST2 + (wave + 8 * _i) * 1024), 16, 0, 0); } while (0)
        M2_STAGE(0, 0);
        for (int q = 0; q < 16; ++q) {
            asm volatile("s_waitcnt vmcnt(0)" ::: "memory");
            __syncthreads();
            if (q + 1 < 16) M2_STAGE((q + 1) & 1, q + 1);
            LAS const unsigned char* sa = lds + moe_hoff(q & 7) + fro32;
            LAS const unsigned char* sb = lds + MOE_B2 + (q & 1) * MOE_ST2 + (wave * 64) * 64 + fro32;
            bf16x8 bfr[4];
#pragma unroll
            for (int ni = 0; ni < 4; ++ni) bfr[ni] = *(LAS const bf16x8*)(sb + ni * 1024);
#pragma unroll
            for (int mi = 0; mi < MOE_MT; ++mi) { const bf16x8 af = *(LAS const bf16x8*)(sa + mi * 1024);
#pragma unroll
                for (int ni = 0; ni < 4; ++ni) acc[mi][ni] = __builtin_amdgcn_mfma_f32_16x16x32_bf16(bfr[ni], af, acc[mi][ni], 0, 0, 0); }
            if ((q & 7) == 7) {
                int lane_y = threadIdx.x & 63; asm volatile("" : "+v"(lane_y));
                const int cb = (q >> 3) * 512 + wave * 64 + (lane_y >> 4) * 4;
#pragma unroll
                for (int mi = 0; mi < MOE_MT; ++mi) { const int row = mi * 16 + (lane_y & 15);
                    if (row < ns) { const float w = wl[row]; bf16_t* yr = ybuf + (size_t)slotl[row] * D + cb;
#pragma unroll
                        for (int ni = 0; ni < 4; ++ni) { const f32x4 v = acc[mi][ni] * w; *(u32x2*)(yr + ni * 16) = (u32x2){pk2(v[0], v[1]), pk2(v[2], v[3])}; } }
#pragma unroll
                    for (int ni = 0; ni < 4; ++ni) acc[mi][ni] = (f32x4){0.f, 0.f, 0.f, 0.f}; }
            }
        }
#undef M2_STAGE
    }
#undef moe_hoff
    __syncthreads();
    MSTAMP(22);
#undef MSTAMP
}
__device__ __forceinline__ void moe_phase(LAS unsigned char* lds, int* cnt, const int* list, const bf16_t* hb, const float* rstd, const float* wslot, const bf16_t* wgu, const bf16_t* wd, bf16_t* ybuf, int bid, int nblk, unsigned long long* tsb = nullptr) {
    const bool grp = (nblk % 8) == 0;
    int ntile[NE]; int gsum = 0; bool fit = grp;
#pragma unroll
    for (int e = 0; e < NE; ++e) { const int c = __hip_atomic_load(cnt + e * 64, __ATOMIC_RELAXED, __HIP_MEMORY_SCOPE_AGENT); const int bm = 144; ntile[e] = (c + bm - 1) / bm;
        gsum = (e & 3) == 0 ? ntile[e] : gsum + ntile[e]; if ((e & 3) == 3 && gsum > nblk / 8) fit = false; }
    const int x = bid % 8;
    int u = fit ? bid / 8 : (grp ? x * (nblk / 8) + bid / 8 : bid), base = 0;
    const int stride = fit ? nblk / 8 : nblk;
#pragma unroll 1
    for (int e = 0; e < NE; ++e) {
        if (fit && (e >> 2) != x) continue;
        const int c = __hip_atomic_load(cnt + e * 64, __ATOMIC_RELAXED, __HIP_MEMORY_SCOPE_AGENT);
        const bool big = false; const int bm = 144, nt = (c + bm - 1) / bm;
        while (u < base + nt) { const int t = u - base; const int ns = c - t * bm < bm ? c - t * bm : bm;
            moe_unit<9>(lds, e, t * bm, ns, list, hb, rstd, wslot, wgu + (size_t)e * 512 * 1024, wd + (size_t)e * 1024 * 256, ybuf, tsb);
            u += stride; }
        base += nt;
    }
}

template <int MT>
__device__ __forceinline__ void l1proj_unit(LAS unsigned char* lds, int row0, int mrow0, bf16_t* hb, const bf16_t* __restrict__ ybuf, const bf16_t* __restrict__ win_t, const bf16_t* __restrict__ wuq_t,
                                            const bf16_t* __restrict__ wukv_t, const float2* __restrict__ cs, bf16_t* kpe, bf16_t* Q1, bf16_t* K1, bf16_t* VT1) {
    constexpr int BM = 16 * MT, STW = (BM + 512) * 64, KT = BM * 64  , CQN = 0, CKV = 8 * KT, RB = 12 * KT, STB = 32768, PART = 3 * STW;
    static_assert(RB + 3 * STB <= LDS_MISC && PART + 8 * BM * 4 <= LDS_MISC, "l1proj lds");
    const int tid = threadIdx.x, lane = tid & 63, wave = __builtin_amdgcn_readfirstlane(tid >> 6);
    LAS float* rsl = (LAS float*)(lds + LDS_MISC + 256);
#define L1_GROW(r) ((r) < 64 ? row0 + (r) : mrow0 + (r) - 64)
    for (int r = wave; r < BM; r += NWAVE) {
        const size_t grow = L1_GROW(r); float ss = 0.f;
#pragma unroll
        for (int j = 0; j < 4; ++j) { const size_t c = j * 256 + lane * 4;
            const u32x2 h = *(const u32x2*)(hb + grow * D + c), y0 = *(const u32x2*)(ybuf + (grow * 2) * D + c), y1 = *(const u32x2*)(ybuf + (grow * 2 + 1) * D + c);
            float v[4];
            v[0] = __uint_as_float(h.x << 16) + __uint_as_float(y0.x << 16) + __uint_as_float(y1.x << 16);
            v[1] = __uint_as_float(h.x & 0xffff0000u) + __uint_as_float(y0.x & 0xffff0000u) + __uint_as_float(y1.x & 0xffff0000u);
            v[2] = __uint_as_float(h.y << 16) + __uint_as_float(y0.y << 16) + __uint_as_float(y1.y << 16);
            v[3] = __uint_as_float(h.y & 0xffff0000u) + __uint_as_float(y0.y & 0xffff0000u) + __uint_as_float(y1.y & 0xffff0000u);
            ss += v[0] * v[0] + v[1] * v[1] + v[2] * v[2] + v[3] * v[3];
            *(u32x2*)(hb + grow * D + c) = (u32x2){pk2(v[0], v[1]), pk2(v[2], v[3])}; }
        ss = wave_sum(ss); if (lane == 0) rsl[r] = rsqrtf(ss * (1.0f / D) + EPS);
    }
    asm volatile("s_waitcnt vmcnt(0)" ::: "memory");
    __syncthreads();
    const int lc = (lane & 3) ^ swzF(lane >> 4);
    const int fro = (lane & 15) * 64 + (((lane >> 4) ^ swzF((lane >> 2) & 3)) << 4);
    f32x4 acc[MT][4];
#pragma unroll
    for (int mi = 0; mi < MT; ++mi)
#pragma unroll
        for (int ni = 0; ni < 4; ++ni) acc[mi][ni] = (f32x4){0.f, 0.f, 0.f, 0.f};
    {
        const char* srcb[4];
#pragma unroll
        for (int i = 0; i < 4; ++i) srcb[i] = (const char*)(win_t + (size_t)((wave + 8 * i) * 16 + (lane >> 2)) * D) + lc * 16;
        const char* srca = (const char*)(hb + (size_t)L1_GROW((wave < MT ? wave : 0) * 16 + (lane >> 2)) * D) + lc * 16;
#define W_ISSUE(st, kt) do { if (wave < MT) __builtin_amdgcn_global_load_lds((const unsigned*)(srca + (size_t)(kt) * 64), (LAS unsigned*)(lds + (st) * STW + wave * 1024), 16, 0, 16); \
        _Pragma("unroll") for (int _i = 0; _i < 4; ++_i) __builtin_amdgcn_global_load_lds((const unsigned*)(srcb[_i] + (size_t)(kt) * 64), (LAS unsigned*)(lds + (st) * STW + (MT + wave + 8 * _i) * 1024), 16, 0, 0); } while (0)
        W_ISSUE(0, 0); W_ISSUE(1, 1);
        int st = 0;
        for (int kt = 0; kt < 32; ++kt) {
            if (kt + 1 < 32) { if (wave < MT) wait_vm<5>(); else wait_vm<4>(); } else wait_vm<0>();
            __builtin_amdgcn_s_barrier(); asm volatile("" ::: "memory");
            if (kt + 2 < 32) W_ISSUE(st == 0 ? 2 : st - 1, kt + 2);
            LAS const unsigned char* sa = lds + st * STW + fro;
            LAS const unsigned char* sb = lds + st * STW + (BM + wave * 64) * 64 + fro;
            bf16x8 bfr[4];
#pragma unroll
            for (int ni = 0; ni < 4; ++ni) bfr[ni] = *(LAS const bf16x8*)(sb + ni * 1024);
#pragma unroll
            for (int mi = 0; mi < MT; ++mi) { const bf16x8 af = *(LAS const bf16x8*)(sa + mi * 1024);
#pragma unroll
                for (int ni = 0; ni < 4; ++ni) acc[mi][ni] = __builtin_amdgcn_mfma_f32_16x16x32_bf16(bfr[ni], af, acc[mi][ni], 0, 0, 0); }
            st = st == 2 ? 0 : st + 1;
        }
#undef W_ISSUE
    }
    asm volatile("s_waitcnt lgkmcnt(0)" ::: "memory");
    __syncthreads();
    LAS float* part = (LAS float*)(lds + PART);
    int lane_e = lane; asm volatile("" : "+v"(lane_e));
#define lane lane_e
#pragma unroll
    for (int mi = 0; mi < MT; ++mi) { const float rs = rsl[mi * 16 + (lane & 15)]; float ss = 0.f;
#pragma unroll
        for (int ni = 0; ni < 4; ++ni) { acc[mi][ni] = acc[mi][ni] * rs; ss += acc[mi][ni][0] * acc[mi][ni][0] + acc[mi][ni][1] * acc[mi][ni][1] + acc[mi][ni][2] * acc[mi][ni][2] + acc[mi][ni][3] * acc[mi][ni][3]; }
        ss += __shfl_xor(ss, 16); ss += __shfl_xor(ss, 32);
        if (lane < 16) part[wave * BM + mi * 16 + lane] = ss; }
    __syncthreads();
    if (wave < 6) {
#pragma unroll
        for (int mi = 0; mi < MT; ++mi) { const int row = mi * 16 + (lane & 15);
            const float tot = wave < 4 ? (part[row] + part[BM + row]) + (part[2 * BM + row] + part[3 * BM + row]) : part[4 * BM + row] + part[5 * BM + row];
            const float rn = rsqrtf(tot * (wave < 4 ? 1.0f / 256 : 1.0f / 128) + EPS);
#pragma unroll
            for (int ni = 0; ni < 4; ++ni) { const int cc = (wave < 4 ? 64 * wave : 64 * (wave - 4)) + ni * 16 + (lane >> 4) * 4; const f32x4 v = acc[mi][ni] * rn;
                *(LAS u32x2*)(lds + (wave < 4 ? CQN : CKV) + (cc >> 5) * KT + row * 64 + (((((cc & 31) >> 3)) ^ swzF((row >> 2) & 3)) << 4) + (cc & 4) * 2) = (u32x2){pk2(v[0], v[1]), pk2(v[2], v[3])}; } }
    } else if (wave == 6) {
#pragma unroll
        for (int mi = 0; mi < MT; ++mi) { const int row = mi * 16 + (lane & 15); const int grow = L1_GROW(row); const int pos = row_pos(grow), d0 = (lane >> 4) * 4;
            f32x4 o1, o2;
#pragma unroll
            for (int r = 0; r < 4; ++r) { const float2 t = cs[pos * 32 + 2 * (d0 + r)]; const float x1 = acc[mi][0][r], x2 = acc[mi][1][r]; o1[r] = x1 * t.x - x2 * t.y; o2[r] = x2 * t.x + x1 * t.y; }
            bf16_t* kr = kpe + ((size_t)row_batch(grow) * LP + pos) * 32;
            *(u32x2*)(kr + d0) = (u32x2){pk2(o1[0], o1[1]), pk2(o1[2], o1[3])}; *(u32x2*)(kr + 16 + d0) = (u32x2){pk2(o2[0], o2[1]), pk2(o2[2], o2[3])}; }
    }
#undef lane
    __syncthreads();
    const char* srcu[4];
#define U_ISSUE(st, base, pitchB, chunk, kt) do { _Pragma("unroll") for (int _i = 0; _i < 4; ++_i) \
        __builtin_amdgcn_global_load_lds((const unsigned*)(srcu[_i] + (size_t)(chunk) * 512 * (pitchB) + (size_t)(kt) * 64), (LAS unsigned*)(lds + RB + (st) * STB + (wave + 8 * _i) * 1024), 16, 0, 0); } while (0)
    {
#pragma unroll
        for (int i = 0; i < 4; ++i) srcu[i] = (const char*)(wuq_t + (size_t)((wave + 8 * i) * 16 + (lane >> 2)) * 256) + lc * 16;
#pragma unroll
        for (int mi = 0; mi < MT; ++mi)
#pragma unroll
            for (int ni = 0; ni < 4; ++ni) acc[mi][ni] = (f32x4){0.f, 0.f, 0.f, 0.f};
        U_ISSUE(0, 0, 512, 0, 0); U_ISSUE(1, 0, 512, 0, 1);
        int st = 0;
        for (int q = 0; q < 24; ++q) {
            if (q + 1 < 24) wait_vm<4>(); else wait_vm<0>();
            __builtin_amdgcn_s_barrier(); asm volatile("" ::: "memory");
            if (q + 2 < 24) U_ISSUE(st == 0 ? 2 : st - 1, 0, 512, (q + 2) >> 3, (q + 2) & 7);
            LAS const unsigned char* sa = lds + CQN + (q & 7) * KT + fro;
            LAS const unsigned char* sb = lds + RB + st * STB + (wave * 64) * 64 + fro;
            bf16x8 bfr[4];
#pragma unroll
            for (int ni = 0; ni < 4; ++ni) bfr[ni] = *(LAS const bf16x8*)(sb + ni * 1024);
#pragma unroll
            for (int mi = 0; mi < MT; ++mi) { const bf16x8 af = *(LAS const bf16x8*)(sa + mi * 1024);
#pragma unroll
                for (int ni = 0; ni < 4; ++ni) acc[mi][ni] = __builtin_amdgcn_mfma_f32_16x16x32_bf16(bfr[ni], af, acc[mi][ni], 0, 0, 0); }
            if ((q & 7) == 7) {
                int lane_q = lane; asm volatile("" : "+v"(lane_q));
#define lane lane_q
                const float scale = 0.10206207261596577f * 1.4426950408889634f; const int d0 = (lane >> 4) * 4;
#pragma unroll
                for (int mi = 0; mi < MT; ++mi) { const int grow = L1_GROW(mi * 16 + (lane & 15)); const int pos = row_pos(grow);
#pragma unroll
                    for (int bi = 0; bi < 2; ++bi) { const int gc = (q >> 3) * 512 + 64 * wave + bi * 32; bf16_t* orow = Q1 + (size_t)grow * 1536 + gc;
                        f32x4 v1 = acc[mi][2 * bi], v2 = acc[mi][2 * bi + 1];
                        if (((gc >> 5) % 3) == 2) {
#pragma unroll
                            for (int r = 0; r < 4; ++r) { const float2 t = cs[pos * 32 + 2 * (d0 + r)]; const float x1 = v1[r], x2 = v2[r]; v1[r] = x1 * t.x - x2 * t.y; v2[r] = x2 * t.x + x1 * t.y; } }
                        v1 = v1 * scale; v2 = v2 * scale;
                        *(u32x2*)(orow + d0) = (u32x2){pk2(v1[0], v1[1]), pk2(v1[2], v1[3])}; *(u32x2*)(orow + 16 + d0) = (u32x2){pk2(v2[0], v2[1]), pk2(v2[2], v2[3])}; }
#pragma unroll
                    for (int ni = 0; ni < 4; ++ni) acc[mi][ni] = (f32x4){0.f, 0.f, 0.f, 0.f}; }
#undef lane
            }
            st = st == 2 ? 0 : st + 1;
        }
    }
    asm volatile("s_waitcnt lgkmcnt(0)" ::: "memory");
    __syncthreads();
    {
#pragma unroll
        for (int i = 0; i < 4; ++i) srcu[i] = (const char*)(wukv_t + (size_t)((wave + 8 * i) * 16 + (lane >> 2)) * 128) + lc * 16;
#pragma unroll
        for (int mi = 0; mi < MT; ++mi)
#pragma unroll
            for (int ni = 0; ni < 4; ++ni) acc[mi][ni] = (f32x4){0.f, 0.f, 0.f, 0.f};
        U_ISSUE(0, 0, 256, 0, 0); U_ISSUE(1, 0, 256, 0, 1);
        int st = 0;
        for (int q = 0; q < 16; ++q) {
            if (q + 1 < 16) wait_vm<4>(); else wait_vm<0>();
            __builtin_amdgcn_s_barrier(); asm volatile("" ::: "memory");
            if (q + 2 < 16) U_ISSUE(st == 0 ? 2 : st - 1, 0, 256, (q + 2) >> 2, (q + 2) & 3);
            LAS const unsigned char* sa = lds + CKV + (q & 3) * KT + fro;
            LAS const unsigned char* sb = lds + RB + st * STB + (wave * 64) * 64 + fro;
            bf16x8 bfr[4];
#pragma unroll
            for (int ni = 0; ni < 4; ++ni) bfr[ni] = *(LAS const bf16x8*)(sb + ni * 1024);
            if (q < 8) {
#pragma unroll
                for (int mi = 0; mi < MT; ++mi) { const bf16x8 af = *(LAS const bf16x8*)(sa + mi * 1024);
#pragma unroll
                    for (int ni = 0; ni < 4; ++ni) acc[mi][ni] = __builtin_amdgcn_mfma_f32_16x16x32_bf16(bfr[ni], af, acc[mi][ni], 0, 0, 0); }
            } else {
#pragma unroll
                for (int mi = 0; mi < MT; ++mi) { const bf16x8 af = *(LAS const bf16x8*)(sa + mi * 1024);
#pragma unroll
                    for (int ni = 0; ni < 4; ++ni) acc[mi][ni] = __builtin_amdgcn_mfma_f32_16x16x32_bf16(af, bfr[ni], acc[mi][ni], 0, 0, 0); }
            }
            if ((q & 3) == 3) {
                const int ch = q >> 2;
                int lane_k = lane; asm volatile("" : "+v"(lane_k));
#define lane lane_k
                if (ch < 2) {
#pragma unroll
                    for (int mi = 0; mi < MT; ++mi) { const int grow = L1_GROW(mi * 16 + (lane & 15)); const size_t kr = (size_t)row_batch(grow) * LP + row_pos(grow);
#pragma unroll
                        for (int ni = 0; ni < 4; ++ni) { const f32x4 v = acc[mi][ni];
                            *(u32x2*)(K1 + kr * D + 512 * ch + 64 * wave + ni * 16 + (lane >> 4) * 4) = (u32x2){pk2(v[0], v[1]), pk2(v[2], v[3])}; acc[mi][ni] = (f32x4){0.f, 0.f, 0.f, 0.f}; } }
                } else {
#pragma unroll
                    for (int mi = 0; mi < MT; ++mi) { const int grow0 = L1_GROW(mi * 16 + (lane >> 4) * 4); const int b = row_batch(grow0), pp = perm16(row_pos(grow0));
#pragma unroll
                        for (int ni = 0; ni < 4; ++ni) { const int hd = 512 * (ch - 2) + 64 * wave + ni * 16 + (lane & 15); const f32x4 v = acc[mi][ni];
                            *(u32x2*)(VT1 + (size_t)(b * 1024 + hd) * LP + pp) = (u32x2){pk2(v[0], v[1]), pk2(v[2], v[3])}; acc[mi][ni] = (f32x4){0.f, 0.f, 0.f, 0.f}; } }
                }
#undef lane
            }
            st = st == 2 ? 0 : st + 1;
        }
    }
#undef U_ISSUE
#undef L1_GROW
    asm volatile("s_waitcnt lgkmcnt(0)" ::: "memory");
    __syncthreads();
}
__device__ __forceinline__ void l1proj_phase(LAS unsigned char* lds, bf16_t* hb, const bf16_t* ybuf, const bf16_t* win_t, const bf16_t* wuq_t, const bf16_t* wukv_t, const float2* cs, bf16_t* kpe,
                                             bf16_t* Q1, bf16_t* K1, bf16_t* VT1, int bid, int nblk) {
    { const int gt = bid * NTHR + threadIdx.x, ngt = nblk * NTHR;
      for (int idx = gt; idx < 2 * 48 * 1024; idx += ngt) { const int b = idx / (48 * 1024), r = idx % (48 * 1024); K1[((size_t)b * LP + 8208) * 1024 + r] = 0; }
      for (int idx = gt; idx < 2 * 16 * 64 * 48; idx += ngt) { const int rr = idx / 48, c = idx % 48; VT1[(size_t)rr * LP + 8208 + c] = 0; } }
    for (int u = bid; u < 256; u += nblk) {
        if (u >= 254) l1proj_unit<5>(lds, u * 64, MREAL + (u - 254) * 16, hb, ybuf, win_t, wuq_t, wukv_t, cs, kpe, Q1, K1, VT1);
        else l1proj_unit<4>(lds, u * 64, MREAL, hb, ybuf, win_t, wuq_t, wukv_t, cs, kpe, Q1, K1, VT1);
    }
}

struct EpiNull { int m0, n0;
    template <int MT, int NT> __device__ __forceinline__ void operator()(f32x4 (&acc)[MT][NT], int, int, int) const {
#pragma unroll
        for (int mi = 0; mi < MT; ++mi)
#pragma unroll
            for (int ni = 0; ni < NT; ++ni) asm volatile("" :: "v"(acc[mi][ni])); } };
__device__ __forceinline__ void transpose_item(const float* __restrict__ W, int N, const float* __restrict__ gain, bf16_t* dst, int ldk, int drow0, int k0, int n0, LAS float* scr, int lane, int dskip = 0) {
#pragma unroll 8
    for (int i = 0; i < 32; ++i) { const int kk = 2 * i + (lane >> 5); float v = W[(size_t)(k0 + kk) * N + n0 + (lane & 31)]; if (gain) v *= gain[k0 + kk]; scr[kk * 33 + (lane & 31)] = v; }
    asm volatile("s_waitcnt lgkmcnt(0)" ::: "memory");
    const int c = lane & 7;
#pragma unroll
    for (int j = 0; j < 4; ++j) { const int n = (lane >> 3) + 8 * j; const LAS float* s = scr + (8 * c) * 33 + n;
        u32x4 o; o.x = pk2(s[0 * 33], s[1 * 33]); o.y = pk2(s[2 * 33], s[3 * 33]); o.z = pk2(s[4 * 33], s[5 * 33]); o.w = pk2(s[6 * 33], s[7 * 33]);
        *(u32x4*)(dst + (size_t)(drow0 + n + (n >= 16 ? dskip : 0)) * ldk + k0 + 8 * c) = o; }
    asm volatile("s_waitcnt lgkmcnt(0)" ::: "memory");
}
struct MoeItem { const float* src; const float* gain; bf16_t* dst; int pitch, ldk, kind, nrow0; };
__device__ __forceinline__ MoeItem moe_item(int it, const float* wgate, const float* wup, const float* wdown, const float* gain, bf16_t* wgu_t, bf16_t* wd_t) {
    const int e = it / 48, r = it % 48, which = r >> 4, q = r & 15; MoeItem d;
    if (which < 2) { d.src = (which ? wup : wgate) + (size_t)e * D * DE + (size_t)q * 64 * DE; d.gain = gain + q * 64; d.dst = wgu_t + (size_t)e * 512 * 1024 + q * 64; d.pitch = DE; d.ldk = 1024; d.kind = which; d.nrow0 = 0; }
    else { const int kb = q >> 2, nb = q & 3; d.src = wdown + (size_t)e * DE * D + (size_t)kb * 64 * D + nb * 256; d.gain = nullptr; d.dst = wd_t + (size_t)e * 1024 * 256 + kb * 64; d.pitch = D; d.ldk = 256; d.kind = 2; d.nrow0 = nb * 256; }
    return d;
}
__device__ __forceinline__ void moe_weight_items(const float* wgate, const float* wup, const float* wdown, const float* gain, bf16_t* wgu_t, bf16_t* wd_t, LAS float* T, int bid, int nblk) {
    const int tid = threadIdx.x;
    f32x4 R[8];
    int it = bid;
    if (it >= NE * 48) return;
    MoeItem cur = moe_item(it, wgate, wup, wdown, gain, wgu_t, wd_t);
#pragma unroll
    for (int i = 0; i < 8; ++i) { const int idx = tid + i * NTHR; R[i] = *(const f32x4*)(cur.src + (size_t)(idx >> 6) * cur.pitch + (idx & 63) * 4); }
    for (;;) {
#pragma unroll
        for (int i = 0; i < 8; ++i) { const int idx = tid + i * NTHR, k = idx >> 6, c4 = idx & 63; f32x4 v = R[i]; if (cur.gain) v = v * cur.gain[k];
            LAS float* t = T + k * 257 + c4 * 4; t[0] = v[0]; t[1] = v[1]; t[2] = v[2]; t[3] = v[3]; }
        __syncthreads();
        const int nit = it + nblk; const bool more = nit < NE * 48;
        MoeItem nxt = cur;
        if (more) { nxt = moe_item(nit, wgate, wup, wdown, gain, wgu_t, wd_t);
#pragma unroll
            for (int i = 0; i < 8; ++i) { const int idx = tid + i * NTHR; R[i] = *(const f32x4*)(nxt.src + (size_t)(idx >> 6) * nxt.pitch + (idx & 63) * 4); } }
#pragma unroll
        for (int i = 0; i < 4; ++i) { const int idx = tid + i * NTHR, kc = idx & 7, n = idx >> 3;
            const LAS float* t = T + (8 * kc) * 257 + n;
            u32x4 o; o.x = pk2(t[0], t[257]); o.y = pk2(t[2 * 257], t[3 * 257]); o.z = pk2(t[4 * 257], t[5 * 257]); o.w = pk2(t[6 * 257], t[7 * 257]);
            const int row = cur.kind == 2 ? cur.nrow0 + n : (n >> 4) * 32 + cur.kind * 16 + (n & 15);
            *(u32x4*)(cur.dst + (size_t)row * cur.ldk + 8 * kc) = o; }
        __syncthreads();
        if (!more) break;
        cur = nxt; it = nit;
    }
}
__device__ __forceinline__ void p0_prologue(const MArgs& a, LAS unsigned char* lds, int bid, int nblk) {
    const int tid = threadIdx.x, lane = tid & 63, wave = __builtin_amdgcn_readfirstlane(tid >> 6);
    const int gw = bid * NWAVE + wave, ngw = nblk * NWAVE, gt = bid * NTHR + tid, ngt = nblk * NTHR;
    unsigned char* ws = a.ws;
    float2* cs = (float2*)(ws + WS_ROPE);
    for (int _r = 0; _r < (PROBE_PHASE == 301 ? 2 : 1); ++_r)
    for (int idx = gt; idx < LPOS * 32; idx += ngt) { const int pos = idx >> 5, i = idx & 31; const float inv = 1.0f / powf(10000.0f, (float)(2 * i) / 64.0f); float s, c; sincosf((float)pos * inv, &s, &c); cs[idx] = make_float2(c, s); }
    float* wrf = (float*)(ws + W2_WRF);
    for (int idx = gt; idx < 2 * 36 * 1024; idx += ngt) { const int l = idx / (36 * 1024), j = (idx >> 10) % 36, k = idx & 1023;
        const float g = a.in[3][l * D + k]; wrf[idx] = g * (j < 4 ? a.in[16][(size_t)l * D * 4 + k * 4 + j] : a.in[18][(size_t)l * D * 32 + k * 32 + (j - 4)]); }
    { u32x4* z = (u32x4*)(ws + W2_WIN + (size_t)416 * 1024 * 2); for (int idx = gt; idx < 96 * 1024 * 2 / 16; idx += ngt) z[idx] = (u32x4){0u, 0u, 0u, 0u}; }
    { bf16_t* kpe = (bf16_t*)(ws + WS_KPE); for (int idx = gt; idx < 2 * 48 * 32; idx += ngt) { const int b = idx / (48 * 32), r = idx % (48 * 32); kpe[((size_t)b * LP + 8208) * 32 + r] = 0; }
      bf16_t* vt0 = (bf16_t*)(ws + B_VT0); for (int idx = gt; idx < 2 * 2 * 64 * 48; idx += ngt) { const int rr = idx / 48, c = idx % 48; vt0[(size_t)rr * LP + 8208 + c] = 0; } }
    { bf16_t* hb = (bf16_t*)(ws + W2_HB); float* rstd = (float*)(ws + W2_RSTD);
      for (int _r = 0; _r < (PROBE_PHASE == 303 ? 2 : 1); ++_r)
      for (int row = gw; row < MTOT; row += ngw) {
        const float* src = row < MREAL ? a.in[0] + (size_t)row * D : a.in[1] + (size_t)row_pos(row) * D;
        float ss = 0.f;
#pragma unroll
        for (int j = 0; j < 4; ++j) { const f32x4 v = *(const f32x4*)(src + j * 256 + lane * 4); ss += v[0] * v[0] + v[1] * v[1] + v[2] * v[2] + v[3] * v[3];
            *(u32x2*)(hb + (size_t)row * D + j * 256 + lane * 4) = (u32x2){pk2(v[0], v[1]), pk2(v[2], v[3])}; }
        ss = wave_sum(ss); if (lane == 0) rstd[row] = rsqrtf(ss * (1.0f / D) + EPS);
      } }
    LAS float* scr = (LAS float*)(lds + wave * 16384);
    for (int _r = 0; _r < (PROBE_PHASE == 304 ? 2 : 1); ++_r)
    for (int it = gw; it < 2192; it += ngw) {
        int r = it;
        if (r < 640) { const int nb = r % 40;
            transpose_item(a.in[5], NQKV, a.in[2], (bf16_t*)(ws + W2_WQKV), 1024, nb < 32 ? 64 * (nb >> 1) + 16 * (nb & 1) : nb * 32, (r / 40) * 64, nb * 32, scr, lane, nb < 32 ? 16 : 0); continue; } r -= 640;
        if (r < 512) { transpose_item(a.in[8], D, nullptr, (bf16_t*)(ws + W2_WO0), 1024, (r & 31) * 32, (r >> 5) * 64, (r & 31) * 32, scr, lane); continue; } r -= 512;
        if (r < 208) { transpose_item(a.in[10], 416, a.in[2] + D, (bf16_t*)(ws + W2_WIN), 1024, (r % 13) * 32, (r / 13) * 64, (r % 13) * 32, scr, lane); continue; } r -= 208;
        if (r < 192) { transpose_item(a.in[13], 1536, a.in[11], (bf16_t*)(ws + W2_WUQ), 256, (r % 48) * 32, (r / 48) * 64, (r % 48) * 32, scr, lane); continue; } r -= 192;
        if (r < 128) { const int nb32 = r & 63, hh = nb32 >> 2, part = nb32 & 3;
            transpose_item(a.in[14], 2048, a.in[12], (bf16_t*)(ws + W2_WUKV), 128, part < 2 ? hh * 64 + part * 32 : 1024 + hh * 64 + (part - 2) * 32, (r >> 6) * 64, nb32 * 32, scr, lane); continue; } r -= 128;
        transpose_item(a.in[15], D, nullptr, (bf16_t*)(ws + W2_WO1), 1024, (r & 31) * 32, (r >> 5) * 64, (r & 31) * 32, scr, lane);
    }
    __syncthreads();
    moe_weight_items(a.in[20], a.in[21], a.in[22], a.in[3], (bf16_t*)(ws + C_W0), (bf16_t*)(ws + C_W0 + MOE_WGU_BYTES), (LAS float*)lds, bid, nblk);
}

template <bool NSW, bool HALFN, class MakeEpi>
__device__ __forceinline__ void gemm_phase(LAS unsigned char* lds, const bf16_t* A, int lda, const bf16_t* Bt, int K, int pn0, int pn1, int bid, int nblk, const MakeEpi& mk) {
    constexpr int BN = HALFN ? 128 : 256;
    const int ntn = pn1 - pn0;
    const bool grp = (nblk % 8) == 0;
    const int x = grp ? bid % 8 : 0, j = grp ? bid / 8 : bid, nslot = grp ? nblk / 8 : nblk, pmg = grp ? 8 : 64;
    for (int u = j; u < pmg * ntn; u += nslot) {
        const int pm = x * pmg + u / ntn, pn = pn0 + u % ntn;
        RowDense ra{A, lda, pm * 256, MTOT - 1}; auto e = mk(pm * 256, pn * BN);
        if (HALFN) gemm_tile<4, 4, 4, 2, NSW>(lds, ra, Bt + (size_t)pn * BN * K, K, K / 32, e);
        else gemm_tile<8, 4, 2, 4, NSW>(lds, ra, Bt + (size_t)pn * BN * K, K, K / 32, e);
    }
    const int nfull = (pmg * ntn + nslot - 1) / nslot;
    for (int pn = pn0; pn < pn1; ++pn) {
        const int owner = (pn - pn0) * 37 % nblk;
        if (bid == owner) { RowDense ra{A, lda, MREAL, MTOT - 1}; auto e = mk(MREAL, pn * BN);
            if (HALFN) gemm_tile<1, 4, 4, 2, NSW>(lds, ra, Bt + (size_t)pn * BN * K, K, K / 32, e);
            else gemm_tile<1, 4, 2, 4, NSW>(lds, ra, Bt + (size_t)pn * BN * K, K, K / 32, e); }
    }
    (void)nfull;
}

constexpr int PH_PROLOGUE = 0, PH_QKV = 1, PH_SWA = 2, PH_OPROJ0 = 3, PH_ROUTE0 = 4, PH_MOE0 = 5, PH_COMBINE = 6, PH_WIN = 7, PH_CEPI = 8, PH_UQKV = 9, PH_MLA = 10, PH_OPROJ1 = 11, PH_ROUTE1 = 12, PH_MOE1 = 13, PH_FINAL = 14, PH_N = 15;
__global__ void __launch_bounds__(NTHR, 2) mega(MArgs a) {
    extern __shared__ __attribute__((aligned(16))) unsigned char lds_raw[];
    LAS unsigned char* lds = (LAS unsigned char*)lds_raw;
    const int tid = threadIdx.x, bid = blockIdx.x, nblk = gridDim.x;
    volatile LAS unsigned* misc = (volatile LAS unsigned*)(lds + LDS_MISC);
    if (tid < 64) misc[tid] = 0u;
    __syncthreads();
    unsigned char* ws = a.ws;
    XcdBarrier bar = xcd_barrier_post((unsigned*)(ws + WS_BAR) + a.li * XCD_BAR_WORDS, misc);
    if (tid == 0) misc[4] = xb_add((unsigned*)(ws + 32 * 1024) + 64 * bar.x, 1u);
    const int lo = a.ph_lo, hi = a.ph_hi;
#define IN(k) (lo <= (k) && (k) < hi)
#define REP(k) for (int _rep = 0; _rep < ((k) == PROBE_PHASE ? 2 : 1); ++_rep, (void)((k) == PROBE_PHASE && _rep == 1 ? (xcd_barrier(bar), 0) : 0))
#define STAMP(i) do { if (PROBE_PHASE >= 600 && bid == 0 && tid == 0) ((unsigned long long*)(ws + 512 * 1024))[i] = __builtin_amdgcn_s_memrealtime(); } while (0)
#define SEAM(k) do { if (IN(k) && IN((k) + 1)) xcd_barrier(bar); STAMP((k) + 1); } while (0)
    STAMP(0);
    if (IN(PH_PROLOGUE)) REP(PH_PROLOGUE) p0_prologue(a, lds, bid, nblk);
    SEAM(PH_PROLOGUE);
    int vbid = bid;
    if (IN(PH_PROLOGUE) && IN(PH_QKV)) {
        if (tid == 0) { bool ok = (nblk % 8) == 0 && bar.x < 8;
            for (int j = 0; j < 8; ++j) ok = ok && xb_ld((unsigned*)(ws + 32 * 1024) + 64 * j) == (unsigned)(nblk / 8);
            misc[5] = ok ? misc[4] * 8u + bar.x : (unsigned)bid; }
        __syncthreads();
        vbid = __builtin_amdgcn_readfirstlane((int)misc[5]);
    }
#define bid vbid
    if (IN(PH_QKV)) REP(PH_QKV) {
        const float* rstd = (const float*)(ws + W2_RSTD); const float* bias = a.in[6]; const float2* cs = (const float2*)(ws + WS_ROPE); bf16_t* qkv = (bf16_t*)(ws + B_QKV); bf16_t* vt0 = (bf16_t*)(ws + B_VT0);
        const bf16_t* hbA = (const bf16_t*)(ws + W2_HB); const bf16_t* Wt = (const bf16_t*)(ws + W2_WQKV);
        const bool grp = (nblk % 8) == 0; const int x = grp ? bid % 8 : 0, j = grp ? bid / 8 : bid, nslot = grp ? nblk / 8 : nblk, pmg = grp ? 8 : 64;
        const bool usepg = nblk == 256;
        if (usepg) { pg8::Gemm g{hbA, Wt, MREAL, 1024, D}; pg8::StaticOrder S; S.init(MREAL, 1024, nblk, bid);
            PgEpiQ E{rstd, bias, cs, qkv};
            pg8::gemm_phase<PgEpiQ, pg8::StaticOrder, true, true>(lds, g, S, E); }
        for (int u = usepg ? pmg * 4 + j : j; u < pmg * 6; u += nslot) {
            if (u < pmg * 4) { const int pm = x * pmg + (u >> 2), pn = u & 3; RowDense ra{hbA, D, pm * 256, MTOT - 1}; EpiQKV e{rstd, bias, cs, qkv, pm * 256, pn * 256, true};
                gemm_tile<8, 4, 2, 4, false>(lds, ra, Wt + (size_t)pn * 256 * D, D, D / 32, e);
            } else if (u < pmg * 5) { const int pm = x * pmg + (u - pmg * 4); RowDense ra{hbA, D, pm * 256, MTOT - 1}; EpiQKV e{rstd, bias, cs, qkv, pm * 256, 1024, false};
                gemm_tile<4, 4, 4, 2, false>(lds, ra, Wt + (size_t)1024 * D, D, D / 32, e);
            } else { const int pm = x * pmg + (u - pmg * 5); RowDense ra{hbA, D, pm * 256, MTOT - 1}; EpiV0 e{rstd, bias, vt0, pm * 256, 1152};
                gemm_tile<4, 4, 4, 2, true>(lds, ra, Wt + (size_t)1152 * D, D, D / 32, e);
            }
        }
        const int mu = bid - (nblk - 6);
        if (mu >= 0 && mu < 4) { RowDense ra{hbA, D, MREAL, MTOT - 1}; EpiQKV e{rstd, bias, cs, qkv, MREAL, mu * 256, true};
            gemm_tile<1, 4, 2, 4, false>(lds, ra, Wt + (size_t)mu * 256 * D, D, D / 32, e);
        } else if (mu == 4) { RowDense ra{hbA, D, MREAL, MTOT - 1}; EpiQKV e{rstd, bias, cs, qkv, MREAL, 1024, false};
            gemm_tile<1, 4, 4, 2, false>(lds, ra, Wt + (size_t)1024 * D, D, D / 32, e);
        } else if (mu == 5) { RowDense ra{hbA, D, MREAL, MTOT - 1}; EpiV0 e{rstd, bias, vt0, MREAL, 1152};
            gemm_tile<1, 4, 4, 2, true>(lds, ra, Wt + (size_t)1152 * D, D, D / 32, e);
        }
    }
    SEAM(PH_QKV);
    if (IN(PH_SWA)) REP(PH_SWA) swa_phase(lds, (const bf16_t*)(ws + B_QKV), (const bf16_t*)(ws + B_VT0), a.in[7], (bf16_t*)(ws + B_O0), bid, nblk);
    SEAM(PH_SWA);
    if (IN(PH_OPROJ0)) REP(PH_OPROJ0) {
        const float* bias = a.in[9]; bf16_t* hb = (bf16_t*)(ws + W2_HB);
        if (nblk == 256) { pg8::Gemm g{(const bf16_t*)(ws + B_O0), (const bf16_t*)(ws + W2_WO0), MREAL, D, D}; pg8::StaticOrder S; S.init(MREAL, D, nblk, bid); PgEpiRes E{bias, hb};
            pg8::gemm_phase<PgEpiRes, pg8::StaticOrder, true, true>(lds, g, S, E);
            if ((bid & 15) == 5) { const int pc = bid >> 4; RowDense ra{(const bf16_t*)(ws + B_O0), D, MREAL, MTOT - 1}; EpiRes e{bias, hb, MREAL, pc * 64};
                gemm_tile<1, 1, 2, 4, false>(lds, ra, (const bf16_t*)(ws + W2_WO0) + (size_t)pc * 64 * D, D, D / 32, e); }
        } else
        gemm_phase<false, false>(lds, (const bf16_t*)(ws + B_O0), D, (const bf16_t*)(ws + W2_WO0), D, 0, 4, bid, nblk, [=](int m0, int n0) { return EpiRes{bias, hb, m0, n0}; });
    }
    SEAM(PH_OPROJ0);
    if (IN(PH_ROUTE0))
        route_phase(lds, (const bf16_t*)(ws + W2_HB), (const float*)(ws + W2_WRF), a.in[17], a.in[19], (float*)(ws + W2_RSTD), (int*)(ws + WS_CTL),
                    (int*)(ws + W2_LIST), (float*)(ws + W2_WSLOT), bid, nblk);
    SEAM(PH_ROUTE0);
    if (IN(PH_MOE0)) REP(PH_MOE0) moe_phase(lds, (int*)(ws + WS_CTL), (const int*)(ws + W2_LIST), (const bf16_t*)(ws + W2_HB), (const float*)(ws + W2_RSTD), (const float*)(ws + W2_WSLOT),
                               (const bf16_t*)(ws + C_W0), (const bf16_t*)(ws + C_W0 + MOE_WGU_BYTES), (bf16_t*)(ws + B_Y0), bid, nblk, (unsigned long long*)(ws + 512 * 1024));
    SEAM(PH_MOE0);
    if (IN(PH_COMBINE)) l1proj_phase(lds, (bf16_t*)(ws + W2_HB), (const bf16_t*)(ws + B_Y0), (const bf16_t*)(ws + W2_WIN), (const bf16_t*)(ws + W2_WUQ), (const bf16_t*)(ws + W2_WUKV),
                                     (const float2*)(ws + WS_ROPE), (bf16_t*)(ws + WS_KPE), (bf16_t*)(ws + C_Q1), (bf16_t*)(ws + C_K1), (bf16_t*)(ws + C_V1), bid, nblk);
    STAMP(PH_WIN); STAMP(PH_CEPI); STAMP(PH_UQKV);
    SEAM(PH_UQKV);
    if (IN(PH_MLA)) REP(100) {
        moe_weight_items(a.in[20] + (size_t)NE * D * DE, a.in[21] + (size_t)NE * D * DE, a.in[22] + (size_t)NE * DE * D, a.in[3] + D, (bf16_t*)(ws + B_W1), (bf16_t*)(ws + B_W1 + MOE_WGU_BYTES),
                         (LAS float*)lds, bid, nblk);
    }
    if (IN(PH_MLA)) REP(PH_MLA) mla_phase(lds, (const bf16_t*)(ws + C_Q1), (const bf16_t*)(ws + C_K1), (const bf16_t*)(ws + WS_KPE), (const bf16_t*)(ws + C_V1), (bf16_t*)(ws + B_O1), bid, nblk);
    SEAM(PH_MLA);
    if (IN(PH_OPROJ1)) REP(PH_OPROJ1) {
        bf16_t* hb = (bf16_t*)(ws + W2_HB);
        if (nblk == 256) { pg8::Gemm g{(const bf16_t*)(ws + B_O1), (const bf16_t*)(ws + W2_WO1), MREAL, D, D}; pg8::StaticOrder S; S.init(MREAL, D, nblk, bid); PgEpiRes E{nullptr, hb};
            pg8::gemm_phase<PgEpiRes, pg8::StaticOrder, true, true>(lds, g, S, E);
            if ((bid & 15) == 5) { const int pc = bid >> 4; RowDense ra{(const bf16_t*)(ws + B_O1), D, MREAL, MTOT - 1}; EpiRes e{nullptr, hb, MREAL, pc * 64};
                gemm_tile<1, 1, 2, 4, false>(lds, ra, (const bf16_t*)(ws + W2_WO1) + (size_t)pc * 64 * D, D, D / 32, e); }
        } else
        gemm_phase<false, false>(lds, (const bf16_t*)(ws + B_O1), D, (const bf16_t*)(ws + W2_WO1), D, 0, 4, bid, nblk, [=](int m0, int n0) { return EpiRes{nullptr, hb, m0, n0}; });
    }
    SEAM(PH_OPROJ1);
    if (IN(PH_ROUTE1))
        route_phase(lds, (const bf16_t*)(ws + W2_HB), (const float*)(ws + W2_WRF) + 36 * 1024, a.in[17] + 4, a.in[19] + 32, (float*)(ws + W2_RSTD), (int*)(ws + WS_CTL) + 2048,
                    (int*)(ws + W2_LIST), (float*)(ws + W2_WSLOT), bid, nblk);
    SEAM(PH_ROUTE1);
    if (IN(PH_MOE1)) REP(PH_MOE1) moe_phase(lds, (int*)(ws + WS_CTL) + 2048, (const int*)(ws + W2_LIST), (const bf16_t*)(ws + W2_HB), (const float*)(ws + W2_RSTD), (const float*)(ws + W2_WSLOT),
                               (const bf16_t*)(ws + B_W1), (const bf16_t*)(ws + B_W1 + MOE_WGU_BYTES), (bf16_t*)(ws + C_Y1), bid, nblk);
    SEAM(PH_MOE1);
    if (IN(PH_FINAL)) REP(PH_FINAL) final_phase((const bf16_t*)(ws + W2_HB), (const bf16_t*)(ws + C_Y1), a.in[4], a.out, bid, nblk);
#undef bid
#undef IN
#undef SEAM
}

static void run_mega(hipStream_t s, const MArgs& base, int lo, int hi, int grid) {
    MArgs a = base; a.ph_lo = lo; a.ph_hi = hi; a.li = lo;
    hipLaunchKernelGGL(mega, dim3(grid), dim3(NTHR), LDS_BYTES, s, a);
}
extern "C" void kernel_launch(void* const* d_in, const int* in_sizes, int n_in, void* d_out, int out_size, void* d_ws, size_t ws_size, hipStream_t stream) {
    static int grid = 0;
    if (grid == 0) {
        if (n_in != 23 || ws_size < WS_END) { fprintf(stderr, "kernel_launch: unexpected n_in %d or ws_size %zu\n", n_in, ws_size); grid = -1; return; }
        if (hipFuncSetAttribute((const void*)mega, hipFuncAttributeMaxDynamicSharedMemorySize, LDS_BYTES) != hipSuccess) { fprintf(stderr, "hipFuncSetAttribute failed\n"); grid = -1; return; }
        int dev = 0, cus = 0, per_cu = 0;
        (void)hipGetDevice(&dev); (void)hipDeviceGetAttribute(&cus, hipDeviceAttributeMultiprocessorCount, dev);
        (void)hipOccupancyMaxActiveBlocksPerMultiprocessor(&per_cu, (const void*)mega, NTHR, LDS_BYTES);
        (void)hipGetLastError();
        if (per_cu < 1 || cus < 8) { fprintf(stderr, "kernel_launch: occupancy query reports %d workgroups/CU on %d CUs for %d threads + %d B LDS; nothing launched\n", per_cu, cus, NTHR, LDS_BYTES); grid = -1; return; }
        grid = cus;
    }
    if (grid < 0) return;
    (void)in_sizes; (void)out_size;
    unsigned char* ws = (unsigned char*)d_ws;
    MArgs base{}; for (int i = 0; i < 23; ++i) base.in[i] = (const float*)d_in[i]; base.out = (float*)d_out; base.ws = ws;
    (void)hipMemsetAsync(ws + WS_CTL, 0, 1 * MiB, stream);
    run_mega(stream, base, 0, PH_N, grid);
}
```

```cpp
#include <hip/hip_runtime.h>
#ifndef PROBE_PHASE
#define PROBE_PHASE -1
#endif
#include <cstdio>
#include <cstdint>

typedef unsigned short bf16_t;

constexpr int D = 1024, SEQ = 8192, NB = 2, NMETA = 16;
constexpr int MREAL = NB * SEQ;
constexpr int MTOT = MREAL + NB * NMETA;
constexpr int LPOS = NMETA + SEQ;
constexpr int NQKV = 1280;
constexpr int NE = 32, DE = 256;
constexpr int CAP = MTOT * 2;
constexpr float EPS = 1e-6f;

__device__ __forceinline__ float bf2f(bf16_t v) { return __uint_as_float(((unsigned)v) << 16); }
__device__ __forceinline__ bf16_t f2bf(float f) { unsigned u = __float_as_uint(f); u += 0x7fffu + ((u >> 16) & 1u); return (bf16_t)(u >> 16); }
__device__ __forceinline__ int row_pos(int row) { return row < MREAL ? NMETA + (row & (SEQ - 1)) : ((row - MREAL) & (NMETA - 1)); }
__device__ __forceinline__ int row_batch(int row) { return row < MREAL ? (row >> 13) : ((row - MREAL) >> 4); }
constexpr int LP = 8256;
__device__ __forceinline__ int perm16(int p) { const int qd = (p >> 2) & 3; return (p & ~12) | ((((qd & 1) << 1) | (qd >> 1)) << 2); }
__device__ __forceinline__ float wave_sum(float v) {
#pragma unroll
    for (int o = 1; o < 64; o <<= 1) v += __shfl_xor(v, o);
    return v;
}

constexpr size_t MiB = 1u << 20;
constexpr size_t WS_CTL = 0;
constexpr size_t WS_ROPE = 1 * MiB;
constexpr size_t WS_END = 256 * MiB;

#define LAS __attribute__((address_space(3)))
#define GAS __attribute__((address_space(1)))
typedef short bf16x8 __attribute__((ext_vector_type(8)));
typedef float f32x4 __attribute__((ext_vector_type(4)));
typedef unsigned u32x4 __attribute__((ext_vector_type(4)));
typedef unsigned u32x2 __attribute__((ext_vector_type(2)));
constexpr int NTHR = 512, NWAVE = 8;
constexpr int LDS_MISC = 162816;
constexpr int LDS_BYTES = LDS_MISC + 1024;

constexpr size_t WS_BAR = 64 * 1024;
constexpr size_t WS_KPE = 3 * MiB + 256 * 1024;
constexpr size_t W2_RSTD = 4 * MiB + 512 * 1024, W2_WSLOT = W2_RSTD + 80 * 1024, W2_EID = W2_WSLOT + 144 * 1024;
constexpr size_t W2_LIST = 5 * MiB;
constexpr size_t W2_WRF = 9 * MiB + 256 * 1024;
constexpr size_t W2_WQKV = 10 * MiB;
constexpr size_t W2_WO0 = W2_WQKV + 2560 * 1024;
constexpr size_t W2_WIN = W2_WO0 + 2048 * 1024;
constexpr size_t W2_WUQ = W2_WIN + 1024 * 1024;
constexpr size_t W2_WUKV = W2_WUQ + 768 * 1024;
constexpr size_t W2_WO1 = W2_WUKV + 512 * 1024;
constexpr size_t W2_HB = 20 * MiB;
constexpr size_t W2_RB = 53 * MiB;
constexpr size_t W2_RC = 134 * MiB;
static_assert(W2_EID + (size_t)MTOT * 8 <= W2_LIST && W2_LIST + (size_t)NE * CAP * 4 <= W2_WRF && W2_WO1 + 2 * MiB <= W2_HB && W2_HB + (size_t)MTOT * 2048 <= W2_RB, "fixed map");
constexpr size_t B_QKV = W2_RB, B_O0 = W2_RB + 41 * MiB, B_VT0 = W2_RB + 74 * MiB  , B_Y0 = W2_RB, B_CBUF = W2_RB, B_CQN = W2_RB + 33 * MiB, B_CKVN = W2_RB + 42 * MiB, B_O1 = W2_RB, B_W1 = W2_RB + 33 * MiB;
constexpr size_t C_W0 = W2_RC, C_HF = W2_RC + 48 * MiB, C_Q1 = W2_RC, C_K1 = W2_RC + 49 * MiB, C_V1 = W2_RC + 82 * MiB, C_HF1 = W2_RC, C_Y1 = W2_RC;
static_assert(C_V1 + (size_t)2 * 16 * 64 * LP * 2 <= WS_END && C_K1 + (size_t)2 * LP * 2048 <= C_V1 && B_VT0 + (size_t)2 * 2 * 64 * LP * 2 <= W2_RC && C_HF + (size_t)MTOT * 4096 <= WS_END && B_W1 + 48 * MiB <= W2_RC, "region map");
constexpr size_t MOE_WGU_BYTES = (size_t)NE * 512 * 1024 * 2, MOE_WD_BYTES = (size_t)NE * 1024 * 256 * 2;

struct MArgs { const float* in[23]; float* out; unsigned char* ws; int ph_lo, ph_hi, li, pad; };

__device__ __forceinline__ unsigned pk2(float lo, float hi) { return (unsigned)f2bf(lo) | ((unsigned)f2bf(hi) << 16); }

#define XB_TMO      128
#define XB_XCNT(j)  (256  + 64 * (j))
#define XB_XSUB(j)  (1280 + 64 * (j))
#define XB_XGEN(j)  (2304 + 64 * (j))
#define XB_TOP      3328
#define XB_TOPGEN   3392
#define XCD_BAR_WORDS 3456
#define XB_SPIN_CAP (1u << 18)
__device__ __forceinline__ unsigned xb_ld(unsigned* p)              { return __hip_atomic_load(p, __ATOMIC_RELAXED, __HIP_MEMORY_SCOPE_AGENT); }
__device__ __forceinline__ unsigned xb_add(unsigned* p, unsigned v) { return __hip_atomic_fetch_add(p, v, __ATOMIC_RELAXED, __HIP_MEMORY_SCOPE_AGENT); }
__device__ __forceinline__ unsigned xb_xcc_id() { return (unsigned)__builtin_amdgcn_s_getreg((3 << 11) | 20) & 0xFu; }
#define XB_SPIN(cond, bar) do { unsigned _sp = 0; while (cond) { __builtin_amdgcn_s_sleep(1); \
    if ((++_sp & 255u) == 0u) { if (xb_ld(&(bar)[XB_TMO])) break; if (_sp > XB_SPIN_CAP) { atomicAdd(&(bar)[XB_TMO], 1u); break; } } } } while (0)
struct XcdBarrier { unsigned* bar; unsigned x; volatile LAS unsigned* st; };
__device__ __forceinline__ XcdBarrier xcd_barrier_post(unsigned* bar, volatile LAS unsigned* st) {
    XcdBarrier b; b.bar = bar; b.x = xb_xcc_id(); b.st = st;
    if (threadIdx.x == 0) (void)xb_add(&bar[XB_XCNT(b.x)], 1u);
    return b;
}
__device__ __forceinline__ void xcd_barrier_complete(unsigned* bar, unsigned x, unsigned& nloc, unsigned& nx) {
    const unsigned G = gridDim.x * gridDim.y * gridDim.z;
    unsigned sum, cnt, mine, sp = 0u;
    for (;;) {
        sum = 0u; cnt = 0u; mine = 0u;
#pragma unroll
        for (unsigned j = 0; j < 16; ++j) { const unsigned c = xb_ld(&bar[XB_XCNT(j)]); sum += c; cnt += (c > 0u) ? 1u : 0u; mine = (j == x) ? c : mine; }
        if (sum == G) break;
        __builtin_amdgcn_s_sleep(1);
        if ((++sp & 255u) == 0u) { if (xb_ld(&bar[XB_TMO])) break; if (sp > XB_SPIN_CAP) { atomicAdd(&bar[XB_TMO], 1u); break; } }
    }
    nloc = mine > 0u ? mine : 1u; nx = cnt > 0u ? cnt : 1u;
}
__device__ __forceinline__ void xcd_barrier(const XcdBarrier& b) {
    asm volatile("s_waitcnt vmcnt(0)" ::: "memory");
    __syncthreads();
    if (threadIdx.x == 0) {
        unsigned* bar = b.bar;
        __builtin_amdgcn_s_waitcnt(0);
        unsigned nloc = b.st[0], nx = b.st[1];
        if (nloc == 0u) { xcd_barrier_complete(bar, b.x, nloc, nx); b.st[0] = nloc; b.st[1] = nx; }
        const unsigned old = xb_add(&bar[XB_XSUB(b.x)], 1u);
        const unsigned gen = old / nloc;
        if (old + 1u == (gen + 1u) * nloc) {
            __builtin_amdgcn_fence(__ATOMIC_RELEASE, "agent");
            asm volatile("s_waitcnt vmcnt(0)" ::: "memory");
            const unsigned og = xb_add(&bar[XB_TOP], 1u);
            const unsigned tg = og / nx;
            if (og + 1u == (tg + 1u) * nx) xb_add(&bar[XB_TOPGEN], 1u);
            else XB_SPIN(xb_ld(&bar[XB_TOPGEN]) == tg, bar);
            __builtin_amdgcn_fence(__ATOMIC_ACQUIRE, "agent");
            xb_add(&bar[XB_XGEN(b.x)], 1u);
            asm volatile("s_waitcnt vmcnt(0)" ::: "memory");
        } else {
            XB_SPIN(xb_ld(&bar[XB_XGEN(b.x)]) == gen, bar);
            __builtin_amdgcn_fence(__ATOMIC_ACQUIRE, "agent");
            asm volatile("s_waitcnt vmcnt(0)" ::: "memory");
        }
    }
    __syncthreads();
}

template <int N> __device__ __forceinline__ void wait_vm() { asm volatile("s_waitcnt vmcnt(%0)" :: "n"(N) : "memory"); }
__device__ __forceinline__ int swzF(int g) { return (0x78 >> (2 * g)) & 3; }
constexpr int GT_NS = 4;
template <int MT, int NT, int WM, int WN, bool NSW, class RowA, class Epi, bool NOLD = false>
__device__ __forceinline__ void gemm_tile(LAS unsigned char* lds, const RowA& rowA, const bf16_t* __restrict__ Bt, int ldb  , int nk  , Epi& epi) {
    constexpr int BM = WM * MT * 16, BN = WN * NT * 16, GA = BM / 16, G = (BM + BN) / 16, NG = (G + 7) / 8, GR = G % 8, STAGE = (BM + BN) * 64;
    static_assert(WM * WN == 8 && GT_NS * STAGE <= LDS_MISC && BM % 16 == 0 && BN % 16 == 0, "gemm_tile config");
    const int tid = threadIdx.x, lane = tid & 63, wave = __builtin_amdgcn_readfirstlane(tid >> 6), wm = wave / WN, wn = wave % WN;
    const char* src[NG];
    const int lc = (lane & 3) ^ swzF(lane >> 4);
#pragma unroll
    for (int i = 0; i < NG; ++i) {
        const int g = wave + 8 * i;
        if (g < GA) src[i] = (const char*)rowA(g * 16 + (lane >> 2)) + lc * 16;
        else if (g < G) src[i] = (const char*)(Bt + (size_t)((g - GA) * 16 + (lane >> 2)) * ldb) + lc * 16;
        else src[i] = nullptr;
    }
    f32x4 acc[MT][NT];
#pragma unroll
    for (int mi = 0; mi < MT; ++mi)
#pragma unroll
        for (int ni = 0; ni < NT; ++ni) acc[mi][ni] = (f32x4){0.f, 0.f, 0.f, 0.f};
    const int fro = (lane & 15) * 64 + (((lane >> 4) ^ swzF((lane >> 2) & 3)) << 4);
    constexpr int LM = PROBE_PHASE == 402 ? 2 : 1;
#define GT_STAGE(st, kt) do { _Pragma("unroll") for (int _i = 0; _i < NG; ++_i) { const int _g = wave + 8 * _i; if (_g < G) { \
        __builtin_amdgcn_global_load_lds((const unsigned*)(src[_i] + (size_t)(kt) * 64), (LAS unsigned*)(lds + (st) * STAGE + _g * 1024), 16, 0, 0); \
        if (LM == 2) __builtin_amdgcn_global_load_lds((const unsigned*)(src[_i] + (size_t)(kt) * 64), (LAS unsigned*)(lds + (st) * STAGE + _g * 1024), 16, 0, 0); } } } while (0)
#define GT_WAIT(ntl) do { if (GR == 0 || wave < GR) wait_vm<LM * NG * (ntl)>(); else wait_vm<LM * (NG - 1) * (ntl)>(); } while (0)
    if (!NOLD) { GT_STAGE(0, 0);
    if (nk > 1) GT_STAGE(1, 1);
    if (nk > 2) GT_STAGE(2, 2); }
    int st = 0;
    for (int kt = 0; kt < nk; ++kt) {
        const int rem = nk - 1 - kt;
        if (!NOLD) { if (rem >= 2) GT_WAIT(2); else if (rem == 1) GT_WAIT(1); else GT_WAIT(0); }
        __builtin_amdgcn_s_barrier(); asm volatile("" ::: "memory");
        const bool doload = (!NOLD || PROBE_PHASE == 505) && kt + 3 < nk;
        LAS const unsigned char* sa = lds + st * STAGE + (wm * MT * 16) * 64 + fro;
        LAS const unsigned char* sb = lds + st * STAGE + (BM + wn * NT * 16) * 64 + fro;
        bf16x8 bfr[NT];
#pragma unroll
        for (int ni = 0; ni < NT; ++ni) bfr[ni] = *(LAS const bf16x8*)(sb + ni * 1024);
        constexpr int PG = MT >= 2 ? 2 : 1, NPG = MT / PG;
        constexpr int LPG = (NG + NPG - 1) / NPG;
        bf16x8 afc[PG], afn[PG];
#pragma unroll
        for (int i = 0; i < PG; ++i) afc[i] = *(LAS const bf16x8*)(sa + i * 1024);
#pragma unroll
        for (int pg = 0; pg < NPG; ++pg) {
            if (doload) {
#pragma unroll
                for (int l = 0; l < LPG; ++l) { const int _i = pg * LPG + l; if (_i < NG) { const int _g = wave + 8 * _i; if (_g < G)
                    __builtin_amdgcn_global_load_lds((const unsigned*)(src[_i] + (size_t)(kt + 3) * 64), (LAS unsigned*)(lds + ((st + 3) & 3) * STAGE + _g * 1024), 16, 0, 0); } }
            }
            if (pg + 1 < NPG) {
#pragma unroll
                for (int i = 0; i < PG; ++i) afn[i] = *(LAS const bf16x8*)(sa + ((pg + 1) * PG + i) * 1024);
            }
#pragma unroll
            for (int i = 0; i < PG; ++i) { const int mi = pg * PG + i;
#pragma unroll
                for (int ni = 0; ni < NT; ++ni) {
                    if (NSW) acc[mi][ni] = __builtin_amdgcn_mfma_f32_16x16x32_bf16(afc[i], bfr[ni], acc[mi][ni], 0, 0, 0);
                    else acc[mi][ni] = __builtin_amdgcn_mfma_f32_16x16x32_bf16(bfr[ni], afc[i], acc[mi][ni], 0, 0, 0);
                } }
#pragma unroll
            for (int i = 0; i < PG; ++i) afc[i] = afn[i];
            __builtin_amdgcn_sched_barrier(0);
        }
        st = (st + 1) & 3;
    }
#undef GT_STAGE
#undef GT_WAIT
    epi(acc, wm * MT * 16, wn * NT * 16, lane);
    asm volatile("s_waitcnt lgkmcnt(0)" ::: "memory");
    __syncthreads();
}

struct RowDense { const bf16_t* A; int lda, m0, mlast; __device__ __forceinline__ const bf16_t* operator()(int r) const { int row = m0 + r; row = row > mlast ? mlast : row; return A + (size_t)row * lda; } };

namespace pg8 {
#define PG8_LAS __attribute__((address_space(3)))
typedef unsigned short bf16_t;
typedef short bf16x8 __attribute__((ext_vector_type(8)));
typedef float f32x4 __attribute__((ext_vector_type(4)));
typedef unsigned u32x4 __attribute__((ext_vector_type(4)));
constexpr int BM = 256, BK = 64, HALF = 128, HTB = HALF * BK * 2  , STAGE_BYTES = 8 * HTB, NXCD = 8, WGM = 8;

__host__ __device__ __forceinline__ int lds_byte(int r, int c) { const int st = (r >> 4) * 2 + (c >> 5), rr = r & 15, cc = c & 31, ob = rr * 64 + cc * 2; return st * 1024 + (ob ^ (((ob >> 9) & 1) << 5)); }
__host__ __device__ __forceinline__ void stage_rc(int b, int& R, int& C) { const int st = b / 1024, sb = b % 1024, swz = sb ^ (((sb >> 9) & 1) << 5); R = (st >> 1) * 16 + swz / 64; C = (st & 1) * 32 + (swz % 64) / 2; }
__host__ __device__ __forceinline__ int perm32(int rho) { const int n = rho >> 4, i = rho & 15; return 8 * (i >> 2) + 4 * n + (i & 3); }

struct Unit { int pm, pn; };
struct Gemm { const bf16_t* A; const bf16_t* Bt; int M, N, K; };

struct StaticOrder {
    int nM, nN, nwg, G, c;
    __host__ __device__ void init(int M, int N, int G_, int c_) { nM = M / BM; nN = N / BM; nwg = nM * nN; G = G_; c = c_; }
    __host__ __device__ bool next(int i, Unit& u) const {
        const long L = (long)i * G + c; if (L >= nwg) return false;
        int wgid = (int)L; { const int q = nwg / NXCD, r = nwg % NXCD, xcd = wgid % NXCD, off = wgid / NXCD; wgid = (xcd < r ? xcd * (q + 1) : r * (q + 1) + (xcd - r) * q) + off; }
        const int nig = WGM * nN, gid = wgid / nig, fm = gid * WGM, gsz = (nM - fm) < WGM ? (nM - fm) : WGM;
        u.pm = fm + ((wgid % nig) % gsz); u.pn = (wgid % nig) / gsz; return true;
    }
    __device__ __forceinline__ void a_ready(const Unit&) const {}
    __device__ __forceinline__ void done(const Unit&) const {}
};


template <class Epi, class Sched, bool ALIGN_EPI = false, bool SP2 = false>
__device__ __forceinline__ void gemm_phase(PG8_LAS unsigned char* lds, const Gemm g, const Sched& S, const Epi& E) {
    const int tid = threadIdx.x, wid = __builtin_amdgcn_readfirstlane(tid >> 6), lane = tid & 63, wr = wid >> 2, wc = wid & 3, fr = lane & 15, fq = lane >> 4;
    const int K = g.K, nt = K / BK;
    unsigned voffA[2], voffB[2];
#pragma unroll
    for (int i = 0; i < 2; ++i) { int R, C; stage_rc(tid * 16 + i * 8192, R, C); const int Rb = Epi::PERM ? ((R & ~31) + perm32(R & 31)) : R;
        voffA[i] = (unsigned)(R * K + C) * 2u; voffB[i] = (unsigned)(Rb * K + C) * 2u; }
    const size_t kstep = (size_t)(BK * 2);
    const size_t hstep = (size_t)HALF * K * 2;
    const size_t tstep = 2 * hstep;
    const unsigned ldsw = (unsigned)wid * 1024u;
    const int aoff = lds_byte(wr * 64 + fr, fq * 8), boff = lds_byte(wc * 32 + fr, fq * 8);
#define PG8_SA(b, h) (((b) * 2 + (h)) * HTB)
#define PG8_SB(b, h) ((4 + (b) * 2 + (h)) * HTB)
#define PG8_STAGE(bufoff, gbase, voff) do { _Pragma("unroll") for (int _i = 0; _i < 2; ++_i) \
        __builtin_amdgcn_global_load_lds((const unsigned*)((const char*)(gbase) + (voff)[_i]), (PG8_LAS unsigned*)(lds + (bufoff) + ldsw + _i * 8192), 16, 0, 0); } while (0)
#define PG8_LDA(dst, b, h) do { _Pragma("unroll") for (int m = 0; m < 4; ++m) _Pragma("unroll") for (int k = 0; k < 2; ++k) dst[m][k] = *(const PG8_LAS bf16x8*)(lds + PG8_SA(b, h) + aoff + m * 2048 + k * 1024); } while (0)
#define PG8_LDB(dst, b, h) do { _Pragma("unroll") for (int n = 0; n < 2; ++n) _Pragma("unroll") for (int k = 0; k < 2; ++k) dst[n][k] = *(const PG8_LAS bf16x8*)(lds + PG8_SB(b, h) + boff + n * 2048 + k * 1024); } while (0)
#define PG8_MMA(ai, bj, At, Bt) do { __builtin_amdgcn_s_setprio(1); _Pragma("unroll") for (int m = 0; m < 4; ++m) _Pragma("unroll") for (int n = 0; n < 2; ++n) _Pragma("unroll") for (int k = 0; k < 2; ++k) \
        acc[ai][bj][m][n] = __builtin_amdgcn_mfma_f32_16x16x32_bf16(Bt[n][k], At[m][k], acc[ai][bj][m][n], 0, 0, 0); __builtin_amdgcn_s_setprio(0); } while (0)
#define PG8_WAIT_V(n) asm volatile("s_waitcnt vmcnt(" #n ")" ::: "memory")
#define PG8_WAIT_L(n) asm volatile("s_waitcnt lgkmcnt(" #n ")" ::: "memory")
#define PG8_BAR __builtin_amdgcn_s_barrier()
#define PG8_SCHED __builtin_amdgcn_sched_barrier(0)
    Unit cur, nxt; int ui = 0;
    if (!S.next(0, cur)) return;
    f32x4 acc[2][2][4][2];
#pragma unroll
    for (int a = 0; a < 2; ++a)
#pragma unroll
        for (int b = 0; b < 2; ++b)
#pragma unroll
            for (int m = 0; m < 4; ++m)
#pragma unroll
                for (int n = 0; n < 2; ++n) acc[a][b][m][n] = (f32x4){0.f, 0.f, 0.f, 0.f};
    bf16x8 At[4][2], B0[2][2], B1[2][2];
    const char* cA = (const char*)g.A + (size_t)cur.pm * tstep; const char* cB = (const char*)g.Bt + (size_t)cur.pn * tstep;
    S.a_ready(cur);
    if constexpr (SP2) {
        PG8_STAGE(PG8_SB(0, 0), cB, voffB); PG8_STAGE(PG8_SB(0, 1), cB + hstep, voffB); PG8_STAGE(PG8_SA(0, 0), cA, voffA); PG8_STAGE(PG8_SA(0, 1), cA + hstep, voffA);
        if (wr == 1) PG8_BAR;
        PG8_WAIT_V(2); PG8_BAR;
        PG8_STAGE(PG8_SB(1, 0), cB + kstep, voffB); PG8_STAGE(PG8_SA(1, 0), cA + kstep, voffA); PG8_STAGE(PG8_SB(1, 1), cB + hstep + kstep, voffB);
        PG8_WAIT_V(6); PG8_BAR;
    } else {
        PG8_STAGE(PG8_SB(0, 0), cB, voffB); PG8_STAGE(PG8_SA(0, 0), cA, voffA); PG8_STAGE(PG8_SB(0, 1), cB + hstep, voffB); PG8_STAGE(PG8_SA(0, 1), cA + hstep, voffA);
        if (wr == 1) PG8_BAR;
        PG8_WAIT_V(4); PG8_BAR;
        PG8_STAGE(PG8_SB(1, 0), cB + kstep, voffB); PG8_STAGE(PG8_SA(1, 0), cA + kstep, voffA); PG8_STAGE(PG8_SB(1, 1), cB + hstep + kstep, voffB);
        PG8_WAIT_V(6); PG8_BAR;
    }
    for (;;) {
        const bool has_next = S.next(ui + 1, nxt);
        const char* nA = has_next ? (const char*)g.A + (size_t)nxt.pm * tstep : cA; const char* nB = has_next ? (const char*)g.Bt + (size_t)nxt.pn * tstep : cB;
        for (int t = 0; t < nt; t += 2) {
            const bool last = (t == nt - 2);
            const char* a1 = cA + (size_t)(t + 1) * kstep;
            const char* a2 = last ? nA : cA + (size_t)(t + 2) * kstep; const char* b2 = last ? nB : cB + (size_t)(t + 2) * kstep;
            const char* a3 = a2 + kstep; const char* b3 = b2 + kstep;
            if (last && has_next) S.a_ready(nxt);
            if constexpr (SP2) {
            PG8_LDB(B0, 0, 0); PG8_LDB(B1, 0, 1); PG8_SCHED; PG8_LDA(At, 0, 0); PG8_STAGE(PG8_SA(1, 1), a1 + hstep, voffA);
            PG8_WAIT_V(8); PG8_WAIT_L(0); PG8_BAR; PG8_MMA(0, 0, At, B0); PG8_MMA(0, 1, At, B1); PG8_BAR; PG8_SCHED;
            PG8_LDA(At, 0, 1); PG8_STAGE(PG8_SB(0, 0), b2, voffB); PG8_STAGE(PG8_SB(0, 1), b2 + hstep, voffB); PG8_STAGE(PG8_SA(0, 0), a2, voffA);
            PG8_WAIT_V(8); PG8_WAIT_L(0); PG8_BAR; PG8_MMA(1, 0, At, B0); PG8_MMA(1, 1, At, B1); PG8_BAR; PG8_SCHED;
            PG8_LDB(B0, 1, 0); PG8_LDB(B1, 1, 1); PG8_SCHED; PG8_LDA(At, 1, 0); PG8_STAGE(PG8_SA(0, 1), a2 + hstep, voffA);
            PG8_WAIT_V(8); PG8_WAIT_L(0); PG8_BAR; PG8_MMA(0, 0, At, B0); PG8_MMA(0, 1, At, B1); PG8_BAR; PG8_SCHED;
            PG8_LDA(At, 1, 1); PG8_STAGE(PG8_SB(1, 0), b3, voffB); PG8_STAGE(PG8_SB(1, 1), b3 + hstep, voffB); PG8_STAGE(PG8_SA(1, 0), a3, voffA);
            PG8_WAIT_V(8); PG8_WAIT_L(0); PG8_BAR; PG8_MMA(1, 0, At, B0); PG8_MMA(1, 1, At, B1); PG8_BAR; PG8_SCHED;
            } else {
            PG8_LDB(B0, 0, 0); PG8_SCHED; PG8_LDA(At, 0, 0); PG8_STAGE(PG8_SA(1, 1), a1 + hstep, voffA);
            PG8_WAIT_L(8); PG8_BAR; PG8_WAIT_L(0); PG8_MMA(0, 0, At, B0); PG8_BAR; PG8_SCHED;
            PG8_LDB(B1, 0, 1); PG8_STAGE(PG8_SB(0, 0), b2, voffB);
            PG8_BAR; PG8_WAIT_L(0); PG8_MMA(0, 1, At, B1); PG8_BAR;
            PG8_LDA(At, 0, 1); PG8_STAGE(PG8_SA(0, 0), a2, voffA);
            PG8_BAR; PG8_WAIT_L(0); PG8_MMA(1, 0, At, B0); PG8_BAR; PG8_SCHED;
            PG8_STAGE(PG8_SB(0, 1), b2 + hstep, voffB);
            PG8_WAIT_V(6); PG8_BAR; PG8_MMA(1, 1, At, B1); PG8_BAR;
            PG8_LDB(B0, 1, 0); PG8_SCHED; PG8_LDA(At, 1, 0); PG8_STAGE(PG8_SA(0, 1), a2 + hstep, voffA);
            PG8_WAIT_L(8); PG8_BAR; PG8_WAIT_L(0); PG8_MMA(0, 0, At, B0); PG8_BAR; PG8_SCHED;
            PG8_LDB(B1, 1, 1); PG8_STAGE(PG8_SB(1, 0), b3, voffB);
            PG8_BAR; PG8_WAIT_L(0); PG8_MMA(0, 1, At, B1); PG8_BAR;
            PG8_LDA(At, 1, 1); PG8_STAGE(PG8_SA(1, 0), a3, voffA);
            PG8_BAR; PG8_WAIT_L(0); PG8_MMA(1, 0, At, B0); PG8_BAR; PG8_SCHED;
            PG8_STAGE(PG8_SB(1, 1), b3 + hstep, voffB);
            PG8_WAIT_V(6); PG8_BAR; PG8_MMA(1, 1, At, B1); PG8_BAR;
            }
        }
        if constexpr (ALIGN_EPI) { if (wr == 0) PG8_BAR; }
        if constexpr (!Epi::AFTER_DRAIN) { E(acc, cur, wr, wc, fr, fq); S.done(cur); }
        if (!has_next) break;
#pragma unroll
        for (int a = 0; a < 2; ++a)
#pragma unroll
            for (int b = 0; b < 2; ++b)
#pragma unroll
                for (int m = 0; m < 4; ++m)
#pragma unroll
                    for (int n = 0; n < 2; ++n) acc[a][b][m][n] = (f32x4){0.f, 0.f, 0.f, 0.f};
        cur = nxt; cA = nA; cB = nB; ++ui;
        if constexpr (ALIGN_EPI) { if (wr == 1) PG8_BAR; }
    }
    PG8_WAIT_V(0);
    if constexpr (!ALIGN_EPI) { if (wr == 0) PG8_BAR; }
    PG8_BAR;
    if constexpr (Epi::AFTER_DRAIN) { E.fused(acc, cur, wr, wc, fr, fq, lds, wid, lane); S.done(cur); }
#undef PG8_SA
#undef PG8_SB
#undef PG8_STAGE
#undef PG8_LDA
#undef PG8_LDB
#undef PG8_MMA
#undef PG8_WAIT_V
#undef PG8_WAIT_L
#undef PG8_BAR
#undef PG8_SCHED
}
}

struct PgEpiRes {
    static constexpr bool PERM = false, AFTER_DRAIN = false;
    const float* bias; unsigned short* hb;
    __device__ __forceinline__ void operator()(const pg8::f32x4 (&acc)[2][2][4][2], const pg8::Unit& u, int wr, int wc, int fr, int fq) const {
#pragma unroll
        for (int ai = 0; ai < 2; ++ai)
#pragma unroll
            for (int m = 0; m < 4; ++m) { const int row = u.pm * 256 + ai * 128 + wr * 64 + m * 16 + fr;
#pragma unroll
                for (int bj = 0; bj < 2; ++bj)
#pragma unroll
                    for (int n = 0; n < 2; ++n) { const int col = u.pn * 256 + bj * 128 + wc * 32 + n * 16 + fq * 4;
                        u32x2* p = (u32x2*)(hb + (size_t)row * D + col); const u32x2 h = *p; pg8::f32x4 v = acc[ai][bj][m][n];
                        if (bias) v += *(const pg8::f32x4*)(bias + col);
                        v[0] += __uint_as_float(h.x << 16); v[1] += __uint_as_float(h.x & 0xffff0000u); v[2] += __uint_as_float(h.y << 16); v[3] += __uint_as_float(h.y & 0xffff0000u);
                        *p = (u32x2){pk2(v[0], v[1]), pk2(v[2], v[3])}; } }
    }
};
struct PgEpiQ {
    static constexpr bool PERM = false, AFTER_DRAIN = false;
    const float* rstd; const float* bias; const float2* cs; unsigned short* qkv;
    __device__ __forceinline__ void operator()(const pg8::f32x4 (&acc)[2][2][4][2], const pg8::Unit& u, int wr, int wc, int fr, int fq) const {
#pragma unroll
        for (int ai = 0; ai < 2; ++ai)
#pragma unroll
            for (int m = 0; m < 4; ++m) { const int row = u.pm * 256 + ai * 128 + wr * 64 + m * 16 + fr; const float rs = rstd[row]; const int pos = row_pos(row);
#pragma unroll
                for (int bj = 0; bj < 2; ++bj) { const int g = 8 * u.pn + 4 * bj + wc, hh = g >> 1, d = 16 * (g & 1) + 4 * fq;
                    const pg8::f32x4 b1 = *(const pg8::f32x4*)(bias + 64 * hh + d), b2 = *(const pg8::f32x4*)(bias + 64 * hh + 32 + d);
                    float o1[4], o2[4];
#pragma unroll
                    for (int r = 0; r < 4; ++r) { const float2 t = cs[pos * 32 + d + r]; const float x1 = acc[ai][bj][m][0][r] * rs + b1[r], x2 = acc[ai][bj][m][1][r] * rs + b2[r];
                        o1[r] = (x1 * t.x - x2 * t.y) * 0.125f; o2[r] = (x2 * t.x + x1 * t.y) * 0.125f; }
                    unsigned short* orow = qkv + (size_t)row * NQKV + 64 * hh + d;
                    *(u32x2*)orow = (u32x2){pk2(o1[0], o1[1]), pk2(o1[2], o1[3])}; *(u32x2*)(orow + 32) = (u32x2){pk2(o2[0], o2[1]), pk2(o2[2], o2[3])}; } }
    }
};

struct EpiQKV {
    const float* rstd; const float* bias; const float2* cs; bf16_t* qkv; int m0, n0; bool perm;
    template <int MT, int NT> __device__ __forceinline__ void operator()(f32x4 (&acc)[MT][NT], int mb, int nb, int lane) const {
        static_assert(NT == 4, "rope needs a 64-column wave span");
        const int cb = n0 + nb, d0 = (lane >> 4) * 4;
#pragma unroll
        for (int mi = 0; mi < MT; ++mi) {
            const int row = m0 + mb + mi * 16 + (lane & 15);
            if (row < MTOT) {
                const float rs = rstd[row]; const int pos = row_pos(row);
                bf16_t* orow = qkv + (size_t)row * NQKV + cb;
                {
                    const float sc = cb < 1024 ? 0.125f : 1.0f;
#pragma unroll
                    for (int ni = 0; ni < 2; ++ni) {
                        const int d = ni * 16 + d0;
                        const f32x4 b1 = *(const f32x4*)(bias + cb + d), b2 = *(const f32x4*)(bias + cb + 32 + d);
                        const f32x4 a1 = perm ? acc[mi][2 * ni] : acc[mi][ni], a2 = perm ? acc[mi][2 * ni + 1] : acc[mi][ni + 2];
                        float o1[4], o2[4];
#pragma unroll
                        for (int r = 0; r < 4; ++r) {
                            const float2 t = cs[pos * 32 + d + r];
                            const float x1 = a1[r] * rs + b1[r], x2 = a2[r] * rs + b2[r];
                            o1[r] = (x1 * t.x - x2 * t.y) * sc; o2[r] = (x2 * t.x + x1 * t.y) * sc;
                        }
                        *(u32x2*)(orow + d) = (u32x2){pk2(o1[0], o1[1]), pk2(o1[2], o1[3])};
                        *(u32x2*)(orow + 32 + d) = (u32x2){pk2(o2[0], o2[1]), pk2(o2[2], o2[3])};
                    }
                }
            }
        }
    }
};
struct EpiV0 {
    const float* rstd; const float* bias; bf16_t* vt0; int m0, n0;
    template <int MT, int NT> __device__ __forceinline__ void operator()(f32x4 (&acc)[MT][NT], int mb, int nb, int lane) const {
        static_assert(NT == 4, "64-column wave span");
        const int cb = n0 + nb, kh = (cb - 1152) >> 6;
#pragma unroll
        for (int mi = 0; mi < MT; ++mi) {
            const int row0 = m0 + mb + mi * 16 + (lane >> 4) * 4;
            if (row0 < MTOT) {
                const f32x4 rs = *(const f32x4*)(rstd + row0); const int b = row_batch(row0), pp = perm16(row_pos(row0));
#pragma unroll
                for (int ni = 0; ni < NT; ++ni) { const int d = ni * 16 + (lane & 15); const float bb = bias[cb + d];
                    const f32x4 v = acc[mi][ni] * rs + bb;
                    *(u32x2*)(vt0 + (size_t)((b * 2 + kh) * 64 + d) * LP + pp) = (u32x2){pk2(v[0], v[1]), pk2(v[2], v[3])}; }
            }
        }
    }
};
struct EpiRes {
    const float* bias; bf16_t* hb; int m0, n0;
    template <int MT, int NT> __device__ __forceinline__ void operator()(f32x4 (&acc)[MT][NT], int mb, int nb, int lane) const {
#pragma unroll
        for (int mi = 0; mi < MT; ++mi) {
            const int row = m0 + mb + mi * 16 + (lane & 15);
            if (row < MTOT) {
#pragma unroll
                for (int ni = 0; ni < NT; ++ni) {
                    const int col = n0 + nb + ni * 16 + (lane >> 4) * 4;
                    u32x2* p = (u32x2*)(hb + (size_t)row * D + col);
                    const u32x2 h = *p;
                    f32x4 v = acc[mi][ni];
                    if (bias) v += *(const f32x4*)(bias + col);
                    v[0] += __uint_as_float(h.x << 16); v[1] += __uint_as_float(h.x & 0xffff0000u); v[2] += __uint_as_float(h.y << 16); v[3] += __uint_as_float(h.y & 0xffff0000u);
                    *p = (u32x2){pk2(v[0], v[1]), pk2(v[2], v[3])};
                }
            }
        }
    }
};
__device__ __forceinline__ void route_phase(LAS unsigned char* lds, const bf16_t* __restrict__ hbr, const float* __restrict__ wrf, const float* __restrict__ bg, const float* __restrict__ br,
                                            float* rstd_out, int* cnt, int* list, float* wslot, int bid, int nblk) {
    const int tid = threadIdx.x, lane = tid & 63, wave = __builtin_amdgcn_readfirstlane(tid >> 6);
    LAS f32x4* wl = (LAS f32x4*)lds;
    LAS int* nrec = (LAS int*)(lds + LDS_MISC + 16); LAS int* bcnt = (LAS int*)(lds + LDS_MISC + 32); LAS int* bbase = (LAS int*)(lds + LDS_MISC + 160); LAS int* rec = (LAS int*)(lds + LDS_MISC + 288);
    for (int i = tid; i < 36 * 256; i += NTHR) wl[i] = *(const f32x4*)(wrf + (size_t)i * 4);
    if (tid < NE) bcnt[tid] = 0;
    if (tid == 0) *nrec = 0;
    __syncthreads();
    for (int row = bid * NWAVE + wave; row < MTOT; row += nblk * NWAVE) {
        f32x4 x[4]; float ss = 0.f;
#pragma unroll
        for (int j = 0; j < 4; ++j) { const u32x2 h = *(const u32x2*)(hbr + (size_t)row * D + j * 256 + lane * 4);
            x[j] = (f32x4){__uint_as_float(h.x << 16), __uint_as_float(h.x & 0xffff0000u), __uint_as_float(h.y << 16), __uint_as_float(h.y & 0xffff0000u)};
            ss += x[j][0] * x[j][0] + x[j][1] * x[j][1] + x[j][2] * x[j][2] + x[j][3] * x[j][3]; }
        ss = wave_sum(ss);
        const float rs = rsqrtf(ss * (1.0f / D) + EPS);
        float lg[4];
#pragma unroll
        for (int c = 0; c < 4; ++c) { float p = 0.f;
#pragma unroll
            for (int j = 0; j < 4; ++j) { const f32x4 w = wl[c * 256 + j * 64 + lane]; p += x[j][0] * w[0] + x[j][1] * w[1] + x[j][2] * w[2] + x[j][3] * w[3]; }
            lg[c] = wave_sum(p) * rs + bg[c]; }
        int gi = 0; float gm = lg[0];
#pragma unroll
        for (int c = 1; c < 4; ++c) if (lg[c] > gm) { gm = lg[c]; gi = c; }
        float gs = 0.f;
#pragma unroll
        for (int c = 0; c < 4; ++c) gs += __expf(lg[c] - gm);
        const float gp = 1.0f / gs;
        gi = __builtin_amdgcn_readfirstlane(gi);
        float e[8];
#pragma unroll
        for (int c = 0; c < 8; ++c) { float p = 0.f;
#pragma unroll
            for (int j = 0; j < 4; ++j) { const f32x4 w = wl[(4 + gi * 8 + c) * 256 + j * 64 + lane]; p += x[j][0] * w[0] + x[j][1] * w[1] + x[j][2] * w[2] + x[j][3] * w[3]; }
            e[c] = wave_sum(p) * rs + br[gi * 8 + c]; }
        int i1 = 0; float v1 = e[0];
#pragma unroll
        for (int c = 1; c < 8; ++c) if (e[c] > v1) { v1 = e[c]; i1 = c; }
        int i2 = -1; float v2 = -3.0e38f;
#pragma unroll
        for (int c = 0; c < 8; ++c) if (c != i1 && e[c] > v2) { v2 = e[c]; i2 = c; }
        if (lane == 0) {
            const float r = __expf(v2 - v1);
            const float w1 = gp / (1.0f + r), w2 = gp * r / (1.0f + r);
            const int e1 = gi * 8 + i1, e2 = gi * 8 + i2;
            const int p1 = atomicAdd((int*)&bcnt[e1], 1), p2 = atomicAdd((int*)&bcnt[e2], 1);
            const int k = atomicAdd((int*)nrec, 2);
            rec[k] = ((row * 2) << 13) | (e1 << 8) | p1; rec[k + 1] = ((row * 2 + 1) << 13) | (e2 << 8) | p2;
            wslot[row * 2] = w1; wslot[row * 2 + 1] = w2; rstd_out[row] = rs;
        }
    }
    __syncthreads();
    if (tid < NE) { const int c = bcnt[tid]; bbase[tid] = c ? __hip_atomic_fetch_add(cnt + tid * 64, c, __ATOMIC_RELAXED, __HIP_MEMORY_SCOPE_AGENT) : 0; }
    __syncthreads();
    for (int k = tid; k < *nrec; k += NTHR) { const int r = rec[k], e = (r >> 8) & 31; list[(size_t)e * CAP + bbase[e] + (r & 255)] = r >> 13; }
    __syncthreads();
}
__device__ __forceinline__ void final_phase(const bf16_t* __restrict__ hb, const bf16_t* __restrict__ ybuf, const float* __restrict__ g, float* out, int bid, int nblk) {
    const int tid = threadIdx.x, lane = tid & 63, wave = tid >> 6;
    for (int row = bid * NWAVE + wave; row < MREAL; row += nblk * NWAVE) {
        f32x4 v[4]; float ss = 0.f;
#pragma unroll
        for (int j = 0; j < 4; ++j) { const size_t c = j * 256 + lane * 4;
            const u32x2 h = *(const u32x2*)(hb + (size_t)row * D + c), y0 = *(const u32x2*)(ybuf + (size_t)(row * 2) * D + c), y1 = *(const u32x2*)(ybuf + (size_t)(row * 2 + 1) * D + c);
            v[j][0] = __uint_as_float(h.x << 16) + __uint_as_float(y0.x << 16) + __uint_as_float(y1.x << 16);
            v[j][1] = __uint_as_float(h.x & 0xffff0000u) + __uint_as_float(y0.x & 0xffff0000u) + __uint_as_float(y1.x & 0xffff0000u);
            v[j][2] = __uint_as_float(h.y << 16) + __uint_as_float(y0.y << 16) + __uint_as_float(y1.y << 16);
            v[j][3] = __uint_as_float(h.y & 0xffff0000u) + __uint_as_float(y0.y & 0xffff0000u) + __uint_as_float(y1.y & 0xffff0000u);
            ss += v[j][0] * v[j][0] + v[j][1] * v[j][1] + v[j][2] * v[j][2] + v[j][3] * v[j][3]; }
        const float rs = rsqrtf(wave_sum(ss) * (1.0f / D) + EPS);
#pragma unroll
        for (int j = 0; j < 4; ++j) { const f32x4 gg = *(const f32x4*)(g + j * 256 + lane * 4); *(f32x4*)(out + (size_t)row * D + j * 256 + lane * 4) = v[j] * rs * gg; }
    }
}

typedef float f32x16 __attribute__((ext_vector_type(16)));
constexpr int AT_STAGE = 20480;
__device__ __forceinline__ unsigned cvtpk(float lo, float hi) { typedef float f2 __attribute__((ext_vector_type(2))); typedef __bf16 b2 __attribute__((ext_vector_type(2)));
    f2 v = {lo, hi}; b2 r = __builtin_convertvector(v, b2); return __builtin_bit_cast(unsigned, r); }
__device__ __forceinline__ float max3f(float a, float b, float c) { float r; asm("v_max3_f32 %0, %1, %2, %3" : "=v"(r) : "v"(a), "v"(b), "v"(c)); return r; }
__device__ __forceinline__ float max2f(float a, float b) { float r; asm("v_max_f32_e32 %0, %1, %2" : "=v"(r) : "v"(a), "v"(b)); return r; }
__device__ __forceinline__ float fadd_s(float a, float b) { float r; asm("v_add_f32_e32 %0, %1, %2" : "=v"(r) : "v"(a), "v"(b)); return r; }
__device__ __forceinline__ void mla_unit(LAS unsigned char* lds, int b, int h, int qi, const bf16_t* __restrict__ Q1, const bf16_t* __restrict__ K1, const bf16_t* __restrict__ kpe,
                                         const bf16_t* __restrict__ VT1, bf16_t* o) {
    const int tid = threadIdx.x, lane = tid & 63, wave = __builtin_amdgcn_readfirstlane(tid >> 6), r32 = lane & 31, hi = lane >> 5;
    const size_t qrow = (size_t)b * SEQ + 256 * qi + 32 * wave + r32;
    bf16x8 qf[6];
#pragma unroll
    for (int s = 0; s < 6; ++s) qf[s] = *(const bf16x8*)(Q1 + qrow * 1536 + h * 96 + 16 * s + 8 * hi);
    const int lr = 8 * wave + (lane >> 3);
    const char* ksrc = (const char*)(K1 + ((size_t)b * LP + lr) * 1024 + h * 64) + (((lane & 7) ^ ((lr >> 1) & 7)) << 4);
    const char* vsrc = (const char*)(VT1 + ((size_t)(b * 16 + h) * 64 + lr) * LP) + (((lane & 7) ^ ((lr >> 1) & 7)) << 4);
    const int pr = 16 * wave + (lane >> 2);
    const char* psrc = (const char*)(kpe + ((size_t)b * LP + (pr & 63)) * 32) + (((lane & 3) ^ ((pr >> 2) & 3)) << 4);
#define MLA_ISSUE(j, st) do { \
        __builtin_amdgcn_global_load_lds((const unsigned*)(ksrc + (size_t)(j) * (64 * 2048)), (LAS unsigned*)(lds + (st) * AT_STAGE + wave * 1024), 16, 0, 0); \
        __builtin_amdgcn_global_load_lds((const unsigned*)(vsrc + (size_t)(j) * 128), (LAS unsigned*)(lds + (st) * AT_STAGE + 8192 + wave * 1024), 16, 0, 0); \
        if (wave < 4) __builtin_amdgcn_global_load_lds((const unsigned*)(psrc + (size_t)(j) * (64 * 64)), (LAS unsigned*)(lds + (st) * AT_STAGE + 16384 + wave * 1024), 16, 0, 0); } while (0)
    const int NT = 4 * qi + 5, jmaxw = 4 * qi + ((32 * wave + 47) >> 6);
    const int qp = 16 + 256 * qi + 32 * wave + r32;
    const int koff = r32 * 128, ksw = (r32 >> 1) & 7, poff = 16384 + r32 * 64, psw = (r32 >> 2) & 3, voff = 8192 + r32 * 128;
    f32x16 oacc[2]; oacc[0] = (f32x16){}; oacc[1] = (f32x16){};
    constexpr float MLA_THR = 8.0f;
    float mref = 0.f, lsum = 0.f;
    f32x16 negm = (f32x16){};
    MLA_ISSUE(0, 0);
    if (NT > 1) MLA_ISSUE(1, 1);
    int st = 0;
    for (int j = 0; j < NT; ++j) {
        if (j + 1 < NT) { if (wave < 4) asm volatile("s_waitcnt vmcnt(3)" ::: "memory"); else asm volatile("s_waitcnt vmcnt(2)" ::: "memory"); }
        else asm volatile("s_waitcnt vmcnt(0)" ::: "memory");
        __builtin_amdgcn_s_barrier(); asm volatile("" ::: "memory");
        if (j + 2 < NT) { const int st2 = st >= 1 ? st - 1 : 2; MLA_ISSUE(j + 2, st2); }
        if (j <= jmaxw) {
            LAS const unsigned char* sb = lds + st * AT_STAGE;
            f32x16 p0, p1;
            {
                const bf16x8 k0 = *(LAS const bf16x8*)(sb + koff + ((hi ^ ksw) << 4));
                const bf16x8 k1 = *(LAS const bf16x8*)(sb + 4096 + koff + ((hi ^ ksw) << 4));
                p0 = __builtin_amdgcn_mfma_f32_32x32x16_bf16(k0, qf[0], negm, 0, 0, 0);
                p1 = __builtin_amdgcn_mfma_f32_32x32x16_bf16(k1, qf[0], negm, 0, 0, 0);
            }
#pragma unroll
            for (int s = 1; s < 4; ++s) {
                const bf16x8 k0 = *(LAS const bf16x8*)(sb + koff + (((2 * s + hi) ^ ksw) << 4));
                const bf16x8 k1 = *(LAS const bf16x8*)(sb + 4096 + koff + (((2 * s + hi) ^ ksw) << 4));
                p0 = __builtin_amdgcn_mfma_f32_32x32x16_bf16(k0, qf[s], p0, 0, 0, 0);
                p1 = __builtin_amdgcn_mfma_f32_32x32x16_bf16(k1, qf[s], p1, 0, 0, 0);
            }
#pragma unroll
            for (int s = 0; s < 2; ++s) {
                const bf16x8 k0 = *(LAS const bf16x8*)(sb + poff + (((2 * s + hi) ^ psw) << 4));
                const bf16x8 k1 = *(LAS const bf16x8*)(sb + 2048 + poff + (((2 * s + hi) ^ psw) << 4));
                p0 = __builtin_amdgcn_mfma_f32_32x32x16_bf16(k0, qf[4 + s], p0, 0, 0, 0);
                p1 = __builtin_amdgcn_mfma_f32_32x32x16_bf16(k1, qf[4 + s], p1, 0, 0, 0);
            }
            if (j >= 4 * qi) {
                const int kb0 = 64 * j + 4 * hi;
#pragma unroll
                for (int r = 0; r < 16; ++r) { const int kp = kb0 + (r & 3) + 8 * (r >> 2); if (kp > qp) p0[r] = -1e30f; if (kp + 32 > qp) p1[r] = -1e30f; }
            }
            asm volatile("s_nop 15\n\ts_nop 7" : "+v"(p0), "+v"(p1));
            float tm;
            { float ma = max3f(p0[0], p0[1], p1[0]), mb = max3f(p0[2], p0[3], p1[1]); ma = max3f(ma, p1[2], p1[3]);
#pragma unroll
              for (int r = 4; r < 16; r += 4) { ma = max3f(ma, p0[r], p0[r + 1]); mb = max3f(mb, p0[r + 2], p0[r + 3]); ma = max3f(ma, p1[r], p1[r + 1]); mb = max3f(mb, p1[r + 2], p1[r + 3]); }
              tm = max2f(ma, mb); }
            { auto rr = __builtin_amdgcn_permlane32_swap(__float_as_uint(tm), __float_as_uint(tm), false, false);
              tm = fmaxf(__uint_as_float(rr[0]), __uint_as_float(rr[1])); }
            if (j == 0 || __any(tm > MLA_THR)) {
                const float dl = j == 0 ? tm : fmaxf(tm, 0.f);
                mref += dl;
                const float f = __builtin_amdgcn_exp2f(-dl);
                lsum *= f;
#pragma unroll
                for (int r = 0; r < 16; ++r) { oacc[0][r] *= f; oacc[1][r] *= f; p0[r] -= dl; p1[r] -= dl; negm[r] = -mref; }
            }
            float ps = 0.f;
#pragma unroll
            for (int r = 0; r < 16; ++r) { p0[r] = __builtin_amdgcn_exp2f(p0[r]); p1[r] = __builtin_amdgcn_exp2f(p1[r]); }
            asm volatile("s_nop 1" : "+v"(p0), "+v"(p1));
#pragma unroll
            for (int r = 0; r < 16; ++r) { ps = fadd_s(ps, p0[r]); ps = fadd_s(ps, p1[r]); }
            lsum += ps;
            u32x4 pf[4];
            pf[0] = (u32x4){cvtpk(p0[0], p0[1]), cvtpk(p0[2], p0[3]), cvtpk(p0[4], p0[5]), cvtpk(p0[6], p0[7])};
            pf[1] = (u32x4){cvtpk(p0[8], p0[9]), cvtpk(p0[10], p0[11]), cvtpk(p0[12], p0[13]), cvtpk(p0[14], p0[15])};
            pf[2] = (u32x4){cvtpk(p1[0], p1[1]), cvtpk(p1[2], p1[3]), cvtpk(p1[4], p1[5]), cvtpk(p1[6], p1[7])};
            pf[3] = (u32x4){cvtpk(p1[8], p1[9]), cvtpk(p1[10], p1[11]), cvtpk(p1[12], p1[13]), cvtpk(p1[14], p1[15])};
#pragma unroll
            for (int s = 0; s < 4; ++s) {
                const bf16x8 v0 = *(LAS const bf16x8*)(sb + voff + (((2 * s + hi) ^ ksw) << 4));
                const bf16x8 v1 = *(LAS const bf16x8*)(sb + 4096 + voff + (((2 * s + hi) ^ ksw) << 4));
                const bf16x8 pb = __builtin_bit_cast(bf16x8, pf[s]);
                oacc[0] = __builtin_amdgcn_mfma_f32_32x32x16_bf16(v0, pb, oacc[0], 0, 0, 0);
                oacc[1] = __builtin_amdgcn_mfma_f32_32x32x16_bf16(v1, pb, oacc[1], 0, 0, 0);
            }
        }
        st = st == 2 ? 0 : st + 1;
    }
#undef MLA_ISSUE
    lsum += __shfl_xor(lsum, 32);
    const float inv = 1.0f / lsum;
    bf16_t* orow = o + qrow * D + h * 64 + 4 * hi;
#pragma unroll
    for (int db = 0; db < 2; ++db)
#pragma unroll
        for (int g = 0; g < 4; ++g)
            *(u32x2*)(orow + 32 * db + 8 * g) = (u32x2){cvtpk(oacc[db][4 * g] * inv, oacc[db][4 * g + 1] * inv), cvtpk(oacc[db][4 * g + 2] * inv, oacc[db][4 * g + 3] * inv)};
    asm volatile("s_waitcnt lgkmcnt(0)" ::: "memory");
    __builtin_amdgcn_s_barrier(); asm volatile("" ::: "memory");
}
__device__ __forceinline__ void unpack8(const u32x4 v, float (&f)[8]) {
    f[0] = __uint_as_float(v.x << 16); f[1] = __uint_as_float(v.x & 0xffff0000u); f[2] = __uint_as_float(v.y << 16); f[3] = __uint_as_float(v.y & 0xffff0000u);
    f[4] = __uint_as_float(v.z << 16); f[5] = __uint_as_float(v.z & 0xffff0000u); f[6] = __uint_as_float(v.w << 16); f[7] = __uint_as_float(v.w & 0xffff0000u);
}
__device__ __forceinline__ void mla_meta(int b, int h, const bf16_t* __restrict__ Q1, const bf16_t* __restrict__ K1, const bf16_t* __restrict__ kpe, const bf16_t* __restrict__ VT1, bf16_t* o, int lane) {
    const int qi = lane & 15, part = lane >> 4; const size_t qrow = (size_t)MREAL + b * 16 + qi;
    float q[24];
#pragma unroll
    for (int c = 0; c < 3; ++c) { float f[8]; unpack8(*(const u32x4*)(Q1 + qrow * 1536 + h * 96 + 24 * part + 8 * c), f);
#pragma unroll
        for (int i = 0; i < 8; ++i) q[8 * c + i] = f[i]; }
    float sc[16]; float mx = -1e30f;
#pragma unroll
    for (int j = 0; j < 16; ++j) {
        const size_t kr = (size_t)b * LP + j; float s = 0.f;
#pragma unroll
        for (int c = 0; c < 3; ++c) { const int g = 24 * part + 8 * c;
            const bf16_t* src = g < 64 ? K1 + kr * D + h * 64 + g : kpe + kr * 32 + (g - 64);
            float f[8]; unpack8(*(const u32x4*)src, f);
#pragma unroll
            for (int i = 0; i < 8; ++i) s += q[8 * c + i] * f[i]; }
        s += __shfl_xor(s, 16); s += __shfl_xor(s, 32);
        sc[j] = j <= qi ? s : -1e30f; mx = fmaxf(mx, sc[j]);
    }
    float l = 0.f;
#pragma unroll
    for (int j = 0; j < 16; ++j) { sc[j] = exp2f(sc[j] - mx); l += sc[j]; }
    const float inv = 1.0f / l;
#pragma unroll
    for (int dd = 0; dd < 16; ++dd) { const int d = 16 * part + dd; const bf16_t* vr = VT1 + ((size_t)(b * 16 + h) * 64 + d) * LP;
        float e[16]; { float f[8]; unpack8(*(const u32x4*)vr, f);
#pragma unroll
            for (int i = 0; i < 8; ++i) e[i] = f[i]; unpack8(*(const u32x4*)(vr + 8), f);
#pragma unroll
            for (int i = 0; i < 8; ++i) e[8 + i] = f[i]; }
        float acc = 0.f;
#pragma unroll
        for (int j = 0; j < 16; ++j) acc += sc[j] * e[(j & 3) | ((((j >> 2) & 1) << 1 | ((j >> 3) & 1)) << 2)];
        o[qrow * D + h * 64 + d] = f2bf(acc * inv); }
}
__device__ __forceinline__ void mla_phase(LAS unsigned char* lds, const bf16_t* Q1, const bf16_t* K1, const bf16_t* kpe, const bf16_t* VT1, bf16_t* o, int bid, int nblk) {
    const int v = (nblk % 8 == 0) ? (bid % 8) * (nblk / 8) + bid / 8 : bid;
    for (int vv = v; vv < 256; vv += nblk) {
        const int bh = vv >> 3, s = vv & 7, b = bh >> 4, h = bh & 15;
#pragma unroll 1
        for (int i = 0; i < 4; ++i) { const int qi = (i == 0) ? s : (i == 1) ? 15 - s : (i == 2) ? 16 + s : 31 - s; mla_unit(lds, b, h, qi, Q1, K1, kpe, VT1, o); }
        if (s == 0 && threadIdx.x < 64) mla_meta(b, h, Q1, K1, kpe, VT1, o, threadIdx.x);
    }
}

constexpr int SW_K = 0, SW_V = 36864, SW_VP = 560;
__device__ __forceinline__ void swa_block32(LAS const unsigned char* lds, int rb, int gk0, int nks, int mode, int i_q, const bf16x8 (&qf)[4], float& m, float& lsum, f32x16 (&oacc)[2], int r32, int hi) {
    const float C2 = 1.4426950408889634f;
    const int ksw = (r32 >> 1) & 7;
    f32x16 p = (f32x16){};
#pragma unroll
    for (int s = 0; s < 4; ++s) { const bf16x8 k = *(LAS const bf16x8*)(lds + SW_K + (rb + r32) * 128 + (((2 * s + hi) ^ ksw) << 4)); p = __builtin_amdgcn_mfma_f32_32x32x16_bf16(k, qf[s], p, 0, 0, 0); }
    if (mode != 0) {
        const int jb = ((rb - 32) & 127) + 4 * hi;
#pragma unroll
        for (int r = 0; r < 16; ++r) { const int kk = (r & 3) + 8 * (r >> 2);
            const bool ok = mode == 1 ? (kk + 4 * hi < 16) : mode == 2 ? (jb + kk > i_q) : (jb + kk <= i_q);
            if (!ok) p[r] = -1e30f; }
    }
    float tm = p[0];
#pragma unroll
    for (int r = 1; r < 16; ++r) tm = fmaxf(tm, p[r]);
    tm = fmaxf(tm, __shfl_xor(tm, 32));
    const float mn = fmaxf(m, tm), alpha = __builtin_amdgcn_exp2f((m - mn) * C2), nmc = -mn * C2;
    m = mn;
    float ps = 0.f;
#pragma unroll
    for (int r = 0; r < 16; ++r) { p[r] = __builtin_amdgcn_exp2f(__builtin_fmaf(p[r], C2, nmc)); ps += p[r]; }
    lsum = lsum * alpha + ps;
#pragma unroll
    for (int r = 0; r < 16; ++r) { oacc[0][r] *= alpha; oacc[1][r] *= alpha; }
    u32x4 pf[2];
    pf[0] = (u32x4){cvtpk(p[0], p[1]), cvtpk(p[2], p[3]), cvtpk(p[4], p[5]), cvtpk(p[6], p[7])};
    pf[1] = (u32x4){cvtpk(p[8], p[9]), cvtpk(p[10], p[11]), cvtpk(p[12], p[13]), cvtpk(p[14], p[15])};
#pragma unroll
    for (int ks = 0; ks < 2; ++ks) if (ks < nks) {
        const bf16x8 v0 = *(LAS const bf16x8*)(lds + SW_V + r32 * SW_VP + (gk0 + ks) * 32 + hi * 16);
        const bf16x8 v1 = *(LAS const bf16x8*)(lds + SW_V + (32 + r32) * SW_VP + (gk0 + ks) * 32 + hi * 16);
        const bf16x8 pb = __builtin_bit_cast(bf16x8, pf[ks]);
        oacc[0] = __builtin_amdgcn_mfma_f32_32x32x16_bf16(v0, pb, oacc[0], 0, 0, 0);
        oacc[1] = __builtin_amdgcn_mfma_f32_32x32x16_bf16(v1, pb, oacc[1], 0, 0, 0);
    }
}
__device__ __forceinline__ void swa_unit(LAS unsigned char* lds, int b, int n, int kh, const bf16_t* __restrict__ qkv, const bf16_t* __restrict__ VT0, const float* __restrict__ sinks, bf16_t* o) {
    const int tid = threadIdx.x, lane = tid & 63, wave = __builtin_amdgcn_readfirstlane(tid >> 6), r32 = lane & 31, hi = lane >> 5;
    for (int idx = tid; idx < 2176; idx += NTHR) {
        const int row = idx >> 3, c = idx & 7;
        if (row < 16 || n > 0 || row >= 144) {
            const size_t srow = row < 16 ? (size_t)MREAL + b * 16 + row : (size_t)b * SEQ + 128 * (n - 1) + (row - 16);
            const int lrow = row < 16 ? row : 16 + row;
            const u32x4 v = *(const u32x4*)(qkv + srow * NQKV + 1024 + kh * 64 + c * 8);
            *(LAS u32x4*)(lds + SW_K + lrow * 128 + ((c ^ ((lrow >> 1) & 7)) << 4)) = v;
        }
    }
    for (int idx = tid; idx < 2176; idx += NTHR) {
        const int d = idx / 34, c = idx % 34;
        if (c < 2 || n > 0 || c >= 18) {
            const bf16_t* src = VT0 + (size_t)((b * 2 + kh) * 64 + d) * LP + (c < 2 ? c * 8 : 16 + 128 * (n - 1) + (c - 2) * 8);
            *(LAS u32x4*)(lds + SW_V + d * SW_VP + c * 16) = *(const u32x4*)src;
        }
    }
    __syncthreads();
    const int hq = kh * 8 + wave;
    const float sink = sinks[hq];
#pragma unroll 1
    for (int qs = 0; qs < 4; ++qs) {
        const size_t qrow = (size_t)b * SEQ + 128 * n + 32 * qs + r32;
        bf16x8 qf[4];
#pragma unroll
        for (int s = 0; s < 4; ++s) qf[s] = *(const bf16x8*)(qkv + qrow * NQKV + hq * 64 + 16 * s + 8 * hi);
        f32x16 oacc[2]; oacc[0] = (f32x16){}; oacc[1] = (f32x16){};
        float m = sink, lsum = hi == 0 ? 1.0f : 0.0f;
        const int i_q = 32 * qs + r32;
        swa_block32(lds, 0, 0, 1, 1, i_q, qf, m, lsum, oacc, r32, hi);
        if (n > 0) {
            swa_block32(lds, 32 + 32 * qs, 1 + 2 * qs, 2, 2, i_q, qf, m, lsum, oacc, r32, hi);
#pragma unroll 1
            for (int kb = qs + 1; kb < 4; ++kb) swa_block32(lds, 32 + 32 * kb, 1 + 2 * kb, 2, 0, i_q, qf, m, lsum, oacc, r32, hi);
        }
#pragma unroll 1
        for (int kb = 0; kb < qs; ++kb) swa_block32(lds, 160 + 32 * kb, 9 + 2 * kb, 2, 0, i_q, qf, m, lsum, oacc, r32, hi);
        swa_block32(lds, 160 + 32 * qs, 9 + 2 * qs, 2, 3, i_q, qf, m, lsum, oacc, r32, hi);
        lsum += __shfl_xor(lsum, 32);
        const float inv = 1.0f / lsum;
        bf16_t* orow = o + qrow * D + hq * 64 + 4 * hi;
#pragma unroll
        for (int db = 0; db < 2; ++db)
#pragma unroll
            for (int g = 0; g < 4; ++g)
                *(u32x2*)(orow + 32 * db + 8 * g) = (u32x2){cvtpk(oacc[db][4 * g] * inv, oacc[db][4 * g + 1] * inv), cvtpk(oacc[db][4 * g + 2] * inv, oacc[db][4 * g + 3] * inv)};
    }
    __syncthreads();
}
__device__ __forceinline__ void swa_meta(int b, int hq, const bf16_t* __restrict__ qkv, const bf16_t* __restrict__ VT0, const float* __restrict__ sinks, bf16_t* o, int lane) {
    const int qi = lane & 15, part = lane >> 4, kh = hq >> 3; const size_t qrow = (size_t)MREAL + b * 16 + qi;
    float q[16];
#pragma unroll
    for (int c = 0; c < 2; ++c) { float f[8]; unpack8(*(const u32x4*)(qkv + qrow * NQKV + hq * 64 + 16 * part + 8 * c), f);
#pragma unroll
        for (int i = 0; i < 8; ++i) q[8 * c + i] = f[i]; }
    const float sink = sinks[hq];
    float sc[16]; float mx = sink;
#pragma unroll
    for (int j = 0; j < 16; ++j) {
        const size_t kr = (size_t)MREAL + b * 16 + j; float s = 0.f;
#pragma unroll
        for (int c = 0; c < 2; ++c) { float f[8]; unpack8(*(const u32x4*)(qkv + kr * NQKV + 1024 + kh * 64 + 16 * part + 8 * c), f);
#pragma unroll
            for (int i = 0; i < 8; ++i) s += q[8 * c + i] * f[i]; }
        s += __shfl_xor(s, 16); s += __shfl_xor(s, 32);
        sc[j] = j <= qi ? s : -1e30f; mx = fmaxf(mx, sc[j]);
    }
    float l = __expf(sink - mx);
#pragma unroll
    for (int j = 0; j < 16; ++j) { sc[j] = __expf(sc[j] - mx); l += sc[j]; }
    const float inv = 1.0f / l;
#pragma unroll
    for (int dd = 0; dd < 16; ++dd) { const int d = 16 * part + dd; const bf16_t* vr = VT0 + ((size_t)(b * 2 + kh) * 64 + d) * LP;
        float e[16]; { float f[8]; unpack8(*(const u32x4*)vr, f);
#pragma unroll
            for (int i = 0; i < 8; ++i) e[i] = f[i]; unpack8(*(const u32x4*)(vr + 8), f);
#pragma unroll
            for (int i = 0; i < 8; ++i) e[8 + i] = f[i]; }
        float acc = 0.f;
#pragma unroll
        for (int j = 0; j < 16; ++j) acc += sc[j] * e[(j & 3) | ((((j >> 2) & 1) << 1 | ((j >> 3) & 1)) << 2)];
        o[qrow * D + hq * 64 + d] = f2bf(acc * inv); }
}
__device__ __forceinline__ void swa_phase(LAS unsigned char* lds, const bf16_t* qkv, const bf16_t* VT0, const float* sinks, bf16_t* o, int bid, int nblk) {
    for (int u = bid; u < 256; u += nblk) {
        const int b = u >> 7, n = (u >> 1) & 63, kh = u & 1;
        swa_unit(lds, b, n, kh, qkv, VT0, sinks, o);
        if (n == 0) swa_meta(b, kh * 8 + (threadIdx.x >> 6), qkv, VT0, sinks, o, threadIdx.x & 63);
    }
}

template <int MOE_MT>
__device__ __forceinline__ void moe_unit(LAS unsigned char* lds, int e, int s0, int ns, const int* __restrict__ list, const bf16_t* __restrict__ hb, const float* __restrict__ rstd,
                                         const float* __restrict__ wslot, const bf16_t* __restrict__ wgu, const bf16_t* __restrict__ wd, bf16_t* ybuf, unsigned long long* tsb = nullptr) {
#define MSTAMP(i) do { if (PROBE_PHASE >= 600 && tsb && blockIdx.x == 0 && threadIdx.x == 0) tsb[i] = __builtin_amdgcn_s_memrealtime(); } while (0)
    MSTAMP(20);
    constexpr int MOE_BM = 16 * MOE_MT, MOE_HT = MOE_BM * 128, MOE_B2 = 2 * MOE_HT, MOE_ST2 = 32768, MOE_HLO = MOE_B2 + 2 * MOE_ST2, MOE_INFO = MOE_HLO + 2 * MOE_HT;
    static_assert(MOE_B2 + 2 * MOE_ST2 <= MOE_HLO && MOE_INFO + 3072 <= LDS_MISC, "moe lds");
#define moe_hoff(kt) ((kt) < 4 ? MOE_HLO + (kt) * (MOE_HT / 2) : ((kt) - 4) * (MOE_HT / 2))
    const int tid = threadIdx.x, lane = tid & 63, wave = __builtin_amdgcn_readfirstlane(tid >> 6);
    LAS int* slotl = (LAS int*)(lds + MOE_INFO); LAS float* rsl = (LAS float*)(lds + MOE_INFO + 1024); LAS float* wl = (LAS float*)(lds + MOE_INFO + 2048);
    if (tid < MOE_BM) { const int sl = list[(size_t)e * CAP + s0 + (tid < ns ? tid : 0)]; slotl[tid] = sl; rsl[tid] = rstd[sl >> 1]; wl[tid] = wslot[sl]; }
    __syncthreads();
    const int lc4 = (lane & 3) ^ swzF(lane >> 4);
    const int fro32 = (lane & 15) * 64 + (((lane >> 4) ^ swzF((lane >> 2) & 3)) << 4);
    {
        constexpr int ST = (MOE_BM + 512) * 64, GA = MOE_BM / 16, G = GA + 32, NG = (G + 7) / 8;
        static_assert(2 * ST <= MOE_HLO && 2 * MOE_HT <= ST, "moe gemm1 lds");
        const char* src[NG];
#pragma unroll
        for (int i = 0; i < NG; ++i) { const int g = wave + 8 * i;
            if (g < GA) src[i] = (const char*)(hb + (size_t)(slotl[g * 16 + (lane >> 2)] >> 1) * D) + lc4 * 16;
            else if (g < G) src[i] = (const char*)(wgu + (size_t)((g - GA) * 16 + (lane >> 2)) * D) + lc4 * 16;
            else src[i] = nullptr; }
        f32x4 acc[MOE_MT][4];
#pragma unroll
        for (int mi = 0; mi < MOE_MT; ++mi)
#pragma unroll
            for (int ni = 0; ni < 4; ++ni) acc[mi][ni] = (f32x4){0.f, 0.f, 0.f, 0.f};
#define M1_STAGE(st, step) do { _Pragma("unroll") for (int _i = 0; _i < NG; ++_i) { const int _g = wave + 8 * _i; if (_g < G) \
        __builtin_amdgcn_global_load_lds((const unsigned*)(src[_i] + (size_t)(step) * 64), (LAS unsigned*)(lds + (st) * ST + _g * 1024), 16, 0, 0); } } while (0)
        M1_STAGE(0, 0);
        for (int step = 0; step < 32; ++step) {
            asm volatile("s_waitcnt vmcnt(0)" ::: "memory");
            __syncthreads();
            if (step + 1 < 32) M1_STAGE((step + 1) & 1, step + 1);
            LAS const unsigned char* sa = lds + (step & 1) * ST + fro32;
            LAS const unsigned char* sb = lds + (step & 1) * ST + (MOE_BM + wave * 64) * 64 + fro32;
            bf16x8 bfr[4];
#pragma unroll
            for (int ni = 0; ni < 4; ++ni) bfr[ni] = *(LAS const bf16x8*)(sb + ni * 1024);
#pragma unroll
            for (int mi = 0; mi < MOE_MT; ++mi) { const bf16x8 af = *(LAS const bf16x8*)(sa + mi * 1024);
#pragma unroll
                for (int ni = 0; ni < 4; ++ni) acc[mi][ni] = __builtin_amdgcn_mfma_f32_16x16x32_bf16(bfr[ni], af, acc[mi][ni], 0, 0, 0); }
        }
#undef M1_STAGE
        int lane_h = threadIdx.x & 63; asm volatile("" : "+v"(lane_h));
#define lane lane_h
#pragma unroll
        for (int p = 0; p < 2; ++p) {
            const int n = 32 * wave + 16 * p + (lane >> 4) * 4;
            const int csw = ((n & 31) >> 3);
#pragma unroll
            for (int mi = 0; mi < MOE_MT; ++mi) { const int row = mi * 16 + (lane & 15); const float rs = rsl[row]; float hv[4];
#pragma unroll
                for (int r = 0; r < 4; ++r) { const float g = acc[mi][2 * p][r] * rs, u = acc[mi][2 * p + 1][r] * rs; hv[r] = g / (1.0f + __expf(-g)) * u; }
                *(LAS u32x2*)(lds + moe_hoff(n >> 5) + row * 64 + ((csw ^ swzF((row >> 2) & 3)) << 4) + (n & 4) * 2) = (u32x2){pk2(hv[0], hv[1]), pk2(hv[2], hv[3])}; }
        }
#undef lane
    }
    __syncthreads();
    MSTAMP(21);
    {
        const char* src2[4];
#pragma unroll
        for (int i = 0; i < 4; ++i) src2[i] = (const char*)(wd + (size_t)((wave + 8 * i) * 16 + (lane >> 2)) * DE) + lc4 * 16;
        f32x4 acc[MOE_MT][4];
#pragma unroll
        for (int mi = 0; mi < MOE_MT; ++mi)
#pragma unroll
            for (int ni = 0; ni < 4; ++ni) acc[mi][ni] = (f32x4){0.f, 0.f, 0.f, 0.f};
#define M2_STAGE(st, q) do { _Pragma("unroll") for (int _i = 0; _i < 4; ++_i) \
        __builtin_amdgcn_global_load_lds((const unsigned*)(src2[_i] + (size_t)((q) >> 3) * (512 * 512) + (size_t)((q) & 7) * 64), (LAS unsigned*)(lds + MOE_B2 + (st) * MOE_ST2 + (wave + 8 * _i) * 1024), 16, 0, 0); } while (0)
        M2_STAGE(0, 0);
        for (int q = 0; q < 16; ++q) {
            asm volatile("s_waitcnt vmcnt(0)" ::: "memory");
            __syncthreads();
            if (q + 1 < 16) M2_STAGE((q + 1) & 1, q + 1);
            LAS const unsigned char* sa = lds + moe_hoff(q & 7) + fro32;
            LAS const unsigned char* sb = lds + MOE_B2 + (q & 1) * MOE_ST2 + (wave * 64) * 64 + fro32;
            bf16x8 bfr[4];
#pragma unroll
            for (int ni = 0; ni < 4; ++ni) bfr[ni] = *(LAS const bf16x8*)(sb + ni * 1024);
#pragma unroll
            for (int mi = 0; mi < MOE_MT; ++mi) { const bf16x8 af = *(LAS const bf16x8*)(sa + mi * 1024);
#pragma unroll
                for (int ni = 0; ni < 4; ++ni) acc[mi][ni] = __builtin_amdgcn_mfma_f32_16x16x32_bf16(bfr[ni], af, acc[mi][ni], 0, 0, 0); }
            if ((q & 7) == 7) {
                int lane_y = threadIdx.x & 63; asm volatile("" : "+v"(lane_y));
                const int cb = (q >> 3) * 512 + wave * 64 + (lane_y >> 4) * 4;
#pragma unroll
                for (int mi = 0; mi < MOE_MT; ++mi) { const int row = mi * 16 + (lane_y & 15);
                    if (row < ns) { const float w = wl[row]; bf16_t* yr = ybuf + (size_t)slotl[row] * D + cb;
#pragma unroll
                        for (int ni = 0; ni < 4; ++ni) { const f32x4 v = acc[mi][ni] * w; *(u32x2*)(yr + ni * 16) = (u32x2){pk2(v[0], v[1]), pk2(v[2], v[3])}; } }
#pragma unroll
                    for (int ni = 0; ni < 4; ++ni) acc[mi][ni] = (f32x4){0.f, 0.f, 0.f, 0.f}; }
            }
        }
#undef M2_STAGE
    }
#undef moe_hoff
    __syncthreads();
    MSTAMP(22);
#undef MSTAMP
}
__device__ __forceinline__ void moe_phase(LAS unsigned char* lds, int* cnt, const int* list, const bf16_t* hb, const float* rstd, const float* wslot, const bf16_t* wgu, const bf16_t* wd, bf16_t* ybuf, int bid, int nblk, unsigned long long* tsb = nullptr) {
    const bool grp = (nblk % 8) == 0;
    int ntile[NE]; int gsum = 0; bool fit = grp;
#pragma unroll
    for (int e = 0; e < NE; ++e) { const int c = __hip_atomic_load(cnt + e * 64, __ATOMIC_RELAXED, __HIP_MEMORY_SCOPE_AGENT); const int bm = 144; ntile[e] = (c + bm - 1) / bm;
        gsum = (e & 3) == 0 ? ntile[e] : gsum + ntile[e]; if ((e & 3) == 3 && gsum > nblk / 8) fit = false; }
    const int x = bid % 8;
    int u = fit ? bid / 8 : (grp ? x * (nblk / 8) + bid / 8 : bid), base = 0;
    const int stride = fit ? nblk / 8 : nblk;
#pragma unroll 1
    for (int e = 0; e < NE; ++e) {
        if (fit && (e >> 2) != x) continue;
        const int c = __hip_atomic_load(cnt + e * 64, __ATOMIC_RELAXED, __HIP_MEMORY_SCOPE_AGENT);
        const bool big = false; const int bm = 144, nt = (c + bm - 1) / bm;
        while (u < base + nt) { const int t = u - base; const int ns = c - t * bm < bm ? c - t * bm : bm;
            moe_unit<9>(lds, e, t * bm, ns, list, hb, rstd, wslot, wgu + (size_t)e * 512 * 1024, wd + (size_t)e * 1024 * 256, ybuf, tsb);
            u += stride; }
        base += nt;
    }
}

template <int MT>
__device__ __forceinline__ void l1proj_unit(LAS unsigned char* lds, int row0, int mrow0, bf16_t* hb, const bf16_t* __restrict__ ybuf, const bf16_t* __restrict__ win_t, const bf16_t* __restrict__ wuq_t,
                                            const bf16_t* __restrict__ wukv_t, const float2* __restrict__ cs, bf16_t* kpe, bf16_t* Q1, bf16_t* K1, bf16_t* VT1) {
    constexpr int BM = 16 * MT, STW = (BM + 512) * 64, KT = BM * 64  , CQN = 0, CKV = 8 * KT, RB = 12 * KT, STB = 32768, PART = 3 * STW;
    static_assert(RB + 3 * STB <= LDS_MISC && PART + 8 * BM * 4 <= LDS_MISC, "l1proj lds");
    const int tid = threadIdx.x, lane = tid & 63, wave = __builtin_amdgcn_readfirstlane(tid >> 6);
    LAS float* rsl = (LAS float*)(lds + LDS_MISC + 256);
#define L1_GROW(r) ((r) < 64 ? row0 + (r) : mrow0 + (r) - 64)
    for (int r = wave; r < BM; r += NWAVE) {
        const size_t grow = L1_GROW(r); float ss = 0.f;
#pragma unroll
        for (int j = 0; j < 4; ++j) { const size_t c = j * 256 + lane * 4;
            const u32x2 h = *(const u32x2*)(hb + grow * D + c), y0 = *(const u32x2*)(ybuf + (grow * 2) * D + c), y1 = *(const u32x2*)(ybuf + (grow * 2 + 1) * D + c);
            float v[4];
            v[0] = __uint_as_float(h.x << 16) + __uint_as_float(y0.x << 16) + __uint_as_float(y1.x << 16);
            v[1] = __uint_as_float(h.x & 0xffff0000u) + __uint_as_float(y0.x & 0xffff0000u) + __uint_as_float(y1.x & 0xffff0000u);
            v[2] = __uint_as_float(h.y << 16) + __uint_as_float(y0.y << 16) + __uint_as_float(y1.y << 16);
            v[3] = __uint_as_float(h.y & 0xffff0000u) + __uint_as_float(y0.y & 0xffff0000u) + __uint_as_float(y1.y & 0xffff0000u);
            ss += v[0] * v[0] + v[1] * v[1] + v[2] * v[2] + v[3] * v[3];
            *(u32x2*)(hb + grow * D + c) = (u32x2){pk2(v[0], v[1]), pk2(v[2], v[3])}; }
        ss = wave_sum(ss); if (lane == 0) rsl[r] = rsqrtf(ss * (1.0f / D) + EPS);
    }
    asm volatile("s_waitcnt vmcnt(0)" ::: "memory");
    __syncthreads();
    const int lc = (lane & 3) ^ swzF(lane >> 4);
    const int fro = (lane & 15) * 64 + (((lane >> 4) ^ swzF((lane >> 2) & 3)) << 4);
    f32x4 acc[MT][4];
#pragma unroll
    for (int mi = 0; mi < MT; ++mi)
#pragma unroll
        for (int ni = 0; ni < 4; ++ni) acc[mi][ni] = (f32x4){0.f, 0.f, 0.f, 0.f};
    {
        const char* srcb[4];
#pragma unroll
        for (int i = 0; i < 4; ++i) srcb[i] = (const char*)(win_t + (size_t)((wave + 8 * i) * 16 + (lane >> 2)) * D) + lc * 16;
        const char* srca = (const char*)(hb + (size_t)L1_GROW((wave < MT ? wave : 0) * 16 + (lane >> 2)) * D) + lc * 16;
#define W_ISSUE(st, kt) do { if (wave < MT) __builtin_amdgcn_global_load_lds((const unsigned*)(srca + (size_t)(kt) * 64), (LAS unsigned*)(lds + (st) * STW + wave * 1024), 16, 0, 16); \
        _Pragma("unroll") for (int _i = 0; _i < 4; ++_i) __builtin_amdgcn_global_load_lds((const unsigned*)(srcb[_i] + (size_t)(kt) * 64), (LAS unsigned*)(lds + (st) * STW + (MT + wave + 8 * _i) * 1024), 16, 0, 0); } while (0)
        W_ISSUE(0, 0); W_ISSUE(1, 1);
        int st = 0;
        for (int kt = 0; kt < 32; ++kt) {
            if (kt + 1 < 32) { if (wave < MT) wait_vm<5>(); else wait_vm<4>(); } else wait_vm<0>();
            __builtin_amdgcn_s_barrier(); asm volatile("" ::: "memory");
            if (kt + 2 < 32) W_ISSUE(st == 0 ? 2 : st - 1, kt + 2);
            LAS const unsigned char* sa = lds + st * STW + fro;
            LAS const unsigned char* sb = lds + st * STW + (BM + wave * 64) * 64 + fro;
            bf16x8 bfr[4];
#pragma unroll
            for (int ni = 0; ni < 4; ++ni) bfr[ni] = *(LAS const bf16x8*)(sb + ni * 1024);
#pragma unroll
            for (int mi = 0; mi < MT; ++mi) { const bf16x8 af = *(LAS const bf16x8*)(sa + mi * 1024);
#pragma unroll
                for (int ni = 0; ni < 4; ++ni) acc[mi][ni] = __builtin_amdgcn_mfma_f32_16x16x32_bf16(bfr[ni], af, acc[mi][ni], 0, 0, 0); }
            st = st == 2 ? 0 : st + 1;
        }
#undef W_ISSUE
    }
    asm volatile("s_waitcnt lgkmcnt(0)" ::: "memory");
    __syncthreads();
    LAS float* part = (LAS float*)(lds + PART);
    int lane_e = lane; asm volatile("" : "+v"(lane_e));
#define lane lane_e
#pragma unroll
    for (int mi = 0; mi < MT; ++mi) { const float rs = rsl[mi * 16 + (lane & 15)]; float ss = 0.f;
#pragma unroll
        for (int ni = 0; ni < 4; ++ni) { acc[mi][ni] = acc[mi][ni] * rs; ss += acc[mi][ni][0] * acc[mi][ni][0] + acc[mi][ni][1] * acc[mi][ni][1] + acc[mi][ni][2] * acc[mi][ni][2] + acc[mi][ni][3] * acc[mi][ni][3]; }
        ss += __shfl_xor(ss, 16); ss += __shfl_xor(ss, 32);
        if (lane < 16) part[wave * BM + mi * 16 + lane] = ss; }
    __syncthreads();
    if (wave < 6) {
#pragma unroll
        for (int mi = 0; mi < MT; ++mi) { const int row = mi * 16 + (lane & 15);
            const float tot = wave < 4 ? (part[row] + part[BM + row]) + (part[2 * BM + row] + part[3 * BM + row]) : part[4 * BM + row] + part[5 * BM + row];
            const float rn = rsqrtf(tot * (wave < 4 ? 1.0f / 256 : 1.0f / 128) + EPS);
#pragma unroll
            for (int ni = 0; ni < 4; ++ni) { const int cc = (wave < 4 ? 64 * wave : 64 * (wave - 4)) + ni * 16 + (lane >> 4) * 4; const f32x4 v = acc[mi][ni] * rn;
                *(LAS u32x2*)(lds + (wave < 4 ? CQN : CKV) + (cc >> 5) * KT + row * 64 + (((((cc & 31) >> 3)) ^ swzF((row >> 2) & 3)) << 4) + (cc & 4) * 2) = (u32x2){pk2(v[0], v[1]), pk2(v[2], v[3])}; } }
    } else if (wave == 6) {
#pragma unroll
        for (int mi = 0; mi < MT; ++mi) { const int row = mi * 16 + (lane & 15); const int grow = L1_GROW(row); const int pos = row_pos(grow), d0 = (lane >> 4) * 4;
            f32x4 o1, o2;
#pragma unroll
            for (int r = 0; r < 4; ++r) { const float2 t = cs[pos * 32 + 2 * (d0 + r)]; const float x1 = acc[mi][0][r], x2 = acc[mi][1][r]; o1[r] = x1 * t.x - x2 * t.y; o2[r] = x2 * t.x + x1 * t.y; }
            bf16_t* kr = kpe + ((size_t)row_batch(grow) * LP + pos) * 32;
            *(u32x2*)(kr + d0) = (u32x2){pk2(o1[0], o1[1]), pk2(o1[2], o1[3])}; *(u32x2*)(kr + 16 + d0) = (u32x2){pk2(o2[0], o2[1]), pk2(o2[2], o2[3])}; }
    }
#undef lane
    __syncthreads();
    const char* srcu[4];
#define U_ISSUE(st, base, pitchB, chunk, kt) do { _Pragma("unroll") for (int _i = 0; _i < 4; ++_i) \
        __builtin_amdgcn_global_load_lds((const unsigned*)(srcu[_i] + (size_t)(chunk) * 512 * (pitchB) + (size_t)(kt) * 64), (LAS unsigned*)(lds + RB + (st) * STB + (wave + 8 * _i) * 1024), 16, 0, 0); } while (0)
    {
#pragma unroll
        for (int i = 0; i < 4; ++i) srcu[i] = (const char*)(wuq_t + (size_t)((wave + 8 * i) * 16 + (lane >> 2)) * 256) + lc * 16;
#pragma unroll
        for (int mi = 0; mi < MT; ++mi)
#pragma unroll
            for (int ni = 0; ni < 4; ++ni) acc[mi][ni] = (f32x4){0.f, 0.f, 0.f, 0.f};
        U_ISSUE(0, 0, 512, 0, 0); U_ISSUE(1, 0, 512, 0, 1);
        int st = 0;
        for (int q = 0; q < 24; ++q) {
            if (q + 1 < 24) wait_vm<4>(); else wait_vm<0>();
            __builtin_amdgcn_s_barrier(); asm volatile("" ::: "memory");
            if (q + 2 < 24) U_ISSUE(st == 0 ? 2 : st - 1, 0, 512, (q + 2) >> 3, (q + 2) & 7);
            LAS const unsigned char* sa = lds + CQN + (q & 7) * KT + fro;
            LAS const unsigned char* sb = lds + RB + st * STB + (wave * 64) * 64 + fro;
            bf16x8 bfr[4];
#pragma unroll
            for (int ni = 0; ni < 4; ++ni) bfr[ni] = *(LAS const bf16x8*)(sb + ni * 1024);
#pragma unroll
            for (int mi = 0; mi < MT; ++mi) { const bf16x8 af = *(LAS const bf16x8*)(sa + mi * 1024);
#pragma unroll
                for (int ni = 0; ni < 4; ++ni) acc[mi][ni] = __builtin_amdgcn_mfma_f32_16x16x32_bf16(bfr[ni], af, acc[mi][ni], 0, 0, 0); }
            if ((q & 7) == 7) {
                int lane_q = lane; asm volatile("" : "+v"(lane_q));
#define lane lane_q
                const float scale = 0.10206207261596577f * 1.4426950408889634f; const int d0 = (lane >> 4) * 4;
#pragma unroll
                for (int mi = 0; mi < MT; ++mi) { const int grow = L1_GROW(mi * 16 + (lane & 15)); const int pos = row_pos(grow);
#pragma unroll
                    for (int bi = 0; bi < 2; ++bi) { const int gc = (q >> 3) * 512 + 64 * wave + bi * 32; bf16_t* orow = Q1 + (size_t)grow * 1536 + gc;
                        f32x4 v1 = acc[mi][2 * bi], v2 = acc[mi][2 * bi + 1];
                        if (((gc >> 5) % 3) == 2) {
#pragma unroll
                            for (int r = 0; r < 4; ++r) { const float2 t = cs[pos * 32 + 2 * (d0 + r)]; const float x1 = v1[r], x2 = v2[r]; v1[r] = x1 * t.x - x2 * t.y; v2[r] = x2 * t.x + x1 * t.y; } }
                        v1 = v1 * scale; v2 = v2 * scale;
                        *(u32x2*)(orow + d0) = (u32x2){pk2(v1[0], v1[1]), pk2(v1[2], v1[3])}; *(u32x2*)(orow + 16 + d0) = (u32x2){pk2(v2[0], v2[1]), pk2(v2[2], v2[3])}; }
#pragma unroll
                    for (int ni = 0; ni < 4; ++ni) acc[mi][ni] = (f32x4){0.f, 0.f, 0.f, 0.f}; }
#undef lane
            }
            st = st == 2 ? 0 : st + 1;
        }
    }
    asm volatile("s_waitcnt lgkmcnt(0)" ::: "memory");
    __syncthreads();
    {
#pragma unroll
        for (int i = 0; i < 4; ++i) srcu[i] = (const char*)(wukv_t + (size_t)((wave + 8 * i) * 16 + (lane >> 2)) * 128) + lc * 16;
#pragma unroll
        for (int mi = 0; mi < MT; ++mi)
#pragma unroll
            for (int ni = 0; ni < 4; ++ni) acc[mi][ni] = (f32x4){0.f, 0.f, 0.f, 0.f};
        U_ISSUE(0, 0, 256, 0, 0); U_ISSUE(1, 0, 256, 0, 1);
        int st = 0;
        for (int q = 0; q < 16; ++q) {
            if (q + 1 < 16) wait_vm<4>(); else wait_vm<0>();
            __builtin_amdgcn_s_barrier(); asm volatile("" ::: "memory");
            if (q + 2 < 16) U_ISSUE(st == 0 ? 2 : st - 1, 0, 256, (q + 2) >> 2, (q + 2) & 3);
            LAS const unsigned char* sa = lds + CKV + (q & 3) * KT + fro;
            LAS const unsigned char* sb = lds + RB + st * STB + (wave * 64) * 64 + fro;
            bf16x8 bfr[4];
#pragma unroll
            for (int ni = 0; ni < 4; ++ni) bfr[ni] = *(LAS const bf16x8*)(sb + ni * 1024);
            if (q < 8) {
#pragma unroll
                for (int mi = 0; mi < MT; ++mi) { const bf16x8 af = *(LAS const bf16x8*)(sa + mi * 1024);
#pragma unroll
                    for (int ni = 0; ni < 4; ++ni) acc[mi][ni] = __builtin_amdgcn_mfma_f32_16x16x32_bf16(bfr[ni], af, acc[mi][ni], 0, 0, 0); }
            } else {
#pragma unroll
                for (int mi = 0; mi < MT; ++mi) { const bf16x8 af = *(LAS const bf16x8*)(sa + mi * 1024);
#pragma unroll
                    for (int ni = 0; ni < 4; ++ni) acc[mi][ni] = __builtin_amdgcn_mfma_f32_16x16x32_bf16(af, bfr[ni], acc[mi][ni], 0, 0, 0); }
            }
            if ((q & 3) == 3) {
                const int ch = q >> 2;
                int lane_k = lane; asm volatile("" : "+v"(lane_k));
#define lane lane_k
                if (ch < 2) {
#pragma unroll
                    for (int mi = 0; mi < MT; ++mi) { const int grow = L1_GROW(mi * 16 + (lane & 15)); const size_t kr = (size_t)row_batch(grow) * LP + row_pos(grow);
#pragma unroll
                        for (int ni = 0; ni < 4; ++ni) { const f32x4 v = acc[mi][ni];
                            *(u32x2*)(K1 + kr * D + 512 * ch + 64 * wave + ni * 16 + (lane >> 4) * 4) = (u32x2){pk2(v[0], v[1]), pk2(v[2], v[3])}; acc[mi][ni] = (f32x4){0.f, 0.f, 0.f, 0.f}; } }
                } else {
#pragma unroll
                    for (int mi = 0; mi < MT; ++mi) { const int grow0 = L1_GROW(mi * 16 + (lane >> 4) * 4); const int b = row_batch(grow0), pp = perm16(row_pos(grow0));
#pragma unroll
                        for (int ni = 0; ni < 4; ++ni) { const int hd = 512 * (ch - 2) + 64 * wave + ni * 16 + (lane & 15); const f32x4 v = acc[mi][ni];
                            *(u32x2*)(VT1 + (size_t)(b * 1024 + hd) * LP + pp) = (u32x2){pk2(v[0], v[1]), pk2(v[2], v[3])}; acc[mi][ni] = (f32x4){0.f, 0.f, 0.f, 0.f}; } }
                }
#undef lane
            }
            st = st == 2 ? 0 : st + 1;
        }
    }
#undef U_ISSUE
#undef L1_GROW
    asm volatile("s_waitcnt lgkmcnt(0)" ::: "memory");
    __syncthreads();
}
__device__ __forceinline__ void l1proj_phase(LAS unsigned char* lds, bf16_t* hb, const bf16_t* ybuf, const bf16_t* win_t, const bf16_t* wuq_t, const bf16_t* wukv_t, const float2* cs, bf16_t* kpe,
                                             bf16_t* Q1, bf16_t* K1, bf16_t* VT1, int bid, int nblk) {
    { const int gt = bid * NTHR + threadIdx.x, ngt = nblk * NTHR;
      for (int idx = gt; idx < 2 * 48 * 1024; idx += ngt) { const int b = idx / (48 * 1024), r = idx % (48 * 1024); K1[((size_t)b * LP + 8208) * 1024 + r] = 0; }
      for (int idx = gt; idx < 2 * 16 * 64 * 48; idx += ngt) { const int rr = idx / 48, c = idx % 48; VT1[(size_t)rr * LP + 8208 + c] = 0; } }
    for (int u = bid; u < 256; u += nblk) {
        if (u >= 254) l1proj_unit<5>(lds, u * 64, MREAL + (u - 254) * 16, hb, ybuf, win_t, wuq_t, wukv_t, cs, kpe, Q1, K1, VT1);
        else l1proj_unit<4>(lds, u * 64, MREAL, hb, ybuf, win_t, wuq_t, wukv_t, cs, kpe, Q1, K1, VT1);
    }
}

struct EpiNull { int m0, n0;
    template <int MT, int NT> __device__ __forceinline__ void operator()(f32x4 (&acc)[MT][NT], int, int, int) const {
#pragma unroll
        for (int mi = 0; mi < MT; ++mi)
#pragma unroll
            for (int ni = 0; ni < NT; ++ni) asm volatile("" :: "v"(acc[mi][ni])); } };
__device__ __forceinline__ void transpose_item(const float* __restrict__ W, int N, const float* __restrict__ gain, bf16_t* dst, int ldk, int drow0, int k0, int n0, LAS float* scr, int lane, int dskip = 0) {
#pragma unroll 8
    for (int i = 0; i < 32; ++i) { const int kk = 2 * i + (lane >> 5); float v = W[(size_t)(k0 + kk) * N + n0 + (lane & 31)]; if (gain) v *= gain[k0 + kk]; scr[kk * 33 + (lane & 31)] = v; }
    asm volatile("s_waitcnt lgkmcnt(0)" ::: "memory");
    const int c = lane & 7;
#pragma unroll
    for (int j = 0; j < 4; ++j) { const int n = (lane >> 3) + 8 * j; const LAS float* s = scr + (8 * c) * 33 + n;
        u32x4 o; o.x = pk2(s[0 * 33], s[1 * 33]); o.y = pk2(s[2 * 33], s[3 * 33]); o.z = pk2(s[4 * 33], s[5 * 33]); o.w = pk2(s[6 * 33], s[7 * 33]);
        *(u32x4*)(dst + (size_t)(drow0 + n + (n >= 16 ? dskip : 0)) * ldk + k0 + 8 * c) = o; }
    asm volatile("s_waitcnt lgkmcnt(0)" ::: "memory");
}
struct MoeItem { const float* src; const float* gain; bf16_t* dst; int pitch, ldk, kind, nrow0; };
__device__ __forceinline__ MoeItem moe_item(int it, const float* wgate, const float* wup, const float* wdown, const float* gain, bf16_t* wgu_t, bf16_t* wd_t) {
    const int e = it / 48, r = it % 48, which = r >> 4, q = r & 15; MoeItem d;
    if (which < 2) { d.src = (which ? wup : wgate) + (size_t)e * D * DE + (size_t)q * 64 * DE; d.gain = gain + q * 64; d.dst = wgu_t + (size_t)e * 512 * 1024 + q * 64; d.pitch = DE; d.ldk = 1024; d.kind = which; d.nrow0 = 0; }
    else { const int kb = q >> 2, nb = q & 3; d.src = wdown + (size_t)e * DE * D + (size_t)kb * 64 * D + nb * 256; d.gain = nullptr; d.dst = wd_t + (size_t)e * 1024 * 256 + kb * 64; d.pitch = D; d.ldk = 256; d.kind = 2; d.nrow0 = nb * 256; }
    return d;
}
__device__ __forceinline__ void moe_weight_items(const float* wgate, const float* wup, const float* wdown, const float* gain, bf16_t* wgu_t, bf16_t* wd_t, LAS float* T, int bid, int nblk) {
    const int tid = threadIdx.x;
    f32x4 R[8];
    int it = bid;
    if (it >= NE * 48) return;
    MoeItem cur = moe_item(it, wgate, wup, wdown, gain, wgu_t, wd_t);
#pragma unroll
    for (int i = 0; i < 8; ++i) { const int idx = tid + i * NTHR; R[i] = *(const f32x4*)(cur.src + (size_t)(idx >> 6) * cur.pitch + (idx & 63) * 4); }
    for (;;) {
#pragma unroll
        for (int i = 0; i < 8; ++i) { const int idx = tid + i * NTHR, k = idx >> 6, c4 = idx & 63; f32x4 v = R[i]; if (cur.gain) v = v * cur.gain[k];
            LAS float* t = T + k * 257 + c4 * 4; t[0] = v[0]; t[1] = v[1]; t[2] = v[2]; t[3] = v[3]; }
        __syncthreads();
        const int nit = it + nblk; const bool more = nit < NE * 48;
        MoeItem nxt = cur;
        if (more) { nxt = moe_item(nit, wgate, wup, wdown, gain, wgu_t, wd_t);
#pragma unroll
            for (int i = 0; i < 8; ++i) { const int idx = tid + i * NTHR; R[i] = *(const f32x4*)(nxt.src + (size_t)(idx >> 6) * nxt.pitch + (idx & 63) * 4); } }
#pragma unroll
        for (int i = 0; i < 4; ++i) { const int idx = tid + i * NTHR, kc = idx & 7, n = idx >> 3;
            const LAS float* t = T + (8 * kc) * 257 + n;
            u32x4 o; o.x = pk2(t[0], t[257]); o.y = pk2(t[2 * 257], t[3 * 257]); o.z = pk2(t[4 * 257], t[5 * 257]); o.w = pk2(t[6 * 257], t[7 * 257]);
            const int row = cur.kind == 2 ? cur.nrow0 + n : (n >> 4) * 32 + cur.kind * 16 + (n & 15);
            *(u32x4*)(cur.dst + (size_t)row * cur.ldk + 8 * kc) = o; }
        __syncthreads();
        if (!more) break;
        cur = nxt; it = nit;
    }
}
__device__ __forceinline__ void p0_prologue(const MArgs& a, LAS unsigned char* lds, int bid, int nblk) {
    const int tid = threadIdx.x, lane = tid & 63, wave = __builtin_amdgcn_readfirstlane(tid >> 6);
    const int gw = bid * NWAVE + wave, ngw = nblk * NWAVE, gt = bid * NTHR + tid, ngt = nblk * NTHR;
    unsigned char* ws = a.ws;
    float2* cs = (float2*)(ws + WS_ROPE);
    for (int _r = 0; _r < (PROBE_PHASE == 301 ? 2 : 1); ++_r)
    for (int idx = gt; idx < LPOS * 32; idx += ngt) { const int pos = idx >> 5, i = idx & 31; const float inv = 1.0f / powf(10000.0f, (float)(2 * i) / 64.0f); float s, c; sincosf((float)pos * inv, &s, &c); cs[idx] = make_float2(c, s); }
    float* wrf = (float*)(ws + W2_WRF);
    for (int idx = gt; idx < 2 * 36 * 1024; idx += ngt) { const int l = idx / (36 * 1024), j = (idx >> 10) % 36, k = idx & 1023;
        const float g = a.in[3][l * D + k]; wrf[idx] = g * (j < 4 ? a.in[16][(size_t)l * D * 4 + k * 4 + j] : a.in[18][(size_t)l * D * 32 + k * 32 + (j - 4)]); }
    { u32x4* z = (u32x4*)(ws + W2_WIN + (size_t)416 * 1024 * 2); for (int idx = gt; idx < 96 * 1024 * 2 / 16; idx += ngt) z[idx] = (u32x4){0u, 0u, 0u, 0u}; }
    { bf16_t* kpe = (bf16_t*)(ws + WS_KPE); for (int idx = gt; idx < 2 * 48 * 32; idx += ngt) { const int b = idx / (48 * 32), r = idx % (48 * 32); kpe[((size_t)b * LP + 8208) * 32 + r] = 0; }
      bf16_t* vt0 = (bf16_t*)(ws + B_VT0); for (int idx = gt; idx < 2 * 2 * 64 * 48; idx += ngt) { const int rr = idx / 48, c = idx % 48; vt0[(size_t)rr * LP + 8208 + c] = 0; } }
    { bf16_t* hb = (bf16_t*)(ws + W2_HB); float* rstd = (float*)(ws + W2_RSTD);
      for (int _r = 0; _r < (PROBE_PHASE == 303 ? 2 : 1); ++_r)
      for (int row = gw; row < MTOT; row += ngw) {
        const float* src = row < MREAL ? a.in[0] + (size_t)row * D : a.in[1] + (size_t)row_pos(row) * D;
        float ss = 0.f;
#pragma unroll
        for (int j = 0; j < 4; ++j) { const f32x4 v = *(const f32x4*)(src + j * 256 + lane * 4); ss += v[0] * v[0] + v[1] * v[1] + v[2] * v[2] + v[3] * v[3];
            *(u32x2*)(hb + (size_t)row * D + j * 256 + lane * 4) = (u32x2){pk2(v[0], v[1]), pk2(v[2], v[3])}; }
        ss = wave_sum(ss); if (lane == 0) rstd[row] = rsqrtf(ss * (1.0f / D) + EPS);
      } }
    LAS float* scr = (LAS float*)(lds + wave * 16384);
    for (int _r = 0; _r < (PROBE_PHASE == 304 ? 2 : 1); ++_r)
    for (int it = gw; it < 2192; it += ngw) {
        int r = it;
        if (r < 640) { const int nb = r % 40;
            transpose_item(a.in[5], NQKV, a.in[2], (bf16_t*)(ws + W2_WQKV), 1024, nb < 32 ? 64 * (nb >> 1) + 16 * (nb & 1) : nb * 32, (r / 40) * 64, nb * 32, scr, lane, nb < 32 ? 16 : 0); continue; } r -= 640;
        if (r < 512) { transpose_item(a.in[8], D, nullptr, (bf16_t*)(ws + W2_WO0), 1024, (r & 31) * 32, (r >> 5) * 64, (r & 31) * 32, scr, lane); continue; } r -= 512;
        if (r < 208) { transpose_item(a.in[10], 416, a.in[2] + D, (bf16_t*)(ws + W2_WIN), 1024, (r % 13) * 32, (r / 13) * 64, (r % 13) * 32, scr, lane); continue; } r -= 208;
        if (r < 192) { transpose_item(a.in[13], 1536, a.in[11], (bf16_t*)(ws + W2_WUQ), 256, (r % 48) * 32, (r / 48) * 64, (r % 48) * 32, scr, lane); continue; } r -= 192;
        if (r < 128) { const int nb32 = r & 63, hh = nb32 >> 2, part = nb32 & 3;
            transpose_item(a.in[14], 2048, a.in[12], (bf16_t*)(ws + W2_WUKV), 128, part < 2 ? hh * 64 + part * 32 : 1024 + hh * 64 + (part - 2) * 32, (r >> 6) * 64, nb32 * 32, scr, lane); continue; } r -= 128;
        transpose_item(a.in[15], D, nullptr, (bf16_t*)(ws + W2_WO1), 1024, (r & 31) * 32, (r >> 5) * 64, (r & 31) * 32, scr, lane);
    }
    __syncthreads();
    moe_weight_items(a.in[20], a.in[21], a.in[22], a.in[3], (bf16_t*)(ws + C_W0), (bf16_t*)(ws + C_W0 + MOE_WGU_BYTES), (LAS float*)lds, bid, nblk);
}

template <bool NSW, bool HALFN, class MakeEpi>
__device__ __forceinline__ void gemm_phase(LAS unsigned char* lds, const bf16_t* A, int lda, const bf16_t* Bt, int K, int pn0, int pn1, int bid, int nblk, const MakeEpi& mk) {
    constexpr int BN = HALFN ? 128 : 256;
    const int ntn = pn1 - pn0;
    const bool grp = (nblk % 8) == 0;
    const int x = grp ? bid % 8 : 0, j = grp ? bid / 8 : bid, nslot = grp ? nblk / 8 : nblk, pmg = grp ? 8 : 64;
    for (int u = j; u < pmg * ntn; u += nslot) {
        const int pm = x * pmg + u / ntn, pn = pn0 + u % ntn;
        RowDense ra{A, lda, pm * 256, MTOT - 1}; auto e = mk(pm * 256, pn * BN);
        if (HALFN) gemm_tile<4, 4, 4, 2, NSW>(lds, ra, Bt + (size_t)pn * BN * K, K, K / 32, e);
        else gemm_tile<8, 4, 2, 4, NSW>(lds, ra, Bt + (size_t)pn * BN * K, K, K / 32, e);
    }
    const int nfull = (pmg * ntn + nslot - 1) / nslot;
    for (int pn = pn0; pn < pn1; ++pn) {
        const int owner = (pn - pn0) * 37 % nblk;
        if (bid == owner) { RowDense ra{A, lda, MREAL, MTOT - 1}; auto e = mk(MREAL, pn * BN);
            if (HALFN) gemm_tile<1, 4, 4, 2, NSW>(lds, ra, Bt + (size_t)pn * BN * K, K, K / 32, e);
            else gemm_tile<1, 4, 2, 4, NSW>(lds, ra, Bt + (size_t)pn * BN * K, K, K / 32, e); }
    }
    (void)nfull;
}

constexpr int PH_PROLOGUE = 0, PH_QKV = 1, PH_SWA = 2, PH_OPROJ0 = 3, PH_ROUTE0 = 4, PH_MOE0 = 5, PH_COMBINE = 6, PH_WIN = 7, PH_CEPI = 8, PH_UQKV = 9, PH_MLA = 10, PH_OPROJ1 = 11, PH_ROUTE1 = 12, PH_MOE1 = 13, PH_FINAL = 14, PH_N = 15;
__global__ void __launch_bounds__(NTHR, 2) mega(MArgs a) {
    extern __shared__ __attribute__((aligned(16))) unsigned char lds_raw[];
    LAS unsigned char* lds = (LAS unsigned char*)lds_raw;
    const int tid = threadIdx.x, bid = blockIdx.x, nblk = gridDim.x;
    volatile LAS unsigned* misc = (volatile LAS unsigned*)(lds + LDS_MISC);
    if (tid < 64) misc[tid] = 0u;
    __syncthreads();
    unsigned char* ws = a.ws;
    XcdBarrier bar = xcd_barrier_post((unsigned*)(ws + WS_BAR) + a.li * XCD_BAR_WORDS, misc);
    if (tid == 0) misc[4] = xb_add((unsigned*)(ws + 32 * 1024) + 64 * bar.x, 1u);
    const int lo = a.ph_lo, hi = a.ph_hi;
#define IN(k) (lo <= (k) && (k) < hi)
#define REP(k) for (int _rep = 0; _rep < ((k) == PROBE_PHASE ? 2 : 1); ++_rep, (void)((k) == PROBE_PHASE && _rep == 1 ? (xcd_barrier(bar), 0) : 0))
#define STAMP(i) do { if (PROBE_PHASE >= 600 && bid == 0 && tid == 0) ((unsigned long long*)(ws + 512 * 1024))[i] = __builtin_amdgcn_s_memrealtime(); } while (0)
#define SEAM(k) do { if (IN(k) && IN((k) + 1)) xcd_barrier(bar); STAMP((k) + 1); } while (0)
    STAMP(0);
    if (IN(PH_PROLOGUE)) REP(PH_PROLOGUE) p0_prologue(a, lds, bid, nblk);
    SEAM(PH_PROLOGUE);
    int vbid = bid;
    if (IN(PH_PROLOGUE) && IN(PH_QKV)) {
        if (tid == 0) { bool ok = (nblk % 8) == 0 && bar.x < 8;
            for (int j = 0; j < 8; ++j) ok = ok && xb_ld((unsigned*)(ws + 32 * 1024) + 64 * j) == (unsigned)(nblk / 8);
            misc[5] = ok ? misc[4] * 8u + bar.x : (unsigned)bid; }
        __syncthreads();
        vbid = __builtin_amdgcn_readfirstlane((int)misc[5]);
    }
#define bid vbid
    if (IN(PH_QKV)) REP(PH_QKV) {
        const float* rstd = (const float*)(ws + W2_RSTD); const float* bias = a.in[6]; const float2* cs = (const float2*)(ws + WS_ROPE); bf16_t* qkv = (bf16_t*)(ws + B_QKV); bf16_t* vt0 = (bf16_t*)(ws + B_VT0);
        const bf16_t* hbA = (const bf16_t*)(ws + W2_HB); const bf16_t* Wt = (const bf16_t*)(ws + W2_WQKV);
        const bool grp = (nblk % 8) == 0; const int x = grp ? bid % 8 : 0, j = grp ? bid / 8 : bid, nslot = grp ? nblk / 8 : nblk, pmg = grp ? 8 : 64;
        const bool usepg = nblk == 256;
        if (usepg) { pg8::Gemm g{hbA, Wt, MREAL, 1024, D}; pg8::StaticOrder S; S.init(MREAL, 1024, nblk, bid);
            PgEpiQ E{rstd, bias, cs, qkv};
            pg8::gemm_phase<PgEpiQ, pg8::StaticOrder, true, true>(lds, g, S, E); }
        for (int u = usepg ? pmg * 4 + j : j; u < pmg * 6; u += nslot) {
            if (u < pmg * 4) { const int pm = x * pmg + (u >> 2), pn = u & 3; RowDense ra{hbA, D, pm * 256, MTOT - 1}; EpiQKV e{rstd, bias, cs, qkv, pm * 256, pn * 256, true};
                gemm_tile<8, 4, 2, 4, false>(lds, ra, Wt + (size_t)pn * 256 * D, D, D / 32, e);
            } else if (u < pmg * 5) { const int pm = x * pmg + (u - pmg * 4); RowDense ra{hbA, D, pm * 256, MTOT - 1}; EpiQKV e{rstd, bias, cs, qkv, pm * 256, 1024, false};
                gemm_tile<4, 4, 4, 2, false>(lds, ra, Wt + (size_t)1024 * D, D, D / 32, e);
            } else { const int pm = x * pmg + (u - pmg * 5); RowDense ra{hbA, D, pm * 256, MTOT - 1}; EpiV0 e{rstd, bias, vt0, pm * 256, 1152};
                gemm_tile<4, 4, 4, 2, true>(lds, ra, Wt + (size_t)1152 * D, D, D / 32, e);
            }
        }
        const int mu = bid - (nblk - 6);
        if (mu >= 0 && mu < 4) { RowDense ra{hbA, D, MREAL, MTOT - 1}; EpiQKV e{rstd, bias, cs, qkv, MREAL, mu * 256, true};
            gemm_tile<1, 4, 2, 4, false>(lds, ra, Wt + (size_t)mu * 256 * D, D, D / 32, e);
        } else if (mu == 4) { RowDense ra{hbA, D, MREAL, MTOT - 1}; EpiQKV e{rstd, bias, cs, qkv, MREAL, 1024, false};
            gemm_tile<1, 4, 4, 2, false>(lds, ra, Wt + (size_t)1024 * D, D, D / 32, e);
        } else if (mu == 5) { RowDense ra{hbA, D, MREAL, MTOT - 1}; EpiV0 e{rstd, bias, vt0, MREAL, 1152};
            gemm_tile<1, 4, 4, 2, true>(lds, ra, Wt + (size_t)1152 * D, D, D / 32, e);
        }
    }
    SEAM(PH_QKV);
    if (IN(PH_SWA)) REP(PH_SWA) swa_phase(lds, (const bf16_t*)(ws + B_QKV), (const bf16_t*)(ws + B_VT0), a.in[7], (bf16_t*)(ws + B_O0), bid, nblk);
    SEAM(PH_SWA);
    if (IN(PH_OPROJ0)) REP(PH_OPROJ0) {
        const float* bias = a.in[9]; bf16_t* hb = (bf16_t*)(ws + W2_HB);
        if (nblk == 256) { pg8::Gemm g{(const bf16_t*)(ws + B_O0), (const bf16_t*)(ws + W2_WO0), MREAL, D, D}; pg8::StaticOrder S; S.init(MREAL, D, nblk, bid); PgEpiRes E{bias, hb};
            pg8::gemm_phase<PgEpiRes, pg8::StaticOrder, true, true>(lds, g, S, E);
            if ((bid & 15) == 5) { const int pc = bid >> 4; RowDense ra{(const bf16_t*)(ws + B_O0), D, MREAL, MTOT - 1}; EpiRes e{bias, hb, MREAL, pc * 64};
                gemm_tile<1, 1, 2, 4, false>(lds, ra, (const bf16_t*)(ws + W2_WO0) + (size_t)pc * 64 * D, D, D / 32, e); }
        } else
        gemm_phase<false, false>(lds, (const bf16_t*)(ws + B_O0), D, (const bf16_t*)(ws + W2_WO0), D, 0, 4, bid, nblk, [=](int m0, int n0) { return EpiRes{bias, hb, m0, n0}; });
    }
    SEAM(PH_OPROJ0);
    if (IN(PH_ROUTE0))
        route_phase(lds, (const bf16_t*)(ws + W2_HB), (const float*)(ws + W2_WRF), a.in[17], a.in[19], (float*)(ws + W2_RSTD), (int*)(ws + WS_CTL),
                    (int*)(ws + W2_LIST), (float*)(ws + W2_WSLOT), bid, nblk);
    SEAM(PH_ROUTE0);
    if (IN(PH_MOE0)) REP(PH_MOE0) moe_phase(lds, (int*)(ws + WS_CTL), (const int*)(ws + W2_LIST), (const bf16_t*)(ws + W2_HB), (const float*)(ws + W2_RSTD), (const float*)(ws + W2_WSLOT),
                               (const bf16_t*)(ws + C_W0), (const bf16_t*)(ws + C_W0 + MOE_WGU_BYTES), (bf16_t*)(ws + B_Y0), bid, nblk, (unsigned long long*)(ws + 512 * 1024));
    SEAM(PH_MOE0);
    if (IN(PH_COMBINE)) l1proj_phase(lds, (bf16_t*)(ws + W2_HB), (const bf16_t*)(ws + B_Y0), (const bf16_t*)(ws + W2_WIN), (const bf16_t*)(ws + W2_WUQ), (const bf16_t*)(ws + W2_WUKV),
                                     (const float2*)(ws + WS_ROPE), (bf16_t*)(ws + WS_KPE), (bf16_t*)(ws + C_Q1), (bf16_t*)(ws + C_K1), (bf16_t*)(ws + C_V1), bid, nblk);
    STAMP(PH_WIN); STAMP(PH_CEPI); STAMP(PH_UQKV);
    SEAM(PH_UQKV);
    if (IN(PH_MLA)) REP(100) {
        moe_weight_items(a.in[20] + (size_t)NE * D * DE, a.in[21] + (size_t)NE * D * DE, a.in[22] + (size_t)NE * DE * D, a.in[3] + D, (bf16_t*)(ws + B_W1), (bf16_t*)(ws + B_W1 + MOE_WGU_BYTES),
                         (LAS float*)lds, bid, nblk);
    }
    if (IN(PH_MLA)) REP(PH_MLA) mla_phase(lds, (const bf16_t*)(ws + C_Q1), (const bf16_t*)(ws + C_K1), (const bf16_t*)(ws + WS_KPE), (const bf16_t*)(ws + C_V1), (bf16_t*)(ws + B_O1), bid, nblk);
    SEAM(PH_MLA);
    if (IN(PH_OPROJ1)) REP(PH_OPROJ1) {
        bf16_t* hb = (bf16_t*)(ws + W2_HB);
        if (nblk == 256) { pg8::Gemm g{(const bf16_t*)(ws + B_O1), (const bf16_t*)(ws + W2_WO1), MREAL, D, D}; pg8::StaticOrder S; S.init(MREAL, D, nblk, bid); PgEpiRes E{nullptr, hb};
            pg8::gemm_phase<PgEpiRes, pg8::StaticOrder, true, true>(lds, g, S, E);
            if ((bid & 15) == 5) { const int pc = bid >> 4; RowDense ra{(const bf16_t*)(ws + B_O1), D, MREAL, MTOT - 1}; EpiRes e{nullptr, hb, MREAL, pc * 64};
                gemm_tile<1, 1, 2, 4, false>(lds, ra, (const bf16_t*)(ws + W2_WO1) + (size_t)pc * 64 * D, D, D / 32, e); }
        } else
        gemm_phase<false, false>(lds, (const bf16_t*)(ws + B_O1), D, (const bf16_t*)(ws + W2_WO1), D, 0, 4, bid, nblk, [=](int m0, int n0) { return EpiRes{nullptr, hb, m0, n0}; });
    }
    SEAM(PH_OPROJ1);
    if (IN(PH_ROUTE1))
        route_phase(lds, (const bf16_t*)(ws + W2_HB), (const float*)(ws + W2_WRF) + 36 * 1024, a.in[17] + 4, a.in[19] + 32, (float*)(ws + W2_RSTD), (int*)(ws + WS_CTL) + 2048,
                    (int*)(ws + W2_LIST), (float*)(ws + W2_WSLOT), bid, nblk);
    SEAM(PH_ROUTE1);
    if (IN(PH_MOE1)) REP(PH_MOE1) moe_phase(lds, (int*)(ws + WS_CTL) + 2048, (const int*)(ws + W2_LIST), (const bf16_t*)(ws + W2_HB), (const float*)(ws + W2_RSTD), (const float*)(ws + W2_WSLOT),
                               (const bf16_t*)(ws + B_W1), (const bf16_t*)(ws + B_W1 + MOE_WGU_BYTES), (bf16_t*)(ws + C_Y1), bid, nblk);
    SEAM(PH_MOE1);
    if (IN(PH_FINAL)) REP(PH_FINAL) final_phase((const bf16_t*)(ws + W2_HB), (const bf16_t*)(ws + C_Y1), a.in[4], a.out, bid, nblk);
#undef bid
#undef IN
#undef SEAM
}

static void run_mega(hipStream_t s, const MArgs& base, int lo, int hi, int grid) {
    MArgs a = base; a.ph_lo = lo; a.ph_hi = hi; a.li = lo;
    hipLaunchKernelGGL(mega, dim3(grid), dim3(NTHR), LDS_BYTES, s, a);
}
extern "C" void kernel_launch(void* const* d_in, const int* in_sizes, int n_in, void* d_out, int out_size, void* d_ws, size_t ws_size, hipStream_t stream) {
    static int grid = 0;
    if (grid == 0) {
        if (n_in != 23 || ws_size < WS_END) { fprintf(stderr, "kernel_launch: unexpected n_in %d or ws_size %zu\n", n_in, ws_size); grid = -1; return; }
        if (hipFuncSetAttribute((const void*)mega, hipFuncAttributeMaxDynamicSharedMemorySize, LDS_BYTES) != hipSuccess) { fprintf(stderr, "hipFuncSetAttribute failed\n"); grid = -1; return; }
        int dev = 0, cus = 0, per_cu = 0;
        (void)hipGetDevice(&dev); (void)hipDeviceGetAttribute(&cus, hipDeviceAttributeMultiprocessorCount, dev);
        (void)hipOccupancyMaxActiveBlocksPerMultiprocessor(&per_cu, (const void*)mega, NTHR, LDS_BYTES);
        (void)hipGetLastError();
        if (per_cu < 1 || cus < 8) { fprintf(stderr, "kernel_launch: occupancy query reports %d workgroups/CU on %d CUs for %d threads + %d B LDS; nothing launched\n", per_cu, cus, NTHR, LDS_BYTES); grid = -1; return; }
        grid = cus;
    }
    if (grid < 0) return;
    (void)in_sizes; (void)out_size;
    unsigned char* ws = (unsigned char*)d_ws;
    MArgs base{}; for (int i = 0; i < 23; ++i) base.in[i] = (const float*)d_in[i]; base.out = (float*)d_out; base.ws = ws;
    (void)hipMemsetAsync(ws + WS_CTL, 0, 1 * MiB, stream);
    run_mega(stream, base, 0, PH_N, grid);
}
```

```cpp
#include <hip/hip_runtime.h>
#ifndef PROBE_PHASE
#define PROBE_PHASE -1
#endif
#include <cstdio>
#include <cstdint>

typedef unsigned short bf16_t;

constexpr int D = 1024, SEQ = 8192, NB = 2, NMETA = 16;
constexpr int MREAL = NB * SEQ;
constexpr int MTOT = MREAL + NB * NMETA;
constexpr int LPOS = NMETA + SEQ;
constexpr int NQKV = 1280;
constexpr int NE = 32, DE = 256;
constexpr int CAP = MTOT * 2;
constexpr float EPS = 1e-6f;

__device__ __forceinline__ float bf2f(bf16_t v) { return __uint_as_float(((unsigned)v) << 16); }
__device__ __forceinline__ bf16_t f2bf(float f) { unsigned u = __float_as_uint(f); u += 0x7fffu + ((u >> 16) & 1u); return (bf16_t)(u >> 16); }
__device__ __forceinline__ int row_pos(int row) { return row < MREAL ? NMETA + (row & (SEQ - 1)) : ((row - MREAL) & (NMETA - 1)); }
__device__ __forceinline__ int row_batch(int row) { return row < MREAL ? (row >> 13) : ((row - MREAL) >> 4); }
constexpr int LP = 8256;
__device__ __forceinline__ int perm16(int p) { const int qd = (p >> 2) & 3; return (p & ~12) | ((((qd & 1) << 1) | (qd >> 1)) << 2); }
template <int CTRL> __device__ __forceinline__ float dpp_f(float v) { return __int_as_float(__builtin_amdgcn_update_dpp(0, __float_as_int(v), CTRL, 0xF, 0xF, true)); }
__device__ __forceinline__ float wave_sum(float v) {
    v += dpp_f<0xB1>(v);
    v += dpp_f<0x4E>(v);
    v += dpp_f<0x141>(v);
    v += dpp_f<0x140>(v);
    { auto rr = __builtin_amdgcn_permlane16_swap(__float_as_uint(v), __float_as_uint(v), false, false); v = __uint_as_float(rr[0]) + __uint_as_float(rr[1]); }
    { auto rr = __builtin_amdgcn_permlane32_swap(__float_as_uint(v), __float_as_uint(v), false, false); v = __uint_as_float(rr[0]) + __uint_as_float(rr[1]); }
    return v;
}
__device__ __forceinline__ float xsum16(float v) { auto rr = __builtin_amdgcn_permlane16_swap(__float_as_uint(v), __float_as_uint(v), false, false); return __uint_as_float(rr[0]) + __uint_as_float(rr[1]); }
__device__ __forceinline__ float xsum32(float v) { auto rr = __builtin_amdgcn_permlane32_swap(__float_as_uint(v), __float_as_uint(v), false, false); return __uint_as_float(rr[0]) + __uint_as_float(rr[1]); }
__device__ __forceinline__ float xmax32(float v) { auto rr = __builtin_amdgcn_permlane32_swap(__float_as_uint(v), __float_as_uint(v), false, false); return fmaxf(__uint_as_float(rr[0]), __uint_as_float(rr[1])); }

constexpr size_t MiB = 1u << 20;
constexpr size_t WS_CTL = 0;
constexpr size_t WS_ROPE = 1 * MiB;
constexpr size_t WS_END = 256 * MiB;

#define LAS __attribute__((address_space(3)))
#define GAS __attribute__((address_space(1)))
typedef short bf16x8 __attribute__((ext_vector_type(8)));
typedef float f32x4 __attribute__((ext_vector_type(4)));
typedef unsigned u32x4 __attribute__((ext_vector_type(4)));
typedef unsigned u32x2 __attribute__((ext_vector_type(2)));
constexpr int NTHR = 512, NWAVE = 8;
constexpr int LDS_MISC = 162816;
constexpr int LDS_BYTES = LDS_MISC + 1024;

constexpr size_t WS_BAR = 64 * 1024;
constexpr size_t WS_KPE = 3 * MiB + 256 * 1024;
constexpr size_t W2_RSTD = 4 * MiB + 512 * 1024, W2_WSLOT = W2_RSTD + 80 * 1024, W2_EID = W2_WSLOT + 144 * 1024;
constexpr size_t W2_LIST = 5 * MiB;
constexpr size_t W2_WRF = 9 * MiB + 256 * 1024;
constexpr size_t W2_WQKV = 10 * MiB;
constexpr size_t W2_WO0 = W2_WQKV + 2560 * 1024;
constexpr size_t W2_WIN = W2_WO0 + 2048 * 1024;
constexpr size_t W2_WUQ = W2_WIN + 1024 * 1024;
constexpr size_t W2_WUKV = W2_WUQ + 768 * 1024;
constexpr size_t W2_WO1 = W2_WUKV + 512 * 1024;
constexpr size_t W2_HB = 20 * MiB;
constexpr size_t W2_RB = 53 * MiB;
constexpr size_t W2_RC = 134 * MiB;
static_assert(W2_EID + (size_t)MTOT * 8 <= W2_LIST && W2_LIST + (size_t)NE * CAP * 4 <= W2_WRF && W2_WO1 + 2 * MiB <= W2_HB && W2_HB + (size_t)MTOT * 2048 <= W2_RB, "fixed map");
constexpr size_t B_QKV = W2_RB, B_O0 = W2_RB + 41 * MiB, B_VT0 = W2_RB + 74 * MiB  , B_Y0 = W2_RB, B_CBUF = W2_RB, B_CQN = W2_RB + 33 * MiB, B_CKVN = W2_RB + 42 * MiB, B_O1 = W2_RB, B_W1 = W2_RB + 33 * MiB;
constexpr size_t C_W0 = W2_RC, C_HF = W2_RC + 48 * MiB, C_Q1 = W2_RC, C_K1 = W2_RC + 49 * MiB, C_V1 = W2_RC + 82 * MiB, C_HF1 = W2_RC, C_Y1 = W2_RC;
static_assert(C_V1 + (size_t)2 * 16 * 64 * LP * 2 <= WS_END && C_K1 + (size_t)2 * LP * 2048 <= C_V1 && B_VT0 + (size_t)2 * 2 * 64 * LP * 2 <= W2_RC && C_HF + (size_t)MTOT * 4096 <= WS_END && B_W1 + 48 * MiB <= W2_RC, "region map");
constexpr size_t MOE_WGU_BYTES = (size_t)NE * 512 * 1024 * 2, MOE_WD_BYTES = (size_t)NE * 1024 * 256 * 2;

struct MArgs { const float* in[23]; float* out; unsigned char* ws; int ph_lo, ph_hi, li, pad; };

__device__ __forceinline__ unsigned cvtpk(float lo, float hi) { typedef float f2 __attribute__((ext_vector_type(2))); typedef __bf16 b2 __attribute__((ext_vector_type(2)));
    f2 v = {lo, hi}; b2 r = __builtin_convertvector(v, b2); return __builtin_bit_cast(unsigned, r); }
__device__ __forceinline__ unsigned pk2(float lo, float hi) { return cvtpk(lo, hi); }

#define XB_TMO      128
#define XB_XCNT(j)  (256  + 64 * (j))
#define XB_XSUB(j)  (1280 + 64 * (j))
#define XB_XGEN(j)  (2304 + 64 * (j))
#define XB_TOP      3328
#define XB_TOPGEN   3392
#define XCD_BAR_WORDS 3456
#define XB_SPIN_CAP (1u << 18)
__device__ __forceinline__ unsigned xb_ld(unsigned* p)              { return __hip_atomic_load(p, __ATOMIC_RELAXED, __HIP_MEMORY_SCOPE_AGENT); }
__device__ __forceinline__ unsigned xb_add(unsigned* p, unsigned v) { return __hip_atomic_fetch_add(p, v, __ATOMIC_RELAXED, __HIP_MEMORY_SCOPE_AGENT); }
__device__ __forceinline__ unsigned xb_xcc_id() { return (unsigned)__builtin_amdgcn_s_getreg((3 << 11) | 20) & 0xFu; }
#define XB_SPIN(cond, bar) do { unsigned _sp = 0; while (cond) { __builtin_amdgcn_s_sleep(1); \
    if ((++_sp & 255u) == 0u) { if (xb_ld(&(bar)[XB_TMO])) break; if (_sp > XB_SPIN_CAP) { atomicAdd(&(bar)[XB_TMO], 1u); break; } } } } while (0)
struct XcdBarrier { unsigned* bar; unsigned x; volatile LAS unsigned* st; };
__device__ __forceinline__ XcdBarrier xcd_barrier_post(unsigned* bar, volatile LAS unsigned* st) {
    XcdBarrier b; b.bar = bar; b.x = xb_xcc_id(); b.st = st;
    if (threadIdx.x == 0) (void)xb_add(&bar[XB_XCNT(b.x)], 1u);
    return b;
}
__device__ __forceinline__ void xcd_barrier_complete(unsigned* bar, unsigned x, unsigned& nloc, unsigned& nx) {
    const unsigned G = gridDim.x * gridDim.y * gridDim.z;
    unsigned sum, cnt, mine, sp = 0u;
    for (;;) {
        sum = 0u; cnt = 0u; mine = 0u;
#pragma unroll
        for (unsigned j = 0; j < 16; ++j) { const unsigned c = xb_ld(&bar[XB_XCNT(j)]); sum += c; cnt += (c > 0u) ? 1u : 0u; mine = (j == x) ? c : mine; }
        if (sum == G) break;
        __builtin_amdgcn_s_sleep(1);
        if ((++sp & 255u) == 0u) { if (xb_ld(&bar[XB_TMO])) break; if (sp > XB_SPIN_CAP) { atomicAdd(&bar[XB_TMO], 1u); break; } }
    }
    nloc = mine > 0u ? mine : 1u; nx = cnt > 0u ? cnt : 1u;
}
__device__ __forceinline__ void xcd_barrier(const XcdBarrier& b) {
    asm volatile("s_waitcnt vmcnt(0)" ::: "memory");
    __syncthreads();
    if (threadIdx.x == 0) {
        unsigned* bar = b.bar;
        __builtin_amdgcn_s_waitcnt(0);
        unsigned nloc = b.st[0], nx = b.st[1];
        if (nloc == 0u) { xcd_barrier_complete(bar, b.x, nloc, nx); b.st[0] = nloc; b.st[1] = nx; }
        const unsigned old = xb_add(&bar[XB_XSUB(b.x)], 1u);
        const unsigned gen = old / nloc;
        if (old + 1u == (gen + 1u) * nloc) {
            __builtin_amdgcn_fence(__ATOMIC_RELEASE, "agent");
            asm volatile("s_waitcnt vmcnt(0)" ::: "memory");
            const unsigned og = xb_add(&bar[XB_TOP], 1u);
            const unsigned tg = og / nx;
            if (og + 1u == (tg + 1u) * nx) xb_add(&bar[XB_TOPGEN], 1u);
            else XB_SPIN(xb_ld(&bar[XB_TOPGEN]) == tg, bar);
            __builtin_amdgcn_fence(__ATOMIC_ACQUIRE, "agent");
            xb_add(&bar[XB_XGEN(b.x)], 1u);
            asm volatile("s_waitcnt vmcnt(0)" ::: "memory");
        } else {
            XB_SPIN(xb_ld(&bar[XB_XGEN(b.x)]) == gen, bar);
            __builtin_amdgcn_fence(__ATOMIC_ACQUIRE, "agent");
            asm volatile("s_waitcnt vmcnt(0)" ::: "memory");
        }
    }
    __syncthreads();
}

template <int N> __device__ __forceinline__ void wait_vm() { asm volatile("s_waitcnt vmcnt(%0)" :: "n"(N) : "memory"); }
__device__ __forceinline__ int swzF(int g) { return (0x78 >> (2 * g)) & 3; }
constexpr int GT_NS = 4;
template <int MT, int NT, int WM, int WN, bool NSW, class RowA, class Epi, bool NOLD = false>
__device__ __forceinline__ void gemm_tile(LAS unsigned char* lds, const RowA& rowA, const bf16_t* __restrict__ Bt, int ldb  , int nk  , Epi& epi) {
    constexpr int BM = WM * MT * 16, BN = WN * NT * 16, GA = BM / 16, G = (BM + BN) / 16, NG = (G + 7) / 8, GR = G % 8, STAGE = (BM + BN) * 64;
    static_assert(WM * WN == 8 && GT_NS * STAGE <= LDS_MISC && BM % 16 == 0 && BN % 16 == 0, "gemm_tile config");
    const int tid = threadIdx.x, lane = tid & 63, wave = __builtin_amdgcn_readfirstlane(tid >> 6), wm = wave / WN, wn = wave % WN;
    const char* src[NG];
    const int lc = (lane & 3) ^ swzF(lane >> 4);
#pragma unroll
    for (int i = 0; i < NG; ++i) {
        const int g = wave + 8 * i;
        if (g < GA) src[i] = (const char*)rowA(g * 16 + (lane >> 2)) + lc * 16;
        else if (g < G) src[i] = (const char*)(Bt + (size_t)((g - GA) * 16 + (lane >> 2)) * ldb) + lc * 16;
        else src[i] = nullptr;
    }
    f32x4 acc[MT][NT];
#pragma unroll
    for (int mi = 0; mi < MT; ++mi)
#pragma unroll
        for (int ni = 0; ni < NT; ++ni) acc[mi][ni] = (f32x4){0.f, 0.f, 0.f, 0.f};
    const int fro = (lane & 15) * 64 + (((lane >> 4) ^ swzF((lane >> 2) & 3)) << 4);
    constexpr int LM = PROBE_PHASE == 402 ? 2 : 1;
#define GT_STAGE(st, kt) do { _Pragma("unroll") for (int _i = 0; _i < NG; ++_i) { const int _g = wave + 8 * _i; if (_g < G) { \
        __builtin_amdgcn_global_load_lds((const unsigned*)(src[_i] + (size_t)(kt) * 64), (LAS unsigned*)(lds + (st) * STAGE + _g * 1024), 16, 0, 0); \
        if (LM == 2) __builtin_amdgcn_global_load_lds((const unsigned*)(src[_i] + (size_t)(kt) * 64), (LAS unsigned*)(lds + (st) * STAGE + _g * 1024), 16, 0, 0); } } } while (0)
#define GT_WAIT(ntl) do { if (GR == 0 || wave < GR) wait_vm<LM * NG * (ntl)>(); else wait_vm<LM * (NG - 1) * (ntl)>(); } while (0)
    if (!NOLD) { GT_STAGE(0, 0);
    if (nk > 1) GT_STAGE(1, 1);
    if (nk > 2) GT_STAGE(2, 2); }
    int st = 0;
    for (int kt = 0; kt < nk; ++kt) {
        const int rem = nk - 1 - kt;
        if (!NOLD) { if (rem >= 2) GT_WAIT(2); else if (rem == 1) GT_WAIT(1); else GT_WAIT(0); }
        __builtin_amdgcn_s_barrier(); asm volatile("" ::: "memory");
        const bool doload = (!NOLD || PROBE_PHASE == 505) && kt + 3 < nk;
        LAS const unsigned char* sa = lds + st * STAGE + (wm * MT * 16) * 64 + fro;
        LAS const unsigned char* sb = lds + st * STAGE + (BM + wn * NT * 16) * 64 + fro;
        bf16x8 bfr[NT];
#pragma unroll
        for (int ni = 0; ni < NT; ++ni) bfr[ni] = *(LAS const bf16x8*)(sb + ni * 1024);
        constexpr int PG = MT >= 2 ? 2 : 1, NPG = MT / PG;
        constexpr int LPG = (NG + NPG - 1) / NPG;
        bf16x8 afc[PG], afn[PG];
#pragma unroll
        for (int i = 0; i < PG; ++i) afc[i] = *(LAS const bf16x8*)(sa + i * 1024);
#pragma unroll
        for (int pg = 0; pg < NPG; ++pg) {
            if (doload) {
#pragma unroll
                for (int l = 0; l < LPG; ++l) { const int _i = pg * LPG + l; if (_i < NG) { const int _g = wave + 8 * _i; if (_g < G)
                    __builtin_amdgcn_global_load_lds((const unsigned*)(src[_i] + (size_t)(kt + 3) * 64), (LAS unsigned*)(lds + ((st + 3) & 3) * STAGE + _g * 1024), 16, 0, 0); } }
            }
            if (pg + 1 < NPG) {
#pragma unroll
                for (int i = 0; i < PG; ++i) afn[i] = *(LAS const bf16x8*)(sa + ((pg + 1) * PG + i) * 1024);
            }
#pragma unroll
            for (int i = 0; i < PG; ++i) { const int mi = pg * PG + i;
#pragma unroll
                for (int ni = 0; ni < NT; ++ni) {
                    if (NSW) acc[mi][ni] = __builtin_amdgcn_mfma_f32_16x16x32_bf16(afc[i], bfr[ni], acc[mi][ni], 0, 0, 0);
                    else acc[mi][ni] = __builtin_amdgcn_mfma_f32_16x16x32_bf16(bfr[ni], afc[i], acc[mi][ni], 0, 0, 0);
                } }
#pragma unroll
            for (int i = 0; i < PG; ++i) afc[i] = afn[i];
            __builtin_amdgcn_sched_barrier(0);
        }
        st = (st + 1) & 3;
    }
#undef GT_STAGE
#undef GT_WAIT
    epi(acc, wm * MT * 16, wn * NT * 16, lane);
    asm volatile("s_waitcnt lgkmcnt(0)" ::: "memory");
    __syncthreads();
}

struct RowDense { const bf16_t* A; int lda, m0, mlast; __device__ __forceinline__ const bf16_t* operator()(int r) const { int row = m0 + r; row = row > mlast ? mlast : row; return A + (size_t)row * lda; } };

namespace pg8 {
#define PG8_LAS __attribute__((address_space(3)))
typedef unsigned short bf16_t;
typedef short bf16x8 __attribute__((ext_vector_type(8)));
typedef float f32x4 __attribute__((ext_vector_type(4)));
typedef unsigned u32x4 __attribute__((ext_vector_type(4)));
constexpr int BM = 256, BK = 64, HALF = 128, HTB = HALF * BK * 2  , STAGE_BYTES = 8 * HTB, NXCD = 8, WGM = 8;

__host__ __device__ __forceinline__ int lds_byte(int r, int c) { const int st = (r >> 4) * 2 + (c >> 5), rr = r & 15, cc = c & 31, ob = rr * 64 + cc * 2; return st * 1024 + (ob ^ (((ob >> 9) & 1) << 5)); }
__host__ __device__ __forceinline__ void stage_rc(int b, int& R, int& C) { const int st = b / 1024, sb = b % 1024, swz = sb ^ (((sb >> 9) & 1) << 5); R = (st >> 1) * 16 + swz / 64; C = (st & 1) * 32 + (swz % 64) / 2; }
__host__ __device__ __forceinline__ int perm32(int rho) { const int n = rho >> 4, i = rho & 15; return 8 * (i >> 2) + 4 * n + (i & 3); }

struct Unit { int pm, pn; };
struct Gemm { const bf16_t* A; const bf16_t* Bt; int M, N, K; };

struct StaticOrder {
    int nM, nN, nwg, G, c;
    __host__ __device__ void init(int M, int N, int G_, int c_) { nM = M / BM; nN = N / BM; nwg = nM * nN; G = G_; c = c_; }
    __host__ __device__ bool next(int i, Unit& u) const {
        const long L = (long)i * G + c; if (L >= nwg) return false;
        int wgid = (int)L; { const int q = nwg / NXCD, r = nwg % NXCD, xcd = wgid % NXCD, off = wgid / NXCD; wgid = (xcd < r ? xcd * (q + 1) : r * (q + 1) + (xcd - r) * q) + off; }
        const int nig = WGM * nN, gid = wgid / nig, fm = gid * WGM, gsz = (nM - fm) < WGM ? (nM - fm) : WGM;
        u.pm = fm + ((wgid % nig) % gsz); u.pn = (wgid % nig) / gsz; return true;
    }
    __device__ __forceinline__ void a_ready(const Unit&) const {}
    __device__ __forceinline__ void done(const Unit&) const {}
};


template <class Epi, class Sched, bool ALIGN_EPI = false, bool SP2 = false>
__device__ __forceinline__ void gemm_phase(PG8_LAS unsigned char* lds, const Gemm g, const Sched& S, const Epi& E) {
    const int tid = threadIdx.x, wid = __builtin_amdgcn_readfirstlane(tid >> 6), lane = tid & 63, wr = wid >> 2, wc = wid & 3, fr = lane & 15, fq = lane >> 4;
    const int K = g.K, nt = K / BK;
    unsigned voffA[2], voffB[2];
#pragma unroll
    for (int i = 0; i < 2; ++i) { int R, C; stage_rc(tid * 16 + i * 8192, R, C); const int Rb = Epi::PERM ? ((R & ~31) + perm32(R & 31)) : R;
        voffA[i] = (unsigned)(R * K + C) * 2u; voffB[i] = (unsigned)(Rb * K + C) * 2u; }
    const size_t kstep = (size_t)(BK * 2);
    const size_t hstep = (size_t)HALF * K * 2;
    const size_t tstep = 2 * hstep;
    const unsigned ldsw = (unsigned)wid * 1024u;
    const int aoff = lds_byte(wr * 64 + fr, fq * 8), boff = lds_byte(wc * 32 + fr, fq * 8);
#define PG8_SA(b, h) (((b) * 2 + (h)) * HTB)
#define PG8_SB(b, h) ((4 + (b) * 2 + (h)) * HTB)
#define PG8_STAGE(bufoff, gbase, voff) do { _Pragma("unroll") for (int _i = 0; _i < 2; ++_i) \
        __builtin_amdgcn_global_load_lds((const unsigned*)((const char*)(gbase) + (voff)[_i]), (PG8_LAS unsigned*)(lds + (bufoff) + ldsw + _i * 8192), 16, 0, 0); } while (0)
#define PG8_LDA(dst, b, h) do { _Pragma("unroll") for (int m = 0; m < 4; ++m) _Pragma("unroll") for (int k = 0; k < 2; ++k) dst[m][k] = *(const PG8_LAS bf16x8*)(lds + PG8_SA(b, h) + aoff + m * 2048 + k * 1024); } while (0)
#define PG8_LDB(dst, b, h) do { _Pragma("unroll") for (int n = 0; n < 2; ++n) _Pragma("unroll") for (int k = 0; k < 2; ++k) dst[n][k] = *(const PG8_LAS bf16x8*)(lds + PG8_SB(b, h) + boff + n * 2048 + k * 1024); } while (0)
#define PG8_MMA(ai, bj, At, Bt) do { __builtin_amdgcn_s_setprio(1); _Pragma("unroll") for (int m = 0; m < 4; ++m) _Pragma("unroll") for (int n = 0; n < 2; ++n) _Pragma("unroll") for (int k = 0; k < 2; ++k) \
        acc[ai][bj][m][n] = __builtin_amdgcn_mfma_f32_16x16x32_bf16(Bt[n][k], At[m][k], acc[ai][bj][m][n], 0, 0, 0); __builtin_amdgcn_s_setprio(0); } while (0)
#define PG8_WAIT_V(n) asm volatile("s_waitcnt vmcnt(" #n ")" ::: "memory")
#define PG8_WAIT_L(n) asm volatile("s_waitcnt lgkmcnt(" #n ")" ::: "memory")
#define PG8_BAR __builtin_amdgcn_s_barrier()
#define PG8_SCHED __builtin_amdgcn_sched_barrier(0)
    Unit cur, nxt; int ui = 0;
    if (!S.next(0, cur)) return;
    f32x4 acc[2][2][4][2];
#pragma unroll
    for (int a = 0; a < 2; ++a)
#pragma unroll
        for (int b = 0; b < 2; ++b)
#pragma unroll
            for (int m = 0; m < 4; ++m)
#pragma unroll
                for (int n = 0; n < 2; ++n) acc[a][b][m][n] = (f32x4){0.f, 0.f, 0.f, 0.f};
    bf16x8 At[4][2], B0[2][2], B1[2][2];
    const char* cA = (const char*)g.A + (size_t)cur.pm * tstep; const char* cB = (const char*)g.Bt + (size_t)cur.pn * tstep;
    S.a_ready(cur);
    if constexpr (SP2) {
        PG8_STAGE(PG8_SB(0, 0), cB, voffB); PG8_STAGE(PG8_SB(0, 1), cB + hstep, voffB); PG8_STAGE(PG8_SA(0, 0), cA, voffA); PG8_STAGE(PG8_SA(0, 1), cA + hstep, voffA);
        if (wr == 1) PG8_BAR;
        PG8_WAIT_V(2); PG8_BAR;
        PG8_STAGE(PG8_SB(1, 0), cB + kstep, voffB); PG8_STAGE(PG8_SA(1, 0), cA + kstep, voffA); PG8_STAGE(PG8_SB(1, 1), cB + hstep + kstep, voffB);
        PG8_WAIT_V(6); PG8_BAR;
    } else {
        PG8_STAGE(PG8_SB(0, 0), cB, voffB); PG8_STAGE(PG8_SA(0, 0), cA, voffA); PG8_STAGE(PG8_SB(0, 1), cB + hstep, voffB); PG8_STAGE(PG8_SA(0, 1), cA + hstep, voffA);
        if (wr == 1) PG8_BAR;
        PG8_WAIT_V(4); PG8_BAR;
        PG8_STAGE(PG8_SB(1, 0), cB + kstep, voffB); PG8_STAGE(PG8_SA(1, 0), cA + kstep, voffA); PG8_STAGE(PG8_SB(1, 1), cB + hstep + kstep, voffB);
        PG8_WAIT_V(6); PG8_BAR;
    }
    for (;;) {
        const bool has_next = S.next(ui + 1, nxt);
        const char* nA = has_next ? (const char*)g.A + (size_t)nxt.pm * tstep : cA; const char* nB = has_next ? (const char*)g.Bt + (size_t)nxt.pn * tstep : cB;
        for (int t = 0; t < nt; t += 2) {
            const bool last = (t == nt - 2);
            const char* a1 = cA + (size_t)(t + 1) * kstep;
            const char* a2 = last ? nA : cA + (size_t)(t + 2) * kstep; const char* b2 = last ? nB : cB + (size_t)(t + 2) * kstep;
            const char* a3 = a2 + kstep; const char* b3 = b2 + kstep;
            if (last && has_next) S.a_ready(nxt);
            if constexpr (SP2) {
            PG8_LDB(B0, 0, 0); PG8_LDB(B1, 0, 1); PG8_SCHED; PG8_LDA(At, 0, 0); PG8_STAGE(PG8_SA(1, 1), a1 + hstep, voffA);
            PG8_WAIT_V(8); PG8_WAIT_L(0); PG8_BAR; PG8_MMA(0, 0, At, B0); PG8_MMA(0, 1, At, B1); PG8_BAR; PG8_SCHED;
            PG8_LDA(At, 0, 1); PG8_STAGE(PG8_SB(0, 0), b2, voffB); PG8_STAGE(PG8_SB(0, 1), b2 + hstep, voffB); PG8_STAGE(PG8_SA(0, 0), a2, voffA);
            PG8_WAIT_V(8); PG8_WAIT_L(0); PG8_BAR; PG8_MMA(1, 0, At, B0); PG8_MMA(1, 1, At, B1); PG8_BAR; PG8_SCHED;
            PG8_LDB(B0, 1, 0); PG8_LDB(B1, 1, 1); PG8_SCHED; PG8_LDA(At, 1, 0); PG8_STAGE(PG8_SA(0, 1), a2 + hstep, voffA);
            PG8_WAIT_V(8); PG8_WAIT_L(0); PG8_BAR; PG8_MMA(0, 0, At, B0); PG8_MMA(0, 1, At, B1); PG8_BAR; PG8_SCHED;
            PG8_LDA(At, 1, 1); PG8_STAGE(PG8_SB(1, 0), b3, voffB); PG8_STAGE(PG8_SB(1, 1), b3 + hstep, voffB); PG8_STAGE(PG8_SA(1, 0), a3, voffA);
            PG8_WAIT_V(8); PG8_WAIT_L(0); PG8_BAR; PG8_MMA(1, 0, At, B0); PG8_MMA(1, 1, At, B1); PG8_BAR; PG8_SCHED;
            } else {
            PG8_LDB(B0, 0, 0); PG8_SCHED; PG8_LDA(At, 0, 0); PG8_STAGE(PG8_SA(1, 1), a1 + hstep, voffA);
            PG8_WAIT_L(8); PG8_BAR; PG8_WAIT_L(0); PG8_MMA(0, 0, At, B0); PG8_BAR; PG8_SCHED;
            PG8_LDB(B1, 0, 1); PG8_STAGE(PG8_SB(0, 0), b2, voffB);
            PG8_BAR; PG8_WAIT_L(0); PG8_MMA(0, 1, At, B1); PG8_BAR;
            PG8_LDA(At, 0, 1); PG8_STAGE(PG8_SA(0, 0), a2, voffA);
            PG8_BAR; PG8_WAIT_L(0); PG8_MMA(1, 0, At, B0); PG8_BAR; PG8_SCHED;
            PG8_STAGE(PG8_SB(0, 1), b2 + hstep, voffB);
            PG8_WAIT_V(6); PG8_BAR; PG8_MMA(1, 1, At, B1); PG8_BAR;
            PG8_LDB(B0, 1, 0); PG8_SCHED; PG8_LDA(At, 1, 0); PG8_STAGE(PG8_SA(0, 1), a2 + hstep, voffA);
            PG8_WAIT_L(8); PG8_BAR; PG8_WAIT_L(0); PG8_MMA(0, 0, At, B0); PG8_BAR; PG8_SCHED;
            PG8_LDB(B1, 1, 1); PG8_STAGE(PG8_SB(1, 0), b3, voffB);
            PG8_BAR; PG8_WAIT_L(0); PG8_MMA(0, 1, At, B1); PG8_BAR;
            PG8_LDA(At, 1, 1); PG8_STAGE(PG8_SA(1, 0), a3, voffA);
            PG8_BAR; PG8_WAIT_L(0); PG8_MMA(1, 0, At, B0); PG8_BAR; PG8_SCHED;
            PG8_STAGE(PG8_SB(1, 1), b3 + hstep, voffB);
            PG8_WAIT_V(6); PG8_BAR; PG8_MMA(1, 1, At, B1); PG8_BAR;
            }
        }
        if constexpr (ALIGN_EPI) { if (wr == 0) PG8_BAR; }
        if constexpr (!Epi::AFTER_DRAIN) { E(acc, cur, wr, wc, fr, fq); S.done(cur); }
        if (!has_next) break;
#pragma unroll
        for (int a = 0; a < 2; ++a)
#pragma unroll
            for (int b = 0; b < 2; ++b)
#pragma unroll
                for (int m = 0; m < 4; ++m)
#pragma unroll
                    for (int n = 0; n < 2; ++n) acc[a][b][m][n] = (f32x4){0.f, 0.f, 0.f, 0.f};
        cur = nxt; cA = nA; cB = nB; ++ui;
        if constexpr (ALIGN_EPI) { if (wr == 1) PG8_BAR; }
    }
    PG8_WAIT_V(0);
    if constexpr (!ALIGN_EPI) { if (wr == 0) PG8_BAR; }
    PG8_BAR;
    if constexpr (Epi::AFTER_DRAIN) { E.fused(acc, cur, wr, wc, fr, fq, lds, wid, lane); S.done(cur); }
#undef PG8_SA
#undef PG8_SB
#undef PG8_STAGE
#undef PG8_LDA
#undef PG8_LDB
#undef PG8_MMA
#undef PG8_WAIT_V
#undef PG8_WAIT_L
#undef PG8_BAR
#undef PG8_SCHED
}
}

struct PgEpiRes {
    static constexpr bool PERM = false, AFTER_DRAIN = false;
    const float* bias; unsigned short* hb;
    __device__ __forceinline__ void operator()(const pg8::f32x4 (&acc)[2][2][4][2], const pg8::Unit& u, int wr, int wc, int fr, int fq) const {
#pragma unroll
        for (int ai = 0; ai < 2; ++ai)
#pragma unroll
            for (int m = 0; m < 4; ++m) { const int row = u.pm * 256 + ai * 128 + wr * 64 + m * 16 + fr;
#pragma unroll
                for (int bj = 0; bj < 2; ++bj)
#pragma unroll
                    for (int n = 0; n < 2; ++n) { const int col = u.pn * 256 + bj * 128 + wc * 32 + n * 16 + fq * 4;
                        u32x2* p = (u32x2*)(hb + (size_t)row * D + col); const u32x2 h = *p; pg8::f32x4 v = acc[ai][bj][m][n];
                        if (bias) v += *(const pg8::f32x4*)(bias + col);
                        v[0] += __uint_as_float(h.x << 16); v[1] += __uint_as_float(h.x & 0xffff0000u); v[2] += __uint_as_float(h.y << 16); v[3] += __uint_as_float(h.y & 0xffff0000u);
                        *p = (u32x2){pk2(v[0], v[1]), pk2(v[2], v[3])}; } }
    }
};
struct PgEpiQ {
    static constexpr bool PERM = false, AFTER_DRAIN = false;
    const float* rstd; const float* bias; const float2* cs; unsigned short* qkv;
    __device__ __forceinline__ void operator()(const pg8::f32x4 (&acc)[2][2][4][2], const pg8::Unit& u, int wr, int wc, int fr, int fq) const {
#pragma unroll
        for (int ai = 0; ai < 2; ++ai)
#pragma unroll
            for (int m = 0; m < 4; ++m) { const int row = u.pm * 256 + ai * 128 + wr * 64 + m * 16 + fr; const float rs = rstd[row]; const int pos = row_pos(row);
#pragma unroll
                for (int bj = 0; bj < 2; ++bj) { const int g = 8 * u.pn + 4 * bj + wc, hh = g >> 1, d = 16 * (g & 1) + 4 * fq;
                    const pg8::f32x4 b1 = *(const pg8::f32x4*)(bias + 64 * hh + d), b2 = *(const pg8::f32x4*)(bias + 64 * hh + 32 + d);
                    float o1[4], o2[4];
#pragma unroll
                    for (int r = 0; r < 4; ++r) { const float2 t = cs[pos * 32 + d + r]; const float x1 = acc[ai][bj][m][0][r] * rs + b1[r], x2 = acc[ai][bj][m][1][r] * rs + b2[r];
                        o1[r] = (x1 * t.x - x2 * t.y) * 0.125f; o2[r] = (x2 * t.x + x1 * t.y) * 0.125f; }
                    unsigned short* orow = qkv + (size_t)row * NQKV + 64 * hh + d;
                    *(u32x2*)orow = (u32x2){pk2(o1[0], o1[1]), pk2(o1[2], o1[3])}; *(u32x2*)(orow + 32) = (u32x2){pk2(o2[0], o2[1]), pk2(o2[2], o2[3])}; } }
    }
};

struct EpiQKV {
    const float* rstd; const float* bias; const float2* cs; bf16_t* qkv; int m0, n0; bool perm;
    template <int MT, int NT> __device__ __forceinline__ void operator()(f32x4 (&acc)[MT][NT], int mb, int nb, int lane) const {
        static_assert(NT == 4, "rope needs a 64-column wave span");
        const int cb = n0 + nb, d0 = (lane >> 4) * 4;
#pragma unroll
        for (int mi = 0; mi < MT; ++mi) {
            const int row = m0 + mb + mi * 16 + (lane & 15);
            if (row < MTOT) {
                const float rs = rstd[row]; const int pos = row_pos(row);
                bf16_t* orow = qkv + (size_t)row * NQKV + cb;
                {
                    const float sc = cb < 1024 ? 0.125f : 1.0f;
#pragma unroll
                    for (int ni = 0; ni < 2; ++ni) {
                        const int d = ni * 16 + d0;
                        const f32x4 b1 = *(const f32x4*)(bias + cb + d), b2 = *(const f32x4*)(bias + cb + 32 + d);
                        const f32x4 a1 = perm ? acc[mi][2 * ni] : acc[mi][ni], a2 = perm ? acc[mi][2 * ni + 1] : acc[mi][ni + 2];
                        float o1[4], o2[4];
#pragma unroll
                        for (int r = 0; r < 4; ++r) {
                            const float2 t = cs[pos * 32 + d + r];
                            const float x1 = a1[r] * rs + b1[r], x2 = a2[r] * rs + b2[r];
                            o1[r] = (x1 * t.x - x2 * t.y) * sc; o2[r] = (x2 * t.x + x1 * t.y) * sc;
                        }
                        *(u32x2*)(orow + d) = (u32x2){pk2(o1[0], o1[1]), pk2(o1[2], o1[3])};
                        *(u32x2*)(orow + 32 + d) = (u32x2){pk2(o2[0], o2[1]), pk2(o2[2], o2[3])};
                    }
                }
            }
        }
    }
};
struct EpiV0 {
    const float* rstd; const float* bias; bf16_t* vt0; int m0, n0;
    template <int MT, int NT> __device__ __forceinline__ void operator()(f32x4 (&acc)[MT][NT], int mb, int nb, int lane) const {
        static_assert(NT == 4, "64-column wave span");
        const int cb = n0 + nb, kh = (cb - 1152) >> 6;
#pragma unroll
        for (int mi = 0; mi < MT; ++mi) {
            const int row0 = m0 + mb + mi * 16 + (lane >> 4) * 4;
            if (row0 < MTOT) {
                const f32x4 rs = *(const f32x4*)(rstd + row0); const int b = row_batch(row0), pp = perm16(row_pos(row0));
#pragma unroll
                for (int ni = 0; ni < NT; ++ni) { const int d = ni * 16 + (lane & 15); const float bb = bias[cb + d];
                    const f32x4 v = acc[mi][ni] * rs + bb;
                    *(u32x2*)(vt0 + (size_t)((b * 2 + kh) * 64 + d) * LP + pp) = (u32x2){pk2(v[0], v[1]), pk2(v[2], v[3])}; }
            }
        }
    }
};
struct EpiRes {
    const float* bias; bf16_t* hb; int m0, n0;
    template <int MT, int NT> __device__ __forceinline__ void operator()(f32x4 (&acc)[MT][NT], int mb, int nb, int lane) const {
#pragma unroll
        for (int mi = 0; mi < MT; ++mi) {
            const int row = m0 + mb + mi * 16 + (lane & 15);
            if (row < MTOT) {
#pragma unroll
                for (int ni = 0; ni < NT; ++ni) {
                    const int col = n0 + nb + ni * 16 + (lane >> 4) * 4;
                    u32x2* p = (u32x2*)(hb + (size_t)row * D + col);
                    const u32x2 h = *p;
                    f32x4 v = acc[mi][ni];
                    if (bias) v += *(const f32x4*)(bias + col);
                    v[0] += __uint_as_float(h.x << 16); v[1] += __uint_as_float(h.x & 0xffff0000u); v[2] += __uint_as_float(h.y << 16); v[3] += __uint_as_float(h.y & 0xffff0000u);
                    *p = (u32x2){pk2(v[0], v[1]), pk2(v[2], v[3])};
                }
            }
        }
    }
};
__device__ __forceinline__ void route_phase(LAS unsigned char* lds, const bf16_t* __restrict__ hbr, const float* __restrict__ wrf, const float* __restrict__ bg, const float* __restrict__ br,
                                            float* rstd_out, int* cnt, int* list, float* wslot, int bid, int nblk) {
    const int tid = threadIdx.x, lane = tid & 63, wave = __builtin_amdgcn_readfirstlane(tid >> 6);
    LAS f32x4* wl = (LAS f32x4*)lds;
    LAS int* nrec = (LAS int*)(lds + LDS_MISC + 16); LAS int* bcnt = (LAS int*)(lds + LDS_MISC + 32); LAS int* bbase = (LAS int*)(lds + LDS_MISC + 160); LAS int* rec = (LAS int*)(lds + LDS_MISC + 288);
    for (int i = tid; i < 36 * 256; i += NTHR) wl[i] = *(const f32x4*)(wrf + (size_t)i * 4);
    if (tid < NE) bcnt[tid] = 0;
    if (tid == 0) *nrec = 0;
    __syncthreads();
    for (int row = bid * NWAVE + wave; row < MTOT; row += nblk * NWAVE) {
        f32x4 x[4]; float ss = 0.f;
#pragma unroll
        for (int j = 0; j < 4; ++j) { const u32x2 h = *(const u32x2*)(hbr + (size_t)row * D + j * 256 + lane * 4);
            x[j] = (f32x4){__uint_as_float(h.x << 16), __uint_as_float(h.x & 0xffff0000u), __uint_as_float(h.y << 16), __uint_as_float(h.y & 0xffff0000u)};
            ss += x[j][0] * x[j][0] + x[j][1] * x[j][1] + x[j][2] * x[j][2] + x[j][3] * x[j][3]; }
        ss = wave_sum(ss);
        const float rs = rsqrtf(ss * (1.0f / D) + EPS);
        float lg[4];
#pragma unroll
        for (int c = 0; c < 4; ++c) { float p = 0.f;
#pragma unroll
            for (int j = 0; j < 4; ++j) { const f32x4 w = wl[c * 256 + j * 64 + lane]; p += x[j][0] * w[0] + x[j][1] * w[1] + x[j][2] * w[2] + x[j][3] * w[3]; }
            lg[c] = wave_sum(p) * rs + bg[c]; }
        int gi = 0; float gm = lg[0];
#pragma unroll
        for (int c = 1; c < 4; ++c) if (lg[c] > gm) { gm = lg[c]; gi = c; }
        float gs = 0.f;
#pragma unroll
        for (int c = 0; c < 4; ++c) gs += __expf(lg[c] - gm);
        const float gp = 1.0f / gs;
        gi = __builtin_amdgcn_readfirstlane(gi);
        float e[8];
#pragma unroll
        for (int c = 0; c < 8; ++c) { float p = 0.f;
#pragma unroll
            for (int j = 0; j < 4; ++j) { const f32x4 w = wl[(4 + gi * 8 + c) * 256 + j * 64 + lane]; p += x[j][0] * w[0] + x[j][1] * w[1] + x[j][2] * w[2] + x[j][3] * w[3]; }
            e[c] = wave_sum(p) * rs + br[gi * 8 + c]; }
        int i1 = 0; float v1 = e[0];
#pragma unroll
        for (int c = 1; c < 8; ++c) if (e[c] > v1) { v1 = e[c]; i1 = c; }
        int i2 = -1; float v2 = -3.0e38f;
#pragma unroll
        for (int c = 0; c < 8; ++c) if (c != i1 && e[c] > v2) { v2 = e[c]; i2 = c; }
        if (lane == 0) {
            const float r = __expf(v2 - v1);
            const float w1 = gp / (1.0f + r), w2 = gp * r / (1.0f + r);
            const int e1 = gi * 8 + i1, e2 = gi * 8 + i2;
            const int p1 = atomicAdd((int*)&bcnt[e1], 1), p2 = atomicAdd((int*)&bcnt[e2], 1);
            const int k = atomicAdd((int*)nrec, 2);
            rec[k] = ((row * 2) << 13) | (e1 << 8) | p1; rec[k + 1] = ((row * 2 + 1) << 13) | (e2 << 8) | p2;
            wslot[row * 2] = w1; wslot[row * 2 + 1] = w2; rstd_out[row] = rs;
        }
    }
    __syncthreads();
    if (tid < NE) { const int c = bcnt[tid]; bbase[tid] = c ? __hip_atomic_fetch_add(cnt + tid * 64, c, __ATOMIC_RELAXED, __HIP_MEMORY_SCOPE_AGENT) : 0; }
    __syncthreads();
    for (int k = tid; k < *nrec; k += NTHR) { const int r = rec[k], e = (r >> 8) & 31; list[(size_t)e * CAP + bbase[e] + (r & 255)] = r >> 13; }
    __syncthreads();
}
__device__ __forceinline__ void final_phase(const bf16_t* __restrict__ hb, const bf16_t* __restrict__ ybuf, const float* __restrict__ g, float* out, int bid, int nblk) {
    const int tid = threadIdx.x, lane = tid & 63, wave = tid >> 6;
    for (int row = bid * NWAVE + wave; row < MREAL; row += nblk * NWAVE) {
        f32x4 v[4]; float ss = 0.f;
#pragma unroll
        for (int j = 0; j < 4; ++j) { const size_t c = j * 256 + lane * 4;
            const u32x2 h = *(const u32x2*)(hb + (size_t)row * D + c), y0 = *(const u32x2*)(ybuf + (size_t)(row * 2) * D + c), y1 = *(const u32x2*)(ybuf + (size_t)(row * 2 + 1) * D + c);
            v[j][0] = __uint_as_float(h.x << 16) + __uint_as_float(y0.x << 16) + __uint_as_float(y1.x << 16);
            v[j][1] = __uint_as_float(h.x & 0xffff0000u) + __uint_as_float(y0.x & 0xffff0000u) + __uint_as_float(y1.x & 0xffff0000u);
            v[j][2] = __uint_as_float(h.y << 16) + __uint_as_float(y0.y << 16) + __uint_as_float(y1.y << 16);
            v[j][3] = __uint_as_float(h.y & 0xffff0000u) + __uint_as_float(y0.y & 0xffff0000u) + __uint_as_float(y1.y & 0xffff0000u);
            ss += v[j][0] * v[j][0] + v[j][1] * v[j][1] + v[j][2] * v[j][2] + v[j][3] * v[j][3]; }
        const float rs = rsqrtf(wave_sum(ss) * (1.0f / D) + EPS);
#pragma unroll
        for (int j = 0; j < 4; ++j) { const f32x4 gg = *(const f32x4*)(g + j * 256 + lane * 4); *(f32x4*)(out + (size_t)row * D + j * 256 + lane * 4) = v[j] * rs * gg; }
    }
}

typedef float f32x16 __attribute__((ext_vector_type(16)));
constexpr int AT_STAGE = 20480;
__device__ __forceinline__ float max3f(float a, float b, float c) { float r; asm("v_max3_f32 %0, %1, %2, %3" : "=v"(r) : "v"(a), "v"(b), "v"(c)); return r; }
__device__ __forceinline__ float max2f(float a, float b) { float r; asm("v_max_f32_e32 %0, %1, %2" : "=v"(r) : "v"(a), "v"(b)); return r; }
__device__ __forceinline__ float fadd_s(float a, float b) { float r; asm("v_add_f32_e32 %0, %1, %2" : "=v"(r) : "v"(a), "v"(b)); return r; }
__device__ __forceinline__ void mla_unit(LAS unsigned char* lds, int b, int h, int qi, const bf16_t* __restrict__ Q1, const bf16_t* __restrict__ K1, const bf16_t* __restrict__ kpe,
                                         const bf16_t* __restrict__ VT1, bf16_t* o) {
    const int tid = threadIdx.x, lane = tid & 63, wave = __builtin_amdgcn_readfirstlane(tid >> 6), r32 = lane & 31, hi = lane >> 5;
    const size_t qrow = (size_t)b * SEQ + 256 * qi + 32 * wave + r32;
    bf16x8 qf[6];
#pragma unroll
    for (int s = 0; s < 6; ++s) qf[s] = *(const bf16x8*)(Q1 + qrow * 1536 + h * 96 + 16 * s + 8 * hi);
    const int lr = 8 * wave + (lane >> 3);
    const char* ksrc = (const char*)(K1 + ((size_t)b * LP + lr) * 1024 + h * 64) + (((lane & 7) ^ ((lr >> 1) & 7)) << 4);
    const char* vsrc = (const char*)(VT1 + ((size_t)(b * 16 + h) * 64 + lr) * LP) + (((lane & 7) ^ ((lr >> 1) & 7)) << 4);
    const int pr = 16 * wave + (lane >> 2);
    const char* psrc = (const char*)(kpe + ((size_t)b * LP + (pr & 63)) * 32) + (((lane & 3) ^ ((pr >> 2) & 3)) << 4);
#define MLA_ISSUE(j, st) do { \
        __builtin_amdgcn_global_load_lds((const unsigned*)(ksrc + (size_t)(j) * (64 * 2048)), (LAS unsigned*)(lds + (st) * AT_STAGE + wave * 1024), 16, 0, 0); \
        __builtin_amdgcn_global_load_lds((const unsigned*)(vsrc + (size_t)(j) * 128), (LAS unsigned*)(lds + (st) * AT_STAGE + 8192 + wave * 1024), 16, 0, 0); \
        if (wave < 4) __builtin_amdgcn_global_load_lds((const unsigned*)(psrc + (size_t)(j) * (64 * 64)), (LAS unsigned*)(lds + (st) * AT_STAGE + 16384 + wave * 1024), 16, 0, 0); } while (0)
    const int NT = 4 * qi + 5, jmaxw = 4 * qi + ((32 * wave + 47) >> 6);
    const int qp = 16 + 256 * qi + 32 * wave + r32;
    const int koff = r32 * 128, ksw = (r32 >> 1) & 7, poff = 16384 + r32 * 64, psw = (r32 >> 2) & 3, voff = 8192 + r32 * 128;
    f32x16 oacc[2]; oacc[0] = (f32x16){}; oacc[1] = (f32x16){};
    constexpr float MLA_THR = 8.0f;
    float mref = 0.f, lsum = 0.f;
    f32x16 negm = (f32x16){};
    MLA_ISSUE(0, 0);
    if (NT > 1) MLA_ISSUE(1, 1);
    int st = 0;
    for (int j = 0; j < NT; ++j) {
        if (j + 1 < NT) { if (wave < 4) asm volatile("s_waitcnt vmcnt(3)" ::: "memory"); else asm volatile("s_waitcnt vmcnt(2)" ::: "memory"); }
        else asm volatile("s_waitcnt vmcnt(0)" ::: "memory");
        __builtin_amdgcn_s_barrier(); asm volatile("" ::: "memory");
        if (j + 2 < NT) { const int st2 = st >= 1 ? st - 1 : 2; MLA_ISSUE(j + 2, st2); }
        if (j <= jmaxw) {
            LAS const unsigned char* sb = lds + st * AT_STAGE;
            f32x16 p0, p1;
            {
                const bf16x8 k0 = *(LAS const bf16x8*)(sb + koff + ((hi ^ ksw) << 4));
                const bf16x8 k1 = *(LAS const bf16x8*)(sb + 4096 + koff + ((hi ^ ksw) << 4));
                p0 = __builtin_amdgcn_mfma_f32_32x32x16_bf16(k0, qf[0], negm, 0, 0, 0);
                p1 = __builtin_amdgcn_mfma_f32_32x32x16_bf16(k1, qf[0], negm, 0, 0, 0);
            }
#pragma unroll
            for (int s = 1; s < 4; ++s) {
                const bf16x8 k0 = *(LAS const bf16x8*)(sb + koff + (((2 * s + hi) ^ ksw) << 4));
                const bf16x8 k1 = *(LAS const bf16x8*)(sb + 4096 + koff + (((2 * s + hi) ^ ksw) << 4));
                p0 = __builtin_amdgcn_mfma_f32_32x32x16_bf16(k0, qf[s], p0, 0, 0, 0);
                p1 = __builtin_amdgcn_mfma_f32_32x32x16_bf16(k1, qf[s], p1, 0, 0, 0);
            }
#pragma unroll
            for (int s = 0; s < 2; ++s) {
                const bf16x8 k0 = *(LAS const bf16x8*)(sb + poff + (((2 * s + hi) ^ psw) << 4));
                const bf16x8 k1 = *(LAS const bf16x8*)(sb + 2048 + poff + (((2 * s + hi) ^ psw) << 4));
                p0 = __builtin_amdgcn_mfma_f32_32x32x16_bf16(k0, qf[4 + s], p0, 0, 0, 0);
                p1 = __builtin_amdgcn_mfma_f32_32x32x16_bf16(k1, qf[4 + s], p1, 0, 0, 0);
            }
            if (j >= 4 * qi) {
                const int kb0 = 64 * j + 4 * hi;
#pragma unroll
                for (int r = 0; r < 16; ++r) { const int kp = kb0 + (r & 3) + 8 * (r >> 2); if (kp > qp) p0[r] = -1e30f; if (kp + 32 > qp) p1[r] = -1e30f; }
            }
            asm volatile("s_nop 15\n\ts_nop 7" : "+v"(p0), "+v"(p1));
            float tm;
            { float ma = max3f(p0[0], p0[1], p1[0]), mb = max3f(p0[2], p0[3], p1[1]); ma = max3f(ma, p1[2], p1[3]);
#pragma unroll
              for (int r = 4; r < 16; r += 4) { ma = max3f(ma, p0[r], p0[r + 1]); mb = max3f(mb, p0[r + 2], p0[r + 3]); ma = max3f(ma, p1[r], p1[r + 1]); mb = max3f(mb, p1[r + 2], p1[r + 3]); }
              tm = max2f(ma, mb); }
            { auto rr = __builtin_amdgcn_permlane32_swap(__float_as_uint(tm), __float_as_uint(tm), false, false);
              tm = fmaxf(__uint_as_float(rr[0]), __uint_as_float(rr[1])); }
            if (j == 0 || __any(tm > MLA_THR)) {
                const float dl = j == 0 ? tm : fmaxf(tm, 0.f);
                mref += dl;
                const float f = __builtin_amdgcn_exp2f(-dl);
                lsum *= f;
#pragma unroll
                for (int r = 0; r < 16; ++r) { oacc[0][r] *= f; oacc[1][r] *= f; p0[r] -= dl; p1[r] -= dl; negm[r] = -mref; }
            }
            float ps = 0.f;
#pragma unroll
            for (int r = 0; r < 16; ++r) { p0[r] = __builtin_amdgcn_exp2f(p0[r]); p1[r] = __builtin_amdgcn_exp2f(p1[r]); }
            asm volatile("s_nop 1" : "+v"(p0), "+v"(p1));
#pragma unroll
            for (int r = 0; r < 16; ++r) { ps = fadd_s(ps, p0[r]); ps = fadd_s(ps, p1[r]); }
            lsum += ps;
            u32x4 pf[4];
            pf[0] = (u32x4){cvtpk(p0[0], p0[1]), cvtpk(p0[2], p0[3]), cvtpk(p0[4], p0[5]), cvtpk(p0[6], p0[7])};
            pf[1] = (u32x4){cvtpk(p0[8], p0[9]), cvtpk(p0[10], p0[11]), cvtpk(p0[12], p0[13]), cvtpk(p0[14], p0[15])};
            pf[2] = (u32x4){cvtpk(p1[0], p1[1]), cvtpk(p1[2], p1[3]), cvtpk(p1[4], p1[5]), cvtpk(p1[6], p1[7])};
            pf[3] = (u32x4){cvtpk(p1[8], p1[9]), cvtpk(p1[10], p1[11]), cvtpk(p1[12], p1[13]), cvtpk(p1[14], p1[15])};
#pragma unroll
            for (int s = 0; s < 4; ++s) {
                const bf16x8 v0 = *(LAS const bf16x8*)(sb + voff + (((2 * s + hi) ^ ksw) << 4));
                const bf16x8 v1 = *(LAS const bf16x8*)(sb + 4096 + voff + (((2 * s + hi) ^ ksw) << 4));
                const bf16x8 pb = __builtin_bit_cast(bf16x8, pf[s]);
                oacc[0] = __builtin_amdgcn_mfma_f32_32x32x16_bf16(v0, pb, oacc[0], 0, 0, 0);
                oacc[1] = __builtin_amdgcn_mfma_f32_32x32x16_bf16(v1, pb, oacc[1], 0, 0, 0);
            }
        }
        st = st == 2 ? 0 : st + 1;
    }
#undef MLA_ISSUE
    lsum = xsum32(lsum);
    const float inv = 1.0f / lsum;
    bf16_t* orow = o + qrow * D + h * 64 + 4 * hi;
#pragma unroll
    for (int db = 0; db < 2; ++db)
#pragma unroll
        for (int g = 0; g < 4; ++g)
            *(u32x2*)(orow + 32 * db + 8 * g) = (u32x2){cvtpk(oacc[db][4 * g] * inv, oacc[db][4 * g + 1] * inv), cvtpk(oacc[db][4 * g + 2] * inv, oacc[db][4 * g + 3] * inv)};
    asm volatile("s_waitcnt lgkmcnt(0)" ::: "memory");
    __builtin_amdgcn_s_barrier(); asm volatile("" ::: "memory");
}
__device__ __forceinline__ void unpack8(const u32x4 v, float (&f)[8]) {
    f[0] = __uint_as_float(v.x << 16); f[1] = __uint_as_float(v.x & 0xffff0000u); f[2] = __uint_as_float(v.y << 16); f[3] = __uint_as_float(v.y & 0xffff0000u);
    f[4] = __uint_as_float(v.z << 16); f[5] = __uint_as_float(v.z & 0xffff0000u); f[6] = __uint_as_float(v.w << 16); f[7] = __uint_as_float(v.w & 0xffff0000u);
}
__device__ __forceinline__ void mla_meta(int b, int h, const bf16_t* __restrict__ Q1, const bf16_t* __restrict__ K1, const bf16_t* __restrict__ kpe, const bf16_t* __restrict__ VT1, bf16_t* o, int lane) {
    const int qi = lane & 15, part = lane >> 4; const size_t qrow = (size_t)MREAL + b * 16 + qi;
    float q[24];
#pragma unroll
    for (int c = 0; c < 3; ++c) { float f[8]; unpack8(*(const u32x4*)(Q1 + qrow * 1536 + h * 96 + 24 * part + 8 * c), f);
#pragma unroll
        for (int i = 0; i < 8; ++i) q[8 * c + i] = f[i]; }
    float sc[16]; float mx = -1e30f;
#pragma unroll
    for (int j = 0; j < 16; ++j) {
        const size_t kr = (size_t)b * LP + j; float s = 0.f;
#pragma unroll
        for (int c = 0; c < 3; ++c) { const int g = 24 * part + 8 * c;
            const bf16_t* src = g < 64 ? K1 + kr * D + h * 64 + g : kpe + kr * 32 + (g - 64);
            float f[8]; unpack8(*(const u32x4*)src, f);
#pragma unroll
            for (int i = 0; i < 8; ++i) s += q[8 * c + i] * f[i]; }
        s = xsum16(s); s = xsum32(s);
        sc[j] = j <= qi ? s : -1e30f; mx = fmaxf(mx, sc[j]);
    }
    float l = 0.f;
#pragma unroll
    for (int j = 0; j < 16; ++j) { sc[j] = exp2f(sc[j] - mx); l += sc[j]; }
    const float inv = 1.0f / l;
#pragma unroll
    for (int dd = 0; dd < 16; ++dd) { const int d = 16 * part + dd; const bf16_t* vr = VT1 + ((size_t)(b * 16 + h) * 64 + d) * LP;
        float e[16]; { float f[8]; unpack8(*(const u32x4*)vr, f);
#pragma unroll
            for (int i = 0; i < 8; ++i) e[i] = f[i]; unpack8(*(const u32x4*)(vr + 8), f);
#pragma unroll
            for (int i = 0; i < 8; ++i) e[8 + i] = f[i]; }
        float acc = 0.f;
#pragma unroll
        for (int j = 0; j < 16; ++j) acc += sc[j] * e[(j & 3) | ((((j >> 2) & 1) << 1 | ((j >> 3) & 1)) << 2)];
        o[qrow * D + h * 64 + d] = f2bf(acc * inv); }
}
__device__ __forceinline__ void mla_phase(LAS unsigned char* lds, const bf16_t* Q1, const bf16_t* K1, const bf16_t* kpe, const bf16_t* VT1, bf16_t* o, int bid, int nblk) {
    const int v = (nblk % 8 == 0) ? (bid % 8) * (nblk / 8) + bid / 8 : bid;
    for (int vv = v; vv < 256; vv += nblk) {
        const int bh = vv >> 3, s = vv & 7, b = bh >> 4, h = bh & 15;
#pragma unroll 1
        for (int i = 0; i < 4; ++i) { const int qi = (i == 0) ? s : (i == 1) ? 15 - s : (i == 2) ? 16 + s : 31 - s; mla_unit(lds, b, h, qi, Q1, K1, kpe, VT1, o); }
        if (s == 0 && threadIdx.x < 64) mla_meta(b, h, Q1, K1, kpe, VT1, o, threadIdx.x);
    }
}

constexpr int SW_K = 0, SW_V = 36864, SW_VP = 560;
__device__ __forceinline__ void swa_block32(LAS const unsigned char* lds, int rb, int gk0, int nks, int mode, int i_q, const bf16x8 (&qf)[4], float& m, float& lsum, f32x16 (&oacc)[2], int r32, int hi) {
    const float C2 = 1.4426950408889634f;
    const int ksw = (r32 >> 1) & 7;
    f32x16 p = (f32x16){};
#pragma unroll
    for (int s = 0; s < 4; ++s) { const bf16x8 k = *(LAS const bf16x8*)(lds + SW_K + (rb + r32) * 128 + (((2 * s + hi) ^ ksw) << 4)); p = __builtin_amdgcn_mfma_f32_32x32x16_bf16(k, qf[s], p, 0, 0, 0); }
    if (mode != 0) {
        const int jb = ((rb - 32) & 127) + 4 * hi;
#pragma unroll
        for (int r = 0; r < 16; ++r) { const int kk = (r & 3) + 8 * (r >> 2);
            const bool ok = mode == 1 ? (kk + 4 * hi < 16) : mode == 2 ? (jb + kk > i_q) : (jb + kk <= i_q);
            if (!ok) p[r] = -1e30f; }
    }
    float tm = p[0];
#pragma unroll
    for (int r = 1; r < 16; ++r) tm = fmaxf(tm, p[r]);
    tm = xmax32(tm);
    const float mn = fmaxf(m, tm), alpha = __builtin_amdgcn_exp2f((m - mn) * C2), nmc = -mn * C2;
    m = mn;
    float ps = 0.f;
#pragma unroll
    for (int r = 0; r < 16; ++r) { p[r] = __builtin_amdgcn_exp2f(__builtin_fmaf(p[r], C2, nmc)); ps += p[r]; }
    lsum = lsum * alpha + ps;
#pragma unroll
    for (int r = 0; r < 16; ++r) { oacc[0][r] *= alpha; oacc[1][r] *= alpha; }
    u32x4 pf[2];
    pf[0] = (u32x4){cvtpk(p[0], p[1]), cvtpk(p[2], p[3]), cvtpk(p[4], p[5]), cvtpk(p[6], p[7])};
    pf[1] = (u32x4){cvtpk(p[8], p[9]), cvtpk(p[10], p[11]), cvtpk(p[12], p[13]), cvtpk(p[14], p[15])};
#pragma unroll
    for (int ks = 0; ks < 2; ++ks) if (ks < nks) {
        const bf16x8 v0 = *(LAS const bf16x8*)(lds + SW_V + r32 * SW_VP + (gk0 + ks) * 32 + hi * 16);
        const bf16x8 v1 = *(LAS const bf16x8*)(lds + SW_V + (32 + r32) * SW_VP + (gk0 + ks) * 32 + hi * 16);
        const bf16x8 pb = __builtin_bit_cast(bf16x8, pf[ks]);
        oacc[0] = __builtin_amdgcn_mfma_f32_32x32x16_bf16(v0, pb, oacc[0], 0, 0, 0);
        oacc[1] = __builtin_amdgcn_mfma_f32_32x32x16_bf16(v1, pb, oacc[1], 0, 0, 0);
    }
}
__device__ __forceinline__ void swa_unit(LAS unsigned char* lds, int b, int n, int kh, const bf16_t* __restrict__ qkv, const bf16_t* __restrict__ VT0, const float* __restrict__ sinks, bf16_t* o) {
    const int tid = threadIdx.x, lane = tid & 63, wave = __builtin_amdgcn_readfirstlane(tid >> 6), r32 = lane & 31, hi = lane >> 5;
    for (int idx = tid; idx < 2176; idx += NTHR) {
        const int row = idx >> 3, c = idx & 7;
        if (row < 16 || n > 0 || row >= 144) {
            const size_t srow = row < 16 ? (size_t)MREAL + b * 16 + row : (size_t)b * SEQ + 128 * (n - 1) + (row - 16);
            const int lrow = row < 16 ? row : 16 + row;
            const u32x4 v = *(const u32x4*)(qkv + srow * NQKV + 1024 + kh * 64 + c * 8);
            *(LAS u32x4*)(lds + SW_K + lrow * 128 + ((c ^ ((lrow >> 1) & 7)) << 4)) = v;
        }
    }
    for (int idx = tid; idx < 2176; idx += NTHR) {
        const int d = idx / 34, c = idx % 34;
        if (c < 2 || n > 0 || c >= 18) {
            const bf16_t* src = VT0 + (size_t)((b * 2 + kh) * 64 + d) * LP + (c < 2 ? c * 8 : 16 + 128 * (n - 1) + (c - 2) * 8);
            *(LAS u32x4*)(lds + SW_V + d * SW_VP + c * 16) = *(const u32x4*)src;
        }
    }
    __syncthreads();
    const int hq = kh * 8 + wave;
    const float sink = sinks[hq];
#pragma unroll 1
    for (int qs = 0; qs < 4; ++qs) {
        const size_t qrow = (size_t)b * SEQ + 128 * n + 32 * qs + r32;
        bf16x8 qf[4];
#pragma unroll
        for (int s = 0; s < 4; ++s) qf[s] = *(const bf16x8*)(qkv + qrow * NQKV + hq * 64 + 16 * s + 8 * hi);
        f32x16 oacc[2]; oacc[0] = (f32x16){}; oacc[1] = (f32x16){};
        float m = sink, lsum = hi == 0 ? 1.0f : 0.0f;
        const int i_q = 32 * qs + r32;
        swa_block32(lds, 0, 0, 1, 1, i_q, qf, m, lsum, oacc, r32, hi);
        if (n > 0) {
            swa_block32(lds, 32 + 32 * qs, 1 + 2 * qs, 2, 2, i_q, qf, m, lsum, oacc, r32, hi);
#pragma unroll 1
            for (int kb = qs + 1; kb < 4; ++kb) swa_block32(lds, 32 + 32 * kb, 1 + 2 * kb, 2, 0, i_q, qf, m, lsum, oacc, r32, hi);
        }
#pragma unroll 1
        for (int kb = 0; kb < qs; ++kb) swa_block32(lds, 160 + 32 * kb, 9 + 2 * kb, 2, 0, i_q, qf, m, lsum, oacc, r32, hi);
        swa_block32(lds, 160 + 32 * qs, 9 + 2 * qs, 2, 3, i_q, qf, m, lsum, oacc, r32, hi);
        lsum = xsum32(lsum);
        const float inv = 1.0f / lsum;
        bf16_t* orow = o + qrow * D + hq * 64 + 4 * hi;
#pragma unroll
        for (int db = 0; db < 2; ++db)
#pragma unroll
            for (int g = 0; g < 4; ++g)
                *(u32x2*)(orow + 32 * db + 8 * g) = (u32x2){cvtpk(oacc[db][4 * g] * inv, oacc[db][4 * g + 1] * inv), cvtpk(oacc[db][4 * g + 2] * inv, oacc[db][4 * g + 3] * inv)};
    }
    __syncthreads();
}
__device__ __forceinline__ void swa_meta(int b, int hq, const bf16_t* __restrict__ qkv, const bf16_t* __restrict__ VT0, const float* __restrict__ sinks, bf16_t* o, int lane) {
    const int qi = lane & 15, part = lane >> 4, kh = hq >> 3; const size_t qrow = (size_t)MREAL + b * 16 + qi;
    float q[16];
#pragma unroll
    for (int c = 0; c < 2; ++c) { float f[8]; unpack8(*(const u32x4*)(qkv + qrow * NQKV + hq * 64 + 16 * part + 8 * c), f);
#pragma unroll
        for (int i = 0; i < 8; ++i) q[8 * c + i] = f[i]; }
    const float sink = sinks[hq];
    float sc[16]; float mx = sink;
#pragma unroll
    for (int j = 0; j < 16; ++j) {
        const size_t kr = (size_t)MREAL + b * 16 + j; float s = 0.f;
#pragma unroll
        for (int c = 0; c < 2; ++c) { float f[8]; unpack8(*(const u32x4*)(qkv + kr * NQKV + 1024 + kh * 64 + 16 * part + 8 * c), f);
#pragma unroll
            for (int i = 0; i < 8; ++i) s += q[8 * c + i] * f[i]; }
        s = xsum16(s); s = xsum32(s);
        sc[j] = j <= qi ? s : -1e30f; mx = fmaxf(mx, sc[j]);
    }
    float l = __expf(sink - mx);
#pragma unroll
    for (int j = 0; j < 16; ++j) { sc[j] = __expf(sc[j] - mx); l += sc[j]; }
    const float inv = 1.0f / l;
#pragma unroll
    for (int dd = 0; dd < 16; ++dd) { const int d = 16 * part + dd; const bf16_t* vr = VT0 + ((size_t)(b * 2 + kh) * 64 + d) * LP;
        float e[16]; { float f[8]; unpack8(*(const u32x4*)vr, f);
#pragma unroll
            for (int i = 0; i < 8; ++i) e[i] = f[i]; unpack8(*(const u32x4*)(vr + 8), f);
#pragma unroll
            for (int i = 0; i < 8; ++i) e[8 + i] = f[i]; }
        float acc = 0.f;
#pragma unroll
        for (int j = 0; j < 16; ++j) acc += sc[j] * e[(j & 3) | ((((j >> 2) & 1) << 1 | ((j >> 3) & 1)) << 2)];
        o[qrow * D + hq * 64 + d] = f2bf(acc * inv); }
}
__device__ __forceinline__ void swa_phase(LAS unsigned char* lds, const bf16_t* qkv, const bf16_t* VT0, const float* sinks, bf16_t* o, int bid, int nblk) {
    for (int u = bid; u < 256; u += nblk) {
        const int b = u >> 7, n = (u >> 1) & 63, kh = u & 1;
        swa_unit(lds, b, n, kh, qkv, VT0, sinks, o);
        if (n == 0) swa_meta(b, kh * 8 + (threadIdx.x >> 6), qkv, VT0, sinks, o, threadIdx.x & 63);
    }
}

template <int MOE_MT>
__device__ __forceinline__ void moe_unit(LAS unsigned char* lds, int e, int s0, int ns, const int* __restrict__ list, const bf16_t* __restrict__ hb, const float* __restrict__ rstd,
                                         const float* __restrict__ wslot, const bf16_t* __restrict__ wgu, const bf16_t* __restrict__ wd, bf16_t* ybuf, unsigned long long* tsb = nullptr) {
#define MSTAMP(i) do { if (PROBE_PHASE >= 600 && tsb && blockIdx.x == 0 && threadIdx.x == 0) tsb[i] = __builtin_amdgcn_s_memrealtime(); } while (0)
    MSTAMP(20);
    constexpr int MOE_BM = 16 * MOE_MT, MOE_HT = MOE_BM * 128, MOE_B2 = 2 * MOE_HT, MOE_ST2 = 32768, MOE_HLO = MOE_B2 + 2 * MOE_ST2, MOE_INFO = MOE_HLO + 2 * MOE_HT;
    static_assert(MOE_B2 + 2 * MOE_ST2 <= MOE_HLO && MOE_INFO + 3072 <= LDS_MISC, "moe lds");
#define moe_hoff(kt) ((kt) < 4 ? MOE_HLO + (kt) * (MOE_HT / 2) : ((kt) - 4) * (MOE_HT / 2))
    const int tid = threadIdx.x, lane = tid & 63, wave = __builtin_amdgcn_readfirstlane(tid >> 6);
    LAS int* slotl = (LAS int*)(lds + MOE_INFO); LAS float* rsl = (LAS float*)(lds + MOE_INFO + 1024); LAS float* wl = (LAS float*)(lds + MOE_INFO + 2048);
    if (tid < MOE_BM) { const int sl = list[(size_t)e * CAP + s0 + (tid < ns ? tid : 0)]; slotl[tid] = sl; rsl[tid] = rstd[sl >> 1]; wl[tid] = wslot[sl]; }
    __syncthreads();
    const int lc4 = (lane & 3) ^ swzF(lane >> 4);
    const int fro32 = (lane & 15) * 64 + (((lane >> 4) ^ swzF((lane >> 2) & 3)) << 4);
    {
        constexpr int ST = (MOE_BM + 512) * 64, GA = MOE_BM / 16, G = GA + 32, NG = (G + 7) / 8;
        static_assert(2 * ST <= MOE_HLO && 2 * MOE_HT <= ST, "moe gemm1 lds");
        const char* src[NG];
#pragma unroll
        for (int i = 0; i < NG; ++i) { const int g = wave + 8 * i;
            if (g < GA) src[i] = (const char*)(hb + (size_t)(slotl[g * 16 + (lane >> 2)] >> 1) * D) + lc4 * 16;
            else if (g < G) src[i] = (const char*)(wgu + (size_t)((g - GA) * 16 + (lane >> 2)) * D) + lc4 * 16;
            else src[i] = nullptr; }
        f32x4 acc[MOE_MT][4];
#pragma unroll
        for (int mi = 0; mi < MOE_MT; ++mi)
#pragma unroll
            for (int ni = 0; ni < 4; ++ni) acc[mi][ni] = (f32x4){0.f, 0.f, 0.f, 0.f};
#define M1_STAGE(st, step) do { _Pragma("unroll") for (int _i = 0; _i < NG; ++_i) { const int _g = wave + 8 * _i; if (_g < G) \
        __builtin_amdgcn_global_load_lds((const unsigned*)(src[_i] + (size_t)(step) * 64), (LAS unsigned*)(lds + (st) * ST + _g * 1024), 16, 0, 0); } } while (0)
        M1_STAGE(0, 0);
        for (int step = 0; step < 32; ++step) {
            asm volatile("s_waitcnt vmcnt(0)" ::: "memory");
            __syncthreads();
            if (step + 1 < 32) M1_STAGE((step + 1) & 1, step + 1);
            LAS const unsigned char* sa = lds + (step & 1) * ST + fro32;
            LAS const unsigned char* sb = lds + (step & 1) * ST + (MOE_BM + wave * 64) * 64 + fro32;
            bf16x8 bfr[4];
#pragma unroll
            for (int ni = 0; ni < 4; ++ni) bfr[ni] = *(LAS const bf16x8*)(sb + ni * 1024);
#pragma unroll
            for (int mi = 0; mi < MOE_MT; ++mi) { const bf16x8 af = *(LAS const bf16x8*)(sa + mi * 1024);
#pragma unroll
                for (int ni = 0; ni < 4; ++ni) acc[mi][ni] = __builtin_amdgcn_mfma_f32_16x16x32_bf16(bfr[ni], af, acc[mi][ni], 0, 0, 0); }
        }
#undef M1_STAGE
        int lane_h = threadIdx.x & 63; asm volatile("" : "+v"(lane_h));
#define lane lane_h
#pragma unroll
        for (int p = 0; p < 2; ++p) {
            const int n = 32 * wave + 16 * p + (lane >> 4) * 4;
            const int csw = ((n & 31) >> 3);
#pragma unroll
            for (int mi = 0; mi < MOE_MT; ++mi) { const int row = mi * 16 + (lane & 15); const float rs = rsl[row]; float hv[4];
#pragma unroll
                for (int r = 0; r < 4; ++r) { const float g = acc[mi][2 * p][r] * rs, u = acc[mi][2 * p + 1][r] * rs; hv[r] = g * __builtin_amdgcn_rcpf(1.0f + __expf(-g)) * u; }
                *(LAS u32x2*)(lds + moe_hoff(n >> 5) + row * 64 + ((csw ^ swzF((row >> 2) & 3)) << 4) + (n & 4) * 2) = (u32x2){pk2(hv[0], hv[1]), pk2(hv[2], hv[3])}; }
        }
#undef lane
    }
    __syncthreads();
    MSTAMP(21);
    {
        const char* src2[4];
#pragma unroll
        for (int i = 0; i < 4; ++i) src2[i] = (const char*)(wd + (size_t)((wave + 8 * i) * 16 + (lane >> 2)) * DE) + lc4 * 16;
        f32x4 acc[MOE_MT][4];
#pragma unroll
        for (int mi = 0; mi < MOE_MT; ++mi)
#pragma unroll
            for (int ni = 0; ni < 4; ++ni) acc[mi][ni] = (f32x4){0.f, 0.f, 0.f, 0.f};
#define M2_STAGE(st, q) do { _Pragma("unroll") for (int _i = 0; _i < 4; ++_i) \
        __builtin_amdgcn_global_load_lds((const unsigned*)(src2[_i] + (size_t)((q) >> 3) * (512 * 512) + (size_t)((q) & 7) * 64), (LAS unsigned*)(lds + MOE_B2 + (st) * MOE_ST2 + (wave + 8 * _i) * 1024), 16, 0, 0); } while (0)
        M2_STAGE(0, 0);
        for (int q = 0; q < 16; ++q) {
            asm volatile("s_waitcnt vmcnt(0)" ::: "memory");
            __syncthreads();
            if (q + 1 < 16) M2_STAGE((q + 1) & 1, q + 1);
            LAS const unsigned char* sa = lds + moe_hoff(q & 7) + fro32;
            LAS const unsigned char* sb = lds + MOE_B2 + (q & 1) * MOE_ST2 + (wave * 64) * 64 + fro32;
            bf16x8 bfr[4];
#pragma unroll
            for (int ni = 0; ni < 4; ++ni) bfr[ni] = *(LAS const bf16x8*)(sb + ni * 1024);
#pragma unroll
            for (int mi = 0; mi < MOE_MT; ++mi) { const bf16x8 af = *(LAS const bf16x8*)(sa + mi * 1024);
#pragma unroll
                for (int ni = 0; ni < 4; ++ni) acc[mi][ni] = __builtin_amdgcn_mfma_f32_16x16x32_bf16(bfr[ni], af, acc[mi][ni], 0, 0, 0); }
            if ((q & 7) == 7) {
                int lane_y = threadIdx.x & 63; asm volatile("" : "+v"(lane_y));
                const int cb = (q >> 3) * 512 + wave * 64 + (lane_y >> 4) * 4;
#pragma unroll
                for (int mi = 0; mi < MOE_MT; ++mi) { const int row = mi * 16 + (lane_y & 15);
                    if (row < ns) { const float w = wl[row]; bf16_t* yr = ybuf + (size_t)slotl[row] * D + cb;
#pragma unroll
                        for (int ni = 0; ni < 4; ++ni) { const f32x4 v = acc[mi][ni] * w; *(u32x2*)(yr + ni * 16) = (u32x2){pk2(v[0], v[1]), pk2(v[2], v[3])}; } }
#pragma unroll
                    for (int ni = 0; ni < 4; ++ni) acc[mi][ni] = (f32x4){0.f, 0.f, 0.f, 0.f}; }
            }
        }
#undef M2_STAGE
    }
#undef moe_hoff
    __syncthreads();
    MSTAMP(22);
#undef MSTAMP
}
__device__ __forceinline__ void moe_phase(LAS unsigned char* lds, int* cnt, const int* list, const bf16_t* hb, const float* rstd, const float* wslot, const bf16_t* wgu, const bf16_t* wd, bf16_t* ybuf, int bid, int nblk, unsigned long long* tsb = nullptr) {
    const bool grp = (nblk % 8) == 0;
    int ntile[NE]; int gsum = 0; bool fit = grp;
#pragma unroll
    for (int e = 0; e < NE; ++e) { const int c = __hip_atomic_load(cnt + e * 64, __ATOMIC_RELAXED, __HIP_MEMORY_SCOPE_AGENT); const int bm = 144; ntile[e] = (c + bm - 1) / bm;
        gsum = (e & 3) == 0 ? ntile[e] : gsum + ntile[e]; if ((e & 3) == 3 && gsum > nblk / 8) fit = false; }
    const int x = bid % 8;
    int u = fit ? bid / 8 : (grp ? x * (nblk / 8) + bid / 8 : bid), base = 0;
    const int stride = fit ? nblk / 8 : nblk;
#pragma unroll 1
    for (int e = 0; e < NE; ++e) {
        if (fit && (e >> 2) != x) continue;
        const int c = __hip_atomic_load(cnt + e * 64, __ATOMIC_RELAXED, __HIP_MEMORY_SCOPE_AGENT);
        const bool big = false; const int bm = 144, nt = (c + bm - 1) / bm;
        while (u < base + nt) { const int t = u - base; const int ns = c - t * bm < bm ? c - t * bm : bm;
            moe_unit<9>(lds, e, t * bm, ns, list, hb, rstd, wslot, wgu + (size_t)e * 512 * 1024, wd + (size_t)e * 1024 * 256, ybuf, tsb);
            u += stride; }
        base += nt;
    }
}

template <int MT>
__device__ __forceinline__ void l1proj_unit(LAS unsigned char* lds, int row0, int mrow0, bf16_t* hb, const bf16_t* __restrict__ ybuf, const bf16_t* __restrict__ win_t, const bf16_t* __restrict__ wuq_t,
                                            const bf16_t* __restrict__ wukv_t, const float2* __restrict__ cs, bf16_t* kpe, bf16_t* Q1, bf16_t* K1, bf16_t* VT1) {
    constexpr int BM = 16 * MT, STW = (BM + 512) * 64, KT = BM * 64  , CQN = 0, CKV = 8 * KT, RB = 12 * KT, STB = 32768, PART = 3 * STW;
    static_assert(RB + 3 * STB <= LDS_MISC && PART + 8 * BM * 4 <= LDS_MISC, "l1proj lds");
    const int tid = threadIdx.x, lane = tid & 63, wave = __builtin_amdgcn_readfirstlane(tid >> 6);
    LAS float* rsl = (LAS float*)(lds + LDS_MISC + 256);
#define L1_GROW(r) ((r) < 64 ? row0 + (r) : mrow0 + (r) - 64)
    for (int r = wave; r < BM; r += NWAVE) {
        const size_t grow = L1_GROW(r); float ss = 0.f;
#pragma unroll
        for (int j = 0; j < 4; ++j) { const size_t c = j * 256 + lane * 4;
            const u32x2 h = *(const u32x2*)(hb + grow * D + c), y0 = *(const u32x2*)(ybuf + (grow * 2) * D + c), y1 = *(const u32x2*)(ybuf + (grow * 2 + 1) * D + c);
            float v[4];
            v[0] = __uint_as_float(h.x << 16) + __uint_as_float(y0.x << 16) + __uint_as_float(y1.x << 16);
            v[1] = __uint_as_float(h.x & 0xffff0000u) + __uint_as_float(y0.x & 0xffff0000u) + __uint_as_float(y1.x & 0xffff0000u);
            v[2] = __uint_as_float(h.y << 16) + __uint_as_float(y0.y << 16) + __uint_as_float(y1.y << 16);
            v[3] = __uint_as_float(h.y & 0xffff0000u) + __uint_as_float(y0.y & 0xffff0000u) + __uint_as_float(y1.y & 0xffff0000u);
            ss += v[0] * v[0] + v[1] * v[1] + v[2] * v[2] + v[3] * v[3];
            *(u32x2*)(hb + grow * D + c) = (u32x2){pk2(v[0], v[1]), pk2(v[2], v[3])}; }
        ss = wave_sum(ss); if (lane == 0) rsl[r] = rsqrtf(ss * (1.0f / D) + EPS);
    }
    asm volatile("s_waitcnt vmcnt(0)" ::: "memory");
    __syncthreads();
    const int lc = (lane & 3) ^ swzF(lane >> 4);
    const int fro = (lane & 15) * 64 + (((lane >> 4) ^ swzF((lane >> 2) & 3)) << 4);
    f32x4 acc[MT][4];
#pragma unroll
    for (int mi = 0; mi < MT; ++mi)
#pragma unroll
        for (int ni = 0; ni < 4; ++ni) acc[mi][ni] = (f32x4){0.f, 0.f, 0.f, 0.f};
    {
        const char* srcb[4];
#pragma unroll
        for (int i = 0; i < 4; ++i) srcb[i] = (const char*)(win_t + (size_t)((wave + 8 * i) * 16 + (lane >> 2)) * D) + lc * 16;
        const char* srca = (const char*)(hb + (size_t)L1_GROW((wave < MT ? wave : 0) * 16 + (lane >> 2)) * D) + lc * 16;
#define W_ISSUE(st, kt) do { if (wave < MT) __builtin_amdgcn_global_load_lds((const unsigned*)(srca + (size_t)(kt) * 64), (LAS unsigned*)(lds + (st) * STW + wave * 1024), 16, 0, 16); \
        _Pragma("unroll") for (int _i = 0; _i < 4; ++_i) __builtin_amdgcn_global_load_lds((const unsigned*)(srcb[_i] + (size_t)(kt) * 64), (LAS unsigned*)(lds + (st) * STW + (MT + wave + 8 * _i) * 1024), 16, 0, 0); } while (0)
        W_ISSUE(0, 0); W_ISSUE(1, 1);
        int st = 0;
        for (int kt = 0; kt < 32; ++kt) {
            if (kt + 1 < 32) { if (wave < MT) wait_vm<5>(); else wait_vm<4>(); } else wait_vm<0>();
            __builtin_amdgcn_s_barrier(); asm volatile("" ::: "memory");
            if (kt + 2 < 32) W_ISSUE(st == 0 ? 2 : st - 1, kt + 2);
            LAS const unsigned char* sa = lds + st * STW + fro;
            LAS const unsigned char* sb = lds + st * STW + (BM + wave * 64) * 64 + fro;
            bf16x8 bfr[4];
#pragma unroll
            for (int ni = 0; ni < 4; ++ni) bfr[ni] = *(LAS const bf16x8*)(sb + ni * 1024);
#pragma unroll
            for (int mi = 0; mi < MT; ++mi) { const bf16x8 af = *(LAS const bf16x8*)(sa + mi * 1024);
#pragma unroll
                for (int ni = 0; ni < 4; ++ni) acc[mi][ni] = __builtin_amdgcn_mfma_f32_16x16x32_bf16(bfr[ni], af, acc[mi][ni], 0, 0, 0); }
            st = st == 2 ? 0 : st + 1;
        }
#undef W_ISSUE
    }
    asm volatile("s_waitcnt lgkmcnt(0)" ::: "memory");
    __syncthreads();
    LAS float* part = (LAS float*)(lds + PART);
    int lane_e = lane; asm volatile("" : "+v"(lane_e));
#define lane lane_e
#pragma unroll
    for (int mi = 0; mi < MT; ++mi) { const float rs = rsl[mi * 16 + (lane & 15)]; float ss = 0.f;
#pragma unroll
        for (int ni = 0; ni < 4; ++ni) { acc[mi][ni] = acc[mi][ni] * rs; ss += acc[mi][ni][0] * acc[mi][ni][0] + acc[mi][ni][1] * acc[mi][ni][1] + acc[mi][ni][2] * acc[mi][ni][2] + acc[mi][ni][3] * acc[mi][ni][3]; }
        ss = xsum16(ss); ss = xsum32(ss);
        if (lane < 16) part[wave * BM + mi * 16 + lane] = ss; }
    __syncthreads();
    if (wave < 6) {
#pragma unroll
        for (int mi = 0; mi < MT; ++mi) { const int row = mi * 16 + (lane & 15);
            const float tot = wave < 4 ? (part[row] + part[BM + row]) + (part[2 * BM + row] + part[3 * BM + row]) : part[4 * BM + row] + part[5 * BM + row];
            const float rn = rsqrtf(tot * (wave < 4 ? 1.0f / 256 : 1.0f / 128) + EPS);
#pragma unroll
            for (int ni = 0; ni < 4; ++ni) { const int cc = (wave < 4 ? 64 * wave : 64 * (wave - 4)) + ni * 16 + (lane >> 4) * 4; const f32x4 v = acc[mi][ni] * rn;
                *(LAS u32x2*)(lds + (wave < 4 ? CQN : CKV) + (cc >> 5) * KT + row * 64 + (((((cc & 31) >> 3)) ^ swzF((row >> 2) & 3)) << 4) + (cc & 4) * 2) = (u32x2){pk2(v[0], v[1]), pk2(v[2], v[3])}; } }
    } else if (wave == 6) {
#pragma unroll
        for (int mi = 0; mi < MT; ++mi) { const int row = mi * 16 + (lane & 15); const int grow = L1_GROW(row); const int pos = row_pos(grow), d0 = (lane >> 4) * 4;
            f32x4 o1, o2;
#pragma unroll
            for (int r = 0; r < 4; ++r) { const float2 t = cs[pos * 32 + 2 * (d0 + r)]; const float x1 = acc[mi][0][r], x2 = acc[mi][1][r]; o1[r] = x1 * t.x - x2 * t.y; o2[r] = x2 * t.x + x1 * t.y; }
            bf16_t* kr = kpe + ((size_t)row_batch(grow) * LP + pos) * 32;
            *(u32x2*)(kr + d0) = (u32x2){pk2(o1[0], o1[1]), pk2(o1[2], o1[3])}; *(u32x2*)(kr + 16 + d0) = (u32x2){pk2(o2[0], o2[1]), pk2(o2[2], o2[3])}; }
    }
#undef lane
    __syncthreads();
    const char* srcu[4];
#define U_ISSUE(st, base, pitchB, chunk, kt) do { _Pragma("unroll") for (int _i = 0; _i < 4; ++_i) \
        __builtin_amdgcn_global_load_lds((const unsigned*)(srcu[_i] + (size_t)(chunk) * 512 * (pitchB) + (size_t)(kt) * 64), (LAS unsigned*)(lds + RB + (st) * STB + (wave + 8 * _i) * 1024), 16, 0, 0); } while (0)
    {
#pragma unroll
        for (int i = 0; i < 4; ++i) srcu[i] = (const char*)(wuq_t + (size_t)((wave + 8 * i) * 16 + (lane >> 2)) * 256) + lc * 16;
#pragma unroll
        for (int mi = 0; mi < MT; ++mi)
#pragma unroll
            for (int ni = 0; ni < 4; ++ni) acc[mi][ni] = (f32x4){0.f, 0.f, 0.f, 0.f};
        U_ISSUE(0, 0, 512, 0, 0); U_ISSUE(1, 0, 512, 0, 1);
        int st = 0;
        for (int q = 0; q < 24; ++q) {
            if (q + 1 < 24) wait_vm<4>(); else wait_vm<0>();
            __builtin_amdgcn_s_barrier(); asm volatile("" ::: "memory");
            if (q + 2 < 24) U_ISSUE(st == 0 ? 2 : st - 1, 0, 512, (q + 2) >> 3, (q + 2) & 7);
            LAS const unsigned char* sa = lds + CQN + (q & 7) * KT + fro;
            LAS const unsigned char* sb = lds + RB + st * STB + (wave * 64) * 64 + fro;
            bf16x8 bfr[4];
#pragma unroll
            for (int ni = 0; ni < 4; ++ni) bfr[ni] = *(LAS const bf16x8*)(sb + ni * 1024);
#pragma unroll
            for (int mi = 0; mi < MT; ++mi) { const bf16x8 af = *(LAS const bf16x8*)(sa + mi * 1024);
#pragma unroll
                for (int ni = 0; ni < 4; ++ni) acc[mi][ni] = __builtin_amdgcn_mfma_f32_16x16x32_bf16(bfr[ni], af, acc[mi][ni], 0, 0, 0); }
            if ((q & 7) == 7) {
                int lane_q = lane; asm volatile("" : "+v"(lane_q));
#define lane lane_q
                const float scale = 0.10206207261596577f * 1.4426950408889634f; const int d0 = (lane >> 4) * 4;
#pragma unroll
                for (int mi = 0; mi < MT; ++mi) { const int grow = L1_GROW(mi * 16 + (lane & 15)); const int pos = row_pos(grow);
#pragma unroll
                    for (int bi = 0; bi < 2; ++bi) { const int gc = (q >> 3) * 512 + 64 * wave + bi * 32; bf16_t* orow = Q1 + (size_t)grow * 1536 + gc;
                        f32x4 v1 = acc[mi][2 * bi], v2 = acc[mi][2 * bi + 1];
                        if (((gc >> 5) % 3) == 2) {
#pragma unroll
                            for (int r = 0; r < 4; ++r) { const float2 t = cs[pos * 32 + 2 * (d0 + r)]; const float x1 = v1[r], x2 = v2[r]; v1[r] = x1 * t.x - x2 * t.y; v2[r] = x2 * t.x + x1 * t.y; } }
                        v1 = v1 * scale; v2 = v2 * scale;
                        *(u32x2*)(orow + d0) = (u32x2){pk2(v1[0], v1[1]), pk2(v1[2], v1[3])}; *(u32x2*)(orow + 16 + d0) = (u32x2){pk2(v2[0], v2[1]), pk2(v2[2], v2[3])}; }
#pragma unroll
                    for (int ni = 0; ni < 4; ++ni) acc[mi][ni] = (f32x4){0.f, 0.f, 0.f, 0.f}; }
#undef lane
            }
            st = st == 2 ? 0 : st + 1;
        }
    }
    asm volatile("s_waitcnt lgkmcnt(0)" ::: "memory");
    __syncthreads();
    {
#pragma unroll
        for (int i = 0; i < 4; ++i) srcu[i] = (const char*)(wukv_t + (size_t)((wave + 8 * i) * 16 + (lane >> 2)) * 128) + lc * 16;
#pragma unroll
        for (int mi = 0; mi < MT; ++mi)
#pragma unroll
            for (int ni = 0; ni < 4; ++ni) acc[mi][ni] = (f32x4){0.f, 0.f, 0.f, 0.f};
        U_ISSUE(0, 0, 256, 0, 0); U_ISSUE(1, 0, 256, 0, 1);
        int st = 0;
        for (int q = 0; q < 16; ++q) {
            if (q + 1 < 16) wait_vm<4>(); else wait_vm<0>();
            __builtin_amdgcn_s_barrier(); asm volatile("" ::: "memory");
            if (q + 2 < 16) U_ISSUE(st == 0 ? 2 : st - 1, 0, 256, (q + 2) >> 2, (q + 2) & 3);
            LAS const unsigned char* sa = lds + CKV + (q & 3) * KT + fro;
            LAS const unsigned char* sb = lds + RB + st * STB + (wave * 64) * 64 + fro;
            bf16x8 bfr[4];
#pragma unroll
            for (int ni = 0; ni < 4; ++ni) bfr[ni] = *(LAS const bf16x8*)(sb + ni * 1024);
            if (q < 8) {
#pragma unroll
                for (int mi = 0; mi < MT; ++mi) { const bf16x8 af = *(LAS const bf16x8*)(sa + mi * 1024);
#pragma unroll
                    for (int ni = 0; ni < 4; ++ni) acc[mi][ni] = __builtin_amdgcn_mfma_f32_16x16x32_bf16(bfr[ni], af, acc[mi][ni], 0, 0, 0); }
            } else {
#pragma unroll
                for (int mi = 0; mi < MT; ++mi) { const bf16x8 af = *(LAS const bf16x8*)(sa + mi * 1024);
#pragma unroll
                    for (int ni = 0; ni < 4; ++ni) acc[mi][ni] = __builtin_amdgcn_mfma_f32_16x16x32_bf16(af, bfr[ni], acc[mi][ni], 0, 0, 0); }
            }
            if ((q & 3) == 3) {
                const int ch = q >> 2;
                int lane_k = lane; asm volatile("" : "+v"(lane_k));
#define lane lane_k
                if (ch < 2) {
#pragma unroll
                    for (int mi = 0; mi < MT; ++mi) { const int grow = L1_GROW(mi * 16 + (lane & 15)); const size_t kr = (size_t)row_batch(grow) * LP + row_pos(grow);
#pragma unroll
                        for (int ni = 0; ni < 4; ++ni) { const f32x4 v = acc[mi][ni];
                            *(u32x2*)(K1 + kr * D + 512 * ch + 64 * wave + ni * 16 + (lane >> 4) * 4) = (u32x2){pk2(v[0], v[1]), pk2(v[2], v[3])}; acc[mi][ni] = (f32x4){0.f, 0.f, 0.f, 0.f}; } }
                } else {
#pragma unroll
                    for (int mi = 0; mi < MT; ++mi) { const int grow0 = L1_GROW(mi * 16 + (lane >> 4) * 4); const int b = row_batch(grow0), pp = perm16(row_pos(grow0));
#pragma unroll
                        for (int ni = 0; ni < 4; ++ni) { const int hd = 512 * (ch - 2) + 64 * wave + ni * 16 + (lane & 15); const f32x4 v = acc[mi][ni];
                            *(u32x2*)(VT1 + (size_t)(b * 1024 + hd) * LP + pp) = (u32x2){pk2(v[0], v[1]), pk2(v[2], v[3])}; acc[mi][ni] = (f32x4){0.f, 0.f, 0.f, 0.f}; } }
                }
#undef lane
            }
            st = st == 2 ? 0 : st + 1;
        }
    }
#undef U_ISSUE
#undef L1_GROW
    asm volatile("s_waitcnt lgkmcnt(0)" ::: "memory");
    __syncthreads();
}
__device__ __forceinline__ void l1proj_phase(LAS unsigned char* lds, bf16_t* hb, const bf16_t* ybuf, const bf16_t* win_t, const bf16_t* wuq_t, const bf16_t* wukv_t, const float2* cs, bf16_t* kpe,
                                             bf16_t* Q1, bf16_t* K1, bf16_t* VT1, int bid, int nblk) {
    { const int gt = bid * NTHR + threadIdx.x, ngt = nblk * NTHR;
      for (int idx = gt; idx < 2 * 48 * 1024; idx += ngt) { const int b = idx / (48 * 1024), r = idx % (48 * 1024); K1[((size_t)b * LP + 8208) * 1024 + r] = 0; }
      for (int idx = gt; idx < 2 * 16 * 64 * 48; idx += ngt) { const int rr = idx / 48, c = idx % 48; VT1[(size_t)rr * LP + 8208 + c] = 0; } }
    for (int u = bid; u < 256; u += nblk) {
        if (u >= 254) l1proj_unit<5>(lds, u * 64, MREAL + (u - 254) * 16, hb, ybuf, win_t, wuq_t, wukv_t, cs, kpe, Q1, K1, VT1);
        else l1proj_unit<4>(lds, u * 64, MREAL, hb, ybuf, win_t, wuq_t, wukv_t, cs, kpe, Q1, K1, VT1);
    }
}

struct EpiNull { int m0, n0;
    template <int MT, int NT> __device__ __forceinline__ void operator()(f32x4 (&acc)[MT][NT], int, int, int) const {
#pragma unroll
        for (int mi = 0; mi < MT; ++mi)
#pragma unroll
            for (int ni = 0; ni < NT; ++ni) asm volatile("" :: "v"(acc[mi][ni])); } };
__device__ __forceinline__ void transpose_item(const float* __restrict__ W, int N, const float* __restrict__ gain, bf16_t* dst, int ldk, int drow0, int k0, int n0, LAS float* scr, int lane, int dskip = 0) {
#pragma unroll 8
    for (int i = 0; i < 32; ++i) { const int kk = 2 * i + (lane >> 5); float v = W[(size_t)(k0 + kk) * N + n0 + (lane & 31)]; if (gain) v *= gain[k0 + kk]; scr[kk * 33 + (lane & 31)] = v; }
    asm volatile("s_waitcnt lgkmcnt(0)" ::: "memory");
    const int c = lane & 7;
#pragma unroll
    for (int j = 0; j < 4; ++j) { const int n = (lane >> 3) + 8 * j; const LAS float* s = scr + (8 * c) * 33 + n;
        u32x4 o; o.x = pk2(s[0 * 33], s[1 * 33]); o.y = pk2(s[2 * 33], s[3 * 33]); o.z = pk2(s[4 * 33], s[5 * 33]); o.w = pk2(s[6 * 33], s[7 * 33]);
        *(u32x4*)(dst + (size_t)(drow0 + n + (n >= 16 ? dskip : 0)) * ldk + k0 + 8 * c) = o; }
    asm volatile("s_waitcnt lgkmcnt(0)" ::: "memory");
}
struct MoeItem { const float* src; const float* gain; bf16_t* dst; int pitch, ldk, kind, nrow0; };
__device__ __forceinline__ MoeItem moe_item(int it, const float* wgate, const float* wup, const float* wdown, const float* gain, bf16_t* wgu_t, bf16_t* wd_t) {
    const int e = it / 48, r = it % 48, which = r >> 4, q = r & 15; MoeItem d;
    if (which < 2) { d.src = (which ? wup : wgate) + (size_t)e * D * DE + (size_t)q * 64 * DE; d.gain = gain + q * 64; d.dst = wgu_t + (size_t)e * 512 * 1024 + q * 64; d.pitch = DE; d.ldk = 1024; d.kind = which; d.nrow0 = 0; }
    else { const int kb = q >> 2, nb = q & 3; d.src = wdown + (size_t)e * DE * D + (size_t)kb * 64 * D + nb * 256; d.gain = nullptr; d.dst = wd_t + (size_t)e * 1024 * 256 + kb * 64; d.pitch = D; d.ldk = 256; d.kind = 2; d.nrow0 = nb * 256; }
    return d;
}
__device__ __forceinline__ void moe_weight_items(const float* wgate, const float* wup, const float* wdown, const float* gain, bf16_t* wgu_t, bf16_t* wd_t, LAS float* T, int bid, int nblk) {
    const int tid = threadIdx.x;
    f32x4 R[8];
    int it = bid;
    if (it >= NE * 48) return;
    MoeItem cur = moe_item(it, wgate, wup, wdown, gain, wgu_t, wd_t);
#pragma unroll
    for (int i = 0; i < 8; ++i) { const int idx = tid + i * NTHR; R[i] = *(const f32x4*)(cur.src + (size_t)(idx >> 6) * cur.pitch + (idx & 63) * 4); }
    for (;;) {
#pragma unroll
        for (int i = 0; i < 8; ++i) { const int idx = tid + i * NTHR, k = idx >> 6, c4 = idx & 63; f32x4 v = R[i]; if (cur.gain) v = v * cur.gain[k];
            LAS float* t = T + k * 257 + c4 * 4; t[0] = v[0]; t[1] = v[1]; t[2] = v[2]; t[3] = v[3]; }
        __syncthreads();
        const int nit = it + nblk; const bool more = nit < NE * 48;
        MoeItem nxt = cur;
        if (more) { nxt = moe_item(nit, wgate, wup, wdown, gain, wgu_t, wd_t);
#pragma unroll
            for (int i = 0; i < 8; ++i) { const int idx = tid + i * NTHR; R[i] = *(const f32x4*)(nxt.src + (size_t)(idx >> 6) * nxt.pitch + (idx & 63) * 4); } }
#pragma unroll
        for (int i = 0; i < 4; ++i) { const int idx = tid + i * NTHR, kc = idx & 7, n = idx >> 3;
            const LAS float* t = T + (8 * kc) * 257 + n;
            u32x4 o; o.x = pk2(t[0], t[257]); o.y = pk2(t[2 * 257], t[3 * 257]); o.z = pk2(t[4 * 257], t[5 * 257]); o.w = pk2(t[6 * 257], t[7 * 257]);
            const int row = cur.kind == 2 ? cur.nrow0 + n : (n >> 4) * 32 + cur.kind * 16 + (n & 15);
            *(u32x4*)(cur.dst + (size_t)row * cur.ldk + 8 * kc) = o; }
        __syncthreads();
        if (!more) break;
        cur = nxt; it = nit;
    }
}
__device__ __forceinline__ void p0_prologue(const MArgs& a, LAS unsigned char* lds, int bid, int nblk) {
    const int tid = threadIdx.x, lane = tid & 63, wave = __builtin_amdgcn_readfirstlane(tid >> 6);
    const int gw = bid * NWAVE + wave, ngw = nblk * NWAVE, gt = bid * NTHR + tid, ngt = nblk * NTHR;
    unsigned char* ws = a.ws;
    float2* cs = (float2*)(ws + WS_ROPE);
    for (int _r = 0; _r < (PROBE_PHASE == 301 ? 2 : 1); ++_r)
    for (int idx = gt; idx < LPOS * 32; idx += ngt) { const int pos = idx >> 5, i = idx & 31; const float inv = 1.0f / powf(10000.0f, (float)(2 * i) / 64.0f); float s, c; sincosf((float)pos * inv, &s, &c); cs[idx] = make_float2(c, s); }
    float* wrf = (float*)(ws + W2_WRF);
    for (int idx = gt; idx < 2 * 36 * 1024; idx += ngt) { const int l = idx / (36 * 1024), j = (idx >> 10) % 36, k = idx & 1023;
        const float g = a.in[3][l * D + k]; wrf[idx] = g * (j < 4 ? a.in[16][(size_t)l * D * 4 + k * 4 + j] : a.in[18][(size_t)l * D * 32 + k * 32 + (j - 4)]); }
    { u32x4* z = (u32x4*)(ws + W2_WIN + (size_t)416 * 1024 * 2); for (int idx = gt; idx < 96 * 1024 * 2 / 16; idx += ngt) z[idx] = (u32x4){0u, 0u, 0u, 0u}; }
    { bf16_t* kpe = (bf16_t*)(ws + WS_KPE); for (int idx = gt; idx < 2 * 48 * 32; idx += ngt) { const int b = idx / (48 * 32), r = idx % (48 * 32); kpe[((size_t)b * LP + 8208) * 32 + r] = 0; }
      bf16_t* vt0 = (bf16_t*)(ws + B_VT0); for (int idx = gt; idx < 2 * 2 * 64 * 48; idx += ngt) { const int rr = idx / 48, c = idx % 48; vt0[(size_t)rr * LP + 8208 + c] = 0; } }
    { bf16_t* hb = (bf16_t*)(ws + W2_HB); float* rstd = (float*)(ws + W2_RSTD);
      for (int _r = 0; _r < (PROBE_PHASE == 303 ? 2 : 1); ++_r)
      for (int row = gw; row < MTOT; row += ngw) {
        const float* src = row < MREAL ? a.in[0] + (size_t)row * D : a.in[1] + (size_t)row_pos(row) * D;
        float ss = 0.f;
#pragma unroll
        for (int j = 0; j < 4; ++j) { const f32x4 v = *(const f32x4*)(src + j * 256 + lane * 4); ss += v[0] * v[0] + v[1] * v[1] + v[2] * v[2] + v[3] * v[3];
            *(u32x2*)(hb + (size_t)row * D + j * 256 + lane * 4) = (u32x2){pk2(v[0], v[1]), pk2(v[2], v[3])}; }
        ss = wave_sum(ss); if (lane == 0) rstd[row] = rsqrtf(ss * (1.0f / D) + EPS);
      } }
    LAS float* scr = (LAS float*)(lds + wave * 16384);
    for (int _r = 0; _r < (PROBE_PHASE == 304 ? 2 : 1); ++_r)
    for (int it = gw; it < 2192; it += ngw) {
        int r = it;
        if (r < 640) { const int nb = r % 40;
            transpose_item(a.in[5], NQKV, a.in[2], (bf16_t*)(ws + W2_WQKV), 1024, nb < 32 ? 64 * (nb >> 1) + 16 * (nb & 1) : nb * 32, (r / 40) * 64, nb * 32, scr, lane, nb < 32 ? 16 : 0); continue; } r -= 640;
        if (r < 512) { transpose_item(a.in[8], D, nullptr, (bf16_t*)(ws + W2_WO0), 1024, (r & 31) * 32, (r >> 5) * 64, (r & 31) * 32, scr, lane); continue; } r -= 512;
        if (r < 208) { transpose_item(a.in[10], 416, a.in[2] + D, (bf16_t*)(ws + W2_WIN), 1024, (r % 13) * 32, (r / 13) * 64, (r % 13) * 32, scr, lane); continue; } r -= 208;
        if (r < 192) { transpose_item(a.in[13], 1536, a.in[11], (bf16_t*)(ws + W2_WUQ), 256, (r % 48) * 32, (r / 48) * 64, (r % 48) * 32, scr, lane); continue; } r -= 192;
        if (r < 128) { const int nb32 = r & 63, hh = nb32 >> 2, part = nb32 & 3;
            transpose_item(a.in[14], 2048, a.in[12], (bf16_t*)(ws + W2_WUKV), 128, part < 2 ? hh * 64 + part * 32 : 1024 + hh * 64 + (part - 2) * 32, (r >> 6) * 64, nb32 * 32, scr, lane); continue; } r -= 128;
        transpose_item(a.in[15], D, nullptr, (bf16_t*)(ws + W2_WO1), 1024, (r & 31) * 32, (r >> 5) * 64, (r & 31) * 32, scr, lane);
    }
    __syncthreads();
    moe_weight_items(a.in[20], a.in[21], a.in[22], a.in[3], (bf16_t*)(ws + C_W0), (bf16_t*)(ws + C_W0 + MOE_WGU_BYTES), (LAS float*)lds, bid, nblk);
}

template <bool NSW, bool HALFN, class MakeEpi>
__device__ __forceinline__ void gemm_phase(LAS unsigned char* lds, const bf16_t* A, int lda, const bf16_t* Bt, int K, int pn0, int pn1, int bid, int nblk, const MakeEpi& mk) {
    constexpr int BN = HALFN ? 128 : 256;
    const int ntn = pn1 - pn0;
    const bool grp = (nblk % 8) == 0;
    const int x = grp ? bid % 8 : 0, j = grp ? bid / 8 : bid, nslot = grp ? nblk / 8 : nblk, pmg = grp ? 8 : 64;
    for (int u = j; u < pmg * ntn; u += nslot) {
        const int pm = x * pmg + u / ntn, pn = pn0 + u % ntn;
        RowDense ra{A, lda, pm * 256, MTOT - 1}; auto e = mk(pm * 256, pn * BN);
        if (HALFN) gemm_tile<4, 4, 4, 2, NSW>(lds, ra, Bt + (size_t)pn * BN * K, K, K / 32, e);
        else gemm_tile<8, 4, 2, 4, NSW>(lds, ra, Bt + (size_t)pn * BN * K, K, K / 32, e);
    }
    const int nfull = (pmg * ntn + nslot - 1) / nslot;
    for (int pn = pn0; pn < pn1; ++pn) {
        const int owner = (pn - pn0) * 37 % nblk;
        if (bid == owner) { RowDense ra{A, lda, MREAL, MTOT - 1}; auto e = mk(MREAL, pn * BN);
            if (HALFN) gemm_tile<1, 4, 4, 2, NSW>(lds, ra, Bt + (size_t)pn * BN * K, K, K / 32, e);
            else gemm_tile<1, 4, 2, 4, NSW>(lds, ra, Bt + (size_t)pn * BN * K, K, K / 32, e); }
    }
    (void)nfull;
}

constexpr int PH_PROLOGUE = 0, PH_QKV = 1, PH_SWA = 2, PH_OPROJ0 = 3, PH_ROUTE0 = 4, PH_MOE0 = 5, PH_COMBINE = 6, PH_WIN = 7, PH_CEPI = 8, PH_UQKV = 9, PH_MLA = 10, PH_OPROJ1 = 11, PH_ROUTE1 = 12, PH_MOE1 = 13, PH_FINAL = 14, PH_N = 15;
__global__ void __launch_bounds__(NTHR, 2) mega(MArgs a) {
    extern __shared__ __attribute__((aligned(16))) unsigned char lds_raw[];
    LAS unsigned char* lds = (LAS unsigned char*)lds_raw;
    const int tid = threadIdx.x, bid = blockIdx.x, nblk = gridDim.x;
    volatile LAS unsigned* misc = (volatile LAS unsigned*)(lds + LDS_MISC);
    if (tid < 64) misc[tid] = 0u;
    __syncthreads();
    unsigned char* ws = a.ws;
    XcdBarrier bar = xcd_barrier_post((unsigned*)(ws + WS_BAR) + a.li * XCD_BAR_WORDS, misc);
    if (tid == 0) misc[4] = xb_add((unsigned*)(ws + 32 * 1024) + 64 * bar.x, 1u);
    const int lo = a.ph_lo, hi = a.ph_hi;
#define IN(k) (lo <= (k) && (k) < hi)
#define REP(k) for (int _rep = 0; _rep < ((k) == PROBE_PHASE ? 2 : 1); ++_rep, (void)((k) == PROBE_PHASE && _rep == 1 ? (xcd_barrier(bar), 0) : 0))
#define STAMP(i) do { if (PROBE_PHASE >= 600 && bid == 0 && tid == 0) ((unsigned long long*)(ws + 512 * 1024))[i] = __builtin_amdgcn_s_memrealtime(); } while (0)
#define SEAM(k) do { if (IN(k) && IN((k) + 1)) xcd_barrier(bar); STAMP((k) + 1); } while (0)
    STAMP(0);
    if (IN(PH_PROLOGUE)) REP(PH_PROLOGUE) p0_prologue(a, lds, bid, nblk);
    SEAM(PH_PROLOGUE);
    int vbid = bid;
    if (IN(PH_PROLOGUE) && IN(PH_QKV)) {
        if (tid == 0) { bool ok = (nblk % 8) == 0 && bar.x < 8;
            for (int j = 0; j < 8; ++j) ok = ok && xb_ld((unsigned*)(ws + 32 * 1024) + 64 * j) == (unsigned)(nblk / 8);
            misc[5] = ok ? misc[4] * 8u + bar.x : (unsigned)bid; }
        __syncthreads();
        vbid = __builtin_amdgcn_readfirstlane((int)misc[5]);
    }
#define bid vbid
    if (IN(PH_QKV)) REP(PH_QKV) {
        const float* rstd = (const float*)(ws + W2_RSTD); const float* bias = a.in[6]; const float2* cs = (const float2*)(ws + WS_ROPE); bf16_t* qkv = (bf16_t*)(ws + B_QKV); bf16_t* vt0 = (bf16_t*)(ws + B_VT0);
        const bf16_t* hbA = (const bf16_t*)(ws + W2_HB); const bf16_t* Wt = (const bf16_t*)(ws + W2_WQKV);
        const bool grp = (nblk % 8) == 0; const int x = grp ? bid % 8 : 0, j = grp ? bid / 8 : bid, nslot = grp ? nblk / 8 : nblk, pmg = grp ? 8 : 64;
        const bool usepg = nblk == 256;
        if (usepg) { pg8::Gemm g{hbA, Wt, MREAL, 1024, D}; pg8::StaticOrder S; S.init(MREAL, 1024, nblk, bid);
            PgEpiQ E{rstd, bias, cs, qkv};
            pg8::gemm_phase<PgEpiQ, pg8::StaticOrder, true, true>(lds, g, S, E); }
        for (int u = usepg ? pmg * 4 + j : j; u < pmg * 6; u += nslot) {
            if (u < pmg * 4) { const int pm = x * pmg + (u >> 2), pn = u & 3; RowDense ra{hbA, D, pm * 256, MTOT - 1}; EpiQKV e{rstd, bias, cs, qkv, pm * 256, pn * 256, true};
                gemm_tile<8, 4, 2, 4, false>(lds, ra, Wt + (size_t)pn * 256 * D, D, D / 32, e);
            } else if (u < pmg * 5) { const int pm = x * pmg + (u - pmg * 4); RowDense ra{hbA, D, pm * 256, MTOT - 1}; EpiQKV e{rstd, bias, cs, qkv, pm * 256, 1024, false};
                gemm_tile<4, 4, 4, 2, false>(lds, ra, Wt + (size_t)1024 * D, D, D / 32, e);
            } else { const int pm = x * pmg + (u - pmg * 5); RowDense ra{hbA, D, pm * 256, MTOT - 1}; EpiV0 e{rstd, bias, vt0, pm * 256, 1152};
                gemm_tile<4, 4, 4, 2, true>(lds, ra, Wt + (size_t)1152 * D, D, D / 32, e);
            }
        }
        const int mu = bid - (nblk - 6);
        if (mu >= 0 && mu < 4) { RowDense ra{hbA, D, MREAL, MTOT - 1}; EpiQKV e{rstd, bias, cs, qkv, MREAL, mu * 256, true};
            gemm_tile<1, 4, 2, 4, false>(lds, ra, Wt + (size_t)mu * 256 * D, D, D / 32, e);
        } else if (mu == 4) { RowDense ra{hbA, D, MREAL, MTOT - 1}; EpiQKV e{rstd, bias, cs, qkv, MREAL, 1024, false};
            gemm_tile<1, 4, 4, 2, false>(lds, ra, Wt + (size_t)1024 * D, D, D / 32, e);
        } else if (mu == 5) { RowDense ra{hbA, D, MREAL, MTOT - 1}; EpiV0 e{rstd, bias, vt0, MREAL, 1152};
            gemm_tile<1, 4, 4, 2, true>(lds, ra, Wt + (size_t)1152 * D, D, D / 32, e);
        }
    }
    SEAM(PH_QKV);
    if (IN(PH_SWA)) REP(PH_SWA) swa_phase(lds, (const bf16_t*)(ws + B_QKV), (const bf16_t*)(ws + B_VT0), a.in[7], (bf16_t*)(ws + B_O0), bid, nblk);
    SEAM(PH_SWA);
    if (IN(PH_OPROJ0)) REP(PH_OPROJ0) {
        const float* bias = a.in[9]; bf16_t* hb = (bf16_t*)(ws + W2_HB);
        if (nblk == 256) { pg8::Gemm g{(const bf16_t*)(ws + B_O0), (const bf16_t*)(ws + W2_WO0), MREAL, D, D}; pg8::StaticOrder S; S.init(MREAL, D, nblk, bid); PgEpiRes E{bias, hb};
            pg8::gemm_phase<PgEpiRes, pg8::StaticOrder, true, true>(lds, g, S, E);
            if ((bid & 15) == 5) { const int pc = bid >> 4; RowDense ra{(const bf16_t*)(ws + B_O0), D, MREAL, MTOT - 1}; EpiRes e{bias, hb, MREAL, pc * 64};
                gemm_tile<1, 1, 2, 4, false>(lds, ra, (const bf16_t*)(ws + W2_WO0) + (size_t)pc * 64 * D, D, D / 32, e); }
        } else
        gemm_phase<false, false>(lds, (const bf16_t*)(ws + B_O0), D, (const bf16_t*)(ws + W2_WO0), D, 0, 4, bid, nblk, [=](int m0, int n0) { return EpiRes{bias, hb, m0, n0}; });
    }
    SEAM(PH_OPROJ0);
    if (IN(PH_ROUTE0))
        route_phase(lds, (const bf16_t*)(ws + W2_HB), (const float*)(ws + W2_WRF), a.in[17], a.in[19], (float*)(ws + W2_RSTD), (int*)(ws + WS_CTL),
                    (int*)(ws + W2_LIST), (float*)(ws + W2_WSLOT), bid, nblk);
    SEAM(PH_ROUTE0);
    if (IN(PH_MOE0)) REP(PH_MOE0) moe_phase(lds, (int*)(ws + WS_CTL), (const int*)(ws + W2_LIST), (const bf16_t*)(ws + W2_HB), (const float*)(ws + W2_RSTD), (const float*)(ws + W2_WSLOT),
                               (const bf16_t*)(ws + C_W0), (const bf16_t*)(ws + C_W0 + MOE_WGU_BYTES), (bf16_t*)(ws + B_Y0), bid, nblk, (unsigned long long*)(ws + 512 * 1024));
    SEAM(PH_MOE0);
    if (IN(PH_COMBINE)) l1proj_phase(lds, (bf16_t*)(ws + W2_HB), (const bf16_t*)(ws + B_Y0), (const bf16_t*)(ws + W2_WIN), (const bf16_t*)(ws + W2_WUQ), (const bf16_t*)(ws + W2_WUKV),
                                     (const float2*)(ws + WS_ROPE), (bf16_t*)(ws + WS_KPE), (bf16_t*)(ws + C_Q1), (bf16_t*)(ws + C_K1), (bf16_t*)(ws + C_V1), bid, nblk);
    STAMP(PH_WIN); STAMP(PH_CEPI); STAMP(PH_UQKV);
    SEAM(PH_UQKV);
    if (IN(PH_MLA)) REP(100) {
        moe_weight_items(a.in[20] + (size_t)NE * D * DE, a.in[21] + (size_t)NE * D * DE, a.in[22] + (size_t)NE * DE * D, a.in[3] + D, (bf16_t*)(ws + B_W1), (bf16_t*)(ws + B_W1 + MOE_WGU_BYTES),
                         (LAS float*)lds, bid, nblk);
    }
    if (IN(PH_MLA)) REP(PH_MLA) mla_phase(lds, (const bf16_t*)(ws + C_Q1), (const bf16_t*)(ws + C_K1), (const bf16_t*)(ws + WS_KPE), (const bf16_t*)(ws + C_V1), (bf16_t*)(ws + B_O1), bid, nblk);
    SEAM(PH_MLA);
    if (IN(PH_OPROJ1)) REP(PH_OPROJ1) {
        bf16_t* hb = (bf16_t*)(ws + W2_HB);
        if (nblk == 256) { pg8::Gemm g{(const bf16_t*)(ws + B_O1), (const bf16_t*)(ws + W2_WO1), MREAL, D, D}; pg8::StaticOrder S; S.init(MREAL, D, nblk, bid); PgEpiRes E{nullptr, hb};
            pg8::gemm_phase<PgEpiRes, pg8::StaticOrder, true, true>(lds, g, S, E);
            if ((bid & 15) == 5) { const int pc = bid >> 4; RowDense ra{(const bf16_t*)(ws + B_O1), D, MREAL, MTOT - 1}; EpiRes e{nullptr, hb, MREAL, pc * 64};
                gemm_tile<1, 1, 2, 4, false>(lds, ra, (const bf16_t*)(ws + W2_WO1) + (size_t)pc * 64 * D, D, D / 32, e); }
        } else
        gemm_phase<false, false>(lds, (const bf16_t*)(ws + B_O1), D, (const bf16_t*)(ws + W2_WO1), D, 0, 4, bid, nblk, [=](int m0, int n0) { return EpiRes{nullptr, hb, m0, n0}; });
    }
    SEAM(PH_OPROJ1);
    if (IN(PH_ROUTE1))
        route_phase(lds, (const bf16_t*)(ws + W2_HB), (const float*)(ws + W2_WRF) + 36 * 1024, a.in[17] + 4, a.in[19] + 32, (float*)(ws + W2_RSTD), (int*)(ws + WS_CTL) + 2048,
                    (int*)(ws + W2_LIST), (float*)(ws + W2_WSLOT), bid, nblk);
    SEAM(PH_ROUTE1);
    if (IN(PH_MOE1)) REP(PH_MOE1) moe_phase(lds, (int*)(ws + WS_CTL) + 2048, (const int*)(ws + W2_LIST), (const bf16_t*)(ws + W2_HB), (const float*)(ws + W2_RSTD), (const float*)(ws + W2_WSLOT),
                               (const bf16_t*)(ws + B_W1), (const bf16_t*)(ws + B_W1 + MOE_WGU_BYTES), (bf16_t*)(ws + C_Y1), bid, nblk);
    SEAM(PH_MOE1);
    if (IN(PH_FINAL)) REP(PH_FINAL) final_phase((const bf16_t*)(ws + W2_HB), (const bf16_t*)(ws + C_Y1), a.in[4], a.out, bid, nblk);
#undef bid
#undef IN
#undef SEAM
}

static void run_mega(hipStream_t s, const MArgs& base, int lo, int hi, int grid) {
    MArgs a = base; a.ph_lo = lo; a.ph_hi = hi; a.li = lo;
    hipLaunchKernelGGL(mega, dim3(grid), dim3(NTHR), LDS_BYTES, s, a);
}
extern "C" void kernel_launch(void* const* d_in, const int* in_sizes, int n_in, void* d_out, int out_size, void* d_ws, size_t ws_size, hipStream_t stream) {
    static int grid = 0;
    if (grid == 0) {
        if (n_in != 23 || ws_size < WS_END) { fprintf(stderr, "kernel_launch: unexpected n_in %d or ws_size %zu\n", n_in, ws_size); grid = -1; return; }
        if (hipFuncSetAttribute((const void*)mega, hipFuncAttributeMaxDynamicSharedMemorySize, LDS_BYTES) != hipSuccess) { fprintf(stderr, "hipFuncSetAttribute failed\n"); grid = -1; return; }
        int dev = 0, cus = 0, per_cu = 0;
        (void)hipGetDevice(&dev); (void)hipDeviceGetAttribute(&cus, hipDeviceAttributeMultiprocessorCount, dev);
        (void)hipOccupancyMaxActiveBlocksPerMultiprocessor(&per_cu, (const void*)mega, NTHR, LDS_BYTES);
        (void)hipGetLastError();
        if (per_cu < 1 || cus < 8) { fprintf(stderr, "kernel_launch: occupancy query reports %d workgroups/CU on %d CUs for %d threads + %d B LDS; nothing launched\n", per_cu, cus, NTHR, LDS_BYTES); grid = -1; return; }
        grid = cus;
    }
    if (grid < 0) return;
    (void)in_sizes; (void)out_size;
    unsigned char* ws = (unsigned char*)d_ws;
    MArgs base{}; for (int i = 0; i < 23; ++i) base.in[i] = (const float*)d_in[i]; base.out = (float*)d_out; base.ws = ws;
    (void)hipMemsetAsync(ws + WS_CTL, 0, 1 * MiB, stream);
    run_mega(stream, base, 0, PH_N, grid);
}
```

```cpp
#include <hip/hip_runtime.h>
#ifndef PROBE_PHASE
#define PROBE_PHASE -1
#endif
#include <cstdio>
#include <cstdint>

typedef unsigned short bf16_t;

constexpr int D = 1024, SEQ = 8192, NB = 2, NMETA = 16;
constexpr int MREAL = NB * SEQ;
constexpr int MTOT = MREAL + NB * NMETA;
constexpr int LPOS = NMETA + SEQ;
constexpr int NQKV = 1280;
constexpr int NE = 32, DE = 256;
constexpr int CAP = MTOT * 2;
constexpr float EPS = 1e-6f;

__device__ __forceinline__ float bf2f(bf16_t v) { return __uint_as_float(((unsigned)v) << 16); }
__device__ __forceinline__ bf16_t f2bf(float f) { unsigned u = __float_as_uint(f); u += 0x7fffu + ((u >> 16) & 1u); return (bf16_t)(u >> 16); }
__device__ __forceinline__ int row_pos(int row) { return row < MREAL ? NMETA + (row & (SEQ - 1)) : ((row - MREAL) & (NMETA - 1)); }
__device__ __forceinline__ int row_batch(int row) { return row < MREAL ? (row >> 13) : ((row - MREAL) >> 4); }
constexpr int LP = 8256;
__device__ __forceinline__ int perm16(int p) { const int qd = (p >> 2) & 3; return (p & ~12) | ((((qd & 1) << 1) | (qd >> 1)) << 2); }
template <int CTRL> __device__ __forceinline__ float dpp_f(float v) { return __int_as_float(__builtin_amdgcn_update_dpp(0, __float_as_int(v), CTRL, 0xF, 0xF, true)); }
__device__ __forceinline__ float wave_sum(float v) {
    v += dpp_f<0xB1>(v);
    v += dpp_f<0x4E>(v);
    v += dpp_f<0x141>(v);
    v += dpp_f<0x140>(v);
    { auto rr = __builtin_amdgcn_permlane16_swap(__float_as_uint(v), __float_as_uint(v), false, false); v = __uint_as_float(rr[0]) + __uint_as_float(rr[1]); }
    { auto rr = __builtin_amdgcn_permlane32_swap(__float_as_uint(v), __float_as_uint(v), false, false); v = __uint_as_float(rr[0]) + __uint_as_float(rr[1]); }
    return v;
}
__device__ __forceinline__ float xsum16(float v) { auto rr = __builtin_amdgcn_permlane16_swap(__float_as_uint(v), __float_as_uint(v), false, false); return __uint_as_float(rr[0]) + __uint_as_float(rr[1]); }
__device__ __forceinline__ float xsum32(float v) { auto rr = __builtin_amdgcn_permlane32_swap(__float_as_uint(v), __float_as_uint(v), false, false); return __uint_as_float(rr[0]) + __uint_as_float(rr[1]); }
__device__ __forceinline__ float xmax32(float v) { auto rr = __builtin_amdgcn_permlane32_swap(__float_as_uint(v), __float_as_uint(v), false, false); return fmaxf(__uint_as_float(rr[0]), __uint_as_float(rr[1])); }

constexpr size_t MiB = 1u << 20;
constexpr size_t WS_CTL = 0;
constexpr size_t WS_ROPE = 1 * MiB;
constexpr size_t WS_END = 256 * MiB;

#define LAS __attribute__((address_space(3)))
#define GAS __attribute__((address_space(1)))
typedef short bf16x8 __attribute__((ext_vector_type(8)));
typedef float f32x4 __attribute__((ext_vector_type(4)));
typedef unsigned u32x4 __attribute__((ext_vector_type(4)));
typedef unsigned u32x2 __attribute__((ext_vector_type(2)));
constexpr int NTHR = 512, NWAVE = 8;
constexpr int LDS_MISC = 162816;
constexpr int LDS_BYTES = LDS_MISC + 1024;

constexpr size_t WS_BAR = 64 * 1024;
constexpr size_t WS_KPE = 3 * MiB + 256 * 1024;
constexpr size_t W2_RSTD = 4 * MiB + 512 * 1024, W2_WSLOT = W2_RSTD + 80 * 1024, W2_EID = W2_WSLOT + 144 * 1024;
constexpr size_t W2_LIST = 5 * MiB;
constexpr size_t W2_WRF = 9 * MiB + 256 * 1024;
constexpr size_t W2_WQKV = 10 * MiB;
constexpr size_t W2_WO0 = W2_WQKV + 2560 * 1024;
constexpr size_t W2_WIN = W2_WO0 + 2048 * 1024;
constexpr size_t W2_WUQ = W2_WIN + 1024 * 1024;
constexpr size_t W2_WUKV = W2_WUQ + 768 * 1024;
constexpr size_t W2_WO1 = W2_WUKV + 512 * 1024;
constexpr size_t W2_HB = 20 * MiB;
constexpr size_t W2_RB = 53 * MiB;
constexpr size_t W2_RC = 134 * MiB;
static_assert(W2_EID + (size_t)MTOT * 8 <= W2_LIST && W2_LIST + (size_t)NE * CAP * 4 <= W2_WRF && W2_WO1 + 2 * MiB <= W2_HB && W2_HB + (size_t)MTOT * 2048 <= W2_RB, "fixed map");
constexpr size_t B_QKV = W2_RB, B_O0 = W2_RB + 41 * MiB, B_VT0 = W2_RB + 74 * MiB  , B_Y0 = W2_RB, B_CBUF = W2_RB, B_CQN = W2_RB + 33 * MiB, B_CKVN = W2_RB + 42 * MiB, B_O1 = W2_RB, B_W1 = W2_RB + 33 * MiB;
constexpr size_t C_W0 = W2_RC, C_HF = W2_RC + 48 * MiB, C_Q1 = W2_RC, C_K1 = W2_RC + 49 * MiB, C_V1 = W2_RC + 82 * MiB, C_HF1 = W2_RC, C_Y1 = W2_RC;
static_assert(C_V1 + (size_t)2 * 16 * 64 * LP * 2 <= WS_END && C_K1 + (size_t)2 * LP * 2048 <= C_V1 && B_VT0 + (size_t)2 * 2 * 64 * LP * 2 <= W2_RC && C_HF + (size_t)MTOT * 4096 <= WS_END && B_W1 + 48 * MiB <= W2_RC, "region map");
constexpr size_t MOE_WGU_BYTES = (size_t)NE * 512 * 1024 * 2, MOE_WD_BYTES = (size_t)NE * 1024 * 256 * 2;

struct MArgs { const float* in[23]; float* out; unsigned char* ws; int ph_lo, ph_hi, li, pad; };

__device__ __forceinline__ unsigned cvtpk(float lo, float hi) { typedef float f2 __attribute__((ext_vector_type(2))); typedef __bf16 b2 __attribute__((ext_vector_type(2)));
    f2 v = {lo, hi}; b2 r = __builtin_convertvector(v, b2); return __builtin_bit_cast(unsigned, r); }
__device__ __forceinline__ unsigned pk2(float lo, float hi) { return cvtpk(lo, hi); }

#define XB_TMO      128
#define XB_XCNT(j)  (256  + 64 * (j))
#define XB_XSUB(j)  (1280 + 64 * (j))
#define XB_XGEN(j)  (2304 + 64 * (j))
#define XB_TOP      3328
#define XB_TOPGEN   3392
#define XCD_BAR_WORDS 3456
#define XB_SPIN_CAP (1u << 18)
__device__ __forceinline__ unsigned xb_ld(unsigned* p)              { return __hip_atomic_load(p, __ATOMIC_RELAXED, __HIP_MEMORY_SCOPE_AGENT); }
__device__ __forceinline__ unsigned xb_add(unsigned* p, unsigned v) { return __hip_atomic_fetch_add(p, v, __ATOMIC_RELAXED, __HIP_MEMORY_SCOPE_AGENT); }
__device__ __forceinline__ unsigned xb_xcc_id() { return (unsigned)__builtin_amdgcn_s_getreg((3 << 11) | 20) & 0xFu; }
#define XB_SPIN(cond, bar) do { unsigned _sp = 0; while (cond) { __builtin_amdgcn_s_sleep(1); \
    if ((++_sp & 255u) == 0u) { if (xb_ld(&(bar)[XB_TMO])) break; if (_sp > XB_SPIN_CAP) { atomicAdd(&(bar)[XB_TMO], 1u); break; } } } } while (0)
struct XcdBarrier { unsigned* bar; unsigned x; volatile LAS unsigned* st; };
__device__ __forceinline__ XcdBarrier xcd_barrier_post(unsigned* bar, volatile LAS unsigned* st) {
    XcdBarrier b; b.bar = bar; b.x = xb_xcc_id(); b.st = st;
    if (threadIdx.x == 0) (void)xb_add(&bar[XB_XCNT(b.x)], 1u);
    return b;
}
__device__ __forceinline__ void xcd_barrier_complete(unsigned* bar, unsigned x, unsigned& nloc, unsigned& nx) {
    const unsigned G = gridDim.x * gridDim.y * gridDim.z;
    unsigned sum, cnt, mine, sp = 0u;
    for (;;) {
        sum = 0u; cnt = 0u; mine = 0u;
#pragma unroll
        for (unsigned j = 0; j < 16; ++j) { const unsigned c = xb_ld(&bar[XB_XCNT(j)]); sum += c; cnt += (c > 0u) ? 1u : 0u; mine = (j == x) ? c : mine; }
        if (sum == G) break;
        __builtin_amdgcn_s_sleep(1);
        if ((++sp & 255u) == 0u) { if (xb_ld(&bar[XB_TMO])) break; if (sp > XB_SPIN_CAP) { atomicAdd(&bar[XB_TMO], 1u); break; } }
    }
    nloc = mine > 0u ? mine : 1u; nx = cnt > 0u ? cnt : 1u;
}
__device__ __forceinline__ void xcd_barrier(const XcdBarrier& b) {
    asm volatile("s_waitcnt vmcnt(0)" ::: "memory");
    __syncthreads();
    if (threadIdx.x == 0) {
        unsigned* bar = b.bar;
        __builtin_amdgcn_s_waitcnt(0);
        unsigned nloc = b.st[0], nx = b.st[1];
        if (nloc == 0u) { xcd_barrier_complete(bar, b.x, nloc, nx); b.st[0] = nloc; b.st[1] = nx; }
        const unsigned old = xb_add(&bar[XB_XSUB(b.x)], 1u);
        const unsigned gen = old / nloc;
        if (old + 1u == (gen + 1u) * nloc) {
            __builtin_amdgcn_fence(__ATOMIC_RELEASE, "agent");
            asm volatile("s_waitcnt vmcnt(0)" ::: "memory");
            const unsigned og = xb_add(&bar[XB_TOP], 1u);
            const unsigned tg = og / nx;
            if (og + 1u == (tg + 1u) * nx) xb_add(&bar[XB_TOPGEN], 1u);
            else XB_SPIN(xb_ld(&bar[XB_TOPGEN]) == tg, bar);
            __builtin_amdgcn_fence(__ATOMIC_ACQUIRE, "agent");
            xb_add(&bar[XB_XGEN(b.x)], 1u);
            asm volatile("s_waitcnt vmcnt(0)" ::: "memory");
        } else {
            XB_SPIN(xb_ld(&bar[XB_XGEN(b.x)]) == gen, bar);
            __builtin_amdgcn_fence(__ATOMIC_ACQUIRE, "agent");
            asm volatile("s_waitcnt vmcnt(0)" ::: "memory");
        }
    }
    __syncthreads();
}

template <int N> __device__ __forceinline__ void wait_vm() { asm volatile("s_waitcnt vmcnt(%0)" :: "n"(N) : "memory"); }
__device__ __forceinline__ int swzF(int g) { return (0x78 >> (2 * g)) & 3; }
constexpr int GT_NS = 4;
template <int MT, int NT, int WM, int WN, bool NSW, class RowA, class Epi, bool NOLD = false>
__device__ __forceinline__ void gemm_tile(LAS unsigned char* lds, const RowA& rowA, const bf16_t* __restrict__ Bt, int ldb  , int nk  , Epi& epi) {
    constexpr int BM = WM * MT * 16, BN = WN * NT * 16, GA = BM / 16, G = (BM + BN) / 16, NG = (G + 7) / 8, GR = G % 8, STAGE = (BM + BN) * 64;
    static_assert(WM * WN == 8 && GT_NS * STAGE <= LDS_MISC && BM % 16 == 0 && BN % 16 == 0, "gemm_tile config");
    const int tid = threadIdx.x, lane = tid & 63, wave = __builtin_amdgcn_readfirstlane(tid >> 6), wm = wave / WN, wn = wave % WN;
    const char* src[NG];
    const int lc = (lane & 3) ^ swzF(lane >> 4);
#pragma unroll
    for (int i = 0; i < NG; ++i) {
        const int g = wave + 8 * i;
        if (g < GA) src[i] = (const char*)rowA(g * 16 + (lane >> 2)) + lc * 16;
        else if (g < G) src[i] = (const char*)(Bt + (size_t)((g - GA) * 16 + (lane >> 2)) * ldb) + lc * 16;
        else src[i] = nullptr;
    }
    f32x4 acc[MT][NT];
#pragma unroll
    for (int mi = 0; mi < MT; ++mi)
#pragma unroll
        for (int ni = 0; ni < NT; ++ni) acc[mi][ni] = (f32x4){0.f, 0.f, 0.f, 0.f};
    const int fro = (lane & 15) * 64 + (((lane >> 4) ^ swzF((lane >> 2) & 3)) << 4);
    constexpr int LM = PROBE_PHASE == 402 ? 2 : 1;
#define GT_STAGE(st, kt) do { _Pragma("unroll") for (int _i = 0; _i < NG; ++_i) { const int _g = wave + 8 * _i; if (_g < G) { \
        __builtin_amdgcn_global_load_lds((const unsigned*)(src[_i] + (size_t)(kt) * 64), (LAS unsigned*)(lds + (st) * STAGE + _g * 1024), 16, 0, 0); \
        if (LM == 2) __builtin_amdgcn_global_load_lds((const unsigned*)(src[_i] + (size_t)(kt) * 64), (LAS unsigned*)(lds + (st) * STAGE + _g * 1024), 16, 0, 0); } } } while (0)
#define GT_WAIT(ntl) do { if (GR == 0 || wave < GR) wait_vm<LM * NG * (ntl)>(); else wait_vm<LM * (NG - 1) * (ntl)>(); } while (0)
    if (!NOLD) { GT_STAGE(0, 0);
    if (nk > 1) GT_STAGE(1, 1);
    if (nk > 2) GT_STAGE(2, 2); }
    int st = 0;
    for (int kt = 0; kt < nk; ++kt) {
        const int rem = nk - 1 - kt;
        if (!NOLD) { if (rem >= 2) GT_WAIT(2); else if (rem == 1) GT_WAIT(1); else GT_WAIT(0); }
        __builtin_amdgcn_s_barrier(); asm volatile("" ::: "memory");
        const bool doload = (!NOLD || PROBE_PHASE == 505) && kt + 3 < nk;
        LAS const unsigned char* sa = lds + st * STAGE + (wm * MT * 16) * 64 + fro;
        LAS const unsigned char* sb = lds + st * STAGE + (BM + wn * NT * 16) * 64 + fro;
        bf16x8 bfr[NT];
#pragma unroll
        for (int ni = 0; ni < NT; ++ni) bfr[ni] = *(LAS const bf16x8*)(sb + ni * 1024);
        constexpr int PG = MT >= 2 ? 2 : 1, NPG = MT / PG;
        constexpr int LPG = (NG + NPG - 1) / NPG;
        bf16x8 afc[PG], afn[PG];
#pragma unroll
        for (int i = 0; i < PG; ++i) afc[i] = *(LAS const bf16x8*)(sa + i * 1024);
#pragma unroll
        for (int pg = 0; pg < NPG; ++pg) {
            if (doload) {
#pragma unroll
                for (int l = 0; l < LPG; ++l) { const int _i = pg * LPG + l; if (_i < NG) { const int _g = wave + 8 * _i; if (_g < G)
                    __builtin_amdgcn_global_load_lds((const unsigned*)(src[_i] + (size_t)(kt + 3) * 64), (LAS unsigned*)(lds + ((st + 3) & 3) * STAGE + _g * 1024), 16, 0, 0); } }
            }
            if (pg + 1 < NPG) {
#pragma unroll
                for (int i = 0; i < PG; ++i) afn[i] = *(LAS const bf16x8*)(sa + ((pg + 1) * PG + i) * 1024);
            }
#pragma unroll
            for (int i = 0; i < PG; ++i) { const int mi = pg * PG + i;
#pragma unroll
                for (int ni = 0; ni < NT; ++ni) {
                    if (NSW) acc[mi][ni] = __builtin_amdgcn_mfma_f32_16x16x32_bf16(afc[i], bfr[ni], acc[mi][ni], 0, 0, 0);
                    else acc[mi][ni] = __builtin_amdgcn_mfma_f32_16x16x32_bf16(bfr[ni], afc[i], acc[mi][ni], 0, 0, 0);
                } }
#pragma unroll
            for (int i = 0; i < PG; ++i) afc[i] = afn[i];
            __builtin_amdgcn_sched_barrier(0);
        }
        st = (st + 1) & 3;
    }
#undef GT_STAGE
#undef GT_WAIT
    epi(acc, wm * MT * 16, wn * NT * 16, lane);
    asm volatile("s_waitcnt lgkmcnt(0)" ::: "memory");
    __syncthreads();
}

struct RowDense { const bf16_t* A; int lda, m0, mlast; __device__ __forceinline__ const bf16_t* operator()(int r) const { int row = m0 + r; row = row > mlast ? mlast : row; return A + (size_t)row * lda; } };

namespace pg8 {
#define PG8_LAS __attribute__((address_space(3)))
typedef unsigned short bf16_t;
typedef short bf16x8 __attribute__((ext_vector_type(8)));
typedef float f32x4 __attribute__((ext_vector_type(4)));
typedef unsigned u32x4 __attribute__((ext_vector_type(4)));
constexpr int BM = 256, BK = 64, HALF = 128, HTB = HALF * BK * 2  , STAGE_BYTES = 8 * HTB, NXCD = 8, WGM = 8;

__host__ __device__ __forceinline__ int lds_byte(int r, int c) { const int st = (r >> 4) * 2 + (c >> 5), rr = r & 15, cc = c & 31, ob = rr * 64 + cc * 2; return st * 1024 + (ob ^ (((ob >> 9) & 1) << 5)); }
__host__ __device__ __forceinline__ void stage_rc(int b, int& R, int& C) { const int st = b / 1024, sb = b % 1024, swz = sb ^ (((sb >> 9) & 1) << 5); R = (st >> 1) * 16 + swz / 64; C = (st & 1) * 32 + (swz % 64) / 2; }
__host__ __device__ __forceinline__ int perm32(int rho) { const int n = rho >> 4, i = rho & 15; return 8 * (i >> 2) + 4 * n + (i & 3); }

struct Unit { int pm, pn; };
struct Gemm { const bf16_t* A; const bf16_t* Bt; int M, N, K; };

struct StaticOrder {
    int nM, nN, nwg, G, c;
    __host__ __device__ void init(int M, int N, int G_, int c_) { nM = M / BM; nN = N / BM; nwg = nM * nN; G = G_; c = c_; }
    __host__ __device__ bool next(int i, Unit& u) const {
        const long L = (long)i * G + c; if (L >= nwg) return false;
        int wgid = (int)L; { const int q = nwg / NXCD, r = nwg % NXCD, xcd = wgid % NXCD, off = wgid / NXCD; wgid = (xcd < r ? xcd * (q + 1) : r * (q + 1) + (xcd - r) * q) + off; }
        const int nig = WGM * nN, gid = wgid / nig, fm = gid * WGM, gsz = (nM - fm) < WGM ? (nM - fm) : WGM;
        u.pm = fm + ((wgid % nig) % gsz); u.pn = (wgid % nig) / gsz; return true;
    }
    __device__ __forceinline__ void a_ready(const Unit&) const {}
    __device__ __forceinline__ void done(const Unit&) const {}
};


template <class Epi, class Sched, bool ALIGN_EPI = false, bool SP2 = false>
__device__ __forceinline__ void gemm_phase(PG8_LAS unsigned char* lds, const Gemm g, const Sched& S, const Epi& E) {
    const int tid = threadIdx.x, wid = __builtin_amdgcn_readfirstlane(tid >> 6), lane = tid & 63, wr = wid >> 2, wc = wid & 3, fr = lane & 15, fq = lane >> 4;
    const int K = g.K, nt = K / BK;
    unsigned voffA[2], voffB[2];
#pragma unroll
    for (int i = 0; i < 2; ++i) { int R, C; stage_rc(tid * 16 + i * 8192, R, C); const int Rb = Epi::PERM ? ((R & ~31) + perm32(R & 31)) : R;
        voffA[i] = (unsigned)(R * K + C) * 2u; voffB[i] = (unsigned)(Rb * K + C) * 2u; }
    const size_t kstep = (size_t)(BK * 2);
    const size_t hstep = (size_t)HALF * K * 2;
    const size_t tstep = 2 * hstep;
    const unsigned ldsw = (unsigned)wid * 1024u;
    const int aoff = lds_byte(wr * 64 + fr, fq * 8), boff = lds_byte(wc * 32 + fr, fq * 8);
#define PG8_SA(b, h) (((b) * 2 + (h)) * HTB)
#define PG8_SB(b, h) ((4 + (b) * 2 + (h)) * HTB)
#define PG8_STAGE(bufoff, gbase, voff) do { _Pragma("unroll") for (int _i = 0; _i < 2; ++_i) \
        __builtin_amdgcn_global_load_lds((const unsigned*)((const char*)(gbase) + (voff)[_i]), (PG8_LAS unsigned*)(lds + (bufoff) + ldsw + _i * 8192), 16, 0, 0); } while (0)
#define PG8_LDA(dst, b, h) do { _Pragma("unroll") for (int m = 0; m < 4; ++m) _Pragma("unroll") for (int k = 0; k < 2; ++k) dst[m][k] = *(const PG8_LAS bf16x8*)(lds + PG8_SA(b, h) + aoff + m * 2048 + k * 1024); } while (0)
#define PG8_LDB(dst, b, h) do { _Pragma("unroll") for (int n = 0; n < 2; ++n) _Pragma("unroll") for (int k = 0; k < 2; ++k) dst[n][k] = *(const PG8_LAS bf16x8*)(lds + PG8_SB(b, h) + boff + n * 2048 + k * 1024); } while (0)
#define PG8_MMA(ai, bj, At, Bt) do { __builtin_amdgcn_s_setprio(1); _Pragma("unroll") for (int m = 0; m < 4; ++m) _Pragma("unroll") for (int n = 0; n < 2; ++n) _Pragma("unroll") for (int k = 0; k < 2; ++k) \
        acc[ai][bj][m][n] = __builtin_amdgcn_mfma_f32_16x16x32_bf16(Bt[n][k], At[m][k], acc[ai][bj][m][n], 0, 0, 0); __builtin_amdgcn_s_setprio(0); } while (0)
#define PG8_WAIT_V(n) asm volatile("s_waitcnt vmcnt(" #n ")" ::: "memory")
#define PG8_WAIT_L(n) asm volatile("s_waitcnt lgkmcnt(" #n ")" ::: "memory")
#define PG8_BAR __builtin_amdgcn_s_barrier()
#define PG8_SCHED __builtin_amdgcn_sched_barrier(0)
    Unit cur, nxt; int ui = 0;
    if (!S.next(0, cur)) return;
    f32x4 acc[2][2][4][2];
#pragma unroll
    for (int a = 0; a < 2; ++a)
#pragma unroll
        for (int b = 0; b < 2; ++b)
#pragma unroll
            for (int m = 0; m < 4; ++m)
#pragma unroll
                for (int n = 0; n < 2; ++n) acc[a][b][m][n] = (f32x4){0.f, 0.f, 0.f, 0.f};
    bf16x8 At[4][2], B0[2][2], B1[2][2];
    const char* cA = (const char*)g.A + (size_t)cur.pm * tstep; const char* cB = (const char*)g.Bt + (size_t)cur.pn * tstep;
    S.a_ready(cur);
    if constexpr (SP2) {
        PG8_STAGE(PG8_SB(0, 0), cB, voffB); PG8_STAGE(PG8_SB(0, 1), cB + hstep, voffB); PG8_STAGE(PG8_SA(0, 0), cA, voffA); PG8_STAGE(PG8_SA(0, 1), cA + hstep, voffA);
        if (wr == 1) PG8_BAR;
        PG8_WAIT_V(2); PG8_BAR;
        PG8_STAGE(PG8_SB(1, 0), cB + kstep, voffB); PG8_STAGE(PG8_SA(1, 0), cA + kstep, voffA); PG8_STAGE(PG8_SB(1, 1), cB + hstep + kstep, voffB);
        PG8_WAIT_V(6); PG8_BAR;
    } else {
        PG8_STAGE(PG8_SB(0, 0), cB, voffB); PG8_STAGE(PG8_SA(0, 0), cA, voffA); PG8_STAGE(PG8_SB(0, 1), cB + hstep, voffB); PG8_STAGE(PG8_SA(0, 1), cA + hstep, voffA);
        if (wr == 1) PG8_BAR;
        PG8_WAIT_V(4); PG8_BAR;
        PG8_STAGE(PG8_SB(1, 0), cB + kstep, voffB); PG8_STAGE(PG8_SA(1, 0), cA + kstep, voffA); PG8_STAGE(PG8_SB(1, 1), cB + hstep + kstep, voffB);
        PG8_WAIT_V(6); PG8_BAR;
    }
    for (;;) {
        const bool has_next = S.next(ui + 1, nxt);
        const char* nA = has_next ? (const char*)g.A + (size_t)nxt.pm * tstep : cA; const char* nB = has_next ? (const char*)g.Bt + (size_t)nxt.pn * tstep : cB;
        for (int t = 0; t < nt; t += 2) {
            const bool last = (t == nt - 2);
            const char* a1 = cA + (size_t)(t + 1) * kstep;
            const char* a2 = last ? nA : cA + (size_t)(t + 2) * kstep; const char* b2 = last ? nB : cB + (size_t)(t + 2) * kstep;
            const char* a3 = a2 + kstep; const char* b3 = b2 + kstep;
            if (last && has_next) S.a_ready(nxt);
            if constexpr (SP2) {
            PG8_LDB(B0, 0, 0); PG8_LDB(B1, 0, 1); PG8_SCHED; PG8_LDA(At, 0, 0); PG8_STAGE(PG8_SA(1, 1), a1 + hstep, voffA);
            PG8_WAIT_V(8); PG8_WAIT_L(0); PG8_BAR; PG8_MMA(0, 0, At, B0); PG8_MMA(0, 1, At, B1); PG8_BAR; PG8_SCHED;
            PG8_LDA(At, 0, 1); PG8_STAGE(PG8_SB(0, 0), b2, voffB); PG8_STAGE(PG8_SB(0, 1), b2 + hstep, voffB); PG8_STAGE(PG8_SA(0, 0), a2, voffA);
            PG8_WAIT_V(8); PG8_WAIT_L(0); PG8_BAR; PG8_MMA(1, 0, At, B0); PG8_MMA(1, 1, At, B1); PG8_BAR; PG8_SCHED;
            PG8_LDB(B0, 1, 0); PG8_LDB(B1, 1, 1); PG8_SCHED; PG8_LDA(At, 1, 0); PG8_STAGE(PG8_SA(0, 1), a2 + hstep, voffA);
            PG8_WAIT_V(8); PG8_WAIT_L(0); PG8_BAR; PG8_MMA(0, 0, At, B0); PG8_MMA(0, 1, At, B1); PG8_BAR; PG8_SCHED;
            PG8_LDA(At, 1, 1); PG8_STAGE(PG8_SB(1, 0), b3, voffB); PG8_STAGE(PG8_SB(1, 1), b3 + hstep, voffB); PG8_STAGE(PG8_SA(1, 0), a3, voffA);
            PG8_WAIT_V(8); PG8_WAIT_L(0); PG8_BAR; PG8_MMA(1, 0, At, B0); PG8_MMA(1, 1, At, B1); PG8_BAR; PG8_SCHED;
            } else {
            PG8_LDB(B0, 0, 0); PG8_SCHED; PG8_LDA(At, 0, 0); PG8_STAGE(PG8_SA(1, 1), a1 + hstep, voffA);
            PG8_WAIT_L(8); PG8_BAR; PG8_WAIT_L(0); PG8_MMA(0, 0, At, B0); PG8_BAR; PG8_SCHED;
            PG8_LDB(B1, 0, 1); PG8_STAGE(PG8_SB(0, 0), b2, voffB);
            PG8_BAR; PG8_WAIT_L(0); PG8_MMA(0, 1, At, B1); PG8_BAR;
            PG8_LDA(At, 0, 1); PG8_STAGE(PG8_SA(0, 0), a2, voffA);
            PG8_BAR; PG8_WAIT_L(0); PG8_MMA(1, 0, At, B0); PG8_BAR; PG8_SCHED;
            PG8_STAGE(PG8_SB(0, 1), b2 + hstep, voffB);
            PG8_WAIT_V(6); PG8_BAR; PG8_MMA(1, 1, At, B1); PG8_BAR;
            PG8_LDB(B0, 1, 0); PG8_SCHED; PG8_LDA(At, 1, 0); PG8_STAGE(PG8_SA(0, 1), a2 + hstep, voffA);
            PG8_WAIT_L(8); PG8_BAR; PG8_WAIT_L(0); PG8_MMA(0, 0, At, B0); PG8_BAR; PG8_SCHED;
            PG8_LDB(B1, 1, 1); PG8_STAGE(PG8_SB(1, 0), b3, voffB);
            PG8_BAR; PG8_WAIT_L(0); PG8_MMA(0, 1, At, B1); PG8_BAR;
            PG8_LDA(At, 1, 1); PG8_STAGE(PG8_SA(1, 0), a3, voffA);
            PG8_BAR; PG8_WAIT_L(0); PG8_MMA(1, 0, At, B0); PG8_BAR; PG8_SCHED;
            PG8_STAGE(PG8_SB(1, 1), b3 + hstep, voffB);
            PG8_WAIT_V(6); PG8_BAR; PG8_MMA(1, 1, At, B1); PG8_BAR;
            }
        }
        if constexpr (ALIGN_EPI) { if (wr == 0) PG8_BAR; }
        if constexpr (!Epi::AFTER_DRAIN) { E(acc, cur, wr, wc, fr, fq); S.done(cur); }
        if (!has_next) break;
#pragma unroll
        for (int a = 0; a < 2; ++a)
#pragma unroll
            for (int b = 0; b < 2; ++b)
#pragma unroll
                for (int m = 0; m < 4; ++m)
#pragma unroll
                    for (int n = 0; n < 2; ++n) acc[a][b][m][n] = (f32x4){0.f, 0.f, 0.f, 0.f};
        cur = nxt; cA = nA; cB = nB; ++ui;
        if constexpr (ALIGN_EPI) { if (wr == 1) PG8_BAR; }
    }
    PG8_WAIT_V(0);
    if constexpr (!ALIGN_EPI) { if (wr == 0) PG8_BAR; }
    PG8_BAR;
    if constexpr (Epi::AFTER_DRAIN) { E.fused(acc, cur, wr, wc, fr, fq, lds, wid, lane); S.done(cur); }
#undef PG8_SA
#undef PG8_SB
#undef PG8_STAGE
#undef PG8_LDA
#undef PG8_LDB
#undef PG8_MMA
#undef PG8_WAIT_V
#undef PG8_WAIT_L
#undef PG8_BAR
#undef PG8_SCHED
}
}

struct PgEpiRes {
    static constexpr bool PERM = false, AFTER_DRAIN = false;
    const float* bias; unsigned short* hb;
    __device__ __forceinline__ void operator()(const pg8::f32x4 (&acc)[2][2][4][2], const pg8::Unit& u, int wr, int wc, int fr, int fq) const {
#pragma unroll
        for (int ai = 0; ai < 2; ++ai)
#pragma unroll
            for (int m = 0; m < 4; ++m) { const int row = u.pm * 256 + ai * 128 + wr * 64 + m * 16 + fr;
#pragma unroll
                for (int bj = 0; bj < 2; ++bj)
#pragma unroll
                    for (int n = 0; n < 2; ++n) { const int col = u.pn * 256 + bj * 128 + wc * 32 + n * 16 + fq * 4;
                        u32x2* p = (u32x2*)(hb + (size_t)row * D + col); const u32x2 h = *p; pg8::f32x4 v = acc[ai][bj][m][n];
                        if (bias) v += *(const pg8::f32x4*)(bias + col);
                        v[0] += __uint_as_float(h.x << 16); v[1] += __uint_as_float(h.x & 0xffff0000u); v[2] += __uint_as_float(h.y << 16); v[3] += __uint_as_float(h.y & 0xffff0000u);
                        *p = (u32x2){pk2(v[0], v[1]), pk2(v[2], v[3])}; } }
    }
};
struct PgEpiQ {
    static constexpr bool PERM = false, AFTER_DRAIN = false;
    const float* rstd; const float* bias; const float2* cs; unsigned short* qkv;
    __device__ __forceinline__ void operator()(const pg8::f32x4 (&acc)[2][2][4][2], const pg8::Unit& u, int wr, int wc, int fr, int fq) const {
#pragma unroll
        for (int ai = 0; ai < 2; ++ai)
#pragma unroll
            for (int m = 0; m < 4; ++m) { const int row = u.pm * 256 + ai * 128 + wr * 64 + m * 16 + fr; const float rs = rstd[row]; const int pos = row_pos(row);
#pragma unroll
                for (int bj = 0; bj < 2; ++bj) { const int g = 8 * u.pn + 4 * bj + wc, hh = g >> 1, d = 16 * (g & 1) + 4 * fq;
                    const pg8::f32x4 b1 = *(const pg8::f32x4*)(bias + 64 * hh + d), b2 = *(const pg8::f32x4*)(bias + 64 * hh + 32 + d);
                    float o1[4], o2[4];
#pragma unroll
                    for (int r = 0; r < 4; ++r) { const float2 t = cs[pos * 32 + d + r]; const float x1 = acc[ai][bj][m][0][r] * rs + b1[r], x2 = acc[ai][bj][m][1][r] * rs + b2[r];
                        o1[r] = (x1 * t.x - x2 * t.y) * 0.125f; o2[r] = (x2 * t.x + x1 * t.y) * 0.125f; }
                    unsigned short* orow = qkv + (size_t)row * NQKV + 64 * hh + d;
                    *(u32x2*)orow = (u32x2){pk2(o1[0], o1[1]), pk2(o1[2], o1[3])}; *(u32x2*)(orow + 32) = (u32x2){pk2(o2[0], o2[1]), pk2(o2[2], o2[3])}; } }
    }
};

struct EpiQKV {
    const float* rstd; const float* bias; const float2* cs; bf16_t* qkv; int m0, n0; bool perm;
    template <int MT, int NT> __device__ __forceinline__ void operator()(f32x4 (&acc)[MT][NT], int mb, int nb, int lane) const {
        static_assert(NT == 4, "rope needs a 64-column wave span");
        const int cb = n0 + nb, d0 = (lane >> 4) * 4;
#pragma unroll
        for (int mi = 0; mi < MT; ++mi) {
            const int row = m0 + mb + mi * 16 + (lane & 15);
            if (row < MTOT) {
                const float rs = rstd[row]; const int pos = row_pos(row);
                bf16_t* orow = qkv + (size_t)row * NQKV + cb;
                {
                    const float sc = cb < 1024 ? 0.125f : 1.0f;
#pragma unroll
                    for (int ni = 0; ni < 2; ++ni) {
                        const int d = ni * 16 + d0;
                        const f32x4 b1 = *(const f32x4*)(bias + cb + d), b2 = *(const f32x4*)(bias + cb + 32 + d);
                        const f32x4 a1 = perm ? acc[mi][2 * ni] : acc[mi][ni], a2 = perm ? acc[mi][2 * ni + 1] : acc[mi][ni + 2];
                        float o1[4], o2[4];
#pragma unroll
                        for (int r = 0; r < 4; ++r) {
                            const float2 t = cs[pos * 32 + d + r];
                            const float x1 = a1[r] * rs + b1[r], x2 = a2[r] * rs + b2[r];
                            o1[r] = (x1 * t.x - x2 * t.y) * sc; o2[r] = (x2 * t.x + x1 * t.y) * sc;
                        }
                        *(u32x2*)(orow + d) = (u32x2){pk2(o1[0], o1[1]), pk2(o1[2], o1[3])};
                        *(u32x2*)(orow + 32 + d) = (u32x2){pk2(o2[0], o2[1]), pk2(o2[2], o2[3])};
                    }
                }
            }
        }
    }
};
struct EpiV0 {
    const float* rstd; const float* bias; bf16_t* vt0; int m0, n0;
    template <int MT, int NT> __device__ __forceinline__ void operator()(f32x4 (&acc)[MT][NT], int mb, int nb, int lane) const {
        static_assert(NT == 4, "64-column wave span");
        const int cb = n0 + nb, kh = (cb - 1152) >> 6;
#pragma unroll
        for (int mi = 0; mi < MT; ++mi) {
            const int row0 = m0 + mb + mi * 16 + (lane >> 4) * 4;
            if (row0 < MTOT) {
                const f32x4 rs = *(const f32x4*)(rstd + row0); const int b = row_batch(row0), pp = perm16(row_pos(row0));
#pragma unroll
                for (int ni = 0; ni < NT; ++ni) { const int d = ni * 16 + (lane & 15); const float bb = bias[cb + d];
                    const f32x4 v = acc[mi][ni] * rs + bb;
                    *(u32x2*)(vt0 + (size_t)((b * 2 + kh) * 64 + d) * LP + pp) = (u32x2){pk2(v[0], v[1]), pk2(v[2], v[3])}; }
            }
        }
    }
};
struct EpiRes {
    const float* bias; bf16_t* hb; int m0, n0;
    template <int MT, int NT> __device__ __forceinline__ void operator()(f32x4 (&acc)[MT][NT], int mb, int nb, int lane) const {
#pragma unroll
        for (int mi = 0; mi < MT; ++mi) {
            const int row = m0 + mb + mi * 16 + (lane & 15);
            if (row < MTOT) {
#pragma unroll
                for (int ni = 0; ni < NT; ++ni) {
                    const int col = n0 + nb + ni * 16 + (lane >> 4) * 4;
                    u32x2* p = (u32x2*)(hb + (size_t)row * D + col);
                    const u32x2 h = *p;
                    f32x4 v = acc[mi][ni];
                    if (bias) v += *(const f32x4*)(bias + col);
                    v[0] += __uint_as_float(h.x << 16); v[1] += __uint_as_float(h.x & 0xffff0000u); v[2] += __uint_as_float(h.y << 16); v[3] += __uint_as_float(h.y & 0xffff0000u);
                    *p = (u32x2){pk2(v[0], v[1]), pk2(v[2], v[3])};
                }
            }
        }
    }
};
__device__ __forceinline__ void route_phase(LAS unsigned char* lds, const bf16_t* __restrict__ hbr, const float* __restrict__ wrf, const float* __restrict__ bg, const float* __restrict__ br,
                                            float* rstd_out, int* cnt, int* list, float* wslot, int bid, int nblk) {
    const int tid = threadIdx.x, lane = tid & 63, wave = __builtin_amdgcn_readfirstlane(tid >> 6);
    LAS f32x4* wl = (LAS f32x4*)lds;
    LAS int* nrec = (LAS int*)(lds + LDS_MISC + 16); LAS int* bcnt = (LAS int*)(lds + LDS_MISC + 32); LAS int* bbase = (LAS int*)(lds + LDS_MISC + 160); LAS int* rec = (LAS int*)(lds + LDS_MISC + 288);
    for (int i = tid; i < 36 * 256; i += NTHR) wl[i] = *(const f32x4*)(wrf + (size_t)i * 4);
    if (tid < NE) bcnt[tid] = 0;
    if (tid == 0) *nrec = 0;
    __syncthreads();
    for (int row = bid * NWAVE + wave; row < MTOT; row += nblk * NWAVE) {
        f32x4 x[4]; float ss = 0.f;
#pragma unroll
        for (int j = 0; j < 4; ++j) { const u32x2 h = *(const u32x2*)(hbr + (size_t)row * D + j * 256 + lane * 4);
            x[j] = (f32x4){__uint_as_float(h.x << 16), __uint_as_float(h.x & 0xffff0000u), __uint_as_float(h.y << 16), __uint_as_float(h.y & 0xffff0000u)};
            ss += x[j][0] * x[j][0] + x[j][1] * x[j][1] + x[j][2] * x[j][2] + x[j][3] * x[j][3]; }
        ss = wave_sum(ss);
        const float rs = rsqrtf(ss * (1.0f / D) + EPS);
        float lg[4];
#pragma unroll
        for (int c = 0; c < 4; ++c) { float p = 0.f;
#pragma unroll
            for (int j = 0; j < 4; ++j) { const f32x4 w = wl[c * 256 + j * 64 + lane]; p += x[j][0] * w[0] + x[j][1] * w[1] + x[j][2] * w[2] + x[j][3] * w[3]; }
            lg[c] = wave_sum(p) * rs + bg[c]; }
        int gi = 0; float gm = lg[0];
#pragma unroll
        for (int c = 1; c < 4; ++c) if (lg[c] > gm) { gm = lg[c]; gi = c; }
        float gs = 0.f;
#pragma unroll
        for (int c = 0; c < 4; ++c) gs += __expf(lg[c] - gm);
        const float gp = 1.0f / gs;
        gi = __builtin_amdgcn_readfirstlane(gi);
        float e[8];
#pragma unroll
        for (int c = 0; c < 8; ++c) { float p = 0.f;
#pragma unroll
            for (int j = 0; j < 4; ++j) { const f32x4 w = wl[(4 + gi * 8 + c) * 256 + j * 64 + lane]; p += x[j][0] * w[0] + x[j][1] * w[1] + x[j][2] * w[2] + x[j][3] * w[3]; }
            e[c] = wave_sum(p) * rs + br[gi * 8 + c]; }
        int i1 = 0; float v1 = e[0];
#pragma unroll
        for (int c = 1; c < 8; ++c) if (e[c] > v1) { v1 = e[c]; i1 = c; }
        int i2 = -1; float v2 = -3.0e38f;
#pragma unroll
        for (int c = 0; c < 8; ++c) if (c != i1 && e[c] > v2) { v2 = e[c]; i2 = c; }
        if (lane == 0) {
            const float r = __expf(v2 - v1);
            const float w1 = gp / (1.0f + r), w2 = gp * r / (1.0f + r);
            const int e1 = gi * 8 + i1, e2 = gi * 8 + i2;
            const int p1 = atomicAdd((int*)&bcnt[e1], 1), p2 = atomicAdd((int*)&bcnt[e2], 1);
            const int k = atomicAdd((int*)nrec, 2);
            rec[k] = ((row * 2) << 13) | (e1 << 8) | p1; rec[k + 1] = ((row * 2 + 1) << 13) | (e2 << 8) | p2;
            wslot[row * 2] = w1; wslot[row * 2 + 1] = w2; rstd_out[row] = rs;
        }
    }
    __syncthreads();
    if (tid < NE) { const int c = bcnt[tid]; bbase[tid] = c ? __hip_atomic_fetch_add(cnt + tid * 64, c, __ATOMIC_RELAXED, __HIP_MEMORY_SCOPE_AGENT) : 0; }
    __syncthreads();
    for (int k = tid; k < *nrec; k += NTHR) { const int r = rec[k], e = (r >> 8) & 31; list[(size_t)e * CAP + bbase[e] + (r & 255)] = r >> 13; }
    __syncthreads();
}
__device__ __forceinline__ void final_phase(const bf16_t* __restrict__ hb, const bf16_t* __restrict__ ybuf, const float* __restrict__ g, float* out, int bid, int nblk) {
    const int tid = threadIdx.x, lane = tid & 63, wave = tid >> 6;
    for (int row = bid * NWAVE + wave; row < MREAL; row += nblk * NWAVE) {
        f32x4 v[4]; float ss = 0.f;
#pragma unroll
        for (int j = 0; j < 4; ++j) { const size_t c = j * 256 + lane * 4;
            const u32x2 h = *(const u32x2*)(hb + (size_t)row * D + c), y0 = *(const u32x2*)(ybuf + (size_t)(row * 2) * D + c), y1 = *(const u32x2*)(ybuf + (size_t)(row * 2 + 1) * D + c);
            v[j][0] = __uint_as_float(h.x << 16) + __uint_as_float(y0.x << 16) + __uint_as_float(y1.x << 16);
            v[j][1] = __uint_as_float(h.x & 0xffff0000u) + __uint_as_float(y0.x & 0xffff0000u) + __uint_as_float(y1.x & 0xffff0000u);
            v[j][2] = __uint_as_float(h.y << 16) + __uint_as_float(y0.y << 16) + __uint_as_float(y1.y << 16);
            v[j][3] = __uint_as_float(h.y & 0xffff0000u) + __uint_as_float(y0.y & 0xffff0000u) + __uint_as_float(y1.y & 0xffff0000u);
            ss += v[j][0] * v[j][0] + v[j][1] * v[j][1] + v[j][2] * v[j][2] + v[j][3] * v[j][3]; }
        const float rs = rsqrtf(wave_sum(ss) * (1.0f / D) + EPS);
#pragma unroll
        for (int j = 0; j < 4; ++j) { const f32x4 gg = *(const f32x4*)(g + j * 256 + lane * 4); *(f32x4*)(out + (size_t)row * D + j * 256 + lane * 4) = v[j] * rs * gg; }
    }
}

typedef float f32x16 __attribute__((ext_vector_type(16)));
constexpr int AT_STAGE = 20480;
__device__ __forceinline__ float max3f(float a, float b, float c) { float r; asm("v_max3_f32 %0, %1, %2, %3" : "=v"(r) : "v"(a), "v"(b), "v"(c)); return r; }
__device__ __forceinline__ float max2f(float a, float b) { float r; asm("v_max_f32_e32 %0, %1, %2" : "=v"(r) : "v"(a), "v"(b)); return r; }
__device__ __forceinline__ float fadd_s(float a, float b) { float r; asm("v_add_f32_e32 %0, %1, %2" : "=v"(r) : "v"(a), "v"(b)); return r; }
__device__ __forceinline__ void mla_unit(LAS unsigned char* lds, int b, int h, int qi, const bf16_t* __restrict__ Q1, const bf16_t* __restrict__ K1, const bf16_t* __restrict__ kpe,
                                         const bf16_t* __restrict__ VT1, bf16_t* o) {
    const int tid = threadIdx.x, lane = tid & 63, wave = __builtin_amdgcn_readfirstlane(tid >> 6), r32 = lane & 31, hi = lane >> 5;
    const size_t qrow = (size_t)b * SEQ + 256 * qi + 32 * wave + r32;
    bf16x8 qf[6];
#pragma unroll
    for (int s = 0; s < 6; ++s) qf[s] = *(const bf16x8*)(Q1 + qrow * 1536 + h * 96 + 16 * s + 8 * hi);
    const int lr = 8 * wave + (lane >> 3);
    const char* ksrc = (const char*)(K1 + ((size_t)b * LP + lr) * 1024 + h * 64) + (((lane & 7) ^ ((lr >> 1) & 7)) << 4);
    const char* vsrc = (const char*)(VT1 + ((size_t)(b * 16 + h) * 64 + lr) * LP) + (((lane & 7) ^ ((lr >> 1) & 7)) << 4);
    const int pr = 16 * wave + (lane >> 2);
    const char* psrc = (const char*)(kpe + ((size_t)b * LP + (pr & 63)) * 32) + (((lane & 3) ^ ((pr >> 2) & 3)) << 4);
#define MLA_ISSUE(j, st) do { \
        __builtin_amdgcn_global_load_lds((const unsigned*)(ksrc + (size_t)(j) * (64 * 2048)), (LAS unsigned*)(lds + (st) * AT_STAGE + wave * 1024), 16, 0, 0); \
        __builtin_amdgcn_global_load_lds((const unsigned*)(vsrc + (size_t)(j) * 128), (LAS unsigned*)(lds + (st) * AT_STAGE + 8192 + wave * 1024), 16, 0, 0); \
        if (wave < 4) __builtin_amdgcn_global_load_lds((const unsigned*)(psrc + (size_t)(j) * (64 * 64)), (LAS unsigned*)(lds + (st) * AT_STAGE + 16384 + wave * 1024), 16, 0, 0); } while (0)
    const int NT = 4 * qi + 5, jmaxw = 4 * qi + ((32 * wave + 47) >> 6);
    const int qp = 16 + 256 * qi + 32 * wave + r32;
    const int koff = r32 * 128, ksw = (r32 >> 1) & 7, poff = 16384 + r32 * 64, psw = (r32 >> 2) & 3, voff = 8192 + r32 * 128;
    f32x16 oacc[2]; oacc[0] = (f32x16){}; oacc[1] = (f32x16){};
    const unsigned lds_a = (unsigned)(size_t)lds;
    unsigned ka[4], pa[2];
#pragma unroll
    for (int s = 0; s < 4; ++s) ka[s] = lds_a + koff + (((2 * s + hi) ^ ksw) << 4);
#pragma unroll
    for (int s = 0; s < 2; ++s) pa[s] = lds_a + poff + (((2 * s + hi) ^ psw) << 4);
#define MLA_DSR(dst, addr, off) asm volatile("ds_read_b128 %0, %1 offset:" #off : "=v"(dst) : "v"(addr))
    constexpr float MLA_THR = 8.0f;
    float mref = 0.f, lsum = 0.f;
    f32x16 negm = (f32x16){};
    MLA_ISSUE(0, 0);
    if (NT > 1) MLA_ISSUE(1, 1);
    int st = 0;
    for (int j = 0; j < NT; ++j) {
        if (j + 1 < NT) { if (wave < 4) asm volatile("s_waitcnt vmcnt(3)" ::: "memory"); else asm volatile("s_waitcnt vmcnt(2)" ::: "memory"); }
        else asm volatile("s_waitcnt vmcnt(0)" ::: "memory");
        __builtin_amdgcn_s_barrier(); asm volatile("" ::: "memory");
        if (j + 2 < NT) { const int st2 = st >= 1 ? st - 1 : 2; MLA_ISSUE(j + 2, st2); }
        if (j <= jmaxw) {
            LAS const unsigned char* sb = lds + st * AT_STAGE;
            f32x16 p0, p1;
            bf16x8 vf[8];
            bf16x8 kf[12];
            { const unsigned so = (unsigned)st * AT_STAGE; const unsigned a0 = ka[0] + so, a1 = ka[1] + so, a2 = ka[2] + so, a3 = ka[3] + so, b0 = pa[0] + so, b1 = pa[1] + so;
              MLA_DSR(kf[0], a0, 0); MLA_DSR(kf[1], a0, 4096); MLA_DSR(kf[2], a1, 0); MLA_DSR(kf[3], a1, 4096); MLA_DSR(kf[4], a2, 0); MLA_DSR(kf[5], a2, 4096); MLA_DSR(kf[6], a3, 0); MLA_DSR(kf[7], a3, 4096);
              MLA_DSR(kf[8], b0, 0); MLA_DSR(kf[9], b0, 2048); MLA_DSR(kf[10], b1, 0); MLA_DSR(kf[11], b1, 2048);
              __builtin_amdgcn_sched_barrier(0);
              asm volatile("s_waitcnt lgkmcnt(10)" : "+v"(kf[0]), "+v"(kf[1]));
              p0 = __builtin_amdgcn_mfma_f32_32x32x16_bf16(kf[0], qf[0], negm, 0, 0, 0);
              p1 = __builtin_amdgcn_mfma_f32_32x32x16_bf16(kf[1], qf[0], negm, 0, 0, 0);
              __builtin_amdgcn_sched_barrier(0);
              asm volatile("s_waitcnt lgkmcnt(8)" : "+v"(kf[2]), "+v"(kf[3]));
              p0 = __builtin_amdgcn_mfma_f32_32x32x16_bf16(kf[2], qf[1], p0, 0, 0, 0);
              p1 = __builtin_amdgcn_mfma_f32_32x32x16_bf16(kf[3], qf[1], p1, 0, 0, 0);
              __builtin_amdgcn_sched_barrier(0);
              asm volatile("s_waitcnt lgkmcnt(6)" : "+v"(kf[4]), "+v"(kf[5]));
              p0 = __builtin_amdgcn_mfma_f32_32x32x16_bf16(kf[4], qf[2], p0, 0, 0, 0);
              p1 = __builtin_amdgcn_mfma_f32_32x32x16_bf16(kf[5], qf[2], p1, 0, 0, 0);
              __builtin_amdgcn_sched_barrier(0);
              asm volatile("s_waitcnt lgkmcnt(4)" : "+v"(kf[6]), "+v"(kf[7]));
              p0 = __builtin_amdgcn_mfma_f32_32x32x16_bf16(kf[6], qf[3], p0, 0, 0, 0);
              p1 = __builtin_amdgcn_mfma_f32_32x32x16_bf16(kf[7], qf[3], p1, 0, 0, 0);
              __builtin_amdgcn_sched_barrier(0);
              asm volatile("s_waitcnt lgkmcnt(2)" : "+v"(kf[8]), "+v"(kf[9]));
              p0 = __builtin_amdgcn_mfma_f32_32x32x16_bf16(kf[8], qf[4], p0, 0, 0, 0);
              p1 = __builtin_amdgcn_mfma_f32_32x32x16_bf16(kf[9], qf[4], p1, 0, 0, 0);
              __builtin_amdgcn_sched_barrier(0);
              asm volatile("s_waitcnt lgkmcnt(0)" : "+v"(kf[10]), "+v"(kf[11]));
              p0 = __builtin_amdgcn_mfma_f32_32x32x16_bf16(kf[10], qf[5], p0, 0, 0, 0);
              p1 = __builtin_amdgcn_mfma_f32_32x32x16_bf16(kf[11], qf[5], p1, 0, 0, 0);
              __builtin_amdgcn_sched_barrier(0);
              MLA_DSR(vf[0], a0, 8192); MLA_DSR(vf[1], a0, 12288); MLA_DSR(vf[2], a1, 8192); MLA_DSR(vf[3], a1, 12288); MLA_DSR(vf[4], a2, 8192); MLA_DSR(vf[5], a2, 12288); MLA_DSR(vf[6], a3, 8192); MLA_DSR(vf[7], a3, 12288); }
            __builtin_amdgcn_sched_barrier(0);
            if (j >= 4 * qi) {
                const int kb0 = 64 * j + 4 * hi;
#pragma unroll
                for (int r = 0; r < 16; ++r) { const int kp = kb0 + (r & 3) + 8 * (r >> 2); if (kp > qp) p0[r] = -1e30f; if (kp + 32 > qp) p1[r] = -1e30f; }
            }
            asm volatile("s_nop 15\n\ts_nop 7" : "+v"(p0), "+v"(p1));
            float tm;
            { float ma = max3f(p0[0], p0[1], p1[0]), mb = max3f(p0[2], p0[3], p1[1]); ma = max3f(ma, p1[2], p1[3]);
#pragma unroll
              for (int r = 4; r < 16; r += 4) { ma = max3f(ma, p0[r], p0[r + 1]); mb = max3f(mb, p0[r + 2], p0[r + 3]); ma = max3f(ma, p1[r], p1[r + 1]); mb = max3f(mb, p1[r + 2], p1[r + 3]); }
              tm = max2f(ma, mb); }
            { auto rr = __builtin_amdgcn_permlane32_swap(__float_as_uint(tm), __float_as_uint(tm), false, false);
              tm = fmaxf(__uint_as_float(rr[0]), __uint_as_float(rr[1])); }
            if (j == 0 || __any(tm > MLA_THR)) {
                const float dl = j == 0 ? tm : fmaxf(tm, 0.f);
                mref += dl;
                const float f = __builtin_amdgcn_exp2f(-dl);
                lsum *= f;
#pragma unroll
                for (int r = 0; r < 16; ++r) { oacc[0][r] *= f; oacc[1][r] *= f; p0[r] -= dl; p1[r] -= dl; negm[r] = -mref; }
            }
            float ps = 0.f;
#pragma unroll
            for (int r = 0; r < 16; ++r) { p0[r] = __builtin_amdgcn_exp2f(p0[r]); p1[r] = __builtin_amdgcn_exp2f(p1[r]); }
            asm volatile("s_nop 1" : "+v"(p0), "+v"(p1));
#pragma unroll
            for (int r = 0; r < 16; ++r) { ps = fadd_s(ps, p0[r]); ps = fadd_s(ps, p1[r]); }
            lsum += ps;
            u32x4 pf[4];
            pf[0] = (u32x4){cvtpk(p0[0], p0[1]), cvtpk(p0[2], p0[3]), cvtpk(p0[4], p0[5]), cvtpk(p0[6], p0[7])};
            pf[1] = (u32x4){cvtpk(p0[8], p0[9]), cvtpk(p0[10], p0[11]), cvtpk(p0[12], p0[13]), cvtpk(p0[14], p0[15])};
            pf[2] = (u32x4){cvtpk(p1[0], p1[1]), cvtpk(p1[2], p1[3]), cvtpk(p1[4], p1[5]), cvtpk(p1[6], p1[7])};
            pf[3] = (u32x4){cvtpk(p1[8], p1[9]), cvtpk(p1[10], p1[11]), cvtpk(p1[12], p1[13]), cvtpk(p1[14], p1[15])};
            asm volatile("s_waitcnt lgkmcnt(0)" : "+v"(vf[0]), "+v"(vf[1]), "+v"(vf[2]), "+v"(vf[3]), "+v"(vf[4]), "+v"(vf[5]), "+v"(vf[6]), "+v"(vf[7]));
#pragma unroll
            for (int s = 0; s < 4; ++s) {
                const bf16x8 pb = __builtin_bit_cast(bf16x8, pf[s]);
                oacc[0] = __builtin_amdgcn_mfma_f32_32x32x16_bf16(vf[2 * s], pb, oacc[0], 0, 0, 0);
                oacc[1] = __builtin_amdgcn_mfma_f32_32x32x16_bf16(vf[2 * s + 1], pb, oacc[1], 0, 0, 0);
            }
        }
        st = st == 2 ? 0 : st + 1;
    }
#undef MLA_ISSUE
#undef MLA_DSR
    lsum = xsum32(lsum);
    const float inv = 1.0f / lsum;
    bf16_t* orow = o + qrow * D + h * 64 + 4 * hi;
#pragma unroll
    for (int db = 0; db < 2; ++db)
#pragma unroll
        for (int g = 0; g < 4; ++g)
            *(u32x2*)(orow + 32 * db + 8 * g) = (u32x2){cvtpk(oacc[db][4 * g] * inv, oacc[db][4 * g + 1] * inv), cvtpk(oacc[db][4 * g + 2] * inv, oacc[db][4 * g + 3] * inv)};
    asm volatile("s_waitcnt lgkmcnt(0)" ::: "memory");
    __builtin_amdgcn_s_barrier(); asm volatile("" ::: "memory");
}
__device__ __forceinline__ void unpack8(const u32x4 v, float (&f)[8]) {
    f[0] = __uint_as_float(v.x << 16); f[1] = __uint_as_float(v.x & 0xffff0000u); f[2] = __uint_as_float(v.y << 16); f[3] = __uint_as_float(v.y & 0xffff0000u);
    f[4] = __uint_as_float(v.z << 16); f[5] = __uint_as_float(v.z & 0xffff0000u); f[6] = __uint_as_float(v.w << 16); f[7] = __uint_as_float(v.w & 0xffff0000u);
}
__device__ __forceinline__ void mla_meta(int b, int h, const bf16_t* __restrict__ Q1, const bf16_t* __restrict__ K1, const bf16_t* __restrict__ kpe, const bf16_t* __restrict__ VT1, bf16_t* o, int lane) {
    const int qi = lane & 15, part = lane >> 4; const size_t qrow = (size_t)MREAL + b * 16 + qi;
    float q[24];
#pragma unroll
    for (int c = 0; c < 3; ++c) { float f[8]; unpack8(*(const u32x4*)(Q1 + qrow * 1536 + h * 96 + 24 * part + 8 * c), f);
#pragma unroll
        for (int i = 0; i < 8; ++i) q[8 * c + i] = f[i]; }
    float sc[16]; float mx = -1e30f;
#pragma unroll
    for (int j = 0; j < 16; ++j) {
        const size_t kr = (size_t)b * LP + j; float s = 0.f;
#pragma unroll
        for (int c = 0; c < 3; ++c) { const int g = 24 * part + 8 * c;
            const bf16_t* src = g < 64 ? K1 + kr * D + h * 64 + g : kpe + kr * 32 + (g - 64);
            float f[8]; unpack8(*(const u32x4*)src, f);
#pragma unroll
            for (int i = 0; i < 8; ++i) s += q[8 * c + i] * f[i]; }
        s = xsum16(s); s = xsum32(s);
        sc[j] = j <= qi ? s : -1e30f; mx = fmaxf(mx, sc[j]);
    }
    float l = 0.f;
#pragma unroll
    for (int j = 0; j < 16; ++j) { sc[j] = exp2f(sc[j] - mx); l += sc[j]; }
    const float inv = 1.0f / l;
#pragma unroll
    for (int dd = 0; dd < 16; ++dd) { const int d = 16 * part + dd; const bf16_t* vr = VT1 + ((size_t)(b * 16 + h) * 64 + d) * LP;
        float e[16]; { float f[8]; unpack8(*(const u32x4*)vr, f);
#pragma unroll
            for (int i = 0; i < 8; ++i) e[i] = f[i]; unpack8(*(const u32x4*)(vr + 8), f);
#pragma unroll
            for (int i = 0; i < 8; ++i) e[8 + i] = f[i]; }
        float acc = 0.f;
#pragma unroll
        for (int j = 0; j < 16; ++j) acc += sc[j] * e[(j & 3) | ((((j >> 2) & 1) << 1 | ((j >> 3) & 1)) << 2)];
        o[qrow * D + h * 64 + d] = f2bf(acc * inv); }
}
__device__ __forceinline__ void mla_phase(LAS unsigned char* lds, const bf16_t* Q1, const bf16_t* K1, const bf16_t* kpe, const bf16_t* VT1, bf16_t* o, int bid, int nblk) {
    const int v = (nblk % 8 == 0) ? (bid % 8) * (nblk / 8) + bid / 8 : bid;
    for (int vv = v; vv < 256; vv += nblk) {
        const int bh = vv >> 3, s = vv & 7, b = bh >> 4, h = bh & 15;
#pragma unroll 1
        for (int i = 0; i < 4; ++i) { const int qi = (i == 0) ? s : (i == 1) ? 15 - s : (i == 2) ? 16 + s : 31 - s; mla_unit(lds, b, h, qi, Q1, K1, kpe, VT1, o); }
        if (s == 0 && threadIdx.x < 64) mla_meta(b, h, Q1, K1, kpe, VT1, o, threadIdx.x);
    }
}

constexpr int SW_K = 0, SW_V = 36864, SW_VP = 560;
__device__ __forceinline__ void swa_block32(LAS const unsigned char* lds, int rb, int gk0, int nks, int mode, int i_q, const bf16x8 (&qf)[4], float& m, float& lsum, f32x16 (&oacc)[2], int r32, int hi) {
    const float C2 = 1.4426950408889634f;
    const int ksw = (r32 >> 1) & 7;
    f32x16 p = (f32x16){};
#pragma unroll
    for (int s = 0; s < 4; ++s) { const bf16x8 k = *(LAS const bf16x8*)(lds + SW_K + (rb + r32) * 128 + (((2 * s + hi) ^ ksw) << 4)); p = __builtin_amdgcn_mfma_f32_32x32x16_bf16(k, qf[s], p, 0, 0, 0); }
    if (mode != 0) {
        const int jb = ((rb - 32) & 127) + 4 * hi;
#pragma unroll
        for (int r = 0; r < 16; ++r) { const int kk = (r & 3) + 8 * (r >> 2);
            const bool ok = mode == 1 ? (kk + 4 * hi < 16) : mode == 2 ? (jb + kk > i_q) : (jb + kk <= i_q);
            if (!ok) p[r] = -1e30f; }
    }
    float tm = p[0];
#pragma unroll
    for (int r = 1; r < 16; ++r) tm = fmaxf(tm, p[r]);
    tm = xmax32(tm);
    const float mn = fmaxf(m, tm), alpha = __builtin_amdgcn_exp2f((m - mn) * C2), nmc = -mn * C2;
    m = mn;
    float ps = 0.f;
#pragma unroll
    for (int r = 0; r < 16; ++r) { p[r] = __builtin_amdgcn_exp2f(__builtin_fmaf(p[r], C2, nmc)); ps += p[r]; }
    lsum = lsum * alpha + ps;
#pragma unroll
    for (int r = 0; r < 16; ++r) { oacc[0][r] *= alpha; oacc[1][r] *= alpha; }
    u32x4 pf[2];
    pf[0] = (u32x4){cvtpk(p[0], p[1]), cvtpk(p[2], p[3]), cvtpk(p[4], p[5]), cvtpk(p[6], p[7])};
    pf[1] = (u32x4){cvtpk(p[8], p[9]), cvtpk(p[10], p[11]), cvtpk(p[12], p[13]), cvtpk(p[14], p[15])};
#pragma unroll
    for (int ks = 0; ks < 2; ++ks) if (ks < nks) {
        const bf16x8 v0 = *(LAS const bf16x8*)(lds + SW_V + r32 * SW_VP + (gk0 + ks) * 32 + hi * 16);
        const bf16x8 v1 = *(LAS const bf16x8*)(lds + SW_V + (32 + r32) * SW_VP + (gk0 + ks) * 32 + hi * 16);
        const bf16x8 pb = __builtin_bit_cast(bf16x8, pf[ks]);
        oacc[0] = __builtin_amdgcn_mfma_f32_32x32x16_bf16(v0, pb, oacc[0], 0, 0, 0);
        oacc[1] = __builtin_amdgcn_mfma_f32_32x32x16_bf16(v1, pb, oacc[1], 0, 0, 0);
    }
}
__device__ __forceinline__ void swa_unit(LAS unsigned char* lds, int b, int n, int kh, const bf16_t* __restrict__ qkv, const bf16_t* __restrict__ VT0, const float* __restrict__ sinks, bf16_t* o) {
    const int tid = threadIdx.x, lane = tid & 63, wave = __builtin_amdgcn_readfirstlane(tid >> 6), r32 = lane & 31, hi = lane >> 5;
    for (int idx = tid; idx < 2176; idx += NTHR) {
        const int row = idx >> 3, c = idx & 7;
        if (row < 16 || n > 0 || row >= 144) {
            const size_t srow = row < 16 ? (size_t)MREAL + b * 16 + row : (size_t)b * SEQ + 128 * (n - 1) + (row - 16);
            const int lrow = row < 16 ? row : 16 + row;
            const u32x4 v = *(const u32x4*)(qkv + srow * NQKV + 1024 + kh * 64 + c * 8);
            *(LAS u32x4*)(lds + SW_K + lrow * 128 + ((c ^ ((lrow >> 1) & 7)) << 4)) = v;
        }
    }
    for (int idx = tid; idx < 2176; idx += NTHR) {
        const int d = idx / 34, c = idx % 34;
        if (c < 2 || n > 0 || c >= 18) {
            const bf16_t* src = VT0 + (size_t)((b * 2 + kh) * 64 + d) * LP + (c < 2 ? c * 8 : 16 + 128 * (n - 1) + (c - 2) * 8);
            *(LAS u32x4*)(lds + SW_V + d * SW_VP + c * 16) = *(const u32x4*)src;
        }
    }
    __syncthreads();
    const int hq = kh * 8 + wave;
    const float sink = sinks[hq];
#pragma unroll 1
    for (int qs = 0; qs < 4; ++qs) {
        const size_t qrow = (size_t)b * SEQ + 128 * n + 32 * qs + r32;
        bf16x8 qf[4];
#pragma unroll
        for (int s = 0; s < 4; ++s) qf[s] = *(const bf16x8*)(qkv + qrow * NQKV + hq * 64 + 16 * s + 8 * hi);
        f32x16 oacc[2]; oacc[0] = (f32x16){}; oacc[1] = (f32x16){};
        float m = sink, lsum = hi == 0 ? 1.0f : 0.0f;
        const int i_q = 32 * qs + r32;
        swa_block32(lds, 0, 0, 1, 1, i_q, qf, m, lsum, oacc, r32, hi);
        if (n > 0) {
            swa_block32(lds, 32 + 32 * qs, 1 + 2 * qs, 2, 2, i_q, qf, m, lsum, oacc, r32, hi);
#pragma unroll 1
            for (int kb = qs + 1; kb < 4; ++kb) swa_block32(lds, 32 + 32 * kb, 1 + 2 * kb, 2, 0, i_q, qf, m, lsum, oacc, r32, hi);
        }
#pragma unroll 1
        for (int kb = 0; kb < qs; ++kb) swa_block32(lds, 160 + 32 * kb, 9 + 2 * kb, 2, 0, i_q, qf, m, lsum, oacc, r32, hi);
        swa_block32(lds, 160 + 32 * qs, 9 + 2 * qs, 2, 3, i_q, qf, m, lsum, oacc, r32, hi);
        lsum = xsum32(lsum);
        const float inv = 1.0f / lsum;
        bf16_t* orow = o + qrow * D + hq * 64 + 4 * hi;
#pragma unroll
        for (int db = 0; db < 2; ++db)
#pragma unroll
            for (int g = 0; g < 4; ++g)
                *(u32x2*)(orow + 32 * db + 8 * g) = (u32x2){cvtpk(oacc[db][4 * g] * inv, oacc[db][4 * g + 1] * inv), cvtpk(oacc[db][4 * g + 2] * inv, oacc[db][4 * g + 3] * inv)};
    }
    __syncthreads();
}
__device__ __forceinline__ void swa_meta(int b, int hq, const bf16_t* __restrict__ qkv, const bf16_t* __restrict__ VT0, const float* __restrict__ sinks, bf16_t* o, int lane) {
    const int qi = lane & 15, part = lane >> 4, kh = hq >> 3; const size_t qrow = (size_t)MREAL + b * 16 + qi;
    float q[16];
#pragma unroll
    for (int c = 0; c < 2; ++c) { float f[8]; unpack8(*(const u32x4*)(qkv + qrow * NQKV + hq * 64 + 16 * part + 8 * c), f);
#pragma unroll
        for (int i = 0; i < 8; ++i) q[8 * c + i] = f[i]; }
    const float sink = sinks[hq];
    float sc[16]; float mx = sink;
#pragma unroll
    for (int j = 0; j < 16; ++j) {
        const size_t kr = (size_t)MREAL + b * 16 + j; float s = 0.f;
#pragma unroll
        for (int c = 0; c < 2; ++c) { float f[8]; unpack8(*(const u32x4*)(qkv + kr * NQKV + 1024 + kh * 64 + 16 * part + 8 * c), f);
#pragma unroll
            for (int i = 0; i < 8; ++i) s += q[8 * c + i] * f[i]; }
        s = xsum16(s); s = xsum32(s);
        sc[j] = j <= qi ? s : -1e30f; mx = fmaxf(mx, sc[j]);
    }
    float l = __expf(sink - mx);
#pragma unroll
    for (int j = 0; j < 16; ++j) { sc[j] = __expf(sc[j] - mx); l += sc[j]; }
    const float inv = 1.0f / l;
#pragma unroll
    for (int dd = 0; dd < 16; ++dd) { const int d = 16 * part + dd; const bf16_t* vr = VT0 + ((size_t)(b * 2 + kh) * 64 + d) * LP;
        float e[16]; { float f[8]; unpack8(*(const u32x4*)vr, f);
#pragma unroll
            for (int i = 0; i < 8; ++i) e[i] = f[i]; unpack8(*(const u32x4*)(vr + 8), f);
#pragma unroll
            for (int i = 0; i < 8; ++i) e[8 + i] = f[i]; }
        float acc = 0.f;
#pragma unroll
        for (int j = 0; j < 16; ++j) acc += sc[j] * e[(j & 3) | ((((j >> 2) & 1) << 1 | ((j >> 3) & 1)) << 2)];
        o[qrow * D + hq * 64 + d] = f2bf(acc * inv); }
}
__device__ __forceinline__ void swa_phase(LAS unsigned char* lds, const bf16_t* qkv, const bf16_t* VT0, const float* sinks, bf16_t* o, int bid, int nblk) {
    for (int u = bid; u < 256; u += nblk) {
        const int b = u >> 7, n = (u >> 1) & 63, kh = u & 1;
        swa_unit(lds, b, n, kh, qkv, VT0, sinks, o);
        if (n == 0) swa_meta(b, kh * 8 + (threadIdx.x >> 6), qkv, VT0, sinks, o, threadIdx.x & 63);
    }
}

template <int MOE_MT>
__device__ __forceinline__ void moe_unit(LAS unsigned char* lds, int e, int s0, int ns, const int* __restrict__ list, const bf16_t* __restrict__ hb, const float* __restrict__ rstd,
                                         const float* __restrict__ wslot, const bf16_t* __restrict__ wgu, const bf16_t* __restrict__ wd, bf16_t* ybuf, unsigned long long* tsb = nullptr) {
#define MSTAMP(i) do { if (PROBE_PHASE >= 600 && tsb && blockIdx.x == 0 && threadIdx.x == 0) tsb[i] = __builtin_amdgcn_s_memrealtime(); } while (0)
    MSTAMP(20);
    constexpr int MOE_BM = 16 * MOE_MT, MOE_HT = MOE_BM * 128, MOE_B2 = 2 * MOE_HT, MOE_ST2 = 32768, MOE_HLO = MOE_B2 + 2 * MOE_ST2, MOE_INFO = MOE_HLO + 2 * MOE_HT;
    static_assert(MOE_B2 + 2 * MOE_ST2 <= MOE_HLO && MOE_INFO + 3072 <= LDS_MISC, "moe lds");
#define moe_hoff(kt) ((kt) < 4 ? MOE_HLO + (kt) * (MOE_HT / 2) : ((kt) - 4) * (MOE_HT / 2))
    const int tid = threadIdx.x, lane = tid & 63, wave = __builtin_amdgcn_readfirstlane(tid >> 6);
    LAS int* slotl = (LAS int*)(lds + MOE_INFO); LAS float* rsl = (LAS float*)(lds + MOE_INFO + 1024); LAS float* wl = (LAS float*)(lds + MOE_INFO + 2048);
    if (tid < MOE_BM) { const int sl = list[(size_t)e * CAP + s0 + (tid < ns ? tid : 0)]; slotl[tid] = sl; rsl[tid] = rstd[sl >> 1]; wl[tid] = wslot[sl]; }
    __syncthreads();
    const int lc4 = (lane & 3) ^ swzF(lane >> 4);
    const int fro32 = (lane & 15) * 64 + (((lane >> 4) ^ swzF((lane >> 2) & 3)) << 4);
    {
        constexpr int ST = (MOE_BM + 512) * 64, GA = MOE_BM / 16, G = GA + 32, NG = (G + 7) / 8;
        static_assert(2 * ST <= MOE_HLO && 2 * MOE_HT <= ST, "moe gemm1 lds");
        const char* src[NG];
#pragma unroll
        for (int i = 0; i < NG; ++i) { const int g = wave + 8 * i;
            if (g < GA) src[i] = (const char*)(hb + (size_t)(slotl[g * 16 + (lane >> 2)] >> 1) * D) + lc4 * 16;
            else if (g < G) src[i] = (const char*)(wgu + (size_t)((g - GA) * 16 + (lane >> 2)) * D) + lc4 * 16;
            else src[i] = nullptr; }
        f32x4 acc[MOE_MT][4];
#pragma unroll
        for (int mi = 0; mi < MOE_MT; ++mi)
#pragma unroll
            for (int ni = 0; ni < 4; ++ni) acc[mi][ni] = (f32x4){0.f, 0.f, 0.f, 0.f};
#define M1_STAGE(st, step) do { _Pragma("unroll") for (int _i = 0; _i < NG; ++_i) { const int _g = wave + 8 * _i; if (_g < G) \
        __builtin_amdgcn_global_load_lds((const unsigned*)(src[_i] + (size_t)(step) * 64), (LAS unsigned*)(lds + (st) * ST + _g * 1024), 16, 0, 0); } } while (0)
        M1_STAGE(0, 0);
        for (int step = 0; step < 32; ++step) {
            asm volatile("s_waitcnt vmcnt(0)" ::: "memory");
            __syncthreads();
            if (step + 1 < 32) M1_STAGE((step + 1) & 1, step + 1);
            LAS const unsigned char* sa = lds + (step & 1) * ST + fro32;
            LAS const unsigned char* sb = lds + (step & 1) * ST + (MOE_BM + wave * 64) * 64 + fro32;
            bf16x8 bfr[4];
#pragma unroll
            for (int ni = 0; ni < 4; ++ni) bfr[ni] = *(LAS const bf16x8*)(sb + ni * 1024);
#pragma unroll
            for (int mi = 0; mi < MOE_MT; ++mi) { const bf16x8 af = *(LAS const bf16x8*)(sa + mi * 1024);
#pragma unroll
                for (int ni = 0; ni < 4; ++ni) acc[mi][ni] = __builtin_amdgcn_mfma_f32_16x16x32_bf16(bfr[ni], af, acc[mi][ni], 0, 0, 0); }
        }
#undef M1_STAGE
        int lane_h = threadIdx.x & 63; asm volatile("" : "+v"(lane_h));
#define lane lane_h
#pragma unroll
        for (int p = 0; p < 2; ++p) {
            const int n = 32 * wave + 16 * p + (lane >> 4) * 4;
            const int csw = ((n & 31) >> 3);
#pragma unroll
            for (int mi = 0; mi < MOE_MT; ++mi) { const int row = mi * 16 + (lane & 15); const float rs = rsl[row]; float hv[4];
#pragma unroll
                for (int r = 0; r < 4; ++r) { const float g = acc[mi][2 * p][r] * rs, u = acc[mi][2 * p + 1][r] * rs; hv[r] = g * __builtin_amdgcn_rcpf(1.0f + __expf(-g)) * u; }
                *(LAS u32x2*)(lds + moe_hoff(n >> 5) + row * 64 + ((csw ^ swzF((row >> 2) & 3)) << 4) + (n & 4) * 2) = (u32x2){pk2(hv[0], hv[1]), pk2(hv[2], hv[3])}; }
        }
#undef lane
    }
    __syncthreads();
    MSTAMP(21);
    {
        const char* src2[4];
#pragma unroll
        for (int i = 0; i < 4; ++i) src2[i] = (const char*)(wd + (size_t)((wave + 8 * i) * 16 + (lane >> 2)) * DE) + lc4 * 16;
        f32x4 acc[MOE_MT][4];
#pragma unroll
        for (int mi = 0; mi < MOE_MT; ++mi)
#pragma unroll
            for (int ni = 0; ni < 4; ++ni) acc[mi][ni] = (f32x4){0.f, 0.f, 0.f, 0.f};
#define M2_STAGE(st, q) do { _Pragma("unroll") for (int _i = 0; _i < 4; ++_i) \
        __builtin_amdgcn_global_load_lds((const unsigned*)(src2[_i] + (size_t)((q) >> 3) * (512 * 512) + (size_t)((q) & 7) * 64), (LAS unsigned*)(lds + MOE_B2 + (st) * MOE_ST2 + (wave + 8 * _i) * 1024), 16, 0, 0); } while (0)
        M2_STAGE(0, 0);
        for (int q = 0; q < 16; ++q) {
            asm volatile("s_waitcnt vmcnt(0)" ::: "memory");
            __syncthreads();
            if (q + 1 < 16) M2_STAGE((q + 1) & 1, q + 1);
            LAS const unsigned char* sa = lds + moe_hoff(q & 7) + fro32;
            LAS const unsigned char* sb = lds + MOE_B2 + (q & 1) * MOE_ST2 + (wave * 64) * 64 + fro32;
            bf16x8 bfr[4];
#pragma unroll
            for (int ni = 0; ni < 4; ++ni) bfr[ni] = *(LAS const bf16x8*)(sb + ni * 1024);
#pragma unroll
            for (int mi = 0; mi < MOE_MT; ++mi) { const bf16x8 af = *(LAS const bf16x8*)(sa + mi * 1024);
#pragma unroll
                for (int ni = 0; ni < 4; ++ni) acc[mi][ni] = __builtin_amdgcn_mfma_f32_16x16x32_bf16(bfr[ni], af, acc[mi][ni], 0, 0, 0); }
            if ((q & 7) == 7) {
                int lane_y = threadIdx.x & 63; asm volatile("" : "+v"(lane_y));
                const int cb = (q >> 3) * 512 + wave * 64 + (lane_y >> 4) * 4;
#pragma unroll
                for (int mi = 0; mi < MOE_MT; ++mi) { const int row = mi * 16 + (lane_y & 15);
                    if (row < ns) { const float w = wl[row]; bf16_t* yr = ybuf + (size_t)slotl[row] * D + cb;
#pragma unroll
                        for (int ni = 0; ni < 4; ++ni) { const f32x4 v = acc[mi][ni] * w; *(u32x2*)(yr + ni * 16) = (u32x2){pk2(v[0], v[1]), pk2(v[2], v[3])}; } }
#pragma unroll
                    for (int ni = 0; ni < 4; ++ni) acc[mi][ni] = (f32x4){0.f, 0.f, 0.f, 0.f}; }
            }
        }
#undef M2_STAGE
    }
#undef moe_hoff
    __syncthreads();
    MSTAMP(22);
#undef MSTAMP
}
__device__ __forceinline__ void moe_phase(LAS unsigned char* lds, int* cnt, const int* list, const bf16_t* hb, const float* rstd, const float* wslot, const bf16_t* wgu, const bf16_t* wd, bf16_t* ybuf, int bid, int nblk, unsigned long long* tsb = nullptr) {
    const bool grp = (nblk % 8) == 0;
    int ntile[NE]; int gsum = 0; bool fit = grp;
#pragma unroll
    for (int e = 0; e < NE; ++e) { const int c = __hip_atomic_load(cnt + e * 64, __ATOMIC_RELAXED, __HIP_MEMORY_SCOPE_AGENT); const int bm = 144; ntile[e] = (c + bm - 1) / bm;
        gsum = (e & 3) == 0 ? ntile[e] : gsum + ntile[e]; if ((e & 3) == 3 && gsum > nblk / 8) fit = false; }
    const int x = bid % 8;
    int u = fit ? bid / 8 : (grp ? x * (nblk / 8) + bid / 8 : bid), base = 0;
    const int stride = fit ? nblk / 8 : nblk;
#pragma unroll 1
    for (int e = 0; e < NE; ++e) {
        if (fit && (e >> 2) != x) continue;
        const int c = __hip_atomic_load(cnt + e * 64, __ATOMIC_RELAXED, __HIP_MEMORY_SCOPE_AGENT);
        const bool big = false; const int bm = 144, nt = (c + bm - 1) / bm;
        while (u < base + nt) { const int t = u - base; const int ns = c - t * bm < bm ? c - t * bm : bm;
            moe_unit<9>(lds, e, t * bm, ns, list, hb, rstd, wslot, wgu + (size_t)e * 512 * 1024, wd + (size_t)e * 1024 * 256, ybuf, tsb);
            u += stride; }
        base += nt;
    }
}

template <int MT>
__device__ __forceinline__ void l1proj_unit(LAS unsigned char* lds, int row0, int mrow0, bf16_t* hb, const bf16_t* __restrict__ ybuf, const bf16_t* __restrict__ win_t, const bf16_t* __restrict__ wuq_t,
                                            const bf16_t* __restrict__ wukv_t, const float2* __restrict__ cs, bf16_t* kpe, bf16_t* Q1, bf16_t* K1, bf16_t* VT1) {
    constexpr int BM = 16 * MT, STW = (BM + 512) * 64, KT = BM * 64  , CQN = 0, CKV = 8 * KT, RB = 12 * KT, STB = 32768, PART = 3 * STW;
    static_assert(RB + 3 * STB <= LDS_MISC && PART + 8 * BM * 4 <= LDS_MISC, "l1proj lds");
    const int tid = threadIdx.x, lane = tid & 63, wave = __builtin_amdgcn_readfirstlane(tid >> 6);
    LAS float* rsl = (LAS float*)(lds + LDS_MISC + 256);
#define L1_GROW(r) ((r) < 64 ? row0 + (r) : mrow0 + (r) - 64)
    for (int r = wave; r < BM; r += NWAVE) {
        const size_t grow = L1_GROW(r); float ss = 0.f;
#pragma unroll
        for (int j = 0; j < 4; ++j) { const size_t c = j * 256 + lane * 4;
            const u32x2 h = *(const u32x2*)(hb + grow * D + c), y0 = *(const u32x2*)(ybuf + (grow * 2) * D + c), y1 = *(const u32x2*)(ybuf + (grow * 2 + 1) * D + c);
            float v[4];
            v[0] = __uint_as_float(h.x << 16) + __uint_as_float(y0.x << 16) + __uint_as_float(y1.x << 16);
            v[1] = __uint_as_float(h.x & 0xffff0000u) + __uint_as_float(y0.x & 0xffff0000u) + __uint_as_float(y1.x & 0xffff0000u);
            v[2] = __uint_as_float(h.y << 16) + __uint_as_float(y0.y << 16) + __uint_as_float(y1.y << 16);
            v[3] = __uint_as_float(h.y & 0xffff0000u) + __uint_as_float(y0.y & 0xffff0000u) + __uint_as_float(y1.y & 0xffff0000u);
            ss += v[0] * v[0] + v[1] * v[1] + v[2] * v[2] + v[3] * v[3];
            *(u32x2*)(hb + grow * D + c) = (u32x2){pk2(v[0], v[1]), pk2(v[2], v[3])}; }
        ss = wave_sum(ss); if (lane == 0) rsl[r] = rsqrtf(ss * (1.0f / D) + EPS);
    }
    asm volatile("s_waitcnt vmcnt(0)" ::: "memory");
    __syncthreads();
    const int lc = (lane & 3) ^ swzF(lane >> 4);
    const int fro = (lane & 15) * 64 + (((lane >> 4) ^ swzF((lane >> 2) & 3)) << 4);
    f32x4 acc[MT][4];
#pragma unroll
    for (int mi = 0; mi < MT; ++mi)
#pragma unroll
        for (int ni = 0; ni < 4; ++ni) acc[mi][ni] = (f32x4){0.f, 0.f, 0.f, 0.f};
    {
        const char* srcb[4];
#pragma unroll
        for (int i = 0; i < 4; ++i) srcb[i] = (const char*)(win_t + (size_t)((wave + 8 * i) * 16 + (lane >> 2)) * D) + lc * 16;
        const char* srca = (const char*)(hb + (size_t)L1_GROW((wave < MT ? wave : 0) * 16 + (lane >> 2)) * D) + lc * 16;
#define W_ISSUE(st, kt) do { if (wave < MT) __builtin_amdgcn_global_load_lds((const unsigned*)(srca + (size_t)(kt) * 64), (LAS unsigned*)(lds + (st) * STW + wave * 1024), 16, 0, 16); \
        _Pragma("unroll") for (int _i = 0; _i < 4; ++_i) __builtin_amdgcn_global_load_lds((const unsigned*)(srcb[_i] + (size_t)(kt) * 64), (LAS unsigned*)(lds + (st) * STW + (MT + wave + 8 * _i) * 1024), 16, 0, 0); } while (0)
        W_ISSUE(0, 0); W_ISSUE(1, 1);
        int st = 0;
        for (int kt = 0; kt < 32; ++kt) {
            if (kt + 1 < 32) { if (wave < MT) wait_vm<5>(); else wait_vm<4>(); } else wait_vm<0>();
            __builtin_amdgcn_s_barrier(); asm volatile("" ::: "memory");
            if (kt + 2 < 32) W_ISSUE(st == 0 ? 2 : st - 1, kt + 2);
            LAS const unsigned char* sa = lds + st * STW + fro;
            LAS const unsigned char* sb = lds + st * STW + (BM + wave * 64) * 64 + fro;
            bf16x8 bfr[4];
#pragma unroll
            for (int ni = 0; ni < 4; ++ni) bfr[ni] = *(LAS const bf16x8*)(sb + ni * 1024);
#pragma unroll
            for (int mi = 0; mi < MT; ++mi) { const bf16x8 af = *(LAS const bf16x8*)(sa + mi * 1024);
#pragma unroll
                for (int ni = 0; ni < 4; ++ni) acc[mi][ni] = __builtin_amdgcn_mfma_f32_16x16x32_bf16(bfr[ni], af, acc[mi][ni], 0, 0, 0); }
            st = st == 2 ? 0 : st + 1;
        }
#undef W_ISSUE
    }
    asm volatile("s_waitcnt lgkmcnt(0)" ::: "memory");
    __syncthreads();
    LAS float* part = (LAS float*)(lds + PART);
    int lane_e = lane; asm volatile("" : "+v"(lane_e));
#define lane lane_e
#pragma unroll
    for (int mi = 0; mi < MT; ++mi) { const float rs = rsl[mi * 16 + (lane & 15)]; float ss = 0.f;
#pragma unroll
        for (int ni = 0; ni < 4; ++ni) { acc[mi][ni] = acc[mi][ni] * rs; ss += acc[mi][ni][0] * acc[mi][ni][0] + acc[mi][ni][1] * acc[mi][ni][1] + acc[mi][ni][2] * acc[mi][ni][2] + acc[mi][ni][3] * acc[mi][ni][3]; }
        ss = xsum16(ss); ss = xsum32(ss);
        if (lane < 16) part[wave * BM + mi * 16 + lane] = ss; }
    __syncthreads();
    if (wave < 6) {
#pragma unroll
        for (int mi = 0; mi < MT; ++mi) { const int row = mi * 16 + (lane & 15);
            const float tot = wave < 4 ? (part[row] + part[BM + row]) + (part[2 * BM + row] + part[3 * BM + row]) : part[4 * BM + row] + part[5 * BM + row];
            const float rn = rsqrtf(tot * (wave < 4 ? 1.0f / 256 : 1.0f / 128) + EPS);
#pragma unroll
            for (int ni = 0; ni < 4; ++ni) { const int cc = (wave < 4 ? 64 * wave : 64 * (wave - 4)) + ni * 16 + (lane >> 4) * 4; const f32x4 v = acc[mi][ni] * rn;
                *(LAS u32x2*)(lds + (wave < 4 ? CQN : CKV) + (cc >> 5) * KT + row * 64 + (((((cc & 31) >> 3)) ^ swzF((row >> 2) & 3)) << 4) + (cc & 4) * 2) = (u32x2){pk2(v[0], v[1]), pk2(v[2], v[3])}; } }
    } else if (wave == 6) {
#pragma unroll
        for (int mi = 0; mi < MT; ++mi) { const int row = mi * 16 + (lane & 15); const int grow = L1_GROW(row); const int pos = row_pos(grow), d0 = (lane >> 4) * 4;
            f32x4 o1, o2;
#pragma unroll
            for (int r = 0; r < 4; ++r) { const float2 t = cs[pos * 32 + 2 * (d0 + r)]; const float x1 = acc[mi][0][r], x2 = acc[mi][1][r]; o1[r] = x1 * t.x - x2 * t.y; o2[r] = x2 * t.x + x1 * t.y; }
            bf16_t* kr = kpe + ((size_t)row_batch(grow) * LP + pos) * 32;
            *(u32x2*)(kr + d0) = (u32x2){pk2(o1[0], o1[1]), pk2(o1[2], o1[3])}; *(u32x2*)(kr + 16 + d0) = (u32x2){pk2(o2[0], o2[1]), pk2(o2[2], o2[3])}; }
    }
#undef lane
    __syncthreads();
    const char* srcu[4];
#define U_ISSUE(st, base, pitchB, chunk, kt) do { _Pragma("unroll") for (int _i = 0; _i < 4; ++_i) \
        __builtin_amdgcn_global_load_lds((const unsigned*)(srcu[_i] + (size_t)(chunk) * 512 * (pitchB) + (size_t)(kt) * 64), (LAS unsigned*)(lds + RB + (st) * STB + (wave + 8 * _i) * 1024), 16, 0, 0); } while (0)
    {
#pragma unroll
        for (int i = 0; i < 4; ++i) srcu[i] = (const char*)(wuq_t + (size_t)((wave + 8 * i) * 16 + (lane >> 2)) * 256) + lc * 16;
#pragma unroll
        for (int mi = 0; mi < MT; ++mi)
#pragma unroll
            for (int ni = 0; ni < 4; ++ni) acc[mi][ni] = (f32x4){0.f, 0.f, 0.f, 0.f};
        U_ISSUE(0, 0, 512, 0, 0); U_ISSUE(1, 0, 512, 0, 1);
        int st = 0;
        for (int q = 0; q < 24; ++q) {
            if (q + 1 < 24) wait_vm<4>(); else wait_vm<0>();
            __builtin_amdgcn_s_barrier(); asm volatile("" ::: "memory");
            if (q + 2 < 24) U_ISSUE(st == 0 ? 2 : st - 1, 0, 512, (q + 2) >> 3, (q + 2) & 7);
            LAS const unsigned char* sa = lds + CQN + (q & 7) * KT + fro;
            LAS const unsigned char* sb = lds + RB + st * STB + (wave * 64) * 64 + fro;
            bf16x8 bfr[4];
#pragma unroll
            for (int ni = 0; ni < 4; ++ni) bfr[ni] = *(LAS const bf16x8*)(sb + ni * 1024);
#pragma unroll
            for (int mi = 0; mi < MT; ++mi) { const bf16x8 af = *(LAS const bf16x8*)(sa + mi * 1024);
#pragma unroll
                for (int ni = 0; ni < 4; ++ni) acc[mi][ni] = __builtin_amdgcn_mfma_f32_16x16x32_bf16(bfr[ni], af, acc[mi][ni], 0, 0, 0); }
            if ((q & 7) == 7) {
                int lane_q = lane; asm volatile("" : "+v"(lane_q));
#define lane lane_q
                const float scale = 0.10206207261596577f * 1.4426950408889634f; const int d0 = (lane >> 4) * 4;
#pragma unroll
                for (int mi = 0; mi < MT; ++mi) { const int grow = L1_GROW(mi * 16 + (lane & 15)); const int pos = row_pos(grow);
#pragma unroll
                    for (int bi = 0; bi < 2; ++bi) { const int gc = (q >> 3) * 512 + 64 * wave + bi * 32; bf16_t* orow = Q1 + (size_t)grow * 1536 + gc;
                        f32x4 v1 = acc[mi][2 * bi], v2 = acc[mi][2 * bi + 1];
                        if (((gc >> 5) % 3) == 2) {
#pragma unroll
                            for (int r = 0; r < 4; ++r) { const float2 t = cs[pos * 32 + 2 * (d0 + r)]; const float x1 = v1[r], x2 = v2[r]; v1[r] = x1 * t.x - x2 * t.y; v2[r] = x2 * t.x + x1 * t.y; } }
                        v1 = v1 * scale; v2 = v2 * scale;
                        *(u32x2*)(orow + d0) = (u32x2){pk2(v1[0], v1[1]), pk2(v1[2], v1[3])}; *(u32x2*)(orow + 16 + d0) = (u32x2){pk2(v2[0], v2[1]), pk2(v2[2], v2[3])}; }
#pragma unroll
                    for (int ni = 0; ni < 4; ++ni) acc[mi][ni] = (f32x4){0.f, 0.f, 0.f, 0.f}; }
#undef lane
            }
            st = st == 2 ? 0 : st + 1;
        }
    }
    asm volatile("s_waitcnt lgkmcnt(0)" ::: "memory");
    __syncthreads();
    {
#pragma unroll
        for (int i = 0; i < 4; ++i) srcu[i] = (const char*)(wukv_t + (size_t)((wave + 8 * i) * 16 + (lane >> 2)) * 128) + lc * 16;
#pragma unroll
        for (int mi = 0; mi < MT; ++mi)
#pragma unroll
            for (int ni = 0; ni < 4; ++ni) acc[mi][ni] = (f32x4){0.f, 0.f, 0.f, 0.f};
        U_ISSUE(0, 0, 256, 0, 0); U_ISSUE(1, 0, 256, 0, 1);
        int st = 0;
        for (int q = 0; q < 16; ++q) {
            if (q + 1 < 16) wait_vm<4>(); else wait_vm<0>();
            __builtin_amdgcn_s_barrier(); asm volatile("" ::: "memory");
            if (q + 2 < 16) U_ISSUE(st == 0 ? 2 : st - 1, 0, 256, (q + 2) >> 2, (q + 2) & 3);
            LAS const unsigned char* sa = lds + CKV + (q & 3) * KT + fro;
            LAS const unsigned char* sb = lds + RB + st * STB + (wave * 64) * 64 + fro;
            bf16x8 bfr[4];
#pragma unroll
            for (int ni = 0; ni < 4; ++ni) bfr[ni] = *(LAS const bf16x8*)(sb + ni * 1024);
            if (q < 8) {
#pragma unroll
                for (int mi = 0; mi < MT; ++mi) { const bf16x8 af = *(LAS const bf16x8*)(sa + mi * 1024);
#pragma unroll
                    for (int ni = 0; ni < 4; ++ni) acc[mi][ni] = __builtin_amdgcn_mfma_f32_16x16x32_bf16(bfr[ni], af, acc[mi][ni], 0, 0, 0); }
            } else {
#pragma unroll
                for (int mi = 0; mi < MT; ++mi) { const bf16x8 af = *(LAS const bf16x8*)(sa + mi * 1024);
#pragma unroll
                    for (int ni = 0; ni < 4; ++ni) acc[mi][ni] = __builtin_amdgcn_mfma_f32_16x16x32_bf16(af, bfr[ni], acc[mi][ni], 0, 0, 0); }
            }
            if ((q & 3) == 3) {
                const int ch = q >> 2;
                int lane_k = lane; asm volatile("" : "+v"(lane_k));
#define lane lane_k
                if (ch < 2) {
#pragma unroll
                    for (int mi = 0; mi < MT; ++mi) { const int grow = L1_GROW(mi * 16 + (lane & 15)); const size_t kr = (size_t)row_batch(grow) * LP + row_pos(grow);
#pragma unroll
                        for (int ni = 0; ni < 4; ++ni) { const f32x4 v = acc[mi][ni];
                            *(u32x2*)(K1 + kr * D + 512 * ch + 64 * wave + ni * 16 + (lane >> 4) * 4) = (u32x2){pk2(v[0], v[1]), pk2(v[2], v[3])}; acc[mi][ni] = (f32x4){0.f, 0.f, 0.f, 0.f}; } }
                } else {
#pragma unroll
                    for (int mi = 0; mi < MT; ++mi) { const int grow0 = L1_GROW(mi * 16 + (lane >> 4) * 4); const int b = row_batch(grow0), pp = perm16(row_pos(grow0));
#pragma unroll
                        for (int ni = 0; ni < 4; ++ni) { const int hd = 512 * (ch - 2) + 64 * wave + ni * 16 + (lane & 15); const f32x4 v = acc[mi][ni];
                            *(u32x2*)(VT1 + (size_t)(b * 1024 + hd) * LP + pp) = (u32x2){pk2(v[0], v[1]), pk2(v[2], v[3])}; acc[mi][ni] = (f32x4){0.f, 0.f, 0.f, 0.f}; } }
                }
#undef lane
            }
            st = st == 2 ? 0 : st + 1;
        }
    }
#undef U_ISSUE
#undef L1_GROW
    asm volatile("s_waitcnt lgkmcnt(0)" ::: "memory");
    __syncthreads();
}
__device__ __forceinline__ void l1proj_phase(LAS unsigned char* lds, bf16_t* hb, const bf16_t* ybuf, const bf16_t* win_t, const bf16_t* wuq_t, const bf16_t* wukv_t, const float2* cs, bf16_t* kpe,
                                             bf16_t* Q1, bf16_t* K1, bf16_t* VT1, int bid, int nblk) {
    { const int gt = bid * NTHR + threadIdx.x, ngt = nblk * NTHR;
      for (int idx = gt; idx < 2 * 48 * 1024; idx += ngt) { const int b = idx / (48 * 1024), r = idx % (48 * 1024); K1[((size_t)b * LP + 8208) * 1024 + r] = 0; }
      for (int idx = gt; idx < 2 * 16 * 64 * 48; idx += ngt) { const int rr = idx / 48, c = idx % 48; VT1[(size_t)rr * LP + 8208 + c] = 0; } }
    for (int u = bid; u < 256; u += nblk) {
        if (u >= 254) l1proj_unit<5>(lds, u * 64, MREAL + (u - 254) * 16, hb, ybuf, win_t, wuq_t, wukv_t, cs, kpe, Q1, K1, VT1);
        else l1proj_unit<4>(lds, u * 64, MREAL, hb, ybuf, win_t, wuq_t, wukv_t, cs, kpe, Q1, K1, VT1);
    }
}

struct EpiNull { int m0, n0;
    template <int MT, int NT> __device__ __forceinline__ void operator()(f32x4 (&acc)[MT][NT], int, int, int) const {
#pragma unroll
        for (int mi = 0; mi < MT; ++mi)
#pragma unroll
            for (int ni = 0; ni < NT; ++ni) asm volatile("" :: "v"(acc[mi][ni])); } };
__device__ __forceinline__ void transpose_item(const float* __restrict__ W, int N, const float* __restrict__ gain, bf16_t* dst, int ldk, int drow0, int k0, int n0, LAS float* scr, int lane, int dskip = 0) {
#pragma unroll 8
    for (int i = 0; i < 32; ++i) { const int kk = 2 * i + (lane >> 5); float v = W[(size_t)(k0 + kk) * N + n0 + (lane & 31)]; if (gain) v *= gain[k0 + kk]; scr[kk * 33 + (lane & 31)] = v; }
    asm volatile("s_waitcnt lgkmcnt(0)" ::: "memory");
    const int c = lane & 7;
#pragma unroll
    for (int j = 0; j < 4; ++j) { const int n = (lane >> 3) + 8 * j; const LAS float* s = scr + (8 * c) * 33 + n;
        u32x4 o; o.x = pk2(s[0 * 33], s[1 * 33]); o.y = pk2(s[2 * 33], s[3 * 33]); o.z = pk2(s[4 * 33], s[5 * 33]); o.w = pk2(s[6 * 33], s[7 * 33]);
        *(u32x4*)(dst + (size_t)(drow0 + n + (n >= 16 ? dskip : 0)) * ldk + k0 + 8 * c) = o; }
    asm volatile("s_waitcnt lgkmcnt(0)" ::: "memory");
}
struct MoeItem { const float* src; const float* gain; bf16_t* dst; int pitch, ldk, kind, nrow0; };
__device__ __forceinline__ MoeItem moe_item(int it, const float* wgate, const float* wup, const float* wdown, const float* gain, bf16_t* wgu_t, bf16_t* wd_t) {
    const int e = it / 48, r = it % 48, which = r >> 4, q = r & 15; MoeItem d;
    if (which < 2) { d.src = (which ? wup : wgate) + (size_t)e * D * DE + (size_t)q * 64 * DE; d.gain = gain + q * 64; d.dst = wgu_t + (size_t)e * 512 * 1024 + q * 64; d.pitch = DE; d.ldk = 1024; d.kind = which; d.nrow0 = 0; }
    else { const int kb = q >> 2, nb = q & 3; d.src = wdown + (size_t)e * DE * D + (size_t)kb * 64 * D + nb * 256; d.gain = nullptr; d.dst = wd_t + (size_t)e * 1024 * 256 + kb * 64; d.pitch = D; d.ldk = 256; d.kind = 2; d.nrow0 = nb * 256; }
    return d;
}
__device__ __forceinline__ void moe_weight_items(const float* wgate, const float* wup, const float* wdown, const float* gain, bf16_t* wgu_t, bf16_t* wd_t, LAS float* T, int bid, int nblk) {
    const int tid = threadIdx.x;
    f32x4 R[8];
    int it = bid;
    if (it >= NE * 48) return;
    MoeItem cur = moe_item(it, wgate, wup, wdown, gain, wgu_t, wd_t);
#pragma unroll
    for (int i = 0; i < 8; ++i) { const int idx = tid + i * NTHR; R[i] = *(const f32x4*)(cur.src + (size_t)(idx >> 6) * cur.pitch + (idx & 63) * 4); }
    for (;;) {
#pragma unroll
        for (int i = 0; i < 8; ++i) { const int idx = tid + i * NTHR, k = idx >> 6, c4 = idx & 63; f32x4 v = R[i]; if (cur.gain) v = v * cur.gain[k];
            LAS float* t = T + k * 257 + c4 * 4; t[0] = v[0]; t[1] = v[1]; t[2] = v[2]; t[3] = v[3]; }
        __syncthreads();
        const int nit = it + nblk; const bool more = nit < NE * 48;
        MoeItem nxt = cur;
        if (more) { nxt = moe_item(nit, wgate, wup, wdown, gain, wgu_t, wd_t);
#pragma unroll
            for (int i = 0; i < 8; ++i) { const int idx = tid + i * NTHR; R[i] = *(const f32x4*)(nxt.src + (size_t)(idx >> 6) * nxt.pitch + (idx & 63) * 4); } }
#pragma unroll
        for (int i = 0; i < 4; ++i) { const int idx = tid + i * NTHR, kc = idx & 7, n = idx >> 3;
            const LAS float* t = T + (8 * kc) * 257 + n;
            u32x4 o; o.x = pk2(t[0], t[257]); o.y = pk2(t[2 * 257], t[3 * 257]); o.z = pk2(t[4 * 257], t[5 * 257]); o.w = pk2(t[6 * 257], t[7 * 257]);
            const int row = cur.kind == 2 ? cur.nrow0 + n : (n >> 4) * 32 + cur.kind * 16 + (n & 15);
            *(u32x4*)(cur.dst + (size_t)row * cur.ldk + 8 * kc) = o; }
        __syncthreads();
        if (!more) break;
        cur = nxt; it = nit;
    }
}
__device__ __forceinline__ void p0_prologue(const MArgs& a, LAS unsigned char* lds, int bid, int nblk) {
    const int tid = threadIdx.x, lane = tid & 63, wave = __builtin_amdgcn_readfirstlane(tid >> 6);
    const int gw = bid * NWAVE + wave, ngw = nblk * NWAVE, gt = bid * NTHR + tid, ngt = nblk * NTHR;
    unsigned char* ws = a.ws;
    float2* cs = (float2*)(ws + WS_ROPE);
    for (int _r = 0; _r < (PROBE_PHASE == 301 ? 2 : 1); ++_r)
    for (int idx = gt; idx < LPOS * 32; idx += ngt) { const int pos = idx >> 5, i = idx & 31; const float inv = 1.0f / powf(10000.0f, (float)(2 * i) / 64.0f); float s, c; sincosf((float)pos * inv, &s, &c); cs[idx] = make_float2(c, s); }
    float* wrf = (float*)(ws + W2_WRF);
    for (int idx = gt; idx < 2 * 36 * 1024; idx += ngt) { const int l = idx / (36 * 1024), j = (idx >> 10) % 36, k = idx & 1023;
        const float g = a.in[3][l * D + k]; wrf[idx] = g * (j < 4 ? a.in[16][(size_t)l * D * 4 + k * 4 + j] : a.in[18][(size_t)l * D * 32 + k * 32 + (j - 4)]); }
    { u32x4* z = (u32x4*)(ws + W2_WIN + (size_t)416 * 1024 * 2); for (int idx = gt; idx < 96 * 1024 * 2 / 16; idx += ngt) z[idx] = (u32x4){0u, 0u, 0u, 0u}; }
    { bf16_t* kpe = (bf16_t*)(ws + WS_KPE); for (int idx = gt; idx < 2 * 48 * 32; idx += ngt) { const int b = idx / (48 * 32), r = idx % (48 * 32); kpe[((size_t)b * LP + 8208) * 32 + r] = 0; }
      bf16_t* vt0 = (bf16_t*)(ws + B_VT0); for (int idx = gt; idx < 2 * 2 * 64 * 48; idx += ngt) { const int rr = idx / 48, c = idx % 48; vt0[(size_t)rr * LP + 8208 + c] = 0; } }
    { bf16_t* hb = (bf16_t*)(ws + W2_HB); float* rstd = (float*)(ws + W2_RSTD);
      for (int _r = 0; _r < (PROBE_PHASE == 303 ? 2 : 1); ++_r)
      for (int row = gw; row < MTOT; row += ngw) {
        const float* src = row < MREAL ? a.in[0] + (size_t)row * D : a.in[1] + (size_t)row_pos(row) * D;
        float ss = 0.f;
#pragma unroll
        for (int j = 0; j < 4; ++j) { const f32x4 v = *(const f32x4*)(src + j * 256 + lane * 4); ss += v[0] * v[0] + v[1] * v[1] + v[2] * v[2] + v[3] * v[3];
            *(u32x2*)(hb + (size_t)row * D + j * 256 + lane * 4) = (u32x2){pk2(v[0], v[1]), pk2(v[2], v[3])}; }
        ss = wave_sum(ss); if (lane == 0) rstd[row] = rsqrtf(ss * (1.0f / D) + EPS);
      } }
    LAS float* scr = (LAS float*)(lds + wave * 16384);
    for (int _r = 0; _r < (PROBE_PHASE == 304 ? 2 : 1); ++_r)
    for (int it = gw; it < 2192; it += ngw) {
        int r = it;
        if (r < 640) { const int nb = r % 40;
            transpose_item(a.in[5], NQKV, a.in[2], (bf16_t*)(ws + W2_WQKV), 1024, nb < 32 ? 64 * (nb >> 1) + 16 * (nb & 1) : nb * 32, (r / 40) * 64, nb * 32, scr, lane, nb < 32 ? 16 : 0); continue; } r -= 640;
        if (r < 512) { transpose_item(a.in[8], D, nullptr, (bf16_t*)(ws + W2_WO0), 1024, (r & 31) * 32, (r >> 5) * 64, (r & 31) * 32, scr, lane); continue; } r -= 512;
        if (r < 208) { transpose_item(a.in[10], 416, a.in[2] + D, (bf16_t*)(ws + W2_WIN), 1024, (r % 13) * 32, (r / 13) * 64, (r % 13) * 32, scr, lane); continue; } r -= 208;
        if (r < 192) { transpose_item(a.in[13], 1536, a.in[11], (bf16_t*)(ws + W2_WUQ), 256, (r % 48) * 32, (r / 48) * 64, (r % 48) * 32, scr, lane); continue; } r -= 192;
        if (r < 128) { const int nb32 = r & 63, hh = nb32 >> 2, part = nb32 & 3;
            transpose_item(a.in[14], 2048, a.in[12], (bf16_t*)(ws + W2_WUKV), 128, part < 2 ? hh * 64 + part * 32 : 1024 + hh * 64 + (part - 2) * 32, (r >> 6) * 64, nb32 * 32, scr, lane); continue; } r -= 128;
        transpose_item(a.in[15], D, nullptr, (bf16_t*)(ws + W2_WO1), 1024, (r & 31) * 32, (r >> 5) * 64, (r & 31) * 32, scr, lane);
    }
    __syncthreads();
    moe_weight_items(a.in[20], a.in[21], a.in[22], a.in[3], (bf16_t*)(ws + C_W0), (bf16_t*)(ws + C_W0 + MOE_WGU_BYTES), (LAS float*)lds, bid, nblk);
}

template <bool NSW, bool HALFN, class MakeEpi>
__device__ __forceinline__ void gemm_phase(LAS unsigned char* lds, const bf16_t* A, int lda, const bf16_t* Bt, int K, int pn0, int pn1, int bid, int nblk, const MakeEpi& mk) {
    constexpr int BN = HALFN ? 128 : 256;
    const int ntn = pn1 - pn0;
    const bool grp = (nblk % 8) == 0;
    const int x = grp ? bid % 8 : 0, j = grp ? bid / 8 : bid, nslot = grp ? nblk / 8 : nblk, pmg = grp ? 8 : 64;
    for (int u = j; u < pmg * ntn; u += nslot) {
        const int pm = x * pmg + u / ntn, pn = pn0 + u % ntn;
        RowDense ra{A, lda, pm * 256, MTOT - 1}; auto e = mk(pm * 256, pn * BN);
        if (HALFN) gemm_tile<4, 4, 4, 2, NSW>(lds, ra, Bt + (size_t)pn * BN * K, K, K / 32, e);
        else gemm_tile<8, 4, 2, 4, NSW>(lds, ra, Bt + (size_t)pn * BN * K, K, K / 32, e);
    }
    const int nfull = (pmg * ntn + nslot - 1) / nslot;
    for (int pn = pn0; pn < pn1; ++pn) {
        const int owner = (pn - pn0) * 37 % nblk;
        if (bid == owner) { RowDense ra{A, lda, MREAL, MTOT - 1}; auto e = mk(MREAL, pn * BN);
            if (HALFN) gemm_tile<1, 4, 4, 2, NSW>(lds, ra, Bt + (size_t)pn * BN * K, K, K / 32, e);
            else gemm_tile<1, 4, 2, 4, NSW>(lds, ra, Bt + (size_t)pn * BN * K, K, K / 32, e); }
    }
    (void)nfull;
}

constexpr int PH_PROLOGUE = 0, PH_QKV = 1, PH_SWA = 2, PH_OPROJ0 = 3, PH_ROUTE0 = 4, PH_MOE0 = 5, PH_COMBINE = 6, PH_WIN = 7, PH_CEPI = 8, PH_UQKV = 9, PH_MLA = 10, PH_OPROJ1 = 11, PH_ROUTE1 = 12, PH_MOE1 = 13, PH_FINAL = 14, PH_N = 15;
__global__ void __launch_bounds__(NTHR, 2) mega(MArgs a) {
    extern __shared__ __attribute__((aligned(16))) unsigned char lds_raw[];
    LAS unsigned char* lds = (LAS unsigned char*)lds_raw;
    const int tid = threadIdx.x, bid = blockIdx.x, nblk = gridDim.x;
    volatile LAS unsigned* misc = (volatile LAS unsigned*)(lds + LDS_MISC);
    if (tid < 64) misc[tid] = 0u;
    __syncthreads();
    unsigned char* ws = a.ws;
    XcdBarrier bar = xcd_barrier_post((unsigned*)(ws + WS_BAR) + a.li * XCD_BAR_WORDS, misc);
    if (tid == 0) misc[4] = xb_add((unsigned*)(ws + 32 * 1024) + 64 * bar.x, 1u);
    const int lo = a.ph_lo, hi = a.ph_hi;
#define IN(k) (lo <= (k) && (k) < hi)
#define REP(k) for (int _rep = 0; _rep < ((k) == PROBE_PHASE ? 2 : 1); ++_rep, (void)((k) == PROBE_PHASE && _rep == 1 ? (xcd_barrier(bar), 0) : 0))
#define STAMP(i) do { if (PROBE_PHASE >= 600 && bid == 0 && tid == 0) ((unsigned long long*)(ws + 512 * 1024))[i] = __builtin_amdgcn_s_memrealtime(); } while (0)
#define SEAM(k) do { if (IN(k) && IN((k) + 1)) xcd_barrier(bar); STAMP((k) + 1); } while (0)
    STAMP(0);
    if (IN(PH_PROLOGUE)) REP(PH_PROLOGUE) p0_prologue(a, lds, bid, nblk);
    SEAM(PH_PROLOGUE);
    int vbid = bid;
    if (IN(PH_PROLOGUE) && IN(PH_QKV)) {
        if (tid == 0) { bool ok = (nblk % 8) == 0 && bar.x < 8;
            for (int j = 0; j < 8; ++j) ok = ok && xb_ld((unsigned*)(ws + 32 * 1024) + 64 * j) == (unsigned)(nblk / 8);
            misc[5] = ok ? misc[4] * 8u + bar.x : (unsigned)bid; }
        __syncthreads();
        vbid = __builtin_amdgcn_readfirstlane((int)misc[5]);
    }
#define bid vbid
    if (IN(PH_QKV)) REP(PH_QKV) {
        const float* rstd = (const float*)(ws + W2_RSTD); const float* bias = a.in[6]; const float2* cs = (const float2*)(ws + WS_ROPE); bf16_t* qkv = (bf16_t*)(ws + B_QKV); bf16_t* vt0 = (bf16_t*)(ws + B_VT0);
        const bf16_t* hbA = (const bf16_t*)(ws + W2_HB); const bf16_t* Wt = (const bf16_t*)(ws + W2_WQKV);
        const bool grp = (nblk % 8) == 0; const int x = grp ? bid % 8 : 0, j = grp ? bid / 8 : bid, nslot = grp ? nblk / 8 : nblk, pmg = grp ? 8 : 64;
        const bool usepg = nblk == 256;
        if (usepg) { pg8::Gemm g{hbA, Wt, MREAL, 1024, D}; pg8::StaticOrder S; S.init(MREAL, 1024, nblk, bid);
            PgEpiQ E{rstd, bias, cs, qkv};
            pg8::gemm_phase<PgEpiQ, pg8::StaticOrder, true, true>(lds, g, S, E); }
        for (int u = usepg ? pmg * 4 + j : j; u < pmg * 6; u += nslot) {
            if (u < pmg * 4) { const int pm = x * pmg + (u >> 2), pn = u & 3; RowDense ra{hbA, D, pm * 256, MTOT - 1}; EpiQKV e{rstd, bias, cs, qkv, pm * 256, pn * 256, true};
                gemm_tile<8, 4, 2, 4, false>(lds, ra, Wt + (size_t)pn * 256 * D, D, D / 32, e);
            } else if (u < pmg * 5) { const int pm = x * pmg + (u - pmg * 4); RowDense ra{hbA, D, pm * 256, MTOT - 1}; EpiQKV e{rstd, bias, cs, qkv, pm * 256, 1024, false};
                gemm_tile<4, 4, 4, 2, false>(lds, ra, Wt + (size_t)1024 * D, D, D / 32, e);
            } else { const int pm = x * pmg + (u - pmg * 5); RowDense ra{hbA, D, pm * 256, MTOT - 1}; EpiV0 e{rstd, bias, vt0, pm * 256, 1152};
                gemm_tile<4, 4, 4, 2, true>(lds, ra, Wt + (size_t)1152 * D, D, D / 32, e);
            }
        }
        const int mu = bid - (nblk - 6);
        if (mu >= 0 && mu < 4) { RowDense ra{hbA, D, MREAL, MTOT - 1}; EpiQKV e{rstd, bias, cs, qkv, MREAL, mu * 256, true};
            gemm_tile<1, 4, 2, 4, false>(lds, ra, Wt + (size_t)mu * 256 * D, D, D / 32, e);
        } else if (mu == 4) { RowDense ra{hbA, D, MREAL, MTOT - 1}; EpiQKV e{rstd, bias, cs, qkv, MREAL, 1024, false};
            gemm_tile<1, 4, 4, 2, false>(lds, ra, Wt + (size_t)1024 * D, D, D / 32, e);
        } else if (mu == 5) { RowDense ra{hbA, D, MREAL, MTOT - 1}; EpiV0 e{rstd, bias, vt0, MREAL, 1152};
            gemm_tile<1, 4, 4, 2, true>(lds, ra, Wt + (size_t)1152 * D, D, D / 32, e);
        }
    }
    SEAM(PH_QKV);
    if (IN(PH_SWA)) REP(PH_SWA) swa_phase(lds, (const bf16_t*)(ws + B_QKV), (const bf16_t*)(ws + B_VT0), a.in[7], (bf16_t*)(ws + B_O0), bid, nblk);
    SEAM(PH_SWA);
    if (IN(PH_OPROJ0)) REP(PH_OPROJ0) {
        const float* bias = a.in[9]; bf16_t* hb = (bf16_t*)(ws + W2_HB);
        if (nblk == 256) { pg8::Gemm g{(const bf16_t*)(ws + B_O0), (const bf16_t*)(ws + W2_WO0), MREAL, D, D}; pg8::StaticOrder S; S.init(MREAL, D, nblk, bid); PgEpiRes E{bias, hb};
            pg8::gemm_phase<PgEpiRes, pg8::StaticOrder, true, true>(lds, g, S, E);
            if ((bid & 15) == 5) { const int pc = bid >> 4; RowDense ra{(const bf16_t*)(ws + B_O0), D, MREAL, MTOT - 1}; EpiRes e{bias, hb, MREAL, pc * 64};
                gemm_tile<1, 1, 2, 4, false>(lds, ra, (const bf16_t*)(ws + W2_WO0) + (size_t)pc * 64 * D, D, D / 32, e); }
        } else
        gemm_phase<false, false>(lds, (const bf16_t*)(ws + B_O0), D, (const bf16_t*)(ws + W2_WO0), D, 0, 4, bid, nblk, [=](int m0, int n0) { return EpiRes{bias, hb, m0, n0}; });
    }
    SEAM(PH_OPROJ0);
    if (IN(PH_ROUTE0))
        route_phase(lds, (const bf16_t*)(ws + W2_HB), (const float*)(ws + W2_WRF), a.in[17], a.in[19], (float*)(ws + W2_RSTD), (int*)(ws + WS_CTL),
                    (int*)(ws + W2_LIST), (float*)(ws + W2_WSLOT), bid, nblk);
    SEAM(PH_ROUTE0);
    if (IN(PH_MOE0)) REP(PH_MOE0) moe_phase(lds, (int*)(ws + WS_CTL), (const int*)(ws + W2_LIST), (const bf16_t*)(ws + W2_HB), (const float*)(ws + W2_RSTD), (const float*)(ws + W2_WSLOT),
                               (const bf16_t*)(ws + C_W0), (const bf16_t*)(ws + C_W0 + MOE_WGU_BYTES), (bf16_t*)(ws + B_Y0), bid, nblk, (unsigned long long*)(ws + 512 * 1024));
    SEAM(PH_MOE0);
    if (IN(PH_COMBINE)) l1proj_phase(lds, (bf16_t*)(ws + W2_HB), (const bf16_t*)(ws + B_Y0), (const bf16_t*)(ws + W2_WIN), (const bf16_t*)(ws + W2_WUQ), (const bf16_t*)(ws + W2_WUKV),
                                     (const float2*)(ws + WS_ROPE), (bf16_t*)(ws + WS_KPE), (bf16_t*)(ws + C_Q1), (bf16_t*)(ws + C_K1), (bf16_t*)(ws + C_V1), bid, nblk);
    STAMP(PH_WIN); STAMP(PH_CEPI); STAMP(PH_UQKV);
    SEAM(PH_UQKV);
    if (IN(PH_MLA)) REP(100) {
        moe_weight_items(a.in[20] + (size_t)NE * D * DE, a.in[21] + (size_t)NE * D * DE, a.in[22] + (size_t)NE * DE * D, a.in[3] + D, (bf16_t*)(ws + B_W1), (bf16_t*)(ws + B_W1 + MOE_WGU_BYTES),
                         (LAS float*)lds, bid, nblk);
    }
    if (IN(PH_MLA)) REP(PH_MLA) mla_phase(lds, (const bf16_t*)(ws + C_Q1), (const bf16_t*)(ws + C_K1), (const bf16_t*)(ws + WS_KPE), (const bf16_t*)(ws + C_V1), (bf16_t*)(ws + B_O1), bid, nblk);
    SEAM(PH_MLA);
    if (IN(PH_OPROJ1)) REP(PH_OPROJ1) {
        bf16_t* hb = (bf16_t*)(ws + W2_HB);
        if (nblk == 256) { pg8::Gemm g{(const bf16_t*)(ws + B_O1), (const bf16_t*)(ws + W2_WO1), MREAL, D, D}; pg8::StaticOrder S; S.init(MREAL, D, nblk, bid); PgEpiRes E{nullptr, hb};
            pg8::gemm_phase<PgEpiRes, pg8::StaticOrder, true, true>(lds, g, S, E);
            if ((bid & 15) == 5) { const int pc = bid >> 4; RowDense ra{(const bf16_t*)(ws + B_O1), D, MREAL, MTOT - 1}; EpiRes e{nullptr, hb, MREAL, pc * 64};
                gemm_tile<1, 1, 2, 4, false>(lds, ra, (const bf16_t*)(ws + W2_WO1) + (size_t)pc * 64 * D, D, D / 32, e); }
        } else
        gemm_phase<false, false>(lds, (const bf16_t*)(ws + B_O1), D, (const bf16_t*)(ws + W2_WO1), D, 0, 4, bid, nblk, [=](int m0, int n0) { return EpiRes{nullptr, hb, m0, n0}; });
    }
    SEAM(PH_OPROJ1);
    if (IN(PH_ROUTE1))
        route_phase(lds, (const bf16_t*)(ws + W2_HB), (const float*)(ws + W2_WRF) + 36 * 1024, a.in[17] + 4, a.in[19] + 32, (float*)(ws + W2_RSTD), (int*)(ws + WS_CTL) + 2048,
                    (int*)(ws + W2_LIST), (float*)(ws + W2_WSLOT), bid, nblk);
    SEAM(PH_ROUTE1);
    if (IN(PH_MOE1)) REP(PH_MOE1) moe_phase(lds, (int*)(ws + WS_CTL) + 2048, (const int*)(ws + W2_LIST), (const bf16_t*)(ws + W2_HB), (const float*)(ws + W2_RSTD), (const float*)(ws + W2_WSLOT),
                               (const bf16_t*)(ws + B_W1), (const bf16_t*)(ws + B_W1 + MOE_WGU_BYTES), (bf16_t*)(ws + C_Y1), bid, nblk);
    SEAM(PH_MOE1);
    if (IN(PH_FINAL)) REP(PH_FINAL) final_phase((const bf16_t*)(ws + W2_HB), (const bf16_t*)(ws + C_Y1), a.in[4], a.out, bid, nblk);
#undef bid
#undef IN
#undef SEAM
}

static void run_mega(hipStream_t s, const MArgs& base, int lo, int hi, int grid) {
    MArgs a = base; a.ph_lo = lo; a.ph_hi = hi; a.li = lo;
    hipLaunchKernelGGL(mega, dim3(grid), dim3(NTHR), LDS_BYTES, s, a);
}
extern "C" void kernel_launch(void* const* d_in, const int* in_sizes, int n_in, void* d_out, int out_size, void* d_ws, size_t ws_size, hipStream_t stream) {
    static int grid = 0;
    if (grid == 0) {
        if (n_in != 23 || ws_size < WS_END) { fprintf(stderr, "kernel_launch: unexpected n_in %d or ws_size %zu\n", n_in, ws_size); grid = -1; return; }
        if (hipFuncSetAttribute((const void*)mega, hipFuncAttributeMaxDynamicSharedMemorySize, LDS_BYTES) != hipSuccess) { fprintf(stderr, "hipFuncSetAttribute failed\n"); grid = -1; return; }
        int dev = 0, cus = 0, per_cu = 0;
        (void)hipGetDevice(&dev); (void)hipDeviceGetAttribute(&cus, hipDeviceAttributeMultiprocessorCount, dev);
        (void)hipOccupancyMaxActiveBlocksPerMultiprocessor(&per_cu, (const void*)mega, NTHR, LDS_BYTES);
        (void)hipGetLastError();
        if (per_cu < 1 || cus < 8) { fprintf(stderr, "kernel_launch: occupancy query reports %d workgroups/CU on %d CUs for %d threads + %d B LDS; nothing launched\n", per_cu, cus, NTHR, LDS_BYTES); grid = -1; return; }
        grid = cus;
    }
    if (grid < 0) return;
    (void)in_sizes; (void)out_size;
    unsigned char* ws = (unsigned char*)d_ws;
    MArgs base{}; for (int i = 0; i < 23; ++i) base.in[i] = (const float*)d_in[i]; base.out = (float*)d_out; base.ws = ws;
    (void)hipMemsetAsync(ws + WS_CTL, 0, 1 * MiB, stream);
    run_mega(stream, base, 0, PH_N, grid);
}
```

```cpp
#include <hip/hip_runtime.h>
#ifndef PROBE_PHASE
#define PROBE_PHASE -1
#endif
#include <cstdio>
#include <cstdint>

typedef unsigned short bf16_t;

constexpr int D = 1024, SEQ = 8192, NB = 2, NMETA = 16;
constexpr int MREAL = NB * SEQ;
constexpr int MTOT = MREAL + NB * NMETA;
constexpr int LPOS = NMETA + SEQ;
constexpr int NQKV = 1280;
constexpr int NE = 32, DE = 256;
constexpr int CAP = MTOT * 2;
constexpr float EPS = 1e-6f;

__device__ __forceinline__ float bf2f(bf16_t v) { return __uint_as_float(((unsigned)v) << 16); }
__device__ __forceinline__ bf16_t f2bf(float f) { unsigned u = __float_as_uint(f); u += 0x7fffu + ((u >> 16) & 1u); return (bf16_t)(u >> 16); }
__device__ __forceinline__ int row_pos(int row) { return row < MREAL ? NMETA + (row & (SEQ - 1)) : ((row - MREAL) & (NMETA - 1)); }
__device__ __forceinline__ int row_batch(int row) { return row < MREAL ? (row >> 13) : ((row - MREAL) >> 4); }
constexpr int LP = 8256;
__device__ __forceinline__ int perm16(int p) { const int qd = (p >> 2) & 3; return (p & ~12) | ((((qd & 1) << 1) | (qd >> 1)) << 2); }
template <int CTRL> __device__ __forceinline__ float dpp_f(float v) { return __int_as_float(__builtin_amdgcn_update_dpp(0, __float_as_int(v), CTRL, 0xF, 0xF, true)); }
__device__ __forceinline__ float wave_sum(float v) {
    v += dpp_f<0xB1>(v);
    v += dpp_f<0x4E>(v);
    v += dpp_f<0x141>(v);
    v += dpp_f<0x140>(v);
    { auto rr = __builtin_amdgcn_permlane16_swap(__float_as_uint(v), __float_as_uint(v), false, false); v = __uint_as_float(rr[0]) + __uint_as_float(rr[1]); }
    { auto rr = __builtin_amdgcn_permlane32_swap(__float_as_uint(v), __float_as_uint(v), false, false); v = __uint_as_float(rr[0]) + __uint_as_float(rr[1]); }
    return v;
}
__device__ __forceinline__ float xsum16(float v) { auto rr = __builtin_amdgcn_permlane16_swap(__float_as_uint(v), __float_as_uint(v), false, false); return __uint_as_float(rr[0]) + __uint_as_float(rr[1]); }
__device__ __forceinline__ float xsum32(float v) { auto rr = __builtin_amdgcn_permlane32_swap(__float_as_uint(v), __float_as_uint(v), false, false); return __uint_as_float(rr[0]) + __uint_as_float(rr[1]); }
__device__ __forceinline__ float xmax32(float v) { auto rr = __builtin_amdgcn_permlane32_swap(__float_as_uint(v), __float_as_uint(v), false, false); return fmaxf(__uint_as_float(rr[0]), __uint_as_float(rr[1])); }

constexpr size_t MiB = 1u << 20;
constexpr size_t WS_CTL = 0;
constexpr size_t WS_ROPE = 1 * MiB;
constexpr size_t WS_END = 256 * MiB;

#define LAS __attribute__((address_space(3)))
#define GAS __attribute__((address_space(1)))
typedef short bf16x8 __attribute__((ext_vector_type(8)));
typedef float f32x4 __attribute__((ext_vector_type(4)));
typedef unsigned u32x4 __attribute__((ext_vector_type(4)));
typedef unsigned u32x2 __attribute__((ext_vector_type(2)));
constexpr int NTHR = 512, NWAVE = 8;
constexpr int LDS_MISC = 162816;
constexpr int LDS_BYTES = LDS_MISC + 1024;

constexpr size_t WS_BAR = 64 * 1024;
constexpr size_t WS_KPE = 3 * MiB + 256 * 1024;
constexpr size_t W2_RSTD = 4 * MiB + 512 * 1024, W2_WSLOT = W2_RSTD + 80 * 1024, W2_EID = W2_WSLOT + 144 * 1024;
constexpr size_t W2_LIST = 5 * MiB;
constexpr size_t W2_WRF = 9 * MiB + 256 * 1024;
constexpr size_t W2_WQKV = 10 * MiB;
constexpr size_t W2_WO0 = W2_WQKV + 2560 * 1024;
constexpr size_t W2_WIN = W2_WO0 + 2048 * 1024;
constexpr size_t W2_WUQ = W2_WIN + 1024 * 1024;
constexpr size_t W2_WUKV = W2_WUQ + 768 * 1024;
constexpr size_t W2_WO1 = W2_WUKV + 512 * 1024;
constexpr size_t W2_HB = 20 * MiB;
constexpr size_t W2_RB = 53 * MiB;
constexpr size_t W2_RC = 134 * MiB;
static_assert(W2_EID + (size_t)MTOT * 8 <= W2_LIST && W2_LIST + (size_t)NE * CAP * 4 <= W2_WRF && W2_WO1 + 2 * MiB <= W2_HB && W2_HB + (size_t)MTOT * 2048 <= W2_RB, "fixed map");
constexpr size_t B_QKV = W2_RB, B_O0 = W2_RB + 41 * MiB, B_VT0 = W2_RB + 74 * MiB  , B_Y0 = W2_RB, B_CBUF = W2_RB, B_CQN = W2_RB + 33 * MiB, B_CKVN = W2_RB + 42 * MiB, B_O1 = W2_RB, B_W1 = W2_RB + 33 * MiB;
constexpr size_t C_W0 = W2_RC, C_HF = W2_RC + 48 * MiB, C_Q1 = W2_RC, C_K1 = W2_RC + 49 * MiB, C_V1 = W2_RC + 82 * MiB, C_HF1 = W2_RC, C_Y1 = W2_RC;
static_assert(C_V1 + (size_t)2 * 16 * 64 * LP * 2 <= WS_END && C_K1 + (size_t)2 * LP * 2048 <= C_V1 && B_VT0 + (size_t)2 * 2 * 64 * LP * 2 <= W2_RC && C_HF + (size_t)MTOT * 4096 <= WS_END && B_W1 + 48 * MiB <= W2_RC, "region map");
constexpr size_t MOE_WGU_BYTES = (size_t)NE * 512 * 1024 * 2, MOE_WD_BYTES = (size_t)NE * 1024 * 256 * 2;

struct MArgs { const float* in[23]; float* out; unsigned char* ws; int ph_lo, ph_hi, li, pad; };

__device__ __forceinline__ unsigned cvtpk(float lo, float hi) { typedef float f2 __attribute__((ext_vector_type(2))); typedef __bf16 b2 __attribute__((ext_vector_type(2)));
    f2 v = {lo, hi}; b2 r = __builtin_convertvector(v, b2); return __builtin_bit_cast(unsigned, r); }
__device__ __forceinline__ unsigned pk2(float lo, float hi) { return cvtpk(lo, hi); }
__device__ __forceinline__ int otid() { int t = threadIdx.x; asm volatile("" : "+v"(t)); return t & (512 - 1); }

#define XB_TMO      128
#define XB_XCNT(j)  (256  + 64 * (j))
#define XB_XSUB(j)  (1280 + 64 * (j))
#define XB_XGEN(j)  (2304 + 64 * (j))
#define XB_TOP      3328
#define XB_TOPGEN   3392
#define XCD_BAR_WORDS 3456
#define XB_SPIN_CAP (1u << 18)
__device__ __forceinline__ unsigned xb_ld(unsigned* p)              { return __hip_atomic_load(p, __ATOMIC_RELAXED, __HIP_MEMORY_SCOPE_AGENT); }
__device__ __forceinline__ unsigned xb_add(unsigned* p, unsigned v) { return __hip_atomic_fetch_add(p, v, __ATOMIC_RELAXED, __HIP_MEMORY_SCOPE_AGENT); }
__device__ __forceinline__ unsigned xb_xcc_id() { return (unsigned)__builtin_amdgcn_s_getreg((3 << 11) | 20) & 0xFu; }
#define XB_SPIN(cond, bar) do { unsigned _sp = 0; while (cond) { __builtin_amdgcn_s_sleep(1); \
    if ((++_sp & 255u) == 0u) { if (xb_ld(&(bar)[XB_TMO])) break; if (_sp > XB_SPIN_CAP) { atomicAdd(&(bar)[XB_TMO], 1u); break; } } } } while (0)
struct XcdBarrier { unsigned* bar; unsigned x; volatile LAS unsigned* st; };
__device__ __forceinline__ XcdBarrier xcd_barrier_post(unsigned* bar, volatile LAS unsigned* st) {
    XcdBarrier b; b.bar = bar; b.x = xb_xcc_id(); b.st = st;
    if (threadIdx.x == 0) (void)xb_add(&bar[XB_XCNT(b.x)], 1u);
    return b;
}
__device__ __forceinline__ void xcd_barrier_complete(unsigned* bar, unsigned x, unsigned& nloc, unsigned& nx) {
    const unsigned G = gridDim.x * gridDim.y * gridDim.z;
    unsigned sum, cnt, mine, sp = 0u;
    for (;;) {
        sum = 0u; cnt = 0u; mine = 0u;
#pragma unroll
        for (unsigned j = 0; j < 16; ++j) { const unsigned c = xb_ld(&bar[XB_XCNT(j)]); sum += c; cnt += (c > 0u) ? 1u : 0u; mine = (j == x) ? c : mine; }
        if (sum == G) break;
        __builtin_amdgcn_s_sleep(1);
        if ((++sp & 255u) == 0u) { if (xb_ld(&bar[XB_TMO])) break; if (sp > XB_SPIN_CAP) { atomicAdd(&bar[XB_TMO], 1u); break; } }
    }
    nloc = mine > 0u ? mine : 1u; nx = cnt > 0u ? cnt : 1u;
}
__device__ __forceinline__ void xcd_barrier(const XcdBarrier& b) {
    asm volatile("s_waitcnt vmcnt(0)" ::: "memory");
    __syncthreads();
    if (threadIdx.x == 0) {
        unsigned* bar = b.bar;
        __builtin_amdgcn_s_waitcnt(0);
        unsigned nloc = b.st[0], nx = b.st[1];
        if (nloc == 0u) { xcd_barrier_complete(bar, b.x, nloc, nx); b.st[0] = nloc; b.st[1] = nx; }
        const unsigned old = xb_add(&bar[XB_XSUB(b.x)], 1u);
        const unsigned gen = old / nloc;
        if (old + 1u == (gen + 1u) * nloc) {
            __builtin_amdgcn_fence(__ATOMIC_RELEASE, "agent");
            asm volatile("s_waitcnt vmcnt(0)" ::: "memory");
            const unsigned og = xb_add(&bar[XB_TOP], 1u);
            const unsigned tg = og / nx;
            if (og + 1u == (tg + 1u) * nx) xb_add(&bar[XB_TOPGEN], 1u);
            else XB_SPIN(xb_ld(&bar[XB_TOPGEN]) == tg, bar);
            __builtin_amdgcn_fence(__ATOMIC_ACQUIRE, "agent");
            xb_add(&bar[XB_XGEN(b.x)], 1u);
            asm volatile("s_waitcnt vmcnt(0)" ::: "memory");
        } else {
            XB_SPIN(xb_ld(&bar[XB_XGEN(b.x)]) == gen, bar);
            __builtin_amdgcn_fence(__ATOMIC_ACQUIRE, "agent");
            asm volatile("s_waitcnt vmcnt(0)" ::: "memory");
        }
    }
    __syncthreads();
}

template <int N> __device__ __forceinline__ void wait_vm() { asm volatile("s_waitcnt vmcnt(%0)" :: "n"(N) : "memory"); }
__device__ __forceinline__ int swzF(int g) { return (0x78 >> (2 * g)) & 3; }
constexpr int GT_NS = 4;
template <int MT, int NT, int WM, int WN, bool NSW, class RowA, class Epi, bool NOLD = false>
__device__ __forceinline__ void gemm_tile(LAS unsigned char* lds, const RowA& rowA, const bf16_t* __restrict__ Bt, int ldb  , int nk  , Epi& epi) {
    constexpr int BM = WM * MT * 16, BN = WN * NT * 16, GA = BM / 16, G = (BM + BN) / 16, NG = (G + 7) / 8, GR = G % 8, STAGE = (BM + BN) * 64;
    static_assert(WM * WN == 8 && GT_NS * STAGE <= LDS_MISC && BM % 16 == 0 && BN % 16 == 0, "gemm_tile config");
    const int tid = otid(), lane = tid & 63, wave = __builtin_amdgcn_readfirstlane(tid >> 6), wm = wave / WN, wn = wave % WN;
    const char* src[NG];
    const int lc = (lane & 3) ^ swzF(lane >> 4);
#pragma unroll
    for (int i = 0; i < NG; ++i) {
        const int g = wave + 8 * i;
        if (g < GA) src[i] = (const char*)rowA(g * 16 + (lane >> 2)) + lc * 16;
        else if (g < G) src[i] = (const char*)(Bt + (size_t)((g - GA) * 16 + (lane >> 2)) * ldb) + lc * 16;
        else src[i] = nullptr;
    }
    f32x4 acc[MT][NT];
#pragma unroll
    for (int mi = 0; mi < MT; ++mi)
#pragma unroll
        for (int ni = 0; ni < NT; ++ni) acc[mi][ni] = (f32x4){0.f, 0.f, 0.f, 0.f};
    const int fro = (lane & 15) * 64 + (((lane >> 4) ^ swzF((lane >> 2) & 3)) << 4);
    constexpr int LM = PROBE_PHASE == 402 ? 2 : 1;
#define GT_STAGE(st, kt) do { _Pragma("unroll") for (int _i = 0; _i < NG; ++_i) { const int _g = wave + 8 * _i; if (_g < G) { \
        __builtin_amdgcn_global_load_lds((const unsigned*)(src[_i] + (size_t)(kt) * 64), (LAS unsigned*)(lds + (st) * STAGE + _g * 1024), 16, 0, 0); \
        if (LM == 2) __builtin_amdgcn_global_load_lds((const unsigned*)(src[_i] + (size_t)(kt) * 64), (LAS unsigned*)(lds + (st) * STAGE + _g * 1024), 16, 0, 0); } } } while (0)
#define GT_WAIT(ntl) do { if (GR == 0 || wave < GR) wait_vm<LM * NG * (ntl)>(); else wait_vm<LM * (NG - 1) * (ntl)>(); } while (0)
    if (!NOLD) { GT_STAGE(0, 0);
    if (nk > 1) GT_STAGE(1, 1);
    if (nk > 2) GT_STAGE(2, 2); }
    int st = 0;
    for (int kt = 0; kt < nk; ++kt) {
        const int rem = nk - 1 - kt;
        if (!NOLD) { if (rem >= 2) GT_WAIT(2); else if (rem == 1) GT_WAIT(1); else GT_WAIT(0); }
        __builtin_amdgcn_s_barrier(); asm volatile("" ::: "memory");
        const bool doload = (!NOLD || PROBE_PHASE == 505) && kt + 3 < nk;
        LAS const unsigned char* sa = lds + st * STAGE + (wm * MT * 16) * 64 + fro;
        LAS const unsigned char* sb = lds + st * STAGE + (BM + wn * NT * 16) * 64 + fro;
        bf16x8 bfr[NT];
#pragma unroll
        for (int ni = 0; ni < NT; ++ni) bfr[ni] = *(LAS const bf16x8*)(sb + ni * 1024);
        constexpr int PG = MT >= 2 ? 2 : 1, NPG = MT / PG;
        constexpr int LPG = (NG + NPG - 1) / NPG;
        bf16x8 afc[PG], afn[PG];
#pragma unroll
        for (int i = 0; i < PG; ++i) afc[i] = *(LAS const bf16x8*)(sa + i * 1024);
#pragma unroll
        for (int pg = 0; pg < NPG; ++pg) {
            if (doload) {
#pragma unroll
                for (int l = 0; l < LPG; ++l) { const int _i = pg * LPG + l; if (_i < NG) { const int _g = wave + 8 * _i; if (_g < G)
                    __builtin_amdgcn_global_load_lds((const unsigned*)(src[_i] + (size_t)(kt + 3) * 64), (LAS unsigned*)(lds + ((st + 3) & 3) * STAGE + _g * 1024), 16, 0, 0); } }
            }
            if (pg + 1 < NPG) {
#pragma unroll
                for (int i = 0; i < PG; ++i) afn[i] = *(LAS const bf16x8*)(sa + ((pg + 1) * PG + i) * 1024);
            }
#pragma unroll
            for (int i = 0; i < PG; ++i) { const int mi = pg * PG + i;
#pragma unroll
                for (int ni = 0; ni < NT; ++ni) {
                    if (NSW) acc[mi][ni] = __builtin_amdgcn_mfma_f32_16x16x32_bf16(afc[i], bfr[ni], acc[mi][ni], 0, 0, 0);
                    else acc[mi][ni] = __builtin_amdgcn_mfma_f32_16x16x32_bf16(bfr[ni], afc[i], acc[mi][ni], 0, 0, 0);
                } }
#pragma unroll
            for (int i = 0; i < PG; ++i) afc[i] = afn[i];
            __builtin_amdgcn_sched_barrier(0);
        }
        st = (st + 1) & 3;
    }
#undef GT_STAGE
#undef GT_WAIT
    epi(acc, wm * MT * 16, wn * NT * 16, lane);
    asm volatile("s_waitcnt lgkmcnt(0)" ::: "memory");
    __syncthreads();
}

struct RowDense { const bf16_t* A; int lda, m0, mlast; __device__ __forceinline__ const bf16_t* operator()(int r) const { int row = m0 + r; row = row > mlast ? mlast : row; return A + (size_t)row * lda; } };

namespace pg8 {
#define PG8_LAS __attribute__((address_space(3)))
typedef unsigned short bf16_t;
typedef short bf16x8 __attribute__((ext_vector_type(8)));
typedef float f32x4 __attribute__((ext_vector_type(4)));
typedef unsigned u32x4 __attribute__((ext_vector_type(4)));
constexpr int BM = 256, BK = 64, HALF = 128, HTB = HALF * BK * 2  , STAGE_BYTES = 8 * HTB, NXCD = 8, WGM = 8;

__host__ __device__ __forceinline__ int lds_byte(int r, int c) { const int st = (r >> 4) * 2 + (c >> 5), rr = r & 15, cc = c & 31, ob = rr * 64 + cc * 2; return st * 1024 + (ob ^ (((ob >> 9) & 1) << 5)); }
__host__ __device__ __forceinline__ void stage_rc(int b, int& R, int& C) { const int st = b / 1024, sb = b % 1024, swz = sb ^ (((sb >> 9) & 1) << 5); R = (st >> 1) * 16 + swz / 64; C = (st & 1) * 32 + (swz % 64) / 2; }
__host__ __device__ __forceinline__ int perm32(int rho) { const int n = rho >> 4, i = rho & 15; return 8 * (i >> 2) + 4 * n + (i & 3); }

struct Unit { int pm, pn; };
struct Gemm { const bf16_t* A; const bf16_t* Bt; int M, N, K; };

struct StaticOrder {
    int nM, nN, nwg, G, c;
    __host__ __device__ void init(int M, int N, int G_, int c_) { nM = M / BM; nN = N / BM; nwg = nM * nN; G = G_; c = c_; }
    __host__ __device__ bool next(int i, Unit& u) const {
        const long L = (long)i * G + c; if (L >= nwg) return false;
        int wgid = (int)L; { const int q = nwg / NXCD, r = nwg % NXCD, xcd = wgid % NXCD, off = wgid / NXCD; wgid = (xcd < r ? xcd * (q + 1) : r * (q + 1) + (xcd - r) * q) + off; }
        const int nig = WGM * nN, gid = wgid / nig, fm = gid * WGM, gsz = (nM - fm) < WGM ? (nM - fm) : WGM;
        u.pm = fm + ((wgid % nig) % gsz); u.pn = (wgid % nig) / gsz; return true;
    }
    __device__ __forceinline__ void a_ready(const Unit&) const {}
    __device__ __forceinline__ void done(const Unit&) const {}
};


template <class Epi, class Sched, bool ALIGN_EPI = false, bool SP2 = false>
__device__ __forceinline__ void gemm_phase(PG8_LAS unsigned char* lds, const Gemm g, const Sched& S, const Epi& E) {
    const int tid = otid(), wid = __builtin_amdgcn_readfirstlane(tid >> 6), lane = tid & 63, wr = wid >> 2, wc = wid & 3, fr = lane & 15, fq = lane >> 4;
    const int K = g.K, nt = K / BK;
    unsigned voffA[2], voffB[2];
#pragma unroll
    for (int i = 0; i < 2; ++i) { int R, C; stage_rc(tid * 16 + i * 8192, R, C); const int Rb = Epi::PERM ? ((R & ~31) + perm32(R & 31)) : R;
        voffA[i] = (unsigned)(R * K + C) * 2u; voffB[i] = (unsigned)(Rb * K + C) * 2u; }
    const size_t kstep = (size_t)(BK * 2);
    const size_t hstep = (size_t)HALF * K * 2;
    const size_t tstep = 2 * hstep;
    const unsigned ldsw = (unsigned)wid * 1024u;
    const int aoff = lds_byte(wr * 64 + fr, fq * 8), boff = lds_byte(wc * 32 + fr, fq * 8);
#define PG8_SA(b, h) (((b) * 2 + (h)) * HTB)
#define PG8_SB(b, h) ((4 + (b) * 2 + (h)) * HTB)
#define PG8_STAGE(bufoff, gbase, voff) do { _Pragma("unroll") for (int _i = 0; _i < 2; ++_i) \
        __builtin_amdgcn_global_load_lds((const unsigned*)((const char*)(gbase) + (voff)[_i]), (PG8_LAS unsigned*)(lds + (bufoff) + ldsw + _i * 8192), 16, 0, 0); } while (0)
#define PG8_LDA(dst, b, h) do { _Pragma("unroll") for (int m = 0; m < 4; ++m) _Pragma("unroll") for (int k = 0; k < 2; ++k) dst[m][k] = *(const PG8_LAS bf16x8*)(lds + PG8_SA(b, h) + aoff + m * 2048 + k * 1024); } while (0)
#define PG8_LDB(dst, b, h) do { _Pragma("unroll") for (int n = 0; n < 2; ++n) _Pragma("unroll") for (int k = 0; k < 2; ++k) dst[n][k] = *(const PG8_LAS bf16x8*)(lds + PG8_SB(b, h) + boff + n * 2048 + k * 1024); } while (0)
#define PG8_MMA(ai, bj, At, Bt) do { __builtin_amdgcn_s_setprio(1); _Pragma("unroll") for (int m = 0; m < 4; ++m) _Pragma("unroll") for (int n = 0; n < 2; ++n) _Pragma("unroll") for (int k = 0; k < 2; ++k) \
        acc[ai][bj][m][n] = __builtin_amdgcn_mfma_f32_16x16x32_bf16(Bt[n][k], At[m][k], acc[ai][bj][m][n], 0, 0, 0); __builtin_amdgcn_s_setprio(0); } while (0)
#define PG8_WAIT_V(n) asm volatile("s_waitcnt vmcnt(" #n ")" ::: "memory")
#define PG8_WAIT_L(n) asm volatile("s_waitcnt lgkmcnt(" #n ")" ::: "memory")
#define PG8_BAR __builtin_amdgcn_s_barrier()
#define PG8_SCHED __builtin_amdgcn_sched_barrier(0)
    Unit cur, nxt; int ui = 0;
    if (!S.next(0, cur)) return;
    f32x4 acc[2][2][4][2];
#pragma unroll
    for (int a = 0; a < 2; ++a)
#pragma unroll
        for (int b = 0; b < 2; ++b)
#pragma unroll
            for (int m = 0; m < 4; ++m)
#pragma unroll
                for (int n = 0; n < 2; ++n) acc[a][b][m][n] = (f32x4){0.f, 0.f, 0.f, 0.f};
    bf16x8 At[4][2], B0[2][2], B1[2][2];
    const char* cA = (const char*)g.A + (size_t)cur.pm * tstep; const char* cB = (const char*)g.Bt + (size_t)cur.pn * tstep;
    S.a_ready(cur);
    if constexpr (SP2) {
        PG8_STAGE(PG8_SB(0, 0), cB, voffB); PG8_STAGE(PG8_SB(0, 1), cB + hstep, voffB); PG8_STAGE(PG8_SA(0, 0), cA, voffA); PG8_STAGE(PG8_SA(0, 1), cA + hstep, voffA);
        if (wr == 1) PG8_BAR;
        PG8_WAIT_V(2); PG8_BAR;
        PG8_STAGE(PG8_SB(1, 0), cB + kstep, voffB); PG8_STAGE(PG8_SA(1, 0), cA + kstep, voffA); PG8_STAGE(PG8_SB(1, 1), cB + hstep + kstep, voffB);
        PG8_WAIT_V(6); PG8_BAR;
    } else {
        PG8_STAGE(PG8_SB(0, 0), cB, voffB); PG8_STAGE(PG8_SA(0, 0), cA, voffA); PG8_STAGE(PG8_SB(0, 1), cB + hstep, voffB); PG8_STAGE(PG8_SA(0, 1), cA + hstep, voffA);
        if (wr == 1) PG8_BAR;
        PG8_WAIT_V(4); PG8_BAR;
        PG8_STAGE(PG8_SB(1, 0), cB + kstep, voffB); PG8_STAGE(PG8_SA(1, 0), cA + kstep, voffA); PG8_STAGE(PG8_SB(1, 1), cB + hstep + kstep, voffB);
        PG8_WAIT_V(6); PG8_BAR;
    }
    for (;;) {
        const bool has_next = S.next(ui + 1, nxt);
        const char* nA = has_next ? (const char*)g.A + (size_t)nxt.pm * tstep : cA; const char* nB = has_next ? (const char*)g.Bt + (size_t)nxt.pn * tstep : cB;
        for (int t = 0; t < nt; t += 2) {
            const bool last = (t == nt - 2);
            const char* a1 = cA + (size_t)(t + 1) * kstep;
            const char* a2 = last ? nA : cA + (size_t)(t + 2) * kstep; const char* b2 = last ? nB : cB + (size_t)(t + 2) * kstep;
            const char* a3 = a2 + kstep; const char* b3 = b2 + kstep;
            if (last && has_next) S.a_ready(nxt);
            if constexpr (SP2) {
            PG8_LDB(B0, 0, 0); PG8_LDB(B1, 0, 1); PG8_SCHED; PG8_LDA(At, 0, 0); PG8_STAGE(PG8_SA(1, 1), a1 + hstep, voffA);
            PG8_WAIT_V(8); PG8_WAIT_L(0); PG8_BAR; PG8_MMA(0, 0, At, B0); PG8_MMA(0, 1, At, B1); PG8_BAR; PG8_SCHED;
            PG8_LDA(At, 0, 1); PG8_STAGE(PG8_SB(0, 0), b2, voffB); PG8_STAGE(PG8_SB(0, 1), b2 + hstep, voffB); PG8_STAGE(PG8_SA(0, 0), a2, voffA);
            PG8_WAIT_V(8); PG8_WAIT_L(0); PG8_BAR; PG8_MMA(1, 0, At, B0); PG8_MMA(1, 1, At, B1); PG8_BAR; PG8_SCHED;
            PG8_LDB(B0, 1, 0); PG8_LDB(B1, 1, 1); PG8_SCHED; PG8_LDA(At, 1, 0); PG8_STAGE(PG8_SA(0, 1), a2 + hstep, voffA);
            PG8_WAIT_V(8); PG8_WAIT_L(0); PG8_BAR; PG8_MMA(0, 0, At, B0); PG8_MMA(0, 1, At, B1); PG8_BAR; PG8_SCHED;
            PG8_LDA(At, 1, 1); PG8_STAGE(PG8_SB(1, 0), b3, voffB); PG8_STAGE(PG8_SB(1, 1), b3 + hstep, voffB); PG8_STAGE(PG8_SA(1, 0), a3, voffA);
            PG8_WAIT_V(8); PG8_WAIT_L(0); PG8_BAR; PG8_MMA(1, 0, At, B0); PG8_MMA(1, 1, At, B1); PG8_BAR; PG8_SCHED;
            } else {
            PG8_LDB(B0, 0, 0); PG8_SCHED; PG8_LDA(At, 0, 0); PG8_STAGE(PG8_SA(1, 1), a1 + hstep, voffA);
            PG8_WAIT_L(8); PG8_BAR; PG8_WAIT_L(0); PG8_MMA(0, 0, At, B0); PG8_BAR; PG8_SCHED;
            PG8_LDB(B1, 0, 1); PG8_STAGE(PG8_SB(0, 0), b2, voffB);
            PG8_BAR; PG8_WAIT_L(0); PG8_MMA(0, 1, At, B1); PG8_BAR;
            PG8_LDA(At, 0, 1); PG8_STAGE(PG8_SA(0, 0), a2, voffA);
            PG8_BAR; PG8_WAIT_L(0); PG8_MMA(1, 0, At, B0); PG8_BAR; PG8_SCHED;
            PG8_STAGE(PG8_SB(0, 1), b2 + hstep, voffB);
            PG8_WAIT_V(6); PG8_BAR; PG8_MMA(1, 1, At, B1); PG8_BAR;
            PG8_LDB(B0, 1, 0); PG8_SCHED; PG8_LDA(At, 1, 0); PG8_STAGE(PG8_SA(0, 1), a2 + hstep, voffA);
            PG8_WAIT_L(8); PG8_BAR; PG8_WAIT_L(0); PG8_MMA(0, 0, At, B0); PG8_BAR; PG8_SCHED;
            PG8_LDB(B1, 1, 1); PG8_STAGE(PG8_SB(1, 0), b3, voffB);
            PG8_BAR; PG8_WAIT_L(0); PG8_MMA(0, 1, At, B1); PG8_BAR;
            PG8_LDA(At, 1, 1); PG8_STAGE(PG8_SA(1, 0), a3, voffA);
            PG8_BAR; PG8_WAIT_L(0); PG8_MMA(1, 0, At, B0); PG8_BAR; PG8_SCHED;
            PG8_STAGE(PG8_SB(1, 1), b3 + hstep, voffB);
            PG8_WAIT_V(6); PG8_BAR; PG8_MMA(1, 1, At, B1); PG8_BAR;
            }
        }
        if constexpr (ALIGN_EPI) { if (wr == 0) PG8_BAR; }
        if constexpr (!Epi::AFTER_DRAIN) { E(acc, cur, wr, wc, fr, fq); S.done(cur); }
        if (!has_next) break;
#pragma unroll
        for (int a = 0; a < 2; ++a)
#pragma unroll
            for (int b = 0; b < 2; ++b)
#pragma unroll
                for (int m = 0; m < 4; ++m)
#pragma unroll
                    for (int n = 0; n < 2; ++n) acc[a][b][m][n] = (f32x4){0.f, 0.f, 0.f, 0.f};
        cur = nxt; cA = nA; cB = nB; ++ui;
        if constexpr (ALIGN_EPI) { if (wr == 1) PG8_BAR; }
    }
    PG8_WAIT_V(0);
    if constexpr (!ALIGN_EPI) { if (wr == 0) PG8_BAR; }
    PG8_BAR;
    if constexpr (Epi::AFTER_DRAIN) { E.fused(acc, cur, wr, wc, fr, fq, lds, wid, lane); S.done(cur); }
#undef PG8_SA
#undef PG8_SB
#undef PG8_STAGE
#undef PG8_LDA
#undef PG8_LDB
#undef PG8_MMA
#undef PG8_WAIT_V
#undef PG8_WAIT_L
#undef PG8_BAR
#undef PG8_SCHED
}
}

struct PgEpiRes {
    static constexpr bool PERM = false, AFTER_DRAIN = false;
    const float* bias; unsigned short* hb;
    __device__ __forceinline__ void operator()(const pg8::f32x4 (&acc)[2][2][4][2], const pg8::Unit& u, int wr, int wc, int fr, int fq) const {
        u32x2 hres[2][4][2][2];
#pragma unroll
        for (int ai = 0; ai < 2; ++ai)
#pragma unroll
            for (int m = 0; m < 4; ++m) { const int row = u.pm * 256 + ai * 128 + wr * 64 + m * 16 + fr;
#pragma unroll
                for (int bj = 0; bj < 2; ++bj)
#pragma unroll
                    for (int n = 0; n < 2; ++n) { const int col = u.pn * 256 + bj * 128 + wc * 32 + n * 16 + fq * 4; hres[ai][m][bj][n] = *(const u32x2*)(hb + (size_t)row * D + col); } }
#pragma unroll
        for (int ai = 0; ai < 2; ++ai)
#pragma unroll
            for (int m = 0; m < 4; ++m) { const int row = u.pm * 256 + ai * 128 + wr * 64 + m * 16 + fr;
#pragma unroll
                for (int bj = 0; bj < 2; ++bj)
#pragma unroll
                    for (int n = 0; n < 2; ++n) { const int col = u.pn * 256 + bj * 128 + wc * 32 + n * 16 + fq * 4;
                        u32x2* p = (u32x2*)(hb + (size_t)row * D + col); const u32x2 h = hres[ai][m][bj][n]; pg8::f32x4 v = acc[ai][bj][m][n];
                        if (bias) v += *(const pg8::f32x4*)(bias + col);
                        v[0] += __uint_as_float(h.x << 16); v[1] += __uint_as_float(h.x & 0xffff0000u); v[2] += __uint_as_float(h.y << 16); v[3] += __uint_as_float(h.y & 0xffff0000u);
                        *p = (u32x2){pk2(v[0], v[1]), pk2(v[2], v[3])}; } }
    }
};
struct PgEpiQ {
    static constexpr bool PERM = false, AFTER_DRAIN = false;
    const float* rstd; const float* bias; const float2* cs; unsigned short* qkv;
    __device__ __forceinline__ void operator()(const pg8::f32x4 (&acc)[2][2][4][2], const pg8::Unit& u, int wr, int wc, int fr, int fq) const {
        const int d = 16 * (wc & 1) + 4 * fq;
        float rsv[2][4]; float2 tv[2][4][4]; pg8::f32x4 b1v[2], b2v[2];
#pragma unroll
        for (int ai = 0; ai < 2; ++ai)
#pragma unroll
            for (int m = 0; m < 4; ++m) { const int row = u.pm * 256 + ai * 128 + wr * 64 + m * 16 + fr; rsv[ai][m] = rstd[row]; const int pos = row_pos(row);
#pragma unroll
                for (int r = 0; r < 4; ++r) tv[ai][m][r] = cs[pos * 32 + d + r]; }
#pragma unroll
        for (int bj = 0; bj < 2; ++bj) { const int g = 8 * u.pn + 4 * bj + wc, hh = g >> 1; b1v[bj] = *(const pg8::f32x4*)(bias + 64 * hh + d); b2v[bj] = *(const pg8::f32x4*)(bias + 64 * hh + 32 + d); }
#pragma unroll
        for (int ai = 0; ai < 2; ++ai)
#pragma unroll
            for (int m = 0; m < 4; ++m) { const int row = u.pm * 256 + ai * 128 + wr * 64 + m * 16 + fr; const float rs = rsv[ai][m];
#pragma unroll
                for (int bj = 0; bj < 2; ++bj) { const int g = 8 * u.pn + 4 * bj + wc, hh = g >> 1;
                    float o1[4], o2[4];
#pragma unroll
                    for (int r = 0; r < 4; ++r) { const float2 t = tv[ai][m][r]; const float x1 = acc[ai][bj][m][0][r] * rs + b1v[bj][r], x2 = acc[ai][bj][m][1][r] * rs + b2v[bj][r];
                        o1[r] = (x1 * t.x - x2 * t.y) * 0.125f; o2[r] = (x2 * t.x + x1 * t.y) * 0.125f; }
                    unsigned short* orow = qkv + (size_t)row * NQKV + 64 * hh + d;
                    *(u32x2*)orow = (u32x2){pk2(o1[0], o1[1]), pk2(o1[2], o1[3])}; *(u32x2*)(orow + 32) = (u32x2){pk2(o2[0], o2[1]), pk2(o2[2], o2[3])}; } }
    }
};

struct EpiQKV {
    const float* rstd; const float* bias; const float2* cs; bf16_t* qkv; int m0, n0; bool perm;
    template <int MT, int NT> __device__ __forceinline__ void operator()(f32x4 (&acc)[MT][NT], int mb, int nb, int lane) const {
        static_assert(NT == 4, "rope needs a 64-column wave span");
        const int cb = n0 + nb, d0 = (lane >> 4) * 4;
#pragma unroll
        for (int mi = 0; mi < MT; ++mi) {
            const int row = m0 + mb + mi * 16 + (lane & 15);
            if (row < MTOT) {
                const float rs = rstd[row]; const int pos = row_pos(row);
                bf16_t* orow = qkv + (size_t)row * NQKV + cb;
                {
                    const float sc = cb < 1024 ? 0.125f : 1.0f;
#pragma unroll
                    for (int ni = 0; ni < 2; ++ni) {
                        const int d = ni * 16 + d0;
                        const f32x4 b1 = *(const f32x4*)(bias + cb + d), b2 = *(const f32x4*)(bias + cb + 32 + d);
                        const f32x4 a1 = perm ? acc[mi][2 * ni] : acc[mi][ni], a2 = perm ? acc[mi][2 * ni + 1] : acc[mi][ni + 2];
                        float o1[4], o2[4];
#pragma unroll
                        for (int r = 0; r < 4; ++r) {
                            const float2 t = cs[pos * 32 + d + r];
                            const float x1 = a1[r] * rs + b1[r], x2 = a2[r] * rs + b2[r];
                            o1[r] = (x1 * t.x - x2 * t.y) * sc; o2[r] = (x2 * t.x + x1 * t.y) * sc;
                        }
                        *(u32x2*)(orow + d) = (u32x2){pk2(o1[0], o1[1]), pk2(o1[2], o1[3])};
                        *(u32x2*)(orow + 32 + d) = (u32x2){pk2(o2[0], o2[1]), pk2(o2[2], o2[3])};
                    }
                }
            }
        }
    }
};
struct EpiV0 {
    const float* rstd; const float* bias; bf16_t* vt0; int m0, n0;
    template <int MT, int NT> __device__ __forceinline__ void operator()(f32x4 (&acc)[MT][NT], int mb, int nb, int lane) const {
        static_assert(NT == 4, "64-column wave span");
        const int cb = n0 + nb, kh = (cb - 1152) >> 6;
#pragma unroll
        for (int mi = 0; mi < MT; ++mi) {
            const int row0 = m0 + mb + mi * 16 + (lane >> 4) * 4;
            if (row0 < MTOT) {
                const f32x4 rs = *(const f32x4*)(rstd + row0); const int b = row_batch(row0), pp = perm16(row_pos(row0));
#pragma unroll
                for (int ni = 0; ni < NT; ++ni) { const int d = ni * 16 + (lane & 15); const float bb = bias[cb + d];
                    const f32x4 v = acc[mi][ni] * rs + bb;
                    *(u32x2*)(vt0 + (size_t)((b * 2 + kh) * 64 + d) * LP + pp) = (u32x2){pk2(v[0], v[1]), pk2(v[2], v[3])}; }
            }
        }
    }
};
struct EpiRes {
    const float* bias; bf16_t* hb; int m0, n0;
    template <int MT, int NT> __device__ __forceinline__ void operator()(f32x4 (&acc)[MT][NT], int mb, int nb, int lane) const {
#pragma unroll
        for (int mi = 0; mi < MT; ++mi) {
            const int row = m0 + mb + mi * 16 + (lane & 15);
            if (row < MTOT) {
#pragma unroll
                for (int ni = 0; ni < NT; ++ni) {
                    const int col = n0 + nb + ni * 16 + (lane >> 4) * 4;
                    u32x2* p = (u32x2*)(hb + (size_t)row * D + col);
                    const u32x2 h = *p;
                    f32x4 v = acc[mi][ni];
                    if (bias) v += *(const f32x4*)(bias + col);
                    v[0] += __uint_as_float(h.x << 16); v[1] += __uint_as_float(h.x & 0xffff0000u); v[2] += __uint_as_float(h.y << 16); v[3] += __uint_as_float(h.y & 0xffff0000u);
                    *p = (u32x2){pk2(v[0], v[1]), pk2(v[2], v[3])};
                }
            }
        }
    }
};
__device__ __forceinline__ void route_phase_mfma(LAS unsigned char* lds, const bf16_t* __restrict__ hbr, const float* __restrict__ wrf, const float* __restrict__ bg, const float* __restrict__ br,
                                                 float* rstd_out, int* cnt, int* list, float* wslot, int bid) {
    constexpr int WP = 4176;
    const int tid = otid(), lane = tid & 63, wave = __builtin_amdgcn_readfirstlane(tid >> 6);
    LAS int* nrec = (LAS int*)(lds + LDS_MISC + 16); LAS int* bcnt = (LAS int*)(lds + LDS_MISC + 32); LAS int* bbase = (LAS int*)(lds + LDS_MISC + 160); LAS int* rec = (LAS int*)(lds + LDS_MISC + 288);
    static_assert(36 * WP <= LDS_MISC, "route lds");
    { f32x4 wv[18];
#pragma unroll
      for (int i = 0; i < 18; ++i) wv[i] = *(const f32x4*)(wrf + (size_t)(tid + i * NTHR) * 4);
#pragma unroll
      for (int i = 0; i < 18; ++i) { const int idx = tid + i * NTHR, n = idx >> 8, kc = (idx & 255) * 4;
          float hi[4], lo[4];
#pragma unroll
          for (int r = 0; r < 4; ++r) { hi[r] = __uint_as_float(__float_as_uint(bf2f(f2bf(wv[i][r])))); lo[r] = wv[i][r] - hi[r]; }
          *(LAS u32x2*)(lds + n * WP + kc * 2) = (u32x2){pk2(hi[0], hi[1]), pk2(hi[2], hi[3])};
          *(LAS u32x2*)(lds + n * WP + 2048 + kc * 2) = (u32x2){pk2(lo[0], lo[1]), pk2(lo[2], lo[3])}; } }
    if (tid < NE) bcnt[tid] = 0;
    if (tid == 0) *nrec = 0;
    __syncthreads();
    const int nm = bid < 2 ? 5 : 4;
    f32x4 acc[2][3]; float ssq[2];
#pragma unroll
    for (int jj = 0; jj < 2; ++jj) {
        const int job = wave + 8 * jj;
        ssq[jj] = 0.f;
#pragma unroll
        for (int ni = 0; ni < 3; ++ni) acc[jj][ni] = (f32x4){0.f, 0.f, 0.f, 0.f};
        if (job < 2 * nm) {
            const int mf = job >> 1, kh = job & 1;
            const int row = (mf < 4 ? bid * 64 + mf * 16 : MREAL + bid * 16) + (lane & 15);
            const bf16_t* ap = hbr + (size_t)row * D + kh * 512 + (lane >> 4) * 8;
            u32x4 af[16];
#pragma unroll
            for (int ks = 0; ks < 16; ++ks) af[ks] = *(const u32x4*)(ap + ks * 32);
            unsigned baddr[3];
#pragma unroll
            for (int ni = 0; ni < 3; ++ni) { int n = ni * 16 + (lane & 15); n = n < 36 ? n : 35; baddr[ni] = (unsigned)(n * WP + kh * 1024 + (lane >> 4) * 16); }
#pragma unroll
            for (int ks = 0; ks < 16; ++ks) {
                const bf16x8 a = __builtin_bit_cast(bf16x8, af[ks]);
                { const u32x4 u = af[ks];
                  const float f0 = __uint_as_float(u.x << 16), f1 = __uint_as_float(u.x & 0xffff0000u), f2 = __uint_as_float(u.y << 16), f3 = __uint_as_float(u.y & 0xffff0000u);
                  const float f4 = __uint_as_float(u.z << 16), f5 = __uint_as_float(u.z & 0xffff0000u), f6 = __uint_as_float(u.w << 16), f7 = __uint_as_float(u.w & 0xffff0000u);
                  ssq[jj] += (f0 * f0 + f1 * f1) + (f2 * f2 + f3 * f3) + (f4 * f4 + f5 * f5) + (f6 * f6 + f7 * f7); }
#pragma unroll
                for (int ni = 0; ni < 3; ++ni) {
                    const bf16x8 bh = *(LAS const bf16x8*)(lds + baddr[ni] + ks * 64), bl = *(LAS const bf16x8*)(lds + baddr[ni] + 2048 + ks * 64);
                    acc[jj][ni] = __builtin_amdgcn_mfma_f32_16x16x32_bf16(bh, a, acc[jj][ni], 0, 0, 0);
                    acc[jj][ni] = __builtin_amdgcn_mfma_f32_16x16x32_bf16(bl, a, acc[jj][ni], 0, 0, 0); }
            }
            ssq[jj] = xsum16(ssq[jj]); ssq[jj] = xsum32(ssq[jj]);
        }
    }
    __syncthreads();
    LAS float* ssum = (LAS float*)lds;
    LAS float* lgb = (LAS float*)(lds + 1024);
#pragma unroll
    for (int jj = 0; jj < 2; ++jj) { const int job = wave + 8 * jj;
        if (job < 2 * nm) { const int mf = job >> 1, kh = job & 1, ri = mf * 16 + (lane & 15);
            if (lane < 16) ssum[kh * 80 + ri] = ssq[jj];
#pragma unroll
            for (int ni = 0; ni < 3; ++ni) *(LAS f32x4*)(lgb + (kh * 80 + ri) * 48 + ni * 16 + (lane >> 4) * 4) = acc[jj][ni]; } }
    __syncthreads();
    if (tid < 16 * nm) { const int ri = tid; const int row = ri < 64 ? bid * 64 + ri : MREAL + bid * 16 + (ri - 64);
        const float rs = rsqrtf((ssum[ri] + ssum[80 + ri]) * (1.0f / D) + EPS);
        const LAS float* l0 = lgb + ri * 48; const LAS float* l1 = lgb + (80 + ri) * 48;
        float lg[4];
#pragma unroll
        for (int c = 0; c < 4; ++c) lg[c] = (l0[c] + l1[c]) * rs + bg[c];
        int gi = 0; float gm = lg[0];
#pragma unroll
        for (int c = 1; c < 4; ++c) if (lg[c] > gm) { gm = lg[c]; gi = c; }
        float gs = 0.f;
#pragma unroll
        for (int c = 0; c < 4; ++c) gs += __expf(lg[c] - gm);
        const float gp = 1.0f / gs;
        float e[8];
#pragma unroll
        for (int c = 0; c < 8; ++c) e[c] = (l0[4 + gi * 8 + c] + l1[4 + gi * 8 + c]) * rs + br[gi * 8 + c];
        int i1 = 0; float v1 = e[0];
#pragma unroll
        for (int c = 1; c < 8; ++c) if (e[c] > v1) { v1 = e[c]; i1 = c; }
        int i2 = -1; float v2 = -3.0e38f;
#pragma unroll
        for (int c = 0; c < 8; ++c) if (c != i1 && e[c] > v2) { v2 = e[c]; i2 = c; }
        const float r = __expf(v2 - v1);
        const float w1 = gp / (1.0f + r), w2 = gp * r / (1.0f + r);
        const int e1 = gi * 8 + i1, e2 = gi * 8 + i2;
        const int p1 = atomicAdd((int*)&bcnt[e1], 1), p2 = atomicAdd((int*)&bcnt[e2], 1);
        const int k = atomicAdd((int*)nrec, 2);
        rec[k] = ((row * 2) << 13) | (e1 << 8) | p1; rec[k + 1] = ((row * 2 + 1) << 13) | (e2 << 8) | p2;
        wslot[row * 2] = w1; wslot[row * 2 + 1] = w2; rstd_out[row] = rs;
    }
    __syncthreads();
    if (tid < NE) { const int c = bcnt[tid]; bbase[tid] = c ? __hip_atomic_fetch_add(cnt + tid * 64, c, __ATOMIC_RELAXED, __HIP_MEMORY_SCOPE_AGENT) : 0; }
    __syncthreads();
    for (int k = tid; k < *nrec; k += NTHR) { const int r = rec[k], e = (r >> 8) & 31; list[(size_t)e * CAP + bbase[e] + (r & 255)] = r >> 13; }
    __syncthreads();
}
__device__ __forceinline__ void route_phase(LAS unsigned char* lds, const bf16_t* __restrict__ hbr, const float* __restrict__ wrf, const float* __restrict__ bg, const float* __restrict__ br,
                                            float* rstd_out, int* cnt, int* list, float* wslot, int bid, int nblk) {
    if (nblk == 256) { route_phase_mfma(lds, hbr, wrf, bg, br, rstd_out, cnt, list, wslot, bid); return; }
    const int tid = otid(), lane = tid & 63, wave = __builtin_amdgcn_readfirstlane(tid >> 6);
    LAS f32x4* wl = (LAS f32x4*)lds;
    LAS int* nrec = (LAS int*)(lds + LDS_MISC + 16); LAS int* bcnt = (LAS int*)(lds + LDS_MISC + 32); LAS int* bbase = (LAS int*)(lds + LDS_MISC + 160); LAS int* rec = (LAS int*)(lds + LDS_MISC + 288);
    { f32x4 wv[18];
#pragma unroll
      for (int i = 0; i < 18; ++i) wv[i] = *(const f32x4*)(wrf + (size_t)(tid + i * NTHR) * 4);
#pragma unroll
      for (int i = 0; i < 18; ++i) wl[tid + i * NTHR] = wv[i]; }
    if (tid < NE) bcnt[tid] = 0;
    if (tid == 0) *nrec = 0;
    __syncthreads();
    u32x2 hn[4];
    { const int row0 = bid * NWAVE + wave; if (row0 < MTOT) {
#pragma unroll
        for (int j = 0; j < 4; ++j) hn[j] = *(const u32x2*)(hbr + (size_t)row0 * D + j * 256 + lane * 4); } }
    for (int row = bid * NWAVE + wave; row < MTOT; row += nblk * NWAVE) {
        f32x4 x[4]; float ss = 0.f;
        u32x2 hc[4];
#pragma unroll
        for (int j = 0; j < 4; ++j) hc[j] = hn[j];
        { const int rown = row + nblk * NWAVE; if (rown < MTOT) {
#pragma unroll
            for (int j = 0; j < 4; ++j) hn[j] = *(const u32x2*)(hbr + (size_t)rown * D + j * 256 + lane * 4); } }
#pragma unroll
        for (int j = 0; j < 4; ++j) { const u32x2 h = hc[j];
            x[j] = (f32x4){__uint_as_float(h.x << 16), __uint_as_float(h.x & 0xffff0000u), __uint_as_float(h.y << 16), __uint_as_float(h.y & 0xffff0000u)};
            ss += x[j][0] * x[j][0] + x[j][1] * x[j][1] + x[j][2] * x[j][2] + x[j][3] * x[j][3]; }
        ss = wave_sum(ss);
        const float rs = rsqrtf(ss * (1.0f / D) + EPS);
        float lg[4];
#pragma unroll
        for (int c = 0; c < 4; ++c) { float p = 0.f;
#pragma unroll
            for (int j = 0; j < 4; ++j) { const f32x4 w = wl[c * 256 + j * 64 + lane]; p += x[j][0] * w[0] + x[j][1] * w[1] + x[j][2] * w[2] + x[j][3] * w[3]; }
            lg[c] = wave_sum(p) * rs + bg[c]; }
        int gi = 0; float gm = lg[0];
#pragma unroll
        for (int c = 1; c < 4; ++c) if (lg[c] > gm) { gm = lg[c]; gi = c; }
        float gs = 0.f;
#pragma unroll
        for (int c = 0; c < 4; ++c) gs += __expf(lg[c] - gm);
        const float gp = 1.0f / gs;
        gi = __builtin_amdgcn_readfirstlane(gi);
        float e[8];
#pragma unroll
        for (int c = 0; c < 8; ++c) { float p = 0.f;
#pragma unroll
            for (int j = 0; j < 4; ++j) { const f32x4 w = wl[(4 + gi * 8 + c) * 256 + j * 64 + lane]; p += x[j][0] * w[0] + x[j][1] * w[1] + x[j][2] * w[2] + x[j][3] * w[3]; }
            e[c] = wave_sum(p) * rs + br[gi * 8 + c]; }
        int i1 = 0; float v1 = e[0];
#pragma unroll
        for (int c = 1; c < 8; ++c) if (e[c] > v1) { v1 = e[c]; i1 = c; }
        int i2 = -1; float v2 = -3.0e38f;
#pragma unroll
        for (int c = 0; c < 8; ++c) if (c != i1 && e[c] > v2) { v2 = e[c]; i2 = c; }
        if (lane == 0) {
            const float r = __expf(v2 - v1);
            const float w1 = gp / (1.0f + r), w2 = gp * r / (1.0f + r);
            const int e1 = gi * 8 + i1, e2 = gi * 8 + i2;
            const int p1 = atomicAdd((int*)&bcnt[e1], 1), p2 = atomicAdd((int*)&bcnt[e2], 1);
            const int k = atomicAdd((int*)nrec, 2);
            rec[k] = ((row * 2) << 13) | (e1 << 8) | p1; rec[k + 1] = ((row * 2 + 1) << 13) | (e2 << 8) | p2;
            wslot[row * 2] = w1; wslot[row * 2 + 1] = w2; rstd_out[row] = rs;
        }
    }
    __syncthreads();
    if (tid < NE) { const int c = bcnt[tid]; bbase[tid] = c ? __hip_atomic_fetch_add(cnt + tid * 64, c, __ATOMIC_RELAXED, __HIP_MEMORY_SCOPE_AGENT) : 0; }
    __syncthreads();
    for (int k = tid; k < *nrec; k += NTHR) { const int r = rec[k], e = (r >> 8) & 31; list[(size_t)e * CAP + bbase[e] + (r & 255)] = r >> 13; }
    __syncthreads();
}
__device__ __forceinline__ void final_phase(const bf16_t* __restrict__ hb, const bf16_t* __restrict__ ybuf, const float* __restrict__ g, float* out, int bid, int nblk) {
    const int tid = otid(), lane = tid & 63, wave = tid >> 6;
    f32x4 gg[4];
#pragma unroll
    for (int j = 0; j < 4; ++j) gg[j] = *(const f32x4*)(g + j * 256 + lane * 4);
    for (int row = bid * NWAVE + wave; row < MREAL; row += nblk * NWAVE) {
        f32x4 v[4]; float ss = 0.f;
#pragma unroll
        for (int j = 0; j < 4; ++j) { const size_t c = j * 256 + lane * 4;
            const u32x2 h = *(const u32x2*)(hb + (size_t)row * D + c), y0 = *(const u32x2*)(ybuf + (size_t)(row * 2) * D + c), y1 = *(const u32x2*)(ybuf + (size_t)(row * 2 + 1) * D + c);
            v[j][0] = __uint_as_float(h.x << 16) + __uint_as_float(y0.x << 16) + __uint_as_float(y1.x << 16);
            v[j][1] = __uint_as_float(h.x & 0xffff0000u) + __uint_as_float(y0.x & 0xffff0000u) + __uint_as_float(y1.x & 0xffff0000u);
            v[j][2] = __uint_as_float(h.y << 16) + __uint_as_float(y0.y << 16) + __uint_as_float(y1.y << 16);
            v[j][3] = __uint_as_float(h.y & 0xffff0000u) + __uint_as_float(y0.y & 0xffff0000u) + __uint_as_float(y1.y & 0xffff0000u);
            ss += v[j][0] * v[j][0] + v[j][1] * v[j][1] + v[j][2] * v[j][2] + v[j][3] * v[j][3]; }
        const float rs = rsqrtf(wave_sum(ss) * (1.0f / D) + EPS);
#pragma unroll
        for (int j = 0; j < 4; ++j) __builtin_nontemporal_store(v[j] * rs * gg[j], (f32x4*)(out + (size_t)row * D + j * 256 + lane * 4));
    }
}

typedef float f32x16 __attribute__((ext_vector_type(16)));
constexpr int AT_STAGE = 20480;
__device__ __forceinline__ float max3f(float a, float b, float c) { float r; asm("v_max3_f32 %0, %1, %2, %3" : "=v"(r) : "v"(a), "v"(b), "v"(c)); return r; }
__device__ __forceinline__ float max2f(float a, float b) { float r; asm("v_max_f32_e32 %0, %1, %2" : "=v"(r) : "v"(a), "v"(b)); return r; }
__device__ __forceinline__ float fadd_s(float a, float b) { float r; asm("v_add_f32_e32 %0, %1, %2" : "=v"(r) : "v"(a), "v"(b)); return r; }
__device__ __forceinline__ void mla_unit(LAS unsigned char* lds, int b, int h, int qi, const bf16_t* __restrict__ Q1, const bf16_t* __restrict__ K1, const bf16_t* __restrict__ kpe,
                                         const bf16_t* __restrict__ VT1, bf16_t* o) {
    const int tid = otid(), lane = tid & 63, wave = __builtin_amdgcn_readfirstlane(tid >> 6), r32 = lane & 31, hi = lane >> 5;
    const size_t qrow = (size_t)b * SEQ + 256 * qi + 32 * wave + r32;
    bf16x8 qf[6];
#pragma unroll
    for (int s = 0; s < 6; ++s) qf[s] = *(const bf16x8*)(Q1 + qrow * 1536 + h * 96 + 16 * s + 8 * hi);
    const int lr = 8 * wave + (lane >> 3);
    const char* ksrc = (const char*)(K1 + ((size_t)b * LP + lr) * 1024 + h * 64) + (((lane & 7) ^ ((lr >> 1) & 7)) << 4);
    const char* vsrc = (const char*)(VT1 + ((size_t)(b * 16 + h) * 64 + lr) * LP) + (((lane & 7) ^ ((lr >> 1) & 7)) << 4);
    const int pr = 16 * wave + (lane >> 2);
    const char* psrc = (const char*)(kpe + ((size_t)b * LP + (pr & 63)) * 32) + (((lane & 3) ^ ((pr >> 2) & 3)) << 4);
#define MLA_ISSUE(j, st) do { \
        __builtin_amdgcn_global_load_lds((const unsigned*)(ksrc + (size_t)(j) * (64 * 2048)), (LAS unsigned*)(lds + (st) * AT_STAGE + wave * 1024), 16, 0, 0); \
        __builtin_amdgcn_global_load_lds((const unsigned*)(vsrc + (size_t)(j) * 128), (LAS unsigned*)(lds + (st) * AT_STAGE + 8192 + wave * 1024), 16, 0, 0); \
        if (wave < 4) __builtin_amdgcn_global_load_lds((const unsigned*)(psrc + (size_t)(j) * (64 * 64)), (LAS unsigned*)(lds + (st) * AT_STAGE + 16384 + wave * 1024), 16, 0, 0); } while (0)
    const int NT = 4 * qi + 5;
    const int qp = 16 + 256 * qi + 32 * wave + r32;
    const int koff = r32 * 128, ksw = (r32 >> 1) & 7, poff = 16384 + r32 * 64, psw = (r32 >> 2) & 3;
    f32x16 oacc[2]; oacc[0] = (f32x16){}; oacc[1] = (f32x16){};
    const unsigned lds_a = (unsigned)(size_t)lds;
    unsigned ka[4], pa[2];
#pragma unroll
    for (int s = 0; s < 4; ++s) ka[s] = lds_a + koff + (((2 * s + hi) ^ ksw) << 4);
#pragma unroll
    for (int s = 0; s < 2; ++s) pa[s] = lds_a + poff + (((2 * s + hi) ^ psw) << 4);
#define MLA_DSR(dst, addr, off) asm volatile("ds_read_b128 %0, %1 offset:" #off : "=v"(dst) : "v"(addr))
    constexpr float MLA_THR = 8.0f;
    float mref = 0.f, lsum = 0.f;
    f32x16 negm = (f32x16){};
#define MLA_KREADS(stg) const unsigned kb0_ = pa[0] + (unsigned)(stg) * AT_STAGE, kb1_ = pa[1] + (unsigned)(stg) * AT_STAGE; \
        do { const unsigned so = (unsigned)(stg) * AT_STAGE; const unsigned a0 = ka[0] + so, a1 = ka[1] + so, a2 = ka[2] + so, a3 = ka[3] + so; \
        MLA_DSR(kf[0], a0, 0); MLA_DSR(kf[1], a0, 4096); MLA_DSR(kf[2], a1, 0); MLA_DSR(kf[3], a1, 4096); MLA_DSR(kf[4], a2, 0); MLA_DSR(kf[5], a2, 4096); MLA_DSR(kf[6], a3, 0); MLA_DSR(kf[7], a3, 4096); \
        __builtin_amdgcn_sched_barrier(0); } while (0)
#define MLA_VREADS(stg) do { const unsigned so = (unsigned)(stg) * AT_STAGE; const unsigned a0 = ka[0] + so, a1 = ka[1] + so, a2 = ka[2] + so, a3 = ka[3] + so; \
        MLA_DSR(vf[0], a0, 8192); MLA_DSR(vf[1], a0, 12288); MLA_DSR(vf[2], a1, 8192); MLA_DSR(vf[3], a1, 12288); MLA_DSR(vf[4], a2, 8192); MLA_DSR(vf[5], a2, 12288); MLA_DSR(vf[6], a3, 8192); MLA_DSR(vf[7], a3, 12288); \
        __builtin_amdgcn_sched_barrier(0); } while (0)
#define MLA_QKP(s, cnt) do { asm volatile("s_waitcnt lgkmcnt(" #cnt ")" : "+v"(kf[2 * (s)]), "+v"(kf[2 * (s) + 1])); \
        p0 = __builtin_amdgcn_mfma_f32_32x32x16_bf16(kf[2 * (s)], qf[s], (s) == 0 ? negm : p0, 0, 0, 0); p1 = __builtin_amdgcn_mfma_f32_32x32x16_bf16(kf[2 * (s) + 1], qf[s], (s) == 0 ? negm : p1, 0, 0, 0); \
        __builtin_amdgcn_sched_barrier(0); } while (0)
#define MLA_QKMMA(t) do { MLA_QKP(0, 6); MLA_QKP(1, 4); \
        MLA_DSR(kf[8], kb0_, 0); MLA_DSR(kf[9], kb0_, 2048); MLA_DSR(kf[10], kb1_, 0); MLA_DSR(kf[11], kb1_, 2048); __builtin_amdgcn_sched_barrier(0); \
        MLA_QKP(2, 6); MLA_QKP(3, 4); MLA_QKP(4, 2); MLA_QKP(5, 0); \
        if ((t) >= 4 * qi) { const int kb0 = 64 * (t) + 4 * hi; \
            _Pragma("unroll") for (int r = 0; r < 16; ++r) { const int kp = kb0 + (r & 3) + 8 * (r >> 2); if (kp > qp) p0[r] = -1e30f; if (kp + 32 > qp) p1[r] = -1e30f; } } } while (0)
#define MLA_SM(t) do { \
        asm volatile("s_nop 15\n\ts_nop 7" : "+v"(p0), "+v"(p1)); \
        float tm; \
        { float ma = max3f(p0[0], p0[1], p0[2]), mb = max3f(p0[3], p1[0], p1[1]), mc = max3f(p1[2], p1[3], p0[4]), md = max3f(p0[5], p0[6], p0[7]);     \
          ma = max3f(ma, p1[4], p1[5]); mb = max3f(mb, p1[6], p1[7]); \
          _Pragma("unroll") for (int r = 8; r < 16; r += 8) { ma = max3f(ma, p0[r], p0[r + 1]); mb = max3f(mb, p0[r + 2], p0[r + 3]); mc = max3f(mc, p0[r + 4], p0[r + 5]); md = max3f(md, p0[r + 6], p0[r + 7]); \
              ma = max3f(ma, p1[r], p1[r + 1]); mb = max3f(mb, p1[r + 2], p1[r + 3]); mc = max3f(mc, p1[r + 4], p1[r + 5]); md = max3f(md, p1[r + 6], p1[r + 7]); } \
          tm = max3f(max2f(ma, mb), mc, md); } \
        { auto rr = __builtin_amdgcn_permlane32_swap(__float_as_uint(tm), __float_as_uint(tm), false, false); \
          tm = fmaxf(__uint_as_float(rr[0]), __uint_as_float(rr[1])); } \
        if ((t) == 0 || __any(tm > MLA_THR)) { \
            const float dl = (t) == 0 ? tm : fmaxf(tm, 0.f); \
            mref += dl; \
            const float f = __builtin_amdgcn_exp2f(-dl); \
            lsum *= f; \
            _Pragma("unroll") for (int r = 0; r < 16; ++r) { oacc[0][r] *= f; oacc[1][r] *= f; p0[r] -= dl; p1[r] -= dl; negm[r] = -mref; } \
        } \
        _Pragma("unroll") for (int r = 0; r < 16; ++r) { p0[r] = __builtin_amdgcn_exp2f(p0[r]); p1[r] = __builtin_amdgcn_exp2f(p1[r]); } \
        asm volatile("s_nop 1" : "+v"(p0), "+v"(p1)); } while (0)
#define MLA_SM2() do { \
        { float sa = fadd_s(p0[0], p1[0]), sb2 = fadd_s(p0[1], p1[1]), sc = fadd_s(p0[2], p1[2]), sd = fadd_s(p0[3], p1[3]);     \
          _Pragma("unroll") for (int r = 4; r < 16; r += 4) { sa = fadd_s(sa, p0[r]); sb2 = fadd_s(sb2, p0[r + 1]); sc = fadd_s(sc, p0[r + 2]); sd = fadd_s(sd, p0[r + 3]); \
              sa = fadd_s(sa, p1[r]); sb2 = fadd_s(sb2, p1[r + 1]); sc = fadd_s(sc, p1[r + 2]); sd = fadd_s(sd, p1[r + 3]); } \
          lsum += fadd_s(fadd_s(sa, sb2), fadd_s(sc, sd)); } \
        pf[0] = (u32x4){cvtpk(p0[0], p0[1]), cvtpk(p0[2], p0[3]), cvtpk(p0[4], p0[5]), cvtpk(p0[6], p0[7])}; \
        pf[1] = (u32x4){cvtpk(p0[8], p0[9]), cvtpk(p0[10], p0[11]), cvtpk(p0[12], p0[13]), cvtpk(p0[14], p0[15])}; \
        pf[2] = (u32x4){cvtpk(p1[0], p1[1]), cvtpk(p1[2], p1[3]), cvtpk(p1[4], p1[5]), cvtpk(p1[6], p1[7])}; \
        pf[3] = (u32x4){cvtpk(p1[8], p1[9]), cvtpk(p1[10], p1[11]), cvtpk(p1[12], p1[13]), cvtpk(p1[14], p1[15])}; } while (0)
#define MLA_PV(cnt) do { asm volatile("s_waitcnt lgkmcnt(" #cnt ")" : "+v"(vf[0]), "+v"(vf[1]), "+v"(vf[2]), "+v"(vf[3]), "+v"(vf[4]), "+v"(vf[5]), "+v"(vf[6]), "+v"(vf[7])); \
        _Pragma("unroll") for (int s = 0; s < 4; ++s) { const bf16x8 pb = __builtin_bit_cast(bf16x8, pf[s]); \
            oacc[0] = __builtin_amdgcn_mfma_f32_32x32x16_bf16(vf[2 * s], pb, oacc[0], 0, 0, 0); oacc[1] = __builtin_amdgcn_mfma_f32_32x32x16_bf16(vf[2 * s + 1], pb, oacc[1], 0, 0, 0); } \
        __builtin_amdgcn_sched_barrier(0); } while (0)
#define MLA_BAR(k) do { if ((k) + 2 < NT) { if (wave < 4) asm volatile("s_waitcnt vmcnt(6)" ::: "memory"); else asm volatile("s_waitcnt vmcnt(4)" ::: "memory"); } \
        else if ((k) + 1 < NT) { if (wave < 4) asm volatile("s_waitcnt vmcnt(3)" ::: "memory"); else asm volatile("s_waitcnt vmcnt(2)" ::: "memory"); } \
        else asm volatile("s_waitcnt vmcnt(0)" ::: "memory"); \
        __builtin_amdgcn_s_barrier(); asm volatile("" ::: "memory"); } while (0)
    MLA_ISSUE(0, 0);
    if (NT > 1) MLA_ISSUE(1, 1);
    if (NT > 2) MLA_ISSUE(2, 2);
    for (int j = 0; j < NT; ++j) {
        MLA_BAR(j);
        bf16x8 kf[12], vf[8]; u32x4 pf[4]; f32x16 p0, p1;
        MLA_KREADS(j & 3); MLA_QKMMA(j);
        MLA_VREADS(j & 3); MLA_SM(j);
        __builtin_amdgcn_sched_barrier(0);
        if (j + 3 < NT) MLA_ISSUE(j + 3, (j + 3) & 3);
        __builtin_amdgcn_sched_barrier(0);
        MLA_SM2(); MLA_PV(0);
    }
#undef MLA_BAR
#undef MLA_ISSUE
#undef MLA_DSR
#undef MLA_KREADS
#undef MLA_VREADS
#undef MLA_QKP
#undef MLA_QKMMA
#undef MLA_SM
#undef MLA_SM2
#undef MLA_PV
    lsum = xsum32(lsum);
    const float inv = 1.0f / lsum;
    int lane_o = threadIdx.x & 63; asm volatile("" : "+v"(lane_o));
    bf16_t* orow = o + ((size_t)b * SEQ + 256 * qi + 32 * wave + (lane_o & 31)) * D + h * 64 + 4 * (lane_o >> 5);
#pragma unroll
    for (int db = 0; db < 2; ++db)
#pragma unroll
        for (int g = 0; g < 4; ++g)
            *(u32x2*)(orow + 32 * db + 8 * g) = (u32x2){cvtpk(oacc[db][4 * g] * inv, oacc[db][4 * g + 1] * inv), cvtpk(oacc[db][4 * g + 2] * inv, oacc[db][4 * g + 3] * inv)};
    asm volatile("s_waitcnt lgkmcnt(0)" ::: "memory");
    __builtin_amdgcn_s_barrier(); asm volatile("" ::: "memory");
}
__device__ __forceinline__ void unpack8(const u32x4 v, float (&f)[8]) {
    f[0] = __uint_as_float(v.x << 16); f[1] = __uint_as_float(v.x & 0xffff0000u); f[2] = __uint_as_float(v.y << 16); f[3] = __uint_as_float(v.y & 0xffff0000u);
    f[4] = __uint_as_float(v.z << 16); f[5] = __uint_as_float(v.z & 0xffff0000u); f[6] = __uint_as_float(v.w << 16); f[7] = __uint_as_float(v.w & 0xffff0000u);
}
__device__ __forceinline__ void mla_meta(int b, int h, const bf16_t* __restrict__ Q1, const bf16_t* __restrict__ K1, const bf16_t* __restrict__ kpe, const bf16_t* __restrict__ VT1, bf16_t* o, int lane) {
    const int qi = lane & 15, part = lane >> 4; const size_t qrow = (size_t)MREAL + b * 16 + qi;
    float q[24];
#pragma unroll
    for (int c = 0; c < 3; ++c) { float f[8]; unpack8(*(const u32x4*)(Q1 + qrow * 1536 + h * 96 + 24 * part + 8 * c), f);
#pragma unroll
        for (int i = 0; i < 8; ++i) q[8 * c + i] = f[i]; }
    float sc[16]; float mx = -1e30f;
#pragma unroll
    for (int jb = 0; jb < 4; ++jb) {
        u32x4 kc[4][3];
#pragma unroll
        for (int jj = 0; jj < 4; ++jj) { const size_t kr = (size_t)b * LP + 4 * jb + jj;
#pragma unroll
            for (int c = 0; c < 3; ++c) { const int g = 24 * part + 8 * c;
                const bf16_t* src = g < 64 ? K1 + kr * D + h * 64 + g : kpe + kr * 32 + (g - 64);
                kc[jj][c] = *(const u32x4*)src; } }
#pragma unroll
        for (int jj = 0; jj < 4; ++jj) { const int j = 4 * jb + jj; float s = 0.f;
#pragma unroll
            for (int c = 0; c < 3; ++c) { float f[8]; unpack8(kc[jj][c], f);
#pragma unroll
                for (int i = 0; i < 8; ++i) s += q[8 * c + i] * f[i]; }
            s = xsum16(s); s = xsum32(s);
            sc[j] = j <= qi ? s : -1e30f; mx = fmaxf(mx, sc[j]); }
    }
    float l = 0.f;
#pragma unroll
    for (int j = 0; j < 16; ++j) { sc[j] = exp2f(sc[j] - mx); l += sc[j]; }
    const float inv = 1.0f / l;
    float res[16];
#pragma unroll
    for (int db = 0; db < 2; ++db) {
        u32x4 vv[8][2];
#pragma unroll
        for (int k = 0; k < 8; ++k) { const int d = 16 * part + 8 * db + k; const bf16_t* vr = VT1 + ((size_t)(b * 16 + h) * 64 + d) * LP;
            vv[k][0] = *(const u32x4*)vr; vv[k][1] = *(const u32x4*)(vr + 8); }
#pragma unroll
        for (int k = 0; k < 8; ++k) { float e[16]; { float f[8]; unpack8(vv[k][0], f);
#pragma unroll
                for (int i = 0; i < 8; ++i) e[i] = f[i]; unpack8(vv[k][1], f);
#pragma unroll
                for (int i = 0; i < 8; ++i) e[8 + i] = f[i]; }
            float acc = 0.f;
#pragma unroll
            for (int j = 0; j < 16; ++j) acc += sc[j] * e[(j & 3) | ((((j >> 2) & 1) << 1 | ((j >> 3) & 1)) << 2)];
            res[8 * db + k] = acc * inv; }
    }
#pragma unroll
    for (int dd = 0; dd < 16; ++dd) o[qrow * D + h * 64 + 16 * part + dd] = f2bf(res[dd]);
}
__device__ __forceinline__ void mla_phase(LAS unsigned char* lds, const bf16_t* Q1, const bf16_t* K1, const bf16_t* kpe, const bf16_t* VT1, bf16_t* o, int bid, int nblk) {
    const int v = (nblk % 8 == 0) ? (bid % 8) * (nblk / 8) + bid / 8 : bid;
    for (int vv = v; vv < 256; vv += nblk) {
        const int bh = vv >> 3, s = vv & 7, b = bh >> 4, h = bh & 15;
#pragma unroll 1
        for (int i = 0; i < 4; ++i) { const int qi = (i == 0) ? s : (i == 1) ? 15 - s : (i == 2) ? 16 + s : 31 - s; mla_unit(lds, b, h, qi, Q1, K1, kpe, VT1, o); }
        if (s == 0 && threadIdx.x < 64) mla_meta(b, h, Q1, K1, kpe, VT1, o, threadIdx.x);
    }
}

constexpr int SW_K = 0, SW_V = 36864, SW_VP = 560;
__device__ __forceinline__ void swa_block32(LAS const unsigned char* lds, int rb, int gk0, int nks, int mode, int i_q, const bf16x8 (&qf)[4], float& m, float& lsum, f32x16 (&oacc)[2], int r32, int hi) {
    const float C2 = 1.4426950408889634f;
    const int ksw = (r32 >> 1) & 7;
    f32x16 p = (f32x16){};
#pragma unroll
    for (int s = 0; s < 4; ++s) { const bf16x8 k = *(LAS const bf16x8*)(lds + SW_K + (rb + r32) * 128 + (((2 * s + hi) ^ ksw) << 4)); p = __builtin_amdgcn_mfma_f32_32x32x16_bf16(k, qf[s], p, 0, 0, 0); }
    if (mode != 0) {
        const int jb = ((rb - 32) & 127) + 4 * hi;
#pragma unroll
        for (int r = 0; r < 16; ++r) { const int kk = (r & 3) + 8 * (r >> 2);
            const bool ok = mode == 1 ? (kk + 4 * hi < 16) : mode == 2 ? (jb + kk > i_q) : (jb + kk <= i_q);
            if (!ok) p[r] = -1e30f; }
    }
    float tm = p[0];
#pragma unroll
    for (int r = 1; r < 16; ++r) tm = fmaxf(tm, p[r]);
    tm = xmax32(tm);
    const float mn = fmaxf(m, tm), alpha = __builtin_amdgcn_exp2f((m - mn) * C2), nmc = -mn * C2;
    m = mn;
    float ps = 0.f;
#pragma unroll
    for (int r = 0; r < 16; ++r) { p[r] = __builtin_amdgcn_exp2f(__builtin_fmaf(p[r], C2, nmc)); ps += p[r]; }
    lsum = lsum * alpha + ps;
#pragma unroll
    for (int r = 0; r < 16; ++r) { oacc[0][r] *= alpha; oacc[1][r] *= alpha; }
    u32x4 pf[2];
    pf[0] = (u32x4){cvtpk(p[0], p[1]), cvtpk(p[2], p[3]), cvtpk(p[4], p[5]), cvtpk(p[6], p[7])};
    pf[1] = (u32x4){cvtpk(p[8], p[9]), cvtpk(p[10], p[11]), cvtpk(p[12], p[13]), cvtpk(p[14], p[15])};
#pragma unroll
    for (int ks = 0; ks < 2; ++ks) if (ks < nks) {
        const bf16x8 v0 = *(LAS const bf16x8*)(lds + SW_V + r32 * SW_VP + (gk0 + ks) * 32 + hi * 16);
        const bf16x8 v1 = *(LAS const bf16x8*)(lds + SW_V + (32 + r32) * SW_VP + (gk0 + ks) * 32 + hi * 16);
        const bf16x8 pb = __builtin_bit_cast(bf16x8, pf[ks]);
        oacc[0] = __builtin_amdgcn_mfma_f32_32x32x16_bf16(v0, pb, oacc[0], 0, 0, 0);
        oacc[1] = __builtin_amdgcn_mfma_f32_32x32x16_bf16(v1, pb, oacc[1], 0, 0, 0);
    }
}
__device__ __forceinline__ void swa_unit(LAS unsigned char* lds, int b, int n, int kh, const bf16_t* __restrict__ qkv, const bf16_t* __restrict__ VT0, const float* __restrict__ sinks, bf16_t* o) {
    const int tid = otid(), lane = tid & 63, wave = __builtin_amdgcn_readfirstlane(tid >> 6), r32 = lane & 31, hi = lane >> 5;
    {
        u32x4 kv[5], vv[5];
#pragma unroll
        for (int it = 0; it < 5; ++it) { const int idx = tid + it * NTHR; const int row = idx >> 3, c = idx & 7;
            if (idx < 2176 && (row < 16 || n > 0 || row >= 144)) {
                const size_t srow = row < 16 ? (size_t)MREAL + b * 16 + row : (size_t)b * SEQ + 128 * (n - 1) + (row - 16);
                kv[it] = *(const u32x4*)(qkv + srow * NQKV + 1024 + kh * 64 + c * 8); } }
#pragma unroll
        for (int it = 0; it < 5; ++it) { const int idx = tid + it * NTHR; const int d = idx / 34, c = idx % 34;
            if (idx < 2176 && (c < 2 || n > 0 || c >= 18)) {
                const bf16_t* src = VT0 + (size_t)((b * 2 + kh) * 64 + d) * LP + (c < 2 ? c * 8 : 16 + 128 * (n - 1) + (c - 2) * 8);
                vv[it] = *(const u32x4*)src; } }
#pragma unroll
        for (int it = 0; it < 5; ++it) { const int idx = tid + it * NTHR; const int row = idx >> 3, c = idx & 7;
            if (idx < 2176 && (row < 16 || n > 0 || row >= 144)) { const int lrow = row < 16 ? row : 16 + row;
                *(LAS u32x4*)(lds + SW_K + lrow * 128 + ((c ^ ((lrow >> 1) & 7)) << 4)) = kv[it]; } }
#pragma unroll
        for (int it = 0; it < 5; ++it) { const int idx = tid + it * NTHR; const int d = idx / 34, c = idx % 34;
            if (idx < 2176 && (c < 2 || n > 0 || c >= 18)) *(LAS u32x4*)(lds + SW_V + d * SW_VP + c * 16) = vv[it]; }
    }
    __syncthreads();
    const int hq = kh * 8 + wave;
    const float sink = sinks[hq];
#pragma unroll 1
    for (int qs = 0; qs < 4; ++qs) {
        const size_t qrow = (size_t)b * SEQ + 128 * n + 32 * qs + r32;
        bf16x8 qf[4];
#pragma unroll
        for (int s = 0; s < 4; ++s) qf[s] = *(const bf16x8*)(qkv + qrow * NQKV + hq * 64 + 16 * s + 8 * hi);
        f32x16 oacc[2]; oacc[0] = (f32x16){}; oacc[1] = (f32x16){};
        float m = sink, lsum = hi == 0 ? 1.0f : 0.0f;
        const int i_q = 32 * qs + r32;
        swa_block32(lds, 0, 0, 1, 1, i_q, qf, m, lsum, oacc, r32, hi);
        if (n > 0) {
            swa_block32(lds, 32 + 32 * qs, 1 + 2 * qs, 2, 2, i_q, qf, m, lsum, oacc, r32, hi);
#pragma unroll 1
            for (int kb = qs + 1; kb < 4; ++kb) swa_block32(lds, 32 + 32 * kb, 1 + 2 * kb, 2, 0, i_q, qf, m, lsum, oacc, r32, hi);
        }
#pragma unroll 1
        for (int kb = 0; kb < qs; ++kb) swa_block32(lds, 160 + 32 * kb, 9 + 2 * kb, 2, 0, i_q, qf, m, lsum, oacc, r32, hi);
        swa_block32(lds, 160 + 32 * qs, 9 + 2 * qs, 2, 3, i_q, qf, m, lsum, oacc, r32, hi);
        lsum = xsum32(lsum);
        const float inv = 1.0f / lsum;
        bf16_t* orow = o + qrow * D + hq * 64 + 4 * hi;
#pragma unroll
        for (int db = 0; db < 2; ++db)
#pragma unroll
            for (int g = 0; g < 4; ++g)
                *(u32x2*)(orow + 32 * db + 8 * g) = (u32x2){cvtpk(oacc[db][4 * g] * inv, oacc[db][4 * g + 1] * inv), cvtpk(oacc[db][4 * g + 2] * inv, oacc[db][4 * g + 3] * inv)};
    }
    __syncthreads();
}
__device__ __forceinline__ void swa_meta(int b, int hq, const bf16_t* __restrict__ qkv, const bf16_t* __restrict__ VT0, const float* __restrict__ sinks, bf16_t* o, int lane) {
    const int qi = lane & 15, part = lane >> 4, kh = hq >> 3; const size_t qrow = (size_t)MREAL + b * 16 + qi;
    float q[16];
#pragma unroll
    for (int c = 0; c < 2; ++c) { float f[8]; unpack8(*(const u32x4*)(qkv + qrow * NQKV + hq * 64 + 16 * part + 8 * c), f);
#pragma unroll
        for (int i = 0; i < 8; ++i) q[8 * c + i] = f[i]; }
    const float sink = sinks[hq];
    float sc[16]; float mx = sink;
#pragma unroll
    for (int jb = 0; jb < 2; ++jb) {
        u32x4 kc[8][2];
#pragma unroll
        for (int jj = 0; jj < 8; ++jj) { const size_t kr = (size_t)MREAL + b * 16 + 8 * jb + jj;
#pragma unroll
            for (int c = 0; c < 2; ++c) kc[jj][c] = *(const u32x4*)(qkv + kr * NQKV + 1024 + kh * 64 + 16 * part + 8 * c); }
#pragma unroll
        for (int jj = 0; jj < 8; ++jj) { const int j = 8 * jb + jj; float s = 0.f;
#pragma unroll
            for (int c = 0; c < 2; ++c) { float f[8]; unpack8(kc[jj][c], f);
#pragma unroll
                for (int i = 0; i < 8; ++i) s += q[8 * c + i] * f[i]; }
            s = xsum16(s); s = xsum32(s);
            sc[j] = j <= qi ? s : -1e30f; mx = fmaxf(mx, sc[j]); }
    }
    float l = __expf(sink - mx);
#pragma unroll
    for (int j = 0; j < 16; ++j) { sc[j] = __expf(sc[j] - mx); l += sc[j]; }
    const float inv = 1.0f / l;
    float res[16];
#pragma unroll
    for (int db = 0; db < 2; ++db) {
        u32x4 vv[8][2];
#pragma unroll
        for (int k = 0; k < 8; ++k) { const int d = 16 * part + 8 * db + k; const bf16_t* vr = VT0 + ((size_t)(b * 2 + kh) * 64 + d) * LP;
            vv[k][0] = *(const u32x4*)vr; vv[k][1] = *(const u32x4*)(vr + 8); }
#pragma unroll
        for (int k = 0; k < 8; ++k) { float e[16]; { float f[8]; unpack8(vv[k][0], f);
#pragma unroll
                for (int i = 0; i < 8; ++i) e[i] = f[i]; unpack8(vv[k][1], f);
#pragma unroll
                for (int i = 0; i < 8; ++i) e[8 + i] = f[i]; }
            float acc = 0.f;
#pragma unroll
            for (int j = 0; j < 16; ++j) acc += sc[j] * e[(j & 3) | ((((j >> 2) & 1) << 1 | ((j >> 3) & 1)) << 2)];
            res[8 * db + k] = acc * inv; }
    }
#pragma unroll
    for (int dd = 0; dd < 16; ++dd) o[qrow * D + hq * 64 + 16 * part + dd] = f2bf(res[dd]);
}
__device__ __forceinline__ void swa_phase(LAS unsigned char* lds, const bf16_t* qkv, const bf16_t* VT0, const float* sinks, bf16_t* o, int bid, int nblk) {
    for (int u = bid; u < 256; u += nblk) {
        const int b = u >> 7, n = (u >> 1) & 63, kh = u & 1;
        swa_unit(lds, b, n, kh, qkv, VT0, sinks, o);
        if (n == 0) swa_meta(b, kh * 8 + (threadIdx.x >> 6), qkv, VT0, sinks, o, threadIdx.x & 63);
    }
}

template <int MOE_MT>
__device__ __forceinline__ void moe_unit(LAS unsigned char* lds, int e, int s0, int ns, const int* __restrict__ list, const bf16_t* __restrict__ hb, const float* __restrict__ rstd,
                                         const float* __restrict__ wslot, const bf16_t* __restrict__ wgu, const bf16_t* __restrict__ wd, bf16_t* ybuf, unsigned long long* tsb = nullptr) {
#define MSTAMP(i) do { if (PROBE_PHASE >= 600 && tsb && blockIdx.x == 0 && threadIdx.x == 0) tsb[i] = __builtin_amdgcn_s_memrealtime(); } while (0)
    MSTAMP(20);
    constexpr int MOE_BM = 16 * MOE_MT, MOE_KT = MOE_BM * 64, ST1 = (MOE_BM + 512) * 64, MOE_ST2 = 32768, MOE_B2A = 4 * MOE_KT, MOE_B2B = 2 * ST1 + 4 * MOE_KT, MOE_INFO = MOE_B2B + MOE_ST2;
    static_assert(MOE_B2A + MOE_ST2 <= 2 * ST1 && 4 * MOE_KT <= ST1 && 3 * ST1 <= MOE_INFO && MOE_INFO + 3072 <= LDS_MISC, "moe lds");
#define moe_hoff(kt) ((kt) < 4 ? (kt) * MOE_KT : 2 * ST1 + ((kt) - 4) * MOE_KT)
    const int tid = otid(), lane = tid & 63, wave = __builtin_amdgcn_readfirstlane(tid >> 6);
    LAS int* slotl = (LAS int*)(lds + MOE_INFO); LAS float* rsl = (LAS float*)(lds + MOE_INFO + 1024); LAS float* wl = (LAS float*)(lds + MOE_INFO + 2048);
    if (tid < MOE_BM) { const int sl = list[(size_t)e * CAP + s0 + (tid < ns ? tid : 0)]; slotl[tid] = sl; rsl[tid] = rstd[sl >> 1]; wl[tid] = wslot[sl]; }
    __syncthreads();
    const int lc4 = (lane & 3) ^ swzF(lane >> 4);
    const int fro32 = (lane & 15) * 64 + (((lane >> 4) ^ swzF((lane >> 2) & 3)) << 4);
    {
        constexpr int ST = ST1;
        const unsigned aoff0 = (unsigned)(slotl[wave * 16 + (lane >> 2)] >> 1) * (unsigned)(D * 2) + lc4 * 16;
        const unsigned aoff1 = (unsigned)(slotl[128 + (lane >> 2)] >> 1) * (unsigned)(D * 2) + lc4 * 16;
        const unsigned boff = (unsigned)(lane >> 2) * (unsigned)(D * 2) + lc4 * 16;
        f32x4 acc[MOE_MT][4];
#pragma unroll
        for (int mi = 0; mi < MOE_MT; ++mi)
#pragma unroll
            for (int ni = 0; ni < 4; ++ni) acc[mi][ni] = (f32x4){0.f, 0.f, 0.f, 0.f};
#define M1_PIECE(i, st, step) do { const int _g = wave + 8 * (i); if (_g < 41) { \
            const char* _base = ((i) == 0 || ((i) == 1 && wave == 0)) ? (const char*)hb : (const char*)wgu + (size_t)(_g - 9) * (16 * D * 2); \
            const unsigned _vo = (i) == 0 ? aoff0 : ((i) == 1 && wave == 0) ? aoff1 : boff; \
            __builtin_amdgcn_global_load_lds((const unsigned*)(_base + (size_t)(step) * 64 + _vo), (LAS unsigned*)(lds + (st) * ST + _g * 1024), 16, 0, 0); } } while (0)
#define M1_STAGE(st, step) do { M1_PIECE(0, st, step); M1_PIECE(1, st, step); M1_PIECE(2, st, step); M1_PIECE(3, st, step); M1_PIECE(4, st, step); M1_PIECE(5, st, step); } while (0)
        asm volatile("s_waitcnt vmcnt(0)" ::: "memory");
        M1_STAGE(0, 0); M1_STAGE(1, 1);
        int st = 0;
        for (int step = 0; step < 32; ++step) {
            if (step + 1 < 32) { if (wave == 0) wait_vm<6>(); else wait_vm<5>(); } else wait_vm<0>();
            __builtin_amdgcn_s_barrier(); asm volatile("" ::: "memory");
            const bool doload = step + 2 < 32;
            const int st2 = st == 0 ? 2 : st - 1;
            LAS const unsigned char* sa = lds + st * ST + fro32;
            LAS const unsigned char* sb = lds + st * ST + (MOE_BM + wave * 64) * 64 + fro32;
            bf16x8 bfr[4];
#pragma unroll
            for (int ni = 0; ni < 4; ++ni) bfr[ni] = *(LAS const bf16x8*)(sb + ni * 1024);
            bf16x8 afc[3], afn[3];
#pragma unroll
            for (int i = 0; i < 3; ++i) afc[i] = *(LAS const bf16x8*)(sa + i * 1024);
#pragma unroll
            for (int pg = 0; pg < 3; ++pg) {
                if (doload) { if (pg == 0) { M1_PIECE(0, st2, step + 2); M1_PIECE(1, st2, step + 2); } else if (pg == 1) { M1_PIECE(2, st2, step + 2); M1_PIECE(3, st2, step + 2); }
                              else { M1_PIECE(4, st2, step + 2); M1_PIECE(5, st2, step + 2); } }
                if (pg + 1 < 3) {
#pragma unroll
                    for (int i = 0; i < 3; ++i) afn[i] = *(LAS const bf16x8*)(sa + ((pg + 1) * 3 + i) * 1024);
                }
#pragma unroll
                for (int i = 0; i < 3; ++i) { const int mi = pg * 3 + i;
#pragma unroll
                    for (int ni = 0; ni < 4; ++ni) acc[mi][ni] = __builtin_amdgcn_mfma_f32_16x16x32_bf16(bfr[ni], afc[i], acc[mi][ni], 0, 0, 0); }
#pragma unroll
                for (int i = 0; i < 3; ++i) afc[i] = afn[i];
                __builtin_amdgcn_sched_barrier(0);
            }
            st = st == 2 ? 0 : st + 1;
        }
#undef M1_STAGE
#undef M1_PIECE
        int lane_h = threadIdx.x & 63; asm volatile("" : "+v"(lane_h));
#define lane lane_h
#pragma unroll
        for (int p = 0; p < 2; ++p) {
            const int n = 32 * wave + 16 * p + (lane >> 4) * 4;
            const int csw = ((n & 31) >> 3);
#pragma unroll
            for (int mi = 0; mi < MOE_MT; ++mi) { const int row = mi * 16 + (lane & 15); const float rs = rsl[row]; float hv[4];
#pragma unroll
                for (int r = 0; r < 4; ++r) { const float g = acc[mi][2 * p][r] * rs, u = acc[mi][2 * p + 1][r] * rs; hv[r] = g * __builtin_amdgcn_rcpf(1.0f + __expf(-g)) * u; }
                *(LAS u32x2*)(lds + moe_hoff(n >> 5) + row * 64 + ((csw ^ swzF((row >> 2) & 3)) << 4) + (n & 4) * 2) = (u32x2){pk2(hv[0], hv[1]), pk2(hv[2], hv[3])}; }
        }
#undef lane
    }
    __syncthreads();
    MSTAMP(21);
    {
        const char* src2[4];
#pragma unroll
        for (int i = 0; i < 4; ++i) src2[i] = (const char*)(wd + (size_t)((wave + 8 * i) * 16 + (lane >> 2)) * DE) + lc4 * 16;
        f32x4 acc[MOE_MT][4];
#pragma unroll
        for (int mi = 0; mi < MOE_MT; ++mi)
#pragma unroll
            for (int ni = 0; ni < 4; ++ni) acc[mi][ni] = (f32x4){0.f, 0.f, 0.f, 0.f};
#define M2_STAGE(st, q) do { _Pragma("unroll") for (int _i = 0; _i < 4; ++_i) \
        __builtin_amdgcn_global_load_lds((const unsigned*)(src2[_i] + (size_t)((q) >> 3) * (512 * 512) + (size_t)((q) & 7) * 64), (LAS unsigned*)(lds + ((st) ? MOE_B2B : MOE_B2A) + (wave + 8 * _i) * 1024), 16, 0, 0); } while (0)
        M2_STAGE(0, 0);
        for (int q = 0; q < 16; ++q) {
            asm volatile("s_waitcnt vmcnt(0)" ::: "memory");
            __syncthreads();
            if (q + 1 < 16) M2_STAGE((q + 1) & 1, q + 1);
            LAS const unsigned char* sa = lds + moe_hoff(q & 7) + fro32;
            LAS const unsigned char* sb = lds + ((q & 1) ? MOE_B2B : MOE_B2A) + (wave * 64) * 64 + fro32;
            bf16x8 bfr[4];
#pragma unroll
            for (int ni = 0; ni < 4; ++ni) bfr[ni] = *(LAS const bf16x8*)(sb + ni * 1024);
#pragma unroll
            for (int mi = 0; mi < MOE_MT; ++mi) { const bf16x8 af = *(LAS const bf16x8*)(sa + mi * 1024);
#pragma unroll
                for (int ni = 0; ni < 4; ++ni) acc[mi][ni] = __builtin_amdgcn_mfma_f32_16x16x32_bf16(bfr[ni], af, acc[mi][ni], 0, 0, 0); }
            if ((q & 7) == 7) {
                int lane_y = threadIdx.x & 63; asm volatile("" : "+v"(lane_y));
                const int cb = (q >> 3) * 512 + wave * 64 + (lane_y >> 4) * 4;
#pragma unroll
                for (int mi = 0; mi < MOE_MT; ++mi) { const int row = mi * 16 + (lane_y & 15);
                    if (row < ns) { const float w = wl[row]; bf16_t* yr = ybuf + (size_t)slotl[row] * D + cb;
#pragma unroll
                        for (int ni = 0; ni < 4; ++ni) { const f32x4 v = acc[mi][ni] * w; *(u32x2*)(yr + ni * 16) = (u32x2){pk2(v[0], v[1]), pk2(v[2], v[3])}; } }
#pragma unroll
                    for (int ni = 0; ni < 4; ++ni) acc[mi][ni] = (f32x4){0.f, 0.f, 0.f, 0.f}; }
            }
        }
#undef M2_STAGE
    }
#undef moe_hoff
    __syncthreads();
    MSTAMP(22);
#undef MSTAMP
}
__device__ __forceinline__ void moe_phase(LAS unsigned char* lds, int* cnt, const int* list, const bf16_t* hb, const float* rstd, const float* wslot, const bf16_t* wgu, const bf16_t* wd, bf16_t* ybuf, int bid, int nblk, unsigned long long* tsb = nullptr) {
    const bool grp = (nblk % 8) == 0;
    int ntile[NE]; int gsum = 0; bool fit = grp;
#pragma unroll
    for (int e = 0; e < NE; ++e) { const int c = __hip_atomic_load(cnt + e * 64, __ATOMIC_RELAXED, __HIP_MEMORY_SCOPE_AGENT); const int bm = 144; ntile[e] = (c + bm - 1) / bm;
        gsum = (e & 3) == 0 ? ntile[e] : gsum + ntile[e]; if ((e & 3) == 3 && gsum > nblk / 8) fit = false; }
    const int x = bid % 8;
    int u = fit ? bid / 8 : (grp ? x * (nblk / 8) + bid / 8 : bid), base = 0;
    const int stride = fit ? nblk / 8 : nblk;
#pragma unroll 1
    for (int e = 0; e < NE; ++e) {
        if (fit && (e >> 2) != x) continue;
        const int c = __hip_atomic_load(cnt + e * 64, __ATOMIC_RELAXED, __HIP_MEMORY_SCOPE_AGENT);
        const bool big = false; const int bm = 144, nt = (c + bm - 1) / bm;
        while (u < base + nt) { const int t = u - base; const int ns = c - t * bm < bm ? c - t * bm : bm;
            moe_unit<9>(lds, e, t * bm, ns, list, hb, rstd, wslot, wgu + (size_t)e * 512 * 1024, wd + (size_t)e * 1024 * 256, ybuf, tsb);
            u += stride; }
        base += nt;
    }
}

template <int MT>
__device__ __forceinline__ void l1proj_unit(LAS unsigned char* lds, int row0, int mrow0, bf16_t* hb, const bf16_t* __restrict__ ybuf, const bf16_t* __restrict__ win_t, const bf16_t* __restrict__ wuq_t,
                                            const bf16_t* __restrict__ wukv_t, const float2* __restrict__ cs, bf16_t* kpe, bf16_t* Q1, bf16_t* K1, bf16_t* VT1) {
    constexpr int BM = 16 * MT, STW = (BM + 512) * 64, KT = BM * 64  , CQN = 0, CKV = 8 * KT, RB = 12 * KT, STB = 32768, PART = 3 * STW;
    static_assert(RB + 3 * STB <= LDS_MISC && PART + 8 * BM * 4 <= LDS_MISC, "l1proj lds");
    const int tid = otid(), lane = tid & 63, wave = __builtin_amdgcn_readfirstlane(tid >> 6);
    LAS float* rsl = (LAS float*)(lds + LDS_MISC + 256);
#define L1_GROW(r) ((r) < 64 ? row0 + (r) : mrow0 + (r) - 64)
    for (int r = wave; r < BM; r += NWAVE) {
        const size_t grow = L1_GROW(r); float ss = 0.f;
#pragma unroll
        for (int j = 0; j < 4; ++j) { const size_t c = j * 256 + lane * 4;
            const u32x2 h = *(const u32x2*)(hb + grow * D + c), y0 = *(const u32x2*)(ybuf + (grow * 2) * D + c), y1 = *(const u32x2*)(ybuf + (grow * 2 + 1) * D + c);
            float v[4];
            v[0] = __uint_as_float(h.x << 16) + __uint_as_float(y0.x << 16) + __uint_as_float(y1.x << 16);
            v[1] = __uint_as_float(h.x & 0xffff0000u) + __uint_as_float(y0.x & 0xffff0000u) + __uint_as_float(y1.x & 0xffff0000u);
            v[2] = __uint_as_float(h.y << 16) + __uint_as_float(y0.y << 16) + __uint_as_float(y1.y << 16);
            v[3] = __uint_as_float(h.y & 0xffff0000u) + __uint_as_float(y0.y & 0xffff0000u) + __uint_as_float(y1.y & 0xffff0000u);
            ss += v[0] * v[0] + v[1] * v[1] + v[2] * v[2] + v[3] * v[3];
            *(u32x2*)(hb + grow * D + c) = (u32x2){pk2(v[0], v[1]), pk2(v[2], v[3])}; }
        ss = wave_sum(ss); if (lane == 0) rsl[r] = rsqrtf(ss * (1.0f / D) + EPS);
    }
    asm volatile("s_waitcnt vmcnt(0)" ::: "memory");
    __syncthreads();
    const int lc = (lane & 3) ^ swzF(lane >> 4);
    const int fro = (lane & 15) * 64 + (((lane >> 4) ^ swzF((lane >> 2) & 3)) << 4);
    f32x4 acc[MT][4];
#pragma unroll
    for (int mi = 0; mi < MT; ++mi)
#pragma unroll
        for (int ni = 0; ni < 4; ++ni) acc[mi][ni] = (f32x4){0.f, 0.f, 0.f, 0.f};
    {
        const char* srcb[4];
#pragma unroll
        for (int i = 0; i < 4; ++i) srcb[i] = (const char*)(win_t + (size_t)((wave + 8 * i) * 16 + (lane >> 2)) * D) + lc * 16;
        const char* srca = (const char*)(hb + (size_t)L1_GROW((wave < MT ? wave : 0) * 16 + (lane >> 2)) * D) + lc * 16;
#define W_ISSUE(st, kt) do { if (wave < MT) __builtin_amdgcn_global_load_lds((const unsigned*)(srca + (size_t)(kt) * 64), (LAS unsigned*)(lds + (st) * STW + wave * 1024), 16, 0, 16); \
        _Pragma("unroll") for (int _i = 0; _i < 4; ++_i) if (_i < 3 || wave < 2)   \
            __builtin_amdgcn_global_load_lds((const unsigned*)(srcb[_i] + (size_t)(kt) * 64), (LAS unsigned*)(lds + (st) * STW + (MT + wave + 8 * _i) * 1024), 16, 0, 0); } while (0)
        W_ISSUE(0, 0); W_ISSUE(1, 1);
        int st = 0;
        const int npw = (wave < MT ? 1 : 0) + (wave < 2 ? 4 : 3);
        for (int kt = 0; kt < 32; ++kt) {
            if (kt + 1 < 32) { if (npw == 5) wait_vm<5>(); else if (npw == 4) wait_vm<4>(); else wait_vm<3>(); } else wait_vm<0>();
            __builtin_amdgcn_s_barrier(); asm volatile("" ::: "memory");
            if (kt + 2 < 32) W_ISSUE(st == 0 ? 2 : st - 1, kt + 2);
            LAS const unsigned char* sa = lds + st * STW + fro;
            LAS const unsigned char* sb = lds + st * STW + (BM + wave * 64) * 64 + fro;
            bf16x8 bfr[4];
#pragma unroll
            for (int ni = 0; ni < 4; ++ni) bfr[ni] = *(LAS const bf16x8*)(sb + ni * 1024);
            if (wave < 7) {
#pragma unroll
            for (int mi = 0; mi < MT; ++mi) { const bf16x8 af = *(LAS const bf16x8*)(sa + mi * 1024);
#pragma unroll
                for (int ni = 0; ni < 4; ++ni) acc[mi][ni] = __builtin_amdgcn_mfma_f32_16x16x32_bf16(bfr[ni], af, acc[mi][ni], 0, 0, 0); } }
            st = st == 2 ? 0 : st + 1;
        }
#undef W_ISSUE
    }
    asm volatile("s_waitcnt lgkmcnt(0)" ::: "memory");
    __syncthreads();
    LAS float* part = (LAS float*)(lds + PART);
    int lane_e = lane; asm volatile("" : "+v"(lane_e));
#define lane lane_e
#pragma unroll
    for (int mi = 0; mi < MT; ++mi) { const float rs = rsl[mi * 16 + (lane & 15)]; float ss = 0.f;
#pragma unroll
        for (int ni = 0; ni < 4; ++ni) { acc[mi][ni] = acc[mi][ni] * rs; ss += acc[mi][ni][0] * acc[mi][ni][0] + acc[mi][ni][1] * acc[mi][ni][1] + acc[mi][ni][2] * acc[mi][ni][2] + acc[mi][ni][3] * acc[mi][ni][3]; }
        ss = xsum16(ss); ss = xsum32(ss);
        if (lane < 16) part[wave * BM + mi * 16 + lane] = ss; }
    __syncthreads();
    if (wave < 6) {
#pragma unroll
        for (int mi = 0; mi < MT; ++mi) { const int row = mi * 16 + (lane & 15);
            const float tot = wave < 4 ? (part[row] + part[BM + row]) + (part[2 * BM + row] + part[3 * BM + row]) : part[4 * BM + row] + part[5 * BM + row];
            const float rn = rsqrtf(tot * (wave < 4 ? 1.0f / 256 : 1.0f / 128) + EPS);
#pragma unroll
            for (int ni = 0; ni < 4; ++ni) { const int cc = (wave < 4 ? 64 * wave : 64 * (wave - 4)) + ni * 16 + (lane >> 4) * 4; const f32x4 v = acc[mi][ni] * rn;
                *(LAS u32x2*)(lds + (wave < 4 ? CQN : CKV) + (cc >> 5) * KT + row * 64 + (((((cc & 31) >> 3)) ^ swzF((row >> 2) & 3)) << 4) + (cc & 4) * 2) = (u32x2){pk2(v[0], v[1]), pk2(v[2], v[3])}; } }
    } else if (wave == 6) {
#pragma unroll
        for (int mi = 0; mi < MT; ++mi) { const int row = mi * 16 + (lane & 15); const int grow = L1_GROW(row); const int pos = row_pos(grow), d0 = (lane >> 4) * 4;
            f32x4 o1, o2;
#pragma unroll
            for (int r = 0; r < 4; ++r) { const float2 t = cs[pos * 32 + 2 * (d0 + r)]; const float x1 = acc[mi][0][r], x2 = acc[mi][1][r]; o1[r] = x1 * t.x - x2 * t.y; o2[r] = x2 * t.x + x1 * t.y; }
            bf16_t* kr = kpe + ((size_t)row_batch(grow) * LP + pos) * 32;
            *(u32x2*)(kr + d0) = (u32x2){pk2(o1[0], o1[1]), pk2(o1[2], o1[3])}; *(u32x2*)(kr + 16 + d0) = (u32x2){pk2(o2[0], o2[1]), pk2(o2[2], o2[3])}; }
    }
#undef lane
    __syncthreads();
    const char* srcu[4];
#define U_ISSUE(st, base, pitchB, chunk, kt) do { _Pragma("unroll") for (int _i = 0; _i < 4; ++_i) \
        __builtin_amdgcn_global_load_lds((const unsigned*)(srcu[_i] + (size_t)(chunk) * 512 * (pitchB) + (size_t)(kt) * 64), (LAS unsigned*)(lds + RB + (st) * STB + (wave + 8 * _i) * 1024), 16, 0, 0); } while (0)
    {
#pragma unroll
        for (int i = 0; i < 4; ++i) srcu[i] = (const char*)(wuq_t + (size_t)((wave + 8 * i) * 16 + (lane >> 2)) * 256) + lc * 16;
#pragma unroll
        for (int mi = 0; mi < MT; ++mi)
#pragma unroll
            for (int ni = 0; ni < 4; ++ni) acc[mi][ni] = (f32x4){0.f, 0.f, 0.f, 0.f};
        U_ISSUE(0, 0, 512, 0, 0); U_ISSUE(1, 0, 512, 0, 1);
        int st = 0;
        for (int q = 0; q < 24; ++q) {
            if (q + 1 < 24) wait_vm<4>(); else wait_vm<0>();
            __builtin_amdgcn_s_barrier(); asm volatile("" ::: "memory");
            if (q + 2 < 24) U_ISSUE(st == 0 ? 2 : st - 1, 0, 512, (q + 2) >> 3, (q + 2) & 7);
            LAS const unsigned char* sa = lds + CQN + (q & 7) * KT + fro;
            LAS const unsigned char* sb = lds + RB + st * STB + (wave * 64) * 64 + fro;
            bf16x8 bfr[4];
#pragma unroll
            for (int ni = 0; ni < 4; ++ni) bfr[ni] = *(LAS const bf16x8*)(sb + ni * 1024);
#pragma unroll
            for (int mi = 0; mi < MT; ++mi) { const bf16x8 af = *(LAS const bf16x8*)(sa + mi * 1024);
#pragma unroll
                for (int ni = 0; ni < 4; ++ni) acc[mi][ni] = __builtin_amdgcn_mfma_f32_16x16x32_bf16(bfr[ni], af, acc[mi][ni], 0, 0, 0); }
            if ((q & 7) == 7) {
                int lane_q = lane; asm volatile("" : "+v"(lane_q));
#define lane lane_q
                const float scale = 0.10206207261596577f * 1.4426950408889634f; const int d0 = (lane >> 4) * 4;
#pragma unroll
                for (int mi = 0; mi < MT; ++mi) { const int grow = L1_GROW(mi * 16 + (lane & 15)); const int pos = row_pos(grow);
#pragma unroll
                    for (int bi = 0; bi < 2; ++bi) { const int gc = (q >> 3) * 512 + 64 * wave + bi * 32; bf16_t* orow = Q1 + (size_t)grow * 1536 + gc;
                        f32x4 v1 = acc[mi][2 * bi], v2 = acc[mi][2 * bi + 1];
                        if (((gc >> 5) % 3) == 2) {
#pragma unroll
                            for (int r = 0; r < 4; ++r) { const float2 t = cs[pos * 32 + 2 * (d0 + r)]; const float x1 = v1[r], x2 = v2[r]; v1[r] = x1 * t.x - x2 * t.y; v2[r] = x2 * t.x + x1 * t.y; } }
                        v1 = v1 * scale; v2 = v2 * scale;
                        *(u32x2*)(orow + d0) = (u32x2){pk2(v1[0], v1[1]), pk2(v1[2], v1[3])}; *(u32x2*)(orow + 16 + d0) = (u32x2){pk2(v2[0], v2[1]), pk2(v2[2], v2[3])}; }
#pragma unroll
                    for (int ni = 0; ni < 4; ++ni) acc[mi][ni] = (f32x4){0.f, 0.f, 0.f, 0.f}; }
#undef lane
            }
            st = st == 2 ? 0 : st + 1;
        }
    }
    asm volatile("s_waitcnt lgkmcnt(0)" ::: "memory");
    __syncthreads();
    {
#pragma unroll
        for (int i = 0; i < 4; ++i) srcu[i] = (const char*)(wukv_t + (size_t)((wave + 8 * i) * 16 + (lane >> 2)) * 128) + lc * 16;
#pragma unroll
        for (int mi = 0; mi < MT; ++mi)
#pragma unroll
            for (int ni = 0; ni < 4; ++ni) acc[mi][ni] = (f32x4){0.f, 0.f, 0.f, 0.f};
        U_ISSUE(0, 0, 256, 0, 0); U_ISSUE(1, 0, 256, 0, 1);
        int st = 0;
        for (int q = 0; q < 16; ++q) {
            if (q + 1 < 16) wait_vm<4>(); else wait_vm<0>();
            __builtin_amdgcn_s_barrier(); asm volatile("" ::: "memory");
            if (q + 2 < 16) U_ISSUE(st == 0 ? 2 : st - 1, 0, 256, (q + 2) >> 2, (q + 2) & 3);
            LAS const unsigned char* sa = lds + CKV + (q & 3) * KT + fro;
            LAS const unsigned char* sb = lds + RB + st * STB + (wave * 64) * 64 + fro;
            bf16x8 bfr[4];
#pragma unroll
            for (int ni = 0; ni < 4; ++ni) bfr[ni] = *(LAS const bf16x8*)(sb + ni * 1024);
            if (q < 8) {
#pragma unroll
                for (int mi = 0; mi < MT; ++mi) { const bf16x8 af = *(LAS const bf16x8*)(sa + mi * 1024);
#pragma unroll
                    for (int ni = 0; ni < 4; ++ni) acc[mi][ni] = __builtin_amdgcn_mfma_f32_16x16x32_bf16(bfr[ni], af, acc[mi][ni], 0, 0, 0); }
            } else {
#pragma unroll
                for (int mi = 0; mi < MT; ++mi) { const bf16x8 af = *(LAS const bf16x8*)(sa + mi * 1024);
#pragma unroll
                    for (int ni = 0; ni < 4; ++ni) acc[mi][ni] = __builtin_amdgcn_mfma_f32_16x16x32_bf16(af, bfr[ni], acc[mi][ni], 0, 0, 0); }
            }
            if ((q & 3) == 3) {
                const int ch = q >> 2;
                int lane_k = lane; asm volatile("" : "+v"(lane_k));
#define lane lane_k
                if (ch < 2) {
#pragma unroll
                    for (int mi = 0; mi < MT; ++mi) { const int grow = L1_GROW(mi * 16 + (lane & 15)); const size_t kr = (size_t)row_batch(grow) * LP + row_pos(grow);
#pragma unroll
                        for (int ni = 0; ni < 4; ++ni) { const f32x4 v = acc[mi][ni];
                            *(u32x2*)(K1 + kr * D + 512 * ch + 64 * wave + ni * 16 + (lane >> 4) * 4) = (u32x2){pk2(v[0], v[1]), pk2(v[2], v[3])}; acc[mi][ni] = (f32x4){0.f, 0.f, 0.f, 0.f}; } }
                } else {
#pragma unroll
                    for (int mi = 0; mi < MT; ++mi) { const int grow0 = L1_GROW(mi * 16 + (lane >> 4) * 4); const int b = row_batch(grow0), pp = perm16(row_pos(grow0));
#pragma unroll
                        for (int ni = 0; ni < 4; ++ni) { const int hd = 512 * (ch - 2) + 64 * wave + ni * 16 + (lane & 15); const f32x4 v = acc[mi][ni];
                            *(u32x2*)(VT1 + (size_t)(b * 1024 + hd) * LP + pp) = (u32x2){pk2(v[0], v[1]), pk2(v[2], v[3])}; acc[mi][ni] = (f32x4){0.f, 0.f, 0.f, 0.f}; } }
                }
#undef lane
            }
            st = st == 2 ? 0 : st + 1;
        }
    }
#undef U_ISSUE
#undef L1_GROW
    asm volatile("s_waitcnt lgkmcnt(0)" ::: "memory");
    __syncthreads();
}
constexpr size_t WS_PAIR = 128 * 1024;
#define L1P_GROW(r) ((r) < 128 ? row0 + (r) : mrow0 + (r) - 128)
template <int MT>
__device__ __forceinline__ void l1p_win(LAS unsigned char* lds, int row0, int mrow0, const bf16_t* hb, const bf16_t* __restrict__ win_t, int wrow0, int nbrows, f32x4 (&acc)[MT][2], int lane, int wave) {
    constexpr int BM = 16 * MT, STW = (BM + 256) * 64, G = MT + 16, NG = (G + 7) / 8;
    const int lc = (lane & 3) ^ swzF(lane >> 4);
    const int fro = (lane & 15) * 64 + (((lane >> 4) ^ swzF((lane >> 2) & 3)) << 4);
    const char* src[NG]; int npw = 0;
#pragma unroll
    for (int i = 0; i < NG; ++i) { const int g = wave + 8 * i;
        if (g < MT) { src[i] = (const char*)(hb + (size_t)L1P_GROW(g * 16 + (lane >> 2)) * D) + lc * 16; ++npw; }
        else if (g < G && 16 * (g - MT) < nbrows) { src[i] = (const char*)(win_t + (size_t)(wrow0 + (g - MT) * 16 + (lane >> 2)) * D) + lc * 16; ++npw; }
        else src[i] = nullptr; }
#define WP_ISSUE(st, k2) do { _Pragma("unroll") for (int _h = 0; _h < 2; ++_h) { _Pragma("unroll") for (int _i = 0; _i < NG; ++_i) { const int _g = wave + 8 * _i; \
        if (_g < MT) __builtin_amdgcn_global_load_lds((const unsigned*)(src[_i] + (size_t)(2 * (k2) + _h) * 64), (LAS unsigned*)(lds + ((st) * 2 + _h) * STW + _g * 1024), 16, 0, 16); \
        else if (_g < G && 16 * (_g - MT) < nbrows) __builtin_amdgcn_global_load_lds((const unsigned*)(src[_i] + (size_t)(2 * (k2) + _h) * 64), (LAS unsigned*)(lds + ((st) * 2 + _h) * STW + _g * 1024), 16, 0, 0); } } } while (0)
    const bool active = 32 * wave < nbrows;
    WP_ISSUE(0, 0); WP_ISSUE(1, 1);
    int st = 0;
    for (int k2 = 0; k2 < 16; ++k2) {
        if (k2 + 1 < 16) { if (npw == 4) wait_vm<8>(); else if (npw == 3) wait_vm<6>(); else if (npw == 2) wait_vm<4>(); else wait_vm<2>(); } else wait_vm<0>();
        __builtin_amdgcn_s_barrier(); asm volatile("" ::: "memory");
        if (k2 + 2 < 16) WP_ISSUE(st == 0 ? 2 : st - 1, k2 + 2);
        if (active) {
#pragma unroll
            for (int hf = 0; hf < 2; ++hf) {
                LAS const unsigned char* sa = lds + (st * 2 + hf) * STW + fro;
                LAS const unsigned char* sb = lds + (st * 2 + hf) * STW + (BM + wave * 32) * 64 + fro;
                const bf16x8 b0 = *(LAS const bf16x8*)sb, b1 = *(LAS const bf16x8*)(sb + 1024);
#pragma unroll
                for (int mi = 0; mi < MT; ++mi) { const bf16x8 af = *(LAS const bf16x8*)(sa + mi * 1024);
                    acc[mi][0] = __builtin_amdgcn_mfma_f32_16x16x32_bf16(b0, af, acc[mi][0], 0, 0, 0); acc[mi][1] = __builtin_amdgcn_mfma_f32_16x16x32_bf16(b1, af, acc[mi][1], 0, 0, 0); }
            }
        }
        st = st == 2 ? 0 : st + 1;
    }
#undef WP_ISSUE
    asm volatile("s_waitcnt lgkmcnt(0)" ::: "memory");
    __syncthreads();
}
__device__ __forceinline__ void l1p_combine(int rbeg, int rend, int row0, int mrow0, bf16_t* hb, const bf16_t* __restrict__ ybuf, float* rstd_g, int lane, int wave) {
    u32x2 nh[4], ny0[4], ny1[4];
    { const int r = rbeg + wave; if (r < rend) { const size_t g0 = L1P_GROW(r);
#pragma unroll
        for (int j = 0; j < 4; ++j) { const size_t c = j * 256 + lane * 4; nh[j] = *(const u32x2*)(hb + g0 * D + c); ny0[j] = *(const u32x2*)(ybuf + (g0 * 2) * D + c); ny1[j] = *(const u32x2*)(ybuf + (g0 * 2 + 1) * D + c); } } }
    for (int r = rbeg + wave; r < rend; r += NWAVE) {
        const size_t grow = L1P_GROW(r); float ss = 0.f;
        u32x2 ch[4], cy0[4], cy1[4];
#pragma unroll
        for (int j = 0; j < 4; ++j) { ch[j] = nh[j]; cy0[j] = ny0[j]; cy1[j] = ny1[j]; }
        if (r + NWAVE < rend) { const size_t gn = L1P_GROW(r + NWAVE);
#pragma unroll
            for (int j = 0; j < 4; ++j) { const size_t c = j * 256 + lane * 4; nh[j] = *(const u32x2*)(hb + gn * D + c); ny0[j] = *(const u32x2*)(ybuf + (gn * 2) * D + c); ny1[j] = *(const u32x2*)(ybuf + (gn * 2 + 1) * D + c); } }
#pragma unroll
        for (int j = 0; j < 4; ++j) { const size_t c = j * 256 + lane * 4; const u32x2 h = ch[j], y0 = cy0[j], y1 = cy1[j];
            float v[4];
            v[0] = __uint_as_float(h.x << 16) + __uint_as_float(y0.x << 16) + __uint_as_float(y1.x << 16);
            v[1] = __uint_as_float(h.x & 0xffff0000u) + __uint_as_float(y0.x & 0xffff0000u) + __uint_as_float(y1.x & 0xffff0000u);
            v[2] = __uint_as_float(h.y << 16) + __uint_as_float(y0.y << 16) + __uint_as_float(y1.y << 16);
            v[3] = __uint_as_float(h.y & 0xffff0000u) + __uint_as_float(y0.y & 0xffff0000u) + __uint_as_float(y1.y & 0xffff0000u);
            ss += v[0] * v[0] + v[1] * v[1] + v[2] * v[2] + v[3] * v[3];
            *(u32x2*)(hb + grow * D + c) = (u32x2){pk2(v[0], v[1]), pk2(v[2], v[3])}; }
        ss = wave_sum(ss); if (lane == 0) rstd_g[grow] = rsqrtf(ss * (1.0f / D) + EPS);
    }
}
__device__ __forceinline__ void l1p_exchange(unsigned* myflag, unsigned* otherflag, int BM, int row0, int mrow0, const float* rstd_g, LAS float* rsl, int tid) {
    asm volatile("s_waitcnt vmcnt(0)" ::: "memory");
    __syncthreads();
    if (tid == 0) { __hip_atomic_store(myflag, 1u, __ATOMIC_RELEASE, __HIP_MEMORY_SCOPE_AGENT);
        unsigned spins = 0; while (__hip_atomic_load(otherflag, __ATOMIC_RELAXED, __HIP_MEMORY_SCOPE_AGENT) == 0u && ++spins < (1u << 26)) __builtin_amdgcn_s_sleep(1);
        __builtin_amdgcn_fence(__ATOMIC_ACQUIRE, "agent"); }
    __syncthreads();
    if (tid < BM) rsl[tid] = __builtin_nontemporal_load(rstd_g + L1P_GROW(tid));
    __syncthreads();
}
template <int MT>
__device__ __forceinline__ void l1p_q_unit(LAS unsigned char* lds, int row0, int mrow0, bf16_t* hb, const bf16_t* __restrict__ ybuf, float* rstd_g, const bf16_t* __restrict__ win_t,
                                           const bf16_t* __restrict__ wuq_t, const float2* __restrict__ cs, bf16_t* Q1, unsigned* flag) {
    constexpr int BM = 16 * MT, STW = (BM + 256) * 64, KT = BM * 64, CQN = 0, PART = 6 * STW, RBQ = 81920, STQ = 24576;
    static_assert(8 * KT <= RBQ && PART + 8 * BM * 4 <= LDS_MISC && RBQ + 3 * STQ <= LDS_MISC, "l1p q lds");
    const int tid = otid(), lane = tid & 63, wave = __builtin_amdgcn_readfirstlane(tid >> 6);
    LAS float* rsl = (LAS float*)(lds + LDS_MISC + 256);
    l1p_combine(0, 64, row0, mrow0, hb, ybuf, rstd_g, lane, wave);
    if (MT > 8) l1p_combine(128, BM, row0, mrow0, hb, ybuf, rstd_g, lane, wave);
    l1p_exchange(flag, flag + 1, BM, row0, mrow0, rstd_g, rsl, tid);
    const int fro = (lane & 15) * 64 + (((lane >> 4) ^ swzF((lane >> 2) & 3)) << 4);
    f32x4 acc[MT][2];
#pragma unroll
    for (int mi = 0; mi < MT; ++mi) { acc[mi][0] = (f32x4){0.f, 0.f, 0.f, 0.f}; acc[mi][1] = (f32x4){0.f, 0.f, 0.f, 0.f}; }
    l1p_win<MT>(lds, row0, mrow0, hb, win_t, 0, 256, acc, lane, wave);
    LAS float* part = (LAS float*)(lds + PART);
#pragma unroll
    for (int mi = 0; mi < MT; ++mi) { const float rs = rsl[mi * 16 + (lane & 15)]; float ss = 0.f;
#pragma unroll
        for (int ni = 0; ni < 2; ++ni) { acc[mi][ni] = acc[mi][ni] * rs; ss += acc[mi][ni][0] * acc[mi][ni][0] + acc[mi][ni][1] * acc[mi][ni][1] + acc[mi][ni][2] * acc[mi][ni][2] + acc[mi][ni][3] * acc[mi][ni][3]; }
        ss = xsum16(ss); ss = xsum32(ss);
        if (lane < 16) part[wave * BM + mi * 16 + lane] = ss; }
    __syncthreads();
#pragma unroll
    for (int mi = 0; mi < MT; ++mi) { const int row = mi * 16 + (lane & 15);
        const float tot = ((part[row] + part[BM + row]) + (part[2 * BM + row] + part[3 * BM + row])) + ((part[4 * BM + row] + part[5 * BM + row]) + (part[6 * BM + row] + part[7 * BM + row]));
        const float rn = rsqrtf(tot * (1.0f / 256) + EPS);
#pragma unroll
        for (int ni = 0; ni < 2; ++ni) { const int cc = 32 * wave + ni * 16 + (lane >> 4) * 4; const f32x4 v = acc[mi][ni] * rn;
            *(LAS u32x2*)(lds + CQN + (cc >> 5) * KT + row * 64 + (((((cc & 31) >> 3)) ^ swzF((row >> 2) & 3)) << 4) + (cc & 4) * 2) = (u32x2){pk2(v[0], v[1]), pk2(v[2], v[3])}; } }
    __syncthreads();
    constexpr int TQA = 8 * KT, TQB = RBQ + 3 * STQ, TQ_ROWS = MT == 8 ? 128 : 112;
    static_assert(MT == 8 ? TQA + 128 * 128 <= RBQ : (TQA + 64 * 128 <= RBQ && TQB + 48 * 128 <= LDS_MISC), "rope table lds");
    typedef float lf2 __attribute__((ext_vector_type(2)));
#define TQ_ADDR(r) (MT == 8 ? TQA + (r) * 128 : ((r) < 64 ? TQA + (r) * 128 : TQB + ((r) - 64) * 128))
    { const int r = tid >> 2, part = tid & 3;
      if (r < TQ_ROWS) { const int pos = row_pos(L1P_GROW(r));
        float2 tv[4];
#pragma unroll
        for (int rr = 0; rr < 4; ++rr) tv[rr] = cs[pos * 32 + 2 * (4 * part + rr)];
        LAS lf2* tq = (LAS lf2*)(lds + TQ_ADDR(r)) + 4 * part;
#pragma unroll
        for (int rr = 0; rr < 4; ++rr) tq[rr] = (lf2){tv[rr].x, tv[rr].y}; } }
    {
        const int lc = (lane & 3) ^ swzF(lane >> 4);
        const char* srcq[3];
#pragma unroll
        for (int i = 0; i < 3; ++i) srcq[i] = (const char*)(wuq_t + (size_t)((wave + 8 * i) * 16 + (lane >> 2)) * 256) + lc * 16;
#define Q_ISSUE(st, chunk, kt) do { _Pragma("unroll") for (int _i = 0; _i < 3; ++_i) \
        __builtin_amdgcn_global_load_lds((const unsigned*)(srcq[_i] + (size_t)(chunk) * 384 * 512 + (size_t)(kt) * 64), (LAS unsigned*)(lds + RBQ + (st) * STQ + (wave + 8 * _i) * 1024), 16, 0, 0); } while (0)
        f32x4 aq[MT][3];
#pragma unroll
        for (int mi = 0; mi < MT; ++mi) { aq[mi][0] = (f32x4){0.f, 0.f, 0.f, 0.f}; aq[mi][1] = (f32x4){0.f, 0.f, 0.f, 0.f}; aq[mi][2] = (f32x4){0.f, 0.f, 0.f, 0.f}; }
        Q_ISSUE(0, 0, 0); Q_ISSUE(1, 0, 1);
        int st = 0;
        for (int q = 0; q < 32; ++q) {
            if (q + 1 < 32) wait_vm<3>(); else wait_vm<0>();
            __builtin_amdgcn_s_barrier(); asm volatile("" ::: "memory");
            if (q + 2 < 32) Q_ISSUE(st == 0 ? 2 : st - 1, (q + 2) >> 3, (q + 2) & 7);
            LAS const unsigned char* sa = lds + CQN + (q & 7) * KT + fro;
            LAS const unsigned char* sb = lds + RBQ + st * STQ + (wave * 48) * 64 + fro;
            const bf16x8 b0 = *(LAS const bf16x8*)sb, b1 = *(LAS const bf16x8*)(sb + 1024), b2 = *(LAS const bf16x8*)(sb + 2048);
#pragma unroll
            for (int mi = 0; mi < MT; ++mi) { const bf16x8 af = *(LAS const bf16x8*)(sa + mi * 1024);
                aq[mi][0] = __builtin_amdgcn_mfma_f32_16x16x32_bf16(b0, af, aq[mi][0], 0, 0, 0); aq[mi][1] = __builtin_amdgcn_mfma_f32_16x16x32_bf16(b1, af, aq[mi][1], 0, 0, 0);
                aq[mi][2] = __builtin_amdgcn_mfma_f32_16x16x32_bf16(b2, af, aq[mi][2], 0, 0, 0); }
            if ((q & 7) == 7) {
                const float scale = 0.10206207261596577f * 1.4426950408889634f; const int d0 = (lane >> 4) * 4;
                const int gc = (q >> 3) * 384 + 48 * wave; const bool odd = (wave & 1) != 0;
#pragma unroll
                for (int mi = 0; mi < MT; ++mi) { const int grow = L1P_GROW(mi * 16 + (lane & 15)); const int pos = row_pos(grow);
                    bf16_t* orow = Q1 + (size_t)grow * 1536 + gc;
                    f32x4 v0 = aq[mi][0], v1 = aq[mi][1], v2 = aq[mi][2];
                    if (odd) {
#pragma unroll
                        for (int r = 0; r < 4; ++r) { float2 t;
                            if (mi * 16 < TQ_ROWS) { const lf2 tl = ((LAS const lf2*)(lds + TQ_ADDR(mi * 16 + (lane & 15))))[d0 + r]; t.x = tl[0]; t.y = tl[1]; }
                            else t = cs[pos * 32 + 2 * (d0 + r)];
                            const float x1 = v1[r], x2 = v2[r]; v1[r] = x1 * t.x - x2 * t.y; v2[r] = x2 * t.x + x1 * t.y; } }
                    v0 = v0 * scale; v1 = v1 * scale; v2 = v2 * scale;
                    *(u32x2*)(orow + d0) = (u32x2){pk2(v0[0], v0[1]), pk2(v0[2], v0[3])}; *(u32x2*)(orow + 16 + d0) = (u32x2){pk2(v1[0], v1[1]), pk2(v1[2], v1[3])};
                    *(u32x2*)(orow + 32 + d0) = (u32x2){pk2(v2[0], v2[1]), pk2(v2[2], v2[3])};
                    aq[mi][0] = (f32x4){0.f, 0.f, 0.f, 0.f}; aq[mi][1] = (f32x4){0.f, 0.f, 0.f, 0.f}; aq[mi][2] = (f32x4){0.f, 0.f, 0.f, 0.f}; }
            }
            st = st == 2 ? 0 : st + 1;
        }
#undef Q_ISSUE
#undef TQ_ADDR
    }
    asm volatile("s_waitcnt lgkmcnt(0)" ::: "memory");
    __syncthreads();
}
template <int MT>
__device__ __forceinline__ void l1p_kv_unit(LAS unsigned char* lds, int row0, int mrow0, bf16_t* hb, const bf16_t* __restrict__ ybuf, float* rstd_g, const bf16_t* __restrict__ win_t, const bf16_t* __restrict__ wukv_t,
                                            const float2* __restrict__ cs, bf16_t* kpe, bf16_t* K1, bf16_t* VT1, unsigned* flag) {
    constexpr int BM = 16 * MT, STW = (BM + 256) * 64, KT = BM * 64, CKV = 0, PART = 6 * STW, RB = 40960, STB = 32768;
    static_assert(4 * KT <= RB && RB + 3 * STB <= LDS_MISC && PART + 8 * BM * 4 <= LDS_MISC, "l1p kv lds");
    const int tid = otid(), lane = tid & 63, wave = __builtin_amdgcn_readfirstlane(tid >> 6);
    LAS float* rsl = (LAS float*)(lds + LDS_MISC + 256);
    l1p_combine(64, 128, row0, mrow0, hb, ybuf, rstd_g, lane, wave);
    l1p_exchange(flag + 1, flag, BM, row0, mrow0, rstd_g, rsl, tid);
    const int fro = (lane & 15) * 64 + (((lane >> 4) ^ swzF((lane >> 2) & 3)) << 4);
    f32x4 acc[MT][4];
    {
        f32x4 a2[MT][2];
#pragma unroll
        for (int mi = 0; mi < MT; ++mi) { a2[mi][0] = (f32x4){0.f, 0.f, 0.f, 0.f}; a2[mi][1] = (f32x4){0.f, 0.f, 0.f, 0.f}; }
        l1p_win<MT>(lds, row0, mrow0, hb, win_t, 256, 160, a2, lane, wave);
        typedef float lf2 __attribute__((ext_vector_type(2)));
        for (int r = tid >> 2; r < BM; r += NTHR / 4) { const int part4 = tid & 3; const int pos = row_pos(L1P_GROW(r));
            float2 tv[4];
#pragma unroll
            for (int rr = 0; rr < 4; ++rr) tv[rr] = cs[pos * 32 + 2 * (4 * part4 + rr)];
            LAS lf2* tq = (LAS lf2*)(lds + RB + r * 128) + 4 * part4;
#pragma unroll
            for (int rr = 0; rr < 4; ++rr) tq[rr] = (lf2){tv[rr].x, tv[rr].y}; }
        LAS float* part = (LAS float*)(lds + PART);
#pragma unroll
        for (int mi = 0; mi < MT; ++mi) { const float rs = rsl[mi * 16 + (lane & 15)]; float ss = 0.f;
#pragma unroll
            for (int ni = 0; ni < 2; ++ni) { a2[mi][ni] = a2[mi][ni] * rs; ss += a2[mi][ni][0] * a2[mi][ni][0] + a2[mi][ni][1] * a2[mi][ni][1] + a2[mi][ni][2] * a2[mi][ni][2] + a2[mi][ni][3] * a2[mi][ni][3]; }
            ss = xsum16(ss); ss = xsum32(ss);
            if (lane < 16 && wave < 4) part[wave * BM + mi * 16 + lane] = ss; }
        __syncthreads();
        if (wave < 4) {
#pragma unroll
            for (int mi = 0; mi < MT; ++mi) { const int row = mi * 16 + (lane & 15);
                const float tot = (part[row] + part[BM + row]) + (part[2 * BM + row] + part[3 * BM + row]);
                const float rn = rsqrtf(tot * (1.0f / 128) + EPS);
#pragma unroll
                for (int ni = 0; ni < 2; ++ni) { const int cc = 32 * wave + ni * 16 + (lane >> 4) * 4; const f32x4 v = a2[mi][ni] * rn;
                    *(LAS u32x2*)(lds + CKV + (cc >> 5) * KT + row * 64 + (((((cc & 31) >> 3)) ^ swzF((row >> 2) & 3)) << 4) + (cc & 4) * 2) = (u32x2){pk2(v[0], v[1]), pk2(v[2], v[3])}; } }
        } else if (wave == 4) {
#pragma unroll
            for (int mi = 0; mi < MT; ++mi) { const int row = mi * 16 + (lane & 15); const int grow = L1P_GROW(row); const int pos = row_pos(grow), d0 = (lane >> 4) * 4;
                f32x4 o1, o2;
#pragma unroll
                for (int r = 0; r < 4; ++r) { const lf2 t = ((LAS const lf2*)(lds + RB + row * 128))[d0 + r]; const float x1 = a2[mi][0][r], x2 = a2[mi][1][r]; o1[r] = x1 * t[0] - x2 * t[1]; o2[r] = x2 * t[0] + x1 * t[1]; }
                bf16_t* kr = kpe + ((size_t)row_batch(grow) * LP + pos) * 32;
                *(u32x2*)(kr + d0) = (u32x2){pk2(o1[0], o1[1]), pk2(o1[2], o1[3])}; *(u32x2*)(kr + 16 + d0) = (u32x2){pk2(o2[0], o2[1]), pk2(o2[2], o2[3])}; }
        }
        __syncthreads();
    }
    {
        const int lc = (lane & 3) ^ swzF(lane >> 4);
        const char* srcu[4];
#pragma unroll
        for (int i = 0; i < 4; ++i) srcu[i] = (const char*)(wukv_t + (size_t)((wave + 8 * i) * 16 + (lane >> 2)) * 128) + lc * 16;
#define KV_ISSUE(st, chunk, kt) do { _Pragma("unroll") for (int _i = 0; _i < 4; ++_i) \
        __builtin_amdgcn_global_load_lds((const unsigned*)(srcu[_i] + (size_t)(chunk) * 512 * 256 + (size_t)(kt) * 64), (LAS unsigned*)(lds + RB + (st) * STB + (wave + 8 * _i) * 1024), 16, 0, 0); } while (0)
#pragma unroll
        for (int mi = 0; mi < MT; ++mi)
#pragma unroll
            for (int ni = 0; ni < 4; ++ni) acc[mi][ni] = (f32x4){0.f, 0.f, 0.f, 0.f};
        KV_ISSUE(0, 0, 0); KV_ISSUE(1, 0, 1);
        int st = 0;
#define KV_STEP(SWAP) do { \
            if (q + 1 < 16) wait_vm<4>(); else wait_vm<0>(); \
            __builtin_amdgcn_s_barrier(); asm volatile("" ::: "memory"); \
            if (q + 2 < 16) KV_ISSUE(st == 0 ? 2 : st - 1, (q + 2) >> 2, (q + 2) & 3); \
            LAS const unsigned char* sa = lds + CKV + (q & 3) * KT + fro; \
            LAS const unsigned char* sb = lds + RB + st * STB + (wave * 64) * 64 + fro; \
            bf16x8 bfr[4]; \
            _Pragma("unroll") for (int ni = 0; ni < 4; ++ni) bfr[ni] = *(LAS const bf16x8*)(sb + ni * 1024); \
            _Pragma("unroll") for (int mi = 0; mi < MT; ++mi) { const bf16x8 af = *(LAS const bf16x8*)(sa + mi * 1024); \
                _Pragma("unroll") for (int ni = 0; ni < 4; ++ni) acc[mi][ni] = (SWAP) ? __builtin_amdgcn_mfma_f32_16x16x32_bf16(af, bfr[ni], acc[mi][ni], 0, 0, 0) \
                                                                                       : __builtin_amdgcn_mfma_f32_16x16x32_bf16(bfr[ni], af, acc[mi][ni], 0, 0, 0); } \
            st = st == 2 ? 0 : st + 1; } while (0)
        for (int q = 0; q < 8; ++q) {
            KV_STEP(false);
            if ((q & 3) == 3) { const int ch = q >> 2;
                int lane_k = lane; asm volatile("" : "+v"(lane_k));
#pragma unroll
                for (int mi = 0; mi < MT; ++mi) { const int grow = L1P_GROW(mi * 16 + (lane_k & 15)); const size_t kr = (size_t)row_batch(grow) * LP + row_pos(grow);
#pragma unroll
                    for (int ni = 0; ni < 4; ++ni) { const f32x4 v = acc[mi][ni];
                        *(u32x2*)(K1 + kr * D + 512 * ch + 64 * wave + ni * 16 + (lane_k >> 4) * 4) = (u32x2){pk2(v[0], v[1]), pk2(v[2], v[3])}; acc[mi][ni] = (f32x4){0.f, 0.f, 0.f, 0.f}; } }
            }
        }
        for (int q = 8; q < 16; ++q) {
            KV_STEP(true);
            if ((q & 3) == 3) { const int ch = q >> 2;
                int lane_k = lane; asm volatile("" : "+v"(lane_k));
#pragma unroll
                for (int mi = 0; mi < MT; ++mi) { const int grow0 = L1P_GROW(mi * 16 + (lane_k >> 4) * 4); const int b = row_batch(grow0), pp = perm16(row_pos(grow0));
#pragma unroll
                    for (int ni = 0; ni < 4; ++ni) { const int hd = 512 * (ch - 2) + 64 * wave + ni * 16 + (lane_k & 15); const f32x4 v = acc[mi][ni];
                        *(u32x2*)(VT1 + (size_t)(b * 1024 + hd) * LP + pp) = (u32x2){pk2(v[0], v[1]), pk2(v[2], v[3])}; acc[mi][ni] = (f32x4){0.f, 0.f, 0.f, 0.f}; } }
            }
        }
#undef KV_STEP
#undef KV_ISSUE
    }
    asm volatile("s_waitcnt lgkmcnt(0)" ::: "memory");
    __syncthreads();
}
#undef L1P_GROW
__device__ __forceinline__ void l1proj_phase(LAS unsigned char* lds, bf16_t* hb, const bf16_t* ybuf, const bf16_t* win_t, const bf16_t* wuq_t, const bf16_t* wukv_t, const float2* cs, bf16_t* kpe,
                                             bf16_t* Q1, bf16_t* K1, bf16_t* VT1, int bid, int nblk, float* rstd_g, unsigned* pairflags) {
    { const int gt = bid * NTHR + threadIdx.x, ngt = nblk * NTHR;
      for (int idx = gt; idx < 2 * 48 * 1024; idx += ngt) { const int b = idx / (48 * 1024), r = idx % (48 * 1024); K1[((size_t)b * LP + 8208) * 1024 + r] = 0; }
      for (int idx = gt; idx < 2 * 16 * 64 * 48; idx += ngt) { const int rr = idx / 48, c = idx % 48; VT1[(size_t)rr * LP + 8208 + c] = 0; } }
    if (nblk == 256) {
        const int role = (bid >> 3) & 1, pr = ((bid >> 4) << 3) | (bid & 7);
        unsigned* flag = pairflags + 16 * pr;
        const int row0 = 128 * pr, mrow0 = MREAL + (pr - 126) * 16;
        if (role == 0) { if (pr >= 126) l1p_q_unit<9>(lds, row0, mrow0, hb, ybuf, rstd_g, win_t, wuq_t, cs, Q1, flag); else l1p_q_unit<8>(lds, row0, MREAL, hb, ybuf, rstd_g, win_t, wuq_t, cs, Q1, flag); }
        else { if (pr >= 126) l1p_kv_unit<9>(lds, row0, mrow0, hb, ybuf, rstd_g, win_t, wukv_t, cs, kpe, K1, VT1, flag); else l1p_kv_unit<8>(lds, row0, MREAL, hb, ybuf, rstd_g, win_t, wukv_t, cs, kpe, K1, VT1, flag); }
        return;
    }
    for (int u = bid; u < 256; u += nblk) {
        if (u >= 254) l1proj_unit<5>(lds, u * 64, MREAL + (u - 254) * 16, hb, ybuf, win_t, wuq_t, wukv_t, cs, kpe, Q1, K1, VT1);
        else l1proj_unit<4>(lds, u * 64, MREAL, hb, ybuf, win_t, wuq_t, wukv_t, cs, kpe, Q1, K1, VT1);
    }
}

struct EpiNull { int m0, n0;
    template <int MT, int NT> __device__ __forceinline__ void operator()(f32x4 (&acc)[MT][NT], int, int, int) const {
#pragma unroll
        for (int mi = 0; mi < MT; ++mi)
#pragma unroll
            for (int ni = 0; ni < NT; ++ni) asm volatile("" :: "v"(acc[mi][ni])); } };
__device__ __forceinline__ void transpose_item(const float* __restrict__ W, int N, const float* __restrict__ gain, bf16_t* dst, int ldk, int drow0, int k0, int n0, LAS float* scr, int lane, int dskip = 0) {
    { float wv[32], gv[32];
#pragma unroll
      for (int i = 0; i < 32; ++i) { const int kk = 2 * i + (lane >> 5); wv[i] = __builtin_nontemporal_load(W + (size_t)(k0 + kk) * N + n0 + (lane & 31)); gv[i] = gain ? gain[k0 + kk] : 1.0f; }
#pragma unroll
      for (int i = 0; i < 32; ++i) { const int kk = 2 * i + (lane >> 5); scr[kk * 33 + (lane & 31)] = wv[i] * gv[i]; } }
    asm volatile("s_waitcnt lgkmcnt(0)" ::: "memory");
    const int c = lane & 7;
#pragma unroll
    for (int j = 0; j < 4; ++j) { const int n = (lane >> 3) + 8 * j; const LAS float* s = scr + (8 * c) * 33 + n;
        u32x4 o; o.x = pk2(s[0 * 33], s[1 * 33]); o.y = pk2(s[2 * 33], s[3 * 33]); o.z = pk2(s[4 * 33], s[5 * 33]); o.w = pk2(s[6 * 33], s[7 * 33]);
        *(u32x4*)(dst + (size_t)(drow0 + n + (n >= 16 ? dskip : 0)) * ldk + k0 + 8 * c) = o; }
    asm volatile("s_waitcnt lgkmcnt(0)" ::: "memory");
}
struct MoeItem { const float* src; const float* gain; bf16_t* dst; int pitch, ldk, kind, nrow0; };
__device__ __forceinline__ MoeItem moe_item(int it, const float* wgate, const float* wup, const float* wdown, const float* gain, bf16_t* wgu_t, bf16_t* wd_t) {
    const int e = it / 48, r = it % 48, which = r >> 4, q = r & 15; MoeItem d;
    if (which < 2) { d.src = (which ? wup : wgate) + (size_t)e * D * DE + (size_t)q * 64 * DE; d.gain = gain + q * 64; d.dst = wgu_t + (size_t)e * 512 * 1024 + q * 64; d.pitch = DE; d.ldk = 1024; d.kind = which; d.nrow0 = 0; }
    else { const int kb = q >> 2, nb = q & 3; d.src = wdown + (size_t)e * DE * D + (size_t)kb * 64 * D + nb * 256; d.gain = nullptr; d.dst = wd_t + (size_t)e * 1024 * 256 + kb * 64; d.pitch = D; d.ldk = 256; d.kind = 2; d.nrow0 = nb * 256; }
    return d;
}
__device__ __forceinline__ void moe_weight_items(const float* wgate, const float* wup, const float* wdown, const float* gain, bf16_t* wgu_t, bf16_t* wd_t, LAS float* T, int bid, int nblk) {
    const int tid = threadIdx.x;
    f32x4 R[8]; float G[8];
    int it = bid;
    if (it >= NE * 48) return;
    MoeItem cur = moe_item(it, wgate, wup, wdown, gain, wgu_t, wd_t);
#define MW_LOAD(M) do { _Pragma("unroll") for (int i = 0; i < 8; ++i) { const int idx = tid + i * NTHR; \
            R[i] = __builtin_nontemporal_load((const f32x4*)((M).src + (size_t)(idx >> 6) * (M).pitch + (idx & 63) * 4)); G[i] = (M).gain ? (M).gain[idx >> 6] : 1.0f; } } while (0)
    MW_LOAD(cur);
    for (;;) {
#pragma unroll
        for (int i = 0; i < 8; ++i) { const int idx = tid + i * NTHR, k = idx >> 6, c4 = idx & 63; const f32x4 v = R[i] * G[i];
            LAS float* t = T + k * 257 + c4 * 4; t[0] = v[0]; t[1] = v[1]; t[2] = v[2]; t[3] = v[3]; }
        __syncthreads();
        const int nit = it + nblk; const bool more = nit < NE * 48;
        MoeItem nxt = cur;
        if (more) { nxt = moe_item(nit, wgate, wup, wdown, gain, wgu_t, wd_t); MW_LOAD(nxt); }
#pragma unroll
        for (int i = 0; i < 4; ++i) { const int idx = tid + i * NTHR, kc = idx & 7, n = idx >> 3;
            const LAS float* t = T + (8 * kc) * 257 + n;
            u32x4 o; o.x = pk2(t[0], t[257]); o.y = pk2(t[2 * 257], t[3 * 257]); o.z = pk2(t[4 * 257], t[5 * 257]); o.w = pk2(t[6 * 257], t[7 * 257]);
            const int row = cur.kind == 2 ? cur.nrow0 + n : (n >> 4) * 32 + cur.kind * 16 + (n & 15);
            *(u32x4*)(cur.dst + (size_t)row * cur.ldk + 8 * kc) = o; }
        __syncthreads();
        if (!more) break;
        cur = nxt; it = nit;
    }
#undef MW_LOAD
}
__device__ __forceinline__ void p0_prologue(const MArgs& a, LAS unsigned char* lds, int bid, int nblk) {
    const int tid = otid(), lane = tid & 63, wave = __builtin_amdgcn_readfirstlane(tid >> 6);
    const int gw = bid * NWAVE + wave, ngw = nblk * NWAVE, gt = bid * NTHR + tid, ngt = nblk * NTHR;
    unsigned char* ws = a.ws;
    float2* cs = (float2*)(ws + WS_ROPE);
    for (int _r = 0; _r < (PROBE_PHASE == 301 ? 2 : 1); ++_r)
    for (int idx = gt; idx < LPOS * 32; idx += ngt) { const int pos = idx >> 5, i = idx & 31; const float inv = 1.0f / powf(10000.0f, (float)(2 * i) / 64.0f); float s, c; sincosf((float)pos * inv, &s, &c); cs[idx] = make_float2(c, s); }
    float* wrf = (float*)(ws + W2_WRF);
    for (int idx = gt; idx < 2 * 36 * 1024; idx += ngt) { const int l = idx / (36 * 1024), j = (idx >> 10) % 36, k = idx & 1023;
        const float g = a.in[3][l * D + k]; wrf[idx] = g * (j < 4 ? a.in[16][(size_t)l * D * 4 + k * 4 + j] : a.in[18][(size_t)l * D * 32 + k * 32 + (j - 4)]); }
    { u32x4* z = (u32x4*)(ws + W2_WIN + (size_t)416 * 1024 * 2); for (int idx = gt; idx < 96 * 1024 * 2 / 16; idx += ngt) z[idx] = (u32x4){0u, 0u, 0u, 0u}; }
    { bf16_t* kpe = (bf16_t*)(ws + WS_KPE); for (int idx = gt; idx < 2 * 48 * 32; idx += ngt) { const int b = idx / (48 * 32), r = idx % (48 * 32); kpe[((size_t)b * LP + 8208) * 32 + r] = 0; }
      bf16_t* vt0 = (bf16_t*)(ws + B_VT0); for (int idx = gt; idx < 2 * 2 * 64 * 48; idx += ngt) { const int rr = idx / 48, c = idx % 48; vt0[(size_t)rr * LP + 8208 + c] = 0; } }
    { bf16_t* hb = (bf16_t*)(ws + W2_HB); float* rstd = (float*)(ws + W2_RSTD);
      if (gw >= ngw - (MTOT - MREAL)) { const int r = MREAL + (gw - (ngw - (MTOT - MREAL))); const float* src = a.in[1] + (size_t)row_pos(r) * D;
        f32x4 w[4]; float ss = 0.f;
#pragma unroll
        for (int j = 0; j < 4; ++j) w[j] = __builtin_nontemporal_load((const f32x4*)(src + j * 256 + lane * 4));
#pragma unroll
        for (int j = 0; j < 4; ++j) { ss += w[j][0] * w[j][0] + w[j][1] * w[j][1] + w[j][2] * w[j][2] + w[j][3] * w[j][3];
            *(u32x2*)(hb + (size_t)r * D + j * 256 + lane * 4) = (u32x2){pk2(w[j][0], w[j][1]), pk2(w[j][2], w[j][3])}; }
        ss = wave_sum(ss);
        if (lane == 0) rstd[r] = rsqrtf(ss * (1.0f / D) + EPS); }
      for (int row = gw; row < MREAL; row += 4 * ngw) {
        f32x4 v[4][4];
#pragma unroll
        for (int k = 0; k < 4; ++k) { const int r = row + k * ngw; const int rc = r < MREAL ? r : row;
            const float* src = a.in[0] + (size_t)rc * D;
#pragma unroll
            for (int j = 0; j < 4; ++j) v[k][j] = __builtin_nontemporal_load((const f32x4*)(src + j * 256 + lane * 4)); }
        float ss[4];
#pragma unroll
        for (int k = 0; k < 4; ++k) { const int r = row + k * ngw; ss[k] = 0.f;
#pragma unroll
            for (int j = 0; j < 4; ++j) { const f32x4 w = v[k][j]; ss[k] += w[0] * w[0] + w[1] * w[1] + w[2] * w[2] + w[3] * w[3];
                if (r < MREAL) *(u32x2*)(hb + (size_t)r * D + j * 256 + lane * 4) = (u32x2){pk2(w[0], w[1]), pk2(w[2], w[3])}; } }
#pragma unroll
        for (int k = 0; k < 4; ++k) ss[k] = wave_sum(ss[k]);
#pragma unroll
        for (int k = 0; k < 4; ++k) { const int r = row + k * ngw; if (lane == 0 && r < MREAL) rstd[r] = rsqrtf(ss[k] * (1.0f / D) + EPS); }
      } }
    LAS float* scr = (LAS float*)(lds + wave * 16384);
    for (int _r = 0; _r < (PROBE_PHASE == 304 ? 2 : 1); ++_r)
    for (int it = gw; it < 2192; it += ngw) {
        int r = it;
        if (r < 640) { const int nb = r % 40;
            transpose_item(a.in[5], NQKV, a.in[2], (bf16_t*)(ws + W2_WQKV), 1024, nb < 32 ? 64 * (nb >> 1) + 16 * (nb & 1) : nb * 32, (r / 40) * 64, nb * 32, scr, lane, nb < 32 ? 16 : 0); continue; } r -= 640;
        if (r < 512) { transpose_item(a.in[8], D, nullptr, (bf16_t*)(ws + W2_WO0), 1024, (r & 31) * 32, (r >> 5) * 64, (r & 31) * 32, scr, lane); continue; } r -= 512;
        if (r < 208) { transpose_item(a.in[10], 416, a.in[2] + D, (bf16_t*)(ws + W2_WIN), 1024, (r % 13) * 32, (r / 13) * 64, (r % 13) * 32, scr, lane); continue; } r -= 208;
        if (r < 192) { transpose_item(a.in[13], 1536, a.in[11], (bf16_t*)(ws + W2_WUQ), 256, (r % 48) * 32, (r / 48) * 64, (r % 48) * 32, scr, lane); continue; } r -= 192;
        if (r < 128) { const int nb32 = r & 63, hh = nb32 >> 2, part = nb32 & 3;
            transpose_item(a.in[14], 2048, a.in[12], (bf16_t*)(ws + W2_WUKV), 128, part < 2 ? hh * 64 + part * 32 : 1024 + hh * 64 + (part - 2) * 32, (r >> 6) * 64, nb32 * 32, scr, lane); continue; } r -= 128;
        transpose_item(a.in[15], D, nullptr, (bf16_t*)(ws + W2_WO1), 1024, (r & 31) * 32, (r >> 5) * 64, (r & 31) * 32, scr, lane);
    }
    __syncthreads();
    moe_weight_items(a.in[20], a.in[21], a.in[22], a.in[3], (bf16_t*)(ws + C_W0), (bf16_t*)(ws + C_W0 + MOE_WGU_BYTES), (LAS float*)lds, bid, nblk);
}

template <bool NSW, bool HALFN, class MakeEpi>
__device__ __forceinline__ void gemm_phase(LAS unsigned char* lds, const bf16_t* A, int lda, const bf16_t* Bt, int K, int pn0, int pn1, int bid, int nblk, const MakeEpi& mk) {
    constexpr int BN = HALFN ? 128 : 256;
    const int ntn = pn1 - pn0;
    const bool grp = (nblk % 8) == 0;
    const int x = grp ? bid % 8 : 0, j = grp ? bid / 8 : bid, nslot = grp ? nblk / 8 : nblk, pmg = grp ? 8 : 64;
    for (int u = j; u < pmg * ntn; u += nslot) {
        const int pm = x * pmg + u / ntn, pn = pn0 + u % ntn;
        RowDense ra{A, lda, pm * 256, MTOT - 1}; auto e = mk(pm * 256, pn * BN);
        if (HALFN) gemm_tile<4, 4, 4, 2, NSW>(lds, ra, Bt + (size_t)pn * BN * K, K, K / 32, e);
        else gemm_tile<8, 4, 2, 4, NSW>(lds, ra, Bt + (size_t)pn * BN * K, K, K / 32, e);
    }
    const int nfull = (pmg * ntn + nslot - 1) / nslot;
    for (int pn = pn0; pn < pn1; ++pn) {
        const int owner = (pn - pn0) * 37 % nblk;
        if (bid == owner) { RowDense ra{A, lda, MREAL, MTOT - 1}; auto e = mk(MREAL, pn * BN);
            if (HALFN) gemm_tile<1, 4, 4, 2, NSW>(lds, ra, Bt + (size_t)pn * BN * K, K, K / 32, e);
            else gemm_tile<1, 4, 2, 4, NSW>(lds, ra, Bt + (size_t)pn * BN * K, K, K / 32, e); }
    }
    (void)nfull;
}

constexpr int PH_PROLOGUE = 0, PH_QKV = 1, PH_SWA = 2, PH_OPROJ0 = 3, PH_ROUTE0 = 4, PH_MOE0 = 5, PH_COMBINE = 6, PH_WIN = 7, PH_CEPI = 8, PH_UQKV = 9, PH_MLA = 10, PH_OPROJ1 = 11, PH_ROUTE1 = 12, PH_MOE1 = 13, PH_FINAL = 14, PH_N = 15;
__global__ void __launch_bounds__(NTHR, 2) mega(MArgs a) {
    extern __shared__ __attribute__((aligned(16))) unsigned char lds_raw[];
    LAS unsigned char* lds = (LAS unsigned char*)lds_raw;
    const int tid = threadIdx.x, bid = blockIdx.x, nblk = gridDim.x;
    volatile LAS unsigned* misc = (volatile LAS unsigned*)(lds + LDS_MISC);
    if (tid < 64) misc[tid] = 0u;
    __syncthreads();
    unsigned char* ws = a.ws;
    XcdBarrier bar = xcd_barrier_post((unsigned*)(ws + WS_BAR) + a.li * XCD_BAR_WORDS, misc);
    if (tid == 0) misc[4] = xb_add((unsigned*)(ws + 32 * 1024) + 64 * bar.x, 1u);
    const int lo = a.ph_lo, hi = a.ph_hi;
#define IN(k) (lo <= (k) && (k) < hi)
#define REP(k) for (int _rep = 0; _rep < ((k) == PROBE_PHASE ? 2 : 1); ++_rep, (void)((k) == PROBE_PHASE && _rep == 1 ? (xcd_barrier(bar), 0) : 0))
#define STAMP(i) do { if (PROBE_PHASE >= 600 && bid == 0 && tid == 0) ((unsigned long long*)(ws + 512 * 1024))[i] = __builtin_amdgcn_s_memrealtime(); } while (0)
#define SEAM(k) do { if (IN(k) && IN((k) + 1)) xcd_barrier(bar); STAMP((k) + 1); } while (0)
    STAMP(0);
    if (IN(PH_PROLOGUE)) REP(PH_PROLOGUE) p0_prologue(a, lds, bid, nblk);
    SEAM(PH_PROLOGUE);
    int vbid = bid;
    if (IN(PH_PROLOGUE) && IN(PH_QKV)) {
        if (tid == 0) { bool ok = (nblk % 8) == 0 && bar.x < 8;
            for (int j = 0; j < 8; ++j) ok = ok && xb_ld((unsigned*)(ws + 32 * 1024) + 64 * j) == (unsigned)(nblk / 8);
            misc[5] = ok ? misc[4] * 8u + bar.x : (unsigned)bid; }
        __syncthreads();
        vbid = __builtin_amdgcn_readfirstlane((int)misc[5]);
    }
#define bid vbid
    if (IN(PH_QKV)) REP(PH_QKV) {
        const float* rstd = (const float*)(ws + W2_RSTD); const float* bias = a.in[6]; const float2* cs = (const float2*)(ws + WS_ROPE); bf16_t* qkv = (bf16_t*)(ws + B_QKV); bf16_t* vt0 = (bf16_t*)(ws + B_VT0);
        const bf16_t* hbA = (const bf16_t*)(ws + W2_HB); const bf16_t* Wt = (const bf16_t*)(ws + W2_WQKV);
        const bool grp = (nblk % 8) == 0; const int x = grp ? bid % 8 : 0, j = grp ? bid / 8 : bid, nslot = grp ? nblk / 8 : nblk, pmg = grp ? 8 : 64;
        const bool usepg = nblk == 256;
        if (usepg) { pg8::Gemm g{hbA, Wt, MREAL, 1024, D}; pg8::StaticOrder S; S.init(MREAL, 1024, nblk, bid);
            PgEpiQ E{rstd, bias, cs, qkv};
            pg8::gemm_phase<PgEpiQ, pg8::StaticOrder, true, true>(lds, g, S, E); }
        for (int u = usepg ? pmg * 4 + j : j; u < pmg * 6; u += nslot) {
            if (u < pmg * 4) { const int pm = x * pmg + (u >> 2), pn = u & 3; RowDense ra{hbA, D, pm * 256, MTOT - 1}; EpiQKV e{rstd, bias, cs, qkv, pm * 256, pn * 256, true};
                gemm_tile<8, 4, 2, 4, false>(lds, ra, Wt + (size_t)pn * 256 * D, D, D / 32, e);
            } else if (u < pmg * 5) { const int pm = x * pmg + (u - pmg * 4); RowDense ra{hbA, D, pm * 256, MTOT - 1}; EpiQKV e{rstd, bias, cs, qkv, pm * 256, 1024, false};
                gemm_tile<4, 4, 4, 2, false>(lds, ra, Wt + (size_t)1024 * D, D, D / 32, e);
            } else { const int pm = x * pmg + (u - pmg * 5); RowDense ra{hbA, D, pm * 256, MTOT - 1}; EpiV0 e{rstd, bias, vt0, pm * 256, 1152};
                gemm_tile<4, 4, 4, 2, true>(lds, ra, Wt + (size_t)1152 * D, D, D / 32, e);
            }
        }
        const int mu = bid - (nblk - 6);
        if (mu >= 0 && mu < 4) { RowDense ra{hbA, D, MREAL, MTOT - 1}; EpiQKV e{rstd, bias, cs, qkv, MREAL, mu * 256, true};
            gemm_tile<1, 4, 2, 4, false>(lds, ra, Wt + (size_t)mu * 256 * D, D, D / 32, e);
        } else if (mu == 4) { RowDense ra{hbA, D, MREAL, MTOT - 1}; EpiQKV e{rstd, bias, cs, qkv, MREAL, 1024, false};
            gemm_tile<1, 4, 4, 2, false>(lds, ra, Wt + (size_t)1024 * D, D, D / 32, e);
        } else if (mu == 5) { RowDense ra{hbA, D, MREAL, MTOT - 1}; EpiV0 e{rstd, bias, vt0, MREAL, 1152};
            gemm_tile<1, 4, 4, 2, true>(lds, ra, Wt + (size_t)1152 * D, D, D / 32, e);
        }
    }
    SEAM(PH_QKV);
    if (IN(PH_SWA)) REP(PH_SWA) swa_phase(lds, (const bf16_t*)(ws + B_QKV), (const bf16_t*)(ws + B_VT0), a.in[7], (bf16_t*)(ws + B_O0), bid, nblk);
    SEAM(PH_SWA);
    if (IN(PH_OPROJ0)) REP(PH_OPROJ0) {
        const float* bias = a.in[9]; bf16_t* hb = (bf16_t*)(ws + W2_HB);
        if (nblk == 256) { pg8::Gemm g{(const bf16_t*)(ws + B_O0), (const bf16_t*)(ws + W2_WO0), MREAL, D, D}; pg8::StaticOrder S; S.init(MREAL, D, nblk, bid); PgEpiRes E{bias, hb};
            pg8::gemm_phase<PgEpiRes, pg8::StaticOrder, true, true>(lds, g, S, E);
            if ((bid & 15) == 5) { const int pc = bid >> 4; RowDense ra{(const bf16_t*)(ws + B_O0), D, MREAL, MTOT - 1}; EpiRes e{bias, hb, MREAL, pc * 64};
                gemm_tile<1, 1, 2, 4, false>(lds, ra, (const bf16_t*)(ws + W2_WO0) + (size_t)pc * 64 * D, D, D / 32, e); }
        } else
        gemm_phase<false, false>(lds, (const bf16_t*)(ws + B_O0), D, (const bf16_t*)(ws + W2_WO0), D, 0, 4, bid, nblk, [=](int m0, int n0) { return EpiRes{bias, hb, m0, n0}; });
    }
    SEAM(PH_OPROJ0);
    if (IN(PH_ROUTE0))
        route_phase(lds, (const bf16_t*)(ws + W2_HB), (const float*)(ws + W2_WRF), a.in[17], a.in[19], (float*)(ws + W2_RSTD), (int*)(ws + WS_CTL),
                    (int*)(ws + W2_LIST), (float*)(ws + W2_WSLOT), bid, nblk);
    SEAM(PH_ROUTE0);
    if (IN(PH_MOE0)) REP(PH_MOE0) moe_phase(lds, (int*)(ws + WS_CTL), (const int*)(ws + W2_LIST), (const bf16_t*)(ws + W2_HB), (const float*)(ws + W2_RSTD), (const float*)(ws + W2_WSLOT),
                               (const bf16_t*)(ws + C_W0), (const bf16_t*)(ws + C_W0 + MOE_WGU_BYTES), (bf16_t*)(ws + B_Y0), bid, nblk, (unsigned long long*)(ws + 512 * 1024));
    SEAM(PH_MOE0);
    if (IN(PH_COMBINE)) l1proj_phase(lds, (bf16_t*)(ws + W2_HB), (const bf16_t*)(ws + B_Y0), (const bf16_t*)(ws + W2_WIN), (const bf16_t*)(ws + W2_WUQ), (const bf16_t*)(ws + W2_WUKV),
                                     (const float2*)(ws + WS_ROPE), (bf16_t*)(ws + WS_KPE), (bf16_t*)(ws + C_Q1), (bf16_t*)(ws + C_K1), (bf16_t*)(ws + C_V1), bid, nblk,
                                     (float*)(ws + W2_RSTD), (unsigned*)(ws + WS_PAIR));
    STAMP(PH_WIN); STAMP(PH_CEPI); STAMP(PH_UQKV);
    SEAM(PH_UQKV);
    if (IN(PH_MLA)) REP(100) {
        moe_weight_items(a.in[20] + (size_t)NE * D * DE, a.in[21] + (size_t)NE * D * DE, a.in[22] + (size_t)NE * DE * D, a.in[3] + D, (bf16_t*)(ws + B_W1), (bf16_t*)(ws + B_W1 + MOE_WGU_BYTES),
                         (LAS float*)lds, bid, nblk);
    }
    if (IN(PH_MLA)) REP(PH_MLA) mla_phase(lds, (const bf16_t*)(ws + C_Q1), (const bf16_t*)(ws + C_K1), (const bf16_t*)(ws + WS_KPE), (const bf16_t*)(ws + C_V1), (bf16_t*)(ws + B_O1), bid, nblk);
    SEAM(PH_MLA);
    if (IN(PH_OPROJ1)) REP(PH_OPROJ1) {
        bf16_t* hb = (bf16_t*)(ws + W2_HB);
        if (nblk == 256) { pg8::Gemm g{(const bf16_t*)(ws + B_O1), (const bf16_t*)(ws + W2_WO1), MREAL, D, D}; pg8::StaticOrder S; S.init(MREAL, D, nblk, bid); PgEpiRes E{nullptr, hb};
            pg8::gemm_phase<PgEpiRes, pg8::StaticOrder, true, true>(lds, g, S, E);
            if ((bid & 15) == 5) { const int pc = bid >> 4; RowDense ra{(const bf16_t*)(ws + B_O1), D, MREAL, MTOT - 1}; EpiRes e{nullptr, hb, MREAL, pc * 64};
                gemm_tile<1, 1, 2, 4, false>(lds, ra, (const bf16_t*)(ws + W2_WO1) + (size_t)pc * 64 * D, D, D / 32, e); }
        } else
        gemm_phase<false, false>(lds, (const bf16_t*)(ws + B_O1), D, (const bf16_t*)(ws + W2_WO1), D, 0, 4, bid, nblk, [=](int m0, int n0) { return EpiRes{nullptr, hb, m0, n0}; });
    }
    SEAM(PH_OPROJ1);
    if (IN(PH_ROUTE1))
        route_phase(lds, (const bf16_t*)(ws + W2_HB), (const float*)(ws + W2_WRF) + 36 * 1024, a.in[17] + 4, a.in[19] + 32, (float*)(ws + W2_RSTD), (int*)(ws + WS_CTL) + 2048,
                    (int*)(ws + W2_LIST), (float*)(ws + W2_WSLOT), bid, nblk);
    SEAM(PH_ROUTE1);
    if (IN(PH_MOE1)) REP(PH_MOE1) moe_phase(lds, (int*)(ws + WS_CTL) + 2048, (const int*)(ws + W2_LIST), (const bf16_t*)(ws + W2_HB), (const float*)(ws + W2_RSTD), (const float*)(ws + W2_WSLOT),
                               (const bf16_t*)(ws + B_W1), (const bf16_t*)(ws + B_W1 + MOE_WGU_BYTES), (bf16_t*)(ws + C_Y1), bid, nblk);
    SEAM(PH_MOE1);
    if (IN(PH_FINAL)) REP(PH_FINAL) final_phase((const bf16_t*)(ws + W2_HB), (const bf16_t*)(ws + C_Y1), a.in[4], a.out, bid, nblk);
#undef bid
#undef IN
#undef SEAM
}

static void run_mega(hipStream_t s, const MArgs& base, int lo, int hi, int grid) {
    MArgs a = base; a.ph_lo = lo; a.ph_hi = hi; a.li = lo;
    hipLaunchKernelGGL(mega, dim3(grid), dim3(NTHR), LDS_BYTES, s, a);
}
extern "C" void kernel_launch(void* const* d_in, const int* in_sizes, int n_in, void* d_out, int out_size, void* d_ws, size_t ws_size, hipStream_t stream) {
    static int grid = 0;
    if (grid == 0) {
        if (n_in != 23 || ws_size < WS_END) { fprintf(stderr, "kernel_launch: unexpected n_in %d or ws_size %zu\n", n_in, ws_size); grid = -1; return; }
        if (hipFuncSetAttribute((const void*)mega, hipFuncAttributeMaxDynamicSharedMemorySize, LDS_BYTES) != hipSuccess) { fprintf(stderr, "hipFuncSetAttribute failed\n"); grid = -1; return; }
        int dev = 0, cus = 0, per_cu = 0;
        (void)hipGetDevice(&dev); (void)hipDeviceGetAttribute(&cus, hipDeviceAttributeMultiprocessorCount, dev);
        (void)hipOccupancyMaxActiveBlocksPerMultiprocessor(&per_cu, (const void*)mega, NTHR, LDS_BYTES);
        (void)hipGetLastError();
        if (per_cu < 1 || cus < 8) { fprintf(stderr, "kernel_launch: occupancy query reports %d workgroups/CU on %d CUs for %d threads + %d B LDS; nothing launched\n", per_cu, cus, NTHR, LDS_BYTES); grid = -1; return; }
        grid = cus;
    }
    if (grid < 0) return;
    (void)in_sizes; (void)out_size;
    unsigned char* ws = (unsigned char*)d_ws;
    MArgs base{}; for (int i = 0; i < 23; ++i) base.in[i] = (const float*)d_in[i]; base.out = (float*)d_out; base.ws = ws;
    (void)hipMemsetAsync(ws + WS_CTL, 0, 1 * MiB, stream);
    run_mega(stream, base, 0, PH_N, grid);
}
```
